# Optimizing an MI355X kernel written in HIP

```python
import jax, jax.numpy as jnp
from jax import lax
import numpy as np

D_MODEL = 1024
BATCH = 4
SEQ = 8192
DEPTH = 4

GRID_W = 64
CTX_LEN = 256
N_MIXERS = 2
N_A = (DEPTH + N_MIXERS - 1) // N_MIXERS
N_B = DEPTH // N_MIXERS
D_INNER = 2 * D_MODEL
M_HEADS = 4
M_HEAD_DIM = D_INNER // M_HEADS
CHUNK = 64
CONV_K = 3
F_GROUPS = 4
D_FF = 4 * D_MODEL
ALPHA = float((2 * DEPTH) ** 0.25)
BETA = float((8 * DEPTH) ** -0.25)
LN_EPS = 1e-5

kernel_name = "hybrid_mlstm_fourier_prefix_dit"


def layer_norm(x):
    xf = x.astype(jnp.float32)
    mu = xf.mean(-1, keepdims=True)
    var = jnp.square(xf - mu).mean(-1, keepdims=True)
    return ((xf - mu) * lax.rsqrt(var + LN_EPS)).astype(x.dtype)


def modulate(x, shift, scale):
    return layer_norm(x) * (1 + scale) + shift


def post_norm(x, g, b):
    return layer_norm(x) * g + b


def conv_grid(x, w):
    B, T, C = x.shape
    rows = T // GRID_W
    y = lax.conv_general_dilated(
        x.reshape(B, rows, GRID_W, C), w[:, :, None, :], window_strides=(1, 1), padding="SAME",
        dimension_numbers=("NHWC", "HWIO", "NHWC"), feature_group_count=C)
    return y.reshape(B, T, C)


def conv_seq(x, w):
    C = x.shape[-1]
    return lax.conv_general_dilated(
        x, w[CONV_K // 2][:, None, :], window_strides=(1,), padding="SAME",
        dimension_numbers=("NWC", "WIO", "NWC"), feature_group_count=C)


def mlstm_chunkwise(q, k, v, log_i, log_f, state):
    B, H, T, dh = q.shape
    nc = T // CHUNK

    def to_chunks(a):
        return jnp.moveaxis(a.reshape(a.shape[:2] + (nc, CHUNK) + a.shape[3:]), 2, 0)

    tril = jnp.tril(jnp.ones((CHUNK, CHUNK), dtype=bool))

    def step(carry, inp):
        C, n, m = carry
        qc, kc, vc, li, lf = inp
        b = jnp.cumsum(lf, axis=-1)
        a_inter = b + m[..., None]
        log_w = jnp.where(tril, b[..., :, None] - b[..., None, :] + li[..., None, :], -jnp.inf)
        m_row = jnp.maximum(a_inter, log_w.max(-1))
        w_inter = jnp.exp(a_inter - m_row)
        s = jnp.einsum("bhld,bhsd->bhls", qc, kc).astype(jnp.float32) * jnp.exp(log_w - m_row[..., None])
        num = (w_inter[..., None] * jnp.einsum("bhed,bhld->bhle", C, qc)
               + jnp.einsum("bhls,bhse->bhle", s, vc))
        den = w_inter * jnp.einsum("bhd,bhld->bhl", n, qc) + s.sum(-1)
        h = num / jnp.maximum(jnp.abs(den), jnp.exp(-m_row))[..., None]
        m_new = m_row[..., -1]
        w_k = jnp.exp(b[..., -1:] - b + li - m_new[..., None])
        decay = jnp.exp(b[..., -1] + m - m_new)
        C = decay[..., None, None] * C + jnp.einsum("bhs,bhse,bhsd->bhed", w_k, vc, kc)
        n = decay[..., None] * n + jnp.einsum("bhs,bhsd->bhd", w_k, kc)
        return (C, n, m_new), h

    state, h = lax.scan(step, state, (to_chunks(q), to_chunks(k), to_chunks(v),
                                      to_chunks(log_i), to_chunks(log_f)))
    return jnp.moveaxis(h, 0, 2).reshape(B, H, T, dh), state


def mlstm_mixer(h_x, h_c, need_ctx, w_in, w_conv, b_conv, w_q, w_k, w_v, w_gate, b_gate, gn_w, skip, w_out):
    wg = w_gate.reshape(3, M_HEADS, M_HEAD_DIM, 4 * M_HEADS)

    def branch(h, conv_fn):
        B, T, _ = h.shape
        x_m, z = jnp.split(h @ w_in, 2, axis=-1)
        x_c = jax.nn.silu(conv_fn(x_m, w_conv) + b_conv)
        xh_c = x_c.reshape(B, T, M_HEADS, M_HEAD_DIM)
        q = jnp.einsum("bthd,hde->bhte", xh_c, w_q)
        k = jnp.einsum("bthd,hde->bhte", xh_c, w_k) * (M_HEAD_DIM ** -0.5)
        v = jnp.einsum("bthd,hde->bhte", x_m.reshape(B, T, M_HEADS, M_HEAD_DIM), w_v)
        pre = (jnp.einsum("bhte,hen->btn", q, wg[0]) + jnp.einsum("bhte,hen->btn", k, wg[1])
               + jnp.einsum("bhte,hen->btn", v, wg[2]) + b_gate).astype(jnp.float32)
        pre = jnp.transpose(pre.reshape(B, T, 2, 2, M_HEADS), (2, 3, 0, 4, 1))
        return x_c, z, q, k, v, pre[:, 0], jax.nn.log_sigmoid(pre[:, 1])

    def readout(h, x_c, z):
        mu = h.mean(-1, keepdims=True)
        var = jnp.square(h - mu).mean(-1, keepdims=True)
        hn = (h - mu) * lax.rsqrt(var + LN_EPS)
        B, H, T, dh = h.shape
        hn = jnp.transpose(hn, (0, 2, 1, 3)).reshape(B, T, H * dh).astype(x_c.dtype) * gn_w
        return ((hn + skip * x_c) * jax.nn.silu(z)) @ w_out

    cb = branch(h_c, conv_seq)
    xb = branch(h_x, conv_grid)
    B = h_c.shape[0]
    outs_c, outs_x = [], []
    for d in range(2):
        if d == 0:
            flip = lambda a: a
        else:
            flip = lambda a: jnp.flip(a, axis=2)
        state0 = (jnp.zeros((B, M_HEADS, M_HEAD_DIM, M_HEAD_DIM), jnp.float32),
                  jnp.zeros((B, M_HEADS, M_HEAD_DIM), jnp.float32),
                  jnp.zeros((B, M_HEADS), jnp.float32))
        hc, st = mlstm_chunkwise(flip(cb[2]), flip(cb[3]), flip(cb[4]), flip(cb[5][d]), flip(cb[6][d]), state0)
        hx, _ = mlstm_chunkwise(flip(xb[2]), flip(xb[3]), flip(xb[4]), flip(xb[5][d]), flip(xb[6][d]), st)
        outs_c.append(flip(hc))
        outs_x.append(flip(hx))
    y_x = readout(outs_x[0] + outs_x[1], xb[0], xb[1])
    y_c = readout(outs_c[0] + outs_c[1], cb[0], cb[1]) if need_ctx else None
    return y_x, y_c


def fourier_mixer(h, w_out):
    B, T, D = h.shape
    hg = h.astype(jnp.float32).reshape(B, T, F_GROUPS, D // F_GROUPS)
    mixed = jnp.fft.fft2(hg, axes=(1, 3), norm="ortho").real
    return mixed.reshape(B, T, D).astype(h.dtype) @ w_out


def sq_relu_mlp(h, w1, w2):
    return jnp.square(jax.nn.relu(h @ w1)) @ w2


def setup_inputs(seed: int = 0) -> dict:
    key = jax.random.key(seed)
    ks = jax.random.split(key, 24)
    nrm = lambda k, shape, s: jax.random.normal(k, shape, jnp.float32) * s
    b_gate = nrm(ks[14], (N_A, 2, 2, M_HEADS), 0.1)
    b_gate = b_gate.at[:, :, 1, :].add(jnp.linspace(3.0, 6.0, M_HEADS, dtype=jnp.float32))
    return {
        "x": nrm(ks[0], (BATCH, SEQ, D_MODEL), 1.0),
        "c": nrm(ks[1], (BATCH, D_MODEL), 1.0),
        "ctx": nrm(ks[2], (BATCH, CTX_LEN, D_MODEL), 1.0),
        "c_ctx": nrm(ks[3], (D_MODEL,), 1.0),
        "ada_w": nrm(ks[4], (DEPTH, D_MODEL, 6 * D_MODEL), D_MODEL ** -0.5),
        "ada_b": nrm(ks[5], (DEPTH, 6 * D_MODEL), 0.02),
        "post_g": 1.0 + nrm(ks[6], (DEPTH, 2, D_MODEL), 0.02),
        "post_b": nrm(ks[7], (DEPTH, 2, D_MODEL), 0.02),
        "m_w_in": nrm(ks[8], (N_A, D_MODEL, 2 * D_INNER), D_MODEL ** -0.5),
        "m_w_conv": nrm(ks[9], (N_A, CONV_K, CONV_K, D_INNER), 1.0 / CONV_K),
        "m_b_conv": nrm(ks[10], (N_A, D_INNER), 0.02),
        "m_w_q": nrm(ks[11], (N_A, M_HEADS, M_HEAD_DIM, M_HEAD_DIM), M_HEAD_DIM ** -0.5),
        "m_w_k": nrm(ks[12], (N_A, M_HEADS, M_HEAD_DIM, M_HEAD_DIM), M_HEAD_DIM ** -0.5),
        "m_w_v": nrm(ks[13], (N_A, M_HEADS, M_HEAD_DIM, M_HEAD_DIM), M_HEAD_DIM ** -0.5),
        "m_w_gate": nrm(ks[15], (N_A, 3, D_INNER, 4 * M_HEADS), (3 * D_INNER) ** -0.5),
        "m_b_gate": b_gate.reshape(N_A, 4 * M_HEADS),
        "m_gn_w": 1.0 + nrm(ks[16], (N_A, D_INNER), 0.02),
        "m_skip": 1.0 + nrm(ks[17], (N_A, D_INNER), 0.02),
        "m_w_out": nrm(ks[18], (N_A, D_INNER, D_MODEL), BETA * D_INNER ** -0.5),
        "f_w_out": nrm(ks[19], (N_B, D_MODEL, D_MODEL), BETA * D_MODEL ** -0.5),
        "mlp_w1": nrm(ks[20], (DEPTH, D_MODEL, D_FF), D_MODEL ** -0.5),
        "mlp_w2": nrm(ks[21], (DEPTH, D_FF, D_MODEL), BETA * D_FF ** -0.5),
    }


def reference(x, c, ctx, c_ctx, ada_w, ada_b, post_g, post_b, m_w_in, m_w_conv, m_b_conv, m_w_q, m_w_k,
              m_w_v, m_w_gate, m_b_gate, m_gn_w, m_skip, m_w_out, f_w_out, mlp_w1, mlp_w2):
    s_lat = jax.nn.silu(c)
    s_ctx = jax.nn.silu(c_ctx)
    for i in range(DEPTH):
        is_mlstm = i % N_MIXERS == 0
        j = i // N_MIXERS
        need_ctx = i < DEPTH - 1
        use_ctx = need_ctx or is_mlstm
        sh1, sc1, g1, sh2, sc2, g2 = jnp.split((s_lat @ ada_w[i] + ada_b[i])[:, None, :], 6, axis=-1)
        h_x = modulate(x, sh1, sc1)
        h_c = None
        if use_ctx:
            csh1, csc1, cg1, csh2, csc2, cg2 = jnp.split(s_ctx @ ada_w[i] + ada_b[i], 6, axis=-1)
            h_c = modulate(ctx, csh1, csc1)
        if is_mlstm:
            y_x, y_c = mlstm_mixer(h_x, h_c, need_ctx, m_w_in[j], m_w_conv[j], m_b_conv[j], m_w_q[j], m_w_k[j],
                                   m_w_v[j], m_w_gate[j], m_b_gate[j], m_gn_w[j], m_skip[j], m_w_out[j])
        else:
            y_x = fourier_mixer(h_x, f_w_out[j])
            y_c = fourier_mixer(h_c, f_w_out[j]) if need_ctx else None
        x = post_norm(ALPHA * x + g1 * y_x, post_g[i, 0], post_b[i, 0])
        x = post_norm(ALPHA * x + g2 * sq_relu_mlp(modulate(x, sh2, sc2), mlp_w1[i], mlp_w2[i]),
                      post_g[i, 1], post_b[i, 1])
        if need_ctx:
            ctx = post_norm(ALPHA * ctx + cg1 * y_c, post_g[i, 0], post_b[i, 0])
            ctx = post_norm(ALPHA * ctx + cg2 * sq_relu_mlp(modulate(ctx, csh2, csc2), mlp_w1[i], mlp_w2[i]),
                            post_g[i, 1], post_b[i, 1])
    return x
```

```cpp
#include <hip/hip_runtime.h>
#include <cstdio>
#include <cstdint>

#define LAS __attribute__((address_space(3)))
typedef unsigned short bf16_t;
typedef short bf16x8 __attribute__((ext_vector_type(8)));
typedef float f32x4 __attribute__((ext_vector_type(4)));
typedef unsigned u32x4 __attribute__((ext_vector_type(4)));
typedef unsigned u32x2 __attribute__((ext_vector_type(2)));


#ifndef EN_PRO
#define EN_PRO 1
#endif
#ifndef EN_WC
#define EN_WC 1
#endif
#ifndef EN_MIX
#define EN_MIX 1
#endif
#ifndef EN_SCAN
#define EN_SCAN 1
#endif
#ifndef EN_FOUR
#define EN_FOUR 1
#endif
#ifndef EN_NORM
#define EN_NORM 1
#endif
#ifndef EN_MLP
#define EN_MLP 1
#endif
#ifndef DUP_MIX
#define DUP_MIX 0
#endif
#ifndef DUP_CTX
#define DUP_CTX 0
#endif
#ifndef DUP_BAR
#define DUP_BAR 0
#endif
#ifndef DUP_MLP
#define DUP_MLP 0
#endif
#ifndef REP_MASK
#define REP_MASK 0
#endif
#define REPN(bit) (((REP_MASK) >> (bit)) & 1 ? 2 : 1)
#ifndef SC_QPAD
#define SC_QPAD 64
#endif
#ifndef SC_ABL
#define SC_ABL 0
#endif
#ifndef SCAN_REP
#define SCAN_REP 1
#endif
#ifndef MK_SINGLE
#define MK_SINGLE 1
#endif

constexpr int D = 1024, NB = 4, T = 8192, CT = 256, DI = 2048, NH = 4, DH = 512, DFF = 4096;
constexpr int R = NB * (T + CT);
constexpr int RH = R / 2;
constexpr int LAT0 = 2 * CT;
constexpr int NCH = RH / 64;
constexpr float ALPHA = 1.6817928305074290f;
constexpr float LN_EPS = 1e-5f;
constexpr int NWAVES = 8, NTHR = 512;

constexpr size_t MiB = 1u << 20;
constexpr size_t WS_CTL = 0, CTL_BYTES = 2 * MiB;
constexpr size_t WS_MOD = 2 * MiB;
constexpr size_t WS_CTXX = 3 * MiB;
constexpr size_t WS_PRE = 7 * MiB;
constexpr size_t WS_TAB = 10 * MiB;
constexpr size_t TAB_A1 = WS_TAB;
constexpr size_t TAB_A2 = TAB_A1 + 512 * 256 * 2;
constexpr size_t TAB_BZ = TAB_A2 + 256 * 64 * 64 * 2;
constexpr size_t TAB_ACTX = TAB_BZ + 256 * 512 * 2;
constexpr size_t TAB_GATE = TAB_ACTX + 512 * 256 * 2;
static_assert(TAB_GATE + 64 * 4096 * 2 <= 15 * MiB, "tables");
constexpr size_t WS_W = 15 * MiB;
constexpr size_t W_IN = WS_W;
constexpr size_t W_Q = W_IN + 8 * MiB, W_K = W_Q + 2 * MiB, W_V = W_K + 2 * MiB;
constexpr size_t W_OUT = W_V + 2 * MiB;
constexpr size_t W_1 = W_OUT + 4 * MiB;
constexpr size_t W_2 = W_1 + 8 * MiB;
static_assert(W_2 + 8 * MiB <= 49 * MiB, "weights");
constexpr size_t WS_HIN = 49 * MiB;
constexpr size_t WS_YB = 115 * MiB;
constexpr size_t WS_BIG = 181 * MiB;
constexpr size_t SLOT = 66 * MiB;
static_assert(WS_BIG + 5 * SLOT <= 512 * MiB, "workspace");
static_assert((size_t)RH * DI * 2 == SLOT, "slot");

#define LDS_BARRIER() do { asm volatile("s_waitcnt lgkmcnt(0)" ::: "memory"); __builtin_amdgcn_s_barrier(); asm volatile("" ::: "memory"); } while (0)
__device__ __forceinline__ unsigned f2bf(float f) { unsigned u = __builtin_bit_cast(unsigned, f); return (u + 0x7fffu + ((u >> 16) & 1u)) >> 16; }
typedef __bf16 bf16x2_t __attribute__((ext_vector_type(2)));
typedef float f32x2_t __attribute__((ext_vector_type(2)));
__device__ __forceinline__ unsigned pk2(float lo, float hi) { const f32x2_t v = {lo, hi}; return __builtin_bit_cast(unsigned, __builtin_convertvector(v, bf16x2_t)); }
__device__ __forceinline__ float bf2f(unsigned short b) { return __builtin_bit_cast(float, ((unsigned)b) << 16); }
__device__ __forceinline__ float u2f(unsigned u) { return __builtin_bit_cast(float, u); }
__device__ __forceinline__ float bflo(unsigned w) { return __builtin_bit_cast(float, w << 16); }
__device__ __forceinline__ float bfhi(unsigned w) { return __builtin_bit_cast(float, w & 0xffff0000u); }
__device__ __forceinline__ float shx(float v, int mask, int lane) { return __builtin_bit_cast(float, __builtin_amdgcn_ds_bpermute((lane ^ mask) << 2, __builtin_bit_cast(int, v))); }
template <int CTRL, int RMASK> __device__ __forceinline__ float dppf(float idv, float src) { return __builtin_bit_cast(float, __builtin_amdgcn_update_dpp(__builtin_bit_cast(int, idv), __builtin_bit_cast(int, src), CTRL, RMASK, 0xF, false)); }
__device__ __forceinline__ float scan_add64(float x) {
    x += dppf<0x111, 0xF>(0.f, x); x += dppf<0x112, 0xF>(0.f, x); x += dppf<0x114, 0xF>(0.f, x); x += dppf<0x118, 0xF>(0.f, x);
    x += dppf<0x142, 0xA>(0.f, x); x += dppf<0x143, 0xC>(0.f, x); return x; }
__device__ __forceinline__ float scan_max64(float x) {
    const float ni = -__builtin_inff();
    x = fmaxf(x, dppf<0x111, 0xF>(ni, x)); x = fmaxf(x, dppf<0x112, 0xF>(ni, x)); x = fmaxf(x, dppf<0x114, 0xF>(ni, x)); x = fmaxf(x, dppf<0x118, 0xF>(ni, x));
    x = fmaxf(x, dppf<0x142, 0xA>(ni, x)); x = fmaxf(x, dppf<0x143, 0xC>(ni, x)); return x; }
__device__ __forceinline__ float shup(float v, int d, int lane) { return __builtin_bit_cast(float, __builtin_amdgcn_ds_bpermute((lane - d) << 2, __builtin_bit_cast(int, v))); }
__device__ __forceinline__ float wave_sum(float v, int lane) {
#pragma unroll
    for (int o = 1; o < 64; o <<= 1) v += shx(v, o, lane);
    return v;
}
__device__ __forceinline__ float siluf(float x) { return x * __builtin_amdgcn_rcpf(1.0f + __expf(-x)); }

struct RowInfo { int is_ctx, b, t; };
__device__ __forceinline__ RowInfo row_info(int r) {
    RowInfo ri;
    if (r < NB * CT) { ri.is_ctx = 1; ri.b = r / CT; ri.t = r % CT; }
    else { ri.is_ctx = 0; const int u = r - NB * CT; ri.b = u / T; ri.t = u % T; }
    return ri;
}
__device__ __forceinline__ int lat_row(int b, int t) { return NB * CT + b * T + t; }
__device__ __forceinline__ int ctx_row(int b, int t) { return b * CT + t; }
constexpr int CR = NB * CT;
constexpr int LH = RH - LAT0;

#define XB_TMO      128
#define XB_XCNT(j)  (256  + 64 * (j))
#define XB_XSUB(j)  (1280 + 64 * (j))
#define XB_XGEN(j)  (2304 + 64 * (j))
#define XB_TOP      3328
#define XB_TOPGEN   3392
#define XCD_BAR_WORDS 3456
#define XB_SPIN_CAP (1u << 18)

__device__ __forceinline__ unsigned xb_ld(unsigned* p)              { return __hip_atomic_load(p, __ATOMIC_RELAXED, __HIP_MEMORY_SCOPE_AGENT); }
__device__ __forceinline__ unsigned xb_add(unsigned* p, unsigned v) { return __hip_atomic_fetch_add(p, v, __ATOMIC_RELAXED, __HIP_MEMORY_SCOPE_AGENT); }
__device__ __forceinline__ unsigned xb_xcc_id() { return (unsigned)__builtin_amdgcn_s_getreg((3 << 11) | 20) & 0xFu; }
#define XB_SPIN(cond, bar) do { unsigned _sp = 0; while (cond) { __builtin_amdgcn_s_sleep(1); \
    if ((++_sp & 255u) == 0u) { if (xb_ld(&(bar)[XB_TMO])) break; if (_sp > XB_SPIN_CAP) { atomicAdd(&(bar)[XB_TMO], 1u); break; } } } } while (0)

struct XcdBarrier { unsigned* bar; unsigned x; volatile LAS unsigned* st; };

__device__ __forceinline__ XcdBarrier xcd_barrier_post(unsigned* bar, volatile LAS unsigned* st) {
    XcdBarrier b; b.bar = bar; b.x = xb_xcc_id(); b.st = st;
    if (threadIdx.x == 0) (void)xb_add(&bar[XB_XCNT(b.x)], 1u);
    return b;
}
__device__ __forceinline__ void xcd_barrier_complete(unsigned* bar, unsigned x, unsigned& nloc, unsigned& nx) {
    const unsigned G = gridDim.x * gridDim.y * gridDim.z;
    unsigned sum, cnt, mine, sp = 0u;
    for (;;) {
        sum = 0u; cnt = 0u; mine = 0u;
#pragma unroll
        for (unsigned j = 0; j < 16; ++j) { const unsigned c = xb_ld(&bar[XB_XCNT(j)]); sum += c; cnt += (c > 0u) ? 1u : 0u; mine = (j == x) ? c : mine; }
        if (sum == G) break;
        __builtin_amdgcn_s_sleep(1);
        if ((++sp & 255u) == 0u) { if (xb_ld(&bar[XB_TMO])) break; if (sp > XB_SPIN_CAP) { atomicAdd(&bar[XB_TMO], 1u); break; } }
    }
    nloc = mine > 0u ? mine : 1u; nx = cnt > 0u ? cnt : 1u;
}
__device__ __forceinline__ void xcd_barrier(const XcdBarrier& b, bool thread0) {
    asm volatile("s_waitcnt vmcnt(0)" ::: "memory");
    __syncthreads();
    if (thread0) {
        unsigned* bar = b.bar;
        __builtin_amdgcn_s_waitcnt(0);
        unsigned nloc = b.st[0], nx = b.st[1];
        if (nloc == 0u) { xcd_barrier_complete(bar, b.x, nloc, nx); b.st[0] = nloc; b.st[1] = nx; }
        const unsigned old = xb_add(&bar[XB_XSUB(b.x)], 1u);
        const unsigned gen = old / nloc;
        if (old + 1u == (gen + 1u) * nloc) {
            __builtin_amdgcn_fence(__ATOMIC_RELEASE, "agent");
            asm volatile("s_waitcnt vmcnt(0)" ::: "memory");
            const unsigned og = xb_add(&bar[XB_TOP], 1u);
            const unsigned tg = og / nx;
            if (og + 1u == (tg + 1u) * nx) xb_add(&bar[XB_TOPGEN], 1u);
            else XB_SPIN(xb_ld(&bar[XB_TOPGEN]) == tg, bar);
            __builtin_amdgcn_fence(__ATOMIC_ACQUIRE, "agent");
            xb_add(&bar[XB_XGEN(b.x)], 1u);
            asm volatile("s_waitcnt vmcnt(0)" ::: "memory");
        } else {
            XB_SPIN(xb_ld(&bar[XB_XGEN(b.x)]) == gen, bar);
            __builtin_amdgcn_fence(__ATOMIC_ACQUIRE, "agent");
            asm volatile("s_waitcnt vmcnt(0)" ::: "memory");
        }
    }
    __syncthreads();
}

__device__ __forceinline__ size_t qtile_off(int q, int h, int cc) {
    const int chunk = q >> 6, p = q & 63, pt = p >> 4, fr = p & 15, w = cc >> 6, ks = (cc >> 5) & 1, fq = (cc >> 3) & 3;
    const size_t blk = ((((size_t)chunk * 4 + h) * 8 + w) * 4 + pt) * 2 + ks;
    return blk * 512 + (size_t)(fq * 16 + fr) * 8 + (cc & 7);
}
__device__ __forceinline__ size_t ktile_off(int d, int h, int q) {
    const int chunk = q >> 6, s = q & 63, ks = s >> 5, fq = (s >> 3) & 3, w = d >> 6, dd = d & 63, mt = 2 * (dd >> 5) + ((dd >> 2) & 1), frp = 4 * ((dd >> 3) & 3) + (dd & 3);
    const size_t blk = ((((size_t)chunk * 4 + h) * 8 + w) * 4 + mt) * 2 + ks;
    return blk * 512 + (size_t)(fq * 16 + frp) * 8 + (s & 7);
}

__device__ __forceinline__ size_t vtile_off(int e, int h, int q) {
    const int chunk = q >> 6, s = q & 63, slice = e >> 5, e5 = e & 31, nt = e5 >> 4, fr = e5 & 15, ks = s >> 5, fq = (s >> 3) & 3;
    const size_t blk = ((((size_t)chunk * 4 + h) * 16 + slice) * 2 + nt) * 2 + ks;
    return blk * 512 + (size_t)(fq * 16 + fr) * 8 + (s & 7);
}
__device__ __forceinline__ size_t htile_off(int q, int h, int e) {
    return ((((size_t)(q >> 6) * 4 + h) * 16 + (e >> 5)) * 2048) + (size_t)(q & 63) * 32 + (e & 31);
}

namespace pg8 {
constexpr int BM = 256, BK = 64, HALF = 128, HTB = HALF * BK * 2, STAGE_BYTES = 8 * HTB, NXCD = 8, WGM = 8;
__device__ __forceinline__ int lds_byte(int r, int c) { const int st = (r >> 4) * 2 + (c >> 5), rr = r & 15, cc = c & 31, ob = rr * 64 + cc * 2; return st * 1024 + (ob ^ (((ob >> 9) & 1) << 5)); }
__device__ __forceinline__ void stage_rc(int b, int& R_, int& C_) { const int st = b / 1024, sb = b % 1024, swz = sb ^ (((sb >> 9) & 1) << 5); R_ = (st >> 1) * 16 + swz / 64; C_ = (st & 1) * 32 + (swz % 64) / 2; }
__device__ __forceinline__ int perm32(int rho) { const int n = rho >> 4, i = rho & 15; return 8 * (i >> 2) + 4 * n + (i & 3); }

struct Unit { int pm, pn, g; };
struct Gemm {
    const bf16_t* A; const bf16_t* Bt; int lda, ldb, K;
    long a_gs, b_gs;
    int nM, nN, nG;
};
struct Order {
    int nM, nNt, nN, nwg, G, c;
    __device__ void init(const Gemm& g, int G_, int c_) { nM = g.nM; nN = g.nN; nNt = g.nN * g.nG; nwg = nM * nNt; G = G_; c = c_; }
    __device__ bool next(int i, Unit& u) const {
        const long L = (long)i * G + c; if (L >= nwg) return false;
        int wgid = (int)L; { const int q = nwg / NXCD, r = nwg % NXCD, xcd = wgid % NXCD, off = wgid / NXCD; wgid = (xcd < r ? xcd * (q + 1) : r * (q + 1) + (xcd - r) * q) + off; }
        const int nig = WGM * nNt, gid = wgid / nig, fm = gid * WGM, gsz = (nM - fm) < WGM ? (nM - fm) : WGM;
        u.pm = fm + ((wgid % nig) % gsz); const int pnt = (wgid % nig) / gsz; u.g = pnt / nN; u.pn = pnt - u.g * nN; return true;
    }
};
__device__ __forceinline__ unsigned cvt_pk_bf16(float lo, float hi) { return pk2(lo, hi); }

struct EpiStore {
    bf16_t* O; long o_gs; int ldc; int act;
    int mode, off;
    __device__ __forceinline__ void operator()(const f32x4 (&acc)[2][2][4][2], const Unit& u, int wr, int wc, int fr, int fq) const {
        const int row0 = u.pm * BM + wr * 64 + fr; const int col0 = u.pn * BM + wc * 32 + 8 * fq; bf16_t* base = O + (long)u.g * o_gs;
#pragma unroll
        for (int ai = 0; ai < 2; ++ai)
#pragma unroll
            for (int m = 0; m < 4; ++m) { bf16_t* rowp = base + (size_t)(row0 + ai * HALF + m * 16) * ldc + col0;
#pragma unroll
                for (int bj = 0; bj < 2; ++bj) { f32x4 v0 = acc[ai][bj][m][0], v1 = acc[ai][bj][m][1];
                    if (act == 1) {
#pragma unroll
                        for (int j = 0; j < 4; ++j) { const float a = fmaxf(v0[j], 0.f), b = fmaxf(v1[j], 0.f); v0[j] = a * a; v1[j] = b * b; } }
                    u32x4 w; w.x = cvt_pk_bf16(v0[0], v0[1]); w.y = cvt_pk_bf16(v0[2], v0[3]); w.z = cvt_pk_bf16(v1[0], v1[1]); w.w = cvt_pk_bf16(v1[2], v1[3]);
                    if (mode == 0) *(u32x4*)(rowp + bj * HALF) = w;
                    else if (mode == 1) *(u32x4*)(O + qtile_off(off + row0 + ai * HALF + m * 16, u.g, col0 + bj * HALF)) = w;
                    else if (mode == 2) *(u32x4*)(O + ktile_off(row0 + ai * HALF + m * 16, u.g, off + col0 + bj * HALF)) = w;
                    else *(u32x4*)(O + vtile_off(row0 + ai * HALF + m * 16, u.g, off + col0 + bj * HALF)) = w; } }
    }
};

template <class Epi>
__device__ __forceinline__ void gemm_phase(LAS unsigned char* lds, const Gemm g, const Epi& E, int G_, int c_, int tid_in) {
    int tid_ = tid_in; asm volatile("" : "+v"(tid_));
    const int tid = tid_, wid = __builtin_amdgcn_readfirstlane(tid >> 6), lane = tid & 63, wr = wid >> 2, wc = wid & 3, fr = lane & 15, fq = lane >> 4;
    const int K = g.K, nt = K / BK;
    Order S; S.init(g, G_, c_);
    unsigned voffA[2], voffB[2];
#pragma unroll
    for (int i = 0; i < 2; ++i) { int R_, C_; stage_rc(tid * 16 + i * 8192, R_, C_); const int Rb = (R_ & ~31) + perm32(R_ & 31);
        voffA[i] = (unsigned)(R_ * g.lda + C_) * 2u; voffB[i] = (unsigned)(Rb * g.ldb + C_) * 2u; }
    const size_t kstep = (size_t)(BK * 2);
    const size_t hstepA = (size_t)HALF * g.lda * 2, hstepB = (size_t)HALF * g.ldb * 2;
    const unsigned ldsw = (unsigned)wid * 1024u;
    const int aoff = lds_byte(wr * 64 + fr, fq * 8), boff = lds_byte(wc * 32 + fr, fq * 8);
#define PG8_SA(b, h) (((b) * 2 + (h)) * HTB)
#define PG8_SB(b, h) ((4 + (b) * 2 + (h)) * HTB)
#define PG8_STAGE(bufoff, gbase, voff) do { _Pragma("unroll") for (int _i = 0; _i < 2; ++_i) \
        __builtin_amdgcn_global_load_lds((const unsigned*)((const char*)(gbase) + (voff)[_i]), (LAS unsigned*)(lds + (bufoff) + ldsw + _i * 8192), 16, 0, 0); } while (0)
#define PG8_LDA(dst, b, h) do { _Pragma("unroll") for (int m = 0; m < 4; ++m) _Pragma("unroll") for (int k = 0; k < 2; ++k) dst[m][k] = *(const LAS bf16x8*)(lds + PG8_SA(b, h) + aoff + m * 2048 + k * 1024); } while (0)
#define PG8_LDB(dst, b, h) do { _Pragma("unroll") for (int n = 0; n < 2; ++n) _Pragma("unroll") for (int k = 0; k < 2; ++k) dst[n][k] = *(const LAS bf16x8*)(lds + PG8_SB(b, h) + boff + n * 2048 + k * 1024); } while (0)
#define PG8_MMA(ai, bj, At, Bt) do { __builtin_amdgcn_s_setprio(1); _Pragma("unroll") for (int m = 0; m < 4; ++m) _Pragma("unroll") for (int n = 0; n < 2; ++n) _Pragma("unroll") for (int k = 0; k < 2; ++k) \
        acc[ai][bj][m][n] = __builtin_amdgcn_mfma_f32_16x16x32_bf16(Bt[n][k], At[m][k], acc[ai][bj][m][n], 0, 0, 0); __builtin_amdgcn_s_setprio(0); } while (0)
#define PG8_WAIT_V(n) asm volatile("s_waitcnt vmcnt(" #n ")" ::: "memory")
#define PG8_WAIT_L(n) asm volatile("s_waitcnt lgkmcnt(" #n ")" ::: "memory")
#define PG8_BAR __builtin_amdgcn_s_barrier()
#define PG8_SCHED __builtin_amdgcn_sched_barrier(0)
#define PG8_APTR(u) ((const char*)(g.A + (long)(u).g * g.a_gs) + (size_t)(u).pm * 2 * hstepA)
#define PG8_BPTR(u) ((const char*)(g.Bt + (long)(u).g * g.b_gs) + (size_t)(u).pn * 2 * hstepB)
    Unit cur, nxt; int ui = 0;
    if (!S.next(0, cur)) return;
    f32x4 acc[2][2][4][2];
#pragma unroll
    for (int a = 0; a < 2; ++a)
#pragma unroll
        for (int b = 0; b < 2; ++b)
#pragma unroll
            for (int m = 0; m < 4; ++m)
#pragma unroll
                for (int n = 0; n < 2; ++n) acc[a][b][m][n] = (f32x4){0.f, 0.f, 0.f, 0.f};
    bf16x8 At[4][2], B0[2][2], B1[2][2];
    const char* cA = PG8_APTR(cur); const char* cB = PG8_BPTR(cur);
    PG8_STAGE(PG8_SB(0, 0), cB, voffB); PG8_STAGE(PG8_SA(0, 0), cA, voffA); PG8_STAGE(PG8_SB(0, 1), cB + hstepB, voffB); PG8_STAGE(PG8_SA(0, 1), cA + hstepA, voffA);
    if (wr == 1) PG8_BAR;
    PG8_WAIT_V(4); PG8_BAR;
    PG8_STAGE(PG8_SB(1, 0), cB + kstep, voffB); PG8_STAGE(PG8_SA(1, 0), cA + kstep, voffA); PG8_STAGE(PG8_SB(1, 1), cB + hstepB + kstep, voffB);
    PG8_WAIT_V(6); PG8_BAR;
    for (;;) {
        const bool has_next = S.next(ui + 1, nxt);
        const char* nA = has_next ? PG8_APTR(nxt) : cA; const char* nB = has_next ? PG8_BPTR(nxt) : cB;
        for (int t = 0; t < nt; t += 2) {
            const bool last = (t == nt - 2);
            const char* a1 = cA + (size_t)(t + 1) * kstep;
            const char* a2 = last ? nA : cA + (size_t)(t + 2) * kstep; const char* b2 = last ? nB : cB + (size_t)(t + 2) * kstep;
            const char* a3 = a2 + kstep; const char* b3 = b2 + kstep;
            PG8_LDB(B0, 0, 0); PG8_SCHED; PG8_LDA(At, 0, 0); PG8_STAGE(PG8_SA(1, 1), a1 + hstepA, voffA);
            PG8_WAIT_L(8); PG8_BAR; PG8_WAIT_L(0); PG8_MMA(0, 0, At, B0); PG8_BAR; PG8_SCHED;
            PG8_LDB(B1, 0, 1); PG8_STAGE(PG8_SB(0, 0), b2, voffB);
            PG8_BAR; PG8_WAIT_L(0); PG8_MMA(0, 1, At, B1); PG8_BAR;
            PG8_LDA(At, 0, 1); PG8_STAGE(PG8_SA(0, 0), a2, voffA);
            PG8_BAR; PG8_WAIT_L(0); PG8_MMA(1, 0, At, B0); PG8_BAR; PG8_SCHED;
            PG8_STAGE(PG8_SB(0, 1), b2 + hstepB, voffB);
            PG8_WAIT_V(6); PG8_BAR; PG8_MMA(1, 1, At, B1); PG8_BAR;
            PG8_LDB(B0, 1, 0); PG8_SCHED; PG8_LDA(At, 1, 0); PG8_STAGE(PG8_SA(0, 1), a2 + hstepA, voffA);
            PG8_WAIT_L(8); PG8_BAR; PG8_WAIT_L(0); PG8_MMA(0, 0, At, B0); PG8_BAR; PG8_SCHED;
            PG8_LDB(B1, 1, 1); PG8_STAGE(PG8_SB(1, 0), b3, voffB);
            PG8_BAR; PG8_WAIT_L(0); PG8_MMA(0, 1, At, B1); PG8_BAR;
            PG8_LDA(At, 1, 1); PG8_STAGE(PG8_SA(1, 0), a3, voffA);
            PG8_BAR; PG8_WAIT_L(0); PG8_MMA(1, 0, At, B0); PG8_BAR; PG8_SCHED;
            PG8_STAGE(PG8_SB(1, 1), b3 + hstepB, voffB);
            PG8_WAIT_V(6); PG8_BAR; PG8_MMA(1, 1, At, B1); PG8_BAR;
        }
        E(acc, cur, wr, wc, fr, fq);
        if (!has_next) break;
#pragma unroll
        for (int a = 0; a < 2; ++a)
#pragma unroll
            for (int b = 0; b < 2; ++b)
#pragma unroll
                for (int m = 0; m < 4; ++m)
#pragma unroll
                    for (int n = 0; n < 2; ++n) acc[a][b][m][n] = (f32x4){0.f, 0.f, 0.f, 0.f};
        cur = nxt; cA = nA; cB = nB; ++ui;
    }
    PG8_WAIT_V(0);
    if (wr == 0) PG8_BAR;
    PG8_BAR;
#undef PG8_SA
#undef PG8_SB
#undef PG8_STAGE
#undef PG8_LDA
#undef PG8_LDB
#undef PG8_MMA
#undef PG8_WAIT_V
#undef PG8_WAIT_L
#undef PG8_BAR
#undef PG8_SCHED
#undef PG8_APTR
#undef PG8_BPTR
}
}

struct SmallGemm { const bf16_t* A; const bf16_t* B; int lda, ldb, K, akseg, bkseg; long aseg, bseg; int a_tiled; };
constexpr int SG_LD = 72;
constexpr int SG_TILE = 64 * SG_LD * 2;
template <class Dec, class Epi>
__device__ __forceinline__ void gemm_small(LAS unsigned char* lds, const SmallGemm g, int nunits, const Dec& dec, const Epi& epi, int G_, int c_, int tid_in) {
    int tid_ = tid_in; asm volatile("" : "+v"(tid_));
    const int tid = tid_, wid = tid >> 6, lane = tid & 63, wm = wid >> 1, wn = wid & 1, fr = lane & 15, fq = lane >> 4;
    const int lrow = tid >> 3, lk = (tid & 7) * 8;
    const int nk = g.K / 64;
    const unsigned stoff = (unsigned)(lrow * SG_LD + lk) * 2u;
#define SG_LOAD(ra_, rb_, kt_) do { const int k_ = (kt_) * 64 + lk; \
        if (g.a_tiled) ra_ = *(const u32x4*)(g.A + (((((size_t)aoff * 8 + (k_ >> 6)) * 4 + (lrow >> 4)) * 2 + ((k_ >> 5) & 1)) * 512 + (size_t)(((k_ >> 3) & 3) * 16 + (lrow & 15)) * 8)); \
        else ra_ = *(const u32x4*)(ap + (long)(k_ / g.akseg) * g.aseg + (k_ % g.akseg)); \
        rb_ = *(const u32x4*)(bp + (long)(k_ / g.bkseg) * g.bseg + (k_ % g.bkseg)); } while (0)
#define SG_STORE(ra_, rb_, bufi_) do { *(LAS u32x4*)(lds + ((bufi_) * 2 + 0) * SG_TILE + stoff) = ra_; *(LAS u32x4*)(lds + ((bufi_) * 2 + 1) * SG_TILE + stoff) = rb_; } while (0)
#define SG_COMPUTE(bufi_) do { const LAS unsigned char* As = lds + ((bufi_) * 2 + 0) * SG_TILE; const LAS unsigned char* Bs = lds + ((bufi_) * 2 + 1) * SG_TILE; \
        _Pragma("unroll") for (int ks = 0; ks < 2; ++ks) { const bf16x8 af = *(const LAS bf16x8*)(As + ((wm * 16 + fr) * SG_LD + ks * 32 + fq * 8) * 2); \
            _Pragma("unroll") for (int nt = 0; nt < 2; ++nt) { const bf16x8 bf = *(const LAS bf16x8*)(Bs + ((wn * 32 + nt * 16 + fr) * SG_LD + ks * 32 + fq * 8) * 2); \
                acc[nt] = __builtin_amdgcn_mfma_f32_16x16x32_bf16(bf, af, acc[nt], 0, 0, 0); } } } while (0)
    for (int u = c_; u < nunits; u += G_) {
        long aoff, boff; dec(u, aoff, boff);
        const bf16_t* ap = g.A + aoff + (long)lrow * g.lda; const bf16_t* bp = g.B + boff + (long)lrow * g.ldb;
        f32x4 acc[2] = {(f32x4){0.f, 0.f, 0.f, 0.f}, (f32x4){0.f, 0.f, 0.f, 0.f}};
        u32x4 ra0, rb0, ra1, rb1, ra2, rb2, ra3, rb3;
        ra0 = (u32x4){0u, 0u, 0u, 0u}; rb0 = ra0; ra1 = ra0; rb1 = ra0; ra2 = ra0; rb2 = ra0; ra3 = ra0; rb3 = ra0;
        SG_LOAD(ra0, rb0, 0); if (nk > 1) SG_LOAD(ra1, rb1, 1); if (nk > 2) SG_LOAD(ra2, rb2, 2); if (nk > 3) SG_LOAD(ra3, rb3, 3);
        SG_STORE(ra0, rb0, 0);
        LDS_BARRIER();
#define SG_TURN(kt_, bufc, rnextA, rnextB, rfreeA, rfreeB) do { if ((kt_) < nk) { \
            SG_COMPUTE(bufc); \
            if ((kt_) + 1 < nk) SG_STORE(rnextA, rnextB, (bufc) ^ 1); \
            if ((kt_) + 4 < nk) SG_LOAD(rfreeA, rfreeB, (kt_) + 4); \
            LDS_BARRIER(); } } while (0)
        for (int kt = 0; kt < nk; kt += 4) {
            SG_TURN(kt,     0, ra1, rb1, ra0, rb0);
            SG_TURN(kt + 1, 1, ra2, rb2, ra1, rb1);
            SG_TURN(kt + 2, 0, ra3, rb3, ra2, rb2);
            SG_TURN(kt + 3, 1, ra0, rb0, ra3, rb3);
        }
#undef SG_TURN
#pragma unroll
        for (int nt = 0; nt < 2; ++nt) epi(u, wm * 16 + fr, wn * 32 + nt * 16 + fq * 4, acc[nt]);
    }
#undef SG_LOAD
#undef SG_STORE
#undef SG_COMPUTE
}

struct SmallDense { bf16_t* O; long o_gs; int ldc, mt, nt, act; long a_gs, b_gs; int mode; };
__device__ __forceinline__ void gemm_small_dense(LAS unsigned char* lds, const SmallGemm g, const SmallDense d, int ngroups, int G_, int c_, int tid_in) {
    const int per = d.mt * d.nt;
    auto dec = [=](int u, long& ao, long& bo) { const int gi = u / per, r = u % per, mi = r / d.nt, ni = r % d.nt; ao = gi * d.a_gs + (long)mi * 64 * g.lda; bo = gi * d.b_gs + (long)ni * 64 * g.ldb; };
    auto epi = [=](int u, int m, int n, const f32x4& v) { const int gi = u / per, r = u % per, mi = r / d.nt, ni = r % d.nt;
        f32x4 x = v; if (d.act == 1) {
#pragma unroll
            for (int i = 0; i < 4; ++i) { const float a = fmaxf(x[i], 0.f); x[i] = a * a; } }
        u32x2 w; w.x = pk2(x[0], x[1]); w.y = pk2(x[2], x[3]);
        if (d.mode == 0) *(u32x2*)(d.O + gi * d.o_gs + (size_t)(mi * 64 + m) * d.ldc + ni * 64 + n) = w;
        else if (d.mode == 1) *(u32x2*)(d.O + qtile_off(mi * 64 + m, gi, ni * 64 + n)) = w;
        else if (d.mode == 2) *(u32x2*)(d.O + ktile_off(mi * 64 + m, gi, ni * 64 + n)) = w;
        else *(u32x2*)(d.O + vtile_off(mi * 64 + m, gi, ni * 64 + n)) = w; };
    gemm_small(lds, g, ngroups * per, dec, epi, G_, c_, tid_in);
}

struct Args { const float* in[22]; float* out; unsigned char* ws; int ph_lo, ph_hi, ph_last, li; };
enum { I_X = 0, I_C, I_CTX, I_CCTX, I_ADAW, I_ADAB, I_PG, I_PB, I_WIN, I_WCONV, I_BCONV, I_WQ, I_WK, I_WV, I_WGATE, I_BGATE, I_GNW, I_SKIP, I_WOUT, I_FWOUT, I_W1, I_W2 };

constexpr int LDS_BYTES = 147456;
constexpr int LDS_MISC = 131072;

__device__ __forceinline__ void transpose_item(const float* W, int K, int N, bf16_t* WT, float scale, LAS float* scr, int item, int lane) {
    const int nblk = N / 32, kb = item / nblk, nb = item % nblk, k0 = 64 * kb, n0 = 32 * nb;
#pragma unroll 8
    for (int i = 0; i < 32; ++i) { const int kk = 2 * i + (lane >> 5); scr[kk * 33 + (lane & 31)] = W[(size_t)(k0 + kk) * N + n0 + (lane & 31)] * scale; }
    asm volatile("s_waitcnt lgkmcnt(0)" ::: "memory");
    const int c = lane & 7;
#pragma unroll
    for (int j = 0; j < 4; ++j) { const int n = (lane >> 3) + 8 * j; const LAS float* s = scr + (8 * c) * 33 + n;
        u32x4 o; o.x = pk2(s[0 * 33], s[1 * 33]); o.y = pk2(s[2 * 33], s[3 * 33]); o.z = pk2(s[4 * 33], s[5 * 33]); o.w = pk2(s[6 * 33], s[7 * 33]);
        *(u32x4*)(WT + (size_t)(n0 + n) * K + k0 + 8 * c) = o; }
    asm volatile("s_waitcnt lgkmcnt(0)" ::: "memory");
}

__device__ __forceinline__ void ln_norm(f32x4 (&v)[4], int lane) {
    float s = 0.f;
#pragma unroll
    for (int j = 0; j < 4; ++j) s += (v[j][0] + v[j][1]) + (v[j][2] + v[j][3]);
    const float mean = wave_sum(s, lane) * (1.f / D); float s2 = 0.f;
#pragma unroll
    for (int j = 0; j < 4; ++j) { v[j] = v[j] - mean; s2 += (v[j][0] * v[j][0] + v[j][1] * v[j][1]) + (v[j][2] * v[j][2] + v[j][3] * v[j][3]); }
    const float rstd = __builtin_amdgcn_rsqf(wave_sum(s2, lane) * (1.f / D) + LN_EPS);
#pragma unroll
    for (int j = 0; j < 4; ++j) v[j] = v[j] * rstd;
}

constexpr int PL = 24;
constexpr int NPHASE = 2 + 4 * PL;
__host__ __device__ inline bool phase_valid(int id) {
    if (id < 2) return true;
    const int layer = (id - 2) / PL, k = (id - 2) % PL;
    if (layer > 3) return false;
    if (k == 0 || (k >= 19 && k <= 22)) return true;
    if (layer & 1) return k >= 1 && k <= 5;
    return k >= 1 && k <= 18;
}


#define MOD ((float*)(ws + WS_MOD))
#define CTXX ((float*)(ws + WS_CTXX))
#define PRE ((float*)(ws + WS_PRE))
#define HIN ((bf16_t*)(ws + WS_HIN))
#define YB ((bf16_t*)(ws + WS_YB))
#define WIN ((bf16_t*)(ws + W_IN))
#define WQ ((bf16_t*)(ws + W_Q))
#define WK ((bf16_t*)(ws + W_K))
#define WV ((bf16_t*)(ws + W_V))
#define WOUT ((bf16_t*)(ws + W_OUT))
#define W1 ((bf16_t*)(ws + W_1))
#define W2 ((bf16_t*)(ws + W_2))
#define GATET ((bf16_t*)(ws + TAB_GATE))
#define S0 ((bf16_t*)(ws + WS_BIG + 0 * SLOT))
#define S1 ((bf16_t*)(ws + WS_BIG + 1 * SLOT))
#define S2 ((bf16_t*)(ws + WS_BIG + 2 * SLOT))
#define S3 ((bf16_t*)(ws + WS_BIG + 3 * SLOT))
#define S4 ((bf16_t*)(ws + WS_BIG + 4 * SLOT))
#define YH (YB + ((size_t)CR + (size_t)half * LH) * D)
#define YHC (YB + (size_t)half * LAT0 * D)
#define HCB (YH + (size_t)NCH * 4 * 2 * 4096 + (size_t)NCH * 4 * 2 * 384 * 2)
#define HH (HIN + ((size_t)CR + (size_t)half * LH) * D)
#define HHC (HIN + (size_t)half * LAT0 * D)
#define HT ((bf16_t*)(ws + WS_BIG))
#define HTC (HT + (size_t)NB * D * T)
#define PB ((bf16_t*)(ws + WS_BIG + 1 * SLOT))
#define WC ((bf16_t*)(ws + WS_BIG + 3 * SLOT))
#define ZF ((bf16_t*)(ws + WS_BIG))
#define HID ((bf16_t*)(ws + WS_BIG))

constexpr int SC_PLD = 36, SC_VLD = 72;
#define SC_ROW0(j) (((j) < 4) ? (bl * CT + (dir ? 3 - (j) : (j)) * 64) : (LAT0 + bl * T + (dir ? 127 - ((j) - 4) : ((j) - 4)) * 64))
#define SC_LOADQ(dst, r0) do { _Pragma("unroll") for (int pt = 0; pt < 4; ++pt) _Pragma("unroll") for (int ks = 0; ks < 2; ++ks) \
        dst[pt][ks] = __builtin_bit_cast(bf16x8, __builtin_amdgcn_raw_buffer_load_b128(rW, loff, oQ + ((((((r0) >> 6) * 4 + hh) * 8 + w) * 4 + pt) * 2 + ks) * 1024, 0)); } while (0)
#define SC_LOADQ1(dst, r0, pt, ks) dst[pt][ks] = __builtin_bit_cast(bf16x8, __builtin_amdgcn_raw_buffer_load_b128(rW, loff, oQ + ((((((r0) >> 6) * 4 + hh) * 8 + w) * 4 + (pt)) * 2 + (ks)) * 1024, 0))
#define SC_LOADK1(dst, r0, mt, ks) dst[mt][ks] = __builtin_bit_cast(bf16x8, __builtin_amdgcn_raw_buffer_load_b128(rW, loff, oK + ((((((r0) >> 6) * 4 + hh) * 8 + w) * 4 + (mt)) * 2 + (ks)) * 1024, 0))
#define SC_LOADK(dst, r0) do { _Pragma("unroll") for (int mt = 0; mt < 4; ++mt) _Pragma("unroll") for (int ks = 0; ks < 2; ++ks) \
        dst[mt][ks] = __builtin_bit_cast(bf16x8, __builtin_amdgcn_raw_buffer_load_b128(rW, loff, oK + ((((((r0) >> 6) * 4 + hh) * 8 + w) * 4 + mt) * 2 + ks) * 1024, 0)); } while (0)
#define SC_LOADS(P, r0) do { const int ci_ = ((((r0) >> 6) * 4 + hh) * 2 + dir); \
        P##sg0 = __builtin_bit_cast(bf16x8, __builtin_amdgcn_raw_buffer_load_b128(rW, loff, oS + ci_ * 8192 + (w >> 1) * 2048, 0)); P##sg1 = __builtin_bit_cast(bf16x8, __builtin_amdgcn_raw_buffer_load_b128(rW, loff, oS + ci_ * 8192 + (w >> 1) * 2048 + 1024, 0)); \
        P##v = __builtin_bit_cast(u32x4, __builtin_amdgcn_raw_buffer_load_b128(rW, voff, oV + ((((r0) >> 6) * 4 + hh) * 16 + slice) * 4096, 0));     \
        P##wka = __builtin_bit_cast(u32x4, __builtin_amdgcn_raw_buffer_load_b128(rW, wkoff, oG + ci_ * 1536 + 1024, 0)); P##wkb = __builtin_bit_cast(u32x4, __builtin_amdgcn_raw_buffer_load_b128(rW, wkoff, oG + ci_ * 1536 + 1024 + 16, 0));         \
        P##wint = __builtin_bit_cast(float, __builtin_amdgcn_raw_buffer_load_b32(rW, gcp, oG + ci_ * 1536 + 512, 0)); P##em = __builtin_bit_cast(float, __builtin_amdgcn_raw_buffer_load_b32(rW, gcp, oG + ci_ * 1536 + 768, 0)); \
        P##dec = __builtin_bit_cast(float, __builtin_amdgcn_raw_buffer_load_b32(rW, 0, oG + ci_ * 1536 + 1280, 0)); } while (0)
#define SC_VWRITE(bufi, P) do { LAS bf16_t* vt_ = VB + (bufi) * 2 * 3072; LAS bf16_t* vw_ = vt_ + 3072; \
        if (w < 5) { const float wk_[8] = {u2f(P##wka.x), u2f(P##wka.y), u2f(P##wka.z), u2f(P##wka.w), u2f(P##wkb.x), u2f(P##wkb.y), u2f(P##wkb.z), u2f(P##wkb.w)};     \
            if (w < 4) { *(LAS u32x4*)(vt_ + tid * 8) = P##v; \
                u32x4 sv_; sv_.x = pk2(bflo(P##v.x) * wk_[0], bfhi(P##v.x) * wk_[1]); sv_.y = pk2(bflo(P##v.y) * wk_[2], bfhi(P##v.y) * wk_[3]); \
                sv_.z = pk2(bflo(P##v.z) * wk_[4], bfhi(P##v.z) * wk_[5]); sv_.w = pk2(bflo(P##v.w) * wk_[6], bfhi(P##v.w) * wk_[7]); *(LAS u32x4*)(vw_ + tid * 8) = sv_; } \
            else if (lane < 8) { u32x4 sv_; sv_.x = pk2(wk_[0], wk_[1]); sv_.y = pk2(wk_[2], wk_[3]); sv_.z = pk2(wk_[4], wk_[5]); sv_.w = pk2(wk_[6], wk_[7]); \
                *(LAS u32x4*)(vw_ + (4 + (lane >> 2)) * 512 + (lane & 3) * 16 * 8) = sv_; } } } while (0)
#define SC_STEP(J, Qc, Qn, Kc, Kn, C, N) do { \
    const int j_ = (J); const int row0 = SC_ROW0(j_); const int jn_ = j_ < 131 ? j_ + 1 : 131; const int row1 = SC_ROW0(jn_); \
    const int hsel = (j_ < 4) ? (dir ? 2 : 0) : ((j_ < 68) ? 0 : 1); \
    const int buf = j_ & 1; \
    const LAS bf16_t* VT = VB + buf * 2 * 3072; const LAS bf16_t* VW = VT + 3072; \
    LDS_BARRIER();                                                       \
    SC_LOADS(N, row1); \
      \
    if (!(abl_ & 1)) _Pragma("unroll") for (int nt = 0; nt < 3; ++nt) { \
        f32x4 d1[4]; \
        _Pragma("unroll") for (int pt = 0; pt < 4; ++pt) d1[pt] = (f32x4){0.f, 0.f, 0.f, 0.f}; \
        _Pragma("unroll") for (int ks = 0; ks < 2; ++ks) { \
            u32x4 bw; bw.x = pg8::cvt_pk_bf16(st[2 * ks][nt][0], st[2 * ks][nt][1]); bw.y = pg8::cvt_pk_bf16(st[2 * ks][nt][2], st[2 * ks][nt][3]); \
            bw.z = pg8::cvt_pk_bf16(st[2 * ks + 1][nt][0], st[2 * ks + 1][nt][1]); bw.w = pg8::cvt_pk_bf16(st[2 * ks + 1][nt][2], st[2 * ks + 1][nt][3]); \
            const bf16x8 bs = __builtin_bit_cast(bf16x8, bw); \
            _Pragma("unroll") for (int pt = 0; pt < 4; ++pt) d1[pt] = __builtin_amdgcn_mfma_f32_16x16x32_bf16(bs, Qc[pt][ks], d1[pt], 0, 0, 0); \
            SC_LOADQ1(Qn, row1, (nt * 2 + ks) >> 1, (nt * 2 + ks) & 1);     } \
        _Pragma("unroll") for (int pt = 0; pt < 4; ++pt) { \
            if (nt < 2) { u32x2 pw_; pw_.x = pg8::cvt_pk_bf16(d1[pt][0], d1[pt][1]); pw_.y = pg8::cvt_pk_bf16(d1[pt][2], d1[pt][3]); *(LAS u32x2*)(Pbh + (w * 64 + 16 * pt + fr) * 40 + 16 * nt + 4 * fq) = pw_; }     \
            else if (fq == 0) NQs[w * 64 + 16 * pt + fr] = d1[pt][0]; } } \
    SC_LOADQ1(Qn, row1, 3, 0); SC_LOADQ1(Qn, row1, 3, 1); \
    if (!(abl_ & 2)) {     \
        const int pt2 = w >> 1, nt2 = w & 1; \
        f32x4 d2 = (f32x4){0.f, 0.f, 0.f, 0.f}, d3 = (f32x4){0.f, 0.f, 0.f, 0.f}; \
        { const bf16x8 vt0 = *(const LAS bf16x8*)(VT + (nt2 * 2 + 0) * 512 + lane * 8), vt1 = *(const LAS bf16x8*)(VT + (nt2 * 2 + 1) * 512 + lane * 8); \
          d2 = __builtin_amdgcn_mfma_f32_16x16x32_bf16(vt0, C##sg0, d2, 0, 0, 0); d2 = __builtin_amdgcn_mfma_f32_16x16x32_bf16(vt1, C##sg1, d2, 0, 0, 0); } \
        *(LAS f32x4*)(O2 + (16 * pt2 + fr) * SC_PLD + 16 * nt2 + 4 * fq) = d2; \
        if (nt2 == 0) { \
            const bf16x8 vt0 = *(const LAS bf16x8*)(VT + 4 * 512 + lane * 8), vt1 = *(const LAS bf16x8*)(VT + 5 * 512 + lane * 8); \
            d3 = __builtin_amdgcn_mfma_f32_16x16x32_bf16(vt0, C##sg0, d3, 0, 0, 0); d3 = __builtin_amdgcn_mfma_f32_16x16x32_bf16(vt1, C##sg1, d3, 0, 0, 0); \
            if (fq == 0) O2[(16 * pt2 + fr) * SC_PLD + 32] = d3[0]; } } \
    LDS_BARRIER();                                                       \
      \
    u32x2 cpr_[8]; float cnq_[8]; \
    _Pragma("unroll") for (int ww = 0; ww < 8; ++ww) { cpr_[ww] = *(const LAS u32x2*)(Pbh + (ww * 64 + cp) * 40 + 4 * ceq); cnq_[ww] = NQs[ww * 64 + cp]; } \
    const f32x4 co2_ = *(const LAS f32x4*)(O2 + cp * SC_PLD + 4 * ceq); const float crs_ = O2[cp * SC_PLD + 32]; \
      \
    if (!(abl_ & 4)) _Pragma("unroll") for (int nt = 0; nt < 3; ++nt) { \
        const bf16x8 vw0 = *(const LAS bf16x8*)(VW + (nt * 2 + 0) * 512 + lane * 8), vw1 = *(const LAS bf16x8*)(VW + (nt * 2 + 1) * 512 + lane * 8); \
        _Pragma("unroll") for (int mt = 0; mt < 4; ++mt) { f32x4 a = st[mt][nt] * C##dec; \
            a = __builtin_amdgcn_mfma_f32_16x16x32_bf16(Kc[mt][0], vw0, a, 0, 0, 0); \
            a = __builtin_amdgcn_mfma_f32_16x16x32_bf16(Kc[mt][1], vw1, a, 0, 0, 0); st[mt][nt] = a; \
            if (nt < 2) SC_LOADK1(Kn, row1, (nt * 4 + mt) >> 1, (nt * 4 + mt) & 1); } } \
    if (!(abl_ & 8)) {     \
        f32x4 o1 = (f32x4){0.f, 0.f, 0.f, 0.f}; float nq = 0.f; \
        _Pragma("unroll") for (int ww = 0; ww < 8; ++ww) { o1 += (f32x4){bflo(cpr_[ww].x), bfhi(cpr_[ww].x), bflo(cpr_[ww].y), bfhi(cpr_[ww].y)}; nq += cnq_[ww]; } \
        const float den = C##wint * nq + crs_; const float scl = __builtin_amdgcn_rcpf(fmaxf(fabsf(den), C##em)); \
        const f32x4 o = (o1 * C##wint + co2_) * scl; \
        u32x2 ow; ow.x = pk2(o[0], o[1]); ow.y = pk2(o[2], o[3]); \
        __builtin_amdgcn_raw_buffer_store_b64(ow, rW, hoff, (rep_ + 1 < SCAN_REP) ? (oC + 512 * DI * 2) : ((hsel == 0 ? oH : (hsel == 1 ? oV : oC)) + (((row0 >> 6) * 4 + hh) * 16 + slice) * 4096), 0); } \
    if (!(abl_ & 16)) SC_VWRITE(buf ^ 1, N);                                     \
} while (0)

__device__ __forceinline__ void scan_phase(LAS unsigned char* lds, unsigned char* ws, int half, const XcdBarrier& bar, int tid, int lane, int wave, int bx) {
    LAS bf16_t* Pbh = (LAS bf16_t*)lds;
    LAS float* NQs = (LAS float*)(lds + 8 * 64 * 40 * 2);
    LAS float* O2 = NQs + 8 * 64; LAS bf16_t* VB = (LAS bf16_t*)(O2 + 64 * SC_PLD);
    const int xcd = bx & 7, idx = bx >> 3;
    const int scn = (xcd * 2 + (idx >> 4)) & 15, slice = idx & 15;
    const int bl = scn >> 3, hh = (scn >> 1) & 3, dir = scn & 1, e0 = slice * 32;
    const int fr = lane & 15, fq = lane >> 4, w = wave;
    const int cp = tid >> 3, ceq = tid & 7;
    const unsigned loff = (unsigned)lane * 16u;
    const unsigned voff = (unsigned)(tid & 255) * 16u;
    const unsigned hoff = (unsigned)(cp * 32 + 4 * ceq) * 2u;
    const unsigned gcp = (unsigned)cp * 4u;
    const unsigned wkoff = (w < 4) ? (unsigned)(32 * ((tid >> 6) & 1) + 8 * ((tid & 63) >> 4)) * 4u : (unsigned)(32 * ((lane >> 2) & 1) + 8 * (lane & 3)) * 4u;
    const __amdgpu_buffer_rsrc_t rW = __builtin_amdgcn_make_buffer_rsrc((void*)ws, 0, (int)(512 * MiB), 0x00020000);
    const int oYH = (int)(WS_YB + ((size_t)CR + (size_t)half * LH) * D * 2);
    const int oQ = (int)(WS_BIG + 3 * SLOT), oK = (int)(WS_BIG + 4 * SLOT), oV = (int)(WS_BIG + 2 * SLOT), oH = (int)(WS_BIG + 0 * SLOT);
    const int oS = oYH, oG = oYH + NCH * 4 * 2 * 8192, oC = oG + NCH * 4 * 2 * 1536;
    for (int i = tid; i < 4 * 1024; i += NTHR) { const int im = i >> 10, r = i & 1023, ln = (r & 511) >> 3; VB[im * 3072 + 2048 + r] = (bf16_t)(((im & 1) == 0 && (ln & 15) == 0) ? 0x3F80u : 0u); }
    __syncthreads();
    for (int rep_ = 0; rep_ < SCAN_REP; ++rep_) {
    const int abl_ = (rep_ + 1 < SCAN_REP) ? SC_ABL : 0;
    f32x4 st[4][3];
#pragma unroll
    for (int a = 0; a < 4; ++a)
#pragma unroll
        for (int b = 0; b < 3; ++b) st[a][b] = (f32x4){0.f, 0.f, 0.f, 0.f};
    bf16x8 Q0[4][2], Q1[4][2], K0[4][2], K1[4][2];
    bf16x8 Asg0, Asg1, Bsg0, Bsg1; u32x4 Av = (u32x4){0u, 0u, 0u, 0u}, Bv = Av, Awka = Av, Awkb = Av, Bwka = Av, Bwkb = Av; float Awint, Aem, Adec, Bwint, Bem, Bdec;
    { const int r0 = SC_ROW0(0); SC_LOADQ(Q0, r0); SC_LOADK(K0, r0); SC_LOADS(A, r0); SC_VWRITE(0, A); }
#pragma unroll 1
    for (int j = 0; j < 132; j += 2) {
        if (j == 68) xcd_barrier(bar, tid == 0);
        SC_STEP(j, Q0, Q1, K0, K1, A, B);
        SC_STEP(j + 1, Q1, Q0, K1, K0, B, A);
    }
    __syncthreads();
    }
}
#undef SC_ROW0
#undef SC_LOADQ
#undef SC_LOADK
#undef SC_LOADS
#undef SC_VWRITE
#undef SC_STEP

typedef const __attribute__((address_space(4))) Args KA;
__device__ __forceinline__ KA* kargs() { KA* k = (KA*)__builtin_amdgcn_kernarg_segment_ptr(); asm volatile("" : "+s"(k)); return k; }
#define PH_BEGIN() \
    KA* ka = kargs(); unsigned char* ws = ka->ws; (void)ws; \
    int wave = wave0; asm volatile("" : "+s"(wave)); \
    unsigned lz_ = 0u; asm volatile("" : "+v"(lz_)); const int lane = (int)__builtin_amdgcn_mbcnt_hi(~0u, __builtin_amdgcn_mbcnt_lo(~0u, lz_)); \
    const int tid = wave * 64 + lane; (void)tid; \
    const int gw = bx * NWAVES + wave, NGW = G * NWAVES; (void)gw; (void)NGW;

__global__ void __launch_bounds__(NTHR, 2) fwd(Args args) {
    extern __shared__ __attribute__((aligned(16))) unsigned char lds_raw[];
    LAS unsigned char* lds = (LAS unsigned char*)lds_raw;
    const int G = gridDim.x, bx = blockIdx.x;
    const int wave0 = __builtin_amdgcn_readfirstlane(threadIdx.x >> 6);
    volatile LAS unsigned* MISC = (volatile LAS unsigned*)(lds + LDS_MISC);
    if (threadIdx.x < 64) MISC[threadIdx.x] = 0u;
    __syncthreads();
    XcdBarrier bar = xcd_barrier_post((unsigned*)(args.ws + WS_CTL + 65536) + (size_t)args.li * 4096, MISC + 8);
    const int lo = args.ph_lo, hi = args.ph_hi, plast = args.ph_last;
#define IN(k) (lo <= (k) && (k) < hi)
#define SEAM(k) do { if ((k) != plast) { xcd_barrier(bar, tid == 0); if (DUP_BAR) xcd_barrier(bar, tid == 0); } } while (0)

    if (EN_PRO && IN(0)) { PH_BEGIN();
        {
            LAS float* sc = (LAS float*)lds;
            for (int i = tid; i < 5 * D; i += NTHR) { const int r = i / D, k = i % D; const float x = r < 4 ? ka->in[I_C][r * D + k] : ka->in[I_CCTX][k]; sc[i] = siluf(x); }
            __syncthreads();
            LAS float* red = (LAS float*)(lds + 32768);
            const int kp = tid >> 5, cc = tid & 31;
            for (int item = bx; item < 4 * 192; item += G) {
                const int layer = item / 192, n0 = (item % 192) * 32;
                const float* w = ka->in[I_ADAW] + (size_t)layer * D * 6 * D + n0 + cc;
                float a0 = 0.f, a1 = 0.f, a2 = 0.f, a3 = 0.f, a4 = 0.f;
#pragma unroll 16
                for (int k = kp * 64; k < kp * 64 + 64; ++k) { const float wv = w[(size_t)k * 6 * D]; a0 += sc[k] * wv; a1 += sc[D + k] * wv; a2 += sc[2 * D + k] * wv; a3 += sc[3 * D + k] * wv; a4 += sc[4 * D + k] * wv; }
                red[(kp * 32 + cc) * 5 + 0] = a0; red[(kp * 32 + cc) * 5 + 1] = a1; red[(kp * 32 + cc) * 5 + 2] = a2; red[(kp * 32 + cc) * 5 + 3] = a3; red[(kp * 32 + cc) * 5 + 4] = a4;
                __syncthreads();
                if (tid < 160) { const int c2 = tid % 32, r = tid / 32; float s = ka->in[I_ADAB][layer * 6 * D + n0 + c2];
                    for (int q = 0; q < 16; ++q) s += red[(q * 32 + c2) * 5 + r];
                    MOD[((size_t)layer * 5 + r) * 6 * D + n0 + c2] = s; }
                __syncthreads();
            }
        }
        {
            bf16_t* A1 = (bf16_t*)(ws + TAB_A1); bf16_t* A2 = (bf16_t*)(ws + TAB_A2); bf16_t* BZ = (bf16_t*)(ws + TAB_BZ); bf16_t* ACTX = (bf16_t*)(ws + TAB_ACTX);
            const int gt = bx * NTHR + tid, NGT = G * NTHR;
            const float s8192 = 0.011048543456039806f;
            for (int i = gt; i < 512 * 256; i += NGT) { const int m = i / 256, t1 = i % 256, ri = m / 256, t1p = m % 256; const int ph = (t1 * t1p) & 255; float sn, cs; sincospif((float)ph * (2.0f / 256.0f), &sn, &cs);
                A1[i] = (bf16_t)f2bf((ri == 0 ? cs : -sn) * s8192);
                ACTX[i] = (bf16_t)f2bf((ri == 0 ? cs : -sn) * 0.0625f); }
            for (int i = gt; i < 256 * 64 * 64; i += NGT) { const int t1p = i / 4096, m = (i / 64) % 64, k = i % 64; const int rip = m / 32, t2p = m % 32, ri = k / 32, t2 = k % 32;
                const int ph = (t2 * t1p + 256 * t2 * t2p) & 8191; float sn, cs; sincospif((float)ph * (2.0f / 8192.0f), &sn, &cs);
                const float v = (rip == ri) ? cs : (rip == 0 ? sn : -sn); A2[i] = (bf16_t)f2bf(v); }
            for (int i = gt; i < 256 * 512; i += NGT) { const int cp = i / 512, k = i % 512, ri = k / 256, c = k % 256; const int ph = (c * cp) & 255; float sn, cs; sincospif((float)ph * (2.0f / 256.0f), &sn, &cs);
                BZ[i] = (bf16_t)f2bf((ri == 0 ? cs : sn) * 0.0625f); }
        }
        SEAM(0);
    }
    if (EN_PRO && IN(1)) { PH_BEGIN();
        for (int r = gw; r < R; r += NGW) {
            const RowInfo ri = row_info(r);
            const float* xr = ri.is_ctx ? ka->in[I_CTX] + ((size_t)ri.b * CT + ri.t) * D : ka->in[I_X] + ((size_t)ri.b * T + ri.t) * D;
            const float* md = MOD + ((size_t)0 * 5 + (ri.is_ctx ? 4 : ri.b)) * 6 * D;
            f32x4 v[4];
#pragma unroll
            for (int j = 0; j < 4; ++j) v[j] = *(const f32x4*)(xr + 256 * j + 4 * lane);
            ln_norm(v, lane);
            bf16_t* o = HIN + (size_t)r * D;
#pragma unroll
            for (int j = 0; j < 4; ++j) { const f32x4 sh = *(const f32x4*)(md + 256 * j + 4 * lane), sc = *(const f32x4*)(md + D + 256 * j + 4 * lane);
                const f32x4 h = v[j] * (1.0f + sc) + sh; u32x2 w; w.x = pk2(h[0], h[1]); w.y = pk2(h[2], h[3]); *(u32x2*)(o + 256 * j + 4 * lane) = w; }
        }
        SEAM(1);
    }

    for (int layer = 0; layer < 4; ++layer) {
        const int pb = 2 + layer * PL;
        if (hi <= pb || lo >= pb + PL) continue;
        const int jl = layer >> 1;
        const bool is_m = (layer & 1) == 0;
        if (EN_WC && IN(pb + 0)) { PH_BEGIN();
 for (int rp_ = 0; rp_ < REPN(5); ++rp_) {
            LAS float* scr = (LAS float*)(lds + wave * 16384);
            const int i_in = (D / 64) * (2 * DI / 32), i_h = (DH / 64) * (DH / 32), i_out = (DI / 64) * (D / 32), i_f = (D / 64) * (D / 32), i_1 = (D / 64) * (DFF / 32), i_2 = (DFF / 64) * (D / 32);
            const int n_mix = is_m ? (i_in + 12 * i_h + i_out) : i_f;
            const int nitems = n_mix + i_1 + i_2;
            for (int it = gw; it < nitems; it += NGW) {
                int r = it;
                if (r >= n_mix) { r -= n_mix;
                    if (r < i_1) transpose_item(ka->in[I_W1] + (size_t)layer * D * DFF, D, DFF, W1, 1.f, scr, r, lane);
                    else transpose_item(ka->in[I_W2] + (size_t)layer * DFF * D, DFF, D, W2, 1.f, scr, r - i_1, lane);
                    continue; }
                if (!is_m) { transpose_item(ka->in[I_FWOUT] + (size_t)jl * D * D, D, D, WOUT, 1.f, scr, r, lane); continue; }
                if (r < i_in) { transpose_item(ka->in[I_WIN] + (size_t)jl * D * 2 * DI, D, 2 * DI, WIN, 1.f, scr, r, lane); continue; } r -= i_in;
                if (r < 12 * i_h) { const int which = r / (4 * i_h), hh = (r / i_h) % 4, rr = r % i_h;
                    const float* src = ka->in[which == 0 ? I_WQ : (which == 1 ? I_WK : I_WV)] + ((size_t)jl * NH + hh) * DH * DH;
                    bf16_t* dst = (which == 0 ? WQ : (which == 1 ? WK : WV)) + (size_t)hh * DH * DH;
                    transpose_item(src, DH, DH, dst, which == 1 ? 0.044194173824159216f : 1.f, scr, rr, lane); continue; } r -= 12 * i_h;
                transpose_item(ka->in[I_WOUT] + (size_t)jl * DI * D, DI, D, WOUT, 1.f, scr, r, lane);
            }
            if (is_m) {
                const float* wg = ka->in[I_WGATE] + (size_t)jl * 3 * DI * 16;
                const int n = lane & 15, eq = lane >> 4;
                for (int k2 = gw; k2 < DI; k2 += NGW) {
                    const int hh = k2 / DH, d = k2 % DH;
                    const float* q = ka->in[I_WQ] + (((size_t)jl * NH + hh) * DH + d) * DH + eq * 128; const float* kx = ka->in[I_WK] + (((size_t)jl * NH + hh) * DH + d) * DH + eq * 128;
                    const float* vx = ka->in[I_WV] + (((size_t)jl * NH + hh) * DH + d) * DH + eq * 128;
                    const float* g0 = wg + ((size_t)0 * DI + hh * DH + eq * 128) * 16 + n; const float* g1 = wg + ((size_t)1 * DI + hh * DH + eq * 128) * 16 + n; const float* g2 = wg + ((size_t)2 * DI + hh * DH + eq * 128) * 16 + n;
                    float s0 = 0.f, s1 = 0.f, s2 = 0.f;
#pragma unroll 8
                    for (int e = 0; e < 128; ++e) { s0 += q[e] * g0[e * 16]; s1 += kx[e] * g1[e * 16]; s2 += vx[e] * g2[e * 16]; }
                    float sa = s0 + 0.044194173824159216f * s1;
                    sa += shx(sa, 16, lane); sa += shx(sa, 32, lane); s2 += shx(s2, 16, lane); s2 += shx(s2, 32, lane);
                    if (lane < 16) { GATET[(size_t)n * 4096 + k2] = (bf16_t)f2bf(sa); GATET[(size_t)n * 4096 + DI + k2] = (bf16_t)f2bf(s2); }
                    else if (lane < 64) { GATET[(size_t)(16 + (lane - 16)) * 4096 + k2] = (bf16_t)0; GATET[(size_t)(16 + (lane - 16)) * 4096 + DI + k2] = (bf16_t)0; }
                }
            }
 }
            SEAM(pb + 0);
        }

        if (EN_MIX && is_m) {
            for (int half = 0; half < 2; ++half) {
                const int hb = pb + 1 + 9 * half;
                if (hi <= hb || lo >= hb + 9) continue;
                if (IN(hb + 0)) { PH_BEGIN();
 for (int rp_ = 0; rp_ < REPN(0); ++rp_) {
                    pg8::Gemm g{HH, WIN, D, D, D, 0, 0, LH / 256, DI / 256, 1};
                    pg8::EpiStore E{S0 + (size_t)LAT0 * DI, 0, DI, 0};
                    pg8::gemm_phase(lds, g, E, G, bx, tid); if (DUP_MIX) pg8::gemm_phase(lds, g, E, G, bx, tid);
                    { SmallGemm sg{HHC, WIN, D, D, D, D, D, 0, 0}; SmallDense sd{S0, 0, DI, LAT0 / 64, DI / 64, 0, 0, 0}; gemm_small_dense(lds, sg, sd, 1, G, bx, tid); if (DUP_CTX) gemm_small_dense(lds, sg, sd, 1, G, bx, tid); }
 }
                    SEAM(hb + 0);
                }
                if (IN(hb + 1)) { PH_BEGIN();
 for (int rp_ = 0; rp_ < REPN(3); ++rp_) {
                    const float* wc = ka->in[I_WCONV] + (size_t)jl * 9 * DI; const float* bc = ka->in[I_BCONV] + (size_t)jl * DI;
                    const int gt = bx * NTHR + tid, NGT = G * NTHR;
                    for (int i = gt; i < 2 * 128 * 2 * (DI / 8); i += NGT) {
                        const int cg = i & 255, rest = i >> 8, hr = rest & 1, r = (rest >> 1) & 127, bl = rest >> 8, c0 = cg * 8, gc0 = 32 * hr;
                        float wv[9][8], bv[8];
#pragma unroll
                        for (int tp = 0; tp < 9; ++tp) { const f32x4 a0 = *(const f32x4*)(wc + (size_t)tp * DI + c0), a1 = *(const f32x4*)(wc + (size_t)tp * DI + c0 + 4);
                            wv[tp][0] = a0[0]; wv[tp][1] = a0[1]; wv[tp][2] = a0[2]; wv[tp][3] = a0[3]; wv[tp][4] = a1[0]; wv[tp][5] = a1[1]; wv[tp][6] = a1[2]; wv[tp][7] = a1[3]; }
                        { const f32x4 a0 = *(const f32x4*)(bc + c0), a1 = *(const f32x4*)(bc + c0 + 4); bv[0] = a0[0]; bv[1] = a0[1]; bv[2] = a0[2]; bv[3] = a0[3]; bv[4] = a1[0]; bv[5] = a1[1]; bv[6] = a1[2]; bv[7] = a1[3]; }
                        const bf16_t* xb = S0 + (size_t)(LAT0 + bl * T + r * 64) * DI + c0;
                        bf16_t* ob = S1 + (size_t)(LAT0 + bl * T + r * 64) * DI + c0;
                        const bool rok[3] = {r > 0, true, r < 127};
                        float win[3][3][8];
#define CV_LOADCOL(slot, col) do { _Pragma("unroll") for (int di = 0; di < 3; ++di) { u32x4 xv = (u32x4){0u, 0u, 0u, 0u}; \
                                if (rok[di] && (col) >= 0 && (col) < 64) xv = *(const u32x4*)(xb + (ptrdiff_t)((di - 1) * 64 + (col)) * DI); \
                                win[slot][di][0] = bflo(xv.x); win[slot][di][1] = bfhi(xv.x); win[slot][di][2] = bflo(xv.y); win[slot][di][3] = bfhi(xv.y); \
                                win[slot][di][4] = bflo(xv.z); win[slot][di][5] = bfhi(xv.z); win[slot][di][6] = bflo(xv.w); win[slot][di][7] = bfhi(xv.w); } } while (0)
#define CV_STEP(sl, sm, sr) do { CV_LOADCOL(sr, gc + 1); \
                                if (gc < gc0 + 32) { float acc[8]; \
                                    _Pragma("unroll") for (int e = 0; e < 8; ++e) { float s = bv[e]; \
                                        _Pragma("unroll") for (int di = 0; di < 3; ++di) s += win[sl][di][e] * wv[di * 3 + 0][e] + win[sm][di][e] * wv[di * 3 + 1][e] + win[sr][di][e] * wv[di * 3 + 2][e]; \
                                        acc[e] = siluf(s); } \
                                    u32x4 o; o.x = pk2(acc[0], acc[1]); o.y = pk2(acc[2], acc[3]); o.z = pk2(acc[4], acc[5]); o.w = pk2(acc[6], acc[7]); \
                                    *(u32x4*)(ob + (size_t)gc * DI) = o; } \
                                ++gc; } while (0)
                        int gc = gc0;
                        CV_LOADCOL(0, gc0 - 1); CV_LOADCOL(1, gc0);
#pragma unroll 1
                        for (int g3 = 0; g3 < 11; ++g3) { CV_STEP(0, 1, 2); CV_STEP(1, 2, 0); CV_STEP(2, 0, 1); }
#undef CV_LOADCOL
#undef CV_STEP
                    }
                    for (int i = gt; i < LAT0 * (DI / 8); i += NGT) {
                        const int q = i / (DI / 8), c0 = (i % (DI / 8)) * 8, t = q % CT;
                        float acc[8];
#pragma unroll
                        for (int e = 0; e < 8; ++e) acc[e] = bc[c0 + e];
#pragma unroll
                        for (int dj = 0; dj < 3; ++dj) { const int tt = t + dj - 1; if (tt < 0 || tt >= CT) continue;
                            const u32x4 xv = *(const u32x4*)(S0 + (size_t)(q + dj - 1) * DI + c0); const float* w = wc + (size_t)(3 + dj) * DI + c0;
                            acc[0] += bflo(xv.x) * w[0]; acc[1] += bfhi(xv.x) * w[1]; acc[2] += bflo(xv.y) * w[2]; acc[3] += bfhi(xv.y) * w[3];
                            acc[4] += bflo(xv.z) * w[4]; acc[5] += bfhi(xv.z) * w[5]; acc[6] += bflo(xv.w) * w[6]; acc[7] += bfhi(xv.w) * w[7]; }
                        u32x4 o; o.x = pk2(siluf(acc[0]), siluf(acc[1])); o.y = pk2(siluf(acc[2]), siluf(acc[3])); o.z = pk2(siluf(acc[4]), siluf(acc[5])); o.w = pk2(siluf(acc[6]), siluf(acc[7]));
                        *(u32x4*)(S1 + (size_t)q * DI + c0) = o;
                    }
 }
                    SEAM(hb + 1);
                }
                if (IN(hb + 2)) { PH_BEGIN();
 for (int rp_ = 0; rp_ < REPN(0); ++rp_) {
                    { pg8::Gemm g{WV, S0 + (size_t)LAT0 * DI, DH, DI, DH, (long)DH * DH, DH, DH / 256, LH / 256, NH};
                      pg8::EpiStore E{S2, 0, 0, 0, 3, LAT0};
                      pg8::gemm_phase(lds, g, E, G, bx, tid); if (DUP_MIX) pg8::gemm_phase(lds, g, E, G, bx, tid); }
                    { SmallGemm sg{WV, S0, DH, DI, DH, DH, DH, 0, 0}; SmallDense sd{S2, 0, 0, DH / 64, LAT0 / 64, 0, (long)DH * DH, DH, 3}; gemm_small_dense(lds, sg, sd, NH, G, bx, tid); if (DUP_CTX) gemm_small_dense(lds, sg, sd, NH, G, bx, tid); }
                    { SmallGemm sg{S1, GATET, DI, 4096, 4096, DI, 4096, (long)(S0 - S1), 0};
                      const float* bg = ka->in[I_BGATE] + (size_t)jl * 16;
                      auto dec = [=](int u, long& ao, long& bo) { ao = (long)u * 64 * DI; bo = 0; };
                      auto epi = [=](int u, int m, int n, const f32x4& v) { if (n < 16) { float* p = PRE + ((size_t)u * 64 + m) * 16 + n; const f32x4 b4 = *(const f32x4*)(bg + n); *(f32x4*)p = v + b4; } };
                      gemm_small(lds, sg, NCH, dec, epi, G, bx, tid); }
 }
                    SEAM(hb + 2);
                }
                if (IN(hb + 3)) { PH_BEGIN();
 for (int rp_ = 0; rp_ < REPN(0); ++rp_) {
                    { pg8::Gemm g{S1 + (size_t)LAT0 * DI, WQ, DI, DH, DH, DH, (long)DH * DH, LH / 256, DH / 256, NH}; pg8::EpiStore E{S3, DH, DI, 0, 1, LAT0}; pg8::gemm_phase(lds, g, E, G, bx, tid); if (DUP_MIX) pg8::gemm_phase(lds, g, E, G, bx, tid); }
                    { SmallGemm sg{S1, WQ, DI, DH, DH, DH, DH, 0, 0}; SmallDense sd{S3, DH, DI, LAT0 / 64, DH / 64, 0, DH, (long)DH * DH, 1}; gemm_small_dense(lds, sg, sd, NH, G, bx, tid); if (DUP_CTX) gemm_small_dense(lds, sg, sd, NH, G, bx, tid); }
                    { pg8::Gemm g{S1 + (size_t)LAT0 * DI, WK, DI, DH, DH, DH, (long)DH * DH, LH / 256, DH / 256, NH}; pg8::EpiStore E{S0 + (size_t)LAT0 * DI, DH, DI, 0}; pg8::gemm_phase(lds, g, E, G, bx, tid); if (DUP_MIX) pg8::gemm_phase(lds, g, E, G, bx, tid); }
                    { SmallGemm sg{S1, WK, DI, DH, DH, DH, DH, 0, 0}; SmallDense sd{S0, DH, DI, LAT0 / 64, DH / 64, 0, DH, (long)DH * DH}; gemm_small_dense(lds, sg, sd, NH, G, bx, tid); if (DUP_CTX) gemm_small_dense(lds, sg, sd, NH, G, bx, tid); }
                    { pg8::Gemm g{WK, S1 + (size_t)LAT0 * DI, DH, DI, DH, (long)DH * DH, DH, DH / 256, LH / 256, NH}; pg8::EpiStore E{S4, (long)DH * RH, RH, 0, 2, LAT0}; pg8::gemm_phase(lds, g, E, G, bx, tid); if (DUP_MIX) pg8::gemm_phase(lds, g, E, G, bx, tid); }
                    { SmallGemm sg{WK, S1, DH, DI, DH, DH, DH, 0, 0}; SmallDense sd{S4, (long)DH * RH, RH, DH / 64, LAT0 / 64, 0, (long)DH * DH, DH, 2}; gemm_small_dense(lds, sg, sd, NH, G, bx, tid); if (DUP_CTX) gemm_small_dense(lds, sg, sd, NH, G, bx, tid); }
                    if (bx < 16) {
                        const int sc = bx, bl = sc >> 3, hh = (sc >> 1) & 3, dir = sc & 1;
                        LAS float* bcs = (LAS float*)lds;
                        LAS float* vss = bcs + 132 * 64;
                        LAS float* bl_ = vss + 132 * 64;
                        LAS float* vm_ = bl_ + 132;
                        LAS float* mi_ = vm_ + 132;
                        const int u = lane, p = dir ? 63 - u : u;
#pragma unroll
                        for (int i = 0; i < 17; ++i) { const int j = wave + 8 * i;
                            if (j < 132) { int row0; if (j < 4) { const int c = dir ? 3 - j : j; row0 = bl * CT + c * 64; } else { const int c = dir ? 127 - (j - 4) : (j - 4); row0 = LAT0 + bl * T + c * 64; }
                                const float* pr = PRE + (size_t)(row0 + p) * 16 + 8 * dir + hh; bcs[j * 64 + p] = pr[4]; vss[j * 64 + p] = pr[0]; } }
                        asm volatile("s_waitcnt vmcnt(0) lgkmcnt(0)" ::: "memory");
#pragma unroll 1
                        for (int i = 0; i < 17; ++i) { const int j = wave + 8 * i;
                            if (j < 132) { const float f = bcs[j * 64 + p], lia = vss[j * 64 + p]; float x = fminf(f, 0.f) - log1pf(__expf(-fabsf(f)));
                                x = scan_add64(x);
                                const float v = lia - x; float pm = v;
                                pm = scan_max64(pm);
                                bcs[j * 64 + p] = x; vss[j * 64 + p] = v; if (u == 63) { bl_[j] = x; vm_[j] = pm; } } }
                        __syncthreads();
                        if (wave == 0) {
                            const float ni = -__builtin_inff();
                            float ea[3], eb[3];
#pragma unroll
                            for (int t = 0; t < 3; ++t) { const int j = 3 * lane + t; const bool ok = j < 132; const float blj = bl_[ok ? j : 0], vmj = vm_[ok ? j : 0]; ea[t] = ok ? blj : 0.f; eb[t] = ok ? blj + vmj : ni; }
                            float A = ea[0] + ea[1], B = fmaxf(eb[0] + ea[1], eb[1]); B = fmaxf(B + ea[2], eb[2]); A += ea[2];
#define G12_STEP(CTRL, RM) do { const float pa_ = dppf<CTRL, RM>(0.f, A), pb_ = dppf<CTRL, RM>(ni, B); B = fmaxf(pb_ + A, B); A += pa_; } while (0)
                            G12_STEP(0x111, 0xF); G12_STEP(0x112, 0xF); G12_STEP(0x114, 0xF); G12_STEP(0x118, 0xF); G12_STEP(0x142, 0xA); G12_STEP(0x143, 0xC);
#undef G12_STEP
                            float EA = shup(A, 1, lane), EB = shup(B, 1, lane); if (lane == 0) { EA = 0.f; EB = ni; }
                            float m = fmaxf(EA, EB);
#pragma unroll
                            for (int t = 0; t < 3; ++t) { const int j = 3 * lane + t; if (j < 132) { mi_[j] = m; m = fmaxf(m + ea[t], eb[t]); } }
                        }
                        __syncthreads();
                        float* GPw = (float*)(YH + (size_t)NCH * 4 * 2 * 4096);
#pragma unroll 1
                        for (int i = 0; i < 17; ++i) { const int j = wave + 8 * i;
                            if (j < 132) { int row0; if (j < 4) { const int c = dir ? 3 - j : j; row0 = bl * CT + c * 64; } else { const int c = dir ? 127 - (j - 4) : (j - 4); row0 = LAT0 + bl * T + c * 64; }
                                const float bc = bcs[j * 64 + p], v = vss[j * 64 + p]; float pm = v;
                                pm = scan_max64(pm);
                                const float m_in = mi_[j], btot = bl_[j], m_new = btot + fmaxf(m_in, vm_[j]);
                                const float uu = -fmaxf(m_in, pm);
                                float* gp = GPw + ((size_t)((row0 >> 6) * 4 + hh) * 2 + dir) * 384;
                                gp[p] = uu; gp[64 + p] = v; gp[128 + p] = __expf(m_in + uu); gp[192 + p] = __expf(uu - bc); gp[256 + p] = __expf(btot - m_new + v);
                                if (u == 0) gp[320] = __expf(btot + m_in - m_new); } }
                    }
 }
                    SEAM(hb + 3);
                }
                if (IN(hb + 4)) { PH_BEGIN();
 for (int rp_ = 0; rp_ < REPN(4); ++rp_) {
                    SmallGemm sg{S3, S0, DI, DI, DH, DH, DH, 0, 0, 1};
                    bf16_t* SGw = YH; const float* GPr = (const float*)(YH + (size_t)NCH * 4 * 2 * 4096);
                    auto dec = [=](int u, long& ao, long& bo) { const int ch = u >> 2, hh = u & 3; ao = u; bo = (long)ch * 64 * DI + hh * DH; };
                    auto epi = [=](int u, int m, int n, const f32x4& v) {
#pragma unroll
                        for (int dir = 0; dir < 2; ++dir) { const float* gp = GPr + ((size_t)u * 2 + dir) * 384; const float up = gp[m]; const f32x4 vs = *(const f32x4*)(gp + 64 + n); float o[4];
#pragma unroll
                            for (int i = 0; i < 4; ++i) { const int s = n + i; const bool ok = dir ? (s >= m) : (s <= m); const float gte = ok ? __expf(up + vs[i]) : 0.f; o[i] = v[i] * gte; }
                            u32x2 w; w.x = pk2(o[0], o[1]); w.y = pk2(o[2], o[3]);
                            *(u32x2*)(SGw + ((size_t)u * 2 + dir) * 4096 + ((m >> 4) * 2 + (n >> 5)) * 512 + (((n >> 3) & 3) * 16 + (m & 15)) * 8 + (n & 7)) = w; } };
                    gemm_small(lds, sg, NCH * 4, dec, epi, G, bx, tid);
 }
                    SEAM(hb + 4);
                }
                if (EN_SCAN && IN(hb + 5)) { PH_BEGIN();
                    scan_phase(lds, ws, half, bar, tid, lane, wave, bx);
                    SEAM(hb + 5);
                }
                if (IN(hb + 6)) { PH_BEGIN();
 for (int rp_ = 0; rp_ < REPN(0); ++rp_) {
                    pg8::Gemm g{HH, WIN + (size_t)DI * D, D, D, D, 0, 0, LH / 256, DI / 256, 1};
                    pg8::EpiStore E{S3 + (size_t)LAT0 * DI, 0, DI, 0};
                    pg8::gemm_phase(lds, g, E, G, bx, tid); if (DUP_MIX) pg8::gemm_phase(lds, g, E, G, bx, tid);
                    if (layer < 2) { SmallGemm sg{HHC, WIN + (size_t)DI * D, D, D, D, D, D, 0, 0}; SmallDense sd{S3, 0, DI, LAT0 / 64, DI / 64, 0, 0, 0}; gemm_small_dense(lds, sg, sd, 1, G, bx, tid); if (DUP_CTX) gemm_small_dense(lds, sg, sd, 1, G, bx, tid); }
 }
                    SEAM(hb + 6);
                }
                if (IN(hb + 7)) { PH_BEGIN();
 for (int rp_ = 0; rp_ < REPN(3); ++rp_) {
                    const float* gn = ka->in[I_GNW] + (size_t)jl * DI; const float* sk = ka->in[I_SKIP] + (size_t)jl * DI;
#define RO_LOAD(q_, A, B, XC, ZZ) do { const bf16_t* h2_ = ((q_) < LAT0) ? HCB : S2; \
                        _Pragma("unroll") for (int hd = 0; hd < 4; ++hd) { const size_t ho_ = htile_off(q_, hd, 8 * lane); const size_t ro_ = (size_t)(q_) * DI + hd * DH + 8 * lane; \
                            A[hd] = *(const u32x4*)(S0 + ho_); B[hd] = *(const u32x4*)(h2_ + ho_); XC[hd] = *(const u32x4*)(S1 + ro_); ZZ[hd] = *(const u32x4*)(S3 + ro_); } } while (0)
                    u32x4 ra[4], rb[4], rx[4], rz[4], na[4], nb[4], nx[4], nz[4];
#pragma unroll
                    for (int hd = 0; hd < 4; ++hd) { ra[hd] = (u32x4){0u, 0u, 0u, 0u}; rb[hd] = ra[hd]; rx[hd] = ra[hd]; rz[hd] = ra[hd]; na[hd] = ra[hd]; nb[hd] = ra[hd]; nx[hd] = ra[hd]; nz[hd] = ra[hd]; }
                    const int q_first = (layer < 2 ? 0 : LAT0) + gw;
                    if (q_first < RH) RO_LOAD(q_first, ra, rb, rx, rz);
                    for (int q = q_first; q < RH; q += NGW) {
                        if (q + NGW < RH) RO_LOAD(q + NGW, na, nb, nx, nz);
#pragma unroll
                        for (int hd = 0; hd < 4; ++hd) {
                            const int c0 = hd * DH + 8 * lane;
                            const u32x4 a = ra[hd], b = rb[hd];
                            float v[8] = {bflo(a.x) + bflo(b.x), bfhi(a.x) + bfhi(b.x), bflo(a.y) + bflo(b.y), bfhi(a.y) + bfhi(b.y), bflo(a.z) + bflo(b.z), bfhi(a.z) + bfhi(b.z), bflo(a.w) + bflo(b.w), bfhi(a.w) + bfhi(b.w)};
                            float s = 0.f;
#pragma unroll
                            for (int i = 0; i < 8; ++i) s += v[i];
                            const float mean = wave_sum(s, lane) * (1.f / DH); float s2 = 0.f;
#pragma unroll
                            for (int i = 0; i < 8; ++i) { v[i] -= mean; s2 += v[i] * v[i]; }
                            const float rstd = __builtin_amdgcn_rsqf(wave_sum(s2, lane) * (1.f / DH) + LN_EPS);
                            const u32x4 xc = rx[hd], zz = rz[hd];
                            const float xcf[8] = {bflo(xc.x), bfhi(xc.x), bflo(xc.y), bfhi(xc.y), bflo(xc.z), bfhi(xc.z), bflo(xc.w), bfhi(xc.w)};
                            const float zf[8] = {bflo(zz.x), bfhi(zz.x), bflo(zz.y), bfhi(zz.y), bflo(zz.z), bfhi(zz.z), bflo(zz.w), bfhi(zz.w)};
                            float o[8];
#pragma unroll
                            for (int i = 0; i < 8; ++i) o[i] = (v[i] * rstd * gn[c0 + i] + sk[c0 + i] * xcf[i]) * siluf(zf[i]);
                            u32x4 w; w.x = pk2(o[0], o[1]); w.y = pk2(o[2], o[3]); w.z = pk2(o[4], o[5]); w.w = pk2(o[6], o[7]);
                            *(u32x4*)(S4 + (size_t)q * DI + c0) = w;
                        }
#pragma unroll
                        for (int hd = 0; hd < 4; ++hd) { ra[hd] = na[hd]; rb[hd] = nb[hd]; rx[hd] = nx[hd]; rz[hd] = nz[hd]; }
                    }
#undef RO_LOAD
 }
                    SEAM(hb + 7);
                }
                if (IN(hb + 8)) { PH_BEGIN();
 for (int rp_ = 0; rp_ < REPN(0); ++rp_) {
                    pg8::Gemm g{S4 + (size_t)LAT0 * DI, WOUT, DI, DI, DI, 0, 0, LH / 256, D / 256, 1};
                    pg8::EpiStore E{YH, 0, D, 0};
                    pg8::gemm_phase(lds, g, E, G, bx, tid); if (DUP_MIX) pg8::gemm_phase(lds, g, E, G, bx, tid);
                    if (layer < 2) { SmallGemm sg{S4, WOUT, DI, DI, DI, DI, DI, 0, 0}; SmallDense sd{YHC, 0, D, LAT0 / 64, D / 64, 0, 0, 0}; gemm_small_dense(lds, sg, sd, 1, G, bx, tid); if (DUP_CTX) gemm_small_dense(lds, sg, sd, 1, G, bx, tid); }
 }
                    SEAM(hb + 8);
                }
            }
        } else if (EN_FOUR) {
            const bool has_ctx = layer < 3;
            if (IN(pb + 1)) { PH_BEGIN();
 for (int rp_ = 0; rp_ < REPN(2); ++rp_) {
                LAS bf16_t* tl = (LAS bf16_t*)(lds + wave * 8704);
                const int ntl = NB * 32 * 4 * 16, ntc = has_ctx ? NB * 4 * 16 : 0;
                for (int it = gw; it < ntl + ntc; it += NGW) {
                    int b, t2, tb, cb; bool isc = it >= ntl;
                    if (!isc) { b = it / 2048; t2 = (it / 64) % 32; tb = (it / 16) % 4; cb = it % 16; } else { const int u = it - ntl; b = u / 64; t2 = 0; tb = (u / 16) % 4; cb = u % 16; }
#pragma unroll
                    for (int i = 0; i < 8; ++i) { const int rr = 8 * i + (lane >> 3), ck = (lane & 7) * 8; const int t1 = 64 * tb + rr;
                        const int grow = isc ? ctx_row(b, t1) : lat_row(b, 32 * t1 + t2);
                        const u32x4 v = *(const u32x4*)(HIN + (size_t)grow * D + 64 * cb + ck);
                        LAS unsigned* d = (LAS unsigned*)(tl + rr * 66 + ck); d[0] = v.x; d[1] = v.y; d[2] = v.z; d[3] = v.w; }
                    asm volatile("s_waitcnt lgkmcnt(0)" ::: "memory");
#pragma unroll
                    for (int i = 0; i < 8; ++i) { const int ch = 8 * i + (lane >> 3), tk = (lane & 7) * 8; unsigned short e[8];
#pragma unroll
                        for (int x = 0; x < 8; ++x) e[x] = tl[(tk + x) * 66 + ch];
                        u32x4 o; o.x = e[0] | ((unsigned)e[1] << 16); o.y = e[2] | ((unsigned)e[3] << 16); o.z = e[4] | ((unsigned)e[5] << 16); o.w = e[6] | ((unsigned)e[7] << 16);
                        bf16_t* dst = isc ? HTC + ((size_t)b * D + 64 * cb + ch) * CT + 64 * tb + tk : HT + (((size_t)b * D + 64 * cb + ch) * 32 + t2) * 256 + 64 * tb + tk;
                        *(u32x4*)dst = o; }
                    asm volatile("s_waitcnt lgkmcnt(0)" ::: "memory");
                }
 }
                SEAM(pb + 1);
            }
            if (IN(pb + 2)) { PH_BEGIN();
 for (int rp_ = 0; rp_ < REPN(2); ++rp_) {
                { pg8::Gemm g{(const bf16_t*)(ws + TAB_A1), HT, 256, 256, 256, 0, (long)D * T, 2, 128, NB};
                  pg8::EpiStore E{PB, (long)512 * 32768, 32768, 0};
                  pg8::gemm_phase(lds, g, E, G, bx, tid); if (DUP_MIX) pg8::gemm_phase(lds, g, E, G, bx, tid); }
                if (has_ctx) {
                    SmallGemm sg{(const bf16_t*)(ws + TAB_ACTX), HTC, 256, 256, 256, 256, 256, 0, 0};
                    auto dec = [=](int u, long& ao, long& bo) { const int b = u / 128, mb = (u / 16) % 8, cht = u % 16; ao = (long)mb * 64 * 256; bo = ((long)b * D + cht * 64) * CT; };
                    auto epi = [=](int u, int m, int n, const f32x4& v) { const int b = u / 128, mb = (u / 16) % 8, cht = u % 16; const int mg = mb * 64 + m, ri = mg >> 8, tp = mg & 255, ch = cht * 64 + n;
                        u32x2 w; w.x = pk2(v[0], v[1]); w.y = pk2(v[2], v[3]); *(u32x2*)(WC + (size_t)ctx_row(b, tp) * DI + (ch >> 8) * 512 + ri * 256 + (ch & 255)) = w; };
                    gemm_small(lds, sg, NB * 8 * 16, dec, epi, G, bx, tid);
                }
 }
                SEAM(pb + 2);
            }
            if (IN(pb + 3)) { PH_BEGIN();
 for (int rp_ = 0; rp_ < REPN(2); ++rp_) {
                {
                    const int wid = tid >> 6, wm = wid >> 1, wn = wid & 1, fr = lane & 15, fq = lane >> 4;
                    const int lrow = tid >> 3, lk = (tid & 7) * 8;
                    const unsigned stoff = (unsigned)(lrow * SG_LD + lk) * 2u;
                    LAS unsigned char* As = lds; LAS unsigned char* Bs0 = lds + SG_TILE; LAS unsigned char* Bs1 = lds + 2 * SG_TILE;
                    const bf16_t* A2 = (const bf16_t*)(ws + TAB_A2);
                    for (int pair = bx; pair < NB * 256; pair += G) {
                        const int b = pair >> 8, t1p = pair & 255;
                        const bf16_t* bp = PB + (size_t)b * 512 * 32768 + (size_t)((lk >> 5) * 256 + t1p) * 32768 + (size_t)lrow * 32 + (lk & 31);
                        u32x4 r0 = *(const u32x4*)(bp), r1 = *(const u32x4*)(bp + 2048), r2 = *(const u32x4*)(bp + 2 * 2048), r3 = *(const u32x4*)(bp + 3 * 2048);
                        *(LAS u32x4*)(As + stoff) = *(const u32x4*)(A2 + (size_t)t1p * 4096 + lrow * 64 + lk);
                        *(LAS u32x4*)(Bs0 + stoff) = r0;
                        LDS_BARRIER();
                        bf16x8 af[2];
#pragma unroll
                        for (int ks = 0; ks < 2; ++ks) af[ks] = *(const LAS bf16x8*)(As + ((wm * 16 + fr) * SG_LD + ks * 32 + fq * 8) * 2);
#define F2_TILE(ct_, BsC, BsN, rcur, rnext) do { \
                            if ((ct_) + 4 < 16) rcur = *(const u32x4*)(bp + ((ct_) + 4) * 2048); \
                            f32x4 acc[2] = {(f32x4){0.f, 0.f, 0.f, 0.f}, (f32x4){0.f, 0.f, 0.f, 0.f}}; \
                            _Pragma("unroll") for (int ks = 0; ks < 2; ++ks) _Pragma("unroll") for (int nt = 0; nt < 2; ++nt) { \
                                const bf16x8 bf = *(const LAS bf16x8*)(BsC + ((wn * 32 + nt * 16 + fr) * SG_LD + ks * 32 + fq * 8) * 2); \
                                acc[nt] = __builtin_amdgcn_mfma_f32_16x16x32_bf16(bf, af[ks], acc[nt], 0, 0, 0); } \
                            if ((ct_) + 1 < 16) *(LAS u32x4*)(BsN + stoff) = rnext; \
                            _Pragma("unroll") for (int nt = 0; nt < 2; ++nt) { const int m = wm * 16 + fr, n = wn * 32 + nt * 16 + fq * 4, rip = m >> 5, t2p = m & 31, ch = (ct_) * 64 + n; \
                                u32x2 w2; w2.x = pk2(acc[nt][0], acc[nt][1]); w2.y = pk2(acc[nt][2], acc[nt][3]); \
                                *(u32x2*)(WC + (size_t)lat_row(b, t1p + 256 * t2p) * DI + (ch >> 8) * 512 + rip * 256 + (ch & 255)) = w2; } \
                            LDS_BARRIER(); } while (0)
#pragma unroll 1
                        for (int ct = 0; ct < 16; ct += 4) { F2_TILE(ct, Bs0, Bs1, r0, r1); F2_TILE(ct + 1, Bs1, Bs0, r1, r2); F2_TILE(ct + 2, Bs0, Bs1, r2, r3); F2_TILE(ct + 3, Bs1, Bs0, r3, r0); }
#undef F2_TILE
                    }
                }
 }
                SEAM(pb + 3);
            }
            if (IN(pb + 4)) { PH_BEGIN();
 for (int rp_ = 0; rp_ < REPN(2); ++rp_) {
                pg8::Gemm g{WC + (size_t)CR * DI, (const bf16_t*)(ws + TAB_BZ), DI, 512, 512, 512, 0, (R - CR) / 256, 1, 4};
                pg8::EpiStore E{ZF + (size_t)CR * D, 256, D, 0};
                pg8::gemm_phase(lds, g, E, G, bx, tid); if (DUP_MIX) pg8::gemm_phase(lds, g, E, G, bx, tid);
                if (has_ctx) { SmallGemm sg{WC, (const bf16_t*)(ws + TAB_BZ), DI, 512, 512, 512, 512, 0, 0}; SmallDense sd{ZF, 256, D, CR / 64, 256 / 64, 0, 512, 0}; gemm_small_dense(lds, sg, sd, 4, G, bx, tid); if (DUP_CTX) gemm_small_dense(lds, sg, sd, 4, G, bx, tid); }
 }
                SEAM(pb + 4);
            }
            if (IN(pb + 5)) { PH_BEGIN();
 for (int rp_ = 0; rp_ < REPN(2); ++rp_) {
                pg8::Gemm g{ZF + (size_t)CR * D, WOUT, D, D, D, 0, 0, (R - CR) / 256, D / 256, 1};
                pg8::EpiStore E{YB + (size_t)CR * D, 0, D, 0};
                pg8::gemm_phase(lds, g, E, G, bx, tid); if (DUP_MIX) pg8::gemm_phase(lds, g, E, G, bx, tid);
                if (has_ctx) { SmallGemm sg{ZF, WOUT, D, D, D, D, D, 0, 0}; SmallDense sd{YB, 0, D, CR / 64, D / 64, 0, 0, 0}; gemm_small_dense(lds, sg, sd, 1, G, bx, tid); if (DUP_CTX) gemm_small_dense(lds, sg, sd, 1, G, bx, tid); }
 }
                SEAM(pb + 5);
            }
        }
#pragma unroll 1
        for (int which = 0; which < 2; ++which) {
            const int pid = pb + (which == 0 ? 19 : 22);
            if (EN_NORM && IN(pid)) { PH_BEGIN();
                const float* pg = ka->in[I_PG] + ((size_t)layer * 2 + which) * D; const float* pbv = ka->in[I_PB] + ((size_t)layer * 2 + which) * D;
                const int mlayer = which == 0 ? layer : layer + 1;
                const int shoff = which == 0 ? 3 * D : 0;
                const int goff = which == 0 ? 2 * D : 5 * D;
                const bool in_f32 = (layer == 0 && which == 0), out_f32 = (layer == 3 && which == 1);
                bf16_t* xbl = (bf16_t*)ka->out; bf16_t* xb3 = S4;
#define NR_LOAD(r_, XW, YW) do { const RowInfo ri_ = row_info(r_); const size_t xi_ = ri_.is_ctx ? ((size_t)ri_.b * CT + ri_.t) * D : ((size_t)ri_.b * T + ri_.t) * D; \
                    const bf16_t* yr_ = YB + (size_t)(r_) * D; \
                    if (in_f32) { const float* xp_ = (ri_.is_ctx ? ka->in[I_CTX] : ka->in[I_X]) + xi_; _Pragma("unroll") for (int j = 0; j < 4; ++j) XW[j] = *(const u32x4*)(xp_ + 256 * j + 4 * lane); } \
                    else { const bf16_t* xp_ = ri_.is_ctx ? (const bf16_t*)CTXX + xi_ : ((layer == 3 && which == 1) ? xb3 + xi_ : xbl + xi_); \
                        _Pragma("unroll") for (int j = 0; j < 4; ++j) { const u32x2 t_ = *(const u32x2*)(xp_ + 256 * j + 4 * lane); XW[j] = (u32x4){t_.x, t_.y, 0u, 0u}; } } \
                    _Pragma("unroll") for (int j = 0; j < 4; ++j) YW[j] = *(const u32x2*)(yr_ + 256 * j + 4 * lane); } while (0)
                const int r_first = (layer < 2 ? 0 : CR) + gw;
                u32x4 xw[4], xn[4]; u32x2 yw[4], yn[4];
#pragma unroll
                for (int j = 0; j < 4; ++j) { xw[j] = (u32x4){0u, 0u, 0u, 0u}; xn[j] = xw[j]; yw[j] = (u32x2){0u, 0u}; yn[j] = yw[j]; }
                if (r_first < R) NR_LOAD(r_first, xw, yw);
                for (int r = r_first; r < R; r += NGW) {
                    if (r + NGW < R) NR_LOAD(r + NGW, xn, yn);
                    const RowInfo ri = row_info(r);
                    const int mi = ri.is_ctx ? 4 : ri.b;
                    const size_t xi = ri.is_ctx ? ((size_t)ri.b * CT + ri.t) * D : ((size_t)ri.b * T + ri.t) * D;
                    bf16_t* xout16 = ri.is_ctx ? (bf16_t*)CTXX + xi : ((layer == 3 && which == 0) ? xb3 + xi : xbl + xi);
                    const float* md = MOD + ((size_t)layer * 5 + mi) * 6 * D;
                    f32x4 v[4];
#pragma unroll
                    for (int j = 0; j < 4; ++j) { const int c = 256 * j + 4 * lane; f32x4 x; if (in_f32) x = __builtin_bit_cast(f32x4, xw[j]); else x = (f32x4){bflo(xw[j].x), bfhi(xw[j].x), bflo(xw[j].y), bfhi(xw[j].y)};
                        const f32x4 gt = *(const f32x4*)(md + goff + c);
                        const f32x4 y = (f32x4){bflo(yw[j].x), bfhi(yw[j].x), bflo(yw[j].y), bfhi(yw[j].y)}; v[j] = x * ALPHA + gt * y; }
                    ln_norm(v, lane);
#pragma unroll
                    for (int j = 0; j < 4; ++j) { const int c = 256 * j + 4 * lane; v[j] = v[j] * *(const f32x4*)(pg + c) + *(const f32x4*)(pbv + c);
                        if (out_f32) *(f32x4*)(ka->out + xi + c) = v[j]; else { u32x2 xo; xo.x = pk2(v[j][0], v[j][1]); xo.y = pk2(v[j][2], v[j][3]); *(u32x2*)(xout16 + c) = xo; } }
                    if (mlayer < 4) {
                        const float* md2 = MOD + ((size_t)mlayer * 5 + mi) * 6 * D + shoff;
                        ln_norm(v, lane);
                        bf16_t* o = HIN + (size_t)r * D;
#pragma unroll
                        for (int j = 0; j < 4; ++j) { const int c = 256 * j + 4 * lane; const f32x4 sh = *(const f32x4*)(md2 + c), sc = *(const f32x4*)(md2 + D + c);
                            const f32x4 h = v[j] * (1.0f + sc) + sh; u32x2 w; w.x = pk2(h[0], h[1]); w.y = pk2(h[2], h[3]); *(u32x2*)(o + c) = w; }
                    }
#pragma unroll
                    for (int j = 0; j < 4; ++j) { xw[j] = xn[j]; yw[j] = yn[j]; }
                }
#undef NR_LOAD
                SEAM(pid);
            }
            if (EN_MLP && which == 0) {
                if (IN(pb + 20)) { PH_BEGIN();
 for (int rp_ = 0; rp_ < REPN(1); ++rp_) {
                    pg8::Gemm g{HIN + (size_t)CR * D, W1, D, D, D, 0, 0, (R - CR) / 256, DFF / 256, 1};
                    pg8::EpiStore E{HID + (size_t)CR * DFF, 0, DFF, 1};
                    pg8::gemm_phase(lds, g, E, G, bx, tid);
#if DUP_MLP
                    pg8::gemm_phase(lds, g, E, G, bx, tid);
#endif
                    if (layer < 2) { SmallGemm sg{HIN, W1, D, D, D, D, D, 0, 0}; SmallDense sd{HID, 0, DFF, CR / 64, DFF / 64, 1, 0, 0}; gemm_small_dense(lds, sg, sd, 1, G, bx, tid); }
 }
                    SEAM(pb + 20);
                }
                if (IN(pb + 21)) { PH_BEGIN();
 for (int rp_ = 0; rp_ < REPN(1); ++rp_) {
                    pg8::Gemm g{HID + (size_t)CR * DFF, W2, DFF, DFF, DFF, 0, 0, (R - CR) / 256, D / 256, 1};
                    pg8::EpiStore E{YB + (size_t)CR * D, 0, D, 0};
                    pg8::gemm_phase(lds, g, E, G, bx, tid);
#if DUP_MLP
                    pg8::gemm_phase(lds, g, E, G, bx, tid);
#endif
                    if (layer < 2) { SmallGemm sg{HID, W2, DFF, DFF, DFF, DFF, DFF, 0, 0}; SmallDense sd{YB, 0, D, CR / 64, D / 64, 0, 0, 0}; gemm_small_dense(lds, sg, sd, 1, G, bx, tid); }
 }
                    SEAM(pb + 21);
                }
            }
        }
    }
#undef IN
#undef SEAM
}

extern "C" void kernel_launch(void* const* d_in, const int* in_sizes, int n_in, void* d_out, int out_size, void* d_ws, size_t ws_size, hipStream_t stream) {
    static int grid = 0;
    if (grid == 0) {
        if (n_in != 22 || ws_size < 512 * MiB) { fprintf(stderr, "kernel_launch: unexpected n_in %d / ws_size %zu\n", n_in, ws_size); grid = -1; return; }
        int dev = 0, cus = 0;
        if (hipGetDevice(&dev) != hipSuccess || hipDeviceGetAttribute(&cus, hipDeviceAttributeMultiprocessorCount, dev) != hipSuccess) { grid = -1; return; }
        if (hipFuncSetAttribute((const void*)fwd, hipFuncAttributeMaxDynamicSharedMemorySize, LDS_BYTES) != hipSuccess) { fprintf(stderr, "kernel_launch: hipFuncSetAttribute failed\n"); grid = -1; return; }
        int per_cu = 0;
        if (hipOccupancyMaxActiveBlocksPerMultiprocessor(&per_cu, (const void*)fwd, NTHR, LDS_BYTES) != hipSuccess || per_cu < 1) fprintf(stderr, "kernel_launch: occupancy query says %d\n", per_cu);
        (void)hipGetLastError();
        grid = cus;
        if (grid != 256) fprintf(stderr, "kernel_launch: %d CUs (built for 256)\n", grid);
    }
    if (grid < 0) return;
    (void)hipMemsetAsync((char*)d_ws + WS_CTL, 0, CTL_BYTES, stream);
    Args a{};
    for (int i = 0; i < 22; ++i) a.in[i] = (const float*)d_in[i];
    a.out = (float*)d_out; a.ws = (unsigned char*)d_ws;
#if MK_SINGLE
    { int last = 0; for (int id = 0; id < NPHASE; ++id) if (phase_valid(id)) last = id;
      a.ph_lo = 0; a.ph_hi = NPHASE; a.ph_last = last; a.li = 0;
      hipLaunchKernelGGL(fwd, dim3(grid), dim3(NTHR), LDS_BYTES, stream, a); }
#else
    { int li = 0;
      for (int id = 0; id < NPHASE; ++id) { if (!phase_valid(id)) continue;
          a.ph_lo = id; a.ph_hi = id + 1; a.ph_last = id; a.li = li++;
          hipLaunchKernelGGL(fwd, dim3(grid), dim3(NTHR), LDS_BYTES, stream, a); } }
#endif
}
```

```cpp
#include <hip/hip_runtime.h>
#include <cstdio>
#include <cstdint>

#define LAS __attribute__((address_space(3)))
typedef unsigned short bf16_t;
typedef short bf16x8 __attribute__((ext_vector_type(8)));
typedef float f32x4 __attribute__((ext_vector_type(4)));
typedef unsigned u32x4 __attribute__((ext_vector_type(4)));
typedef unsigned u32x2 __attribute__((ext_vector_type(2)));


#ifndef EN_PRO
#define EN_PRO 1
#endif
#ifndef EN_WC
#define EN_WC 1
#endif
#ifndef EN_MIX
#define EN_MIX 1
#endif
#ifndef EN_SCAN
#define EN_SCAN 1
#endif
#ifndef EN_FOUR
#define EN_FOUR 1
#endif
#ifndef EN_NORM
#define EN_NORM 1
#endif
#ifndef EN_MLP
#define EN_MLP 1
#endif
#ifndef DUP_MIX
#define DUP_MIX 0
#endif
#ifndef DUP_CTX
#define DUP_CTX 0
#endif
#ifndef DUP_BAR
#define DUP_BAR 0
#endif
#ifndef DUP_MLP
#define DUP_MLP 0
#endif
#ifndef REP_MASK
#define REP_MASK 0
#endif
#define REPN(bit) (((REP_MASK) >> (bit)) & 1 ? 2 : 1)
#ifndef SC_QPAD
#define SC_QPAD 64
#endif
#ifndef SC_ABL
#define SC_ABL 0
#endif
#ifndef SCAN_REP
#define SCAN_REP 1
#endif
#ifndef MK_SINGLE
#define MK_SINGLE 1
#endif

constexpr int D = 1024, NB = 4, T = 8192, CT = 256, DI = 2048, NH = 4, DH = 512, DFF = 4096;
constexpr int R = NB * (T + CT);
constexpr int RH = R / 2;
constexpr int LAT0 = 2 * CT;
constexpr int NCH = RH / 64;
constexpr float ALPHA = 1.6817928305074290f;
constexpr float LN_EPS = 1e-5f;
constexpr int NWAVES = 8, NTHR = 512;

constexpr size_t MiB = 1u << 20;
constexpr size_t WS_CTL = 0, CTL_BYTES = 2 * MiB;
constexpr size_t WS_MOD = 2 * MiB;
constexpr size_t WS_CTXX = 3 * MiB;
constexpr size_t WS_PRE = 7 * MiB;
constexpr size_t WS_TAB = 10 * MiB;
constexpr size_t TAB_A1 = WS_TAB;
constexpr size_t TAB_A2 = TAB_A1 + 512 * 256 * 2;
constexpr size_t TAB_BZ = TAB_A2 + 256 * 64 * 64 * 2;
constexpr size_t TAB_ACTX = TAB_BZ + 256 * 512 * 2;
constexpr size_t TAB_GATE = TAB_ACTX + 512 * 256 * 2;
static_assert(TAB_GATE + 64 * 4096 * 2 <= 15 * MiB, "tables");
constexpr size_t WS_W = 15 * MiB;
constexpr size_t W_IN = WS_W;
constexpr size_t W_Q = W_IN + 8 * MiB, W_K = W_Q + 2 * MiB, W_V = W_K + 2 * MiB;
constexpr size_t W_OUT = W_V + 2 * MiB;
constexpr size_t W_1 = W_OUT + 4 * MiB;
constexpr size_t W_2 = W_1 + 8 * MiB;
static_assert(W_2 + 8 * MiB <= 49 * MiB, "weights");
constexpr size_t WS_HIN = 49 * MiB;
constexpr size_t WS_YB = 115 * MiB;
constexpr size_t WS_BIG = 181 * MiB;
constexpr size_t SLOT = 66 * MiB;
static_assert(WS_BIG + 5 * SLOT <= 512 * MiB, "workspace");
static_assert((size_t)RH * DI * 2 == SLOT, "slot");

#define LDS_BARRIER() do { asm volatile("s_waitcnt lgkmcnt(0)" ::: "memory"); __builtin_amdgcn_s_barrier(); asm volatile("" ::: "memory"); } while (0)
__device__ __forceinline__ unsigned f2bf(float f) { unsigned u = __builtin_bit_cast(unsigned, f); return (u + 0x7fffu + ((u >> 16) & 1u)) >> 16; }
typedef __bf16 bf16x2_t __attribute__((ext_vector_type(2)));
typedef float f32x2_t __attribute__((ext_vector_type(2)));
__device__ __forceinline__ unsigned pk2(float lo, float hi) { const f32x2_t v = {lo, hi}; return __builtin_bit_cast(unsigned, __builtin_convertvector(v, bf16x2_t)); }
__device__ __forceinline__ float bf2f(unsigned short b) { return __builtin_bit_cast(float, ((unsigned)b) << 16); }
__device__ __forceinline__ float u2f(unsigned u) { return __builtin_bit_cast(float, u); }
__device__ __forceinline__ float bflo(unsigned w) { return __builtin_bit_cast(float, w << 16); }
__device__ __forceinline__ float bfhi(unsigned w) { return __builtin_bit_cast(float, w & 0xffff0000u); }
__device__ __forceinline__ float shx(float v, int mask, int lane) { return __builtin_bit_cast(float, __builtin_amdgcn_ds_bpermute((lane ^ mask) << 2, __builtin_bit_cast(int, v))); }
template <int CTRL, int RMASK> __device__ __forceinline__ float dppf(float idv, float src) { return __builtin_bit_cast(float, __builtin_amdgcn_update_dpp(__builtin_bit_cast(int, idv), __builtin_bit_cast(int, src), CTRL, RMASK, 0xF, false)); }
__device__ __forceinline__ float scan_add64(float x) {
    x += dppf<0x111, 0xF>(0.f, x); x += dppf<0x112, 0xF>(0.f, x); x += dppf<0x114, 0xF>(0.f, x); x += dppf<0x118, 0xF>(0.f, x);
    x += dppf<0x142, 0xA>(0.f, x); x += dppf<0x143, 0xC>(0.f, x); return x; }
__device__ __forceinline__ float scan_max64(float x) {
    const float ni = -__builtin_inff();
    x = fmaxf(x, dppf<0x111, 0xF>(ni, x)); x = fmaxf(x, dppf<0x112, 0xF>(ni, x)); x = fmaxf(x, dppf<0x114, 0xF>(ni, x)); x = fmaxf(x, dppf<0x118, 0xF>(ni, x));
    x = fmaxf(x, dppf<0x142, 0xA>(ni, x)); x = fmaxf(x, dppf<0x143, 0xC>(ni, x)); return x; }
__device__ __forceinline__ float shup(float v, int d, int lane) { return __builtin_bit_cast(float, __builtin_amdgcn_ds_bpermute((lane - d) << 2, __builtin_bit_cast(int, v))); }
__device__ __forceinline__ float wave_sum(float v, int lane) {
#pragma unroll
    for (int o = 1; o < 64; o <<= 1) v += shx(v, o, lane);
    return v;
}
__device__ __forceinline__ float siluf(float x) { return x * __builtin_amdgcn_rcpf(1.0f + __expf(-x)); }

struct RowInfo { int is_ctx, b, t; };
__device__ __forceinline__ RowInfo row_info(int r) {
    RowInfo ri;
    if (r < NB * CT) { ri.is_ctx = 1; ri.b = r / CT; ri.t = r % CT; }
    else { ri.is_ctx = 0; const int u = r - NB * CT; ri.b = u / T; ri.t = u % T; }
    return ri;
}
__device__ __forceinline__ int lat_row(int b, int t) { return NB * CT + b * T + t; }
__device__ __forceinline__ int ctx_row(int b, int t) { return b * CT + t; }
constexpr int CR = NB * CT;
constexpr int LH = RH - LAT0;

#define XB_TMO      128
#define XB_XCNT(j)  (256  + 64 * (j))
#define XB_XSUB(j)  (1280 + 64 * (j))
#define XB_XGEN(j)  (2304 + 64 * (j))
#define XB_TOP      3328
#define XB_TOPGEN   3392
#define XCD_BAR_WORDS 3456
#define XB_SPIN_CAP (1u << 18)

__device__ __forceinline__ unsigned xb_ld(unsigned* p)              { return __hip_atomic_load(p, __ATOMIC_RELAXED, __HIP_MEMORY_SCOPE_AGENT); }
__device__ __forceinline__ unsigned xb_add(unsigned* p, unsigned v) { return __hip_atomic_fetch_add(p, v, __ATOMIC_RELAXED, __HIP_MEMORY_SCOPE_AGENT); }
__device__ __forceinline__ unsigned xb_xcc_id() { return (unsigned)__builtin_amdgcn_s_getreg((3 << 11) | 20) & 0xFu; }
#define XB_SPIN(cond, bar) do { unsigned _sp = 0; while (cond) { __builtin_amdgcn_s_sleep(1); \
    if ((++_sp & 255u) == 0u) { if (xb_ld(&(bar)[XB_TMO])) break; if (_sp > XB_SPIN_CAP) { atomicAdd(&(bar)[XB_TMO], 1u); break; } } } } while (0)

struct XcdBarrier { unsigned* bar; unsigned x; volatile LAS unsigned* st; };

__device__ __forceinline__ XcdBarrier xcd_barrier_post(unsigned* bar, volatile LAS unsigned* st) {
    XcdBarrier b; b.bar = bar; b.x = xb_xcc_id(); b.st = st;
    if (threadIdx.x == 0) (void)xb_add(&bar[XB_XCNT(b.x)], 1u);
    return b;
}
__device__ __forceinline__ void xcd_barrier_complete(unsigned* bar, unsigned x, unsigned& nloc, unsigned& nx) {
    const unsigned G = gridDim.x * gridDim.y * gridDim.z;
    unsigned sum, cnt, mine, sp = 0u;
    for (;;) {
        sum = 0u; cnt = 0u; mine = 0u;
#pragma unroll
        for (unsigned j = 0; j < 16; ++j) { const unsigned c = xb_ld(&bar[XB_XCNT(j)]); sum += c; cnt += (c > 0u) ? 1u : 0u; mine = (j == x) ? c : mine; }
        if (sum == G) break;
        __builtin_amdgcn_s_sleep(1);
        if ((++sp & 255u) == 0u) { if (xb_ld(&bar[XB_TMO])) break; if (sp > XB_SPIN_CAP) { atomicAdd(&bar[XB_TMO], 1u); break; } }
    }
    nloc = mine > 0u ? mine : 1u; nx = cnt > 0u ? cnt : 1u;
}
__device__ __forceinline__ void xcd_barrier(const XcdBarrier& b, bool thread0) {
    asm volatile("s_waitcnt vmcnt(0)" ::: "memory");
    __syncthreads();
    if (thread0) {
        unsigned* bar = b.bar;
        __builtin_amdgcn_s_waitcnt(0);
        unsigned nloc = b.st[0], nx = b.st[1];
        if (nloc == 0u) { xcd_barrier_complete(bar, b.x, nloc, nx); b.st[0] = nloc; b.st[1] = nx; }
        const unsigned old = xb_add(&bar[XB_XSUB(b.x)], 1u);
        const unsigned gen = old / nloc;
        if (old + 1u == (gen + 1u) * nloc) {
            __builtin_amdgcn_fence(__ATOMIC_RELEASE, "agent");
            asm volatile("s_waitcnt vmcnt(0)" ::: "memory");
            const unsigned og = xb_add(&bar[XB_TOP], 1u);
            const unsigned tg = og / nx;
            if (og + 1u == (tg + 1u) * nx) xb_add(&bar[XB_TOPGEN], 1u);
            else XB_SPIN(xb_ld(&bar[XB_TOPGEN]) == tg, bar);
            __builtin_amdgcn_fence(__ATOMIC_ACQUIRE, "agent");
            xb_add(&bar[XB_XGEN(b.x)], 1u);
            asm volatile("s_waitcnt vmcnt(0)" ::: "memory");
        } else {
            XB_SPIN(xb_ld(&bar[XB_XGEN(b.x)]) == gen, bar);
            __builtin_amdgcn_fence(__ATOMIC_ACQUIRE, "agent");
            asm volatile("s_waitcnt vmcnt(0)" ::: "memory");
        }
    }
    __syncthreads();
}

__device__ __forceinline__ size_t qtile_off(int q, int h, int cc) {
    const int chunk = q >> 6, p = q & 63, pt = p >> 4, fr = p & 15, w = cc >> 6, ks = (cc >> 5) & 1, fq = (cc >> 3) & 3;
    const size_t blk = ((((size_t)chunk * 4 + h) * 8 + w) * 4 + pt) * 2 + ks;
    return blk * 512 + (size_t)(fq * 16 + fr) * 8 + (cc & 7);
}
__device__ __forceinline__ size_t ktile_off(int d, int h, int q) {
    const int chunk = q >> 6, s = q & 63, ks = s >> 5, fq = (s >> 3) & 3, w = d >> 6, dd = d & 63, mt = 2 * (dd >> 5) + ((dd >> 2) & 1), frp = 4 * ((dd >> 3) & 3) + (dd & 3);
    const size_t blk = ((((size_t)chunk * 4 + h) * 8 + w) * 4 + mt) * 2 + ks;
    return blk * 512 + (size_t)(fq * 16 + frp) * 8 + (s & 7);
}

__device__ __forceinline__ size_t vtile_off(int e, int h, int q) {
    const int chunk = q >> 6, s = q & 63, slice = e >> 5, e5 = e & 31, nt = e5 >> 4, fr = e5 & 15, ks = s >> 5, fq = (s >> 3) & 3;
    const size_t blk = ((((size_t)chunk * 4 + h) * 16 + slice) * 2 + nt) * 2 + ks;
    return blk * 512 + (size_t)(fq * 16 + fr) * 8 + (s & 7);
}
__device__ __forceinline__ size_t htile_off(int q, int h, int e) {
    return ((((size_t)(q >> 6) * 4 + h) * 16 + (e >> 5)) * 2048) + (size_t)(q & 63) * 32 + (e & 31);
}

namespace pg8 {
constexpr int BM = 256, BK = 64, HALF = 128, HTB = HALF * BK * 2, STAGE_BYTES = 8 * HTB, NXCD = 8, WGM = 8;
__device__ __forceinline__ int lds_byte(int r, int c) { const int st = (r >> 4) * 2 + (c >> 5), rr = r & 15, cc = c & 31, ob = rr * 64 + cc * 2; return st * 1024 + (ob ^ (((ob >> 9) & 1) << 5)); }
__device__ __forceinline__ void stage_rc(int b, int& R_, int& C_) { const int st = b / 1024, sb = b % 1024, swz = sb ^ (((sb >> 9) & 1) << 5); R_ = (st >> 1) * 16 + swz / 64; C_ = (st & 1) * 32 + (swz % 64) / 2; }
__device__ __forceinline__ int perm32(int rho) { const int n = rho >> 4, i = rho & 15; return 8 * (i >> 2) + 4 * n + (i & 3); }

struct Unit { int pm, pn, g; };
struct Gemm {
    const bf16_t* A; const bf16_t* Bt; int lda, ldb, K;
    long a_gs, b_gs;
    int nM, nN, nG;
};
struct Order {
    int nM, nNt, nN, nwg, G, c;
    __device__ void init(const Gemm& g, int G_, int c_) { nM = g.nM; nN = g.nN; nNt = g.nN * g.nG; nwg = nM * nNt; G = G_; c = c_; }
    __device__ bool next(int i, Unit& u) const {
        const long L = (long)i * G + c; if (L >= nwg) return false;
        int wgid = (int)L; { const int q = nwg / NXCD, r = nwg % NXCD, xcd = wgid % NXCD, off = wgid / NXCD; wgid = (xcd < r ? xcd * (q + 1) : r * (q + 1) + (xcd - r) * q) + off; }
        const int nig = WGM * nNt, gid = wgid / nig, fm = gid * WGM, gsz = (nM - fm) < WGM ? (nM - fm) : WGM;
        u.pm = fm + ((wgid % nig) % gsz); const int pnt = (wgid % nig) / gsz; u.g = pnt / nN; u.pn = pnt - u.g * nN; return true;
    }
};
__device__ __forceinline__ unsigned cvt_pk_bf16(float lo, float hi) { return pk2(lo, hi); }

struct EpiStore {
    bf16_t* O; long o_gs; int ldc; int act;
    int mode, off;
    __device__ __forceinline__ void operator()(const f32x4 (&acc)[2][2][4][2], const Unit& u, int wr, int wc, int fr, int fq) const {
        const int row0 = u.pm * BM + wr * 64 + fr; const int col0 = u.pn * BM + wc * 32 + 8 * fq; bf16_t* base = O + (long)u.g * o_gs;
#pragma unroll
        for (int ai = 0; ai < 2; ++ai)
#pragma unroll
            for (int m = 0; m < 4; ++m) { bf16_t* rowp = base + (size_t)(row0 + ai * HALF + m * 16) * ldc + col0;
#pragma unroll
                for (int bj = 0; bj < 2; ++bj) { f32x4 v0 = acc[ai][bj][m][0], v1 = acc[ai][bj][m][1];
                    if (act == 1) {
#pragma unroll
                        for (int j = 0; j < 4; ++j) { const float a = fmaxf(v0[j], 0.f), b = fmaxf(v1[j], 0.f); v0[j] = a * a; v1[j] = b * b; } }
                    u32x4 w; w.x = cvt_pk_bf16(v0[0], v0[1]); w.y = cvt_pk_bf16(v0[2], v0[3]); w.z = cvt_pk_bf16(v1[0], v1[1]); w.w = cvt_pk_bf16(v1[2], v1[3]);
                    if (mode == 0) *(u32x4*)(rowp + bj * HALF) = w;
                    else if (mode == 1) *(u32x4*)(O + qtile_off(off + row0 + ai * HALF + m * 16, u.g, col0 + bj * HALF)) = w;
                    else if (mode == 2) *(u32x4*)(O + ktile_off(row0 + ai * HALF + m * 16, u.g, off + col0 + bj * HALF)) = w;
                    else *(u32x4*)(O + vtile_off(row0 + ai * HALF + m * 16, u.g, off + col0 + bj * HALF)) = w; } }
    }
};

template <class Epi>
__device__ __forceinline__ void gemm_phase(LAS unsigned char* lds, const Gemm g, const Epi& E, int G_, int c_, int tid_in) {
    int tid_ = tid_in; asm volatile("" : "+v"(tid_));
    const int tid = tid_, wid = __builtin_amdgcn_readfirstlane(tid >> 6), lane = tid & 63, wr = wid >> 2, wc = wid & 3, fr = lane & 15, fq = lane >> 4;
    const int K = g.K, nt = K / BK;
    Order S; S.init(g, G_, c_);
    unsigned voffA[2], voffB[2];
#pragma unroll
    for (int i = 0; i < 2; ++i) { int R_, C_; stage_rc(tid * 16 + i * 8192, R_, C_); const int Rb = (R_ & ~31) + perm32(R_ & 31);
        voffA[i] = (unsigned)(R_ * g.lda + C_) * 2u; voffB[i] = (unsigned)(Rb * g.ldb + C_) * 2u; }
    const size_t kstep = (size_t)(BK * 2);
    const size_t hstepA = (size_t)HALF * g.lda * 2, hstepB = (size_t)HALF * g.ldb * 2;
    const unsigned ldsw = (unsigned)wid * 1024u;
    const int aoff = lds_byte(wr * 64 + fr, fq * 8), boff = lds_byte(wc * 32 + fr, fq * 8);
#define PG8_SA(b, h) (((b) * 2 + (h)) * HTB)
#define PG8_SB(b, h) ((4 + (b) * 2 + (h)) * HTB)
#define PG8_STAGE(bufoff, gbase, voff) do { _Pragma("unroll") for (int _i = 0; _i < 2; ++_i) \
        __builtin_amdgcn_global_load_lds((const unsigned*)((const char*)(gbase) + (voff)[_i]), (LAS unsigned*)(lds + (bufoff) + ldsw + _i * 8192), 16, 0, 0); } while (0)
#define PG8_LDA(dst, b, h) do { _Pragma("unroll") for (int m = 0; m < 4; ++m) _Pragma("unroll") for (int k = 0; k < 2; ++k) dst[m][k] = *(const LAS bf16x8*)(lds + PG8_SA(b, h) + aoff + m * 2048 + k * 1024); } while (0)
#define PG8_LDB(dst, b, h) do { _Pragma("unroll") for (int n = 0; n < 2; ++n) _Pragma("unroll") for (int k = 0; k < 2; ++k) dst[n][k] = *(const LAS bf16x8*)(lds + PG8_SB(b, h) + boff + n * 2048 + k * 1024); } while (0)
#define PG8_MMA(ai, bj, At, Bt) do { __builtin_amdgcn_s_setprio(1); _Pragma("unroll") for (int m = 0; m < 4; ++m) _Pragma("unroll") for (int n = 0; n < 2; ++n) _Pragma("unroll") for (int k = 0; k < 2; ++k) \
        acc[ai][bj][m][n] = __builtin_amdgcn_mfma_f32_16x16x32_bf16(Bt[n][k], At[m][k], acc[ai][bj][m][n], 0, 0, 0); __builtin_amdgcn_s_setprio(0); } while (0)
#define PG8_WAIT_V(n) asm volatile("s_waitcnt vmcnt(" #n ")" ::: "memory")
#define PG8_WAIT_L(n) asm volatile("s_waitcnt lgkmcnt(" #n ")" ::: "memory")
#define PG8_BAR __builtin_amdgcn_s_barrier()
#define PG8_SCHED __builtin_amdgcn_sched_barrier(0)
#define PG8_APTR(u) ((const char*)(g.A + (long)(u).g * g.a_gs) + (size_t)(u).pm * 2 * hstepA)
#define PG8_BPTR(u) ((const char*)(g.Bt + (long)(u).g * g.b_gs) + (size_t)(u).pn * 2 * hstepB)
    Unit cur, nxt; int ui = 0;
    if (!S.next(0, cur)) return;
    f32x4 acc[2][2][4][2];
#pragma unroll
    for (int a = 0; a < 2; ++a)
#pragma unroll
        for (int b = 0; b < 2; ++b)
#pragma unroll
            for (int m = 0; m < 4; ++m)
#pragma unroll
                for (int n = 0; n < 2; ++n) acc[a][b][m][n] = (f32x4){0.f, 0.f, 0.f, 0.f};
    bf16x8 At[4][2], B0[2][2], B1[2][2];
    const char* cA = PG8_APTR(cur); const char* cB = PG8_BPTR(cur);
    PG8_STAGE(PG8_SB(0, 0), cB, voffB); PG8_STAGE(PG8_SA(0, 0), cA, voffA); PG8_STAGE(PG8_SB(0, 1), cB + hstepB, voffB); PG8_STAGE(PG8_SA(0, 1), cA + hstepA, voffA);
    if (wr == 1) PG8_BAR;
    PG8_WAIT_V(4); PG8_BAR;
    PG8_STAGE(PG8_SB(1, 0), cB + kstep, voffB); PG8_STAGE(PG8_SA(1, 0), cA + kstep, voffA); PG8_STAGE(PG8_SB(1, 1), cB + hstepB + kstep, voffB);
    PG8_WAIT_V(6); PG8_BAR;
    for (;;) {
        const bool has_next = S.next(ui + 1, nxt);
        const char* nA = has_next ? PG8_APTR(nxt) : cA; const char* nB = has_next ? PG8_BPTR(nxt) : cB;
        for (int t = 0; t < nt; t += 2) {
            const bool last = (t == nt - 2);
            const char* a1 = cA + (size_t)(t + 1) * kstep;
            const char* a2 = last ? nA : cA + (size_t)(t + 2) * kstep; const char* b2 = last ? nB : cB + (size_t)(t + 2) * kstep;
            const char* a3 = a2 + kstep; const char* b3 = b2 + kstep;
            PG8_LDB(B0, 0, 0); PG8_SCHED; PG8_LDA(At, 0, 0); PG8_STAGE(PG8_SA(1, 1), a1 + hstepA, voffA);
            PG8_WAIT_L(8); PG8_BAR; PG8_WAIT_L(0); PG8_MMA(0, 0, At, B0); PG8_BAR; PG8_SCHED;
            PG8_LDB(B1, 0, 1); PG8_STAGE(PG8_SB(0, 0), b2, voffB);
            PG8_BAR; PG8_WAIT_L(0); PG8_MMA(0, 1, At, B1); PG8_BAR;
            PG8_LDA(At, 0, 1); PG8_STAGE(PG8_SA(0, 0), a2, voffA);
            PG8_BAR; PG8_WAIT_L(0); PG8_MMA(1, 0, At, B0); PG8_BAR; PG8_SCHED;
            PG8_STAGE(PG8_SB(0, 1), b2 + hstepB, voffB);
            PG8_WAIT_V(6); PG8_BAR; PG8_MMA(1, 1, At, B1); PG8_BAR;
            PG8_LDB(B0, 1, 0); PG8_SCHED; PG8_LDA(At, 1, 0); PG8_STAGE(PG8_SA(0, 1), a2 + hstepA, voffA);
            PG8_WAIT_L(8); PG8_BAR; PG8_WAIT_L(0); PG8_MMA(0, 0, At, B0); PG8_BAR; PG8_SCHED;
            PG8_LDB(B1, 1, 1); PG8_STAGE(PG8_SB(1, 0), b3, voffB);
            PG8_BAR; PG8_WAIT_L(0); PG8_MMA(0, 1, At, B1); PG8_BAR;
            PG8_LDA(At, 1, 1); PG8_STAGE(PG8_SA(1, 0), a3, voffA);
            PG8_BAR; PG8_WAIT_L(0); PG8_MMA(1, 0, At, B0); PG8_BAR; PG8_SCHED;
            PG8_STAGE(PG8_SB(1, 1), b3 + hstepB, voffB);
            PG8_WAIT_V(6); PG8_BAR; PG8_MMA(1, 1, At, B1); PG8_BAR;
        }
        E(acc, cur, wr, wc, fr, fq);
        if (!has_next) break;
#pragma unroll
        for (int a = 0; a < 2; ++a)
#pragma unroll
            for (int b = 0; b < 2; ++b)
#pragma unroll
                for (int m = 0; m < 4; ++m)
#pragma unroll
                    for (int n = 0; n < 2; ++n) acc[a][b][m][n] = (f32x4){0.f, 0.f, 0.f, 0.f};
        cur = nxt; cA = nA; cB = nB; ++ui;
    }
    PG8_WAIT_V(0);
    if (wr == 0) PG8_BAR;
    PG8_BAR;
#undef PG8_SA
#undef PG8_SB
#undef PG8_STAGE
#undef PG8_LDA
#undef PG8_LDB
#undef PG8_MMA
#undef PG8_WAIT_V
#undef PG8_WAIT_L
#undef PG8_BAR
#undef PG8_SCHED
#undef PG8_APTR
#undef PG8_BPTR
}
}

struct SmallGemm { const bf16_t* A; const bf16_t* B; int lda, ldb, K, akseg, bkseg; long aseg, bseg; int a_tiled; };
constexpr int SG_LD = 72;
constexpr int SG_TILE = 64 * SG_LD * 2;
template <class Dec, class Epi>
__device__ __forceinline__ void gemm_small(LAS unsigned char* lds, const SmallGemm g, int nunits, const Dec& dec, const Epi& epi, int G_, int c_, int tid_in) {
    int tid_ = tid_in; asm volatile("" : "+v"(tid_));
    const int tid = tid_, wid = tid >> 6, lane = tid & 63, wm = wid >> 1, wn = wid & 1, fr = lane & 15, fq = lane >> 4;
    const int lrow = tid >> 3, lk = (tid & 7) * 8;
    const int nk = g.K / 64;
    const unsigned stoff = (unsigned)(lrow * SG_LD + lk) * 2u;
#define SG_LOAD(ra_, rb_, kt_) do { const int k_ = (kt_) * 64 + lk; \
        if (g.a_tiled) ra_ = *(const u32x4*)(g.A + (((((size_t)aoff * 8 + (k_ >> 6)) * 4 + (lrow >> 4)) * 2 + ((k_ >> 5) & 1)) * 512 + (size_t)(((k_ >> 3) & 3) * 16 + (lrow & 15)) * 8)); \
        else ra_ = *(const u32x4*)(ap + (long)(k_ / g.akseg) * g.aseg + (k_ % g.akseg)); \
        rb_ = *(const u32x4*)(bp + (long)(k_ / g.bkseg) * g.bseg + (k_ % g.bkseg)); } while (0)
#define SG_STORE(ra_, rb_, bufi_) do { *(LAS u32x4*)(lds + ((bufi_) * 2 + 0) * SG_TILE + stoff) = ra_; *(LAS u32x4*)(lds + ((bufi_) * 2 + 1) * SG_TILE + stoff) = rb_; } while (0)
#define SG_COMPUTE(bufi_) do { const LAS unsigned char* As = lds + ((bufi_) * 2 + 0) * SG_TILE; const LAS unsigned char* Bs = lds + ((bufi_) * 2 + 1) * SG_TILE; \
        _Pragma("unroll") for (int ks = 0; ks < 2; ++ks) { const bf16x8 af = *(const LAS bf16x8*)(As + ((wm * 16 + fr) * SG_LD + ks * 32 + fq * 8) * 2); \
            _Pragma("unroll") for (int nt = 0; nt < 2; ++nt) { const bf16x8 bf = *(const LAS bf16x8*)(Bs + ((wn * 32 + nt * 16 + fr) * SG_LD + ks * 32 + fq * 8) * 2); \
                acc[nt] = __builtin_amdgcn_mfma_f32_16x16x32_bf16(bf, af, acc[nt], 0, 0, 0); } } } while (0)
    for (int u = c_; u < nunits; u += G_) {
        long aoff, boff; dec(u, aoff, boff);
        const bf16_t* ap = g.A + aoff + (long)lrow * g.lda; const bf16_t* bp = g.B + boff + (long)lrow * g.ldb;
        f32x4 acc[2] = {(f32x4){0.f, 0.f, 0.f, 0.f}, (f32x4){0.f, 0.f, 0.f, 0.f}};
        u32x4 ra0, rb0, ra1, rb1, ra2, rb2, ra3, rb3;
        ra0 = (u32x4){0u, 0u, 0u, 0u}; rb0 = ra0; ra1 = ra0; rb1 = ra0; ra2 = ra0; rb2 = ra0; ra3 = ra0; rb3 = ra0;
        SG_LOAD(ra0, rb0, 0); if (nk > 1) SG_LOAD(ra1, rb1, 1); if (nk > 2) SG_LOAD(ra2, rb2, 2); if (nk > 3) SG_LOAD(ra3, rb3, 3);
        SG_STORE(ra0, rb0, 0);
        LDS_BARRIER();
#define SG_TURN(kt_, bufc, rnextA, rnextB, rfreeA, rfreeB) do { if ((kt_) < nk) { \
            SG_COMPUTE(bufc); \
            if ((kt_) + 1 < nk) SG_STORE(rnextA, rnextB, (bufc) ^ 1); \
            if ((kt_) + 4 < nk) SG_LOAD(rfreeA, rfreeB, (kt_) + 4); \
            LDS_BARRIER(); } } while (0)
        for (int kt = 0; kt < nk; kt += 4) {
            SG_TURN(kt,     0, ra1, rb1, ra0, rb0);
            SG_TURN(kt + 1, 1, ra2, rb2, ra1, rb1);
            SG_TURN(kt + 2, 0, ra3, rb3, ra2, rb2);
            SG_TURN(kt + 3, 1, ra0, rb0, ra3, rb3);
        }
#undef SG_TURN
#pragma unroll
        for (int nt = 0; nt < 2; ++nt) epi(u, wm * 16 + fr, wn * 32 + nt * 16 + fq * 4, acc[nt]);
    }
#undef SG_LOAD
#undef SG_STORE
#undef SG_COMPUTE
}

struct SmallDense { bf16_t* O; long o_gs; int ldc, mt, nt, act; long a_gs, b_gs; int mode; };
__device__ __forceinline__ void gemm_small_dense(LAS unsigned char* lds, const SmallGemm g, const SmallDense d, int ngroups, int G_, int c_, int tid_in) {
    const int per = d.mt * d.nt;
    auto dec = [=](int u, long& ao, long& bo) { const int gi = u / per, r = u % per, mi = r / d.nt, ni = r % d.nt; ao = gi * d.a_gs + (long)mi * 64 * g.lda; bo = gi * d.b_gs + (long)ni * 64 * g.ldb; };
    auto epi = [=](int u, int m, int n, const f32x4& v) { const int gi = u / per, r = u % per, mi = r / d.nt, ni = r % d.nt;
        f32x4 x = v; if (d.act == 1) {
#pragma unroll
            for (int i = 0; i < 4; ++i) { const float a = fmaxf(x[i], 0.f); x[i] = a * a; } }
        u32x2 w; w.x = pk2(x[0], x[1]); w.y = pk2(x[2], x[3]);
        if (d.mode == 0) *(u32x2*)(d.O + gi * d.o_gs + (size_t)(mi * 64 + m) * d.ldc + ni * 64 + n) = w;
        else if (d.mode == 1) *(u32x2*)(d.O + qtile_off(mi * 64 + m, gi, ni * 64 + n)) = w;
        else if (d.mode == 2) *(u32x2*)(d.O + ktile_off(mi * 64 + m, gi, ni * 64 + n)) = w;
        else *(u32x2*)(d.O + vtile_off(mi * 64 + m, gi, ni * 64 + n)) = w; };
    gemm_small(lds, g, ngroups * per, dec, epi, G_, c_, tid_in);
}

struct Args { const float* in[22]; float* out; unsigned char* ws; int ph_lo, ph_hi, ph_last, li; };
enum { I_X = 0, I_C, I_CTX, I_CCTX, I_ADAW, I_ADAB, I_PG, I_PB, I_WIN, I_WCONV, I_BCONV, I_WQ, I_WK, I_WV, I_WGATE, I_BGATE, I_GNW, I_SKIP, I_WOUT, I_FWOUT, I_W1, I_W2 };

constexpr int LDS_BYTES = 147456;
constexpr int LDS_MISC = LDS_BYTES - 256;

__device__ __forceinline__ void transpose_item(const float* W, int K, int N, bf16_t* WT, float scale, LAS float* scr, int item, int lane) {
    const int nblk = N / 32, kb = item / nblk, nb = item % nblk, k0 = 64 * kb, n0 = 32 * nb;
#pragma unroll 8
    for (int i = 0; i < 32; ++i) { const int kk = 2 * i + (lane >> 5); scr[kk * 33 + (lane & 31)] = W[(size_t)(k0 + kk) * N + n0 + (lane & 31)] * scale; }
    asm volatile("s_waitcnt lgkmcnt(0)" ::: "memory");
    const int c = lane & 7;
#pragma unroll
    for (int j = 0; j < 4; ++j) { const int n = (lane >> 3) + 8 * j; const LAS float* s = scr + (8 * c) * 33 + n;
        u32x4 o; o.x = pk2(s[0 * 33], s[1 * 33]); o.y = pk2(s[2 * 33], s[3 * 33]); o.z = pk2(s[4 * 33], s[5 * 33]); o.w = pk2(s[6 * 33], s[7 * 33]);
        *(u32x4*)(WT + (size_t)(n0 + n) * K + k0 + 8 * c) = o; }
    asm volatile("s_waitcnt lgkmcnt(0)" ::: "memory");
}

__device__ __forceinline__ void ln_norm(f32x4 (&v)[4], int lane) {
    float s = 0.f;
#pragma unroll
    for (int j = 0; j < 4; ++j) s += (v[j][0] + v[j][1]) + (v[j][2] + v[j][3]);
    const float mean = wave_sum(s, lane) * (1.f / D); float s2 = 0.f;
#pragma unroll
    for (int j = 0; j < 4; ++j) { v[j] = v[j] - mean; s2 += (v[j][0] * v[j][0] + v[j][1] * v[j][1]) + (v[j][2] * v[j][2] + v[j][3] * v[j][3]); }
    const float rstd = __builtin_amdgcn_rsqf(wave_sum(s2, lane) * (1.f / D) + LN_EPS);
#pragma unroll
    for (int j = 0; j < 4; ++j) v[j] = v[j] * rstd;
}

constexpr int PL = 24;
constexpr int NPHASE = 2 + 4 * PL;
__host__ __device__ inline bool phase_valid(int id) {
    if (id < 2) return true;
    const int layer = (id - 2) / PL, k = (id - 2) % PL;
    if (layer > 3) return false;
    if (k == 0 || (k >= 19 && k <= 22)) return true;
    if (layer & 1) return k >= 2 && k <= 5;
    return k >= 1 && k <= 18;
}


#define MOD ((float*)(ws + WS_MOD))
#define CTXX ((float*)(ws + WS_CTXX))
#define PRE ((float*)(ws + WS_PRE))
#define HIN ((bf16_t*)(ws + WS_HIN))
#define YB ((bf16_t*)(ws + WS_YB))
#define WIN ((bf16_t*)(ws + W_IN))
#define WQ ((bf16_t*)(ws + W_Q))
#define WK ((bf16_t*)(ws + W_K))
#define WV ((bf16_t*)(ws + W_V))
#define WOUT ((bf16_t*)(ws + W_OUT))
#define W1 ((bf16_t*)(ws + W_1))
#define W2 ((bf16_t*)(ws + W_2))
#define GATET ((bf16_t*)(ws + TAB_GATE))
#define S0 ((bf16_t*)(ws + WS_BIG + 0 * SLOT))
#define S1 ((bf16_t*)(ws + WS_BIG + 1 * SLOT))
#define S2 ((bf16_t*)(ws + WS_BIG + 2 * SLOT))
#define S3 ((bf16_t*)(ws + WS_BIG + 3 * SLOT))
#define S4 ((bf16_t*)(ws + WS_BIG + 4 * SLOT))
#define YH (YB + ((size_t)CR + (size_t)half * LH) * D)
#define YHC (YB + (size_t)half * LAT0 * D)
#define HCB (YH + (size_t)NCH * 4 * 2 * 4096 + (size_t)NCH * 4 * 2 * 384 * 2)
#define HH (HIN + ((size_t)CR + (size_t)half * LH) * D)
#define HHC (HIN + (size_t)half * LAT0 * D)
#define HT ((bf16_t*)(ws + WS_BIG))
#define HTC (HT + (size_t)NB * D * T)
#define PB ((bf16_t*)(ws + WS_BIG + 1 * SLOT))
#define WC ((bf16_t*)(ws + WS_BIG + 3 * SLOT))
#define ZF ((bf16_t*)(ws + WS_BIG))
#define HID ((bf16_t*)(ws + WS_BIG))

constexpr int SC_PLD = 36, SC_VLD = 72;
#define SC_ROW0(j) (((j) < 4) ? (bl * CT + (dir ? 3 - (j) : (j)) * 64) : (LAT0 + bl * T + (dir ? 127 - ((j) - 4) : ((j) - 4)) * 64))
#define SC_LOADQ(dst, r0) do { _Pragma("unroll") for (int pt = 0; pt < 4; ++pt) _Pragma("unroll") for (int ks = 0; ks < 2; ++ks) \
        dst[pt][ks] = __builtin_bit_cast(bf16x8, __builtin_amdgcn_raw_buffer_load_b128(rW, loff, oQ + ((((((r0) >> 6) * 4 + hh) * 8 + w) * 4 + pt) * 2 + ks) * 1024, 0)); } while (0)
#define SC_LOADQ1(dst, r0, pt, ks) dst[pt][ks] = __builtin_bit_cast(bf16x8, __builtin_amdgcn_raw_buffer_load_b128(rW, loff, oQ + ((((((r0) >> 6) * 4 + hh) * 8 + w) * 4 + (pt)) * 2 + (ks)) * 1024, 0))
#define SC_LOADK1(dst, r0, mt, ks) dst[mt][ks] = __builtin_bit_cast(bf16x8, __builtin_amdgcn_raw_buffer_load_b128(rW, loff, oK + ((((((r0) >> 6) * 4 + hh) * 8 + w) * 4 + (mt)) * 2 + (ks)) * 1024, 0))
#define SC_LOADK(dst, r0) do { _Pragma("unroll") for (int mt = 0; mt < 4; ++mt) _Pragma("unroll") for (int ks = 0; ks < 2; ++ks) \
        dst[mt][ks] = __builtin_bit_cast(bf16x8, __builtin_amdgcn_raw_buffer_load_b128(rW, loff, oK + ((((((r0) >> 6) * 4 + hh) * 8 + w) * 4 + mt) * 2 + ks) * 1024, 0)); } while (0)
#define SC_LOADS(P, r0) do { const int ci_ = ((((r0) >> 6) * 4 + hh) * 2 + dir); \
        P##sg0 = __builtin_bit_cast(bf16x8, __builtin_amdgcn_raw_buffer_load_b128(rW, loff, oS + ci_ * 8192 + (w >> 1) * 2048, 0)); P##sg1 = __builtin_bit_cast(bf16x8, __builtin_amdgcn_raw_buffer_load_b128(rW, loff, oS + ci_ * 8192 + (w >> 1) * 2048 + 1024, 0)); \
        P##v = __builtin_bit_cast(u32x4, __builtin_amdgcn_raw_buffer_load_b128(rW, voff, oV + ((((r0) >> 6) * 4 + hh) * 16 + slice) * 4096, 0));     \
        P##wka = __builtin_bit_cast(u32x4, __builtin_amdgcn_raw_buffer_load_b128(rW, wkoff, oG + ci_ * 1536 + 1024, 0)); P##wkb = __builtin_bit_cast(u32x4, __builtin_amdgcn_raw_buffer_load_b128(rW, wkoff, oG + ci_ * 1536 + 1024 + 16, 0));         \
        P##wint = __builtin_bit_cast(float, __builtin_amdgcn_raw_buffer_load_b32(rW, gcp, oG + ci_ * 1536 + 512, 0)); P##em = __builtin_bit_cast(float, __builtin_amdgcn_raw_buffer_load_b32(rW, gcp, oG + ci_ * 1536 + 768, 0)); \
        P##dec = __builtin_bit_cast(float, __builtin_amdgcn_raw_buffer_load_b32(rW, 0, oG + ci_ * 1536 + 1280, 0)); } while (0)
#define SC_VWRITE(bufi, P) do { LAS bf16_t* vt_ = VB + (bufi) * 2 * 3072; LAS bf16_t* vw_ = vt_ + 3072; \
        if (w < 5) { const float wk_[8] = {u2f(P##wka.x), u2f(P##wka.y), u2f(P##wka.z), u2f(P##wka.w), u2f(P##wkb.x), u2f(P##wkb.y), u2f(P##wkb.z), u2f(P##wkb.w)};     \
            if (w < 4) { *(LAS u32x4*)(vt_ + tid * 8) = P##v; \
                u32x4 sv_; sv_.x = pk2(bflo(P##v.x) * wk_[0], bfhi(P##v.x) * wk_[1]); sv_.y = pk2(bflo(P##v.y) * wk_[2], bfhi(P##v.y) * wk_[3]); \
                sv_.z = pk2(bflo(P##v.z) * wk_[4], bfhi(P##v.z) * wk_[5]); sv_.w = pk2(bflo(P##v.w) * wk_[6], bfhi(P##v.w) * wk_[7]); *(LAS u32x4*)(vw_ + tid * 8) = sv_; } \
            else if (lane < 8) { u32x4 sv_; sv_.x = pk2(wk_[0], wk_[1]); sv_.y = pk2(wk_[2], wk_[3]); sv_.z = pk2(wk_[4], wk_[5]); sv_.w = pk2(wk_[6], wk_[7]); \
                *(LAS u32x4*)(vw_ + (4 + (lane >> 2)) * 512 + (lane & 3) * 16 * 8) = sv_; } } } while (0)
#define SC_STEP(J, Qc, Qn, Kc, Kn, C, N) do { \
    const int j_ = (J); const int row0 = SC_ROW0(j_); const int jn_ = j_ < 131 ? j_ + 1 : 131; const int row1 = SC_ROW0(jn_); \
    const int hsel = (j_ < 4) ? (dir ? 2 : 0) : ((j_ < 68) ? 0 : 1); \
    const int buf = j_ & 1; \
    const LAS bf16_t* VT = VB + buf * 2 * 3072; const LAS bf16_t* VW = VT + 3072; \
    LDS_BARRIER();                                                       \
    SC_LOADS(N, row1); \
      \
    if (!(abl_ & 1)) _Pragma("unroll") for (int nt = 0; nt < 3; ++nt) { \
        f32x4 d1[4]; \
        _Pragma("unroll") for (int pt = 0; pt < 4; ++pt) d1[pt] = (f32x4){0.f, 0.f, 0.f, 0.f}; \
        _Pragma("unroll") for (int ks = 0; ks < 2; ++ks) { \
            u32x4 bw; bw.x = pg8::cvt_pk_bf16(st[2 * ks][nt][0], st[2 * ks][nt][1]); bw.y = pg8::cvt_pk_bf16(st[2 * ks][nt][2], st[2 * ks][nt][3]); \
            bw.z = pg8::cvt_pk_bf16(st[2 * ks + 1][nt][0], st[2 * ks + 1][nt][1]); bw.w = pg8::cvt_pk_bf16(st[2 * ks + 1][nt][2], st[2 * ks + 1][nt][3]); \
            const bf16x8 bs = __builtin_bit_cast(bf16x8, bw); \
            _Pragma("unroll") for (int pt = 0; pt < 4; ++pt) d1[pt] = __builtin_amdgcn_mfma_f32_16x16x32_bf16(bs, Qc[pt][ks], d1[pt], 0, 0, 0); \
            SC_LOADQ1(Qn, row1, (nt * 2 + ks) >> 1, (nt * 2 + ks) & 1);     } \
        _Pragma("unroll") for (int pt = 0; pt < 4; ++pt) { \
            if (nt < 2) { u32x2 pw_; pw_.x = pg8::cvt_pk_bf16(d1[pt][0], d1[pt][1]); pw_.y = pg8::cvt_pk_bf16(d1[pt][2], d1[pt][3]); *(LAS u32x2*)(Pbh + (w * 64 + 16 * pt + fr) * 40 + 16 * nt + 4 * fq) = pw_; }     \
            else if (fq == 0) NQs[w * 64 + 16 * pt + fr] = d1[pt][0]; } } \
    SC_LOADQ1(Qn, row1, 3, 0); SC_LOADQ1(Qn, row1, 3, 1); \
    if (!(abl_ & 2)) {     \
        const int pt2 = w >> 1, nt2 = w & 1; \
        f32x4 d2 = (f32x4){0.f, 0.f, 0.f, 0.f}, d3 = (f32x4){0.f, 0.f, 0.f, 0.f}; \
        { const bf16x8 vt0 = *(const LAS bf16x8*)(VT + (nt2 * 2 + 0) * 512 + lane * 8), vt1 = *(const LAS bf16x8*)(VT + (nt2 * 2 + 1) * 512 + lane * 8); \
          d2 = __builtin_amdgcn_mfma_f32_16x16x32_bf16(vt0, C##sg0, d2, 0, 0, 0); d2 = __builtin_amdgcn_mfma_f32_16x16x32_bf16(vt1, C##sg1, d2, 0, 0, 0); } \
        *(LAS f32x4*)(O2 + (16 * pt2 + fr) * SC_PLD + 16 * nt2 + 4 * fq) = d2; \
        if (nt2 == 0) { \
            const bf16x8 vt0 = *(const LAS bf16x8*)(VT + 4 * 512 + lane * 8), vt1 = *(const LAS bf16x8*)(VT + 5 * 512 + lane * 8); \
            d3 = __builtin_amdgcn_mfma_f32_16x16x32_bf16(vt0, C##sg0, d3, 0, 0, 0); d3 = __builtin_amdgcn_mfma_f32_16x16x32_bf16(vt1, C##sg1, d3, 0, 0, 0); \
            if (fq == 0) O2[(16 * pt2 + fr) * SC_PLD + 32] = d3[0]; } } \
    LDS_BARRIER();                                                       \
      \
    u32x2 cpr_[8]; float cnq_[8]; \
    _Pragma("unroll") for (int ww = 0; ww < 8; ++ww) { cpr_[ww] = *(const LAS u32x2*)(Pbh + (ww * 64 + cp) * 40 + 4 * ceq); cnq_[ww] = NQs[ww * 64 + cp]; } \
    const f32x4 co2_ = *(const LAS f32x4*)(O2 + cp * SC_PLD + 4 * ceq); const float crs_ = O2[cp * SC_PLD + 32]; \
      \
    if (!(abl_ & 4)) _Pragma("unroll") for (int nt = 0; nt < 3; ++nt) { \
        const bf16x8 vw0 = *(const LAS bf16x8*)(VW + (nt * 2 + 0) * 512 + lane * 8), vw1 = *(const LAS bf16x8*)(VW + (nt * 2 + 1) * 512 + lane * 8); \
        _Pragma("unroll") for (int mt = 0; mt < 4; ++mt) { f32x4 a = st[mt][nt] * C##dec; \
            a = __builtin_amdgcn_mfma_f32_16x16x32_bf16(Kc[mt][0], vw0, a, 0, 0, 0); \
            a = __builtin_amdgcn_mfma_f32_16x16x32_bf16(Kc[mt][1], vw1, a, 0, 0, 0); st[mt][nt] = a; \
            if (nt < 2) SC_LOADK1(Kn, row1, (nt * 4 + mt) >> 1, (nt * 4 + mt) & 1); } } \
    if (!(abl_ & 8)) {     \
        f32x4 o1 = (f32x4){0.f, 0.f, 0.f, 0.f}; float nq = 0.f; \
        _Pragma("unroll") for (int ww = 0; ww < 8; ++ww) { o1 += (f32x4){bflo(cpr_[ww].x), bfhi(cpr_[ww].x), bflo(cpr_[ww].y), bfhi(cpr_[ww].y)}; nq += cnq_[ww]; } \
        const float den = C##wint * nq + crs_; const float scl = __builtin_amdgcn_rcpf(fmaxf(fabsf(den), C##em)); \
        const f32x4 o = (o1 * C##wint + co2_) * scl; \
        u32x2 ow; ow.x = pk2(o[0], o[1]); ow.y = pk2(o[2], o[3]); \
        __builtin_amdgcn_raw_buffer_store_b64(ow, rW, hoff, (rep_ + 1 < SCAN_REP) ? (oC + 512 * DI * 2) : ((hsel == 0 ? oH : (hsel == 1 ? oV : oC)) + (((row0 >> 6) * 4 + hh) * 16 + slice) * 4096), 0); } \
    if (!(abl_ & 16)) SC_VWRITE(buf ^ 1, N);                                     \
} while (0)

__device__ __forceinline__ void scan_phase(LAS unsigned char* lds, unsigned char* ws, int half, const XcdBarrier& bar, int tid, int lane, int wave, int bx) {
    LAS bf16_t* Pbh = (LAS bf16_t*)lds;
    LAS float* NQs = (LAS float*)(lds + 8 * 64 * 40 * 2);
    LAS float* O2 = NQs + 8 * 64; LAS bf16_t* VB = (LAS bf16_t*)(O2 + 64 * SC_PLD);
    const int xcd = bx & 7, idx = bx >> 3;
    const int scn = (xcd * 2 + (idx >> 4)) & 15, slice = idx & 15;
    const int bl = scn >> 3, hh = (scn >> 1) & 3, dir = scn & 1, e0 = slice * 32;
    const int fr = lane & 15, fq = lane >> 4, w = wave;
    const int cp = tid >> 3, ceq = tid & 7;
    const unsigned loff = (unsigned)lane * 16u;
    const unsigned voff = (unsigned)(tid & 255) * 16u;
    const unsigned hoff = (unsigned)(cp * 32 + 4 * ceq) * 2u;
    const unsigned gcp = (unsigned)cp * 4u;
    const unsigned wkoff = (w < 4) ? (unsigned)(32 * ((tid >> 6) & 1) + 8 * ((tid & 63) >> 4)) * 4u : (unsigned)(32 * ((lane >> 2) & 1) + 8 * (lane & 3)) * 4u;
    const __amdgpu_buffer_rsrc_t rW = __builtin_amdgcn_make_buffer_rsrc((void*)ws, 0, (int)(512 * MiB), 0x00020000);
    const int oYH = (int)(WS_YB + ((size_t)CR + (size_t)half * LH) * D * 2);
    const int oQ = (int)(WS_BIG + 3 * SLOT), oK = (int)(WS_BIG + 4 * SLOT), oV = (int)(WS_BIG + 2 * SLOT), oH = (int)(WS_BIG + 0 * SLOT);
    const int oS = oYH, oG = oYH + NCH * 4 * 2 * 8192, oC = oG + NCH * 4 * 2 * 1536;
    for (int i = tid; i < 4 * 1024; i += NTHR) { const int im = i >> 10, r = i & 1023, ln = (r & 511) >> 3; VB[im * 3072 + 2048 + r] = (bf16_t)(((im & 1) == 0 && (ln & 15) == 0) ? 0x3F80u : 0u); }
    __syncthreads();
    for (int rep_ = 0; rep_ < SCAN_REP; ++rep_) {
    const int abl_ = (rep_ + 1 < SCAN_REP) ? SC_ABL : 0;
    f32x4 st[4][3];
#pragma unroll
    for (int a = 0; a < 4; ++a)
#pragma unroll
        for (int b = 0; b < 3; ++b) st[a][b] = (f32x4){0.f, 0.f, 0.f, 0.f};
    bf16x8 Q0[4][2], Q1[4][2], K0[4][2], K1[4][2];
    bf16x8 Asg0, Asg1, Bsg0, Bsg1; u32x4 Av = (u32x4){0u, 0u, 0u, 0u}, Bv = Av, Awka = Av, Awkb = Av, Bwka = Av, Bwkb = Av; float Awint, Aem, Adec, Bwint, Bem, Bdec;
    { const int r0 = SC_ROW0(0); SC_LOADQ(Q0, r0); SC_LOADK(K0, r0); SC_LOADS(A, r0); SC_VWRITE(0, A); }
#pragma unroll 1
    for (int j = 0; j < 132; j += 2) {
        if (j == 68) xcd_barrier(bar, tid == 0);
        SC_STEP(j, Q0, Q1, K0, K1, A, B);
        SC_STEP(j + 1, Q1, Q0, K1, K0, B, A);
    }
    __syncthreads();
    }
}
#undef SC_ROW0
#undef SC_LOADQ
#undef SC_LOADK
#undef SC_LOADS
#undef SC_VWRITE
#undef SC_STEP

typedef const __attribute__((address_space(4))) Args KA;
__device__ __forceinline__ KA* kargs() { KA* k = (KA*)__builtin_amdgcn_kernarg_segment_ptr(); asm volatile("" : "+s"(k)); return k; }
#define PH_BEGIN() \
    KA* ka = kargs(); unsigned char* ws = ka->ws; (void)ws; \
    int wave = wave0; asm volatile("" : "+s"(wave)); \
    unsigned lz_ = 0u; asm volatile("" : "+v"(lz_)); const int lane = (int)__builtin_amdgcn_mbcnt_hi(~0u, __builtin_amdgcn_mbcnt_lo(~0u, lz_)); \
    const int tid = wave * 64 + lane; (void)tid; \
    const int gw = bx * NWAVES + wave, NGW = G * NWAVES; (void)gw; (void)NGW;

__global__ void __launch_bounds__(NTHR, 2) fwd(Args args) {
    extern __shared__ __attribute__((aligned(16))) unsigned char lds_raw[];
    LAS unsigned char* lds = (LAS unsigned char*)lds_raw;
    const int G = gridDim.x, bx = blockIdx.x;
    const int wave0 = __builtin_amdgcn_readfirstlane(threadIdx.x >> 6);
    volatile LAS unsigned* MISC = (volatile LAS unsigned*)(lds + LDS_MISC);
    if (threadIdx.x < 64) MISC[threadIdx.x] = 0u;
    __syncthreads();
    XcdBarrier bar = xcd_barrier_post((unsigned*)(args.ws + WS_CTL + 65536) + (size_t)args.li * 4096, MISC + 8);
    const int lo = args.ph_lo, hi = args.ph_hi, plast = args.ph_last;
#define IN(k) (lo <= (k) && (k) < hi)
#define SEAM(k) do { if ((k) != plast) { xcd_barrier(bar, tid == 0); if (DUP_BAR) xcd_barrier(bar, tid == 0); } } while (0)

    if (EN_PRO && IN(0)) { PH_BEGIN();
        {
            LAS float* sc = (LAS float*)lds;
            for (int i = tid; i < 5 * D; i += NTHR) { const int r = i / D, k = i % D; const float x = r < 4 ? ka->in[I_C][r * D + k] : ka->in[I_CCTX][k]; sc[i] = siluf(x); }
            __syncthreads();
            LAS float* red = (LAS float*)(lds + 32768);
            const int kp = tid >> 6, cc = tid & 63;
            for (int item = bx; item < 4 * 96; item += G) {
                const int layer = item / 96, n0 = (item % 96) * 64;
                const float* w = ka->in[I_ADAW] + (size_t)layer * D * 6 * D + n0 + cc;
                float a0 = 0.f, a1 = 0.f, a2 = 0.f, a3 = 0.f, a4 = 0.f;
                for (int k = kp * 128; k < kp * 128 + 128; ++k) { const float wv = w[(size_t)k * 6 * D]; a0 += sc[k] * wv; a1 += sc[D + k] * wv; a2 += sc[2 * D + k] * wv; a3 += sc[3 * D + k] * wv; a4 += sc[4 * D + k] * wv; }
                red[(kp * 64 + cc) * 5 + 0] = a0; red[(kp * 64 + cc) * 5 + 1] = a1; red[(kp * 64 + cc) * 5 + 2] = a2; red[(kp * 64 + cc) * 5 + 3] = a3; red[(kp * 64 + cc) * 5 + 4] = a4;
                __syncthreads();
                if (tid < 320) { const int c2 = tid % 64, r = tid / 64; float s = ka->in[I_ADAB][layer * 6 * D + n0 + c2];
                    for (int q = 0; q < 8; ++q) s += red[(q * 64 + c2) * 5 + r];
                    MOD[((size_t)layer * 5 + r) * 6 * D + n0 + c2] = s; }
                __syncthreads();
            }
        }
        {
            bf16_t* A1 = (bf16_t*)(ws + TAB_A1); bf16_t* A2 = (bf16_t*)(ws + TAB_A2); bf16_t* BZ = (bf16_t*)(ws + TAB_BZ); bf16_t* ACTX = (bf16_t*)(ws + TAB_ACTX);
            const int gt = bx * NTHR + tid, NGT = G * NTHR;
            const float s8192 = 0.011048543456039806f;
            for (int i = gt; i < 512 * 256; i += NGT) { const int m = i / 256, t1 = i % 256, ri = m / 256, t1p = m % 256; const int ph = (t1 * t1p) & 255; float sn, cs; sincospif((float)ph * (2.0f / 256.0f), &sn, &cs);
                A1[i] = (bf16_t)f2bf((ri == 0 ? cs : -sn) * s8192);
                ACTX[i] = (bf16_t)f2bf((ri == 0 ? cs : -sn) * 0.0625f); }
            for (int i = gt; i < 256 * 64 * 64; i += NGT) { const int t1p = i / 4096, m = (i / 64) % 64, k = i % 64; const int rip = m / 32, t2p = m % 32, ri = k / 32, t2 = k % 32;
                const int ph = (t2 * t1p + 256 * t2 * t2p) & 8191; float sn, cs; sincospif((float)ph * (2.0f / 8192.0f), &sn, &cs);
                const float v = (rip == ri) ? cs : (rip == 0 ? sn : -sn); A2[i] = (bf16_t)f2bf(v); }
            for (int i = gt; i < 256 * 512; i += NGT) { const int cp = i / 512, k = i % 512, ri = k / 256, c = k % 256; const int ph = (c * cp) & 255; float sn, cs; sincospif((float)ph * (2.0f / 256.0f), &sn, &cs);
                BZ[i] = (bf16_t)f2bf((ri == 0 ? cs : sn) * 0.0625f); }
        }
        SEAM(0);
    }
    if (EN_PRO && IN(1)) { PH_BEGIN();
        for (int r = gw; r < R; r += NGW) {
            const RowInfo ri = row_info(r);
            const float* xr = ri.is_ctx ? ka->in[I_CTX] + ((size_t)ri.b * CT + ri.t) * D : ka->in[I_X] + ((size_t)ri.b * T + ri.t) * D;
            const float* md = MOD + ((size_t)0 * 5 + (ri.is_ctx ? 4 : ri.b)) * 6 * D;
            f32x4 v[4];
#pragma unroll
            for (int j = 0; j < 4; ++j) v[j] = *(const f32x4*)(xr + 256 * j + 4 * lane);
            ln_norm(v, lane);
            bf16_t* o = HIN + (size_t)r * D;
#pragma unroll
            for (int j = 0; j < 4; ++j) { const f32x4 sh = *(const f32x4*)(md + 256 * j + 4 * lane), sc = *(const f32x4*)(md + D + 256 * j + 4 * lane);
                const f32x4 h = v[j] * (1.0f + sc) + sh; u32x2 w; w.x = pk2(h[0], h[1]); w.y = pk2(h[2], h[3]); *(u32x2*)(o + 256 * j + 4 * lane) = w; }
        }
        SEAM(1);
    }

    for (int layer = 0; layer < 4; ++layer) {
        const int pb = 2 + layer * PL;
        if (hi <= pb || lo >= pb + PL) continue;
        const int jl = layer >> 1;
        const bool is_m = (layer & 1) == 0;
        if (EN_WC && IN(pb + 0)) { PH_BEGIN();
 for (int rp_ = 0; rp_ < REPN(5); ++rp_) {
            LAS float* scr = (LAS float*)(lds + wave * 16384);
            const int i_in = (D / 64) * (2 * DI / 32), i_h = (DH / 64) * (DH / 32), i_out = (DI / 64) * (D / 32), i_f = (D / 64) * (D / 32), i_1 = (D / 64) * (DFF / 32), i_2 = (DFF / 64) * (D / 32);
            const int n_mix = is_m ? (i_in + 12 * i_h + i_out) : i_f;
            const int nitems = n_mix + i_1 + i_2;
            for (int it = gw; it < nitems; it += NGW) {
                int r = it;
                if (r >= n_mix) { r -= n_mix;
                    if (r < i_1) transpose_item(ka->in[I_W1] + (size_t)layer * D * DFF, D, DFF, W1, 1.f, scr, r, lane);
                    else transpose_item(ka->in[I_W2] + (size_t)layer * DFF * D, DFF, D, W2, 1.f, scr, r - i_1, lane);
                    continue; }
                if (!is_m) { transpose_item(ka->in[I_FWOUT] + (size_t)jl * D * D, D, D, WOUT, 1.f, scr, r, lane); continue; }
                if (r < i_in) { transpose_item(ka->in[I_WIN] + (size_t)jl * D * 2 * DI, D, 2 * DI, WIN, 1.f, scr, r, lane); continue; } r -= i_in;
                if (r < 12 * i_h) { const int which = r / (4 * i_h), hh = (r / i_h) % 4, rr = r % i_h;
                    const float* src = ka->in[which == 0 ? I_WQ : (which == 1 ? I_WK : I_WV)] + ((size_t)jl * NH + hh) * DH * DH;
                    bf16_t* dst = (which == 0 ? WQ : (which == 1 ? WK : WV)) + (size_t)hh * DH * DH;
                    transpose_item(src, DH, DH, dst, which == 1 ? 0.044194173824159216f : 1.f, scr, rr, lane); continue; } r -= 12 * i_h;
                transpose_item(ka->in[I_WOUT] + (size_t)jl * DI * D, DI, D, WOUT, 1.f, scr, r, lane);
            }
            if (is_m) {
                const float* wg = ka->in[I_WGATE] + (size_t)jl * 3 * DI * 16;
                const int n = lane & 15, eq = lane >> 4;
                for (int k2 = gw; k2 < DI; k2 += NGW) {
                    const int hh = k2 / DH, d = k2 % DH;
                    const float* q = ka->in[I_WQ] + (((size_t)jl * NH + hh) * DH + d) * DH + eq * 128; const float* kx = ka->in[I_WK] + (((size_t)jl * NH + hh) * DH + d) * DH + eq * 128;
                    const float* vx = ka->in[I_WV] + (((size_t)jl * NH + hh) * DH + d) * DH + eq * 128;
                    const float* g0 = wg + ((size_t)0 * DI + hh * DH + eq * 128) * 16 + n; const float* g1 = wg + ((size_t)1 * DI + hh * DH + eq * 128) * 16 + n; const float* g2 = wg + ((size_t)2 * DI + hh * DH + eq * 128) * 16 + n;
                    float s0 = 0.f, s1 = 0.f, s2 = 0.f;
#pragma unroll 8
                    for (int e = 0; e < 128; ++e) { s0 += q[e] * g0[e * 16]; s1 += kx[e] * g1[e * 16]; s2 += vx[e] * g2[e * 16]; }
                    float sa = s0 + 0.044194173824159216f * s1;
                    sa += shx(sa, 16, lane); sa += shx(sa, 32, lane); s2 += shx(s2, 16, lane); s2 += shx(s2, 32, lane);
                    if (lane < 16) { GATET[(size_t)n * 4096 + k2] = (bf16_t)f2bf(sa); GATET[(size_t)n * 4096 + DI + k2] = (bf16_t)f2bf(s2); }
                    else if (lane < 64) { GATET[(size_t)(16 + (lane - 16)) * 4096 + k2] = (bf16_t)0; GATET[(size_t)(16 + (lane - 16)) * 4096 + DI + k2] = (bf16_t)0; }
                }
            }
 }
            SEAM(pb + 0);
        }

        if (EN_MIX && is_m) {
            for (int half = 0; half < 2; ++half) {
                const int hb = pb + 1 + 9 * half;
                if (hi <= hb || lo >= hb + 9) continue;
                if (IN(hb + 0)) { PH_BEGIN();
 for (int rp_ = 0; rp_ < REPN(0); ++rp_) {
                    pg8::Gemm g{HH, WIN, D, D, D, 0, 0, LH / 256, DI / 256, 1};
                    pg8::EpiStore E{S0 + (size_t)LAT0 * DI, 0, DI, 0};
                    pg8::gemm_phase(lds, g, E, G, bx, tid); if (DUP_MIX) pg8::gemm_phase(lds, g, E, G, bx, tid);
                    { SmallGemm sg{HHC, WIN, D, D, D, D, D, 0, 0}; SmallDense sd{S0, 0, DI, LAT0 / 64, DI / 64, 0, 0, 0}; gemm_small_dense(lds, sg, sd, 1, G, bx, tid); if (DUP_CTX) gemm_small_dense(lds, sg, sd, 1, G, bx, tid); }
 }
                    SEAM(hb + 0);
                }
                if (IN(hb + 1)) { PH_BEGIN();
 for (int rp_ = 0; rp_ < REPN(3); ++rp_) {
                    const float* wc = ka->in[I_WCONV] + (size_t)jl * 9 * DI; const float* bc = ka->in[I_BCONV] + (size_t)jl * DI;
                    const int gt = bx * NTHR + tid, NGT = G * NTHR;
                    for (int i = gt; i < 2 * 128 * 2 * (DI / 8); i += NGT) {
                        const int cg = i & 255, rest = i >> 8, hr = rest & 1, r = (rest >> 1) & 127, bl = rest >> 8, c0 = cg * 8, gc0 = 32 * hr;
                        float wv[9][8], bv[8];
#pragma unroll
                        for (int tp = 0; tp < 9; ++tp) { const f32x4 a0 = *(const f32x4*)(wc + (size_t)tp * DI + c0), a1 = *(const f32x4*)(wc + (size_t)tp * DI + c0 + 4);
                            wv[tp][0] = a0[0]; wv[tp][1] = a0[1]; wv[tp][2] = a0[2]; wv[tp][3] = a0[3]; wv[tp][4] = a1[0]; wv[tp][5] = a1[1]; wv[tp][6] = a1[2]; wv[tp][7] = a1[3]; }
                        { const f32x4 a0 = *(const f32x4*)(bc + c0), a1 = *(const f32x4*)(bc + c0 + 4); bv[0] = a0[0]; bv[1] = a0[1]; bv[2] = a0[2]; bv[3] = a0[3]; bv[4] = a1[0]; bv[5] = a1[1]; bv[6] = a1[2]; bv[7] = a1[3]; }
                        const bf16_t* xb = S0 + (size_t)(LAT0 + bl * T + r * 64) * DI + c0;
                        bf16_t* ob = S1 + (size_t)(LAT0 + bl * T + r * 64) * DI + c0;
                        const bool rok[3] = {r > 0, true, r < 127};
                        float win[3][3][8];
#define CV_LOADCOL(slot, col) do { _Pragma("unroll") for (int di = 0; di < 3; ++di) { u32x4 xv = (u32x4){0u, 0u, 0u, 0u}; \
                                if (rok[di] && (col) >= 0 && (col) < 64) xv = *(const u32x4*)(xb + (ptrdiff_t)((di - 1) * 64 + (col)) * DI); \
                                win[slot][di][0] = bflo(xv.x); win[slot][di][1] = bfhi(xv.x); win[slot][di][2] = bflo(xv.y); win[slot][di][3] = bfhi(xv.y); \
                                win[slot][di][4] = bflo(xv.z); win[slot][di][5] = bfhi(xv.z); win[slot][di][6] = bflo(xv.w); win[slot][di][7] = bfhi(xv.w); } } while (0)
#define CV_STEP(sl, sm, sr) do { CV_LOADCOL(sr, gc + 1); \
                                if (gc < gc0 + 32) { float acc[8]; \
                                    _Pragma("unroll") for (int e = 0; e < 8; ++e) { float s = bv[e]; \
                                        _Pragma("unroll") for (int di = 0; di < 3; ++di) s += win[sl][di][e] * wv[di * 3 + 0][e] + win[sm][di][e] * wv[di * 3 + 1][e] + win[sr][di][e] * wv[di * 3 + 2][e]; \
                                        acc[e] = siluf(s); } \
                                    u32x4 o; o.x = pk2(acc[0], acc[1]); o.y = pk2(acc[2], acc[3]); o.z = pk2(acc[4], acc[5]); o.w = pk2(acc[6], acc[7]); \
                                    *(u32x4*)(ob + (size_t)gc * DI) = o; } \
                                ++gc; } while (0)
                        int gc = gc0;
                        CV_LOADCOL(0, gc0 - 1); CV_LOADCOL(1, gc0);
#pragma unroll 1
                        for (int g3 = 0; g3 < 11; ++g3) { CV_STEP(0, 1, 2); CV_STEP(1, 2, 0); CV_STEP(2, 0, 1); }
#undef CV_LOADCOL
#undef CV_STEP
                    }
                    for (int i = gt; i < LAT0 * (DI / 8); i += NGT) {
                        const int q = i / (DI / 8), c0 = (i % (DI / 8)) * 8, t = q % CT;
                        float acc[8];
#pragma unroll
                        for (int e = 0; e < 8; ++e) acc[e] = bc[c0 + e];
#pragma unroll
                        for (int dj = 0; dj < 3; ++dj) { const int tt = t + dj - 1; if (tt < 0 || tt >= CT) continue;
                            const u32x4 xv = *(const u32x4*)(S0 + (size_t)(q + dj - 1) * DI + c0); const float* w = wc + (size_t)(3 + dj) * DI + c0;
                            acc[0] += bflo(xv.x) * w[0]; acc[1] += bfhi(xv.x) * w[1]; acc[2] += bflo(xv.y) * w[2]; acc[3] += bfhi(xv.y) * w[3];
                            acc[4] += bflo(xv.z) * w[4]; acc[5] += bfhi(xv.z) * w[5]; acc[6] += bflo(xv.w) * w[6]; acc[7] += bfhi(xv.w) * w[7]; }
                        u32x4 o; o.x = pk2(siluf(acc[0]), siluf(acc[1])); o.y = pk2(siluf(acc[2]), siluf(acc[3])); o.z = pk2(siluf(acc[4]), siluf(acc[5])); o.w = pk2(siluf(acc[6]), siluf(acc[7]));
                        *(u32x4*)(S1 + (size_t)q * DI + c0) = o;
                    }
 }
                    SEAM(hb + 1);
                }
                if (IN(hb + 2)) { PH_BEGIN();
 for (int rp_ = 0; rp_ < REPN(0); ++rp_) {
                    { pg8::Gemm g{WV, S0 + (size_t)LAT0 * DI, DH, DI, DH, (long)DH * DH, DH, DH / 256, LH / 256, NH};
                      pg8::EpiStore E{S2, 0, 0, 0, 3, LAT0};
                      pg8::gemm_phase(lds, g, E, G, bx, tid); if (DUP_MIX) pg8::gemm_phase(lds, g, E, G, bx, tid); }
                    { SmallGemm sg{WV, S0, DH, DI, DH, DH, DH, 0, 0}; SmallDense sd{S2, 0, 0, DH / 64, LAT0 / 64, 0, (long)DH * DH, DH, 3}; gemm_small_dense(lds, sg, sd, NH, G, bx, tid); if (DUP_CTX) gemm_small_dense(lds, sg, sd, NH, G, bx, tid); }
                    { SmallGemm sg{S1, GATET, DI, 4096, 4096, DI, 4096, (long)(S0 - S1), 0};
                      const float* bg = ka->in[I_BGATE] + (size_t)jl * 16;
                      auto dec = [=](int u, long& ao, long& bo) { ao = (long)u * 64 * DI; bo = 0; };
                      auto epi = [=](int u, int m, int n, const f32x4& v) { if (n < 16) { float* p = PRE + ((size_t)u * 64 + m) * 16 + n; const f32x4 b4 = *(const f32x4*)(bg + n); *(f32x4*)p = v + b4; } };
                      gemm_small(lds, sg, NCH, dec, epi, G, bx, tid); }
 }
                    SEAM(hb + 2);
                }
                if (IN(hb + 3)) { PH_BEGIN();
 for (int rp_ = 0; rp_ < REPN(0); ++rp_) {
                    { pg8::Gemm g{S1 + (size_t)LAT0 * DI, WQ, DI, DH, DH, DH, (long)DH * DH, LH / 256, DH / 256, NH}; pg8::EpiStore E{S3, DH, DI, 0, 1, LAT0}; pg8::gemm_phase(lds, g, E, G, bx, tid); if (DUP_MIX) pg8::gemm_phase(lds, g, E, G, bx, tid); }
                    { SmallGemm sg{S1, WQ, DI, DH, DH, DH, DH, 0, 0}; SmallDense sd{S3, DH, DI, LAT0 / 64, DH / 64, 0, DH, (long)DH * DH, 1}; gemm_small_dense(lds, sg, sd, NH, G, bx, tid); if (DUP_CTX) gemm_small_dense(lds, sg, sd, NH, G, bx, tid); }
                    { pg8::Gemm g{S1 + (size_t)LAT0 * DI, WK, DI, DH, DH, DH, (long)DH * DH, LH / 256, DH / 256, NH}; pg8::EpiStore E{S0 + (size_t)LAT0 * DI, DH, DI, 0}; pg8::gemm_phase(lds, g, E, G, bx, tid); if (DUP_MIX) pg8::gemm_phase(lds, g, E, G, bx, tid); }
                    { SmallGemm sg{S1, WK, DI, DH, DH, DH, DH, 0, 0}; SmallDense sd{S0, DH, DI, LAT0 / 64, DH / 64, 0, DH, (long)DH * DH}; gemm_small_dense(lds, sg, sd, NH, G, bx, tid); if (DUP_CTX) gemm_small_dense(lds, sg, sd, NH, G, bx, tid); }
                    { pg8::Gemm g{WK, S1 + (size_t)LAT0 * DI, DH, DI, DH, (long)DH * DH, DH, DH / 256, LH / 256, NH}; pg8::EpiStore E{S4, (long)DH * RH, RH, 0, 2, LAT0}; pg8::gemm_phase(lds, g, E, G, bx, tid); if (DUP_MIX) pg8::gemm_phase(lds, g, E, G, bx, tid); }
                    { SmallGemm sg{WK, S1, DH, DI, DH, DH, DH, 0, 0}; SmallDense sd{S4, (long)DH * RH, RH, DH / 64, LAT0 / 64, 0, (long)DH * DH, DH, 2}; gemm_small_dense(lds, sg, sd, NH, G, bx, tid); if (DUP_CTX) gemm_small_dense(lds, sg, sd, NH, G, bx, tid); }
                    if (bx < 16) {
                        const int sc = bx, bl = sc >> 3, hh = (sc >> 1) & 3, dir = sc & 1;
                        LAS float* bcs = (LAS float*)lds;
                        LAS float* vss = bcs + 132 * 64;
                        LAS float* bl_ = vss + 132 * 64;
                        LAS float* vm_ = bl_ + 132;
                        LAS float* mi_ = vm_ + 132;
                        const int u = lane, p = dir ? 63 - u : u;
#pragma unroll
                        for (int i = 0; i < 17; ++i) { const int j = wave + 8 * i;
                            if (j < 132) { int row0; if (j < 4) { const int c = dir ? 3 - j : j; row0 = bl * CT + c * 64; } else { const int c = dir ? 127 - (j - 4) : (j - 4); row0 = LAT0 + bl * T + c * 64; }
                                const float* pr = PRE + (size_t)(row0 + p) * 16 + 8 * dir + hh; bcs[j * 64 + p] = pr[4]; vss[j * 64 + p] = pr[0]; } }
                        asm volatile("s_waitcnt vmcnt(0) lgkmcnt(0)" ::: "memory");
#pragma unroll 1
                        for (int i = 0; i < 17; ++i) { const int j = wave + 8 * i;
                            if (j < 132) { const float f = bcs[j * 64 + p], lia = vss[j * 64 + p]; float x = fminf(f, 0.f) - log1pf(__expf(-fabsf(f)));
                                x = scan_add64(x);
                                const float v = lia - x; float pm = v;
                                pm = scan_max64(pm);
                                bcs[j * 64 + p] = x; vss[j * 64 + p] = v; if (u == 63) { bl_[j] = x; vm_[j] = pm; } } }
                        __syncthreads();
                        if (wave == 0) {
                            const float ni = -__builtin_inff();
                            float ea[3], eb[3];
#pragma unroll
                            for (int t = 0; t < 3; ++t) { const int j = 3 * lane + t; const bool ok = j < 132; const float blj = bl_[ok ? j : 0], vmj = vm_[ok ? j : 0]; ea[t] = ok ? blj : 0.f; eb[t] = ok ? blj + vmj : ni; }
                            float A = ea[0] + ea[1], B = fmaxf(eb[0] + ea[1], eb[1]); B = fmaxf(B + ea[2], eb[2]); A += ea[2];
#define G12_STEP(CTRL, RM) do { const float pa_ = dppf<CTRL, RM>(0.f, A), pb_ = dppf<CTRL, RM>(ni, B); B = fmaxf(pb_ + A, B); A += pa_; } while (0)
                            G12_STEP(0x111, 0xF); G12_STEP(0x112, 0xF); G12_STEP(0x114, 0xF); G12_STEP(0x118, 0xF); G12_STEP(0x142, 0xA); G12_STEP(0x143, 0xC);
#undef G12_STEP
                            float EA = shup(A, 1, lane), EB = shup(B, 1, lane); if (lane == 0) { EA = 0.f; EB = ni; }
                            float m = fmaxf(EA, EB);
#pragma unroll
                            for (int t = 0; t < 3; ++t) { const int j = 3 * lane + t; if (j < 132) { mi_[j] = m; m = fmaxf(m + ea[t], eb[t]); } }
                        }
                        __syncthreads();
                        float* GPw = (float*)(YH + (size_t)NCH * 4 * 2 * 4096);
#pragma unroll 1
                        for (int i = 0; i < 17; ++i) { const int j = wave + 8 * i;
                            if (j < 132) { int row0; if (j < 4) { const int c = dir ? 3 - j : j; row0 = bl * CT + c * 64; } else { const int c = dir ? 127 - (j - 4) : (j - 4); row0 = LAT0 + bl * T + c * 64; }
                                const float bc = bcs[j * 64 + p], v = vss[j * 64 + p]; float pm = v;
                                pm = scan_max64(pm);
                                const float m_in = mi_[j], btot = bl_[j], m_new = btot + fmaxf(m_in, vm_[j]);
                                const float uu = -fmaxf(m_in, pm);
                                float* gp = GPw + ((size_t)((row0 >> 6) * 4 + hh) * 2 + dir) * 384;
                                gp[p] = uu; gp[64 + p] = v; gp[128 + p] = __expf(m_in + uu); gp[192 + p] = __expf(uu - bc); gp[256 + p] = __expf(btot - m_new + v);
                                if (u == 0) gp[320] = __expf(btot + m_in - m_new); } }
                    }
 }
                    SEAM(hb + 3);
                }
                if (IN(hb + 4)) { PH_BEGIN();
 for (int rp_ = 0; rp_ < REPN(4); ++rp_) {
                    SmallGemm sg{S3, S0, DI, DI, DH, DH, DH, 0, 0, 1};
                    bf16_t* SGw = YH; const float* GPr = (const float*)(YH + (size_t)NCH * 4 * 2 * 4096);
                    auto dec = [=](int u, long& ao, long& bo) { const int ch = u >> 2, hh = u & 3; ao = u; bo = (long)ch * 64 * DI + hh * DH; };
                    auto epi = [=](int u, int m, int n, const f32x4& v) {
#pragma unroll
                        for (int dir = 0; dir < 2; ++dir) { const float* gp = GPr + ((size_t)u * 2 + dir) * 384; const float up = gp[m]; const f32x4 vs = *(const f32x4*)(gp + 64 + n); float o[4];
#pragma unroll
                            for (int i = 0; i < 4; ++i) { const int s = n + i; const bool ok = dir ? (s >= m) : (s <= m); const float gte = ok ? __expf(up + vs[i]) : 0.f; o[i] = v[i] * gte; }
                            u32x2 w; w.x = pk2(o[0], o[1]); w.y = pk2(o[2], o[3]);
                            *(u32x2*)(SGw + ((size_t)u * 2 + dir) * 4096 + ((m >> 4) * 2 + (n >> 5)) * 512 + (((n >> 3) & 3) * 16 + (m & 15)) * 8 + (n & 7)) = w; } };
                    gemm_small(lds, sg, NCH * 4, dec, epi, G, bx, tid);
 }
                    SEAM(hb + 4);
                }
                if (EN_SCAN && IN(hb + 5)) { PH_BEGIN();
                    scan_phase(lds, ws, half, bar, tid, lane, wave, bx);
                    SEAM(hb + 5);
                }
                if (IN(hb + 6)) { PH_BEGIN();
 for (int rp_ = 0; rp_ < REPN(0); ++rp_) {
                    pg8::Gemm g{HH, WIN + (size_t)DI * D, D, D, D, 0, 0, LH / 256, DI / 256, 1};
                    pg8::EpiStore E{S3 + (size_t)LAT0 * DI, 0, DI, 0};
                    pg8::gemm_phase(lds, g, E, G, bx, tid); if (DUP_MIX) pg8::gemm_phase(lds, g, E, G, bx, tid);
                    if (layer < 2) { SmallGemm sg{HHC, WIN + (size_t)DI * D, D, D, D, D, D, 0, 0}; SmallDense sd{S3, 0, DI, LAT0 / 64, DI / 64, 0, 0, 0}; gemm_small_dense(lds, sg, sd, 1, G, bx, tid); if (DUP_CTX) gemm_small_dense(lds, sg, sd, 1, G, bx, tid); }
 }
                    SEAM(hb + 6);
                }
                if (IN(hb + 7)) { PH_BEGIN();
 for (int rp_ = 0; rp_ < REPN(3); ++rp_) {
                    const float* gn = ka->in[I_GNW] + (size_t)jl * DI; const float* sk = ka->in[I_SKIP] + (size_t)jl * DI;
#define RO_LOAD(q_, A, B, XC, ZZ) do { const bf16_t* h2_ = ((q_) < LAT0) ? HCB : S2; \
                        _Pragma("unroll") for (int hd = 0; hd < 4; ++hd) { const size_t ho_ = htile_off(q_, hd, 8 * lane); const size_t ro_ = (size_t)(q_) * DI + hd * DH + 8 * lane; \
                            A[hd] = *(const u32x4*)(S0 + ho_); B[hd] = *(const u32x4*)(h2_ + ho_); XC[hd] = *(const u32x4*)(S1 + ro_); ZZ[hd] = *(const u32x4*)(S3 + ro_); } } while (0)
                    u32x4 ra[4], rb[4], rx[4], rz[4], na[4], nb[4], nx[4], nz[4];
#pragma unroll
                    for (int hd = 0; hd < 4; ++hd) { ra[hd] = (u32x4){0u, 0u, 0u, 0u}; rb[hd] = ra[hd]; rx[hd] = ra[hd]; rz[hd] = ra[hd]; na[hd] = ra[hd]; nb[hd] = ra[hd]; nx[hd] = ra[hd]; nz[hd] = ra[hd]; }
                    const int q_first = (layer < 2 ? 0 : LAT0) + gw;
                    if (q_first < RH) RO_LOAD(q_first, ra, rb, rx, rz);
                    for (int q = q_first; q < RH; q += NGW) {
                        if (q + NGW < RH) RO_LOAD(q + NGW, na, nb, nx, nz);
#pragma unroll
                        for (int hd = 0; hd < 4; ++hd) {
                            const int c0 = hd * DH + 8 * lane;
                            const u32x4 a = ra[hd], b = rb[hd];
                            float v[8] = {bflo(a.x) + bflo(b.x), bfhi(a.x) + bfhi(b.x), bflo(a.y) + bflo(b.y), bfhi(a.y) + bfhi(b.y), bflo(a.z) + bflo(b.z), bfhi(a.z) + bfhi(b.z), bflo(a.w) + bflo(b.w), bfhi(a.w) + bfhi(b.w)};
                            float s = 0.f;
#pragma unroll
                            for (int i = 0; i < 8; ++i) s += v[i];
                            const float mean = wave_sum(s, lane) * (1.f / DH); float s2 = 0.f;
#pragma unroll
                            for (int i = 0; i < 8; ++i) { v[i] -= mean; s2 += v[i] * v[i]; }
                            const float rstd = __builtin_amdgcn_rsqf(wave_sum(s2, lane) * (1.f / DH) + LN_EPS);
                            const u32x4 xc = rx[hd], zz = rz[hd];
                            const float xcf[8] = {bflo(xc.x), bfhi(xc.x), bflo(xc.y), bfhi(xc.y), bflo(xc.z), bfhi(xc.z), bflo(xc.w), bfhi(xc.w)};
                            const float zf[8] = {bflo(zz.x), bfhi(zz.x), bflo(zz.y), bfhi(zz.y), bflo(zz.z), bfhi(zz.z), bflo(zz.w), bfhi(zz.w)};
                            float o[8];
#pragma unroll
                            for (int i = 0; i < 8; ++i) o[i] = (v[i] * rstd * gn[c0 + i] + sk[c0 + i] * xcf[i]) * siluf(zf[i]);
                            u32x4 w; w.x = pk2(o[0], o[1]); w.y = pk2(o[2], o[3]); w.z = pk2(o[4], o[5]); w.w = pk2(o[6], o[7]);
                            *(u32x4*)(S4 + (size_t)q * DI + c0) = w;
                        }
#pragma unroll
                        for (int hd = 0; hd < 4; ++hd) { ra[hd] = na[hd]; rb[hd] = nb[hd]; rx[hd] = nx[hd]; rz[hd] = nz[hd]; }
                    }
#undef RO_LOAD
 }
                    SEAM(hb + 7);
                }
                if (IN(hb + 8)) { PH_BEGIN();
 for (int rp_ = 0; rp_ < REPN(0); ++rp_) {
                    pg8::Gemm g{S4 + (size_t)LAT0 * DI, WOUT, DI, DI, DI, 0, 0, LH / 256, D / 256, 1};
                    pg8::EpiStore E{YH, 0, D, 0};
                    pg8::gemm_phase(lds, g, E, G, bx, tid); if (DUP_MIX) pg8::gemm_phase(lds, g, E, G, bx, tid);
                    if (layer < 2) { SmallGemm sg{S4, WOUT, DI, DI, DI, DI, DI, 0, 0}; SmallDense sd{YHC, 0, D, LAT0 / 64, D / 64, 0, 0, 0}; gemm_small_dense(lds, sg, sd, 1, G, bx, tid); if (DUP_CTX) gemm_small_dense(lds, sg, sd, 1, G, bx, tid); }
 }
                    SEAM(hb + 8);
                }
            }
        } else if (EN_FOUR) {
            const bool has_ctx = layer < 3;
            if (IN(pb + 2)) { PH_BEGIN();
 for (int rp_ = 0; rp_ < REPN(2); ++rp_) {
                { pg8::Gemm g{(const bf16_t*)(ws + TAB_A1), HT, 256, 256, 256, 0, (long)D * T, 2, 128, NB};
                  pg8::EpiStore E{PB, (long)512 * 32768, 32768, 0};
                  pg8::gemm_phase(lds, g, E, G, bx, tid); if (DUP_MIX) pg8::gemm_phase(lds, g, E, G, bx, tid); }
                if (has_ctx) {
                    SmallGemm sg{(const bf16_t*)(ws + TAB_ACTX), HTC, 256, 256, 256, 256, 256, 0, 0};
                    auto dec = [=](int u, long& ao, long& bo) { const int b = u / 128, mb = (u / 16) % 8, cht = u % 16; ao = (long)mb * 64 * 256; bo = ((long)b * D + cht * 64) * CT; };
                    auto epi = [=](int u, int m, int n, const f32x4& v) { const int b = u / 128, mb = (u / 16) % 8, cht = u % 16; const int mg = mb * 64 + m, ri = mg >> 8, tp = mg & 255, ch = cht * 64 + n;
                        u32x2 w; w.x = pk2(v[0], v[1]); w.y = pk2(v[2], v[3]); *(u32x2*)(WC + (size_t)ctx_row(b, tp) * DI + (ch >> 8) * 512 + ri * 256 + (ch & 255)) = w; };
                    gemm_small(lds, sg, NB * 8 * 16, dec, epi, G, bx, tid);
                }
 }
                SEAM(pb + 2);
            }
            if (IN(pb + 3)) { PH_BEGIN();
 for (int rp_ = 0; rp_ < REPN(2); ++rp_) {
                {
                    const int wid = tid >> 6, wm = wid >> 1, wn = wid & 1, fr = lane & 15, fq = lane >> 4;
                    const int lrow = tid >> 3, lk = (tid & 7) * 8;
                    const unsigned stoff = (unsigned)(lrow * SG_LD + lk) * 2u;
                    LAS unsigned char* As = lds; LAS unsigned char* Bs0 = lds + SG_TILE; LAS unsigned char* Bs1 = lds + 2 * SG_TILE;
                    const bf16_t* A2 = (const bf16_t*)(ws + TAB_A2);
                    for (int pair = bx; pair < NB * 256; pair += G) {
                        const int b = pair >> 8, t1p = pair & 255;
                        const bf16_t* bp = PB + (size_t)b * 512 * 32768 + (size_t)((lk >> 5) * 256 + t1p) * 32768 + (size_t)lrow * 32 + (lk & 31);
                        u32x4 r0 = *(const u32x4*)(bp), r1 = *(const u32x4*)(bp + 2048), r2 = *(const u32x4*)(bp + 2 * 2048), r3 = *(const u32x4*)(bp + 3 * 2048);
                        *(LAS u32x4*)(As + stoff) = *(const u32x4*)(A2 + (size_t)t1p * 4096 + lrow * 64 + lk);
                        *(LAS u32x4*)(Bs0 + stoff) = r0;
                        LDS_BARRIER();
                        bf16x8 af[2];
#pragma unroll
                        for (int ks = 0; ks < 2; ++ks) af[ks] = *(const LAS bf16x8*)(As + ((wm * 16 + fr) * SG_LD + ks * 32 + fq * 8) * 2);
#define F2_TILE(ct_, BsC, BsN, rcur, rnext) do { \
                            if ((ct_) + 4 < 16) rcur = *(const u32x4*)(bp + ((ct_) + 4) * 2048); \
                            f32x4 acc[2] = {(f32x4){0.f, 0.f, 0.f, 0.f}, (f32x4){0.f, 0.f, 0.f, 0.f}}; \
                            _Pragma("unroll") for (int ks = 0; ks < 2; ++ks) _Pragma("unroll") for (int nt = 0; nt < 2; ++nt) { \
                                const bf16x8 bf = *(const LAS bf16x8*)(BsC + ((wn * 32 + nt * 16 + fr) * SG_LD + ks * 32 + fq * 8) * 2); \
                                acc[nt] = __builtin_amdgcn_mfma_f32_16x16x32_bf16(bf, af[ks], acc[nt], 0, 0, 0); } \
                            if ((ct_) + 1 < 16) *(LAS u32x4*)(BsN + stoff) = rnext; \
                            _Pragma("unroll") for (int nt = 0; nt < 2; ++nt) { const int m = wm * 16 + fr, n = wn * 32 + nt * 16 + fq * 4, rip = m >> 5, t2p = m & 31, ch = (ct_) * 64 + n; \
                                u32x2 w2; w2.x = pk2(acc[nt][0], acc[nt][1]); w2.y = pk2(acc[nt][2], acc[nt][3]); \
                                *(u32x2*)(WC + (size_t)lat_row(b, t1p + 256 * t2p) * DI + (ch >> 8) * 512 + rip * 256 + (ch & 255)) = w2; } \
                            LDS_BARRIER(); } while (0)
#pragma unroll 1
                        for (int ct = 0; ct < 16; ct += 4) { F2_TILE(ct, Bs0, Bs1, r0, r1); F2_TILE(ct + 1, Bs1, Bs0, r1, r2); F2_TILE(ct + 2, Bs0, Bs1, r2, r3); F2_TILE(ct + 3, Bs1, Bs0, r3, r0); }
#undef F2_TILE
                    }
                }
 }
                SEAM(pb + 3);
            }
            if (IN(pb + 4)) { PH_BEGIN();
 for (int rp_ = 0; rp_ < REPN(2); ++rp_) {
                pg8::Gemm g{WC + (size_t)CR * DI, (const bf16_t*)(ws + TAB_BZ), DI, 512, 512, 512, 0, (R - CR) / 256, 1, 4};
                pg8::EpiStore E{ZF + (size_t)CR * D, 256, D, 0};
                pg8::gemm_phase(lds, g, E, G, bx, tid); if (DUP_MIX) pg8::gemm_phase(lds, g, E, G, bx, tid);
                if (has_ctx) { SmallGemm sg{WC, (const bf16_t*)(ws + TAB_BZ), DI, 512, 512, 512, 512, 0, 0}; SmallDense sd{ZF, 256, D, CR / 64, 256 / 64, 0, 512, 0}; gemm_small_dense(lds, sg, sd, 4, G, bx, tid); if (DUP_CTX) gemm_small_dense(lds, sg, sd, 4, G, bx, tid); }
 }
                SEAM(pb + 4);
            }
            if (IN(pb + 5)) { PH_BEGIN();
 for (int rp_ = 0; rp_ < REPN(2); ++rp_) {
                pg8::Gemm g{ZF + (size_t)CR * D, WOUT, D, D, D, 0, 0, (R - CR) / 256, D / 256, 1};
                pg8::EpiStore E{YB + (size_t)CR * D, 0, D, 0};
                pg8::gemm_phase(lds, g, E, G, bx, tid); if (DUP_MIX) pg8::gemm_phase(lds, g, E, G, bx, tid);
                if (has_ctx) { SmallGemm sg{ZF, WOUT, D, D, D, D, D, 0, 0}; SmallDense sd{YB, 0, D, CR / 64, D / 64, 0, 0, 0}; gemm_small_dense(lds, sg, sd, 1, G, bx, tid); if (DUP_CTX) gemm_small_dense(lds, sg, sd, 1, G, bx, tid); }
 }
                SEAM(pb + 5);
            }
        }
#pragma unroll 1
        for (int which = 0; which < 2; ++which) {
            const int pid = pb + (which == 0 ? 19 : 22);
            if (EN_NORM && IN(pid)) { PH_BEGIN();
                const float* pg = ka->in[I_PG] + ((size_t)layer * 2 + which) * D; const float* pbv = ka->in[I_PB] + ((size_t)layer * 2 + which) * D;
                const int mlayer = which == 0 ? layer : layer + 1;
                const int shoff = which == 0 ? 3 * D : 0;
                const int goff = which == 0 ? 2 * D : 5 * D;
                const bool in_f32 = (layer == 0 && which == 0), out_f32 = (layer == 3 && which == 1);
                bf16_t* xbl = (bf16_t*)ka->out; bf16_t* xb3 = S4;
#define NR_LOAD(r_, XW, YW) do { const RowInfo ri_ = row_info(r_); const size_t xi_ = ri_.is_ctx ? ((size_t)ri_.b * CT + ri_.t) * D : ((size_t)ri_.b * T + ri_.t) * D; \
                    const bf16_t* yr_ = YB + (size_t)(r_) * D; \
                    if (in_f32) { const float* xp_ = (ri_.is_ctx ? ka->in[I_CTX] : ka->in[I_X]) + xi_; _Pragma("unroll") for (int j = 0; j < 4; ++j) XW[j] = *(const u32x4*)(xp_ + 256 * j + 4 * lane); } \
                    else { const bf16_t* xp_ = ri_.is_ctx ? (const bf16_t*)CTXX + xi_ : ((layer == 3 && which == 1) ? xb3 + xi_ : xbl + xi_); \
                        _Pragma("unroll") for (int j = 0; j < 4; ++j) { const u32x2 t_ = *(const u32x2*)(xp_ + 256 * j + 4 * lane); XW[j] = (u32x4){t_.x, t_.y, 0u, 0u}; } } \
                    _Pragma("unroll") for (int j = 0; j < 4; ++j) YW[j] = *(const u32x2*)(yr_ + 256 * j + 4 * lane); } while (0)
                if (which == 1 && (layer & 1) == 0) {
                    constexpr int TLD = 1026;
                    LAS bf16_t* TL = (LAS bf16_t*)lds;
                    const float* md2b = MOD + ((size_t)mlayer * 5) * 6 * D + shoff;
#define NT_ROW(r_, i_) do { const RowInfo ri = row_info(r_); const int mi = ri.is_ctx ? 4 : ri.b; \
                        const size_t xi = ri.is_ctx ? ((size_t)ri.b * CT + ri.t) * D : ((size_t)ri.b * T + ri.t) * D; \
                        bf16_t* xout16 = ri.is_ctx ? (bf16_t*)CTXX + xi : xbl + xi; \
                        const float* md = MOD + ((size_t)layer * 5 + mi) * 6 * D; f32x4 v[4]; \
                        _Pragma("unroll") for (int j = 0; j < 4; ++j) { const int c = 256 * j + 4 * lane; const f32x4 x = (f32x4){bflo(xw[j].x), bfhi(xw[j].x), bflo(xw[j].y), bfhi(xw[j].y)}; \
                            const f32x4 gt = *(const f32x4*)(md + goff + c); const f32x4 y = (f32x4){bflo(yw[j].x), bfhi(yw[j].x), bflo(yw[j].y), bfhi(yw[j].y)}; v[j] = x * ALPHA + gt * y; } \
                        ln_norm(v, lane); \
                        _Pragma("unroll") for (int j = 0; j < 4; ++j) { const int c = 256 * j + 4 * lane; v[j] = v[j] * *(const f32x4*)(pg + c) + *(const f32x4*)(pbv + c); \
                            u32x2 xo; xo.x = pk2(v[j][0], v[j][1]); xo.y = pk2(v[j][2], v[j][3]); *(u32x2*)(xout16 + c) = xo; } \
                        ln_norm(v, lane); \
                        const float* md2 = md2b + (size_t)mi * 6 * D; \
                        _Pragma("unroll") for (int j = 0; j < 4; ++j) { const int c = 256 * j + 4 * lane; const f32x4 sh = *(const f32x4*)(md2 + c), sc = *(const f32x4*)(md2 + D + c); \
                            const f32x4 h = v[j] * (1.0f + sc) + sh; LAS unsigned* d_ = (LAS unsigned*)(TL + (i_) * TLD + c); d_[0] = pk2(h[0], h[1]); d_[1] = pk2(h[2], h[3]); } } while (0)
                    u32x4 xw[4], xn[4]; u32x2 yw[4], yn[4];
#pragma unroll
                    for (int j = 0; j < 4; ++j) { xw[j] = (u32x4){0u, 0u, 0u, 0u}; xn[j] = xw[j]; yw[j] = (u32x2){0u, 0u}; yn[j] = yw[j]; }
                    for (int item = bx; item < NB * 32 * 4; item += G) {
                        const int b = item >> 7, t2 = (item >> 2) & 31, tb = item & 3;
                        const int rbase = lat_row(b, 32 * (64 * tb + wave * 8) + t2);
                        NR_LOAD(rbase, xw, yw);
#pragma unroll 1
                        for (int j8 = 0; j8 < 8; ++j8) {
                            if (j8 < 7) NR_LOAD(rbase + 32 * (j8 + 1), xn, yn);
                            NT_ROW(rbase + 32 * j8, wave * 8 + j8);
#pragma unroll
                            for (int j = 0; j < 4; ++j) { xw[j] = xn[j]; yw[j] = yn[j]; }
                        }
                        LDS_BARRIER();
#pragma unroll 4
                        for (int k = 0; k < 16; ++k) { const int idx = k * NTHR + tid, g8 = idx & 7, ch = idx >> 3; const LAS bf16_t* s = TL + (8 * g8) * TLD + ch;
                            u32x4 o; o.x = (unsigned)s[0] | ((unsigned)s[TLD] << 16); o.y = (unsigned)s[2 * TLD] | ((unsigned)s[3 * TLD] << 16); o.z = (unsigned)s[4 * TLD] | ((unsigned)s[5 * TLD] << 16); o.w = (unsigned)s[6 * TLD] | ((unsigned)s[7 * TLD] << 16);
                            *(u32x4*)(HT + (((size_t)b * D + ch) * 32 + t2) * 256 + 64 * tb + 8 * g8) = o; }
                        LDS_BARRIER();
                    }
                    if (layer < 2) {
                        for (int item = bx; item < NB * (CT / 8); item += G) {
                            const int b = item / (CT / 8), t8 = item % (CT / 8);
                            const int r = ctx_row(b, 8 * t8 + wave);
                            NR_LOAD(r, xw, yw);
                            NT_ROW(r, wave);
                            LDS_BARRIER();
#pragma unroll
                            for (int k = 0; k < 2; ++k) { const int ch = k * NTHR + tid; const LAS bf16_t* s = TL + ch;
                                u32x4 o; o.x = (unsigned)s[0] | ((unsigned)s[TLD] << 16); o.y = (unsigned)s[2 * TLD] | ((unsigned)s[3 * TLD] << 16); o.z = (unsigned)s[4 * TLD] | ((unsigned)s[5 * TLD] << 16); o.w = (unsigned)s[6 * TLD] | ((unsigned)s[7 * TLD] << 16);
                                *(u32x4*)(HTC + ((size_t)b * D + ch) * CT + 8 * t8) = o; }
                            LDS_BARRIER();
                        }
                    }
#undef NT_ROW
                } else {
                const int r_first = (layer < 2 ? 0 : CR) + gw;
                u32x4 xw[4], xn[4]; u32x2 yw[4], yn[4];
#pragma unroll
                for (int j = 0; j < 4; ++j) { xw[j] = (u32x4){0u, 0u, 0u, 0u}; xn[j] = xw[j]; yw[j] = (u32x2){0u, 0u}; yn[j] = yw[j]; }
                if (r_first < R) NR_LOAD(r_first, xw, yw);
                for (int r = r_first; r < R; r += NGW) {
                    if (r + NGW < R) NR_LOAD(r + NGW, xn, yn);
                    const RowInfo ri = row_info(r);
                    const int mi = ri.is_ctx ? 4 : ri.b;
                    const size_t xi = ri.is_ctx ? ((size_t)ri.b * CT + ri.t) * D : ((size_t)ri.b * T + ri.t) * D;
                    bf16_t* xout16 = ri.is_ctx ? (bf16_t*)CTXX + xi : ((layer == 3 && which == 0) ? xb3 + xi : xbl + xi);
                    const float* md = MOD + ((size_t)layer * 5 + mi) * 6 * D;
                    f32x4 v[4];
#pragma unroll
                    for (int j = 0; j < 4; ++j) { const int c = 256 * j + 4 * lane; f32x4 x; if (in_f32) x = __builtin_bit_cast(f32x4, xw[j]); else x = (f32x4){bflo(xw[j].x), bfhi(xw[j].x), bflo(xw[j].y), bfhi(xw[j].y)};
                        const f32x4 gt = *(const f32x4*)(md + goff + c);
                        const f32x4 y = (f32x4){bflo(yw[j].x), bfhi(yw[j].x), bflo(yw[j].y), bfhi(yw[j].y)}; v[j] = x * ALPHA + gt * y; }
                    ln_norm(v, lane);
#pragma unroll
                    for (int j = 0; j < 4; ++j) { const int c = 256 * j + 4 * lane; v[j] = v[j] * *(const f32x4*)(pg + c) + *(const f32x4*)(pbv + c);
                        if (out_f32) *(f32x4*)(ka->out + xi + c) = v[j]; else { u32x2 xo; xo.x = pk2(v[j][0], v[j][1]); xo.y = pk2(v[j][2], v[j][3]); *(u32x2*)(xout16 + c) = xo; } }
                    if (mlayer < 4) {
                        const float* md2 = MOD + ((size_t)mlayer * 5 + mi) * 6 * D + shoff;
                        ln_norm(v, lane);
                        bf16_t* o = HIN + (size_t)r * D;
#pragma unroll
                        for (int j = 0; j < 4; ++j) { const int c = 256 * j + 4 * lane; const f32x4 sh = *(const f32x4*)(md2 + c), sc = *(const f32x4*)(md2 + D + c);
                            const f32x4 h = v[j] * (1.0f + sc) + sh; u32x2 w; w.x = pk2(h[0], h[1]); w.y = pk2(h[2], h[3]); *(u32x2*)(o + c) = w; }
                    }
#pragma unroll
                    for (int j = 0; j < 4; ++j) { xw[j] = xn[j]; yw[j] = yn[j]; }
                }
                }
#undef NR_LOAD
                SEAM(pid);
            }
            if (EN_MLP && which == 0) {
                if (IN(pb + 20)) { PH_BEGIN();
 for (int rp_ = 0; rp_ < REPN(1); ++rp_) {
                    pg8::Gemm g{HIN + (size_t)CR * D, W1, D, D, D, 0, 0, (R - CR) / 256, DFF / 256, 1};
                    pg8::EpiStore E{HID + (size_t)CR * DFF, 0, DFF, 1};
                    pg8::gemm_phase(lds, g, E, G, bx, tid);
#if DUP_MLP
                    pg8::gemm_phase(lds, g, E, G, bx, tid);
#endif
                    if (layer < 2) { SmallGemm sg{HIN, W1, D, D, D, D, D, 0, 0}; SmallDense sd{HID, 0, DFF, CR / 64, DFF / 64, 1, 0, 0}; gemm_small_dense(lds, sg, sd, 1, G, bx, tid); }
 }
                    SEAM(pb + 20);
                }
                if (IN(pb + 21)) { PH_BEGIN();
 for (int rp_ = 0; rp_ < REPN(1); ++rp_) {
                    pg8::Gemm g{HID + (size_t)CR * DFF, W2, DFF, DFF, DFF, 0, 0, (R - CR) / 256, D / 256, 1};
                    pg8::EpiStore E{YB + (size_t)CR * D, 0, D, 0};
                    pg8::gemm_phase(lds, g, E, G, bx, tid);
#if DUP_MLP
                    pg8::gemm_phase(lds, g, E, G, bx, tid);
#endif
                    if (layer < 2) { SmallGemm sg{HID, W2, DFF, DFF, DFF, DFF, DFF, 0, 0}; SmallDense sd{YB, 0, D, CR / 64, D / 64, 0, 0, 0}; gemm_small_dense(lds, sg, sd, 1, G, bx, tid); }
 }
                    SEAM(pb + 21);
                }
            }
        }
    }
#undef IN
#undef SEAM
}

extern "C" void kernel_launch(void* const* d_in, const int* in_sizes, int n_in, void* d_out, int out_size, void* d_ws, size_t ws_size, hipStream_t stream) {
    static int grid = 0;
    if (grid == 0) {
        if (n_in != 22 || ws_size < 512 * MiB) { fprintf(stderr, "kernel_launch: unexpected n_in %d / ws_size %zu\n", n_in, ws_size); grid = -1; return; }
        int dev = 0, cus = 0;
        if (hipGetDevice(&dev) != hipSuccess || hipDeviceGetAttribute(&cus, hipDeviceAttributeMultiprocessorCount, dev) != hipSuccess) { grid = -1; return; }
        if (hipFuncSetAttribute((const void*)fwd, hipFuncAttributeMaxDynamicSharedMemorySize, LDS_BYTES) != hipSuccess) { fprintf(stderr, "kernel_launch: hipFuncSetAttribute failed\n"); grid = -1; return; }
        int per_cu = 0;
        if (hipOccupancyMaxActiveBlocksPerMultiprocessor(&per_cu, (const void*)fwd, NTHR, LDS_BYTES) != hipSuccess || per_cu < 1) fprintf(stderr, "kernel_launch: occupancy query says %d\n", per_cu);
        (void)hipGetLastError();
        grid = cus;
        if (grid != 256) fprintf(stderr, "kernel_launch: %d CUs (built for 256)\n", grid);
    }
    if (grid < 0) return;
    (void)hipMemsetAsync((char*)d_ws + WS_CTL, 0, CTL_BYTES, stream);
    Args a{};
    for (int i = 0; i < 22; ++i) a.in[i] = (const float*)d_in[i];
    a.out = (float*)d_out; a.ws = (unsigned char*)d_ws;
#if MK_SINGLE
    { int last = 0; for (int id = 0; id < NPHASE; ++id) if (phase_valid(id)) last = id;
      a.ph_lo = 0; a.ph_hi = NPHASE; a.ph_last = last; a.li = 0;
      hipLaunchKernelGGL(fwd, dim3(grid), dim3(NTHR), LDS_BYTES, stream, a); }
#else
    { int li = 0;
      for (int id = 0; id < NPHASE; ++id) { if (!phase_valid(id)) continue;
          a.ph_lo = id; a.ph_hi = id + 1; a.ph_last = id; a.li = li++;
          hipLaunchKernelGGL(fwd, dim3(grid), dim3(NTHR), LDS_BYTES, stream, a); } }
#endif
}
```

```cpp
#include <hip/hip_runtime.h>
#include <cstdio>
#include <cstdint>

#define LAS __attribute__((address_space(3)))
typedef unsigned short bf16_t;
typedef short bf16x8 __attribute__((ext_vector_type(8)));
typedef float f32x4 __attribute__((ext_vector_type(4)));
typedef unsigned u32x4 __attribute__((ext_vector_type(4)));
typedef unsigned u32x2 __attribute__((ext_vector_type(2)));


#ifndef EN_PRO
#define EN_PRO 1
#endif
#ifndef EN_WC
#define EN_WC 1
#endif
#ifndef EN_MIX
#define EN_MIX 1
#endif
#ifndef EN_SCAN
#define EN_SCAN 1
#endif
#ifndef EN_FOUR
#define EN_FOUR 1
#endif
#ifndef EN_NORM
#define EN_NORM 1
#endif
#ifndef EN_MLP
#define EN_MLP 1
#endif
#ifndef DUP_MIX
#define DUP_MIX 0
#endif
#ifndef DUP_CTX
#define DUP_CTX 0
#endif
#ifndef DUP_BAR
#define DUP_BAR 0
#endif
#ifndef DUP_MLP
#define DUP_MLP 0
#endif
#ifndef REP_MASK
#define REP_MASK 0
#endif
#define REPN(bit) (((REP_MASK) >> (bit)) & 1 ? 2 : 1)
#ifndef SC_QPAD
#define SC_QPAD 64
#endif
#ifndef SC_ABL
#define SC_ABL 0
#endif
#ifndef SCAN_REP
#define SCAN_REP 1
#endif
#ifndef MK_SINGLE
#define MK_SINGLE 1
#endif

constexpr int D = 1024, NB = 4, T = 8192, CT = 256, DI = 2048, NH = 4, DH = 512, DFF = 4096;
constexpr int R = NB * (T + CT);
constexpr int RH = R / 2;
constexpr int LAT0 = 2 * CT;
constexpr int NCH = RH / 64;
constexpr float ALPHA = 1.6817928305074290f;
constexpr float LN_EPS = 1e-5f;
constexpr int NWAVES = 8, NTHR = 512;

constexpr size_t MiB = 1u << 20;
constexpr size_t WS_CTL = 0, CTL_BYTES = 2 * MiB;
constexpr size_t WS_MOD = 2 * MiB;
constexpr size_t WS_CTXX = 3 * MiB;
constexpr size_t WS_PRE = 7 * MiB;
constexpr size_t WS_TAB = 10 * MiB;
constexpr size_t TAB_A1 = WS_TAB;
constexpr size_t TAB_A2 = TAB_A1 + 512 * 256 * 2;
constexpr size_t TAB_BZ = TAB_A2 + 256 * 64 * 64 * 2;
constexpr size_t TAB_ACTX = TAB_BZ + 256 * 512 * 2;
constexpr size_t TAB_GATE = TAB_ACTX + 512 * 256 * 2;
static_assert(TAB_GATE + 64 * 4096 * 2 <= 15 * MiB, "tables");
constexpr size_t WS_W = 15 * MiB;
constexpr size_t W_IN = WS_W;
constexpr size_t W_Q = W_IN + 8 * MiB, W_K = W_Q + 2 * MiB, W_V = W_K + 2 * MiB;
constexpr size_t W_OUT = W_V + 2 * MiB;
constexpr size_t W_1 = W_OUT + 4 * MiB;
constexpr size_t W_2 = W_1 + 8 * MiB;
static_assert(W_2 + 8 * MiB <= 49 * MiB, "weights");
constexpr size_t WS_HIN = 49 * MiB;
constexpr size_t WS_YB = 115 * MiB;
constexpr size_t WS_BIG = 181 * MiB;
constexpr size_t SLOT = 66 * MiB;
static_assert(WS_BIG + 5 * SLOT <= 512 * MiB, "workspace");
static_assert((size_t)RH * DI * 2 == SLOT, "slot");

#define LDS_BARRIER() do { asm volatile("s_waitcnt lgkmcnt(0)" ::: "memory"); __builtin_amdgcn_s_barrier(); asm volatile("" ::: "memory"); } while (0)
__device__ __forceinline__ unsigned f2bf(float f) { unsigned u = __builtin_bit_cast(unsigned, f); return (u + 0x7fffu + ((u >> 16) & 1u)) >> 16; }
typedef __bf16 bf16x2_t __attribute__((ext_vector_type(2)));
typedef float f32x2_t __attribute__((ext_vector_type(2)));
__device__ __forceinline__ unsigned pk2(float lo, float hi) { const f32x2_t v = {lo, hi}; return __builtin_bit_cast(unsigned, __builtin_convertvector(v, bf16x2_t)); }
__device__ __forceinline__ float bf2f(unsigned short b) { return __builtin_bit_cast(float, ((unsigned)b) << 16); }
__device__ __forceinline__ float u2f(unsigned u) { return __builtin_bit_cast(float, u); }
__device__ __forceinline__ float bflo(unsigned w) { return __builtin_bit_cast(float, w << 16); }
__device__ __forceinline__ float bfhi(unsigned w) { return __builtin_bit_cast(float, w & 0xffff0000u); }
__device__ __forceinline__ float shx(float v, int mask, int lane) { return __builtin_bit_cast(float, __builtin_amdgcn_ds_bpermute((lane ^ mask) << 2, __builtin_bit_cast(int, v))); }
template <int CTRL, int RMASK> __device__ __forceinline__ float dppf(float idv, float src) { return __builtin_bit_cast(float, __builtin_amdgcn_update_dpp(__builtin_bit_cast(int, idv), __builtin_bit_cast(int, src), CTRL, RMASK, 0xF, false)); }
__device__ __forceinline__ float scan_add64(float x) {
    x += dppf<0x111, 0xF>(0.f, x); x += dppf<0x112, 0xF>(0.f, x); x += dppf<0x114, 0xF>(0.f, x); x += dppf<0x118, 0xF>(0.f, x);
    x += dppf<0x142, 0xA>(0.f, x); x += dppf<0x143, 0xC>(0.f, x); return x; }
__device__ __forceinline__ float scan_max64(float x) {
    const float ni = -__builtin_inff();
    x = fmaxf(x, dppf<0x111, 0xF>(ni, x)); x = fmaxf(x, dppf<0x112, 0xF>(ni, x)); x = fmaxf(x, dppf<0x114, 0xF>(ni, x)); x = fmaxf(x, dppf<0x118, 0xF>(ni, x));
    x = fmaxf(x, dppf<0x142, 0xA>(ni, x)); x = fmaxf(x, dppf<0x143, 0xC>(ni, x)); return x; }
__device__ __forceinline__ float shup(float v, int d, int lane) { return __builtin_bit_cast(float, __builtin_amdgcn_ds_bpermute((lane - d) << 2, __builtin_bit_cast(int, v))); }
__device__ __forceinline__ float wave_sum(float v, int lane) {
#pragma unroll
    for (int o = 1; o < 64; o <<= 1) v += shx(v, o, lane);
    return v;
}
__device__ __forceinline__ float siluf(float x) { return x * __builtin_amdgcn_rcpf(1.0f + __expf(-x)); }

struct RowInfo { int is_ctx, b, t; };
__device__ __forceinline__ RowInfo row_info(int r) {
    RowInfo ri;
    if (r < NB * CT) { ri.is_ctx = 1; ri.b = r / CT; ri.t = r % CT; }
    else { ri.is_ctx = 0; const int u = r - NB * CT; ri.b = u / T; ri.t = u % T; }
    return ri;
}
__device__ __forceinline__ int lat_row(int b, int t) { return NB * CT + b * T + t; }
__device__ __forceinline__ int ctx_row(int b, int t) { return b * CT + t; }
constexpr int CR = NB * CT;
constexpr int LH = RH - LAT0;

#define XB_TMO      128
#define XB_XCNT(j)  (256  + 64 * (j))
#define XB_XSUB(j)  (1280 + 64 * (j))
#define XB_XGEN(j)  (2304 + 64 * (j))
#define XB_TOP      3328
#define XB_TOPGEN   3392
#define XCD_BAR_WORDS 3456
#define XB_SPIN_CAP (1u << 18)

__device__ __forceinline__ unsigned xb_ld(unsigned* p)              { return __hip_atomic_load(p, __ATOMIC_RELAXED, __HIP_MEMORY_SCOPE_AGENT); }
__device__ __forceinline__ unsigned xb_add(unsigned* p, unsigned v) { return __hip_atomic_fetch_add(p, v, __ATOMIC_RELAXED, __HIP_MEMORY_SCOPE_AGENT); }
__device__ __forceinline__ unsigned xb_xcc_id() { return (unsigned)__builtin_amdgcn_s_getreg((3 << 11) | 20) & 0xFu; }
#define XB_SPIN(cond, bar) do { unsigned _sp = 0; while (cond) { __builtin_amdgcn_s_sleep(1); \
    if ((++_sp & 255u) == 0u) { if (xb_ld(&(bar)[XB_TMO])) break; if (_sp > XB_SPIN_CAP) { atomicAdd(&(bar)[XB_TMO], 1u); break; } } } } while (0)

struct XcdBarrier { unsigned* bar; unsigned x; volatile LAS unsigned* st; };

__device__ __forceinline__ XcdBarrier xcd_barrier_post(unsigned* bar, volatile LAS unsigned* st) {
    XcdBarrier b; b.bar = bar; b.x = xb_xcc_id(); b.st = st;
    if (threadIdx.x == 0) (void)xb_add(&bar[XB_XCNT(b.x)], 1u);
    return b;
}
__device__ __forceinline__ void xcd_barrier_complete(unsigned* bar, unsigned x, unsigned& nloc, unsigned& nx) {
    const unsigned G = gridDim.x * gridDim.y * gridDim.z;
    unsigned sum, cnt, mine, sp = 0u;
    for (;;) {
        sum = 0u; cnt = 0u; mine = 0u;
#pragma unroll
        for (unsigned j = 0; j < 16; ++j) { const unsigned c = xb_ld(&bar[XB_XCNT(j)]); sum += c; cnt += (c > 0u) ? 1u : 0u; mine = (j == x) ? c : mine; }
        if (sum == G) break;
        __builtin_amdgcn_s_sleep(1);
        if ((++sp & 255u) == 0u) { if (xb_ld(&bar[XB_TMO])) break; if (sp > XB_SPIN_CAP) { atomicAdd(&bar[XB_TMO], 1u); break; } }
    }
    nloc = mine > 0u ? mine : 1u; nx = cnt > 0u ? cnt : 1u;
}
__device__ __forceinline__ void xcd_barrier(const XcdBarrier& b, bool thread0) {
    asm volatile("s_waitcnt vmcnt(0)" ::: "memory");
    __syncthreads();
    if (thread0) {
        unsigned* bar = b.bar;
        __builtin_amdgcn_s_waitcnt(0);
        unsigned nloc = b.st[0], nx = b.st[1];
        if (nloc == 0u) { xcd_barrier_complete(bar, b.x, nloc, nx); b.st[0] = nloc; b.st[1] = nx; }
        const unsigned old = xb_add(&bar[XB_XSUB(b.x)], 1u);
        const unsigned gen = old / nloc;
        if (old + 1u == (gen + 1u) * nloc) {
            __builtin_amdgcn_fence(__ATOMIC_RELEASE, "agent");
            asm volatile("s_waitcnt vmcnt(0)" ::: "memory");
            const unsigned og = xb_add(&bar[XB_TOP], 1u);
            const unsigned tg = og / nx;
            if (og + 1u == (tg + 1u) * nx) xb_add(&bar[XB_TOPGEN], 1u);
            else XB_SPIN(xb_ld(&bar[XB_TOPGEN]) == tg, bar);
            __builtin_amdgcn_fence(__ATOMIC_ACQUIRE, "agent");
            xb_add(&bar[XB_XGEN(b.x)], 1u);
            asm volatile("s_waitcnt vmcnt(0)" ::: "memory");
        } else {
            XB_SPIN(xb_ld(&bar[XB_XGEN(b.x)]) == gen, bar);
            __builtin_amdgcn_fence(__ATOMIC_ACQUIRE, "agent");
            asm volatile("s_waitcnt vmcnt(0)" ::: "memory");
        }
    }
    __syncthreads();
}

__device__ __forceinline__ size_t qtile_off(int q, int h, int cc) {
    const int chunk = q >> 6, p = q & 63, pt = p >> 4, fr = p & 15, w = cc >> 6, ks = (cc >> 5) & 1, fq = (cc >> 3) & 3;
    const size_t blk = ((((size_t)chunk * 4 + h) * 8 + w) * 4 + pt) * 2 + ks;
    return blk * 512 + (size_t)(fq * 16 + fr) * 8 + (cc & 7);
}
__device__ __forceinline__ size_t ktile_off(int d, int h, int q) {
    const int chunk = q >> 6, s = q & 63, ks = s >> 5, fq = (s >> 3) & 3, w = d >> 6, dd = d & 63, mt = 2 * (dd >> 5) + ((dd >> 2) & 1), frp = 4 * ((dd >> 3) & 3) + (dd & 3);
    const size_t blk = ((((size_t)chunk * 4 + h) * 8 + w) * 4 + mt) * 2 + ks;
    return blk * 512 + (size_t)(fq * 16 + frp) * 8 + (s & 7);
}

__device__ __forceinline__ size_t vtile_off(int e, int h, int q) {
    const int chunk = q >> 6, s = q & 63, slice = e >> 5, e5 = e & 31, nt = e5 >> 4, fr = e5 & 15, ks = s >> 5, fq = (s >> 3) & 3;
    const size_t blk = ((((size_t)chunk * 4 + h) * 16 + slice) * 2 + nt) * 2 + ks;
    return blk * 512 + (size_t)(fq * 16 + fr) * 8 + (s & 7);
}
__device__ __forceinline__ size_t htile_off(int q, int h, int e) {
    return ((((size_t)(q >> 6) * 4 + h) * 16 + (e >> 5)) * 2048) + (size_t)(q & 63) * 32 + (e & 31);
}

namespace pg8 {
constexpr int BM = 256, BK = 64, HALF = 128, HTB = HALF * BK * 2, STAGE_BYTES = 8 * HTB, NXCD = 8, WGM = 8;
__device__ __forceinline__ int lds_byte(int r, int c) { const int st = (r >> 4) * 2 + (c >> 5), rr = r & 15, cc = c & 31, ob = rr * 64 + cc * 2; return st * 1024 + (ob ^ (((ob >> 9) & 1) << 5)); }
__device__ __forceinline__ void stage_rc(int b, int& R_, int& C_) { const int st = b / 1024, sb = b % 1024, swz = sb ^ (((sb >> 9) & 1) << 5); R_ = (st >> 1) * 16 + swz / 64; C_ = (st & 1) * 32 + (swz % 64) / 2; }
__device__ __forceinline__ int perm32(int rho) { const int n = rho >> 4, i = rho & 15; return 8 * (i >> 2) + 4 * n + (i & 3); }

struct Unit { int pm, pn, g; };
struct Gemm {
    const bf16_t* A; const bf16_t* Bt; int lda, ldb, K;
    long a_gs, b_gs;
    int nM, nN, nG;
};
struct Order {
    int nM, nNt, nN, nwg, G, c;
    __device__ void init(const Gemm& g, int G_, int c_) { nM = g.nM; nN = g.nN; nNt = g.nN * g.nG; nwg = nM * nNt; G = G_; c = c_; }
    __device__ bool next(int i, Unit& u) const {
        const long L = (long)i * G + c; if (L >= nwg) return false;
        int wgid = (int)L; { const int q = nwg / NXCD, r = nwg % NXCD, xcd = wgid % NXCD, off = wgid / NXCD; wgid = (xcd < r ? xcd * (q + 1) : r * (q + 1) + (xcd - r) * q) + off; }
        const int nig = WGM * nNt, gid = wgid / nig, fm = gid * WGM, gsz = (nM - fm) < WGM ? (nM - fm) : WGM;
        u.pm = fm + ((wgid % nig) % gsz); const int pnt = (wgid % nig) / gsz; u.g = pnt / nN; u.pn = pnt - u.g * nN; return true;
    }
};
__device__ __forceinline__ unsigned cvt_pk_bf16(float lo, float hi) { return pk2(lo, hi); }

struct EpiStore {
    bf16_t* O; long o_gs; int ldc; int act;
    int mode, off;
    __device__ __forceinline__ void operator()(const f32x4 (&acc)[2][2][4][2], const Unit& u, int wr, int wc, int fr, int fq) const {
        const int row0 = u.pm * BM + wr * 64 + fr; const int col0 = u.pn * BM + wc * 32 + 8 * fq; bf16_t* base = O + (long)u.g * o_gs;
#pragma unroll
        for (int ai = 0; ai < 2; ++ai)
#pragma unroll
            for (int m = 0; m < 4; ++m) { bf16_t* rowp = base + (size_t)(row0 + ai * HALF + m * 16) * ldc + col0;
#pragma unroll
                for (int bj = 0; bj < 2; ++bj) { f32x4 v0 = acc[ai][bj][m][0], v1 = acc[ai][bj][m][1];
                    if (act == 1) {
#pragma unroll
                        for (int j = 0; j < 4; ++j) { const float a = fmaxf(v0[j], 0.f), b = fmaxf(v1[j], 0.f); v0[j] = a * a; v1[j] = b * b; } }
                    u32x4 w; w.x = cvt_pk_bf16(v0[0], v0[1]); w.y = cvt_pk_bf16(v0[2], v0[3]); w.z = cvt_pk_bf16(v1[0], v1[1]); w.w = cvt_pk_bf16(v1[2], v1[3]);
                    if (mode == 0) *(u32x4*)(rowp + bj * HALF) = w;
                    else if (mode == 1) *(u32x4*)(O + qtile_off(off + row0 + ai * HALF + m * 16, u.g, col0 + bj * HALF)) = w;
                    else if (mode == 2) *(u32x4*)(O + ktile_off(row0 + ai * HALF + m * 16, u.g, off + col0 + bj * HALF)) = w;
                    else *(u32x4*)(O + vtile_off(row0 + ai * HALF + m * 16, u.g, off + col0 + bj * HALF)) = w; } }
    }
};

template <class Epi>
__device__ __forceinline__ void gemm_phase(LAS unsigned char* lds, const Gemm g, const Epi& E, int G_, int c_, int tid_in) {
    int tid_ = tid_in; asm volatile("" : "+v"(tid_));
    const int tid = tid_, wid = __builtin_amdgcn_readfirstlane(tid >> 6), lane = tid & 63, wr = wid >> 2, wc = wid & 3, fr = lane & 15, fq = lane >> 4;
    const int K = g.K, nt = K / BK;
    Order S; S.init(g, G_, c_);
    unsigned voffA[2], voffB[2];
#pragma unroll
    for (int i = 0; i < 2; ++i) { int R_, C_; stage_rc(tid * 16 + i * 8192, R_, C_); const int Rb = (R_ & ~31) + perm32(R_ & 31);
        voffA[i] = (unsigned)(R_ * g.lda + C_) * 2u; voffB[i] = (unsigned)(Rb * g.ldb + C_) * 2u; }
    const size_t kstep = (size_t)(BK * 2);
    const size_t hstepA = (size_t)HALF * g.lda * 2, hstepB = (size_t)HALF * g.ldb * 2;
    const unsigned ldsw = (unsigned)wid * 1024u;
    const int aoff = lds_byte(wr * 64 + fr, fq * 8), boff = lds_byte(wc * 32 + fr, fq * 8);
#define PG8_SA(b, h) (((b) * 2 + (h)) * HTB)
#define PG8_SB(b, h) ((4 + (b) * 2 + (h)) * HTB)
#define PG8_STAGE(bufoff, gbase, voff) do { _Pragma("unroll") for (int _i = 0; _i < 2; ++_i) \
        __builtin_amdgcn_global_load_lds((const unsigned*)((const char*)(gbase) + (voff)[_i]), (LAS unsigned*)(lds + (bufoff) + ldsw + _i * 8192), 16, 0, 0); } while (0)
#define PG8_LDA(dst, b, h) do { _Pragma("unroll") for (int m = 0; m < 4; ++m) _Pragma("unroll") for (int k = 0; k < 2; ++k) dst[m][k] = *(const LAS bf16x8*)(lds + PG8_SA(b, h) + aoff + m * 2048 + k * 1024); } while (0)
#define PG8_LDB(dst, b, h) do { _Pragma("unroll") for (int n = 0; n < 2; ++n) _Pragma("unroll") for (int k = 0; k < 2; ++k) dst[n][k] = *(const LAS bf16x8*)(lds + PG8_SB(b, h) + boff + n * 2048 + k * 1024); } while (0)
#define PG8_MMA(ai, bj, At, Bt) do { __builtin_amdgcn_s_setprio(1); _Pragma("unroll") for (int m = 0; m < 4; ++m) _Pragma("unroll") for (int n = 0; n < 2; ++n) _Pragma("unroll") for (int k = 0; k < 2; ++k) \
        acc[ai][bj][m][n] = __builtin_amdgcn_mfma_f32_16x16x32_bf16(Bt[n][k], At[m][k], acc[ai][bj][m][n], 0, 0, 0); __builtin_amdgcn_s_setprio(0); } while (0)
#define PG8_WAIT_V(n) asm volatile("s_waitcnt vmcnt(" #n ")" ::: "memory")
#define PG8_WAIT_L(n) asm volatile("s_waitcnt lgkmcnt(" #n ")" ::: "memory")
#define PG8_BAR __builtin_amdgcn_s_barrier()
#define PG8_SCHED __builtin_amdgcn_sched_barrier(0)
#define PG8_APTR(u) ((const char*)(g.A + (long)(u).g * g.a_gs) + (size_t)(u).pm * 2 * hstepA)
#define PG8_BPTR(u) ((const char*)(g.Bt + (long)(u).g * g.b_gs) + (size_t)(u).pn * 2 * hstepB)
    Unit cur, nxt; int ui = 0;
    if (!S.next(0, cur)) return;
    f32x4 acc[2][2][4][2];
#pragma unroll
    for (int a = 0; a < 2; ++a)
#pragma unroll
        for (int b = 0; b < 2; ++b)
#pragma unroll
            for (int m = 0; m < 4; ++m)
#pragma unroll
                for (int n = 0; n < 2; ++n) acc[a][b][m][n] = (f32x4){0.f, 0.f, 0.f, 0.f};
    bf16x8 At[4][2], B0[2][2], B1[2][2];
    const char* cA = PG8_APTR(cur); const char* cB = PG8_BPTR(cur);
    PG8_STAGE(PG8_SB(0, 0), cB, voffB); PG8_STAGE(PG8_SA(0, 0), cA, voffA); PG8_STAGE(PG8_SB(0, 1), cB + hstepB, voffB); PG8_STAGE(PG8_SA(0, 1), cA + hstepA, voffA);
    if (wr == 1) PG8_BAR;
    PG8_WAIT_V(4); PG8_BAR;
    PG8_STAGE(PG8_SB(1, 0), cB + kstep, voffB); PG8_STAGE(PG8_SA(1, 0), cA + kstep, voffA); PG8_STAGE(PG8_SB(1, 1), cB + hstepB + kstep, voffB);
    PG8_WAIT_V(6); PG8_BAR;
    for (;;) {
        const bool has_next = S.next(ui + 1, nxt);
        const char* nA = has_next ? PG8_APTR(nxt) : cA; const char* nB = has_next ? PG8_BPTR(nxt) : cB;
        for (int t = 0; t < nt; t += 2) {
            const bool last = (t == nt - 2);
            const char* a1 = cA + (size_t)(t + 1) * kstep;
            const char* a2 = last ? nA : cA + (size_t)(t + 2) * kstep; const char* b2 = last ? nB : cB + (size_t)(t + 2) * kstep;
            const char* a3 = a2 + kstep; const char* b3 = b2 + kstep;
            PG8_LDB(B0, 0, 0); PG8_SCHED; PG8_LDA(At, 0, 0); PG8_STAGE(PG8_SA(1, 1), a1 + hstepA, voffA);
            PG8_WAIT_L(8); PG8_BAR; PG8_WAIT_L(0); PG8_MMA(0, 0, At, B0); PG8_BAR; PG8_SCHED;
            PG8_LDB(B1, 0, 1); PG8_STAGE(PG8_SB(0, 0), b2, voffB);
            PG8_BAR; PG8_WAIT_L(0); PG8_MMA(0, 1, At, B1); PG8_BAR;
            PG8_LDA(At, 0, 1); PG8_STAGE(PG8_SA(0, 0), a2, voffA);
            PG8_BAR; PG8_WAIT_L(0); PG8_MMA(1, 0, At, B0); PG8_BAR; PG8_SCHED;
            PG8_STAGE(PG8_SB(0, 1), b2 + hstepB, voffB);
            PG8_WAIT_V(6); PG8_BAR; PG8_MMA(1, 1, At, B1); PG8_BAR;
            PG8_LDB(B0, 1, 0); PG8_SCHED; PG8_LDA(At, 1, 0); PG8_STAGE(PG8_SA(0, 1), a2 + hstepA, voffA);
            PG8_WAIT_L(8); PG8_BAR; PG8_WAIT_L(0); PG8_MMA(0, 0, At, B0); PG8_BAR; PG8_SCHED;
            PG8_LDB(B1, 1, 1); PG8_STAGE(PG8_SB(1, 0), b3, voffB);
            PG8_BAR; PG8_WAIT_L(0); PG8_MMA(0, 1, At, B1); PG8_BAR;
            PG8_LDA(At, 1, 1); PG8_STAGE(PG8_SA(1, 0), a3, voffA);
            PG8_BAR; PG8_WAIT_L(0); PG8_MMA(1, 0, At, B0); PG8_BAR; PG8_SCHED;
            PG8_STAGE(PG8_SB(1, 1), b3 + hstepB, voffB);
            PG8_WAIT_V(6); PG8_BAR; PG8_MMA(1, 1, At, B1); PG8_BAR;
        }
        E(acc, cur, wr, wc, fr, fq);
        if (!has_next) break;
#pragma unroll
        for (int a = 0; a < 2; ++a)
#pragma unroll
            for (int b = 0; b < 2; ++b)
#pragma unroll
                for (int m = 0; m < 4; ++m)
#pragma unroll
                    for (int n = 0; n < 2; ++n) acc[a][b][m][n] = (f32x4){0.f, 0.f, 0.f, 0.f};
        cur = nxt; cA = nA; cB = nB; ++ui;
    }
    PG8_WAIT_V(0);
    if (wr == 0) PG8_BAR;
    PG8_BAR;
#undef PG8_SA
#undef PG8_SB
#undef PG8_STAGE
#undef PG8_LDA
#undef PG8_LDB
#undef PG8_MMA
#undef PG8_WAIT_V
#undef PG8_WAIT_L
#undef PG8_BAR
#undef PG8_SCHED
#undef PG8_APTR
#undef PG8_BPTR
}
}

struct SmallGemm { const bf16_t* A; const bf16_t* B; int lda, ldb, K, akseg, bkseg; long aseg, bseg; int a_tiled; };
constexpr int SG_LD = 72;
constexpr int SG_TILE = 64 * SG_LD * 2;
template <class Dec, class Epi>
__device__ __forceinline__ void gemm_small(LAS unsigned char* lds, const SmallGemm g, int nunits, const Dec& dec, const Epi& epi, int G_, int c_, int tid_in) {
    int tid_ = tid_in; asm volatile("" : "+v"(tid_));
    const int tid = tid_, wid = tid >> 6, lane = tid & 63, wm = wid >> 1, wn = wid & 1, fr = lane & 15, fq = lane >> 4;
    const int lrow = tid >> 3, lk = (tid & 7) * 8;
    const int nk = g.K / 64;
    const unsigned stoff = (unsigned)(lrow * SG_LD + lk) * 2u;
#define SG_LOAD(ra_, rb_, kt_) do { const int k_ = (kt_) * 64 + lk; \
        if (g.a_tiled) ra_ = *(const u32x4*)(g.A + (((((size_t)aoff * 8 + (k_ >> 6)) * 4 + (lrow >> 4)) * 2 + ((k_ >> 5) & 1)) * 512 + (size_t)(((k_ >> 3) & 3) * 16 + (lrow & 15)) * 8)); \
        else ra_ = *(const u32x4*)(ap + (long)(k_ / g.akseg) * g.aseg + (k_ % g.akseg)); \
        rb_ = *(const u32x4*)(bp + (long)(k_ / g.bkseg) * g.bseg + (k_ % g.bkseg)); } while (0)
#define SG_STORE(ra_, rb_, bufi_) do { *(LAS u32x4*)(lds + ((bufi_) * 2 + 0) * SG_TILE + stoff) = ra_; *(LAS u32x4*)(lds + ((bufi_) * 2 + 1) * SG_TILE + stoff) = rb_; } while (0)
#define SG_COMPUTE(bufi_) do { const LAS unsigned char* As = lds + ((bufi_) * 2 + 0) * SG_TILE; const LAS unsigned char* Bs = lds + ((bufi_) * 2 + 1) * SG_TILE; \
        _Pragma("unroll") for (int ks = 0; ks < 2; ++ks) { const bf16x8 af = *(const LAS bf16x8*)(As + ((wm * 16 + fr) * SG_LD + ks * 32 + fq * 8) * 2); \
            _Pragma("unroll") for (int nt = 0; nt < 2; ++nt) { const bf16x8 bf = *(const LAS bf16x8*)(Bs + ((wn * 32 + nt * 16 + fr) * SG_LD + ks * 32 + fq * 8) * 2); \
                acc[nt] = __builtin_amdgcn_mfma_f32_16x16x32_bf16(bf, af, acc[nt], 0, 0, 0); } } } while (0)
    for (int u = c_; u < nunits; u += G_) {
        long aoff, boff; dec(u, aoff, boff);
        const bf16_t* ap = g.A + aoff + (long)lrow * g.lda; const bf16_t* bp = g.B + boff + (long)lrow * g.ldb;
        f32x4 acc[2] = {(f32x4){0.f, 0.f, 0.f, 0.f}, (f32x4){0.f, 0.f, 0.f, 0.f}};
        u32x4 ra0, rb0, ra1, rb1, ra2, rb2, ra3, rb3;
        ra0 = (u32x4){0u, 0u, 0u, 0u}; rb0 = ra0; ra1 = ra0; rb1 = ra0; ra2 = ra0; rb2 = ra0; ra3 = ra0; rb3 = ra0;
        SG_LOAD(ra0, rb0, 0); if (nk > 1) SG_LOAD(ra1, rb1, 1); if (nk > 2) SG_LOAD(ra2, rb2, 2); if (nk > 3) SG_LOAD(ra3, rb3, 3);
        SG_STORE(ra0, rb0, 0);
        LDS_BARRIER();
#define SG_TURN(kt_, bufc, rnextA, rnextB, rfreeA, rfreeB) do { if ((kt_) < nk) { \
            SG_COMPUTE(bufc); \
            if ((kt_) + 1 < nk) SG_STORE(rnextA, rnextB, (bufc) ^ 1); \
            if ((kt_) + 4 < nk) SG_LOAD(rfreeA, rfreeB, (kt_) + 4); \
            LDS_BARRIER(); } } while (0)
        for (int kt = 0; kt < nk; kt += 4) {
            SG_TURN(kt,     0, ra1, rb1, ra0, rb0);
            SG_TURN(kt + 1, 1, ra2, rb2, ra1, rb1);
            SG_TURN(kt + 2, 0, ra3, rb3, ra2, rb2);
            SG_TURN(kt + 3, 1, ra0, rb0, ra3, rb3);
        }
#undef SG_TURN
#pragma unroll
        for (int nt = 0; nt < 2; ++nt) epi(u, wm * 16 + fr, wn * 32 + nt * 16 + fq * 4, acc[nt]);
    }
#undef SG_LOAD
#undef SG_STORE
#undef SG_COMPUTE
}

struct SmallDense { bf16_t* O; long o_gs; int ldc, mt, nt, act; long a_gs, b_gs; int mode; };
__device__ __forceinline__ void gemm_small_dense(LAS unsigned char* lds, const SmallGemm g, const SmallDense d, int ngroups, int G_, int c_, int tid_in) {
    const int per = d.mt * d.nt;
    auto dec = [=](int u, long& ao, long& bo) { const int gi = u / per, r = u % per, mi = r / d.nt, ni = r % d.nt; ao = gi * d.a_gs + (long)mi * 64 * g.lda; bo = gi * d.b_gs + (long)ni * 64 * g.ldb; };
    auto epi = [=](int u, int m, int n, const f32x4& v) { const int gi = u / per, r = u % per, mi = r / d.nt, ni = r % d.nt;
        f32x4 x = v; if (d.act == 1) {
#pragma unroll
            for (int i = 0; i < 4; ++i) { const float a = fmaxf(x[i], 0.f); x[i] = a * a; } }
        u32x2 w; w.x = pk2(x[0], x[1]); w.y = pk2(x[2], x[3]);
        if (d.mode == 0) *(u32x2*)(d.O + gi * d.o_gs + (size_t)(mi * 64 + m) * d.ldc + ni * 64 + n) = w;
        else if (d.mode == 1) *(u32x2*)(d.O + qtile_off(mi * 64 + m, gi, ni * 64 + n)) = w;
        else if (d.mode == 2) *(u32x2*)(d.O + ktile_off(mi * 64 + m, gi, ni * 64 + n)) = w;
        else *(u32x2*)(d.O + vtile_off(mi * 64 + m, gi, ni * 64 + n)) = w; };
    gemm_small(lds, g, ngroups * per, dec, epi, G_, c_, tid_in);
}

struct Args { const float* in[22]; float* out; unsigned char* ws; int ph_lo, ph_hi, ph_last, li; };
enum { I_X = 0, I_C, I_CTX, I_CCTX, I_ADAW, I_ADAB, I_PG, I_PB, I_WIN, I_WCONV, I_BCONV, I_WQ, I_WK, I_WV, I_WGATE, I_BGATE, I_GNW, I_SKIP, I_WOUT, I_FWOUT, I_W1, I_W2 };

constexpr int LDS_BYTES = 147456;
constexpr int LDS_MISC = LDS_BYTES - 256;

__device__ __forceinline__ void transpose_item(const float* W, int K, int N, bf16_t* WT, float scale, LAS float* scr, int item, int lane) {
    const int nblk = N / 32, kb = item / nblk, nb = item % nblk, k0 = 64 * kb, n0 = 32 * nb;
#pragma unroll 8
    for (int i = 0; i < 32; ++i) { const int kk = 2 * i + (lane >> 5); scr[kk * 33 + (lane & 31)] = W[(size_t)(k0 + kk) * N + n0 + (lane & 31)] * scale; }
    asm volatile("s_waitcnt lgkmcnt(0)" ::: "memory");
    const int c = lane & 7;
#pragma unroll
    for (int j = 0; j < 4; ++j) { const int n = (lane >> 3) + 8 * j; const LAS float* s = scr + (8 * c) * 33 + n;
        u32x4 o; o.x = pk2(s[0 * 33], s[1 * 33]); o.y = pk2(s[2 * 33], s[3 * 33]); o.z = pk2(s[4 * 33], s[5 * 33]); o.w = pk2(s[6 * 33], s[7 * 33]);
        *(u32x4*)(WT + (size_t)(n0 + n) * K + k0 + 8 * c) = o; }
    asm volatile("s_waitcnt lgkmcnt(0)" ::: "memory");
}

__device__ __forceinline__ void ln_norm(f32x4 (&v)[4], int lane) {
    float s = 0.f;
#pragma unroll
    for (int j = 0; j < 4; ++j) s += (v[j][0] + v[j][1]) + (v[j][2] + v[j][3]);
    const float mean = wave_sum(s, lane) * (1.f / D); float s2 = 0.f;
#pragma unroll
    for (int j = 0; j < 4; ++j) { v[j] = v[j] - mean; s2 += (v[j][0] * v[j][0] + v[j][1] * v[j][1]) + (v[j][2] * v[j][2] + v[j][3] * v[j][3]); }
    const float rstd = __builtin_amdgcn_rsqf(wave_sum(s2, lane) * (1.f / D) + LN_EPS);
#pragma unroll
    for (int j = 0; j < 4; ++j) v[j] = v[j] * rstd;
}

constexpr int PL = 24;
constexpr int NPHASE = 2 + 4 * PL;
__host__ __device__ inline bool phase_valid(int id) {
    if (id < 2) return true;
    const int layer = (id - 2) / PL, k = (id - 2) % PL;
    if (layer > 3) return false;
    if (k == 0 || (k >= 19 && k <= 22)) return true;
    if (layer & 1) return k >= 2 && k <= 5;
    return k >= 1 && k <= 18;
}


#define MOD ((float*)(ws + WS_MOD))
#define CTXX ((float*)(ws + WS_CTXX))
#define PRE ((float*)(ws + WS_PRE))
#define HIN ((bf16_t*)(ws + WS_HIN))
#define YB ((bf16_t*)(ws + WS_YB))
#define WIN ((bf16_t*)(ws + W_IN))
#define WQ ((bf16_t*)(ws + W_Q))
#define WK ((bf16_t*)(ws + W_K))
#define WV ((bf16_t*)(ws + W_V))
#define WOUT ((bf16_t*)(ws + W_OUT))
#define W1 ((bf16_t*)(ws + W_1))
#define W2 ((bf16_t*)(ws + W_2))
#define GATET ((bf16_t*)(ws + TAB_GATE))
#define S0 ((bf16_t*)(ws + WS_BIG + 0 * SLOT))
#define S1 ((bf16_t*)(ws + WS_BIG + 1 * SLOT))
#define S2 ((bf16_t*)(ws + WS_BIG + 2 * SLOT))
#define S3 ((bf16_t*)(ws + WS_BIG + 3 * SLOT))
#define S4 ((bf16_t*)(ws + WS_BIG + 4 * SLOT))
#define YH (YB + ((size_t)CR + (size_t)half * LH) * D)
#define YHC (YB + (size_t)half * LAT0 * D)
#define HCB (YH + (size_t)NCH * 4 * 2 * 4096 + (size_t)NCH * 4 * 2 * 384 * 2)
#define PREQ ((float*)(HCB + (size_t)LAT0 * DI))
#define HH (HIN + ((size_t)CR + (size_t)half * LH) * D)
#define HHC (HIN + (size_t)half * LAT0 * D)
#define HT ((bf16_t*)(ws + WS_BIG))
#define HTC (HT + (size_t)NB * D * T)
#define PB ((bf16_t*)(ws + WS_BIG + 1 * SLOT))
#define WC ((bf16_t*)(ws + WS_BIG + 3 * SLOT))
#define ZF ((bf16_t*)(ws + WS_BIG))
#define HID ((bf16_t*)(ws + WS_BIG))

constexpr int SC_PLD = 36, SC_VLD = 72;
#define SC_ROW0(j) (((j) < 4) ? (bl * CT + (dir ? 3 - (j) : (j)) * 64) : (LAT0 + bl * T + (dir ? 127 - ((j) - 4) : ((j) - 4)) * 64))
#define SC_LOADQ(dst, r0) do { _Pragma("unroll") for (int pt = 0; pt < 4; ++pt) _Pragma("unroll") for (int ks = 0; ks < 2; ++ks) \
        dst[pt][ks] = __builtin_bit_cast(bf16x8, __builtin_amdgcn_raw_buffer_load_b128(rW, loff, oQ + ((((((r0) >> 6) * 4 + hh) * 8 + w) * 4 + pt) * 2 + ks) * 1024, 0)); } while (0)
#define SC_LOADQ1(dst, r0, pt, ks) dst[pt][ks] = __builtin_bit_cast(bf16x8, __builtin_amdgcn_raw_buffer_load_b128(rW, loff, oQ + ((((((r0) >> 6) * 4 + hh) * 8 + w) * 4 + (pt)) * 2 + (ks)) * 1024, 0))
#define SC_LOADK1(dst, r0, mt, ks) dst[mt][ks] = __builtin_bit_cast(bf16x8, __builtin_amdgcn_raw_buffer_load_b128(rW, loff, oK + ((((((r0) >> 6) * 4 + hh) * 8 + w) * 4 + (mt)) * 2 + (ks)) * 1024, 0))
#define SC_LOADK(dst, r0) do { _Pragma("unroll") for (int mt = 0; mt < 4; ++mt) _Pragma("unroll") for (int ks = 0; ks < 2; ++ks) \
        dst[mt][ks] = __builtin_bit_cast(bf16x8, __builtin_amdgcn_raw_buffer_load_b128(rW, loff, oK + ((((((r0) >> 6) * 4 + hh) * 8 + w) * 4 + mt) * 2 + ks) * 1024, 0)); } while (0)
#define SC_LOADS(P, r0) do { const int ci_ = ((((r0) >> 6) * 4 + hh) * 2 + dir); \
        P##sg0 = __builtin_bit_cast(bf16x8, __builtin_amdgcn_raw_buffer_load_b128(rW, loff, oS + ci_ * 8192 + (w >> 1) * 2048, 0)); P##sg1 = __builtin_bit_cast(bf16x8, __builtin_amdgcn_raw_buffer_load_b128(rW, loff, oS + ci_ * 8192 + (w >> 1) * 2048 + 1024, 0)); \
        P##v = __builtin_bit_cast(u32x4, __builtin_amdgcn_raw_buffer_load_b128(rW, voff, oV + ((((r0) >> 6) * 4 + hh) * 16 + slice) * 4096, 0));     \
        P##wka = __builtin_bit_cast(u32x4, __builtin_amdgcn_raw_buffer_load_b128(rW, wkoff, oG + ci_ * 1536 + 1024, 0)); P##wkb = __builtin_bit_cast(u32x4, __builtin_amdgcn_raw_buffer_load_b128(rW, wkoff, oG + ci_ * 1536 + 1024 + 16, 0));         \
        P##wint = __builtin_bit_cast(float, __builtin_amdgcn_raw_buffer_load_b32(rW, gcp, oG + ci_ * 1536 + 512, 0)); P##em = __builtin_bit_cast(float, __builtin_amdgcn_raw_buffer_load_b32(rW, gcp, oG + ci_ * 1536 + 768, 0)); \
        P##dec = __builtin_bit_cast(float, __builtin_amdgcn_raw_buffer_load_b32(rW, 0, oG + ci_ * 1536 + 1280, 0)); } while (0)
#define SC_VWRITE(bufi, P) do { LAS bf16_t* vt_ = VB + (bufi) * 2 * 3072; LAS bf16_t* vw_ = vt_ + 3072; \
        if (w < 5) { const float wk_[8] = {u2f(P##wka.x), u2f(P##wka.y), u2f(P##wka.z), u2f(P##wka.w), u2f(P##wkb.x), u2f(P##wkb.y), u2f(P##wkb.z), u2f(P##wkb.w)};     \
            if (w < 4) { *(LAS u32x4*)(vt_ + tid * 8) = P##v; \
                u32x4 sv_; sv_.x = pk2(bflo(P##v.x) * wk_[0], bfhi(P##v.x) * wk_[1]); sv_.y = pk2(bflo(P##v.y) * wk_[2], bfhi(P##v.y) * wk_[3]); \
                sv_.z = pk2(bflo(P##v.z) * wk_[4], bfhi(P##v.z) * wk_[5]); sv_.w = pk2(bflo(P##v.w) * wk_[6], bfhi(P##v.w) * wk_[7]); *(LAS u32x4*)(vw_ + tid * 8) = sv_; } \
            else if (lane < 8) { u32x4 sv_; sv_.x = pk2(wk_[0], wk_[1]); sv_.y = pk2(wk_[2], wk_[3]); sv_.z = pk2(wk_[4], wk_[5]); sv_.w = pk2(wk_[6], wk_[7]); \
                *(LAS u32x4*)(vw_ + (4 + (lane >> 2)) * 512 + (lane & 3) * 16 * 8) = sv_; } } } while (0)
#define SC_STEP(J, Qc, Qn, Kc, Kn, C, N) do { \
    const int j_ = (J); const int row0 = SC_ROW0(j_); const int jn_ = j_ < 131 ? j_ + 1 : 131; const int row1 = SC_ROW0(jn_); \
    const int hsel = (j_ < 4) ? (dir ? 2 : 0) : ((j_ < 68) ? 0 : 1); \
    const int buf = j_ & 1; \
    const LAS bf16_t* VT = VB + buf * 2 * 3072; const LAS bf16_t* VW = VT + 3072; \
    LDS_BARRIER();                                                       \
    SC_LOADS(N, row1); \
      \
    if (!(abl_ & 1)) _Pragma("unroll") for (int nt = 0; nt < 3; ++nt) { \
        f32x4 d1[4]; \
        _Pragma("unroll") for (int pt = 0; pt < 4; ++pt) d1[pt] = (f32x4){0.f, 0.f, 0.f, 0.f}; \
        _Pragma("unroll") for (int ks = 0; ks < 2; ++ks) { \
            u32x4 bw; bw.x = pg8::cvt_pk_bf16(st[2 * ks][nt][0], st[2 * ks][nt][1]); bw.y = pg8::cvt_pk_bf16(st[2 * ks][nt][2], st[2 * ks][nt][3]); \
            bw.z = pg8::cvt_pk_bf16(st[2 * ks + 1][nt][0], st[2 * ks + 1][nt][1]); bw.w = pg8::cvt_pk_bf16(st[2 * ks + 1][nt][2], st[2 * ks + 1][nt][3]); \
            const bf16x8 bs = __builtin_bit_cast(bf16x8, bw); \
            _Pragma("unroll") for (int pt = 0; pt < 4; ++pt) d1[pt] = __builtin_amdgcn_mfma_f32_16x16x32_bf16(bs, Qc[pt][ks], d1[pt], 0, 0, 0); \
            SC_LOADQ1(Qn, row1, (nt * 2 + ks) >> 1, (nt * 2 + ks) & 1);     } \
        _Pragma("unroll") for (int pt = 0; pt < 4; ++pt) { \
            if (nt < 2) { u32x2 pw_; pw_.x = pg8::cvt_pk_bf16(d1[pt][0], d1[pt][1]); pw_.y = pg8::cvt_pk_bf16(d1[pt][2], d1[pt][3]); *(LAS u32x2*)(Pbh + (w * 64 + 16 * pt + fr) * 40 + 16 * nt + 4 * fq) = pw_; }     \
            else if (fq == 0) NQs[w * 64 + 16 * pt + fr] = d1[pt][0]; } } \
    SC_LOADQ1(Qn, row1, 3, 0); SC_LOADQ1(Qn, row1, 3, 1); \
    if (!(abl_ & 2)) {     \
        const int pt2 = w >> 1, nt2 = w & 1; \
        f32x4 d2 = (f32x4){0.f, 0.f, 0.f, 0.f}, d3 = (f32x4){0.f, 0.f, 0.f, 0.f}; \
        { const bf16x8 vt0 = *(const LAS bf16x8*)(VT + (nt2 * 2 + 0) * 512 + lane * 8), vt1 = *(const LAS bf16x8*)(VT + (nt2 * 2 + 1) * 512 + lane * 8); \
          d2 = __builtin_amdgcn_mfma_f32_16x16x32_bf16(vt0, C##sg0, d2, 0, 0, 0); d2 = __builtin_amdgcn_mfma_f32_16x16x32_bf16(vt1, C##sg1, d2, 0, 0, 0); } \
        *(LAS f32x4*)(O2 + (16 * pt2 + fr) * SC_PLD + 16 * nt2 + 4 * fq) = d2; \
        if (nt2 == 0) { \
            const bf16x8 vt0 = *(const LAS bf16x8*)(VT + 4 * 512 + lane * 8), vt1 = *(const LAS bf16x8*)(VT + 5 * 512 + lane * 8); \
            d3 = __builtin_amdgcn_mfma_f32_16x16x32_bf16(vt0, C##sg0, d3, 0, 0, 0); d3 = __builtin_amdgcn_mfma_f32_16x16x32_bf16(vt1, C##sg1, d3, 0, 0, 0); \
            if (fq == 0) O2[(16 * pt2 + fr) * SC_PLD + 32] = d3[0]; } } \
    LDS_BARRIER();                                                       \
      \
    u32x2 cpr_[8]; float cnq_[8]; \
    _Pragma("unroll") for (int ww = 0; ww < 8; ++ww) { cpr_[ww] = *(const LAS u32x2*)(Pbh + (ww * 64 + cp) * 40 + 4 * ceq); cnq_[ww] = NQs[ww * 64 + cp]; } \
    const f32x4 co2_ = *(const LAS f32x4*)(O2 + cp * SC_PLD + 4 * ceq); const float crs_ = O2[cp * SC_PLD + 32]; \
      \
    if (!(abl_ & 4)) _Pragma("unroll") for (int nt = 0; nt < 3; ++nt) { \
        const bf16x8 vw0 = *(const LAS bf16x8*)(VW + (nt * 2 + 0) * 512 + lane * 8), vw1 = *(const LAS bf16x8*)(VW + (nt * 2 + 1) * 512 + lane * 8); \
        _Pragma("unroll") for (int mt = 0; mt < 4; ++mt) { f32x4 a = st[mt][nt] * C##dec; \
            a = __builtin_amdgcn_mfma_f32_16x16x32_bf16(Kc[mt][0], vw0, a, 0, 0, 0); \
            a = __builtin_amdgcn_mfma_f32_16x16x32_bf16(Kc[mt][1], vw1, a, 0, 0, 0); st[mt][nt] = a; \
            if (nt < 2) SC_LOADK1(Kn, row1, (nt * 4 + mt) >> 1, (nt * 4 + mt) & 1); } } \
    if (!(abl_ & 8)) {     \
        f32x4 o1 = (f32x4){0.f, 0.f, 0.f, 0.f}; float nq = 0.f; \
        _Pragma("unroll") for (int ww = 0; ww < 8; ++ww) { o1 += (f32x4){bflo(cpr_[ww].x), bfhi(cpr_[ww].x), bflo(cpr_[ww].y), bfhi(cpr_[ww].y)}; nq += cnq_[ww]; } \
        const float den = C##wint * nq + crs_; const float scl = __builtin_amdgcn_rcpf(fmaxf(fabsf(den), C##em)); \
        const f32x4 o = (o1 * C##wint + co2_) * scl; \
        u32x2 ow; ow.x = pk2(o[0], o[1]); ow.y = pk2(o[2], o[3]); \
        __builtin_amdgcn_raw_buffer_store_b64(ow, rW, hoff, (rep_ + 1 < SCAN_REP) ? (oC + 512 * DI * 2) : ((hsel == 0 ? oH : (hsel == 1 ? oV : oC)) + (((row0 >> 6) * 4 + hh) * 16 + slice) * 4096), 0); } \
    if (!(abl_ & 16)) SC_VWRITE(buf ^ 1, N);                                     \
} while (0)

__device__ __forceinline__ void scan_phase(LAS unsigned char* lds, unsigned char* ws, int half, const XcdBarrier& bar, int tid, int lane, int wave, int bx) {
    LAS bf16_t* Pbh = (LAS bf16_t*)lds;
    LAS float* NQs = (LAS float*)(lds + 8 * 64 * 40 * 2);
    LAS float* O2 = NQs + 8 * 64; LAS bf16_t* VB = (LAS bf16_t*)(O2 + 64 * SC_PLD);
    const int xcd = bx & 7, idx = bx >> 3;
    const int scn = (xcd * 2 + (idx >> 4)) & 15, slice = idx & 15;
    const int bl = scn >> 3, hh = (scn >> 1) & 3, dir = scn & 1, e0 = slice * 32;
    const int fr = lane & 15, fq = lane >> 4, w = wave;
    const int cp = tid >> 3, ceq = tid & 7;
    const unsigned loff = (unsigned)lane * 16u;
    const unsigned voff = (unsigned)(tid & 255) * 16u;
    const unsigned hoff = (unsigned)(cp * 32 + 4 * ceq) * 2u;
    const unsigned gcp = (unsigned)cp * 4u;
    const unsigned wkoff = (w < 4) ? (unsigned)(32 * ((tid >> 6) & 1) + 8 * ((tid & 63) >> 4)) * 4u : (unsigned)(32 * ((lane >> 2) & 1) + 8 * (lane & 3)) * 4u;
    const __amdgpu_buffer_rsrc_t rW = __builtin_amdgcn_make_buffer_rsrc((void*)ws, 0, (int)(512 * MiB), 0x00020000);
    const int oYH = (int)(WS_YB + ((size_t)CR + (size_t)half * LH) * D * 2);
    const int oQ = (int)(WS_BIG + 3 * SLOT), oK = (int)(WS_BIG + 4 * SLOT), oV = (int)(WS_BIG + 2 * SLOT), oH = (int)(WS_BIG + 0 * SLOT);
    const int oS = oYH, oG = oYH + NCH * 4 * 2 * 8192, oC = oG + NCH * 4 * 2 * 1536;
    for (int i = tid; i < 4 * 1024; i += NTHR) { const int im = i >> 10, r = i & 1023, ln = (r & 511) >> 3; VB[im * 3072 + 2048 + r] = (bf16_t)(((im & 1) == 0 && (ln & 15) == 0) ? 0x3F80u : 0u); }
    __syncthreads();
    for (int rep_ = 0; rep_ < SCAN_REP; ++rep_) {
    const int abl_ = (rep_ + 1 < SCAN_REP) ? SC_ABL : 0;
    f32x4 st[4][3];
#pragma unroll
    for (int a = 0; a < 4; ++a)
#pragma unroll
        for (int b = 0; b < 3; ++b) st[a][b] = (f32x4){0.f, 0.f, 0.f, 0.f};
    bf16x8 Q0[4][2], Q1[4][2], K0[4][2], K1[4][2];
    bf16x8 Asg0, Asg1, Bsg0, Bsg1; u32x4 Av = (u32x4){0u, 0u, 0u, 0u}, Bv = Av, Awka = Av, Awkb = Av, Bwka = Av, Bwkb = Av; float Awint, Aem, Adec, Bwint, Bem, Bdec;
    { const int r0 = SC_ROW0(0); SC_LOADQ(Q0, r0); SC_LOADK(K0, r0); SC_LOADS(A, r0); SC_VWRITE(0, A); }
#pragma unroll 1
    for (int j = 0; j < 132; j += 2) {
        if (j == 68) xcd_barrier(bar, tid == 0);
        SC_STEP(j, Q0, Q1, K0, K1, A, B);
        SC_STEP(j + 1, Q1, Q0, K1, K0, B, A);
    }
    __syncthreads();
    }
}
#undef SC_ROW0
#undef SC_LOADQ
#undef SC_LOADK
#undef SC_LOADS
#undef SC_VWRITE
#undef SC_STEP

typedef const __attribute__((address_space(4))) Args KA;
__device__ __forceinline__ KA* kargs() { KA* k = (KA*)__builtin_amdgcn_kernarg_segment_ptr(); asm volatile("" : "+s"(k)); return k; }
#define PH_BEGIN() \
    KA* ka = kargs(); unsigned char* ws = ka->ws; (void)ws; \
    int wave = wave0; asm volatile("" : "+s"(wave)); \
    unsigned lz_ = 0u; asm volatile("" : "+v"(lz_)); const int lane = (int)__builtin_amdgcn_mbcnt_hi(~0u, __builtin_amdgcn_mbcnt_lo(~0u, lz_)); \
    const int tid = wave * 64 + lane; (void)tid; \
    const int gw = bx * NWAVES + wave, NGW = G * NWAVES; (void)gw; (void)NGW;

__global__ void __launch_bounds__(NTHR, 2) fwd(Args args) {
    extern __shared__ __attribute__((aligned(16))) unsigned char lds_raw[];
    LAS unsigned char* lds = (LAS unsigned char*)lds_raw;
    const int G = gridDim.x, bx = blockIdx.x;
    const int wave0 = __builtin_amdgcn_readfirstlane(threadIdx.x >> 6);
    volatile LAS unsigned* MISC = (volatile LAS unsigned*)(lds + LDS_MISC);
    if (threadIdx.x < 64) MISC[threadIdx.x] = 0u;
    __syncthreads();
    XcdBarrier bar = xcd_barrier_post((unsigned*)(args.ws + WS_CTL + 65536) + (size_t)args.li * 4096, MISC + 8);
    const int lo = args.ph_lo, hi = args.ph_hi, plast = args.ph_last;
#define IN(k) (lo <= (k) && (k) < hi)
#define SEAM(k) do { if ((k) != plast) { xcd_barrier(bar, tid == 0); if (DUP_BAR) xcd_barrier(bar, tid == 0); } } while (0)

    if (EN_PRO && IN(0)) { PH_BEGIN();
        {
            LAS float* sc = (LAS float*)lds;
            for (int i = tid; i < 5 * D; i += NTHR) { const int r = i / D, k = i % D; const float x = r < 4 ? ka->in[I_C][r * D + k] : ka->in[I_CCTX][k]; sc[i] = siluf(x); }
            __syncthreads();
            LAS float* red = (LAS float*)(lds + 32768);
            const int kp = tid >> 6, cc = tid & 63;
            for (int item = bx; item < 4 * 96; item += G) {
                const int layer = item / 96, n0 = (item % 96) * 64;
                const float* w = ka->in[I_ADAW] + (size_t)layer * D * 6 * D + n0 + cc;
                float a0 = 0.f, a1 = 0.f, a2 = 0.f, a3 = 0.f, a4 = 0.f;
                for (int k = kp * 128; k < kp * 128 + 128; ++k) { const float wv = w[(size_t)k * 6 * D]; a0 += sc[k] * wv; a1 += sc[D + k] * wv; a2 += sc[2 * D + k] * wv; a3 += sc[3 * D + k] * wv; a4 += sc[4 * D + k] * wv; }
                red[(kp * 64 + cc) * 5 + 0] = a0; red[(kp * 64 + cc) * 5 + 1] = a1; red[(kp * 64 + cc) * 5 + 2] = a2; red[(kp * 64 + cc) * 5 + 3] = a3; red[(kp * 64 + cc) * 5 + 4] = a4;
                __syncthreads();
                if (tid < 320) { const int c2 = tid % 64, r = tid / 64; float s = ka->in[I_ADAB][layer * 6 * D + n0 + c2];
                    for (int q = 0; q < 8; ++q) s += red[(q * 64 + c2) * 5 + r];
                    MOD[((size_t)layer * 5 + r) * 6 * D + n0 + c2] = s; }
                __syncthreads();
            }
        }
        {
            bf16_t* A1 = (bf16_t*)(ws + TAB_A1); bf16_t* A2 = (bf16_t*)(ws + TAB_A2); bf16_t* BZ = (bf16_t*)(ws + TAB_BZ); bf16_t* ACTX = (bf16_t*)(ws + TAB_ACTX);
            const int gt = bx * NTHR + tid, NGT = G * NTHR;
            const float s8192 = 0.011048543456039806f;
            for (int i = gt; i < 512 * 256; i += NGT) { const int m = i / 256, t1 = i % 256, ri = m / 256, t1p = m % 256; const int ph = (t1 * t1p) & 255; float sn, cs; sincospif((float)ph * (2.0f / 256.0f), &sn, &cs);
                A1[i] = (bf16_t)f2bf((ri == 0 ? cs : -sn) * s8192);
                ACTX[i] = (bf16_t)f2bf((ri == 0 ? cs : -sn) * 0.0625f); }
            for (int i = gt; i < 256 * 64 * 64; i += NGT) { const int t1p = i / 4096, m = (i / 64) % 64, k = i % 64; const int rip = m / 32, t2p = m % 32, ri = k / 32, t2 = k % 32;
                const int ph = (t2 * t1p + 256 * t2 * t2p) & 8191; float sn, cs; sincospif((float)ph * (2.0f / 8192.0f), &sn, &cs);
                const float v = (rip == ri) ? cs : (rip == 0 ? sn : -sn); A2[i] = (bf16_t)f2bf(v); }
            for (int i = gt; i < 256 * 512; i += NGT) { const int cp = i / 512, k = i % 512, ri = k / 256, c = k % 256; const int ph = (c * cp) & 255; float sn, cs; sincospif((float)ph * (2.0f / 256.0f), &sn, &cs);
                BZ[i] = (bf16_t)f2bf((ri == 0 ? cs : sn) * 0.0625f); }
        }
        SEAM(0);
    }
    if (EN_PRO && IN(1)) { PH_BEGIN();
        for (int r = gw; r < R; r += NGW) {
            const RowInfo ri = row_info(r);
            const float* xr = ri.is_ctx ? ka->in[I_CTX] + ((size_t)ri.b * CT + ri.t) * D : ka->in[I_X] + ((size_t)ri.b * T + ri.t) * D;
            const float* md = MOD + ((size_t)0 * 5 + (ri.is_ctx ? 4 : ri.b)) * 6 * D;
            f32x4 v[4];
#pragma unroll
            for (int j = 0; j < 4; ++j) v[j] = *(const f32x4*)(xr + 256 * j + 4 * lane);
            ln_norm(v, lane);
            bf16_t* o = HIN + (size_t)r * D;
#pragma unroll
            for (int j = 0; j < 4; ++j) { const f32x4 sh = *(const f32x4*)(md + 256 * j + 4 * lane), sc = *(const f32x4*)(md + D + 256 * j + 4 * lane);
                const f32x4 h = v[j] * (1.0f + sc) + sh; u32x2 w; w.x = pk2(h[0], h[1]); w.y = pk2(h[2], h[3]); *(u32x2*)(o + 256 * j + 4 * lane) = w; }
        }
        SEAM(1);
    }

    for (int layer = 0; layer < 4; ++layer) {
        const int pb = 2 + layer * PL;
        if (hi <= pb || lo >= pb + PL) continue;
        const int jl = layer >> 1;
        const bool is_m = (layer & 1) == 0;
        if (EN_WC && IN(pb + 0)) { PH_BEGIN();
 for (int rp_ = 0; rp_ < REPN(5); ++rp_) {
            LAS float* scr = (LAS float*)(lds + wave * 16384);
            const int i_in = (D / 64) * (2 * DI / 32), i_h = (DH / 64) * (DH / 32), i_out = (DI / 64) * (D / 32), i_f = (D / 64) * (D / 32), i_1 = (D / 64) * (DFF / 32), i_2 = (DFF / 64) * (D / 32);
            const int n_mix = is_m ? (i_in + 12 * i_h + i_out) : i_f;
            const int nitems = n_mix + i_1 + i_2;
            for (int it = gw; it < nitems; it += NGW) {
                int r = it;
                if (r >= n_mix) { r -= n_mix;
                    if (r < i_1) transpose_item(ka->in[I_W1] + (size_t)layer * D * DFF, D, DFF, W1, 1.f, scr, r, lane);
                    else transpose_item(ka->in[I_W2] + (size_t)layer * DFF * D, DFF, D, W2, 1.f, scr, r - i_1, lane);
                    continue; }
                if (!is_m) { transpose_item(ka->in[I_FWOUT] + (size_t)jl * D * D, D, D, WOUT, 1.f, scr, r, lane); continue; }
                if (r < i_in) { transpose_item(ka->in[I_WIN] + (size_t)jl * D * 2 * DI, D, 2 * DI, WIN, 1.f, scr, r, lane); continue; } r -= i_in;
                if (r < 12 * i_h) { const int which = r / (4 * i_h), hh = (r / i_h) % 4, rr = r % i_h;
                    const float* src = ka->in[which == 0 ? I_WQ : (which == 1 ? I_WK : I_WV)] + ((size_t)jl * NH + hh) * DH * DH;
                    bf16_t* dst = (which == 0 ? WQ : (which == 1 ? WK : WV)) + (size_t)hh * DH * DH;
                    transpose_item(src, DH, DH, dst, which == 1 ? 0.044194173824159216f : 1.f, scr, rr, lane); continue; } r -= 12 * i_h;
                transpose_item(ka->in[I_WOUT] + (size_t)jl * DI * D, DI, D, WOUT, 1.f, scr, r, lane);
            }
            if (is_m) {
                const float* wg = ka->in[I_WGATE] + (size_t)jl * 3 * DI * 16;
                const int n = lane & 15, eq = lane >> 4;
                for (int k2 = gw; k2 < DI; k2 += NGW) {
                    const int hh = k2 / DH, d = k2 % DH;
                    const float* q = ka->in[I_WQ] + (((size_t)jl * NH + hh) * DH + d) * DH + eq * 128; const float* kx = ka->in[I_WK] + (((size_t)jl * NH + hh) * DH + d) * DH + eq * 128;
                    const float* vx = ka->in[I_WV] + (((size_t)jl * NH + hh) * DH + d) * DH + eq * 128;
                    const float* g0 = wg + ((size_t)0 * DI + hh * DH + eq * 128) * 16 + n; const float* g1 = wg + ((size_t)1 * DI + hh * DH + eq * 128) * 16 + n; const float* g2 = wg + ((size_t)2 * DI + hh * DH + eq * 128) * 16 + n;
                    float s0 = 0.f, s1 = 0.f, s2 = 0.f;
#pragma unroll 8
                    for (int e = 0; e < 128; ++e) { s0 += q[e] * g0[e * 16]; s1 += kx[e] * g1[e * 16]; s2 += vx[e] * g2[e * 16]; }
                    float sa = s0 + 0.044194173824159216f * s1;
                    sa += shx(sa, 16, lane); sa += shx(sa, 32, lane); s2 += shx(s2, 16, lane); s2 += shx(s2, 32, lane);
                    if (lane < 16) { GATET[(size_t)n * 4096 + k2] = (bf16_t)f2bf(sa); GATET[(size_t)n * 4096 + DI + k2] = (bf16_t)f2bf(s2); }
                    else if (lane < 64) { GATET[(size_t)(16 + (lane - 16)) * 4096 + k2] = (bf16_t)0; GATET[(size_t)(16 + (lane - 16)) * 4096 + DI + k2] = (bf16_t)0; }
                }
            }
 }
            SEAM(pb + 0);
        }

        if (EN_MIX && is_m) {
            for (int half = 0; half < 2; ++half) {
                const int hb = pb + 1 + 9 * half;
                if (hi <= hb || lo >= hb + 9) continue;
                if (IN(hb + 0)) { PH_BEGIN();
 for (int rp_ = 0; rp_ < REPN(0); ++rp_) {
                    pg8::Gemm g{HH, WIN, D, D, D, 0, 0, LH / 256, DI / 256, 1};
                    pg8::EpiStore E{S0 + (size_t)LAT0 * DI, 0, DI, 0};
                    pg8::gemm_phase(lds, g, E, G, bx, tid); if (DUP_MIX) pg8::gemm_phase(lds, g, E, G, bx, tid);
                    { SmallGemm sg{HHC, WIN, D, D, D, D, D, 0, 0}; SmallDense sd{S0, 0, DI, LAT0 / 64, DI / 64, 0, 0, 0}; gemm_small_dense(lds, sg, sd, 1, G, bx, tid); if (DUP_CTX) gemm_small_dense(lds, sg, sd, 1, G, bx, tid); }
 }
                    SEAM(hb + 0);
                }
                if (IN(hb + 1)) { PH_BEGIN();
 for (int rp_ = 0; rp_ < REPN(3); ++rp_) {
                    const float* wc = ka->in[I_WCONV] + (size_t)jl * 9 * DI; const float* bc = ka->in[I_BCONV] + (size_t)jl * DI;
                    const int gt = bx * NTHR + tid, NGT = G * NTHR;
                    for (int i = gt; i < 2 * 128 * 2 * (DI / 8); i += NGT) {
                        const int cg = i & 255, rest = i >> 8, hr = rest & 1, r = (rest >> 1) & 127, bl = rest >> 8, c0 = cg * 8, gc0 = 32 * hr;
                        float wv[9][8], bv[8];
#pragma unroll
                        for (int tp = 0; tp < 9; ++tp) { const f32x4 a0 = *(const f32x4*)(wc + (size_t)tp * DI + c0), a1 = *(const f32x4*)(wc + (size_t)tp * DI + c0 + 4);
                            wv[tp][0] = a0[0]; wv[tp][1] = a0[1]; wv[tp][2] = a0[2]; wv[tp][3] = a0[3]; wv[tp][4] = a1[0]; wv[tp][5] = a1[1]; wv[tp][6] = a1[2]; wv[tp][7] = a1[3]; }
                        { const f32x4 a0 = *(const f32x4*)(bc + c0), a1 = *(const f32x4*)(bc + c0 + 4); bv[0] = a0[0]; bv[1] = a0[1]; bv[2] = a0[2]; bv[3] = a0[3]; bv[4] = a1[0]; bv[5] = a1[1]; bv[6] = a1[2]; bv[7] = a1[3]; }
                        const bf16_t* xb = S0 + (size_t)(LAT0 + bl * T + r * 64) * DI + c0;
                        bf16_t* ob = S1 + (size_t)(LAT0 + bl * T + r * 64) * DI + c0;
                        const bool rok[3] = {r > 0, true, r < 127};
                        float win[3][3][8];
#define CV_LOADCOL(slot, col) do { _Pragma("unroll") for (int di = 0; di < 3; ++di) { u32x4 xv = (u32x4){0u, 0u, 0u, 0u}; \
                                if (rok[di] && (col) >= 0 && (col) < 64) xv = *(const u32x4*)(xb + (ptrdiff_t)((di - 1) * 64 + (col)) * DI); \
                                win[slot][di][0] = bflo(xv.x); win[slot][di][1] = bfhi(xv.x); win[slot][di][2] = bflo(xv.y); win[slot][di][3] = bfhi(xv.y); \
                                win[slot][di][4] = bflo(xv.z); win[slot][di][5] = bfhi(xv.z); win[slot][di][6] = bflo(xv.w); win[slot][di][7] = bfhi(xv.w); } } while (0)
#define CV_STEP(sl, sm, sr) do { CV_LOADCOL(sr, gc + 1); \
                                if (gc < gc0 + 32) { float acc[8]; \
                                    _Pragma("unroll") for (int e = 0; e < 8; ++e) { float s = bv[e]; \
                                        _Pragma("unroll") for (int di = 0; di < 3; ++di) s += win[sl][di][e] * wv[di * 3 + 0][e] + win[sm][di][e] * wv[di * 3 + 1][e] + win[sr][di][e] * wv[di * 3 + 2][e]; \
                                        acc[e] = siluf(s); } \
                                    u32x4 o; o.x = pk2(acc[0], acc[1]); o.y = pk2(acc[2], acc[3]); o.z = pk2(acc[4], acc[5]); o.w = pk2(acc[6], acc[7]); \
                                    *(u32x4*)(ob + (size_t)gc * DI) = o; } \
                                ++gc; } while (0)
                        int gc = gc0;
                        CV_LOADCOL(0, gc0 - 1); CV_LOADCOL(1, gc0);
#pragma unroll 1
                        for (int g3 = 0; g3 < 11; ++g3) { CV_STEP(0, 1, 2); CV_STEP(1, 2, 0); CV_STEP(2, 0, 1); }
#undef CV_LOADCOL
#undef CV_STEP
                    }
                    for (int i = gt; i < LAT0 * (DI / 8); i += NGT) {
                        const int q = i / (DI / 8), c0 = (i % (DI / 8)) * 8, t = q % CT;
                        float acc[8];
#pragma unroll
                        for (int e = 0; e < 8; ++e) acc[e] = bc[c0 + e];
#pragma unroll
                        for (int dj = 0; dj < 3; ++dj) { const int tt = t + dj - 1; if (tt < 0 || tt >= CT) continue;
                            const u32x4 xv = *(const u32x4*)(S0 + (size_t)(q + dj - 1) * DI + c0); const float* w = wc + (size_t)(3 + dj) * DI + c0;
                            acc[0] += bflo(xv.x) * w[0]; acc[1] += bfhi(xv.x) * w[1]; acc[2] += bflo(xv.y) * w[2]; acc[3] += bfhi(xv.y) * w[3];
                            acc[4] += bflo(xv.z) * w[4]; acc[5] += bfhi(xv.z) * w[5]; acc[6] += bflo(xv.w) * w[6]; acc[7] += bfhi(xv.w) * w[7]; }
                        u32x4 o; o.x = pk2(siluf(acc[0]), siluf(acc[1])); o.y = pk2(siluf(acc[2]), siluf(acc[3])); o.z = pk2(siluf(acc[4]), siluf(acc[5])); o.w = pk2(siluf(acc[6]), siluf(acc[7]));
                        *(u32x4*)(S1 + (size_t)q * DI + c0) = o;
                    }
 }
                    SEAM(hb + 1);
                }
                if (IN(hb + 2)) { PH_BEGIN();
 for (int rp_ = 0; rp_ < REPN(0); ++rp_) {
                    { pg8::Gemm g{WV, S0 + (size_t)LAT0 * DI, DH, DI, DH, (long)DH * DH, DH, DH / 256, LH / 256, NH};
                      pg8::EpiStore E{S2, 0, 0, 0, 3, LAT0};
                      pg8::gemm_phase(lds, g, E, G, bx, tid); if (DUP_MIX) pg8::gemm_phase(lds, g, E, G, bx, tid); }
                    { SmallGemm sg{WV, S0, DH, DI, DH, DH, DH, 0, 0}; SmallDense sd{S2, 0, 0, DH / 64, LAT0 / 64, 0, (long)DH * DH, DH, 3}; gemm_small_dense(lds, sg, sd, NH, G, bx, tid); if (DUP_CTX) gemm_small_dense(lds, sg, sd, NH, G, bx, tid); }
                    {
                      SmallGemm sg{S1, GATET, DI, 4096, 1024, 1024, 1024, 0, 0};
                      const long xm_off = (long)(S0 - S1);
                      auto dec = [=](int uq, long& ao, long& bo) { const int u = uq >> 2, q = uq & 3; ao = (long)u * 64 * DI + (q & 1) * 1024 + (q >> 1) * xm_off; bo = q * 1024; };
                      auto epi = [=](int uq, int m, int n, const f32x4& v) { const int u = uq >> 2, q = uq & 3; if (n < 16) *(f32x4*)(PREQ + (size_t)q * RH * 16 + ((size_t)u * 64 + m) * 16 + n) = v; };
                      gemm_small(lds, sg, NCH * 4, dec, epi, G, bx, tid); }
 }
                    SEAM(hb + 2);
                }
                if (IN(hb + 3)) { PH_BEGIN();
 for (int rp_ = 0; rp_ < REPN(0); ++rp_) {
                    { pg8::Gemm g{S1 + (size_t)LAT0 * DI, WQ, DI, DH, DH, DH, (long)DH * DH, LH / 256, DH / 256, NH}; pg8::EpiStore E{S3, DH, DI, 0, 1, LAT0}; pg8::gemm_phase(lds, g, E, G, bx, tid); if (DUP_MIX) pg8::gemm_phase(lds, g, E, G, bx, tid); }
                    { SmallGemm sg{S1, WQ, DI, DH, DH, DH, DH, 0, 0}; SmallDense sd{S3, DH, DI, LAT0 / 64, DH / 64, 0, DH, (long)DH * DH, 1}; gemm_small_dense(lds, sg, sd, NH, G, bx, tid); if (DUP_CTX) gemm_small_dense(lds, sg, sd, NH, G, bx, tid); }
                    { pg8::Gemm g{S1 + (size_t)LAT0 * DI, WK, DI, DH, DH, DH, (long)DH * DH, LH / 256, DH / 256, NH}; pg8::EpiStore E{S0 + (size_t)LAT0 * DI, DH, DI, 0}; pg8::gemm_phase(lds, g, E, G, bx, tid); if (DUP_MIX) pg8::gemm_phase(lds, g, E, G, bx, tid); }
                    { SmallGemm sg{S1, WK, DI, DH, DH, DH, DH, 0, 0}; SmallDense sd{S0, DH, DI, LAT0 / 64, DH / 64, 0, DH, (long)DH * DH}; gemm_small_dense(lds, sg, sd, NH, G, bx, tid); if (DUP_CTX) gemm_small_dense(lds, sg, sd, NH, G, bx, tid); }
                    { pg8::Gemm g{WK, S1 + (size_t)LAT0 * DI, DH, DI, DH, (long)DH * DH, DH, DH / 256, LH / 256, NH}; pg8::EpiStore E{S4, (long)DH * RH, RH, 0, 2, LAT0}; pg8::gemm_phase(lds, g, E, G, bx, tid); if (DUP_MIX) pg8::gemm_phase(lds, g, E, G, bx, tid); }
                    { SmallGemm sg{WK, S1, DH, DI, DH, DH, DH, 0, 0}; SmallDense sd{S4, (long)DH * RH, RH, DH / 64, LAT0 / 64, 0, (long)DH * DH, DH, 2}; gemm_small_dense(lds, sg, sd, NH, G, bx, tid); if (DUP_CTX) gemm_small_dense(lds, sg, sd, NH, G, bx, tid); }
                    if (bx < 16) {
                        const int sc = bx, bl = sc >> 3, hh = (sc >> 1) & 3, dir = sc & 1;
                        LAS float* bcs = (LAS float*)lds;
                        LAS float* vss = bcs + 132 * 64;
                        LAS float* bl_ = vss + 132 * 64;
                        LAS float* vm_ = bl_ + 132;
                        LAS float* mi_ = vm_ + 132;
                        const int u = lane, p = dir ? 63 - u : u;
                        const float* bgp = ka->in[I_BGATE] + (size_t)jl * 16 + 8 * dir + hh;
#pragma unroll
                        for (int i = 0; i < 17; ++i) { const int j = wave + 8 * i;
                            if (j < 132) { int row0; if (j < 4) { const int c = dir ? 3 - j : j; row0 = bl * CT + c * 64; } else { const int c = dir ? 127 - (j - 4) : (j - 4); row0 = LAT0 + bl * T + c * 64; }
                                const float* pr = PREQ + (size_t)(row0 + p) * 16 + 8 * dir + hh; const size_t qs = (size_t)RH * 16;
                                bcs[j * 64 + p] = (pr[4] + pr[qs + 4]) + (pr[2 * qs + 4] + pr[3 * qs + 4]) + bgp[4]; vss[j * 64 + p] = (pr[0] + pr[qs]) + (pr[2 * qs] + pr[3 * qs]) + bgp[0]; } }
                        asm volatile("s_waitcnt vmcnt(0) lgkmcnt(0)" ::: "memory");
#pragma unroll 1
                        for (int i = 0; i < 17; ++i) { const int j = wave + 8 * i;
                            if (j < 132) { const float f = bcs[j * 64 + p], lia = vss[j * 64 + p]; float x = fminf(f, 0.f) - log1pf(__expf(-fabsf(f)));
                                x = scan_add64(x);
                                const float v = lia - x; float pm = v;
                                pm = scan_max64(pm);
                                bcs[j * 64 + p] = x; vss[j * 64 + p] = v; if (u == 63) { bl_[j] = x; vm_[j] = pm; } } }
                        __syncthreads();
                        if (wave == 0) {
                            const float ni = -__builtin_inff();
                            float ea[3], eb[3];
#pragma unroll
                            for (int t = 0; t < 3; ++t) { const int j = 3 * lane + t; const bool ok = j < 132; const float blj = bl_[ok ? j : 0], vmj = vm_[ok ? j : 0]; ea[t] = ok ? blj : 0.f; eb[t] = ok ? blj + vmj : ni; }
                            float A = ea[0] + ea[1], B = fmaxf(eb[0] + ea[1], eb[1]); B = fmaxf(B + ea[2], eb[2]); A += ea[2];
#define G12_STEP(CTRL, RM) do { const float pa_ = dppf<CTRL, RM>(0.f, A), pb_ = dppf<CTRL, RM>(ni, B); B = fmaxf(pb_ + A, B); A += pa_; } while (0)
                            G12_STEP(0x111, 0xF); G12_STEP(0x112, 0xF); G12_STEP(0x114, 0xF); G12_STEP(0x118, 0xF); G12_STEP(0x142, 0xA); G12_STEP(0x143, 0xC);
#undef G12_STEP
                            float EA = shup(A, 1, lane), EB = shup(B, 1, lane); if (lane == 0) { EA = 0.f; EB = ni; }
                            float m = fmaxf(EA, EB);
#pragma unroll
                            for (int t = 0; t < 3; ++t) { const int j = 3 * lane + t; if (j < 132) { mi_[j] = m; m = fmaxf(m + ea[t], eb[t]); } }
                        }
                        __syncthreads();
                        float* GPw = (float*)(YH + (size_t)NCH * 4 * 2 * 4096);
#pragma unroll 1
                        for (int i = 0; i < 17; ++i) { const int j = wave + 8 * i;
                            if (j < 132) { int row0; if (j < 4) { const int c = dir ? 3 - j : j; row0 = bl * CT + c * 64; } else { const int c = dir ? 127 - (j - 4) : (j - 4); row0 = LAT0 + bl * T + c * 64; }
                                const float bc = bcs[j * 64 + p], v = vss[j * 64 + p]; float pm = v;
                                pm = scan_max64(pm);
                                const float m_in = mi_[j], btot = bl_[j], m_new = btot + fmaxf(m_in, vm_[j]);
                                const float uu = -fmaxf(m_in, pm);
                                float* gp = GPw + ((size_t)((row0 >> 6) * 4 + hh) * 2 + dir) * 384;
                                gp[p] = uu; gp[64 + p] = v; gp[128 + p] = __expf(m_in + uu); gp[192 + p] = __expf(uu - bc); gp[256 + p] = __expf(btot - m_new + v);
                                if (u == 0) gp[320] = __expf(btot + m_in - m_new); } }
                    }
 }
                    SEAM(hb + 3);
                }
                if (IN(hb + 4)) { PH_BEGIN();
 for (int rp_ = 0; rp_ < REPN(4); ++rp_) {
                    SmallGemm sg{S3, S0, DI, DI, DH, DH, DH, 0, 0, 1};
                    bf16_t* SGw = YH; const float* GPr = (const float*)(YH + (size_t)NCH * 4 * 2 * 4096);
                    auto dec = [=](int u, long& ao, long& bo) { const int ch = u >> 2, hh = u & 3; ao = u; bo = (long)ch * 64 * DI + hh * DH; };
                    auto epi = [=](int u, int m, int n, const f32x4& v) {
#pragma unroll
                        for (int dir = 0; dir < 2; ++dir) { const float* gp = GPr + ((size_t)u * 2 + dir) * 384; const float up = gp[m]; const f32x4 vs = *(const f32x4*)(gp + 64 + n); float o[4];
#pragma unroll
                            for (int i = 0; i < 4; ++i) { const int s = n + i; const bool ok = dir ? (s >= m) : (s <= m); const float gte = ok ? __expf(up + vs[i]) : 0.f; o[i] = v[i] * gte; }
                            u32x2 w; w.x = pk2(o[0], o[1]); w.y = pk2(o[2], o[3]);
                            *(u32x2*)(SGw + ((size_t)u * 2 + dir) * 4096 + ((m >> 4) * 2 + (n >> 5)) * 512 + (((n >> 3) & 3) * 16 + (m & 15)) * 8 + (n & 7)) = w; } };
                    gemm_small(lds, sg, NCH * 4, dec, epi, G, bx, tid);
 }
                    SEAM(hb + 4);
                }
                if (EN_SCAN && IN(hb + 5)) { PH_BEGIN();
                    scan_phase(lds, ws, half, bar, tid, lane, wave, bx);
                    SEAM(hb + 5);
                }
                if (IN(hb + 6)) { PH_BEGIN();
 for (int rp_ = 0; rp_ < REPN(0); ++rp_) {
                    pg8::Gemm g{HH, WIN + (size_t)DI * D, D, D, D, 0, 0, LH / 256, DI / 256, 1};
                    pg8::EpiStore E{S3 + (size_t)LAT0 * DI, 0, DI, 0};
                    pg8::gemm_phase(lds, g, E, G, bx, tid); if (DUP_MIX) pg8::gemm_phase(lds, g, E, G, bx, tid);
                    if (layer < 2) { SmallGemm sg{HHC, WIN + (size_t)DI * D, D, D, D, D, D, 0, 0}; SmallDense sd{S3, 0, DI, LAT0 / 64, DI / 64, 0, 0, 0}; gemm_small_dense(lds, sg, sd, 1, G, bx, tid); if (DUP_CTX) gemm_small_dense(lds, sg, sd, 1, G, bx, tid); }
 }
                    SEAM(hb + 6);
                }
                if (IN(hb + 7)) { PH_BEGIN();
 for (int rp_ = 0; rp_ < REPN(3); ++rp_) {
                    const float* gn = ka->in[I_GNW] + (size_t)jl * DI; const float* sk = ka->in[I_SKIP] + (size_t)jl * DI;
#define RO_LOAD(q_, A, B, XC, ZZ) do { const bf16_t* h2_ = ((q_) < LAT0) ? HCB : S2; \
                        _Pragma("unroll") for (int hd = 0; hd < 4; ++hd) { const size_t ho_ = htile_off(q_, hd, 8 * lane); const size_t ro_ = (size_t)(q_) * DI + hd * DH + 8 * lane; \
                            A[hd] = *(const u32x4*)(S0 + ho_); B[hd] = *(const u32x4*)(h2_ + ho_); XC[hd] = *(const u32x4*)(S1 + ro_); ZZ[hd] = *(const u32x4*)(S3 + ro_); } } while (0)
                    u32x4 ra[4], rb[4], rx[4], rz[4], na[4], nb[4], nx[4], nz[4];
#pragma unroll
                    for (int hd = 0; hd < 4; ++hd) { ra[hd] = (u32x4){0u, 0u, 0u, 0u}; rb[hd] = ra[hd]; rx[hd] = ra[hd]; rz[hd] = ra[hd]; na[hd] = ra[hd]; nb[hd] = ra[hd]; nx[hd] = ra[hd]; nz[hd] = ra[hd]; }
                    const int q_first = (layer < 2 ? 0 : LAT0) + gw;
                    if (q_first < RH) RO_LOAD(q_first, ra, rb, rx, rz);
                    for (int q = q_first; q < RH; q += NGW) {
                        if (q + NGW < RH) RO_LOAD(q + NGW, na, nb, nx, nz);
#pragma unroll
                        for (int hd = 0; hd < 4; ++hd) {
                            const int c0 = hd * DH + 8 * lane;
                            const u32x4 a = ra[hd], b = rb[hd];
                            float v[8] = {bflo(a.x) + bflo(b.x), bfhi(a.x) + bfhi(b.x), bflo(a.y) + bflo(b.y), bfhi(a.y) + bfhi(b.y), bflo(a.z) + bflo(b.z), bfhi(a.z) + bfhi(b.z), bflo(a.w) + bflo(b.w), bfhi(a.w) + bfhi(b.w)};
                            float s = 0.f;
#pragma unroll
                            for (int i = 0; i < 8; ++i) s += v[i];
                            const float mean = wave_sum(s, lane) * (1.f / DH); float s2 = 0.f;
#pragma unroll
                            for (int i = 0; i < 8; ++i) { v[i] -= mean; s2 += v[i] * v[i]; }
                            const float rstd = __builtin_amdgcn_rsqf(wave_sum(s2, lane) * (1.f / DH) + LN_EPS);
                            const u32x4 xc = rx[hd], zz = rz[hd];
                            const float xcf[8] = {bflo(xc.x), bfhi(xc.x), bflo(xc.y), bfhi(xc.y), bflo(xc.z), bfhi(xc.z), bflo(xc.w), bfhi(xc.w)};
                            const float zf[8] = {bflo(zz.x), bfhi(zz.x), bflo(zz.y), bfhi(zz.y), bflo(zz.z), bfhi(zz.z), bflo(zz.w), bfhi(zz.w)};
                            float o[8];
#pragma unroll
                            for (int i = 0; i < 8; ++i) o[i] = (v[i] * rstd * gn[c0 + i] + sk[c0 + i] * xcf[i]) * siluf(zf[i]);
                            u32x4 w; w.x = pk2(o[0], o[1]); w.y = pk2(o[2], o[3]); w.z = pk2(o[4], o[5]); w.w = pk2(o[6], o[7]);
                            *(u32x4*)(S4 + (size_t)q * DI + c0) = w;
                        }
#pragma unroll
                        for (int hd = 0; hd < 4; ++hd) { ra[hd] = na[hd]; rb[hd] = nb[hd]; rx[hd] = nx[hd]; rz[hd] = nz[hd]; }
                    }
#undef RO_LOAD
 }
                    SEAM(hb + 7);
                }
                if (IN(hb + 8)) { PH_BEGIN();
 for (int rp_ = 0; rp_ < REPN(0); ++rp_) {
                    pg8::Gemm g{S4 + (size_t)LAT0 * DI, WOUT, DI, DI, DI, 0, 0, LH / 256, D / 256, 1};
                    pg8::EpiStore E{YH, 0, D, 0};
                    pg8::gemm_phase(lds, g, E, G, bx, tid); if (DUP_MIX) pg8::gemm_phase(lds, g, E, G, bx, tid);
                    if (layer < 2) { SmallGemm sg{S4, WOUT, DI, DI, DI, DI, DI, 0, 0}; SmallDense sd{YHC, 0, D, LAT0 / 64, D / 64, 0, 0, 0}; gemm_small_dense(lds, sg, sd, 1, G, bx, tid); if (DUP_CTX) gemm_small_dense(lds, sg, sd, 1, G, bx, tid); }
 }
                    SEAM(hb + 8);
                }
            }
        } else if (EN_FOUR) {
            const bool has_ctx = layer < 3;
            if (IN(pb + 2)) { PH_BEGIN();
 for (int rp_ = 0; rp_ < REPN(2); ++rp_) {
                { pg8::Gemm g{(const bf16_t*)(ws + TAB_A1), HT, 256, 256, 256, 0, (long)D * T, 2, 128, NB};
                  pg8::EpiStore E{PB, (long)512 * 32768, 32768, 0};
                  pg8::gemm_phase(lds, g, E, G, bx, tid); if (DUP_MIX) pg8::gemm_phase(lds, g, E, G, bx, tid); }
                if (has_ctx) {
                    SmallGemm sg{(const bf16_t*)(ws + TAB_ACTX), HTC, 256, 256, 256, 256, 256, 0, 0};
                    auto dec = [=](int u, long& ao, long& bo) { const int b = u / 128, mb = (u / 16) % 8, cht = u % 16; ao = (long)mb * 64 * 256; bo = ((long)b * D + cht * 64) * CT; };
                    auto epi = [=](int u, int m, int n, const f32x4& v) { const int b = u / 128, mb = (u / 16) % 8, cht = u % 16; const int mg = mb * 64 + m, ri = mg >> 8, tp = mg & 255, ch = cht * 64 + n;
                        u32x2 w; w.x = pk2(v[0], v[1]); w.y = pk2(v[2], v[3]); *(u32x2*)(WC + (size_t)ctx_row(b, tp) * DI + (ch >> 8) * 512 + ri * 256 + (ch & 255)) = w; };
                    gemm_small(lds, sg, NB * 8 * 16, dec, epi, G, bx, tid);
                }
 }
                SEAM(pb + 2);
            }
            if (IN(pb + 3)) { PH_BEGIN();
 for (int rp_ = 0; rp_ < REPN(2); ++rp_) {
                {
                    const int wid = tid >> 6, wm = wid >> 1, wn = wid & 1, fr = lane & 15, fq = lane >> 4;
                    const int lrow = tid >> 3, lk = (tid & 7) * 8;
                    const unsigned stoff = (unsigned)(lrow * SG_LD + lk) * 2u;
                    LAS unsigned char* As = lds; LAS unsigned char* Bs0 = lds + SG_TILE; LAS unsigned char* Bs1 = lds + 2 * SG_TILE;
                    const bf16_t* A2 = (const bf16_t*)(ws + TAB_A2);
                    for (int pair = bx; pair < NB * 256; pair += G) {
                        const int b = pair >> 8, t1p = pair & 255;
                        const bf16_t* bp = PB + (size_t)b * 512 * 32768 + (size_t)((lk >> 5) * 256 + t1p) * 32768 + (size_t)lrow * 32 + (lk & 31);
                        u32x4 r0 = *(const u32x4*)(bp), r1 = *(const u32x4*)(bp + 2048), r2 = *(const u32x4*)(bp + 2 * 2048), r3 = *(const u32x4*)(bp + 3 * 2048);
                        *(LAS u32x4*)(As + stoff) = *(const u32x4*)(A2 + (size_t)t1p * 4096 + lrow * 64 + lk);
                        *(LAS u32x4*)(Bs0 + stoff) = r0;
                        LDS_BARRIER();
                        bf16x8 af[2];
#pragma unroll
                        for (int ks = 0; ks < 2; ++ks) af[ks] = *(const LAS bf16x8*)(As + ((wm * 16 + fr) * SG_LD + ks * 32 + fq * 8) * 2);
#define F2_TILE(ct_, BsC, BsN, rcur, rnext) do { \
                            if ((ct_) + 4 < 16) rcur = *(const u32x4*)(bp + ((ct_) + 4) * 2048); \
                            f32x4 acc[2] = {(f32x4){0.f, 0.f, 0.f, 0.f}, (f32x4){0.f, 0.f, 0.f, 0.f}}; \
                            _Pragma("unroll") for (int ks = 0; ks < 2; ++ks) _Pragma("unroll") for (int nt = 0; nt < 2; ++nt) { \
                                const bf16x8 bf = *(const LAS bf16x8*)(BsC + ((wn * 32 + nt * 16 + fr) * SG_LD + ks * 32 + fq * 8) * 2); \
                                acc[nt] = __builtin_amdgcn_mfma_f32_16x16x32_bf16(bf, af[ks], acc[nt], 0, 0, 0); } \
                            if ((ct_) + 1 < 16) *(LAS u32x4*)(BsN + stoff) = rnext; \
                            _Pragma("unroll") for (int nt = 0; nt < 2; ++nt) { const int m = wm * 16 + fr, n = wn * 32 + nt * 16 + fq * 4, rip = m >> 5, t2p = m & 31, ch = (ct_) * 64 + n; \
                                u32x2 w2; w2.x = pk2(acc[nt][0], acc[nt][1]); w2.y = pk2(acc[nt][2], acc[nt][3]); \
                                *(u32x2*)(WC + (size_t)lat_row(b, t1p + 256 * t2p) * DI + (ch >> 8) * 512 + rip * 256 + (ch & 255)) = w2; } \
                            LDS_BARRIER(); } while (0)
#pragma unroll 1
                        for (int ct = 0; ct < 16; ct += 4) { F2_TILE(ct, Bs0, Bs1, r0, r1); F2_TILE(ct + 1, Bs1, Bs0, r1, r2); F2_TILE(ct + 2, Bs0, Bs1, r2, r3); F2_TILE(ct + 3, Bs1, Bs0, r3, r0); }
#undef F2_TILE
                    }
                }
 }
                SEAM(pb + 3);
            }
            if (IN(pb + 4)) { PH_BEGIN();
 for (int rp_ = 0; rp_ < REPN(2); ++rp_) {
                pg8::Gemm g{WC + (size_t)CR * DI, (const bf16_t*)(ws + TAB_BZ), DI, 512, 512, 512, 0, (R - CR) / 256, 1, 4};
                pg8::EpiStore E{ZF + (size_t)CR * D, 256, D, 0};
                pg8::gemm_phase(lds, g, E, G, bx, tid); if (DUP_MIX) pg8::gemm_phase(lds, g, E, G, bx, tid);
                if (has_ctx) { SmallGemm sg{WC, (const bf16_t*)(ws + TAB_BZ), DI, 512, 512, 512, 512, 0, 0}; SmallDense sd{ZF, 256, D, CR / 64, 256 / 64, 0, 512, 0}; gemm_small_dense(lds, sg, sd, 4, G, bx, tid); if (DUP_CTX) gemm_small_dense(lds, sg, sd, 4, G, bx, tid); }
 }
                SEAM(pb + 4);
            }
            if (IN(pb + 5)) { PH_BEGIN();
 for (int rp_ = 0; rp_ < REPN(2); ++rp_) {
                pg8::Gemm g{ZF + (size_t)CR * D, WOUT, D, D, D, 0, 0, (R - CR) / 256, D / 256, 1};
                pg8::EpiStore E{YB + (size_t)CR * D, 0, D, 0};
                pg8::gemm_phase(lds, g, E, G, bx, tid); if (DUP_MIX) pg8::gemm_phase(lds, g, E, G, bx, tid);
                if (has_ctx) { SmallGemm sg{ZF, WOUT, D, D, D, D, D, 0, 0}; SmallDense sd{YB, 0, D, CR / 64, D / 64, 0, 0, 0}; gemm_small_dense(lds, sg, sd, 1, G, bx, tid); if (DUP_CTX) gemm_small_dense(lds, sg, sd, 1, G, bx, tid); }
 }
                SEAM(pb + 5);
            }
        }
#pragma unroll 1
        for (int which = 0; which < 2; ++which) {
            const int pid = pb + (which == 0 ? 19 : 22);
            if (EN_NORM && IN(pid)) { PH_BEGIN();
                const float* pg = ka->in[I_PG] + ((size_t)layer * 2 + which) * D; const float* pbv = ka->in[I_PB] + ((size_t)layer * 2 + which) * D;
                const int mlayer = which == 0 ? layer : layer + 1;
                const int shoff = which == 0 ? 3 * D : 0;
                const int goff = which == 0 ? 2 * D : 5 * D;
                const bool in_f32 = (layer == 0 && which == 0), out_f32 = (layer == 3 && which == 1);
                bf16_t* xbl = (bf16_t*)ka->out; bf16_t* xb3 = S4;
#define NR_LOAD(r_, XW, YW) do { const RowInfo ri_ = row_info(r_); const size_t xi_ = ri_.is_ctx ? ((size_t)ri_.b * CT + ri_.t) * D : ((size_t)ri_.b * T + ri_.t) * D; \
                    const bf16_t* yr_ = YB + (size_t)(r_) * D; \
                    if (in_f32) { const float* xp_ = (ri_.is_ctx ? ka->in[I_CTX] : ka->in[I_X]) + xi_; _Pragma("unroll") for (int j = 0; j < 4; ++j) XW[j] = *(const u32x4*)(xp_ + 256 * j + 4 * lane); } \
                    else { const bf16_t* xp_ = ri_.is_ctx ? (const bf16_t*)CTXX + xi_ : ((layer == 3 && which == 1) ? xb3 + xi_ : xbl + xi_); \
                        _Pragma("unroll") for (int j = 0; j < 4; ++j) { const u32x2 t_ = *(const u32x2*)(xp_ + 256 * j + 4 * lane); XW[j] = (u32x4){t_.x, t_.y, 0u, 0u}; } } \
                    _Pragma("unroll") for (int j = 0; j < 4; ++j) YW[j] = *(const u32x2*)(yr_ + 256 * j + 4 * lane); } while (0)
                if (which == 1 && (layer & 1) == 0) {
                    constexpr int TLD = 1026;
                    LAS bf16_t* TL = (LAS bf16_t*)lds;
                    const float* md2b = MOD + ((size_t)mlayer * 5) * 6 * D + shoff;
#define NT_ROW(r_, i_) do { const RowInfo ri = row_info(r_); const int mi = ri.is_ctx ? 4 : ri.b; \
                        const size_t xi = ri.is_ctx ? ((size_t)ri.b * CT + ri.t) * D : ((size_t)ri.b * T + ri.t) * D; \
                        bf16_t* xout16 = ri.is_ctx ? (bf16_t*)CTXX + xi : xbl + xi; \
                        const float* md = MOD + ((size_t)layer * 5 + mi) * 6 * D; f32x4 v[4]; \
                        _Pragma("unroll") for (int j = 0; j < 4; ++j) { const int c = 256 * j + 4 * lane; const f32x4 x = (f32x4){bflo(xw[j].x), bfhi(xw[j].x), bflo(xw[j].y), bfhi(xw[j].y)}; \
                            const f32x4 gt = *(const f32x4*)(md + goff + c); const f32x4 y = (f32x4){bflo(yw[j].x), bfhi(yw[j].x), bflo(yw[j].y), bfhi(yw[j].y)}; v[j] = x * ALPHA + gt * y; } \
                        ln_norm(v, lane); \
                        _Pragma("unroll") for (int j = 0; j < 4; ++j) { const int c = 256 * j + 4 * lane; v[j] = v[j] * *(const f32x4*)(pg + c) + *(const f32x4*)(pbv + c); \
                            u32x2 xo; xo.x = pk2(v[j][0], v[j][1]); xo.y = pk2(v[j][2], v[j][3]); *(u32x2*)(xout16 + c) = xo; } \
                        ln_norm(v, lane); \
                        const float* md2 = md2b + (size_t)mi * 6 * D; \
                        _Pragma("unroll") for (int j = 0; j < 4; ++j) { const int c = 256 * j + 4 * lane; const f32x4 sh = *(const f32x4*)(md2 + c), sc = *(const f32x4*)(md2 + D + c); \
                            const f32x4 h = v[j] * (1.0f + sc) + sh; LAS unsigned* d_ = (LAS unsigned*)(TL + (i_) * TLD + c); d_[0] = pk2(h[0], h[1]); d_[1] = pk2(h[2], h[3]); } } while (0)
                    u32x4 xw[4], xn[4]; u32x2 yw[4], yn[4];
#pragma unroll
                    for (int j = 0; j < 4; ++j) { xw[j] = (u32x4){0u, 0u, 0u, 0u}; xn[j] = xw[j]; yw[j] = (u32x2){0u, 0u}; yn[j] = yw[j]; }
                    for (int item = bx; item < NB * 32 * 4; item += G) {
                        const int b = item >> 7, t2 = (item >> 2) & 31, tb = item & 3;
                        const int rbase = lat_row(b, 32 * (64 * tb + wave * 8) + t2);
                        NR_LOAD(rbase, xw, yw);
#pragma unroll 1
                        for (int j8 = 0; j8 < 8; ++j8) {
                            if (j8 < 7) NR_LOAD(rbase + 32 * (j8 + 1), xn, yn);
                            NT_ROW(rbase + 32 * j8, wave * 8 + j8);
#pragma unroll
                            for (int j = 0; j < 4; ++j) { xw[j] = xn[j]; yw[j] = yn[j]; }
                        }
                        LDS_BARRIER();
#pragma unroll 4
                        for (int k = 0; k < 16; ++k) { const int idx = k * NTHR + tid, g8 = idx & 7, ch = idx >> 3; const LAS bf16_t* s = TL + (8 * g8) * TLD + ch;
                            u32x4 o; o.x = (unsigned)s[0] | ((unsigned)s[TLD] << 16); o.y = (unsigned)s[2 * TLD] | ((unsigned)s[3 * TLD] << 16); o.z = (unsigned)s[4 * TLD] | ((unsigned)s[5 * TLD] << 16); o.w = (unsigned)s[6 * TLD] | ((unsigned)s[7 * TLD] << 16);
                            *(u32x4*)(HT + (((size_t)b * D + ch) * 32 + t2) * 256 + 64 * tb + 8 * g8) = o; }
                        LDS_BARRIER();
                    }
                    if (layer < 2) {
                        for (int item = bx; item < NB * (CT / 8); item += G) {
                            const int b = item / (CT / 8), t8 = item % (CT / 8);
                            const int r = ctx_row(b, 8 * t8 + wave);
                            NR_LOAD(r, xw, yw);
                            NT_ROW(r, wave);
                            LDS_BARRIER();
#pragma unroll
                            for (int k = 0; k < 2; ++k) { const int ch = k * NTHR + tid; const LAS bf16_t* s = TL + ch;
                                u32x4 o; o.x = (unsigned)s[0] | ((unsigned)s[TLD] << 16); o.y = (unsigned)s[2 * TLD] | ((unsigned)s[3 * TLD] << 16); o.z = (unsigned)s[4 * TLD] | ((unsigned)s[5 * TLD] << 16); o.w = (unsigned)s[6 * TLD] | ((unsigned)s[7 * TLD] << 16);
                                *(u32x4*)(HTC + ((size_t)b * D + ch) * CT + 8 * t8) = o; }
                            LDS_BARRIER();
                        }
                    }
#undef NT_ROW
                } else {
                const int r_first = (layer < 2 ? 0 : CR) + gw;
                u32x4 xw[4], xn[4]; u32x2 yw[4], yn[4];
#pragma unroll
                for (int j = 0; j < 4; ++j) { xw[j] = (u32x4){0u, 0u, 0u, 0u}; xn[j] = xw[j]; yw[j] = (u32x2){0u, 0u}; yn[j] = yw[j]; }
                if (r_first < R) NR_LOAD(r_first, xw, yw);
                for (int r = r_first; r < R; r += NGW) {
                    if (r + NGW < R) NR_LOAD(r + NGW, xn, yn);
                    const RowInfo ri = row_info(r);
                    const int mi = ri.is_ctx ? 4 : ri.b;
                    const size_t xi = ri.is_ctx ? ((size_t)ri.b * CT + ri.t) * D : ((size_t)ri.b * T + ri.t) * D;
                    bf16_t* xout16 = ri.is_ctx ? (bf16_t*)CTXX + xi : ((layer == 3 && which == 0) ? xb3 + xi : xbl + xi);
                    const float* md = MOD + ((size_t)layer * 5 + mi) * 6 * D;
                    f32x4 v[4];
#pragma unroll
                    for (int j = 0; j < 4; ++j) { const int c = 256 * j + 4 * lane; f32x4 x; if (in_f32) x = __builtin_bit_cast(f32x4, xw[j]); else x = (f32x4){bflo(xw[j].x), bfhi(xw[j].x), bflo(xw[j].y), bfhi(xw[j].y)};
                        const f32x4 gt = *(const f32x4*)(md + goff + c);
                        const f32x4 y = (f32x4){bflo(yw[j].x), bfhi(yw[j].x), bflo(yw[j].y), bfhi(yw[j].y)}; v[j] = x * ALPHA + gt * y; }
                    ln_norm(v, lane);
#pragma unroll
                    for (int j = 0; j < 4; ++j) { const int c = 256 * j + 4 * lane; v[j] = v[j] * *(const f32x4*)(pg + c) + *(const f32x4*)(pbv + c);
                        if (out_f32) *(f32x4*)(ka->out + xi + c) = v[j]; else { u32x2 xo; xo.x = pk2(v[j][0], v[j][1]); xo.y = pk2(v[j][2], v[j][3]); *(u32x2*)(xout16 + c) = xo; } }
                    if (mlayer < 4) {
                        const float* md2 = MOD + ((size_t)mlayer * 5 + mi) * 6 * D + shoff;
                        ln_norm(v, lane);
                        bf16_t* o = HIN + (size_t)r * D;
#pragma unroll
                        for (int j = 0; j < 4; ++j) { const int c = 256 * j + 4 * lane; const f32x4 sh = *(const f32x4*)(md2 + c), sc = *(const f32x4*)(md2 + D + c);
                            const f32x4 h = v[j] * (1.0f + sc) + sh; u32x2 w; w.x = pk2(h[0], h[1]); w.y = pk2(h[2], h[3]); *(u32x2*)(o + c) = w; }
                    }
#pragma unroll
                    for (int j = 0; j < 4; ++j) { xw[j] = xn[j]; yw[j] = yn[j]; }
                }
                }
#undef NR_LOAD
                SEAM(pid);
            }
            if (EN_MLP && which == 0) {
                if (IN(pb + 20)) { PH_BEGIN();
 for (int rp_ = 0; rp_ < REPN(1); ++rp_) {
                    pg8::Gemm g{HIN + (size_t)CR * D, W1, D, D, D, 0, 0, (R - CR) / 256, DFF / 256, 1};
                    pg8::EpiStore E{HID + (size_t)CR * DFF, 0, DFF, 1};
                    pg8::gemm_phase(lds, g, E, G, bx, tid);
#if DUP_MLP
                    pg8::gemm_phase(lds, g, E, G, bx, tid);
#endif
                    if (layer < 2) { SmallGemm sg{HIN, W1, D, D, D, D, D, 0, 0}; SmallDense sd{HID, 0, DFF, CR / 64, DFF / 64, 1, 0, 0}; gemm_small_dense(lds, sg, sd, 1, G, bx, tid); }
 }
                    SEAM(pb + 20);
                }
                if (IN(pb + 21)) { PH_BEGIN();
 for (int rp_ = 0; rp_ < REPN(1); ++rp_) {
                    pg8::Gemm g{HID + (size_t)CR * DFF, W2, DFF, DFF, DFF, 0, 0, (R - CR) / 256, D / 256, 1};
                    pg8::EpiStore E{YB + (size_t)CR * D, 0, D, 0};
                    pg8::gemm_phase(lds, g, E, G, bx, tid);
#if DUP_MLP
                    pg8::gemm_phase(lds, g, E, G, bx, tid);
#endif
                    if (layer < 2) { SmallGemm sg{HID, W2, DFF, DFF, DFF, DFF, DFF, 0, 0}; SmallDense sd{YB, 0, D, CR / 64, D / 64, 0, 0, 0}; gemm_small_dense(lds, sg, sd, 1, G, bx, tid); }
 }
                    SEAM(pb + 21);
                }
            }
        }
    }
#undef IN
#undef SEAM
}

extern "C" void kernel_launch(void* const* d_in, const int* in_sizes, int n_in, void* d_out, int out_size, void* d_ws, size_t ws_size, hipStream_t stream) {
    static int grid = 0;
    if (grid == 0) {
        if (n_in != 22 || ws_size < 512 * MiB) { fprintf(stderr, "kernel_launch: unexpected n_in %d / ws_size %zu\n", n_in, ws_size); grid = -1; return; }
        int dev = 0, cus = 0;
        if (hipGetDevice(&dev) != hipSuccess || hipDeviceGetAttribute(&cus, hipDeviceAttributeMultiprocessorCount, dev) != hipSuccess) { grid = -1; return; }
        if (hipFuncSetAttribute((const void*)fwd, hipFuncAttributeMaxDynamicSharedMemorySize, LDS_BYTES) != hipSuccess) { fprintf(stderr, "kernel_launch: hipFuncSetAttribute failed\n"); grid = -1; return; }
        int per_cu = 0;
        if (hipOccupancyMaxActiveBlocksPerMultiprocessor(&per_cu, (const void*)fwd, NTHR, LDS_BYTES) != hipSuccess || per_cu < 1) fprintf(stderr, "kernel_launch: occupancy query says %d\n", per_cu);
        (void)hipGetLastError();
        grid = cus;
        if (grid != 256) fprintf(stderr, "kernel_launch: %d CUs (built for 256)\n", grid);
    }
    if (grid < 0) return;
    (void)hipMemsetAsync((char*)d_ws + WS_CTL, 0, CTL_BYTES, stream);
    Args a{};
    for (int i = 0; i < 22; ++i) a.in[i] = (const float*)d_in[i];
    a.out = (float*)d_out; a.ws = (unsigned char*)d_ws;
#if MK_SINGLE
    { int last = 0; for (int id = 0; id < NPHASE; ++id) if (phase_valid(id)) last = id;
      a.ph_lo = 0; a.ph_hi = NPHASE; a.ph_last = last; a.li = 0;
      hipLaunchKernelGGL(fwd, dim3(grid), dim3(NTHR), LDS_BYTES, stream, a); }
#else
    { int li = 0;
      for (int id = 0; id < NPHASE; ++id) { if (!phase_valid(id)) continue;
          a.ph_lo = id; a.ph_hi = id + 1; a.ph_last = id; a.li = li++;
          hipLaunchKernelGGL(fwd, dim3(grid), dim3(NTHR), LDS_BYTES, stream, a); } }
#endif
}
```

```cpp
#include <hip/hip_runtime.h>
#include <cstdio>
#include <cstdint>

#define LAS __attribute__((address_space(3)))
typedef unsigned short bf16_t;
typedef short bf16x8 __attribute__((ext_vector_type(8)));
typedef float f32x4 __attribute__((ext_vector_type(4)));
typedef unsigned u32x4 __attribute__((ext_vector_type(4)));
typedef unsigned u32x2 __attribute__((ext_vector_type(2)));


#ifndef EN_PRO
#define EN_PRO 1
#endif
#ifndef EN_WC
#define EN_WC 1
#endif
#ifndef EN_MIX
#define EN_MIX 1
#endif
#ifndef EN_SCAN
#define EN_SCAN 1
#endif
#ifndef EN_FOUR
#define EN_FOUR 1
#endif
#ifndef EN_NORM
#define EN_NORM 1
#endif
#ifndef EN_MLP
#define EN_MLP 1
#endif
#ifndef DUP_MIX
#define DUP_MIX 0
#endif
#ifndef DUP_CTX
#define DUP_CTX 0
#endif
#ifndef DUP_BAR
#define DUP_BAR 0
#endif
#ifndef DUP_MLP
#define DUP_MLP 0
#endif
#ifndef REP_MASK
#define REP_MASK 0
#endif
#define REPN(bit) (((REP_MASK) >> (bit)) & 1 ? 2 : 1)
#ifndef SC_QPAD
#define SC_QPAD 64
#endif
#ifndef SC_ABL
#define SC_ABL 0
#endif
#ifndef SCAN_REP
#define SCAN_REP 1
#endif
#ifndef MK_SINGLE
#define MK_SINGLE 1
#endif

constexpr int D = 1024, NB = 4, T = 8192, CT = 256, DI = 2048, NH = 4, DH = 512, DFF = 4096;
constexpr int R = NB * (T + CT);
constexpr int RH = R / 2;
constexpr int LAT0 = 2 * CT;
constexpr int NCH = RH / 64;
constexpr float ALPHA = 1.6817928305074290f;
constexpr float LN_EPS = 1e-5f;
constexpr int NWAVES = 8, NTHR = 512;

constexpr size_t MiB = 1u << 20;
constexpr size_t WS_CTL = 0, CTL_BYTES = 2 * MiB;
constexpr size_t WS_MOD = 2 * MiB;
constexpr size_t WS_CTXX = 3 * MiB;
constexpr size_t WS_PRE = 7 * MiB;
constexpr size_t WS_TAB = 10 * MiB;
constexpr size_t TAB_A1 = WS_TAB;
constexpr size_t TAB_A2 = TAB_A1 + 512 * 256 * 2;
constexpr size_t TAB_BZ = TAB_A2 + 256 * 64 * 64 * 2;
constexpr size_t TAB_ACTX = TAB_BZ + 256 * 512 * 2;
constexpr size_t TAB_GATE = TAB_ACTX + 512 * 256 * 2;
static_assert(TAB_GATE + 64 * 4096 * 2 <= 15 * MiB, "tables");
constexpr size_t WS_W = 15 * MiB;
constexpr size_t W_IN = WS_W;
constexpr size_t W_Q = W_IN + 8 * MiB, W_K = W_Q + 2 * MiB, W_V = W_K + 2 * MiB;
constexpr size_t W_OUT = W_V + 2 * MiB;
constexpr size_t W_1 = W_OUT + 4 * MiB;
constexpr size_t W_2 = W_1 + 8 * MiB;
static_assert(W_2 + 8 * MiB <= 49 * MiB, "weights");
constexpr size_t WS_HIN = 49 * MiB;
constexpr size_t WS_YB = 115 * MiB;
constexpr size_t WS_BIG = 181 * MiB;
constexpr size_t SLOT = 66 * MiB;
static_assert(WS_BIG + 5 * SLOT <= 512 * MiB, "workspace");
static_assert((size_t)RH * DI * 2 == SLOT, "slot");

#define LDS_BARRIER() do { asm volatile("s_waitcnt lgkmcnt(0)" ::: "memory"); __builtin_amdgcn_s_barrier(); asm volatile("" ::: "memory"); } while (0)
__device__ __forceinline__ unsigned f2bf(float f) { unsigned u = __builtin_bit_cast(unsigned, f); return (u + 0x7fffu + ((u >> 16) & 1u)) >> 16; }
typedef __bf16 bf16x2_t __attribute__((ext_vector_type(2)));
typedef float f32x2_t __attribute__((ext_vector_type(2)));
__device__ __forceinline__ unsigned pk2(float lo, float hi) { const f32x2_t v = {lo, hi}; return __builtin_bit_cast(unsigned, __builtin_convertvector(v, bf16x2_t)); }
__device__ __forceinline__ float bf2f(unsigned short b) { return __builtin_bit_cast(float, ((unsigned)b) << 16); }
__device__ __forceinline__ float u2f(unsigned u) { return __builtin_bit_cast(float, u); }
__device__ __forceinline__ float bflo(unsigned w) { return __builtin_bit_cast(float, w << 16); }
__device__ __forceinline__ float bfhi(unsigned w) { return __builtin_bit_cast(float, w & 0xffff0000u); }
__device__ __forceinline__ float shx(float v, int mask, int lane) { return __builtin_bit_cast(float, __builtin_amdgcn_ds_bpermute((lane ^ mask) << 2, __builtin_bit_cast(int, v))); }
template <int CTRL, int RMASK> __device__ __forceinline__ float dppf(float idv, float src) { return __builtin_bit_cast(float, __builtin_amdgcn_update_dpp(__builtin_bit_cast(int, idv), __builtin_bit_cast(int, src), CTRL, RMASK, 0xF, false)); }
__device__ __forceinline__ float scan_add64(float x) {
    x += dppf<0x111, 0xF>(0.f, x); x += dppf<0x112, 0xF>(0.f, x); x += dppf<0x114, 0xF>(0.f, x); x += dppf<0x118, 0xF>(0.f, x);
    x += dppf<0x142, 0xA>(0.f, x); x += dppf<0x143, 0xC>(0.f, x); return x; }
__device__ __forceinline__ float scan_max64(float x) {
    const float ni = -__builtin_inff();
    x = fmaxf(x, dppf<0x111, 0xF>(ni, x)); x = fmaxf(x, dppf<0x112, 0xF>(ni, x)); x = fmaxf(x, dppf<0x114, 0xF>(ni, x)); x = fmaxf(x, dppf<0x118, 0xF>(ni, x));
    x = fmaxf(x, dppf<0x142, 0xA>(ni, x)); x = fmaxf(x, dppf<0x143, 0xC>(ni, x)); return x; }
__device__ __forceinline__ float shup(float v, int d, int lane) { return __builtin_bit_cast(float, __builtin_amdgcn_ds_bpermute((lane - d) << 2, __builtin_bit_cast(int, v))); }
__device__ __forceinline__ float wave_sum(float v, int lane) {
#pragma unroll
    for (int o = 1; o < 64; o <<= 1) v += shx(v, o, lane);
    return v;
}
__device__ __forceinline__ float siluf(float x) { return x * __builtin_amdgcn_rcpf(1.0f + __expf(-x)); }

struct RowInfo { int is_ctx, b, t; };
__device__ __forceinline__ RowInfo row_info(int r) {
    RowInfo ri;
    if (r < NB * CT) { ri.is_ctx = 1; ri.b = r / CT; ri.t = r % CT; }
    else { ri.is_ctx = 0; const int u = r - NB * CT; ri.b = u / T; ri.t = u % T; }
    return ri;
}
__device__ __forceinline__ int lat_row(int b, int t) { return NB * CT + b * T + t; }
__device__ __forceinline__ int ctx_row(int b, int t) { return b * CT + t; }
constexpr int CR = NB * CT;
constexpr int LH = RH - LAT0;

#define XB_TMO      128
#define XB_XCNT(j)  (256  + 64 * (j))
#define XB_XSUB(j)  (1280 + 64 * (j))
#define XB_XGEN(j)  (2304 + 64 * (j))
#define XB_TOP      3328
#define XB_TOPGEN   3392
#define XCD_BAR_WORDS 3456
#define XB_SPIN_CAP (1u << 18)

__device__ __forceinline__ unsigned xb_ld(unsigned* p)              { return __hip_atomic_load(p, __ATOMIC_RELAXED, __HIP_MEMORY_SCOPE_AGENT); }
__device__ __forceinline__ unsigned xb_add(unsigned* p, unsigned v) { return __hip_atomic_fetch_add(p, v, __ATOMIC_RELAXED, __HIP_MEMORY_SCOPE_AGENT); }
__device__ __forceinline__ unsigned xb_xcc_id() { return (unsigned)__builtin_amdgcn_s_getreg((3 << 11) | 20) & 0xFu; }
#define XB_SPIN(cond, bar) do { unsigned _sp = 0; while (cond) { __builtin_amdgcn_s_sleep(1); \
    if ((++_sp & 255u) == 0u) { if (xb_ld(&(bar)[XB_TMO])) break; if (_sp > XB_SPIN_CAP) { atomicAdd(&(bar)[XB_TMO], 1u); break; } } } } while (0)

struct XcdBarrier { unsigned* bar; unsigned x; volatile LAS unsigned* st; };

__device__ __forceinline__ XcdBarrier xcd_barrier_post(unsigned* bar, volatile LAS unsigned* st) {
    XcdBarrier b; b.bar = bar; b.x = xb_xcc_id(); b.st = st;
    if (threadIdx.x == 0) (void)xb_add(&bar[XB_XCNT(b.x)], 1u);
    return b;
}
__device__ __forceinline__ void xcd_barrier_complete(unsigned* bar, unsigned x, unsigned& nloc, unsigned& nx) {
    const unsigned G = gridDim.x * gridDim.y * gridDim.z;
    unsigned sum, cnt, mine, sp = 0u;
    for (;;) {
        sum = 0u; cnt = 0u; mine = 0u;
#pragma unroll
        for (unsigned j = 0; j < 16; ++j) { const unsigned c = xb_ld(&bar[XB_XCNT(j)]); sum += c; cnt += (c > 0u) ? 1u : 0u; mine = (j == x) ? c : mine; }
        if (sum == G) break;
        __builtin_amdgcn_s_sleep(1);
        if ((++sp & 255u) == 0u) { if (xb_ld(&bar[XB_TMO])) break; if (sp > XB_SPIN_CAP) { atomicAdd(&bar[XB_TMO], 1u); break; } }
    }
    nloc = mine > 0u ? mine : 1u; nx = cnt > 0u ? cnt : 1u;
}
__device__ __forceinline__ void xcd_barrier(const XcdBarrier& b, bool thread0) {
    asm volatile("s_waitcnt vmcnt(0)" ::: "memory");
    __syncthreads();
    if (thread0) {
        unsigned* bar = b.bar;
        __builtin_amdgcn_s_waitcnt(0);
        unsigned nloc = b.st[0], nx = b.st[1];
        if (nloc == 0u) { xcd_barrier_complete(bar, b.x, nloc, nx); b.st[0] = nloc; b.st[1] = nx; }
        const unsigned old = xb_add(&bar[XB_XSUB(b.x)], 1u);
        const unsigned gen = old / nloc;
        if (old + 1u == (gen + 1u) * nloc) {
            __builtin_amdgcn_fence(__ATOMIC_RELEASE, "agent");
            asm volatile("s_waitcnt vmcnt(0)" ::: "memory");
            const unsigned og = xb_add(&bar[XB_TOP], 1u);
            const unsigned tg = og / nx;
            if (og + 1u == (tg + 1u) * nx) xb_add(&bar[XB_TOPGEN], 1u);
            else XB_SPIN(xb_ld(&bar[XB_TOPGEN]) == tg, bar);
            __builtin_amdgcn_fence(__ATOMIC_ACQUIRE, "agent");
            xb_add(&bar[XB_XGEN(b.x)], 1u);
            asm volatile("s_waitcnt vmcnt(0)" ::: "memory");
        } else {
            XB_SPIN(xb_ld(&bar[XB_XGEN(b.x)]) == gen, bar);
            __builtin_amdgcn_fence(__ATOMIC_ACQUIRE, "agent");
            asm volatile("s_waitcnt vmcnt(0)" ::: "memory");
        }
    }
    __syncthreads();
}

__device__ __forceinline__ size_t qtile_off(int q, int h, int cc) {
    const int chunk = q >> 6, p = q & 63, pt = p >> 4, fr = p & 15, w = cc >> 6, ks = (cc >> 5) & 1, fq = (cc >> 3) & 3;
    const size_t blk = ((((size_t)chunk * 4 + h) * 8 + w) * 4 + pt) * 2 + ks;
    return blk * 512 + (size_t)(fq * 16 + fr) * 8 + (cc & 7);
}
__device__ __forceinline__ size_t ktile_off(int d, int h, int q) {
    const int chunk = q >> 6, s = q & 63, ks = s >> 5, fq = (s >> 3) & 3, w = d >> 6, dd = d & 63, mt = 2 * (dd >> 5) + ((dd >> 2) & 1), frp = 4 * ((dd >> 3) & 3) + (dd & 3);
    const size_t blk = ((((size_t)chunk * 4 + h) * 8 + w) * 4 + mt) * 2 + ks;
    return blk * 512 + (size_t)(fq * 16 + frp) * 8 + (s & 7);
}

__device__ __forceinline__ size_t vtile_off(int e, int h, int q) {
    const int chunk = q >> 6, s = q & 63, slice = e >> 5, e5 = e & 31, nt = e5 >> 4, fr = e5 & 15, ks = s >> 5, fq = (s >> 3) & 3;
    const size_t blk = ((((size_t)chunk * 4 + h) * 16 + slice) * 2 + nt) * 2 + ks;
    return blk * 512 + (size_t)(fq * 16 + fr) * 8 + (s & 7);
}
__device__ __forceinline__ size_t htile_off(int q, int h, int e) {
    return ((((size_t)(q >> 6) * 4 + h) * 16 + (e >> 5)) * 2048) + (size_t)(q & 63) * 32 + (e & 31);
}

namespace pg8 {
constexpr int BM = 256, BK = 64, HALF = 128, HTB = HALF * BK * 2, STAGE_BYTES = 8 * HTB, NXCD = 8, WGM = 8;
__device__ __forceinline__ int lds_byte(int r, int c) { const int st = (r >> 4) * 2 + (c >> 5), rr = r & 15, cc = c & 31, ob = rr * 64 + cc * 2; return st * 1024 + (ob ^ (((ob >> 9) & 1) << 5)); }
__device__ __forceinline__ void stage_rc(int b, int& R_, int& C_) { const int st = b / 1024, sb = b % 1024, swz = sb ^ (((sb >> 9) & 1) << 5); R_ = (st >> 1) * 16 + swz / 64; C_ = (st & 1) * 32 + (swz % 64) / 2; }
__device__ __forceinline__ int perm32(int rho) { const int n = rho >> 4, i = rho & 15; return 8 * (i >> 2) + 4 * n + (i & 3); }

struct Unit { int pm, pn, g; };
struct Gemm {
    const bf16_t* A; const bf16_t* Bt; int lda, ldb, K;
    long a_gs, b_gs;
    int nM, nN, nG;
};
struct Order {
    int nM, nNt, nN, nwg, G, c;
    __device__ void init(const Gemm& g, int G_, int c_) { nM = g.nM; nN = g.nN; nNt = g.nN * g.nG; nwg = nM * nNt; G = G_; c = c_; }
    __device__ bool next(int i, Unit& u) const {
        const long L = (long)i * G + c; if (L >= nwg) return false;
        int wgid = (int)L; { const int q = nwg / NXCD, r = nwg % NXCD, xcd = wgid % NXCD, off = wgid / NXCD; wgid = (xcd < r ? xcd * (q + 1) : r * (q + 1) + (xcd - r) * q) + off; }
        const int nig = WGM * nNt, gid = wgid / nig, fm = gid * WGM, gsz = (nM - fm) < WGM ? (nM - fm) : WGM;
        u.pm = fm + ((wgid % nig) % gsz); const int pnt = (wgid % nig) / gsz; u.g = pnt / nN; u.pn = pnt - u.g * nN; return true;
    }
};
__device__ __forceinline__ unsigned cvt_pk_bf16(float lo, float hi) { return pk2(lo, hi); }

struct EpiStore {
    bf16_t* O; long o_gs; int ldc; int act;
    int mode, off;
    __device__ __forceinline__ void operator()(const f32x4 (&acc)[2][2][4][2], const Unit& u, int wr, int wc, int fr, int fq) const {
        const int row0 = u.pm * BM + wr * 64 + fr; const int col0 = u.pn * BM + wc * 32 + 8 * fq; bf16_t* base = O + (long)u.g * o_gs;
#pragma unroll
        for (int ai = 0; ai < 2; ++ai)
#pragma unroll
            for (int m = 0; m < 4; ++m) { bf16_t* rowp = base + (size_t)(row0 + ai * HALF + m * 16) * ldc + col0;
#pragma unroll
                for (int bj = 0; bj < 2; ++bj) { f32x4 v0 = acc[ai][bj][m][0], v1 = acc[ai][bj][m][1];
                    if (act == 1) {
#pragma unroll
                        for (int j = 0; j < 4; ++j) { const float a = fmaxf(v0[j], 0.f), b = fmaxf(v1[j], 0.f); v0[j] = a * a; v1[j] = b * b; } }
                    u32x4 w; w.x = cvt_pk_bf16(v0[0], v0[1]); w.y = cvt_pk_bf16(v0[2], v0[3]); w.z = cvt_pk_bf16(v1[0], v1[1]); w.w = cvt_pk_bf16(v1[2], v1[3]);
                    if (mode == 0) *(u32x4*)(rowp + bj * HALF) = w;
                    else if (mode == 1) *(u32x4*)(O + qtile_off(off + row0 + ai * HALF + m * 16, u.g, col0 + bj * HALF)) = w;
                    else if (mode == 2) *(u32x4*)(O + ktile_off(row0 + ai * HALF + m * 16, u.g, off + col0 + bj * HALF)) = w;
                    else *(u32x4*)(O + vtile_off(row0 + ai * HALF + m * 16, u.g, off + col0 + bj * HALF)) = w; } }
    }
};

template <class Epi>
__device__ __forceinline__ void gemm_phase(LAS unsigned char* lds, const Gemm g, const Epi& E, int G_, int c_, int tid_in) {
    int tid_ = tid_in; asm volatile("" : "+v"(tid_));
    const int tid = tid_, wid = __builtin_amdgcn_readfirstlane(tid >> 6), lane = tid & 63, wr = wid >> 2, wc = wid & 3, fr = lane & 15, fq = lane >> 4;
    const int K = g.K, nt = K / BK;
    Order S; S.init(g, G_, c_);
    unsigned voffA[2], voffB[2];
#pragma unroll
    for (int i = 0; i < 2; ++i) { int R_, C_; stage_rc(tid * 16 + i * 8192, R_, C_); const int Rb = (R_ & ~31) + perm32(R_ & 31);
        voffA[i] = (unsigned)(R_ * g.lda + C_) * 2u; voffB[i] = (unsigned)(Rb * g.ldb + C_) * 2u; }
    const size_t kstep = (size_t)(BK * 2);
    const size_t hstepA = (size_t)HALF * g.lda * 2, hstepB = (size_t)HALF * g.ldb * 2;
    const unsigned ldsw = (unsigned)wid * 1024u;
    const int aoff = lds_byte(wr * 64 + fr, fq * 8), boff = lds_byte(wc * 32 + fr, fq * 8);
#define PG8_SA(b, h) (((b) * 2 + (h)) * HTB)
#define PG8_SB(b, h) ((4 + (b) * 2 + (h)) * HTB)
#define PG8_STAGE(bufoff, gbase, voff) do { _Pragma("unroll") for (int _i = 0; _i < 2; ++_i) \
        __builtin_amdgcn_global_load_lds((const unsigned*)((const char*)(gbase) + (voff)[_i]), (LAS unsigned*)(lds + (bufoff) + ldsw + _i * 8192), 16, 0, 0); } while (0)
#define PG8_LDA(dst, b, h) do { _Pragma("unroll") for (int m = 0; m < 4; ++m) _Pragma("unroll") for (int k = 0; k < 2; ++k) dst[m][k] = *(const LAS bf16x8*)(lds + PG8_SA(b, h) + aoff + m * 2048 + k * 1024); } while (0)
#define PG8_LDB(dst, b, h) do { _Pragma("unroll") for (int n = 0; n < 2; ++n) _Pragma("unroll") for (int k = 0; k < 2; ++k) dst[n][k] = *(const LAS bf16x8*)(lds + PG8_SB(b, h) + boff + n * 2048 + k * 1024); } while (0)
#define PG8_MMA(ai, bj, At, Bt) do { __builtin_amdgcn_s_setprio(1); _Pragma("unroll") for (int m = 0; m < 4; ++m) _Pragma("unroll") for (int n = 0; n < 2; ++n) _Pragma("unroll") for (int k = 0; k < 2; ++k) \
        acc[ai][bj][m][n] = __builtin_amdgcn_mfma_f32_16x16x32_bf16(Bt[n][k], At[m][k], acc[ai][bj][m][n], 0, 0, 0); __builtin_amdgcn_s_setprio(0); } while (0)
#define PG8_WAIT_V(n) asm volatile("s_waitcnt vmcnt(" #n ")" ::: "memory")
#define PG8_WAIT_L(n) asm volatile("s_waitcnt lgkmcnt(" #n ")" ::: "memory")
#define PG8_BAR __builtin_amdgcn_s_barrier()
#define PG8_SCHED __builtin_amdgcn_sched_barrier(0)
#define PG8_APTR(u) ((const char*)(g.A + (long)(u).g * g.a_gs) + (size_t)(u).pm * 2 * hstepA)
#define PG8_BPTR(u) ((const char*)(g.Bt + (long)(u).g * g.b_gs) + (size_t)(u).pn * 2 * hstepB)
    Unit cur, nxt; int ui = 0;
    if (!S.next(0, cur)) return;
    f32x4 acc[2][2][4][2];
#pragma unroll
    for (int a = 0; a < 2; ++a)
#pragma unroll
        for (int b = 0; b < 2; ++b)
#pragma unroll
            for (int m = 0; m < 4; ++m)
#pragma unroll
                for (int n = 0; n < 2; ++n) acc[a][b][m][n] = (f32x4){0.f, 0.f, 0.f, 0.f};
    bf16x8 At[4][2], B0[2][2], B1[2][2];
    const char* cA = PG8_APTR(cur); const char* cB = PG8_BPTR(cur);
    PG8_STAGE(PG8_SB(0, 0), cB, voffB); PG8_STAGE(PG8_SA(0, 0), cA, voffA); PG8_STAGE(PG8_SB(0, 1), cB + hstepB, voffB); PG8_STAGE(PG8_SA(0, 1), cA + hstepA, voffA);
    if (wr == 1) PG8_BAR;
    PG8_WAIT_V(4); PG8_BAR;
    PG8_STAGE(PG8_SB(1, 0), cB + kstep, voffB); PG8_STAGE(PG8_SA(1, 0), cA + kstep, voffA); PG8_STAGE(PG8_SB(1, 1), cB + hstepB + kstep, voffB);
    PG8_WAIT_V(6); PG8_BAR;
    for (;;) {
        const bool has_next = S.next(ui + 1, nxt);
        const char* nA = has_next ? PG8_APTR(nxt) : cA; const char* nB = has_next ? PG8_BPTR(nxt) : cB;
        for (int t = 0; t < nt; t += 2) {
            const bool last = (t == nt - 2);
            const char* a1 = cA + (size_t)(t + 1) * kstep;
            const char* a2 = last ? nA : cA + (size_t)(t + 2) * kstep; const char* b2 = last ? nB : cB + (size_t)(t + 2) * kstep;
            const char* a3 = a2 + kstep; const char* b3 = b2 + kstep;
            PG8_LDB(B0, 0, 0); PG8_SCHED; PG8_LDA(At, 0, 0); PG8_STAGE(PG8_SA(1, 1), a1 + hstepA, voffA);
            PG8_WAIT_L(8); PG8_BAR; PG8_WAIT_L(0); PG8_MMA(0, 0, At, B0); PG8_BAR; PG8_SCHED;
            PG8_LDB(B1, 0, 1); PG8_STAGE(PG8_SB(0, 0), b2, voffB);
            PG8_BAR; PG8_WAIT_L(0); PG8_MMA(0, 1, At, B1); PG8_BAR;
            PG8_LDA(At, 0, 1); PG8_STAGE(PG8_SA(0, 0), a2, voffA);
            PG8_BAR; PG8_WAIT_L(0); PG8_MMA(1, 0, At, B0); PG8_BAR; PG8_SCHED;
            PG8_STAGE(PG8_SB(0, 1), b2 + hstepB, voffB);
            PG8_WAIT_V(6); PG8_BAR; PG8_MMA(1, 1, At, B1); PG8_BAR;
            PG8_LDB(B0, 1, 0); PG8_SCHED; PG8_LDA(At, 1, 0); PG8_STAGE(PG8_SA(0, 1), a2 + hstepA, voffA);
            PG8_WAIT_L(8); PG8_BAR; PG8_WAIT_L(0); PG8_MMA(0, 0, At, B0); PG8_BAR; PG8_SCHED;
            PG8_LDB(B1, 1, 1); PG8_STAGE(PG8_SB(1, 0), b3, voffB);
            PG8_BAR; PG8_WAIT_L(0); PG8_MMA(0, 1, At, B1); PG8_BAR;
            PG8_LDA(At, 1, 1); PG8_STAGE(PG8_SA(1, 0), a3, voffA);
            PG8_BAR; PG8_WAIT_L(0); PG8_MMA(1, 0, At, B0); PG8_BAR; PG8_SCHED;
            PG8_STAGE(PG8_SB(1, 1), b3 + hstepB, voffB);
            PG8_WAIT_V(6); PG8_BAR; PG8_MMA(1, 1, At, B1); PG8_BAR;
        }
        E(acc, cur, wr, wc, fr, fq);
        if (!has_next) break;
#pragma unroll
        for (int a = 0; a < 2; ++a)
#pragma unroll
            for (int b = 0; b < 2; ++b)
#pragma unroll
                for (int m = 0; m < 4; ++m)
#pragma unroll
                    for (int n = 0; n < 2; ++n) acc[a][b][m][n] = (f32x4){0.f, 0.f, 0.f, 0.f};
        cur = nxt; cA = nA; cB = nB; ++ui;
    }
    PG8_WAIT_V(0);
    if (wr == 0) PG8_BAR;
    PG8_BAR;
#undef PG8_SA
#undef PG8_SB
#undef PG8_STAGE
#undef PG8_LDA
#undef PG8_LDB
#undef PG8_MMA
#undef PG8_WAIT_V
#undef PG8_WAIT_L
#undef PG8_BAR
#undef PG8_SCHED
#undef PG8_APTR
#undef PG8_BPTR
}
}

struct SmallGemm { const bf16_t* A; const bf16_t* B; int lda, ldb, K, akseg, bkseg; long aseg, bseg; int a_tiled; };
constexpr int SG_LD = 72;
constexpr int SG_TILE = 64 * SG_LD * 2;
template <class Dec, class Epi>
__device__ __forceinline__ void gemm_small(LAS unsigned char* lds, const SmallGemm g, int nunits, const Dec& dec, const Epi& epi, int G_, int c_, int tid_in) {
    int tid_ = tid_in; asm volatile("" : "+v"(tid_));
    const int tid = tid_, wid = tid >> 6, lane = tid & 63, wm = wid >> 1, wn = wid & 1, fr = lane & 15, fq = lane >> 4;
    const int lrow = tid >> 3, lk = (tid & 7) * 8;
    const int nk = g.K / 64;
    const unsigned stoff = (unsigned)(lrow * SG_LD + lk) * 2u;
#define SG_LOAD(ra_, rb_, kt_) do { const int k_ = (kt_) * 64 + lk; \
        if (g.a_tiled) ra_ = *(const u32x4*)(g.A + (((((size_t)aoff * 8 + (k_ >> 6)) * 4 + (lrow >> 4)) * 2 + ((k_ >> 5) & 1)) * 512 + (size_t)(((k_ >> 3) & 3) * 16 + (lrow & 15)) * 8)); \
        else ra_ = *(const u32x4*)(ap + (long)(k_ / g.akseg) * g.aseg + (k_ % g.akseg)); \
        rb_ = *(const u32x4*)(bp + (long)(k_ / g.bkseg) * g.bseg + (k_ % g.bkseg)); } while (0)
#define SG_STORE(ra_, rb_, bufi_) do { *(LAS u32x4*)(lds + ((bufi_) * 2 + 0) * SG_TILE + stoff) = ra_; *(LAS u32x4*)(lds + ((bufi_) * 2 + 1) * SG_TILE + stoff) = rb_; } while (0)
#define SG_COMPUTE(bufi_) do { const LAS unsigned char* As = lds + ((bufi_) * 2 + 0) * SG_TILE; const LAS unsigned char* Bs = lds + ((bufi_) * 2 + 1) * SG_TILE; \
        _Pragma("unroll") for (int ks = 0; ks < 2; ++ks) { const bf16x8 af = *(const LAS bf16x8*)(As + ((wm * 16 + fr) * SG_LD + ks * 32 + fq * 8) * 2); \
            _Pragma("unroll") for (int nt = 0; nt < 2; ++nt) { const bf16x8 bf = *(const LAS bf16x8*)(Bs + ((wn * 32 + nt * 16 + fr) * SG_LD + ks * 32 + fq * 8) * 2); \
                acc[nt] = __builtin_amdgcn_mfma_f32_16x16x32_bf16(bf, af, acc[nt], 0, 0, 0); } } } while (0)
    for (int u = c_; u < nunits; u += G_) {
        long aoff, boff; dec(u, aoff, boff);
        const bf16_t* ap = g.A + aoff + (long)lrow * g.lda; const bf16_t* bp = g.B + boff + (long)lrow * g.ldb;
        f32x4 acc[2] = {(f32x4){0.f, 0.f, 0.f, 0.f}, (f32x4){0.f, 0.f, 0.f, 0.f}};
        u32x4 ra0, rb0, ra1, rb1, ra2, rb2, ra3, rb3;
        ra0 = (u32x4){0u, 0u, 0u, 0u}; rb0 = ra0; ra1 = ra0; rb1 = ra0; ra2 = ra0; rb2 = ra0; ra3 = ra0; rb3 = ra0;
        SG_LOAD(ra0, rb0, 0); if (nk > 1) SG_LOAD(ra1, rb1, 1); if (nk > 2) SG_LOAD(ra2, rb2, 2); if (nk > 3) SG_LOAD(ra3, rb3, 3);
        SG_STORE(ra0, rb0, 0);
        LDS_BARRIER();
#define SG_TURN(kt_, bufc, rnextA, rnextB, rfreeA, rfreeB) do { if ((kt_) < nk) { \
            SG_COMPUTE(bufc); \
            if ((kt_) + 1 < nk) SG_STORE(rnextA, rnextB, (bufc) ^ 1); \
            if ((kt_) + 4 < nk) SG_LOAD(rfreeA, rfreeB, (kt_) + 4); \
            LDS_BARRIER(); } } while (0)
        for (int kt = 0; kt < nk; kt += 4) {
            SG_TURN(kt,     0, ra1, rb1, ra0, rb0);
            SG_TURN(kt + 1, 1, ra2, rb2, ra1, rb1);
            SG_TURN(kt + 2, 0, ra3, rb3, ra2, rb2);
            SG_TURN(kt + 3, 1, ra0, rb0, ra3, rb3);
        }
#undef SG_TURN
#pragma unroll
        for (int nt = 0; nt < 2; ++nt) epi(u, wm * 16 + fr, wn * 32 + nt * 16 + fq * 4, acc[nt]);
    }
#undef SG_LOAD
#undef SG_STORE
#undef SG_COMPUTE
}

struct SmallDense { bf16_t* O; long o_gs; int ldc, mt, nt, act; long a_gs, b_gs; int mode; };
__device__ __forceinline__ void gemm_small_dense(LAS unsigned char* lds, const SmallGemm g, const SmallDense d, int ngroups, int G_, int c_, int tid_in) {
    const int per = d.mt * d.nt;
    auto dec = [=](int u, long& ao, long& bo) { const int gi = u / per, r = u % per, mi = r / d.nt, ni = r % d.nt; ao = gi * d.a_gs + (long)mi * 64 * g.lda; bo = gi * d.b_gs + (long)ni * 64 * g.ldb; };
    auto epi = [=](int u, int m, int n, const f32x4& v) { const int gi = u / per, r = u % per, mi = r / d.nt, ni = r % d.nt;
        f32x4 x = v; if (d.act == 1) {
#pragma unroll
            for (int i = 0; i < 4; ++i) { const float a = fmaxf(x[i], 0.f); x[i] = a * a; } }
        u32x2 w; w.x = pk2(x[0], x[1]); w.y = pk2(x[2], x[3]);
        if (d.mode == 0) *(u32x2*)(d.O + gi * d.o_gs + (size_t)(mi * 64 + m) * d.ldc + ni * 64 + n) = w;
        else if (d.mode == 1) *(u32x2*)(d.O + qtile_off(mi * 64 + m, gi, ni * 64 + n)) = w;
        else if (d.mode == 2) *(u32x2*)(d.O + ktile_off(mi * 64 + m, gi, ni * 64 + n)) = w;
        else *(u32x2*)(d.O + vtile_off(mi * 64 + m, gi, ni * 64 + n)) = w; };
    gemm_small(lds, g, ngroups * per, dec, epi, G_, c_, tid_in);
}

struct Args { const float* in[22]; float* out; unsigned char* ws; int ph_lo, ph_hi, ph_last, li; };
enum { I_X = 0, I_C, I_CTX, I_CCTX, I_ADAW, I_ADAB, I_PG, I_PB, I_WIN, I_WCONV, I_BCONV, I_WQ, I_WK, I_WV, I_WGATE, I_BGATE, I_GNW, I_SKIP, I_WOUT, I_FWOUT, I_W1, I_W2 };

constexpr int LDS_BYTES = 147456;
constexpr int LDS_MISC = LDS_BYTES - 256;

__device__ __forceinline__ void transpose_item(const float* W, int K, int N, bf16_t* WT, float scale, LAS float* scr, int item, int lane) {
    const int nblk = N / 32, kb = item / nblk, nb = item % nblk, k0 = 64 * kb, n0 = 32 * nb;
#pragma unroll 8
    for (int i = 0; i < 32; ++i) { const int kk = 2 * i + (lane >> 5); scr[kk * 33 + (lane & 31)] = W[(size_t)(k0 + kk) * N + n0 + (lane & 31)] * scale; }
    asm volatile("s_waitcnt lgkmcnt(0)" ::: "memory");
    const int c = lane & 7;
#pragma unroll
    for (int j = 0; j < 4; ++j) { const int n = (lane >> 3) + 8 * j; const LAS float* s = scr + (8 * c) * 33 + n;
        u32x4 o; o.x = pk2(s[0 * 33], s[1 * 33]); o.y = pk2(s[2 * 33], s[3 * 33]); o.z = pk2(s[4 * 33], s[5 * 33]); o.w = pk2(s[6 * 33], s[7 * 33]);
        *(u32x4*)(WT + (size_t)(n0 + n) * K + k0 + 8 * c) = o; }
    asm volatile("s_waitcnt lgkmcnt(0)" ::: "memory");
}

__device__ __forceinline__ void ln_norm(f32x4 (&v)[4], int lane) {
    float s = 0.f;
#pragma unroll
    for (int j = 0; j < 4; ++j) s += (v[j][0] + v[j][1]) + (v[j][2] + v[j][3]);
    const float mean = wave_sum(s, lane) * (1.f / D); float s2 = 0.f;
#pragma unroll
    for (int j = 0; j < 4; ++j) { v[j] = v[j] - mean; s2 += (v[j][0] * v[j][0] + v[j][1] * v[j][1]) + (v[j][2] * v[j][2] + v[j][3] * v[j][3]); }
    const float rstd = __builtin_amdgcn_rsqf(wave_sum(s2, lane) * (1.f / D) + LN_EPS);
#pragma unroll
    for (int j = 0; j < 4; ++j) v[j] = v[j] * rstd;
}

constexpr int PL = 24;
constexpr int NPHASE = 2 + 4 * PL;
__host__ __device__ inline bool phase_valid(int id) {
    if (id < 2) return true;
    const int layer = (id - 2) / PL, k = (id - 2) % PL;
    if (layer > 3) return false;
    if (k == 0 || (k >= 19 && k <= 22)) return true;
    if (layer & 1) return k >= 2 && k <= 5;
    return k >= 1 && k <= 18;
}


#define MOD ((float*)(ws + WS_MOD))
#define CTXX ((float*)(ws + WS_CTXX))
#define PRE ((float*)(ws + WS_PRE))
#define HIN ((bf16_t*)(ws + WS_HIN))
#define YB ((bf16_t*)(ws + WS_YB))
#define WIN ((bf16_t*)(ws + W_IN))
#define WQ ((bf16_t*)(ws + W_Q))
#define WK ((bf16_t*)(ws + W_K))
#define WV ((bf16_t*)(ws + W_V))
#define WOUT ((bf16_t*)(ws + W_OUT))
#define W1 ((bf16_t*)(ws + W_1))
#define W2 ((bf16_t*)(ws + W_2))
#define GATET ((bf16_t*)(ws + TAB_GATE))
#define S0 ((bf16_t*)(ws + WS_BIG + 0 * SLOT))
#define S1 ((bf16_t*)(ws + WS_BIG + 1 * SLOT))
#define S2 ((bf16_t*)(ws + WS_BIG + 2 * SLOT))
#define S3 ((bf16_t*)(ws + WS_BIG + 3 * SLOT))
#define S4 ((bf16_t*)(ws + WS_BIG + 4 * SLOT))
#define YH (YB + ((size_t)CR + (size_t)half * LH) * D)
#define YHC (YB + (size_t)half * LAT0 * D)
#define HCB (YH + (size_t)NCH * 4 * 2 * 4096 + (size_t)NCH * 4 * 2 * 384 * 2)
#define PREQ ((float*)(HCB + (size_t)LAT0 * DI))
#define HH (HIN + ((size_t)CR + (size_t)half * LH) * D)
#define HHC (HIN + (size_t)half * LAT0 * D)
#define HT ((bf16_t*)(ws + WS_BIG))
#define HTC (HT + (size_t)NB * D * T)
#define PB ((bf16_t*)(ws + WS_BIG + 1 * SLOT))
#define WC ((bf16_t*)(ws + WS_BIG + 3 * SLOT))
#define ZF ((bf16_t*)(ws + WS_BIG))
#define HID ((bf16_t*)(ws + WS_BIG))

constexpr int SC_PLD = 36, SC_VLD = 72;
#define SC_ROW0(j) (((j) < 4) ? (bl * CT + (dir ? 3 - (j) : (j)) * 64) : (LAT0 + bl * T + (dir ? 127 - ((j) - 4) : ((j) - 4)) * 64))
#define SC_LOADQ(dst, r0) do { _Pragma("unroll") for (int pt = 0; pt < 4; ++pt) _Pragma("unroll") for (int ks = 0; ks < 2; ++ks) \
        dst[pt][ks] = __builtin_bit_cast(bf16x8, __builtin_amdgcn_raw_buffer_load_b128(rW, loff, oQ + ((((((r0) >> 6) * 4 + hh) * 8 + w) * 4 + pt) * 2 + ks) * 1024, 0)); } while (0)
#define SC_LOADQ1(dst, r0, pt, ks) dst[pt][ks] = __builtin_bit_cast(bf16x8, __builtin_amdgcn_raw_buffer_load_b128(rW, loff, oQ + ((((((r0) >> 6) * 4 + hh) * 8 + w) * 4 + (pt)) * 2 + (ks)) * 1024, 0))
#define SC_LOADK1(dst, r0, mt, ks) dst[mt][ks] = __builtin_bit_cast(bf16x8, __builtin_amdgcn_raw_buffer_load_b128(rW, loff, oK + ((((((r0) >> 6) * 4 + hh) * 8 + w) * 4 + (mt)) * 2 + (ks)) * 1024, 0))
#define SC_LOADK(dst, r0) do { _Pragma("unroll") for (int mt = 0; mt < 4; ++mt) _Pragma("unroll") for (int ks = 0; ks < 2; ++ks) \
        dst[mt][ks] = __builtin_bit_cast(bf16x8, __builtin_amdgcn_raw_buffer_load_b128(rW, loff, oK + ((((((r0) >> 6) * 4 + hh) * 8 + w) * 4 + mt) * 2 + ks) * 1024, 0)); } while (0)
#define SC_LOADS(P, r0) do { const int ci_ = ((((r0) >> 6) * 4 + hh) * 2 + dir); \
        P##sg0 = __builtin_bit_cast(bf16x8, __builtin_amdgcn_raw_buffer_load_b128(rW, loff, oS + ci_ * 8192 + (w >> 1) * 2048, 0)); P##sg1 = __builtin_bit_cast(bf16x8, __builtin_amdgcn_raw_buffer_load_b128(rW, loff, oS + ci_ * 8192 + (w >> 1) * 2048 + 1024, 0)); \
        P##v = __builtin_bit_cast(u32x4, __builtin_amdgcn_raw_buffer_load_b128(rW, loff, oV + ((((r0) >> 6) * 4 + hh) * 16 + slice) * 4096 + (w & 3) * 1024, 0));     \
        P##wka = __builtin_bit_cast(u32x4, __builtin_amdgcn_raw_buffer_load_b128(rW, wkoff, oG + ci_ * 1536 + 1296, 0));         \
        P##wint = __builtin_bit_cast(float, __builtin_amdgcn_raw_buffer_load_b32(rW, gcp, oG + ci_ * 1536 + 512, 0)); P##em = __builtin_bit_cast(float, __builtin_amdgcn_raw_buffer_load_b32(rW, gcp, oG + ci_ * 1536 + 768, 0)); \
        P##dec = __builtin_bit_cast(float, __builtin_amdgcn_raw_buffer_load_b32(rW, 0, oG + ci_ * 1536 + 1280, 0)); } while (0)
#define SC_VWRITE(bufi, P) do { LAS bf16_t* vt_ = VB + (bufi) * 2 * 3072; LAS bf16_t* vw_ = vt_ + 3072; \
        if (w < 5) { const float wk_[8] = {bflo(P##wka.x), bfhi(P##wka.x), bflo(P##wka.y), bfhi(P##wka.y), bflo(P##wka.z), bfhi(P##wka.z), bflo(P##wka.w), bfhi(P##wka.w)};     \
            if (w < 4) { *(LAS u32x4*)(vt_ + tid * 8) = P##v; \
                u32x4 sv_; sv_.x = pk2(bflo(P##v.x) * wk_[0], bfhi(P##v.x) * wk_[1]); sv_.y = pk2(bflo(P##v.y) * wk_[2], bfhi(P##v.y) * wk_[3]); \
                sv_.z = pk2(bflo(P##v.z) * wk_[4], bfhi(P##v.z) * wk_[5]); sv_.w = pk2(bflo(P##v.w) * wk_[6], bfhi(P##v.w) * wk_[7]); *(LAS u32x4*)(vw_ + tid * 8) = sv_; } \
            else if (lane < 8) { const u32x4 sv_ = P##wka; \
                int ln_ = lane; asm volatile("" : "+v"(ln_));     \
                *(LAS u32x4*)(vw_ + (4 + (ln_ >> 2)) * 512 + (ln_ & 3) * 16 * 8) = sv_; } } } while (0)
#define SC_STEP(J, Qc, Qn, Kc, Kn, C, N) do { \
    const int j_ = (J); const int row0 = SC_ROW0(j_); const int jn_ = j_ < 131 ? j_ + 1 : 131; const int row1 = SC_ROW0(jn_); \
    const int hsel = (j_ < 4) ? (dir ? 2 : 0) : ((j_ < 68) ? 0 : 1); \
    const int buf = j_ & 1; \
    const LAS bf16_t* VT = VB + buf * 2 * 3072; const LAS bf16_t* VW = VT + 3072; \
    LAS bf16_t* Pb_ = Pbh + buf * (8 * 64 * 40); LAS float* Nq_ = NQs + buf * (8 * 64);        \
    SC_LOADS(N, row1); \
      \
    if (!(abl_ & 1)) _Pragma("unroll") for (int nt = 0; nt < 3; ++nt) { \
        f32x4 d1[4]; \
        _Pragma("unroll") for (int pt = 0; pt < 4; ++pt) d1[pt] = (f32x4){0.f, 0.f, 0.f, 0.f}; \
        _Pragma("unroll") for (int ks = 0; ks < 2; ++ks) { \
            u32x4 bw; bw.x = pg8::cvt_pk_bf16(st[2 * ks][nt][0], st[2 * ks][nt][1]); bw.y = pg8::cvt_pk_bf16(st[2 * ks][nt][2], st[2 * ks][nt][3]); \
            bw.z = pg8::cvt_pk_bf16(st[2 * ks + 1][nt][0], st[2 * ks + 1][nt][1]); bw.w = pg8::cvt_pk_bf16(st[2 * ks + 1][nt][2], st[2 * ks + 1][nt][3]); \
            const bf16x8 bs = __builtin_bit_cast(bf16x8, bw); \
            _Pragma("unroll") for (int pt = 0; pt < 4; ++pt) d1[pt] = __builtin_amdgcn_mfma_f32_16x16x32_bf16(bs, Qc[pt][ks], d1[pt], 0, 0, 0); \
            SC_LOADQ1(Qn, row1, (nt * 2 + ks) >> 1, (nt * 2 + ks) & 1);     } \
        _Pragma("unroll") for (int pt = 0; pt < 4; ++pt) { \
            if (nt < 2) { u32x2 pw_; pw_.x = pg8::cvt_pk_bf16(d1[pt][0], d1[pt][1]); pw_.y = pg8::cvt_pk_bf16(d1[pt][2], d1[pt][3]); *(LAS u32x2*)(Pb_ + (w * 64 + 16 * pt + fr) * 40 + 16 * nt + 4 * fq) = pw_; }     \
            else if (fq == 0) Nq_[w * 64 + 16 * pt + fr] = d1[pt][0]; } } \
    SC_LOADQ1(Qn, row1, 3, 0); SC_LOADQ1(Qn, row1, 3, 1); \
    LDS_BARRIER();                                                       \
      \
    f32x4 d2 = (f32x4){0.f, 0.f, 0.f, 0.f}, d3 = (f32x4){0.f, 0.f, 0.f, 0.f}; \
    if (!(abl_ & 2)) {     \
        const int nt2 = w & 1; \
        const bf16x8 vt0 = *(const LAS bf16x8*)(VT + (nt2 * 2 + 0) * 512 + lane * 8), vt1 = *(const LAS bf16x8*)(VT + (nt2 * 2 + 1) * 512 + lane * 8); \
        const bf16x8 vo0 = *(const LAS bf16x8*)(VT + 4 * 512 + lane * 8), vo1 = *(const LAS bf16x8*)(VT + 5 * 512 + lane * 8); \
        d2 = __builtin_amdgcn_mfma_f32_16x16x32_bf16(vt0, C##sg0, d2, 0, 0, 0); d3 = __builtin_amdgcn_mfma_f32_16x16x32_bf16(vo0, C##sg0, d3, 0, 0, 0); \
        d2 = __builtin_amdgcn_mfma_f32_16x16x32_bf16(vt1, C##sg1, d2, 0, 0, 0); d3 = __builtin_amdgcn_mfma_f32_16x16x32_bf16(vo1, C##sg1, d3, 0, 0, 0); } \
      \
    if (!(abl_ & 4)) _Pragma("unroll") for (int nt = 0; nt < 3; ++nt) { \
        const bf16x8 vw0 = *(const LAS bf16x8*)(VW + (nt * 2 + 0) * 512 + lane * 8), vw1 = *(const LAS bf16x8*)(VW + (nt * 2 + 1) * 512 + lane * 8); \
        _Pragma("unroll") for (int mt = 0; mt < 4; ++mt) { f32x4 a = st[mt][nt] * C##dec; \
            a = __builtin_amdgcn_mfma_f32_16x16x32_bf16(Kc[mt][0], vw0, a, 0, 0, 0); \
            a = __builtin_amdgcn_mfma_f32_16x16x32_bf16(Kc[mt][1], vw1, a, 0, 0, 0); st[mt][nt] = a; \
            if (nt < 2) SC_LOADK1(Kn, row1, (nt * 4 + mt) >> 1, (nt * 4 + mt) & 1); } } \
    if (!(abl_ & 8)) {     \
        f32x4 o1 = (f32x4){0.f, 0.f, 0.f, 0.f}; float nq = 0.f; \
        _Pragma("unroll") for (int ww = 0; ww < 8; ++ww) { const u32x2 cpr_ = *(const LAS u32x2*)(Pb_ + (ww * 64 + cp) * 40 + cv); nq += Nq_[ww * 64 + cp]; \
            o1 += (f32x4){bflo(cpr_.x), bfhi(cpr_.x), bflo(cpr_.y), bfhi(cpr_.y)}; } \
        const float den = C##wint * nq + d3[0]; const float scl = __builtin_amdgcn_rcpf(fmaxf(fabsf(den), C##em)); \
        const f32x4 o = (o1 * C##wint + d2) * scl; \
        u32x2 ow; ow.x = pk2(o[0], o[1]); ow.y = pk2(o[2], o[3]); \
        unsigned lo_ = loff; asm volatile("" : "+v"(lo_)); const unsigned hoff_ = ((lo_ >> 4) & 15u) * 64u + (lo_ >> 8) * 8u;     \
        __builtin_amdgcn_raw_buffer_store_b64(ow, rW, hoff_, (rep_ + 1 < SCAN_REP) ? (oC + 512 * DI * 2) : ((hsel == 0 ? oH : (hsel == 1 ? oV : oC)) + (((row0 >> 6) * 4 + hh) * 16 + slice) * 4096 + (w >> 1) * 1024 + (w & 1) * 32), 0); } \
    if (!(abl_ & 16)) SC_VWRITE(buf ^ 1, N);                                     \
} while (0)

__device__ __forceinline__ void scan_phase(LAS unsigned char* lds, unsigned char* ws, int half, const XcdBarrier& bar, int tid, int lane, int wave, int bx) {
    LAS bf16_t* Pbh = (LAS bf16_t*)lds;
    LAS float* NQs = (LAS float*)(lds + 2 * 8 * 64 * 40 * 2);
    LAS bf16_t* VB = (LAS bf16_t*)(NQs + 2 * 8 * 64);
    const int xcd = bx & 7, idx = bx >> 3;
    const int scn = (xcd * 2 + (idx >> 4)) & 15, slice = idx & 15;
    const int bl = scn >> 3, hh = (scn >> 1) & 3, dir = scn & 1, e0 = slice * 32;
    const int fr = lane & 15, fq = lane >> 4, w = wave;
    const int cp = 16 * (w >> 1) + fr, cv = 16 * (w & 1) + 4 * fq;
    const unsigned loff = (unsigned)lane * 16u;
    const unsigned gcp = (unsigned)cp * 4u;
    const unsigned wkoff = (w < 4) ? (unsigned)(32 * ((tid >> 6) & 1) + 8 * ((tid & 63) >> 4)) * 2u : (unsigned)(32 * ((lane >> 2) & 1) + 8 * (lane & 3)) * 2u;
    const __amdgpu_buffer_rsrc_t rW = __builtin_amdgcn_make_buffer_rsrc((void*)ws, 0, (int)(512 * MiB), 0x00020000);
    const int oYH = (int)(WS_YB + ((size_t)CR + (size_t)half * LH) * D * 2);
    const int oQ = (int)(WS_BIG + 3 * SLOT), oK = (int)(WS_BIG + 4 * SLOT), oV = (int)(WS_BIG + 2 * SLOT), oH = (int)(WS_BIG + 0 * SLOT);
    const int oS = oYH, oG = oYH + NCH * 4 * 2 * 8192, oC = oG + NCH * 4 * 2 * 1536;
    for (int i = tid; i < 4 * 1024; i += NTHR) { const int im = i >> 10, r = i & 1023, ln = (r & 511) >> 3; VB[im * 3072 + 2048 + r] = (bf16_t)(((im & 1) == 0 && (ln & 3) == 0) ? 0x3F80u : 0u); }
    __syncthreads();
    for (int rep_ = 0; rep_ < SCAN_REP; ++rep_) {
    const int abl_ = (rep_ + 1 < SCAN_REP) ? SC_ABL : 0;
    f32x4 st[4][3];
#pragma unroll
    for (int a = 0; a < 4; ++a)
#pragma unroll
        for (int b = 0; b < 3; ++b) st[a][b] = (f32x4){0.f, 0.f, 0.f, 0.f};
    bf16x8 Q0[4][2], Q1[4][2], K0[4][2], K1[4][2];
    bf16x8 Asg0, Asg1, Bsg0, Bsg1; u32x4 Av = (u32x4){0u, 0u, 0u, 0u}, Bv = Av, Awka = Av, Bwka = Av; float Awint, Aem, Adec, Bwint, Bem, Bdec;
    { const int r0 = SC_ROW0(0); SC_LOADQ(Q0, r0); SC_LOADK(K0, r0); SC_LOADS(A, r0); SC_VWRITE(0, A); }
#pragma unroll 1
    for (int j = 0; j < 132; j += 2) {
        if (j == 68) xcd_barrier(bar, tid == 0);
        SC_STEP(j, Q0, Q1, K0, K1, A, B);
        SC_STEP(j + 1, Q1, Q0, K1, K0, B, A);
    }
    __syncthreads();
    }
}
#undef SC_ROW0
#undef SC_LOADQ
#undef SC_LOADK
#undef SC_LOADS
#undef SC_VWRITE
#undef SC_STEP

typedef const __attribute__((address_space(4))) Args KA;
__device__ __forceinline__ KA* kargs() { KA* k = (KA*)__builtin_amdgcn_kernarg_segment_ptr(); asm volatile("" : "+s"(k)); return k; }
#define PH_BEGIN() \
    KA* ka = kargs(); unsigned char* ws = ka->ws; (void)ws; \
    int wave = wave0; asm volatile("" : "+s"(wave)); \
    unsigned lz_ = 0u; asm volatile("" : "+v"(lz_)); const int lane = (int)__builtin_amdgcn_mbcnt_hi(~0u, __builtin_amdgcn_mbcnt_lo(~0u, lz_)); \
    const int tid = wave * 64 + lane; (void)tid; \
    const int gw = bx * NWAVES + wave, NGW = G * NWAVES; (void)gw; (void)NGW;

__global__ void __launch_bounds__(NTHR, 2) fwd(Args args) {
    extern __shared__ __attribute__((aligned(16))) unsigned char lds_raw[];
    LAS unsigned char* lds = (LAS unsigned char*)lds_raw;
    const int G = gridDim.x, bx = blockIdx.x;
    const int wave0 = __builtin_amdgcn_readfirstlane(threadIdx.x >> 6);
    volatile LAS unsigned* MISC = (volatile LAS unsigned*)(lds + LDS_MISC);
    if (threadIdx.x < 64) MISC[threadIdx.x] = 0u;
    __syncthreads();
    XcdBarrier bar = xcd_barrier_post((unsigned*)(args.ws + WS_CTL + 65536) + (size_t)args.li * 4096, MISC + 8);
    const int lo = args.ph_lo, hi = args.ph_hi, plast = args.ph_last;
#define IN(k) (lo <= (k) && (k) < hi)
#define SEAM(k) do { if ((k) != plast) { xcd_barrier(bar, tid == 0); if (DUP_BAR) xcd_barrier(bar, tid == 0); } } while (0)

    if (EN_PRO && IN(0)) { PH_BEGIN();
        {
            LAS float* sc = (LAS float*)lds;
            for (int i = tid; i < 5 * D; i += NTHR) { const int r = i / D, k = i % D; const float x = r < 4 ? ka->in[I_C][r * D + k] : ka->in[I_CCTX][k]; sc[i] = siluf(x); }
            __syncthreads();
            LAS float* red = (LAS float*)(lds + 32768);
            const int kp = tid >> 6, cc = tid & 63;
            for (int item = bx; item < 4 * 96; item += G) {
                const int layer = item / 96, n0 = (item % 96) * 64;
                const float* w = ka->in[I_ADAW] + (size_t)layer * D * 6 * D + n0 + cc;
                float a0 = 0.f, a1 = 0.f, a2 = 0.f, a3 = 0.f, a4 = 0.f;
                for (int k = kp * 128; k < kp * 128 + 128; ++k) { const float wv = w[(size_t)k * 6 * D]; a0 += sc[k] * wv; a1 += sc[D + k] * wv; a2 += sc[2 * D + k] * wv; a3 += sc[3 * D + k] * wv; a4 += sc[4 * D + k] * wv; }
                red[(kp * 64 + cc) * 5 + 0] = a0; red[(kp * 64 + cc) * 5 + 1] = a1; red[(kp * 64 + cc) * 5 + 2] = a2; red[(kp * 64 + cc) * 5 + 3] = a3; red[(kp * 64 + cc) * 5 + 4] = a4;
                __syncthreads();
                if (tid < 320) { const int c2 = tid % 64, r = tid / 64; float s = ka->in[I_ADAB][layer * 6 * D + n0 + c2];
                    for (int q = 0; q < 8; ++q) s += red[(q * 64 + c2) * 5 + r];
                    MOD[((size_t)layer * 5 + r) * 6 * D + n0 + c2] = s; }
                __syncthreads();
            }
        }
        {
            bf16_t* A1 = (bf16_t*)(ws + TAB_A1); bf16_t* A2 = (bf16_t*)(ws + TAB_A2); bf16_t* BZ = (bf16_t*)(ws + TAB_BZ); bf16_t* ACTX = (bf16_t*)(ws + TAB_ACTX);
            const int gt = bx * NTHR + tid, NGT = G * NTHR;
            const float s8192 = 0.011048543456039806f;
            for (int i = gt; i < 512 * 256; i += NGT) { const int m = i / 256, t1 = i % 256, ri = m / 256, t1p = m % 256; const int ph = (t1 * t1p) & 255; float sn, cs; sincospif((float)ph * (2.0f / 256.0f), &sn, &cs);
                A1[i] = (bf16_t)f2bf((ri == 0 ? cs : -sn) * s8192);
                ACTX[i] = (bf16_t)f2bf((ri == 0 ? cs : -sn) * 0.0625f); }
            for (int i = gt; i < 256 * 64 * 64; i += NGT) { const int t1p = i / 4096, m = (i / 64) % 64, k = i % 64; const int rip = m / 32, t2p = m % 32, ri = k / 32, t2 = k % 32;
                const int ph = (t2 * t1p + 256 * t2 * t2p) & 8191; float sn, cs; sincospif((float)ph * (2.0f / 8192.0f), &sn, &cs);
                const float v = (rip == ri) ? cs : (rip == 0 ? sn : -sn); A2[i] = (bf16_t)f2bf(v); }
            for (int i = gt; i < 256 * 512; i += NGT) { const int cp = i / 512, k = i % 512, ri = k / 256, c = k % 256; const int ph = (c * cp) & 255; float sn, cs; sincospif((float)ph * (2.0f / 256.0f), &sn, &cs);
                BZ[i] = (bf16_t)f2bf((ri == 0 ? cs : sn) * 0.0625f); }
        }
        SEAM(0);
    }
    if (EN_PRO && IN(1)) { PH_BEGIN();
        for (int r = gw; r < R; r += NGW) {
            const RowInfo ri = row_info(r);
            const float* xr = ri.is_ctx ? ka->in[I_CTX] + ((size_t)ri.b * CT + ri.t) * D : ka->in[I_X] + ((size_t)ri.b * T + ri.t) * D;
            const float* md = MOD + ((size_t)0 * 5 + (ri.is_ctx ? 4 : ri.b)) * 6 * D;
            f32x4 v[4];
#pragma unroll
            for (int j = 0; j < 4; ++j) v[j] = *(const f32x4*)(xr + 256 * j + 4 * lane);
            ln_norm(v, lane);
            bf16_t* o = HIN + (size_t)r * D;
#pragma unroll
            for (int j = 0; j < 4; ++j) { const f32x4 sh = *(const f32x4*)(md + 256 * j + 4 * lane), sc = *(const f32x4*)(md + D + 256 * j + 4 * lane);
                const f32x4 h = v[j] * (1.0f + sc) + sh; u32x2 w; w.x = pk2(h[0], h[1]); w.y = pk2(h[2], h[3]); *(u32x2*)(o + 256 * j + 4 * lane) = w; }
        }
        SEAM(1);
    }

    for (int layer = 0; layer < 4; ++layer) {
        const int pb = 2 + layer * PL;
        if (hi <= pb || lo >= pb + PL) continue;
        const int jl = layer >> 1;
        const bool is_m = (layer & 1) == 0;
        if (EN_WC && IN(pb + 0)) { PH_BEGIN();
 for (int rp_ = 0; rp_ < REPN(5); ++rp_) {
            LAS float* scr = (LAS float*)(lds + wave * 16384);
            const int i_in = (D / 64) * (2 * DI / 32), i_h = (DH / 64) * (DH / 32), i_out = (DI / 64) * (D / 32), i_f = (D / 64) * (D / 32), i_1 = (D / 64) * (DFF / 32), i_2 = (DFF / 64) * (D / 32);
            const int n_mix = is_m ? (i_in + 12 * i_h + i_out) : i_f;
            const int nitems = n_mix + i_1 + i_2;
            for (int it = gw; it < nitems; it += NGW) {
                int r = it;
                if (r >= n_mix) { r -= n_mix;
                    if (r < i_1) transpose_item(ka->in[I_W1] + (size_t)layer * D * DFF, D, DFF, W1, 1.f, scr, r, lane);
                    else transpose_item(ka->in[I_W2] + (size_t)layer * DFF * D, DFF, D, W2, 1.f, scr, r - i_1, lane);
                    continue; }
                if (!is_m) { transpose_item(ka->in[I_FWOUT] + (size_t)jl * D * D, D, D, WOUT, 1.f, scr, r, lane); continue; }
                if (r < i_in) { transpose_item(ka->in[I_WIN] + (size_t)jl * D * 2 * DI, D, 2 * DI, WIN, 1.f, scr, r, lane); continue; } r -= i_in;
                if (r < 12 * i_h) { const int which = r / (4 * i_h), hh = (r / i_h) % 4, rr = r % i_h;
                    const float* src = ka->in[which == 0 ? I_WQ : (which == 1 ? I_WK : I_WV)] + ((size_t)jl * NH + hh) * DH * DH;
                    bf16_t* dst = (which == 0 ? WQ : (which == 1 ? WK : WV)) + (size_t)hh * DH * DH;
                    transpose_item(src, DH, DH, dst, which == 1 ? 0.044194173824159216f : 1.f, scr, rr, lane); continue; } r -= 12 * i_h;
                transpose_item(ka->in[I_WOUT] + (size_t)jl * DI * D, DI, D, WOUT, 1.f, scr, r, lane);
            }
            if (is_m) {
                const float* wg = ka->in[I_WGATE] + (size_t)jl * 3 * DI * 16;
                const int n = lane & 15, eq = lane >> 4;
                for (int k2 = gw; k2 < DI; k2 += NGW) {
                    const int hh = k2 / DH, d = k2 % DH;
                    const float* q = ka->in[I_WQ] + (((size_t)jl * NH + hh) * DH + d) * DH + eq * 128; const float* kx = ka->in[I_WK] + (((size_t)jl * NH + hh) * DH + d) * DH + eq * 128;
                    const float* vx = ka->in[I_WV] + (((size_t)jl * NH + hh) * DH + d) * DH + eq * 128;
                    const float* g0 = wg + ((size_t)0 * DI + hh * DH + eq * 128) * 16 + n; const float* g1 = wg + ((size_t)1 * DI + hh * DH + eq * 128) * 16 + n; const float* g2 = wg + ((size_t)2 * DI + hh * DH + eq * 128) * 16 + n;
                    float s0 = 0.f, s1 = 0.f, s2 = 0.f;
#pragma unroll 8
                    for (int e = 0; e < 128; ++e) { s0 += q[e] * g0[e * 16]; s1 += kx[e] * g1[e * 16]; s2 += vx[e] * g2[e * 16]; }
                    float sa = s0 + 0.044194173824159216f * s1;
                    sa += shx(sa, 16, lane); sa += shx(sa, 32, lane); s2 += shx(s2, 16, lane); s2 += shx(s2, 32, lane);
                    if (lane < 16) { GATET[(size_t)n * 4096 + k2] = (bf16_t)f2bf(sa); GATET[(size_t)n * 4096 + DI + k2] = (bf16_t)f2bf(s2); }
                    else if (lane < 64) { GATET[(size_t)(16 + (lane - 16)) * 4096 + k2] = (bf16_t)0; GATET[(size_t)(16 + (lane - 16)) * 4096 + DI + k2] = (bf16_t)0; }
                }
            }
 }
            SEAM(pb + 0);
        }

        if (EN_MIX && is_m) {
            for (int half = 0; half < 2; ++half) {
                const int hb = pb + 1 + 9 * half;
                if (hi <= hb || lo >= hb + 9) continue;
                if (IN(hb + 0)) { PH_BEGIN();
 for (int rp_ = 0; rp_ < REPN(0); ++rp_) {
                    pg8::Gemm g{HH, WIN, D, D, D, 0, 0, LH / 256, DI / 256, 1};
                    pg8::EpiStore E{S0 + (size_t)LAT0 * DI, 0, DI, 0};
                    pg8::gemm_phase(lds, g, E, G, bx, tid); if (DUP_MIX) pg8::gemm_phase(lds, g, E, G, bx, tid);
                    { SmallGemm sg{HHC, WIN, D, D, D, D, D, 0, 0}; SmallDense sd{S0, 0, DI, LAT0 / 64, DI / 64, 0, 0, 0}; gemm_small_dense(lds, sg, sd, 1, G, bx, tid); if (DUP_CTX) gemm_small_dense(lds, sg, sd, 1, G, bx, tid); }
 }
                    SEAM(hb + 0);
                }
                if (IN(hb + 1)) { PH_BEGIN();
 for (int rp_ = 0; rp_ < REPN(3); ++rp_) {
                    const float* wc = ka->in[I_WCONV] + (size_t)jl * 9 * DI; const float* bc = ka->in[I_BCONV] + (size_t)jl * DI;
                    const int gt = bx * NTHR + tid, NGT = G * NTHR;
                    for (int i = gt; i < 2 * 128 * 2 * (DI / 8); i += NGT) {
                        const int cg = i & 255, rest = i >> 8, hr = rest & 1, r = (rest >> 1) & 127, bl = rest >> 8, c0 = cg * 8, gc0 = 32 * hr;
                        float wv[9][8], bv[8];
#pragma unroll
                        for (int tp = 0; tp < 9; ++tp) { const f32x4 a0 = *(const f32x4*)(wc + (size_t)tp * DI + c0), a1 = *(const f32x4*)(wc + (size_t)tp * DI + c0 + 4);
                            wv[tp][0] = a0[0]; wv[tp][1] = a0[1]; wv[tp][2] = a0[2]; wv[tp][3] = a0[3]; wv[tp][4] = a1[0]; wv[tp][5] = a1[1]; wv[tp][6] = a1[2]; wv[tp][7] = a1[3]; }
                        { const f32x4 a0 = *(const f32x4*)(bc + c0), a1 = *(const f32x4*)(bc + c0 + 4); bv[0] = a0[0]; bv[1] = a0[1]; bv[2] = a0[2]; bv[3] = a0[3]; bv[4] = a1[0]; bv[5] = a1[1]; bv[6] = a1[2]; bv[7] = a1[3]; }
                        const bf16_t* xb = S0 + (size_t)(LAT0 + bl * T + r * 64) * DI + c0;
                        bf16_t* ob = S1 + (size_t)(LAT0 + bl * T + r * 64) * DI + c0;
                        const bool rok[3] = {r > 0, true, r < 127};
                        float win[3][3][8];
#define CV_LOADCOL(slot, col) do { _Pragma("unroll") for (int di = 0; di < 3; ++di) { u32x4 xv = (u32x4){0u, 0u, 0u, 0u}; \
                                if (rok[di] && (col) >= 0 && (col) < 64) xv = *(const u32x4*)(xb + (ptrdiff_t)((di - 1) * 64 + (col)) * DI); \
                                win[slot][di][0] = bflo(xv.x); win[slot][di][1] = bfhi(xv.x); win[slot][di][2] = bflo(xv.y); win[slot][di][3] = bfhi(xv.y); \
                                win[slot][di][4] = bflo(xv.z); win[slot][di][5] = bfhi(xv.z); win[slot][di][6] = bflo(xv.w); win[slot][di][7] = bfhi(xv.w); } } while (0)
#define CV_STEP(sl, sm, sr) do { CV_LOADCOL(sr, gc + 1); \
                                if (gc < gc0 + 32) { float acc[8]; \
                                    _Pragma("unroll") for (int e = 0; e < 8; ++e) { float s = bv[e]; \
                                        _Pragma("unroll") for (int di = 0; di < 3; ++di) s += win[sl][di][e] * wv[di * 3 + 0][e] + win[sm][di][e] * wv[di * 3 + 1][e] + win[sr][di][e] * wv[di * 3 + 2][e]; \
                                        acc[e] = siluf(s); } \
                                    u32x4 o; o.x = pk2(acc[0], acc[1]); o.y = pk2(acc[2], acc[3]); o.z = pk2(acc[4], acc[5]); o.w = pk2(acc[6], acc[7]); \
                                    *(u32x4*)(ob + (size_t)gc * DI) = o; } \
                                ++gc; } while (0)
                        int gc = gc0;
                        CV_LOADCOL(0, gc0 - 1); CV_LOADCOL(1, gc0);
#pragma unroll 1
                        for (int g3 = 0; g3 < 11; ++g3) { CV_STEP(0, 1, 2); CV_STEP(1, 2, 0); CV_STEP(2, 0, 1); }
#undef CV_LOADCOL
#undef CV_STEP
                    }
                    for (int i = gt; i < LAT0 * (DI / 8); i += NGT) {
                        const int q = i / (DI / 8), c0 = (i % (DI / 8)) * 8, t = q % CT;
                        float acc[8];
#pragma unroll
                        for (int e = 0; e < 8; ++e) acc[e] = bc[c0 + e];
#pragma unroll
                        for (int dj = 0; dj < 3; ++dj) { const int tt = t + dj - 1; if (tt < 0 || tt >= CT) continue;
                            const u32x4 xv = *(const u32x4*)(S0 + (size_t)(q + dj - 1) * DI + c0); const float* w = wc + (size_t)(3 + dj) * DI + c0;
                            acc[0] += bflo(xv.x) * w[0]; acc[1] += bfhi(xv.x) * w[1]; acc[2] += bflo(xv.y) * w[2]; acc[3] += bfhi(xv.y) * w[3];
                            acc[4] += bflo(xv.z) * w[4]; acc[5] += bfhi(xv.z) * w[5]; acc[6] += bflo(xv.w) * w[6]; acc[7] += bfhi(xv.w) * w[7]; }
                        u32x4 o; o.x = pk2(siluf(acc[0]), siluf(acc[1])); o.y = pk2(siluf(acc[2]), siluf(acc[3])); o.z = pk2(siluf(acc[4]), siluf(acc[5])); o.w = pk2(siluf(acc[6]), siluf(acc[7]));
                        *(u32x4*)(S1 + (size_t)q * DI + c0) = o;
                    }
 }
                    SEAM(hb + 1);
                }
                if (IN(hb + 2)) { PH_BEGIN();
 for (int rp_ = 0; rp_ < REPN(0); ++rp_) {
                    { pg8::Gemm g{WV, S0 + (size_t)LAT0 * DI, DH, DI, DH, (long)DH * DH, DH, DH / 256, LH / 256, NH};
                      pg8::EpiStore E{S2, 0, 0, 0, 3, LAT0};
                      pg8::gemm_phase(lds, g, E, G, bx, tid); if (DUP_MIX) pg8::gemm_phase(lds, g, E, G, bx, tid); }
                    { SmallGemm sg{WV, S0, DH, DI, DH, DH, DH, 0, 0}; SmallDense sd{S2, 0, 0, DH / 64, LAT0 / 64, 0, (long)DH * DH, DH, 3}; gemm_small_dense(lds, sg, sd, NH, G, bx, tid); if (DUP_CTX) gemm_small_dense(lds, sg, sd, NH, G, bx, tid); }
                    {
                      SmallGemm sg{S1, GATET, DI, 4096, 1024, 1024, 1024, 0, 0};
                      const long xm_off = (long)(S0 - S1);
                      auto dec = [=](int uq, long& ao, long& bo) { const int u = uq >> 2, q = uq & 3; ao = (long)u * 64 * DI + (q & 1) * 1024 + (q >> 1) * xm_off; bo = q * 1024; };
                      auto epi = [=](int uq, int m, int n, const f32x4& v) { const int u = uq >> 2, q = uq & 3; if (n < 16) *(f32x4*)(PREQ + (size_t)q * RH * 16 + ((size_t)u * 64 + m) * 16 + n) = v; };
                      gemm_small(lds, sg, NCH * 4, dec, epi, G, bx, tid); }
 }
                    SEAM(hb + 2);
                }
                if (IN(hb + 3)) { PH_BEGIN();
 for (int rp_ = 0; rp_ < REPN(0); ++rp_) {
                    { pg8::Gemm g{S1 + (size_t)LAT0 * DI, WQ, DI, DH, DH, DH, (long)DH * DH, LH / 256, DH / 256, NH}; pg8::EpiStore E{S3, DH, DI, 0, 1, LAT0}; pg8::gemm_phase(lds, g, E, G, bx, tid); if (DUP_MIX) pg8::gemm_phase(lds, g, E, G, bx, tid); }
                    { SmallGemm sg{S1, WQ, DI, DH, DH, DH, DH, 0, 0}; SmallDense sd{S3, DH, DI, LAT0 / 64, DH / 64, 0, DH, (long)DH * DH, 1}; gemm_small_dense(lds, sg, sd, NH, G, bx, tid); if (DUP_CTX) gemm_small_dense(lds, sg, sd, NH, G, bx, tid); }
                    { pg8::Gemm g{S1 + (size_t)LAT0 * DI, WK, DI, DH, DH, DH, (long)DH * DH, LH / 256, DH / 256, NH}; pg8::EpiStore E{S0 + (size_t)LAT0 * DI, DH, DI, 0}; pg8::gemm_phase(lds, g, E, G, bx, tid); if (DUP_MIX) pg8::gemm_phase(lds, g, E, G, bx, tid); }
                    { SmallGemm sg{S1, WK, DI, DH, DH, DH, DH, 0, 0}; SmallDense sd{S0, DH, DI, LAT0 / 64, DH / 64, 0, DH, (long)DH * DH}; gemm_small_dense(lds, sg, sd, NH, G, bx, tid); if (DUP_CTX) gemm_small_dense(lds, sg, sd, NH, G, bx, tid); }
                    { pg8::Gemm g{WK, S1 + (size_t)LAT0 * DI, DH, DI, DH, (long)DH * DH, DH, DH / 256, LH / 256, NH}; pg8::EpiStore E{S4, (long)DH * RH, RH, 0, 2, LAT0}; pg8::gemm_phase(lds, g, E, G, bx, tid); if (DUP_MIX) pg8::gemm_phase(lds, g, E, G, bx, tid); }
                    { SmallGemm sg{WK, S1, DH, DI, DH, DH, DH, 0, 0}; SmallDense sd{S4, (long)DH * RH, RH, DH / 64, LAT0 / 64, 0, (long)DH * DH, DH, 2}; gemm_small_dense(lds, sg, sd, NH, G, bx, tid); if (DUP_CTX) gemm_small_dense(lds, sg, sd, NH, G, bx, tid); }
                    if (bx < 16) {
                        const int sc = bx, bl = sc >> 3, hh = (sc >> 1) & 3, dir = sc & 1;
                        LAS float* bcs = (LAS float*)lds;
                        LAS float* vss = bcs + 132 * 64;
                        LAS float* bl_ = vss + 132 * 64;
                        LAS float* vm_ = bl_ + 132;
                        LAS float* mi_ = vm_ + 132;
                        const int u = lane, p = dir ? 63 - u : u;
                        const float* bgp = ka->in[I_BGATE] + (size_t)jl * 16 + 8 * dir + hh;
#pragma unroll
                        for (int i = 0; i < 17; ++i) { const int j = wave + 8 * i;
                            if (j < 132) { int row0; if (j < 4) { const int c = dir ? 3 - j : j; row0 = bl * CT + c * 64; } else { const int c = dir ? 127 - (j - 4) : (j - 4); row0 = LAT0 + bl * T + c * 64; }
                                const float* pr = PREQ + (size_t)(row0 + p) * 16 + 8 * dir + hh; const size_t qs = (size_t)RH * 16;
                                bcs[j * 64 + p] = (pr[4] + pr[qs + 4]) + (pr[2 * qs + 4] + pr[3 * qs + 4]) + bgp[4]; vss[j * 64 + p] = (pr[0] + pr[qs]) + (pr[2 * qs] + pr[3 * qs]) + bgp[0]; } }
                        asm volatile("s_waitcnt vmcnt(0) lgkmcnt(0)" ::: "memory");
#pragma unroll 1
                        for (int i = 0; i < 17; ++i) { const int j = wave + 8 * i;
                            if (j < 132) { const float f = bcs[j * 64 + p], lia = vss[j * 64 + p]; float x = fminf(f, 0.f) - log1pf(__expf(-fabsf(f)));
                                x = scan_add64(x);
                                const float v = lia - x; float pm = v;
                                pm = scan_max64(pm);
                                bcs[j * 64 + p] = x; vss[j * 64 + p] = v; if (u == 63) { bl_[j] = x; vm_[j] = pm; } } }
                        __syncthreads();
                        if (wave == 0) {
                            const float ni = -__builtin_inff();
                            float ea[3], eb[3];
#pragma unroll
                            for (int t = 0; t < 3; ++t) { const int j = 3 * lane + t; const bool ok = j < 132; const float blj = bl_[ok ? j : 0], vmj = vm_[ok ? j : 0]; ea[t] = ok ? blj : 0.f; eb[t] = ok ? blj + vmj : ni; }
                            float A = ea[0] + ea[1], B = fmaxf(eb[0] + ea[1], eb[1]); B = fmaxf(B + ea[2], eb[2]); A += ea[2];
#define G12_STEP(CTRL, RM) do { const float pa_ = dppf<CTRL, RM>(0.f, A), pb_ = dppf<CTRL, RM>(ni, B); B = fmaxf(pb_ + A, B); A += pa_; } while (0)
                            G12_STEP(0x111, 0xF); G12_STEP(0x112, 0xF); G12_STEP(0x114, 0xF); G12_STEP(0x118, 0xF); G12_STEP(0x142, 0xA); G12_STEP(0x143, 0xC);
#undef G12_STEP
                            float EA = shup(A, 1, lane), EB = shup(B, 1, lane); if (lane == 0) { EA = 0.f; EB = ni; }
                            float m = fmaxf(EA, EB);
#pragma unroll
                            for (int t = 0; t < 3; ++t) { const int j = 3 * lane + t; if (j < 132) { mi_[j] = m; m = fmaxf(m + ea[t], eb[t]); } }
                        }
                        __syncthreads();
                        float* GPw = (float*)(YH + (size_t)NCH * 4 * 2 * 4096);
#pragma unroll 1
                        for (int i = 0; i < 17; ++i) { const int j = wave + 8 * i;
                            if (j < 132) { int row0; if (j < 4) { const int c = dir ? 3 - j : j; row0 = bl * CT + c * 64; } else { const int c = dir ? 127 - (j - 4) : (j - 4); row0 = LAT0 + bl * T + c * 64; }
                                const float bc = bcs[j * 64 + p], v = vss[j * 64 + p]; float pm = v;
                                pm = scan_max64(pm);
                                const float m_in = mi_[j], btot = bl_[j], m_new = btot + fmaxf(m_in, vm_[j]);
                                const float uu = -fmaxf(m_in, pm);
                                float* gp = GPw + ((size_t)((row0 >> 6) * 4 + hh) * 2 + dir) * 384;
                                gp[p] = uu; gp[64 + p] = v; gp[128 + p] = __expf(m_in + uu); gp[192 + p] = __expf(uu - bc); ((bf16_t*)(gp + 324))[p] = (bf16_t)f2bf(__expf(btot - m_new + v));
                                if (u == 0) gp[320] = __expf(btot + m_in - m_new); } }
                    }
 }
                    SEAM(hb + 3);
                }
                if (IN(hb + 4)) { PH_BEGIN();
 for (int rp_ = 0; rp_ < REPN(4); ++rp_) {
                    SmallGemm sg{S3, S0, DI, DI, DH, DH, DH, 0, 0, 1};
                    bf16_t* SGw = YH; const float* GPr = (const float*)(YH + (size_t)NCH * 4 * 2 * 4096);
                    auto dec = [=](int u, long& ao, long& bo) { const int ch = u >> 2, hh = u & 3; ao = u; bo = (long)ch * 64 * DI + hh * DH; };
                    auto epi = [=](int u, int m, int n, const f32x4& v) {
#pragma unroll
                        for (int dir = 0; dir < 2; ++dir) { const float* gp = GPr + ((size_t)u * 2 + dir) * 384; const float up = gp[m]; const f32x4 vs = *(const f32x4*)(gp + 64 + n); float o[4];
#pragma unroll
                            for (int i = 0; i < 4; ++i) { const int s = n + i; const bool ok = dir ? (s >= m) : (s <= m); const float gte = ok ? __expf(up + vs[i]) : 0.f; o[i] = v[i] * gte; }
                            u32x2 w; w.x = pk2(o[0], o[1]); w.y = pk2(o[2], o[3]);
                            *(u32x2*)(SGw + ((size_t)u * 2 + dir) * 4096 + ((m >> 4) * 2 + (n >> 5)) * 512 + (((n >> 3) & 3) * 16 + (m & 15)) * 8 + (n & 7)) = w; } };
                    gemm_small(lds, sg, NCH * 4, dec, epi, G, bx, tid);
 }
                    SEAM(hb + 4);
                }
                if (EN_SCAN && IN(hb + 5)) { PH_BEGIN();
                    scan_phase(lds, ws, half, bar, tid, lane, wave, bx);
                    SEAM(hb + 5);
                }
                if (IN(hb + 6)) { PH_BEGIN();
 for (int rp_ = 0; rp_ < REPN(0); ++rp_) {
                    pg8::Gemm g{HH, WIN + (size_t)DI * D, D, D, D, 0, 0, LH / 256, DI / 256, 1};
                    pg8::EpiStore E{S3 + (size_t)LAT0 * DI, 0, DI, 0};
                    pg8::gemm_phase(lds, g, E, G, bx, tid); if (DUP_MIX) pg8::gemm_phase(lds, g, E, G, bx, tid);
                    if (layer < 2) { SmallGemm sg{HHC, WIN + (size_t)DI * D, D, D, D, D, D, 0, 0}; SmallDense sd{S3, 0, DI, LAT0 / 64, DI / 64, 0, 0, 0}; gemm_small_dense(lds, sg, sd, 1, G, bx, tid); if (DUP_CTX) gemm_small_dense(lds, sg, sd, 1, G, bx, tid); }
 }
                    SEAM(hb + 6);
                }
                if (IN(hb + 7)) { PH_BEGIN();
 for (int rp_ = 0; rp_ < REPN(3); ++rp_) {
                    const float* gn = ka->in[I_GNW] + (size_t)jl * DI; const float* sk = ka->in[I_SKIP] + (size_t)jl * DI;
#define RO_LOAD(q_, A, B, XC, ZZ) do { const bf16_t* h2_ = ((q_) < LAT0) ? HCB : S2; \
                        _Pragma("unroll") for (int hd = 0; hd < 4; ++hd) { const size_t ho_ = htile_off(q_, hd, 8 * lane); const size_t ro_ = (size_t)(q_) * DI + hd * DH + 8 * lane; \
                            A[hd] = *(const u32x4*)(S0 + ho_); B[hd] = *(const u32x4*)(h2_ + ho_); XC[hd] = *(const u32x4*)(S1 + ro_); ZZ[hd] = *(const u32x4*)(S3 + ro_); } } while (0)
                    u32x4 ra[4], rb[4], rx[4], rz[4], na[4], nb[4], nx[4], nz[4];
#pragma unroll
                    for (int hd = 0; hd < 4; ++hd) { ra[hd] = (u32x4){0u, 0u, 0u, 0u}; rb[hd] = ra[hd]; rx[hd] = ra[hd]; rz[hd] = ra[hd]; na[hd] = ra[hd]; nb[hd] = ra[hd]; nx[hd] = ra[hd]; nz[hd] = ra[hd]; }
                    const int q_first = (layer < 2 ? 0 : LAT0) + gw;
                    if (q_first < RH) RO_LOAD(q_first, ra, rb, rx, rz);
                    for (int q = q_first; q < RH; q += NGW) {
                        if (q + NGW < RH) RO_LOAD(q + NGW, na, nb, nx, nz);
#pragma unroll
                        for (int hd = 0; hd < 4; ++hd) {
                            const int c0 = hd * DH + 8 * lane;
                            const u32x4 a = ra[hd], b = rb[hd];
                            float v[8] = {bflo(a.x) + bflo(b.x), bfhi(a.x) + bfhi(b.x), bflo(a.y) + bflo(b.y), bfhi(a.y) + bfhi(b.y), bflo(a.z) + bflo(b.z), bfhi(a.z) + bfhi(b.z), bflo(a.w) + bflo(b.w), bfhi(a.w) + bfhi(b.w)};
                            float s = 0.f;
#pragma unroll
                            for (int i = 0; i < 8; ++i) s += v[i];
                            const float mean = wave_sum(s, lane) * (1.f / DH); float s2 = 0.f;
#pragma unroll
                            for (int i = 0; i < 8; ++i) { v[i] -= mean; s2 += v[i] * v[i]; }
                            const float rstd = __builtin_amdgcn_rsqf(wave_sum(s2, lane) * (1.f / DH) + LN_EPS);
                            const u32x4 xc = rx[hd], zz = rz[hd];
                            const float xcf[8] = {bflo(xc.x), bfhi(xc.x), bflo(xc.y), bfhi(xc.y), bflo(xc.z), bfhi(xc.z), bflo(xc.w), bfhi(xc.w)};
                            const float zf[8] = {bflo(zz.x), bfhi(zz.x), bflo(zz.y), bfhi(zz.y), bflo(zz.z), bfhi(zz.z), bflo(zz.w), bfhi(zz.w)};
                            float o[8];
#pragma unroll
                            for (int i = 0; i < 8; ++i) o[i] = (v[i] * rstd * gn[c0 + i] + sk[c0 + i] * xcf[i]) * siluf(zf[i]);
                            u32x4 w; w.x = pk2(o[0], o[1]); w.y = pk2(o[2], o[3]); w.z = pk2(o[4], o[5]); w.w = pk2(o[6], o[7]);
                            *(u32x4*)(S4 + (size_t)q * DI + c0) = w;
                        }
#pragma unroll
                        for (int hd = 0; hd < 4; ++hd) { ra[hd] = na[hd]; rb[hd] = nb[hd]; rx[hd] = nx[hd]; rz[hd] = nz[hd]; }
                    }
#undef RO_LOAD
 }
                    SEAM(hb + 7);
                }
                if (IN(hb + 8)) { PH_BEGIN();
 for (int rp_ = 0; rp_ < REPN(0); ++rp_) {
                    pg8::Gemm g{S4 + (size_t)LAT0 * DI, WOUT, DI, DI, DI, 0, 0, LH / 256, D / 256, 1};
                    pg8::EpiStore E{YH, 0, D, 0};
                    pg8::gemm_phase(lds, g, E, G, bx, tid); if (DUP_MIX) pg8::gemm_phase(lds, g, E, G, bx, tid);
                    if (layer < 2) { SmallGemm sg{S4, WOUT, DI, DI, DI, DI, DI, 0, 0}; SmallDense sd{YHC, 0, D, LAT0 / 64, D / 64, 0, 0, 0}; gemm_small_dense(lds, sg, sd, 1, G, bx, tid); if (DUP_CTX) gemm_small_dense(lds, sg, sd, 1, G, bx, tid); }
 }
                    SEAM(hb + 8);
                }
            }
        } else if (EN_FOUR) {
            const bool has_ctx = layer < 3;
            if (IN(pb + 2)) { PH_BEGIN();
 for (int rp_ = 0; rp_ < REPN(2); ++rp_) {
                { pg8::Gemm g{(const bf16_t*)(ws + TAB_A1), HT, 256, 256, 256, 0, (long)D * T, 2, 128, NB};
                  pg8::EpiStore E{PB, (long)512 * 32768, 32768, 0};
                  pg8::gemm_phase(lds, g, E, G, bx, tid); if (DUP_MIX) pg8::gemm_phase(lds, g, E, G, bx, tid); }
                if (has_ctx) {
                    SmallGemm sg{(const bf16_t*)(ws + TAB_ACTX), HTC, 256, 256, 256, 256, 256, 0, 0};
                    auto dec = [=](int u, long& ao, long& bo) { const int b = u / 128, mb = (u / 16) % 8, cht = u % 16; ao = (long)mb * 64 * 256; bo = ((long)b * D + cht * 64) * CT; };
                    auto epi = [=](int u, int m, int n, const f32x4& v) { const int b = u / 128, mb = (u / 16) % 8, cht = u % 16; const int mg = mb * 64 + m, ri = mg >> 8, tp = mg & 255, ch = cht * 64 + n;
                        u32x2 w; w.x = pk2(v[0], v[1]); w.y = pk2(v[2], v[3]); *(u32x2*)(WC + (size_t)ctx_row(b, tp) * DI + (ch >> 8) * 512 + ri * 256 + (ch & 255)) = w; };
                    gemm_small(lds, sg, NB * 8 * 16, dec, epi, G, bx, tid);
                }
 }
                SEAM(pb + 2);
            }
            if (IN(pb + 3)) { PH_BEGIN();
 for (int rp_ = 0; rp_ < REPN(2); ++rp_) {
                {
                    const int wid = tid >> 6, wm = wid >> 1, wn = wid & 1, fr = lane & 15, fq = lane >> 4;
                    const int lrow = tid >> 3, lk = (tid & 7) * 8;
                    const unsigned stoff = (unsigned)(lrow * SG_LD + lk) * 2u;
                    LAS unsigned char* As = lds; LAS unsigned char* Bs0 = lds + SG_TILE; LAS unsigned char* Bs1 = lds + 2 * SG_TILE;
                    const bf16_t* A2 = (const bf16_t*)(ws + TAB_A2);
                    for (int pair = bx; pair < NB * 256; pair += G) {
                        const int b = pair >> 8, t1p = pair & 255;
                        const bf16_t* bp = PB + (size_t)b * 512 * 32768 + (size_t)((lk >> 5) * 256 + t1p) * 32768 + (size_t)lrow * 32 + (lk & 31);
                        u32x4 r0 = *(const u32x4*)(bp), r1 = *(const u32x4*)(bp + 2048), r2 = *(const u32x4*)(bp + 2 * 2048), r3 = *(const u32x4*)(bp + 3 * 2048);
                        *(LAS u32x4*)(As + stoff) = *(const u32x4*)(A2 + (size_t)t1p * 4096 + lrow * 64 + lk);
                        *(LAS u32x4*)(Bs0 + stoff) = r0;
                        LDS_BARRIER();
                        bf16x8 af[2];
#pragma unroll
                        for (int ks = 0; ks < 2; ++ks) af[ks] = *(const LAS bf16x8*)(As + ((wm * 16 + fr) * SG_LD + ks * 32 + fq * 8) * 2);
#define F2_TILE(ct_, BsC, BsN, rcur, rnext) do { \
                            if ((ct_) + 4 < 16) rcur = *(const u32x4*)(bp + ((ct_) + 4) * 2048); \
                            f32x4 acc[2] = {(f32x4){0.f, 0.f, 0.f, 0.f}, (f32x4){0.f, 0.f, 0.f, 0.f}}; \
                            _Pragma("unroll") for (int ks = 0; ks < 2; ++ks) _Pragma("unroll") for (int nt = 0; nt < 2; ++nt) { \
                                const bf16x8 bf = *(const LAS bf16x8*)(BsC + ((wn * 32 + nt * 16 + fr) * SG_LD + ks * 32 + fq * 8) * 2); \
                                acc[nt] = __builtin_amdgcn_mfma_f32_16x16x32_bf16(bf, af[ks], acc[nt], 0, 0, 0); } \
                            if ((ct_) + 1 < 16) *(LAS u32x4*)(BsN + stoff) = rnext; \
                            _Pragma("unroll") for (int nt = 0; nt < 2; ++nt) { const int m = wm * 16 + fr, n = wn * 32 + nt * 16 + fq * 4, rip = m >> 5, t2p = m & 31, ch = (ct_) * 64 + n; \
                                u32x2 w2; w2.x = pk2(acc[nt][0], acc[nt][1]); w2.y = pk2(acc[nt][2], acc[nt][3]); \
                                *(u32x2*)(WC + (size_t)lat_row(b, t1p + 256 * t2p) * DI + (ch >> 8) * 512 + rip * 256 + (ch & 255)) = w2; } \
                            LDS_BARRIER(); } while (0)
#pragma unroll 1
                        for (int ct = 0; ct < 16; ct += 4) { F2_TILE(ct, Bs0, Bs1, r0, r1); F2_TILE(ct + 1, Bs1, Bs0, r1, r2); F2_TILE(ct + 2, Bs0, Bs1, r2, r3); F2_TILE(ct + 3, Bs1, Bs0, r3, r0); }
#undef F2_TILE
                    }
                }
 }
                SEAM(pb + 3);
            }
            if (IN(pb + 4)) { PH_BEGIN();
 for (int rp_ = 0; rp_ < REPN(2); ++rp_) {
                pg8::Gemm g{WC + (size_t)CR * DI, (const bf16_t*)(ws + TAB_BZ), DI, 512, 512, 512, 0, (R - CR) / 256, 1, 4};
                pg8::EpiStore E{ZF + (size_t)CR * D, 256, D, 0};
                pg8::gemm_phase(lds, g, E, G, bx, tid); if (DUP_MIX) pg8::gemm_phase(lds, g, E, G, bx, tid);
                if (has_ctx) { SmallGemm sg{WC, (const bf16_t*)(ws + TAB_BZ), DI, 512, 512, 512, 512, 0, 0}; SmallDense sd{ZF, 256, D, CR / 64, 256 / 64, 0, 512, 0}; gemm_small_dense(lds, sg, sd, 4, G, bx, tid); if (DUP_CTX) gemm_small_dense(lds, sg, sd, 4, G, bx, tid); }
 }
                SEAM(pb + 4);
            }
            if (IN(pb + 5)) { PH_BEGIN();
 for (int rp_ = 0; rp_ < REPN(2); ++rp_) {
                pg8::Gemm g{ZF + (size_t)CR * D, WOUT, D, D, D, 0, 0, (R - CR) / 256, D / 256, 1};
                pg8::EpiStore E{YB + (size_t)CR * D, 0, D, 0};
                pg8::gemm_phase(lds, g, E, G, bx, tid); if (DUP_MIX) pg8::gemm_phase(lds, g, E, G, bx, tid);
                if (has_ctx) { SmallGemm sg{ZF, WOUT, D, D, D, D, D, 0, 0}; SmallDense sd{YB, 0, D, CR / 64, D / 64, 0, 0, 0}; gemm_small_dense(lds, sg, sd, 1, G, bx, tid); if (DUP_CTX) gemm_small_dense(lds, sg, sd, 1, G, bx, tid); }
 }
                SEAM(pb + 5);
            }
        }
#pragma unroll 1
        for (int which = 0; which < 2; ++which) {
            const int pid = pb + (which == 0 ? 19 : 22);
            if (EN_NORM && IN(pid)) { PH_BEGIN();
                const float* pg = ka->in[I_PG] + ((size_t)layer * 2 + which) * D; const float* pbv = ka->in[I_PB] + ((size_t)layer * 2 + which) * D;
                const int mlayer = which == 0 ? layer : layer + 1;
                const int shoff = which == 0 ? 3 * D : 0;
                const int goff = which == 0 ? 2 * D : 5 * D;
                const bool in_f32 = (layer == 0 && which == 0), out_f32 = (layer == 3 && which == 1);
                bf16_t* xbl = (bf16_t*)ka->out; bf16_t* xb3 = S4;
#define NR_LOAD(r_, XW, YW) do { const RowInfo ri_ = row_info(r_); const size_t xi_ = ri_.is_ctx ? ((size_t)ri_.b * CT + ri_.t) * D : ((size_t)ri_.b * T + ri_.t) * D; \
                    const bf16_t* yr_ = YB + (size_t)(r_) * D; \
                    if (in_f32) { const float* xp_ = (ri_.is_ctx ? ka->in[I_CTX] : ka->in[I_X]) + xi_; _Pragma("unroll") for (int j = 0; j < 4; ++j) XW[j] = *(const u32x4*)(xp_ + 256 * j + 4 * lane); } \
                    else { const bf16_t* xp_ = ri_.is_ctx ? (const bf16_t*)CTXX + xi_ : ((layer == 3 && which == 1) ? xb3 + xi_ : xbl + xi_); \
                        _Pragma("unroll") for (int j = 0; j < 4; ++j) { const u32x2 t_ = *(const u32x2*)(xp_ + 256 * j + 4 * lane); XW[j] = (u32x4){t_.x, t_.y, 0u, 0u}; } } \
                    _Pragma("unroll") for (int j = 0; j < 4; ++j) YW[j] = *(const u32x2*)(yr_ + 256 * j + 4 * lane); } while (0)
                if (which == 1 && (layer & 1) == 0) {
                    constexpr int TLD = 1026;
                    LAS bf16_t* TL = (LAS bf16_t*)lds;
                    const float* md2b = MOD + ((size_t)mlayer * 5) * 6 * D + shoff;
#define NT_ROW(r_, i_) do { const RowInfo ri = row_info(r_); const int mi = ri.is_ctx ? 4 : ri.b; \
                        const size_t xi = ri.is_ctx ? ((size_t)ri.b * CT + ri.t) * D : ((size_t)ri.b * T + ri.t) * D; \
                        bf16_t* xout16 = ri.is_ctx ? (bf16_t*)CTXX + xi : xbl + xi; \
                        const float* md = MOD + ((size_t)layer * 5 + mi) * 6 * D; f32x4 v[4]; \
                        _Pragma("unroll") for (int j = 0; j < 4; ++j) { const int c = 256 * j + 4 * lane; const f32x4 x = (f32x4){bflo(xw[j].x), bfhi(xw[j].x), bflo(xw[j].y), bfhi(xw[j].y)}; \
                            const f32x4 gt = *(const f32x4*)(md + goff + c); const f32x4 y = (f32x4){bflo(yw[j].x), bfhi(yw[j].x), bflo(yw[j].y), bfhi(yw[j].y)}; v[j] = x * ALPHA + gt * y; } \
                        ln_norm(v, lane); \
                        _Pragma("unroll") for (int j = 0; j < 4; ++j) { const int c = 256 * j + 4 * lane; v[j] = v[j] * *(const f32x4*)(pg + c) + *(const f32x4*)(pbv + c); \
                            u32x2 xo; xo.x = pk2(v[j][0], v[j][1]); xo.y = pk2(v[j][2], v[j][3]); *(u32x2*)(xout16 + c) = xo; } \
                        ln_norm(v, lane); \
                        const float* md2 = md2b + (size_t)mi * 6 * D; \
                        _Pragma("unroll") for (int j = 0; j < 4; ++j) { const int c = 256 * j + 4 * lane; const f32x4 sh = *(const f32x4*)(md2 + c), sc = *(const f32x4*)(md2 + D + c); \
                            const f32x4 h = v[j] * (1.0f + sc) + sh; LAS unsigned* d_ = (LAS unsigned*)(TL + (i_) * TLD + c); d_[0] = pk2(h[0], h[1]); d_[1] = pk2(h[2], h[3]); } } while (0)
                    u32x4 xw[4], xn[4]; u32x2 yw[4], yn[4];
#pragma unroll
                    for (int j = 0; j < 4; ++j) { xw[j] = (u32x4){0u, 0u, 0u, 0u}; xn[j] = xw[j]; yw[j] = (u32x2){0u, 0u}; yn[j] = yw[j]; }
                    for (int item = bx; item < NB * 32 * 4; item += G) {
                        const int b = item >> 7, t2 = (item >> 2) & 31, tb = item & 3;
                        const int rbase = lat_row(b, 32 * (64 * tb + wave * 8) + t2);
                        NR_LOAD(rbase, xw, yw);
#pragma unroll 1
                        for (int j8 = 0; j8 < 8; ++j8) {
                            if (j8 < 7) NR_LOAD(rbase + 32 * (j8 + 1), xn, yn);
                            NT_ROW(rbase + 32 * j8, wave * 8 + j8);
#pragma unroll
                            for (int j = 0; j < 4; ++j) { xw[j] = xn[j]; yw[j] = yn[j]; }
                        }
                        LDS_BARRIER();
#pragma unroll 4
                        for (int k = 0; k < 16; ++k) { const int idx = k * NTHR + tid, g8 = idx & 7, ch = idx >> 3; const LAS bf16_t* s = TL + (8 * g8) * TLD + ch;
                            u32x4 o; o.x = (unsigned)s[0] | ((unsigned)s[TLD] << 16); o.y = (unsigned)s[2 * TLD] | ((unsigned)s[3 * TLD] << 16); o.z = (unsigned)s[4 * TLD] | ((unsigned)s[5 * TLD] << 16); o.w = (unsigned)s[6 * TLD] | ((unsigned)s[7 * TLD] << 16);
                            *(u32x4*)(HT + (((size_t)b * D + ch) * 32 + t2) * 256 + 64 * tb + 8 * g8) = o; }
                        LDS_BARRIER();
                    }
                    if (layer < 2) {
                        for (int item = bx; item < NB * (CT / 8); item += G) {
                            const int b = item / (CT / 8), t8 = item % (CT / 8);
                            const int r = ctx_row(b, 8 * t8 + wave);
                            NR_LOAD(r, xw, yw);
                            NT_ROW(r, wave);
                            LDS_BARRIER();
#pragma unroll
                            for (int k = 0; k < 2; ++k) { const int ch = k * NTHR + tid; const LAS bf16_t* s = TL + ch;
                                u32x4 o; o.x = (unsigned)s[0] | ((unsigned)s[TLD] << 16); o.y = (unsigned)s[2 * TLD] | ((unsigned)s[3 * TLD] << 16); o.z = (unsigned)s[4 * TLD] | ((unsigned)s[5 * TLD] << 16); o.w = (unsigned)s[6 * TLD] | ((unsigned)s[7 * TLD] << 16);
                                *(u32x4*)(HTC + ((size_t)b * D + ch) * CT + 8 * t8) = o; }
                            LDS_BARRIER();
                        }
                    }
#undef NT_ROW
                } else {
                const int r_first = (layer < 2 ? 0 : CR) + gw;
                u32x4 xw[4], xn[4]; u32x2 yw[4], yn[4];
#pragma unroll
                for (int j = 0; j < 4; ++j) { xw[j] = (u32x4){0u, 0u, 0u, 0u}; xn[j] = xw[j]; yw[j] = (u32x2){0u, 0u}; yn[j] = yw[j]; }
                if (r_first < R) NR_LOAD(r_first, xw, yw);
                for (int r = r_first; r < R; r += NGW) {
                    if (r + NGW < R) NR_LOAD(r + NGW, xn, yn);
                    const RowInfo ri = row_info(r);
                    const int mi = ri.is_ctx ? 4 : ri.b;
                    const size_t xi = ri.is_ctx ? ((size_t)ri.b * CT + ri.t) * D : ((size_t)ri.b * T + ri.t) * D;
                    bf16_t* xout16 = ri.is_ctx ? (bf16_t*)CTXX + xi : ((layer == 3 && which == 0) ? xb3 + xi : xbl + xi);
                    const float* md = MOD + ((size_t)layer * 5 + mi) * 6 * D;
                    f32x4 v[4];
#pragma unroll
                    for (int j = 0; j < 4; ++j) { const int c = 256 * j + 4 * lane; f32x4 x; if (in_f32) x = __builtin_bit_cast(f32x4, xw[j]); else x = (f32x4){bflo(xw[j].x), bfhi(xw[j].x), bflo(xw[j].y), bfhi(xw[j].y)};
                        const f32x4 gt = *(const f32x4*)(md + goff + c);
                        const f32x4 y = (f32x4){bflo(yw[j].x), bfhi(yw[j].x), bflo(yw[j].y), bfhi(yw[j].y)}; v[j] = x * ALPHA + gt * y; }
                    ln_norm(v, lane);
#pragma unroll
                    for (int j = 0; j < 4; ++j) { const int c = 256 * j + 4 * lane; v[j] = v[j] * *(const f32x4*)(pg + c) + *(const f32x4*)(pbv + c);
                        if (out_f32) *(f32x4*)(ka->out + xi + c) = v[j]; else { u32x2 xo; xo.x = pk2(v[j][0], v[j][1]); xo.y = pk2(v[j][2], v[j][3]); *(u32x2*)(xout16 + c) = xo; } }
                    if (mlayer < 4) {
                        const float* md2 = MOD + ((size_t)mlayer * 5 + mi) * 6 * D + shoff;
                        ln_norm(v, lane);
                        bf16_t* o = HIN + (size_t)r * D;
#pragma unroll
                        for (int j = 0; j < 4; ++j) { const int c = 256 * j + 4 * lane; const f32x4 sh = *(const f32x4*)(md2 + c), sc = *(const f32x4*)(md2 + D + c);
                            const f32x4 h = v[j] * (1.0f + sc) + sh; u32x2 w; w.x = pk2(h[0], h[1]); w.y = pk2(h[2], h[3]); *(u32x2*)(o + c) = w; }
                    }
#pragma unroll
                    for (int j = 0; j < 4; ++j) { xw[j] = xn[j]; yw[j] = yn[j]; }
                }
                }
#undef NR_LOAD
                SEAM(pid);
            }
            if (EN_MLP && which == 0) {
                if (IN(pb + 20)) { PH_BEGIN();
 for (int rp_ = 0; rp_ < REPN(1); ++rp_) {
                    pg8::Gemm g{HIN + (size_t)CR * D, W1, D, D, D, 0, 0, (R - CR) / 256, DFF / 256, 1};
                    pg8::EpiStore E{HID + (size_t)CR * DFF, 0, DFF, 1};
                    pg8::gemm_phase(lds, g, E, G, bx, tid);
#if DUP_MLP
                    pg8::gemm_phase(lds, g, E, G, bx, tid);
#endif
                    if (layer < 2) { SmallGemm sg{HIN, W1, D, D, D, D, D, 0, 0}; SmallDense sd{HID, 0, DFF, CR / 64, DFF / 64, 1, 0, 0}; gemm_small_dense(lds, sg, sd, 1, G, bx, tid); }
 }
                    SEAM(pb + 20);
                }
                if (IN(pb + 21)) { PH_BEGIN();
 for (int rp_ = 0; rp_ < REPN(1); ++rp_) {
                    pg8::Gemm g{HID + (size_t)CR * DFF, W2, DFF, DFF, DFF, 0, 0, (R - CR) / 256, D / 256, 1};
                    pg8::EpiStore E{YB + (size_t)CR * D, 0, D, 0};
                    pg8::gemm_phase(lds, g, E, G, bx, tid);
#if DUP_MLP
                    pg8::gemm_phase(lds, g, E, G, bx, tid);
#endif
                    if (layer < 2) { SmallGemm sg{HID, W2, DFF, DFF, DFF, DFF, DFF, 0, 0}; SmallDense sd{YB, 0, D, CR / 64, D / 64, 0, 0, 0}; gemm_small_dense(lds, sg, sd, 1, G, bx, tid); }
 }
                    SEAM(pb + 21);
                }
            }
        }
    }
#undef IN
#undef SEAM
}

extern "C" void kernel_launch(void* const* d_in, const int* in_sizes, int n_in, void* d_out, int out_size, void* d_ws, size_t ws_size, hipStream_t stream) {
    static int grid = 0;
    if (grid == 0) {
        if (n_in != 22 || ws_size < 512 * MiB) { fprintf(stderr, "kernel_launch: unexpected n_in %d / ws_size %zu\n", n_in, ws_size); grid = -1; return; }
        int dev = 0, cus = 0;
        if (hipGetDevice(&dev) != hipSuccess || hipDeviceGetAttribute(&cus, hipDeviceAttributeMultiprocessorCount, dev) != hipSuccess) { grid = -1; return; }
        if (hipFuncSetAttribute((const void*)fwd, hipFuncAttributeMaxDynamicSharedMemorySize, LDS_BYTES) != hipSuccess) { fprintf(stderr, "kernel_launch: hipFuncSetAttribute failed\n"); grid = -1; return; }
        int per_cu = 0;
        if (hipOccupancyMaxActiveBlocksPerMultiprocessor(&per_cu, (const void*)fwd, NTHR, LDS_BYTES) != hipSuccess || per_cu < 1) fprintf(stderr, "kernel_launch: occupancy query says %d\n", per_cu);
        (void)hipGetLastError();
        grid = cus;
        if (grid != 256) fprintf(stderr, "kernel_launch: %d CUs (built for 256)\n", grid);
    }
    if (grid < 0) return;
    (void)hipMemsetAsync((char*)d_ws + WS_CTL, 0, CTL_BYTES, stream);
    Args a{};
    for (int i = 0; i < 22; ++i) a.in[i] = (const float*)d_in[i];
    a.out = (float*)d_out; a.ws = (unsigned char*)d_ws;
#if MK_SINGLE
    { int last = 0; for (int id = 0; id < NPHASE; ++id) if (phase_valid(id)) last = id;
      a.ph_lo = 0; a.ph_hi = NPHASE; a.ph_last = last; a.li = 0;
      hipLaunchKernelGGL(fwd, dim3(grid), dim3(NTHR), LDS_BYTES, stream, a); }
#else
    { int li = 0;
      for (int id = 0; id < NPHASE; ++id) { if (!phase_valid(id)) continue;
          a.ph_lo = id; a.ph_hi = id + 1; a.ph_last = id; a.li = li++;
          hipLaunchKernelGGL(fwd, dim3(grid), dim3(NTHR), LDS_BYTES, stream, a); } }
#endif
}
```

```cpp
#include <hip/hip_runtime.h>
#include <cstdio>
#include <cstdint>

#define LAS __attribute__((address_space(3)))
typedef unsigned short bf16_t;
typedef short bf16x8 __attribute__((ext_vector_type(8)));
typedef float f32x4 __attribute__((ext_vector_type(4)));
typedef unsigned u32x4 __attribute__((ext_vector_type(4)));
typedef unsigned u32x2 __attribute__((ext_vector_type(2)));


#ifndef EN_PRO
#define EN_PRO 1
#endif
#ifndef EN_WC
#define EN_WC 1
#endif
#ifndef EN_MIX
#define EN_MIX 1
#endif
#ifndef EN_SCAN
#define EN_SCAN 1
#endif
#ifndef EN_FOUR
#define EN_FOUR 1
#endif
#ifndef EN_NORM
#define EN_NORM 1
#endif
#ifndef EN_MLP
#define EN_MLP 1
#endif
#ifndef DUP_MIX
#define DUP_MIX 0
#endif
#ifndef DUP_CTX
#define DUP_CTX 0
#endif
#ifndef DUP_BAR
#define DUP_BAR 0
#endif
#ifndef DUP_MLP
#define DUP_MLP 0
#endif
#ifndef REP_MASK
#define REP_MASK 0
#endif
#define REPN(bit) (((REP_MASK) >> (bit)) & 1 ? 2 : 1)
#ifndef SC_QPAD
#define SC_QPAD 64
#endif
#ifndef SC_ABL
#define SC_ABL 0
#endif
#ifndef SCAN_REP
#define SCAN_REP 1
#endif
#ifndef MK_SINGLE
#define MK_SINGLE 1
#endif

constexpr int D = 1024, NB = 4, T = 8192, CT = 256, DI = 2048, NH = 4, DH = 512, DFF = 4096;
constexpr int R = NB * (T + CT);
constexpr int RH = R / 2;
constexpr int LAT0 = 2 * CT;
constexpr int NCH = RH / 64;
constexpr float ALPHA = 1.6817928305074290f;
constexpr float LN_EPS = 1e-5f;
constexpr int NWAVES = 8, NTHR = 512;

constexpr size_t MiB = 1u << 20;
constexpr size_t WS_CTL = 0, CTL_BYTES = 2 * MiB;
constexpr size_t WS_MOD = 2 * MiB;
constexpr size_t WS_CTXX = 3 * MiB;
constexpr size_t WS_PRE = 7 * MiB;
constexpr size_t WS_TAB = 10 * MiB;
constexpr size_t TAB_A1 = WS_TAB;
constexpr size_t TAB_A2 = TAB_A1 + 512 * 256 * 2;
constexpr size_t TAB_BZ = TAB_A2 + 256 * 64 * 64 * 2;
constexpr size_t TAB_ACTX = TAB_BZ + 256 * 512 * 2;
constexpr size_t TAB_GATE = TAB_ACTX + 512 * 256 * 2;
static_assert(TAB_GATE + 64 * 4096 * 2 <= 15 * MiB, "tables");
constexpr size_t WS_W = 15 * MiB;
constexpr size_t W_IN = WS_W;
constexpr size_t W_Q = W_IN + 8 * MiB, W_K = W_Q + 2 * MiB, W_V = W_K + 2 * MiB;
constexpr size_t W_OUT = W_V + 2 * MiB;
constexpr size_t W_1 = W_OUT + 4 * MiB;
constexpr size_t W_2 = W_1 + 8 * MiB;
static_assert(W_2 + 8 * MiB <= 49 * MiB, "weights");
constexpr size_t WS_HIN = 49 * MiB;
constexpr size_t WS_YB = 115 * MiB;
constexpr size_t WS_BIG = 181 * MiB;
constexpr size_t SLOT = 66 * MiB;
static_assert(WS_BIG + 5 * SLOT <= 512 * MiB, "workspace");
static_assert((size_t)RH * DI * 2 == SLOT, "slot");

#define LDS_BARRIER() do { asm volatile("s_waitcnt lgkmcnt(0)" ::: "memory"); __builtin_amdgcn_s_barrier(); asm volatile("" ::: "memory"); } while (0)
__device__ __forceinline__ unsigned f2bf(float f) { unsigned u = __builtin_bit_cast(unsigned, f); return (u + 0x7fffu + ((u >> 16) & 1u)) >> 16; }
typedef __bf16 bf16x2_t __attribute__((ext_vector_type(2)));
typedef float f32x2_t __attribute__((ext_vector_type(2)));
__device__ __forceinline__ unsigned pk2(float lo, float hi) { const f32x2_t v = {lo, hi}; return __builtin_bit_cast(unsigned, __builtin_convertvector(v, bf16x2_t)); }
__device__ __forceinline__ float bf2f(unsigned short b) { return __builtin_bit_cast(float, ((unsigned)b) << 16); }
__device__ __forceinline__ float u2f(unsigned u) { return __builtin_bit_cast(float, u); }
__device__ __forceinline__ float bflo(unsigned w) { return __builtin_bit_cast(float, w << 16); }
__device__ __forceinline__ float bfhi(unsigned w) { return __builtin_bit_cast(float, w & 0xffff0000u); }
__device__ __forceinline__ float shx(float v, int mask, int lane) { return __builtin_bit_cast(float, __builtin_amdgcn_ds_bpermute((lane ^ mask) << 2, __builtin_bit_cast(int, v))); }
template <int CTRL, int RMASK> __device__ __forceinline__ float dppf(float idv, float src) { return __builtin_bit_cast(float, __builtin_amdgcn_update_dpp(__builtin_bit_cast(int, idv), __builtin_bit_cast(int, src), CTRL, RMASK, 0xF, false)); }
__device__ __forceinline__ float scan_add64(float x) {
    x += dppf<0x111, 0xF>(0.f, x); x += dppf<0x112, 0xF>(0.f, x); x += dppf<0x114, 0xF>(0.f, x); x += dppf<0x118, 0xF>(0.f, x);
    x += dppf<0x142, 0xA>(0.f, x); x += dppf<0x143, 0xC>(0.f, x); return x; }
__device__ __forceinline__ float scan_max64(float x) {
    const float ni = -__builtin_inff();
    x = fmaxf(x, dppf<0x111, 0xF>(ni, x)); x = fmaxf(x, dppf<0x112, 0xF>(ni, x)); x = fmaxf(x, dppf<0x114, 0xF>(ni, x)); x = fmaxf(x, dppf<0x118, 0xF>(ni, x));
    x = fmaxf(x, dppf<0x142, 0xA>(ni, x)); x = fmaxf(x, dppf<0x143, 0xC>(ni, x)); return x; }
__device__ __forceinline__ float shup(float v, int d, int lane) { return __builtin_bit_cast(float, __builtin_amdgcn_ds_bpermute((lane - d) << 2, __builtin_bit_cast(int, v))); }
__device__ __forceinline__ float wave_sum(float v, int lane) {
    (void)lane;
    return __builtin_bit_cast(float, __builtin_amdgcn_readlane(__builtin_bit_cast(int, scan_add64(v)), 63));
}
__device__ __forceinline__ float siluf(float x) { return x * __builtin_amdgcn_rcpf(1.0f + __expf(-x)); }

struct RowInfo { int is_ctx, b, t; };
__device__ __forceinline__ RowInfo row_info(int r) {
    RowInfo ri;
    if (r < NB * CT) { ri.is_ctx = 1; ri.b = r / CT; ri.t = r % CT; }
    else { ri.is_ctx = 0; const int u = r - NB * CT; ri.b = u / T; ri.t = u % T; }
    return ri;
}
__device__ __forceinline__ int lat_row(int b, int t) { return NB * CT + b * T + t; }
__device__ __forceinline__ int ctx_row(int b, int t) { return b * CT + t; }
constexpr int CR = NB * CT;
constexpr int LH = RH - LAT0;

#define XB_TMO      128
#define XB_XCNT(j)  (256  + 64 * (j))
#define XB_XSUB(j)  (1280 + 64 * (j))
#define XB_XGEN(j)  (2304 + 64 * (j))
#define XB_TOP      3328
#define XB_TOPGEN   3392
#define XCD_BAR_WORDS 3456
#define XB_SPIN_CAP (1u << 18)

__device__ __forceinline__ unsigned xb_ld(unsigned* p)              { return __hip_atomic_load(p, __ATOMIC_RELAXED, __HIP_MEMORY_SCOPE_AGENT); }
__device__ __forceinline__ unsigned xb_add(unsigned* p, unsigned v) { return __hip_atomic_fetch_add(p, v, __ATOMIC_RELAXED, __HIP_MEMORY_SCOPE_AGENT); }
__device__ __forceinline__ unsigned xb_xcc_id() { return (unsigned)__builtin_amdgcn_s_getreg((3 << 11) | 20) & 0xFu; }
#define XB_SPIN(cond, bar) do { unsigned _sp = 0; while (cond) { __builtin_amdgcn_s_sleep(1); \
    if ((++_sp & 255u) == 0u) { if (xb_ld(&(bar)[XB_TMO])) break; if (_sp > XB_SPIN_CAP) { atomicAdd(&(bar)[XB_TMO], 1u); break; } } } } while (0)

struct XcdBarrier { unsigned* bar; unsigned x; volatile LAS unsigned* st; };

__device__ __forceinline__ XcdBarrier xcd_barrier_post(unsigned* bar, volatile LAS unsigned* st) {
    XcdBarrier b; b.bar = bar; b.x = xb_xcc_id(); b.st = st;
    if (threadIdx.x == 0) (void)xb_add(&bar[XB_XCNT(b.x)], 1u);
    return b;
}
__device__ __forceinline__ void xcd_barrier_complete(unsigned* bar, unsigned x, unsigned& nloc, unsigned& nx) {
    const unsigned G = gridDim.x * gridDim.y * gridDim.z;
    unsigned sum, cnt, mine, sp = 0u;
    for (;;) {
        sum = 0u; cnt = 0u; mine = 0u;
#pragma unroll
        for (unsigned j = 0; j < 16; ++j) { const unsigned c = xb_ld(&bar[XB_XCNT(j)]); sum += c; cnt += (c > 0u) ? 1u : 0u; mine = (j == x) ? c : mine; }
        if (sum == G) break;
        __builtin_amdgcn_s_sleep(1);
        if ((++sp & 255u) == 0u) { if (xb_ld(&bar[XB_TMO])) break; if (sp > XB_SPIN_CAP) { atomicAdd(&bar[XB_TMO], 1u); break; } }
    }
    nloc = mine > 0u ? mine : 1u; nx = cnt > 0u ? cnt : 1u;
}
__device__ __forceinline__ void xcd_barrier(const XcdBarrier& b, bool thread0) {
    asm volatile("s_waitcnt vmcnt(0)" ::: "memory");
    __syncthreads();
    if (thread0) {
        unsigned* bar = b.bar;
        __builtin_amdgcn_s_waitcnt(0);
        unsigned nloc = b.st[0], nx = b.st[1];
        if (nloc == 0u) { xcd_barrier_complete(bar, b.x, nloc, nx); b.st[0] = nloc; b.st[1] = nx; }
        const unsigned old = xb_add(&bar[XB_XSUB(b.x)], 1u);
        const unsigned gen = old / nloc;
        if (old + 1u == (gen + 1u) * nloc) {
            __builtin_amdgcn_fence(__ATOMIC_RELEASE, "agent");
            asm volatile("s_waitcnt vmcnt(0)" ::: "memory");
            const unsigned og = xb_add(&bar[XB_TOP], 1u);
            const unsigned tg = og / nx;
            if (og + 1u == (tg + 1u) * nx) xb_add(&bar[XB_TOPGEN], 1u);
            else XB_SPIN(xb_ld(&bar[XB_TOPGEN]) == tg, bar);
            __builtin_amdgcn_fence(__ATOMIC_ACQUIRE, "agent");
            xb_add(&bar[XB_XGEN(b.x)], 1u);
            asm volatile("s_waitcnt vmcnt(0)" ::: "memory");
        } else {
            XB_SPIN(xb_ld(&bar[XB_XGEN(b.x)]) == gen, bar);
            __builtin_amdgcn_fence(__ATOMIC_ACQUIRE, "agent");
            asm volatile("s_waitcnt vmcnt(0)" ::: "memory");
        }
    }
    __syncthreads();
}

__device__ __forceinline__ size_t qtile_off(int q, int h, int cc) {
    const int chunk = q >> 6, p = q & 63, pt = p >> 4, fr = p & 15, w = cc >> 6, ks = (cc >> 5) & 1, fq = (cc >> 3) & 3;
    const size_t blk = ((((size_t)chunk * 4 + h) * 8 + w) * 4 + pt) * 2 + ks;
    return blk * 512 + (size_t)(fq * 16 + fr) * 8 + (cc & 7);
}
__device__ __forceinline__ size_t ktile_off(int d, int h, int q) {
    const int chunk = q >> 6, s = q & 63, ks = s >> 5, fq = (s >> 3) & 3, w = d >> 6, dd = d & 63, mt = 2 * (dd >> 5) + ((dd >> 2) & 1), frp = 4 * ((dd >> 3) & 3) + (dd & 3);
    const size_t blk = ((((size_t)chunk * 4 + h) * 8 + w) * 4 + mt) * 2 + ks;
    return blk * 512 + (size_t)(fq * 16 + frp) * 8 + (s & 7);
}

__device__ __forceinline__ size_t vtile_off(int e, int h, int q) {
    const int chunk = q >> 6, s = q & 63, slice = e >> 5, e5 = e & 31, nt = e5 >> 4, fr = e5 & 15, ks = s >> 5, fq = (s >> 3) & 3;
    const size_t blk = ((((size_t)chunk * 4 + h) * 16 + slice) * 2 + nt) * 2 + ks;
    return blk * 512 + (size_t)(fq * 16 + fr) * 8 + (s & 7);
}
__device__ __forceinline__ size_t htile_off(int q, int h, int e) {
    return ((((size_t)(q >> 6) * 4 + h) * 16 + (e >> 5)) * 2048) + (size_t)(q & 63) * 32 + (e & 31);
}

namespace pg8 {
constexpr int BM = 256, BK = 64, HALF = 128, HTB = HALF * BK * 2, STAGE_BYTES = 8 * HTB, NXCD = 8, WGM = 8;
__device__ __forceinline__ int lds_byte(int r, int c) { const int st = (r >> 4) * 2 + (c >> 5), rr = r & 15, cc = c & 31, ob = rr * 64 + cc * 2; return st * 1024 + (ob ^ (((ob >> 9) & 1) << 5)); }
__device__ __forceinline__ void stage_rc(int b, int& R_, int& C_) { const int st = b / 1024, sb = b % 1024, swz = sb ^ (((sb >> 9) & 1) << 5); R_ = (st >> 1) * 16 + swz / 64; C_ = (st & 1) * 32 + (swz % 64) / 2; }
__device__ __forceinline__ int perm32(int rho) { const int n = rho >> 4, i = rho & 15; return 8 * (i >> 2) + 4 * n + (i & 3); }

struct Unit { int pm, pn, g; };
struct Gemm {
    const bf16_t* A; const bf16_t* Bt; int lda, ldb, K;
    long a_gs, b_gs;
    int nM, nN, nG;
};
struct Order {
    int nM, nNt, nN, nwg, G, c;
    __device__ void init(const Gemm& g, int G_, int c_) { nM = g.nM; nN = g.nN; nNt = g.nN * g.nG; nwg = nM * nNt; G = G_; c = c_; }
    __device__ bool next(int i, Unit& u) const {
        const long L = (long)i * G + c; if (L >= nwg) return false;
        int wgid = (int)L; { const int q = nwg / NXCD, r = nwg % NXCD, xcd = wgid % NXCD, off = wgid / NXCD; wgid = (xcd < r ? xcd * (q + 1) : r * (q + 1) + (xcd - r) * q) + off; }
        const int nig = WGM * nNt, gid = wgid / nig, fm = gid * WGM, gsz = (nM - fm) < WGM ? (nM - fm) : WGM;
        u.pm = fm + ((wgid % nig) % gsz); const int pnt = (wgid % nig) / gsz; u.g = pnt / nN; u.pn = pnt - u.g * nN; return true;
    }
};
__device__ __forceinline__ unsigned cvt_pk_bf16(float lo, float hi) { return pk2(lo, hi); }

struct EpiStore {
    bf16_t* O; long o_gs; int ldc; int act;
    int mode, off;
    __device__ __forceinline__ void operator()(const f32x4 (&acc)[2][2][4][2], const Unit& u, int wr, int wc, int fr, int fq) const {
        const int row0 = u.pm * BM + wr * 64 + fr; const int col0 = u.pn * BM + wc * 32 + 8 * fq; bf16_t* base = O + (long)u.g * o_gs;
#pragma unroll
        for (int ai = 0; ai < 2; ++ai)
#pragma unroll
            for (int m = 0; m < 4; ++m) { bf16_t* rowp = base + (size_t)(row0 + ai * HALF + m * 16) * ldc + col0;
#pragma unroll
                for (int bj = 0; bj < 2; ++bj) { f32x4 v0 = acc[ai][bj][m][0], v1 = acc[ai][bj][m][1];
                    if (act == 1) {
#pragma unroll
                        for (int j = 0; j < 4; ++j) { const float a = fmaxf(v0[j], 0.f), b = fmaxf(v1[j], 0.f); v0[j] = a * a; v1[j] = b * b; } }
                    u32x4 w; w.x = cvt_pk_bf16(v0[0], v0[1]); w.y = cvt_pk_bf16(v0[2], v0[3]); w.z = cvt_pk_bf16(v1[0], v1[1]); w.w = cvt_pk_bf16(v1[2], v1[3]);
                    if (mode == 0) *(u32x4*)(rowp + bj * HALF) = w;
                    else if (mode == 1) *(u32x4*)(O + qtile_off(off + row0 + ai * HALF + m * 16, u.g, col0 + bj * HALF)) = w;
                    else if (mode == 2) *(u32x4*)(O + ktile_off(row0 + ai * HALF + m * 16, u.g, off + col0 + bj * HALF)) = w;
                    else *(u32x4*)(O + vtile_off(row0 + ai * HALF + m * 16, u.g, off + col0 + bj * HALF)) = w; } }
    }
};

template <class Epi>
__device__ __forceinline__ void gemm_phase(LAS unsigned char* lds, const Gemm g, const Epi& E, int G_, int c_, int tid_in) {
    int tid_ = tid_in; asm volatile("" : "+v"(tid_));
    const int tid = tid_, wid = __builtin_amdgcn_readfirstlane(tid >> 6), lane = tid & 63, wr = wid >> 2, wc = wid & 3, fr = lane & 15, fq = lane >> 4;
    const int K = g.K, nt = K / BK;
    Order S; S.init(g, G_, c_);
    unsigned voffA[2], voffB[2];
#pragma unroll
    for (int i = 0; i < 2; ++i) { int R_, C_; stage_rc(tid * 16 + i * 8192, R_, C_); const int Rb = (R_ & ~31) + perm32(R_ & 31);
        voffA[i] = (unsigned)(R_ * g.lda + C_) * 2u; voffB[i] = (unsigned)(Rb * g.ldb + C_) * 2u; }
    const size_t kstep = (size_t)(BK * 2);
    const size_t hstepA = (size_t)HALF * g.lda * 2, hstepB = (size_t)HALF * g.ldb * 2;
    const unsigned ldsw = (unsigned)wid * 1024u;
    const int aoff = lds_byte(wr * 64 + fr, fq * 8), boff = lds_byte(wc * 32 + fr, fq * 8);
#define PG8_SA(b, h) (((b) * 2 + (h)) * HTB)
#define PG8_SB(b, h) ((4 + (b) * 2 + (h)) * HTB)
#define PG8_STAGE(bufoff, gbase, voff) do { _Pragma("unroll") for (int _i = 0; _i < 2; ++_i) \
        __builtin_amdgcn_global_load_lds((const unsigned*)((const char*)(gbase) + (voff)[_i]), (LAS unsigned*)(lds + (bufoff) + ldsw + _i * 8192), 16, 0, 0); } while (0)
#define PG8_LDA(dst, b, h) do { _Pragma("unroll") for (int m = 0; m < 4; ++m) _Pragma("unroll") for (int k = 0; k < 2; ++k) dst[m][k] = *(const LAS bf16x8*)(lds + PG8_SA(b, h) + aoff + m * 2048 + k * 1024); } while (0)
#define PG8_LDB(dst, b, h) do { _Pragma("unroll") for (int n = 0; n < 2; ++n) _Pragma("unroll") for (int k = 0; k < 2; ++k) dst[n][k] = *(const LAS bf16x8*)(lds + PG8_SB(b, h) + boff + n * 2048 + k * 1024); } while (0)
#define PG8_MMA(ai, bj, At, Bt) do { __builtin_amdgcn_s_setprio(1); _Pragma("unroll") for (int m = 0; m < 4; ++m) _Pragma("unroll") for (int n = 0; n < 2; ++n) _Pragma("unroll") for (int k = 0; k < 2; ++k) \
        acc[ai][bj][m][n] = __builtin_amdgcn_mfma_f32_16x16x32_bf16(Bt[n][k], At[m][k], acc[ai][bj][m][n], 0, 0, 0); __builtin_amdgcn_s_setprio(0); } while (0)
#define PG8_WAIT_V(n) asm volatile("s_waitcnt vmcnt(" #n ")" ::: "memory")
#define PG8_WAIT_L(n) asm volatile("s_waitcnt lgkmcnt(" #n ")" ::: "memory")
#define PG8_BAR __builtin_amdgcn_s_barrier()
#define PG8_SCHED __builtin_amdgcn_sched_barrier(0)
#define PG8_APTR(u) ((const char*)(g.A + (long)(u).g * g.a_gs) + (size_t)(u).pm * 2 * hstepA)
#define PG8_BPTR(u) ((const char*)(g.Bt + (long)(u).g * g.b_gs) + (size_t)(u).pn * 2 * hstepB)
    Unit cur, nxt; int ui = 0;
    if (!S.next(0, cur)) return;
    f32x4 acc[2][2][4][2];
#pragma unroll
    for (int a = 0; a < 2; ++a)
#pragma unroll
        for (int b = 0; b < 2; ++b)
#pragma unroll
            for (int m = 0; m < 4; ++m)
#pragma unroll
                for (int n = 0; n < 2; ++n) acc[a][b][m][n] = (f32x4){0.f, 0.f, 0.f, 0.f};
    bf16x8 At[4][2], B0[2][2], B1[2][2];
    const char* cA = PG8_APTR(cur); const char* cB = PG8_BPTR(cur);
    PG8_STAGE(PG8_SB(0, 0), cB, voffB); PG8_STAGE(PG8_SA(0, 0), cA, voffA); PG8_STAGE(PG8_SB(0, 1), cB + hstepB, voffB); PG8_STAGE(PG8_SA(0, 1), cA + hstepA, voffA);
    if (wr == 1) PG8_BAR;
    PG8_WAIT_V(4); PG8_BAR;
    PG8_STAGE(PG8_SB(1, 0), cB + kstep, voffB); PG8_STAGE(PG8_SA(1, 0), cA + kstep, voffA); PG8_STAGE(PG8_SB(1, 1), cB + hstepB + kstep, voffB);
    PG8_WAIT_V(6); PG8_BAR;
    for (;;) {
        const bool has_next = S.next(ui + 1, nxt);
        const char* nA = has_next ? PG8_APTR(nxt) : cA; const char* nB = has_next ? PG8_BPTR(nxt) : cB;
        for (int t = 0; t < nt; t += 2) {
            const bool last = (t == nt - 2);
            const char* a1 = cA + (size_t)(t + 1) * kstep;
            const char* a2 = last ? nA : cA + (size_t)(t + 2) * kstep; const char* b2 = last ? nB : cB + (size_t)(t + 2) * kstep;
            const char* a3 = a2 + kstep; const char* b3 = b2 + kstep;
            PG8_LDB(B0, 0, 0); PG8_SCHED; PG8_LDA(At, 0, 0); PG8_STAGE(PG8_SA(1, 1), a1 + hstepA, voffA);
            PG8_WAIT_L(8); PG8_BAR; PG8_WAIT_L(0); PG8_MMA(0, 0, At, B0); PG8_BAR; PG8_SCHED;
            PG8_LDB(B1, 0, 1); PG8_STAGE(PG8_SB(0, 0), b2, voffB);
            PG8_BAR; PG8_WAIT_L(0); PG8_MMA(0, 1, At, B1); PG8_BAR;
            PG8_LDA(At, 0, 1); PG8_STAGE(PG8_SA(0, 0), a2, voffA);
            PG8_BAR; PG8_WAIT_L(0); PG8_MMA(1, 0, At, B0); PG8_BAR; PG8_SCHED;
            PG8_STAGE(PG8_SB(0, 1), b2 + hstepB, voffB);
            PG8_WAIT_V(6); PG8_BAR; PG8_MMA(1, 1, At, B1); PG8_BAR;
            PG8_LDB(B0, 1, 0); PG8_SCHED; PG8_LDA(At, 1, 0); PG8_STAGE(PG8_SA(0, 1), a2 + hstepA, voffA);
            PG8_WAIT_L(8); PG8_BAR; PG8_WAIT_L(0); PG8_MMA(0, 0, At, B0); PG8_BAR; PG8_SCHED;
            PG8_LDB(B1, 1, 1); PG8_STAGE(PG8_SB(1, 0), b3, voffB);
            PG8_BAR; PG8_WAIT_L(0); PG8_MMA(0, 1, At, B1); PG8_BAR;
            PG8_LDA(At, 1, 1); PG8_STAGE(PG8_SA(1, 0), a3, voffA);
            PG8_BAR; PG8_WAIT_L(0); PG8_MMA(1, 0, At, B0); PG8_BAR; PG8_SCHED;
            PG8_STAGE(PG8_SB(1, 1), b3 + hstepB, voffB);
            PG8_WAIT_V(6); PG8_BAR; PG8_MMA(1, 1, At, B1); PG8_BAR;
        }
        E(acc, cur, wr, wc, fr, fq);
        if (!has_next) break;
#pragma unroll
        for (int a = 0; a < 2; ++a)
#pragma unroll
            for (int b = 0; b < 2; ++b)
#pragma unroll
                for (int m = 0; m < 4; ++m)
#pragma unroll
                    for (int n = 0; n < 2; ++n) acc[a][b][m][n] = (f32x4){0.f, 0.f, 0.f, 0.f};
        cur = nxt; cA = nA; cB = nB; ++ui;
    }
    PG8_WAIT_V(0);
    if (wr == 0) PG8_BAR;
    PG8_BAR;
#undef PG8_SA
#undef PG8_SB
#undef PG8_STAGE
#undef PG8_LDA
#undef PG8_LDB
#undef PG8_MMA
#undef PG8_WAIT_V
#undef PG8_WAIT_L
#undef PG8_BAR
#undef PG8_SCHED
#undef PG8_APTR
#undef PG8_BPTR
}
}

struct SmallGemm { const bf16_t* A; const bf16_t* B; int lda, ldb, K, akseg, bkseg; long aseg, bseg; int a_tiled; };
constexpr int SG_LD = 72;
constexpr int SG_TILE = 64 * SG_LD * 2;
template <class Dec, class Epi>
__device__ __forceinline__ void gemm_small(LAS unsigned char* lds, const SmallGemm g, int nunits, const Dec& dec, const Epi& epi, int G_, int c_, int tid_in) {
    int tid_ = tid_in; asm volatile("" : "+v"(tid_));
    const int tid = tid_, wid = tid >> 6, lane = tid & 63, wm = wid >> 1, wn = wid & 1, fr = lane & 15, fq = lane >> 4;
    const int lrow = tid >> 3, lk = (tid & 7) * 8;
    const int nk = g.K / 64;
    const unsigned stoff = (unsigned)(lrow * SG_LD + lk) * 2u;
#define SG_LOAD(ra_, rb_, kt_) do { const int k_ = (kt_) * 64 + lk; \
        if (g.a_tiled) ra_ = *(const u32x4*)(g.A + (((((size_t)aoff * 8 + (k_ >> 6)) * 4 + (lrow >> 4)) * 2 + ((k_ >> 5) & 1)) * 512 + (size_t)(((k_ >> 3) & 3) * 16 + (lrow & 15)) * 8)); \
        else ra_ = *(const u32x4*)(ap + (long)(k_ / g.akseg) * g.aseg + (k_ % g.akseg)); \
        rb_ = *(const u32x4*)(bp + (long)(k_ / g.bkseg) * g.bseg + (k_ % g.bkseg)); } while (0)
#define SG_STORE(ra_, rb_, bufi_) do { *(LAS u32x4*)(lds + ((bufi_) * 2 + 0) * SG_TILE + stoff) = ra_; *(LAS u32x4*)(lds + ((bufi_) * 2 + 1) * SG_TILE + stoff) = rb_; } while (0)
#define SG_COMPUTE(bufi_) do { const LAS unsigned char* As = lds + ((bufi_) * 2 + 0) * SG_TILE; const LAS unsigned char* Bs = lds + ((bufi_) * 2 + 1) * SG_TILE; \
        _Pragma("unroll") for (int ks = 0; ks < 2; ++ks) { const bf16x8 af = *(const LAS bf16x8*)(As + ((wm * 16 + fr) * SG_LD + ks * 32 + fq * 8) * 2); \
            _Pragma("unroll") for (int nt = 0; nt < 2; ++nt) { const bf16x8 bf = *(const LAS bf16x8*)(Bs + ((wn * 32 + nt * 16 + fr) * SG_LD + ks * 32 + fq * 8) * 2); \
                acc[nt] = __builtin_amdgcn_mfma_f32_16x16x32_bf16(bf, af, acc[nt], 0, 0, 0); } } } while (0)
    for (int u = c_; u < nunits; u += G_) {
        long aoff, boff; dec(u, aoff, boff);
        const bf16_t* ap = g.A + aoff + (long)lrow * g.lda; const bf16_t* bp = g.B + boff + (long)lrow * g.ldb;
        f32x4 acc[2] = {(f32x4){0.f, 0.f, 0.f, 0.f}, (f32x4){0.f, 0.f, 0.f, 0.f}};
        u32x4 ra0, rb0, ra1, rb1, ra2, rb2, ra3, rb3;
        ra0 = (u32x4){0u, 0u, 0u, 0u}; rb0 = ra0; ra1 = ra0; rb1 = ra0; ra2 = ra0; rb2 = ra0; ra3 = ra0; rb3 = ra0;
        SG_LOAD(ra0, rb0, 0); if (nk > 1) SG_LOAD(ra1, rb1, 1); if (nk > 2) SG_LOAD(ra2, rb2, 2); if (nk > 3) SG_LOAD(ra3, rb3, 3);
        SG_STORE(ra0, rb0, 0);
        LDS_BARRIER();
#define SG_TURN(kt_, bufc, rnextA, rnextB, rfreeA, rfreeB) do { if ((kt_) < nk) { \
            SG_COMPUTE(bufc); \
            if ((kt_) + 1 < nk) SG_STORE(rnextA, rnextB, (bufc) ^ 1); \
            if ((kt_) + 4 < nk) SG_LOAD(rfreeA, rfreeB, (kt_) + 4); \
            LDS_BARRIER(); } } while (0)
        for (int kt = 0; kt < nk; kt += 4) {
            SG_TURN(kt,     0, ra1, rb1, ra0, rb0);
            SG_TURN(kt + 1, 1, ra2, rb2, ra1, rb1);
            SG_TURN(kt + 2, 0, ra3, rb3, ra2, rb2);
            SG_TURN(kt + 3, 1, ra0, rb0, ra3, rb3);
        }
#undef SG_TURN
#pragma unroll
        for (int nt = 0; nt < 2; ++nt) epi(u, wm * 16 + fr, wn * 32 + nt * 16 + fq * 4, acc[nt]);
    }
#undef SG_LOAD
#undef SG_STORE
#undef SG_COMPUTE
}

struct SmallDense { bf16_t* O; long o_gs; int ldc, mt, nt, act; long a_gs, b_gs; int mode; };
__device__ __forceinline__ void gemm_small_dense(LAS unsigned char* lds, const SmallGemm g, const SmallDense d, int ngroups, int G_, int c_, int tid_in) {
    const int per = d.mt * d.nt;
    auto dec = [=](int u, long& ao, long& bo) { const int gi = u / per, r = u % per, mi = r / d.nt, ni = r % d.nt; ao = gi * d.a_gs + (long)mi * 64 * g.lda; bo = gi * d.b_gs + (long)ni * 64 * g.ldb; };
    auto epi = [=](int u, int m, int n, const f32x4& v) { const int gi = u / per, r = u % per, mi = r / d.nt, ni = r % d.nt;
        f32x4 x = v; if (d.act == 1) {
#pragma unroll
            for (int i = 0; i < 4; ++i) { const float a = fmaxf(x[i], 0.f); x[i] = a * a; } }
        u32x2 w; w.x = pk2(x[0], x[1]); w.y = pk2(x[2], x[3]);
        if (d.mode == 0) *(u32x2*)(d.O + gi * d.o_gs + (size_t)(mi * 64 + m) * d.ldc + ni * 64 + n) = w;
        else if (d.mode == 1) *(u32x2*)(d.O + qtile_off(mi * 64 + m, gi, ni * 64 + n)) = w;
        else if (d.mode == 2) *(u32x2*)(d.O + ktile_off(mi * 64 + m, gi, ni * 64 + n)) = w;
        else *(u32x2*)(d.O + vtile_off(mi * 64 + m, gi, ni * 64 + n)) = w; };
    gemm_small(lds, g, ngroups * per, dec, epi, G_, c_, tid_in);
}

struct Args { const float* in[22]; float* out; unsigned char* ws; int ph_lo, ph_hi, ph_last, li; };
enum { I_X = 0, I_C, I_CTX, I_CCTX, I_ADAW, I_ADAB, I_PG, I_PB, I_WIN, I_WCONV, I_BCONV, I_WQ, I_WK, I_WV, I_WGATE, I_BGATE, I_GNW, I_SKIP, I_WOUT, I_FWOUT, I_W1, I_W2 };

constexpr int LDS_BYTES = 147456;
constexpr int LDS_MISC = LDS_BYTES - 256;

__device__ __forceinline__ void transpose_item(const float* W, int K, int N, bf16_t* WT, float scale, LAS float* scr, int item, int lane) {
    const int nblk = N / 32, kb = item / nblk, nb = item % nblk, k0 = 64 * kb, n0 = 32 * nb;
#pragma unroll 8
    for (int i = 0; i < 32; ++i) { const int kk = 2 * i + (lane >> 5); scr[kk * 33 + (lane & 31)] = W[(size_t)(k0 + kk) * N + n0 + (lane & 31)] * scale; }
    asm volatile("s_waitcnt lgkmcnt(0)" ::: "memory");
    const int c = lane & 7;
#pragma unroll
    for (int j = 0; j < 4; ++j) { const int n = (lane >> 3) + 8 * j; const LAS float* s = scr + (8 * c) * 33 + n;
        u32x4 o; o.x = pk2(s[0 * 33], s[1 * 33]); o.y = pk2(s[2 * 33], s[3 * 33]); o.z = pk2(s[4 * 33], s[5 * 33]); o.w = pk2(s[6 * 33], s[7 * 33]);
        *(u32x4*)(WT + (size_t)(n0 + n) * K + k0 + 8 * c) = o; }
    asm volatile("s_waitcnt lgkmcnt(0)" ::: "memory");
}

__device__ __forceinline__ void ln_norm(f32x4 (&v)[4], int lane) {
    float s = 0.f;
#pragma unroll
    for (int j = 0; j < 4; ++j) s += (v[j][0] + v[j][1]) + (v[j][2] + v[j][3]);
    const float mean = wave_sum(s, lane) * (1.f / D); float s2 = 0.f;
#pragma unroll
    for (int j = 0; j < 4; ++j) { v[j] = v[j] - mean; s2 += (v[j][0] * v[j][0] + v[j][1] * v[j][1]) + (v[j][2] * v[j][2] + v[j][3] * v[j][3]); }
    const float rstd = __builtin_amdgcn_rsqf(wave_sum(s2, lane) * (1.f / D) + LN_EPS);
#pragma unroll
    for (int j = 0; j < 4; ++j) v[j] = v[j] * rstd;
}

constexpr int PL = 24;
constexpr int NPHASE = 2 + 4 * PL;
__host__ __device__ inline bool phase_valid(int id) {
    if (id < 2) return true;
    const int layer = (id - 2) / PL, k = (id - 2) % PL;
    if (layer > 3) return false;
    if (k == 0 || (k >= 19 && k <= 22)) return true;
    if (layer & 1) return k >= 2 && k <= 5;
    return k >= 1 && k <= 18;
}


#define MOD ((float*)(ws + WS_MOD))
#define CTXX ((float*)(ws + WS_CTXX))
#define PRE ((float*)(ws + WS_PRE))
#define HIN ((bf16_t*)(ws + WS_HIN))
#define YB ((bf16_t*)(ws + WS_YB))
#define WIN ((bf16_t*)(ws + W_IN))
#define WQ ((bf16_t*)(ws + W_Q))
#define WK ((bf16_t*)(ws + W_K))
#define WV ((bf16_t*)(ws + W_V))
#define WOUT ((bf16_t*)(ws + W_OUT))
#define W1 ((bf16_t*)(ws + W_1))
#define W2 ((bf16_t*)(ws + W_2))
#define GATET ((bf16_t*)(ws + TAB_GATE))
#define S0 ((bf16_t*)(ws + WS_BIG + 0 * SLOT))
#define S1 ((bf16_t*)(ws + WS_BIG + 1 * SLOT))
#define S2 ((bf16_t*)(ws + WS_BIG + 2 * SLOT))
#define S3 ((bf16_t*)(ws + WS_BIG + 3 * SLOT))
#define S4 ((bf16_t*)(ws + WS_BIG + 4 * SLOT))
#define YH (YB + ((size_t)CR + (size_t)half * LH) * D)
#define YHC (YB + (size_t)half * LAT0 * D)
#define HCB (YH + (size_t)NCH * 4 * 2 * 4096 + (size_t)NCH * 4 * 2 * 384 * 2)
#define PREQ ((float*)(HCB + (size_t)LAT0 * DI))
#define HH (HIN + ((size_t)CR + (size_t)half * LH) * D)
#define HHC (HIN + (size_t)half * LAT0 * D)
#define HT ((bf16_t*)(ws + WS_BIG))
#define HTC (HT + (size_t)NB * D * T)
#define PB ((bf16_t*)(ws + WS_BIG + 1 * SLOT))
#define WC ((bf16_t*)(ws + WS_BIG + 3 * SLOT))
#define ZF ((bf16_t*)(ws + WS_BIG))
#define HID ((bf16_t*)(ws + WS_BIG))

constexpr int SC_PLD = 36, SC_VLD = 72;
#define SC_ROW0(j) (((j) < 4) ? (bl * CT + (dir ? 3 - (j) : (j)) * 64) : (LAT0 + bl * T + (dir ? 127 - ((j) - 4) : ((j) - 4)) * 64))
#define SC_LOADQ(dst, r0) do { _Pragma("unroll") for (int pt = 0; pt < 4; ++pt) _Pragma("unroll") for (int ks = 0; ks < 2; ++ks) \
        dst[pt][ks] = __builtin_bit_cast(bf16x8, __builtin_amdgcn_raw_buffer_load_b128(rW, loff, oQ + ((((((r0) >> 6) * 4 + hh) * 8 + w) * 4 + pt) * 2 + ks) * 1024, 0)); } while (0)
#define SC_LOADQ1(dst, r0, pt, ks) dst[pt][ks] = __builtin_bit_cast(bf16x8, __builtin_amdgcn_raw_buffer_load_b128(rW, loff, oQ + ((((((r0) >> 6) * 4 + hh) * 8 + w) * 4 + (pt)) * 2 + (ks)) * 1024, 0))
#define SC_LOADK1(dst, r0, mt, ks) dst[mt][ks] = __builtin_bit_cast(bf16x8, __builtin_amdgcn_raw_buffer_load_b128(rW, loff, oK + ((((((r0) >> 6) * 4 + hh) * 8 + w) * 4 + (mt)) * 2 + (ks)) * 1024, 0))
#define SC_LOADK(dst, r0) do { _Pragma("unroll") for (int mt = 0; mt < 4; ++mt) _Pragma("unroll") for (int ks = 0; ks < 2; ++ks) \
        dst[mt][ks] = __builtin_bit_cast(bf16x8, __builtin_amdgcn_raw_buffer_load_b128(rW, loff, oK + ((((((r0) >> 6) * 4 + hh) * 8 + w) * 4 + mt) * 2 + ks) * 1024, 0)); } while (0)
#define SC_LOADS(P, r0) do { const int ci_ = ((((r0) >> 6) * 4 + hh) * 2 + dir); \
        P##sg0 = __builtin_bit_cast(bf16x8, __builtin_amdgcn_raw_buffer_load_b128(rW, loff, oS + ci_ * 8192 + (w >> 1) * 2048, 0)); P##sg1 = __builtin_bit_cast(bf16x8, __builtin_amdgcn_raw_buffer_load_b128(rW, loff, oS + ci_ * 8192 + (w >> 1) * 2048 + 1024, 0)); \
        P##v = __builtin_bit_cast(u32x4, __builtin_amdgcn_raw_buffer_load_b128(rW, loff, oV + ((((r0) >> 6) * 4 + hh) * 16 + slice) * 4096 + (w & 3) * 1024, 0));     \
        P##wka = __builtin_bit_cast(u32x4, __builtin_amdgcn_raw_buffer_load_b128(rW, wkoff, oG + ci_ * 1536 + 1296, 0));         \
        P##wint = __builtin_bit_cast(float, __builtin_amdgcn_raw_buffer_load_b32(rW, gcp, oG + ci_ * 1536 + 512, 0)); P##em = __builtin_bit_cast(float, __builtin_amdgcn_raw_buffer_load_b32(rW, gcp, oG + ci_ * 1536 + 768, 0)); \
        P##dec = __builtin_bit_cast(float, __builtin_amdgcn_raw_buffer_load_b32(rW, 0, oG + ci_ * 1536 + 1280, 0)); } while (0)
#define SC_VWRITE(bufi, P) do { LAS bf16_t* vt_ = VB + (bufi) * 2 * 3072; LAS bf16_t* vw_ = vt_ + 3072; \
        if (w < 5) { const float wk_[8] = {bflo(P##wka.x), bfhi(P##wka.x), bflo(P##wka.y), bfhi(P##wka.y), bflo(P##wka.z), bfhi(P##wka.z), bflo(P##wka.w), bfhi(P##wka.w)};     \
            if (w < 4) { *(LAS u32x4*)(vt_ + tid * 8) = P##v; \
                u32x4 sv_; sv_.x = pk2(bflo(P##v.x) * wk_[0], bfhi(P##v.x) * wk_[1]); sv_.y = pk2(bflo(P##v.y) * wk_[2], bfhi(P##v.y) * wk_[3]); \
                sv_.z = pk2(bflo(P##v.z) * wk_[4], bfhi(P##v.z) * wk_[5]); sv_.w = pk2(bflo(P##v.w) * wk_[6], bfhi(P##v.w) * wk_[7]); *(LAS u32x4*)(vw_ + tid * 8) = sv_; } \
            else if (lane < 8) { const u32x4 sv_ = P##wka; \
                int ln_ = lane; asm volatile("" : "+v"(ln_));     \
                *(LAS u32x4*)(vw_ + (4 + (ln_ >> 2)) * 512 + (ln_ & 3) * 16 * 8) = sv_; } } } while (0)
#define SC_STEP(J, Qc, Qn, Kc, Kn, C, N) do { \
    const int j_ = (J); const int row0 = SC_ROW0(j_); const int jn_ = j_ < 131 ? j_ + 1 : 131; const int row1 = SC_ROW0(jn_); \
    const int hsel = (j_ < 4) ? (dir ? 2 : 0) : ((j_ < 68) ? 0 : 1); \
    const int buf = j_ & 1; \
    const LAS bf16_t* VT = VB + buf * 2 * 3072; const LAS bf16_t* VW = VT + 3072; \
    LAS bf16_t* Pb_ = Pbh + buf * (8 * 64 * 40); LAS float* Nq_ = NQs + buf * (8 * 64);        \
    SC_LOADS(N, row1); \
      \
    if (!(abl_ & 1)) _Pragma("unroll") for (int nt = 0; nt < 3; ++nt) { \
        f32x4 d1[4]; \
        _Pragma("unroll") for (int pt = 0; pt < 4; ++pt) d1[pt] = (f32x4){0.f, 0.f, 0.f, 0.f}; \
        _Pragma("unroll") for (int ks = 0; ks < 2; ++ks) { \
            u32x4 bw; bw.x = pg8::cvt_pk_bf16(st[2 * ks][nt][0], st[2 * ks][nt][1]); bw.y = pg8::cvt_pk_bf16(st[2 * ks][nt][2], st[2 * ks][nt][3]); \
            bw.z = pg8::cvt_pk_bf16(st[2 * ks + 1][nt][0], st[2 * ks + 1][nt][1]); bw.w = pg8::cvt_pk_bf16(st[2 * ks + 1][nt][2], st[2 * ks + 1][nt][3]); \
            const bf16x8 bs = __builtin_bit_cast(bf16x8, bw); \
            _Pragma("unroll") for (int pt = 0; pt < 4; ++pt) d1[pt] = __builtin_amdgcn_mfma_f32_16x16x32_bf16(bs, Qc[pt][ks], d1[pt], 0, 0, 0); \
            SC_LOADQ1(Qn, row1, (nt * 2 + ks) >> 1, (nt * 2 + ks) & 1);     } \
        _Pragma("unroll") for (int pt = 0; pt < 4; ++pt) { \
            if (nt < 2) { u32x2 pw_; pw_.x = pg8::cvt_pk_bf16(d1[pt][0], d1[pt][1]); pw_.y = pg8::cvt_pk_bf16(d1[pt][2], d1[pt][3]); *(LAS u32x2*)(Pb_ + (w * 64 + 16 * pt + fr) * 40 + 16 * nt + 4 * fq) = pw_; }     \
            else if (fq == 0) Nq_[w * 64 + 16 * pt + fr] = d1[pt][0]; } } \
    SC_LOADQ1(Qn, row1, 3, 0); SC_LOADQ1(Qn, row1, 3, 1); \
    LDS_BARRIER();                                                       \
      \
    f32x4 d2 = (f32x4){0.f, 0.f, 0.f, 0.f}, d3 = (f32x4){0.f, 0.f, 0.f, 0.f}; \
    if (!(abl_ & 2)) {     \
        const int nt2 = w & 1; \
        const bf16x8 vt0 = *(const LAS bf16x8*)(VT + (nt2 * 2 + 0) * 512 + lane * 8), vt1 = *(const LAS bf16x8*)(VT + (nt2 * 2 + 1) * 512 + lane * 8); \
        const bf16x8 vo0 = *(const LAS bf16x8*)(VT + 4 * 512 + lane * 8), vo1 = *(const LAS bf16x8*)(VT + 5 * 512 + lane * 8); \
        d2 = __builtin_amdgcn_mfma_f32_16x16x32_bf16(vt0, C##sg0, d2, 0, 0, 0); d3 = __builtin_amdgcn_mfma_f32_16x16x32_bf16(vo0, C##sg0, d3, 0, 0, 0); \
        d2 = __builtin_amdgcn_mfma_f32_16x16x32_bf16(vt1, C##sg1, d2, 0, 0, 0); d3 = __builtin_amdgcn_mfma_f32_16x16x32_bf16(vo1, C##sg1, d3, 0, 0, 0); } \
      \
    if (!(abl_ & 4)) _Pragma("unroll") for (int nt = 0; nt < 3; ++nt) { \
        const bf16x8 vw0 = *(const LAS bf16x8*)(VW + (nt * 2 + 0) * 512 + lane * 8), vw1 = *(const LAS bf16x8*)(VW + (nt * 2 + 1) * 512 + lane * 8); \
        _Pragma("unroll") for (int mt = 0; mt < 4; ++mt) { f32x4 a = st[mt][nt] * C##dec; \
            a = __builtin_amdgcn_mfma_f32_16x16x32_bf16(Kc[mt][0], vw0, a, 0, 0, 0); \
            a = __builtin_amdgcn_mfma_f32_16x16x32_bf16(Kc[mt][1], vw1, a, 0, 0, 0); st[mt][nt] = a; \
            if (nt < 2) SC_LOADK1(Kn, row1, (nt * 4 + mt) >> 1, (nt * 4 + mt) & 1); } } \
    if (!(abl_ & 8)) {     \
        f32x4 o1 = (f32x4){0.f, 0.f, 0.f, 0.f}; float nq = 0.f; \
        _Pragma("unroll") for (int ww = 0; ww < 8; ++ww) { const u32x2 cpr_ = *(const LAS u32x2*)(Pb_ + (ww * 64 + cp) * 40 + cv); nq += Nq_[ww * 64 + cp]; \
            o1 += (f32x4){bflo(cpr_.x), bfhi(cpr_.x), bflo(cpr_.y), bfhi(cpr_.y)}; } \
        const float den = C##wint * nq + d3[0]; const float scl = __builtin_amdgcn_rcpf(fmaxf(fabsf(den), C##em)); \
        const f32x4 o = (o1 * C##wint + d2) * scl; \
        u32x2 ow; ow.x = pk2(o[0], o[1]); ow.y = pk2(o[2], o[3]); \
        unsigned lo_ = loff; asm volatile("" : "+v"(lo_)); const unsigned hoff_ = ((lo_ >> 4) & 15u) * 64u + (lo_ >> 8) * 8u;     \
        __builtin_amdgcn_raw_buffer_store_b64(ow, rW, hoff_, (rep_ + 1 < SCAN_REP) ? (oC + 512 * DI * 2) : ((hsel == 0 ? oH : (hsel == 1 ? oV : oC)) + (((row0 >> 6) * 4 + hh) * 16 + slice) * 4096 + (w >> 1) * 1024 + (w & 1) * 32), 0); } \
    if (!(abl_ & 16)) SC_VWRITE(buf ^ 1, N);                                     \
} while (0)

__device__ __forceinline__ void scan_phase(LAS unsigned char* lds, unsigned char* ws, int half, const XcdBarrier& bar, int tid, int lane, int wave, int bx) {
    LAS bf16_t* Pbh = (LAS bf16_t*)lds;
    LAS float* NQs = (LAS float*)(lds + 2 * 8 * 64 * 40 * 2);
    LAS bf16_t* VB = (LAS bf16_t*)(NQs + 2 * 8 * 64);
    const int xcd = bx & 7, idx = bx >> 3;
    const int scn = (xcd * 2 + (idx >> 4)) & 15, slice = idx & 15;
    const int bl = scn >> 3, hh = (scn >> 1) & 3, dir = scn & 1, e0 = slice * 32;
    const int fr = lane & 15, fq = lane >> 4, w = wave;
    const int cp = 16 * (w >> 1) + fr, cv = 16 * (w & 1) + 4 * fq;
    const unsigned loff = (unsigned)lane * 16u;
    const unsigned gcp = (unsigned)cp * 4u;
    const unsigned wkoff = (w < 4) ? (unsigned)(32 * ((tid >> 6) & 1) + 8 * ((tid & 63) >> 4)) * 2u : (unsigned)(32 * ((lane >> 2) & 1) + 8 * (lane & 3)) * 2u;
    const __amdgpu_buffer_rsrc_t rW = __builtin_amdgcn_make_buffer_rsrc((void*)ws, 0, (int)(512 * MiB), 0x00020000);
    const int oYH = (int)(WS_YB + ((size_t)CR + (size_t)half * LH) * D * 2);
    const int oQ = (int)(WS_BIG + 3 * SLOT), oK = (int)(WS_BIG + 4 * SLOT), oV = (int)(WS_BIG + 2 * SLOT), oH = (int)(WS_BIG + 0 * SLOT);
    const int oS = oYH, oG = oYH + NCH * 4 * 2 * 8192, oC = oG + NCH * 4 * 2 * 1536;
    for (int i = tid; i < 4 * 1024; i += NTHR) { const int im = i >> 10, r = i & 1023, ln = (r & 511) >> 3; VB[im * 3072 + 2048 + r] = (bf16_t)(((im & 1) == 0 && (ln & 3) == 0) ? 0x3F80u : 0u); }
    __syncthreads();
    for (int rep_ = 0; rep_ < SCAN_REP; ++rep_) {
    const int abl_ = (rep_ + 1 < SCAN_REP) ? SC_ABL : 0;
    f32x4 st[4][3];
#pragma unroll
    for (int a = 0; a < 4; ++a)
#pragma unroll
        for (int b = 0; b < 3; ++b) st[a][b] = (f32x4){0.f, 0.f, 0.f, 0.f};
    bf16x8 Q0[4][2], Q1[4][2], K0[4][2], K1[4][2];
    bf16x8 Asg0, Asg1, Bsg0, Bsg1; u32x4 Av = (u32x4){0u, 0u, 0u, 0u}, Bv = Av, Awka = Av, Bwka = Av; float Awint, Aem, Adec, Bwint, Bem, Bdec;
    { const int r0 = SC_ROW0(0); SC_LOADQ(Q0, r0); SC_LOADK(K0, r0); SC_LOADS(A, r0); SC_VWRITE(0, A); }
#pragma unroll 1
    for (int j = 0; j < 132; j += 2) {
        if (j == 68) xcd_barrier(bar, tid == 0);
        SC_STEP(j, Q0, Q1, K0, K1, A, B);
        SC_STEP(j + 1, Q1, Q0, K1, K0, B, A);
    }
    __syncthreads();
    }
}
#undef SC_ROW0
#undef SC_LOADQ
#undef SC_LOADK
#undef SC_LOADS
#undef SC_VWRITE
#undef SC_STEP

typedef const __attribute__((address_space(4))) Args KA;
__device__ __forceinline__ KA* kargs() { KA* k = (KA*)__builtin_amdgcn_kernarg_segment_ptr(); asm volatile("" : "+s"(k)); return k; }
#define PH_BEGIN() \
    KA* ka = kargs(); unsigned char* ws = ka->ws; (void)ws; \
    int wave = wave0; asm volatile("" : "+s"(wave)); \
    unsigned lz_ = 0u; asm volatile("" : "+v"(lz_)); const int lane = (int)__builtin_amdgcn_mbcnt_hi(~0u, __builtin_amdgcn_mbcnt_lo(~0u, lz_)); \
    const int tid = wave * 64 + lane; (void)tid; \
    const int gw = bx * NWAVES + wave, NGW = G * NWAVES; (void)gw; (void)NGW;

__global__ void __launch_bounds__(NTHR, 2) fwd(Args args) {
    extern __shared__ __attribute__((aligned(16))) unsigned char lds_raw[];
    LAS unsigned char* lds = (LAS unsigned char*)lds_raw;
    const int G = gridDim.x, bx = blockIdx.x;
    const int wave0 = __builtin_amdgcn_readfirstlane(threadIdx.x >> 6);
    volatile LAS unsigned* MISC = (volatile LAS unsigned*)(lds + LDS_MISC);
    if (threadIdx.x < 64) MISC[threadIdx.x] = 0u;
    __syncthreads();
    XcdBarrier bar = xcd_barrier_post((unsigned*)(args.ws + WS_CTL + 65536) + (size_t)args.li * 4096, MISC + 8);
    const int lo = args.ph_lo, hi = args.ph_hi, plast = args.ph_last;
#define IN(k) (lo <= (k) && (k) < hi)
#define SEAM(k) do { if ((k) != plast) { xcd_barrier(bar, tid == 0); if (DUP_BAR) xcd_barrier(bar, tid == 0); } } while (0)

    if (EN_PRO && IN(0)) { PH_BEGIN();
        {
            LAS float* sc = (LAS float*)lds;
            for (int i = tid; i < 5 * D; i += NTHR) { const int r = i / D, k = i % D; const float x = r < 4 ? ka->in[I_C][r * D + k] : ka->in[I_CCTX][k]; sc[i] = siluf(x); }
            __syncthreads();
            LAS float* red = (LAS float*)(lds + 32768);
            const int kp = tid >> 6, cc = tid & 63;
            for (int item = bx; item < 4 * 96; item += G) {
                const int layer = item / 96, n0 = (item % 96) * 64;
                const float* w = ka->in[I_ADAW] + (size_t)layer * D * 6 * D + n0 + cc;
                float a0 = 0.f, a1 = 0.f, a2 = 0.f, a3 = 0.f, a4 = 0.f;
                for (int k = kp * 128; k < kp * 128 + 128; ++k) { const float wv = w[(size_t)k * 6 * D]; a0 += sc[k] * wv; a1 += sc[D + k] * wv; a2 += sc[2 * D + k] * wv; a3 += sc[3 * D + k] * wv; a4 += sc[4 * D + k] * wv; }
                red[(kp * 64 + cc) * 5 + 0] = a0; red[(kp * 64 + cc) * 5 + 1] = a1; red[(kp * 64 + cc) * 5 + 2] = a2; red[(kp * 64 + cc) * 5 + 3] = a3; red[(kp * 64 + cc) * 5 + 4] = a4;
                __syncthreads();
                if (tid < 320) { const int c2 = tid % 64, r = tid / 64; float s = ka->in[I_ADAB][layer * 6 * D + n0 + c2];
                    for (int q = 0; q < 8; ++q) s += red[(q * 64 + c2) * 5 + r];
                    MOD[((size_t)layer * 5 + r) * 6 * D + n0 + c2] = s; }
                __syncthreads();
            }
        }
        {
            bf16_t* A1 = (bf16_t*)(ws + TAB_A1); bf16_t* A2 = (bf16_t*)(ws + TAB_A2); bf16_t* BZ = (bf16_t*)(ws + TAB_BZ); bf16_t* ACTX = (bf16_t*)(ws + TAB_ACTX);
            const int gt = bx * NTHR + tid, NGT = G * NTHR;
            const float s8192 = 0.011048543456039806f;
            for (int i = gt; i < 512 * 256; i += NGT) { const int m = i / 256, t1 = i % 256, ri = m / 256, t1p = m % 256; const int ph = (t1 * t1p) & 255; float sn, cs; sincospif((float)ph * (2.0f / 256.0f), &sn, &cs);
                A1[i] = (bf16_t)f2bf((ri == 0 ? cs : -sn) * s8192);
                ACTX[i] = (bf16_t)f2bf((ri == 0 ? cs : -sn) * 0.0625f); }
            for (int i = gt; i < 256 * 64 * 64; i += NGT) { const int t1p = i / 4096, m = (i / 64) % 64, k = i % 64; const int rip = m / 32, t2p = m % 32, ri = k / 32, t2 = k % 32;
                const int ph = (t2 * t1p + 256 * t2 * t2p) & 8191; float sn, cs; sincospif((float)ph * (2.0f / 8192.0f), &sn, &cs);
                const float v = (rip == ri) ? cs : (rip == 0 ? sn : -sn); A2[i] = (bf16_t)f2bf(v); }
            for (int i = gt; i < 256 * 512; i += NGT) { const int cp = i / 512, k = i % 512, ri = k / 256, c = k % 256; const int ph = (c * cp) & 255; float sn, cs; sincospif((float)ph * (2.0f / 256.0f), &sn, &cs);
                BZ[i] = (bf16_t)f2bf((ri == 0 ? cs : sn) * 0.0625f); }
        }
        SEAM(0);
    }
    if (EN_PRO && IN(1)) { PH_BEGIN();
        for (int r = gw; r < R; r += NGW) {
            const RowInfo ri = row_info(r);
            const float* xr = ri.is_ctx ? ka->in[I_CTX] + ((size_t)ri.b * CT + ri.t) * D : ka->in[I_X] + ((size_t)ri.b * T + ri.t) * D;
            const float* md = MOD + ((size_t)0 * 5 + (ri.is_ctx ? 4 : ri.b)) * 6 * D;
            f32x4 v[4];
#pragma unroll
            for (int j = 0; j < 4; ++j) v[j] = *(const f32x4*)(xr + 256 * j + 4 * lane);
            ln_norm(v, lane);
            bf16_t* o = HIN + (size_t)r * D;
#pragma unroll
            for (int j = 0; j < 4; ++j) { const f32x4 sh = *(const f32x4*)(md + 256 * j + 4 * lane), sc = *(const f32x4*)(md + D + 256 * j + 4 * lane);
                const f32x4 h = v[j] * (1.0f + sc) + sh; u32x2 w; w.x = pk2(h[0], h[1]); w.y = pk2(h[2], h[3]); *(u32x2*)(o + 256 * j + 4 * lane) = w; }
        }
        SEAM(1);
    }

    for (int layer = 0; layer < 4; ++layer) {
        const int pb = 2 + layer * PL;
        if (hi <= pb || lo >= pb + PL) continue;
        const int jl = layer >> 1;
        const bool is_m = (layer & 1) == 0;
        if (EN_WC && IN(pb + 0)) { PH_BEGIN();
 for (int rp_ = 0; rp_ < REPN(5); ++rp_) {
            LAS float* scr = (LAS float*)(lds + wave * 16384);
            const int i_in = (D / 64) * (2 * DI / 32), i_h = (DH / 64) * (DH / 32), i_out = (DI / 64) * (D / 32), i_f = (D / 64) * (D / 32), i_1 = (D / 64) * (DFF / 32), i_2 = (DFF / 64) * (D / 32);
            const int n_mix = is_m ? (i_in + 12 * i_h + i_out) : i_f;
            const int nitems = n_mix + i_1 + i_2;
            for (int it = gw; it < nitems; it += NGW) {
                int r = it;
                if (r >= n_mix) { r -= n_mix;
                    if (r < i_1) transpose_item(ka->in[I_W1] + (size_t)layer * D * DFF, D, DFF, W1, 1.f, scr, r, lane);
                    else transpose_item(ka->in[I_W2] + (size_t)layer * DFF * D, DFF, D, W2, 1.f, scr, r - i_1, lane);
                    continue; }
                if (!is_m) { transpose_item(ka->in[I_FWOUT] + (size_t)jl * D * D, D, D, WOUT, 1.f, scr, r, lane); continue; }
                if (r < i_in) { transpose_item(ka->in[I_WIN] + (size_t)jl * D * 2 * DI, D, 2 * DI, WIN, 1.f, scr, r, lane); continue; } r -= i_in;
                if (r < 12 * i_h) { const int which = r / (4 * i_h), hh = (r / i_h) % 4, rr = r % i_h;
                    const float* src = ka->in[which == 0 ? I_WQ : (which == 1 ? I_WK : I_WV)] + ((size_t)jl * NH + hh) * DH * DH;
                    bf16_t* dst = (which == 0 ? WQ : (which == 1 ? WK : WV)) + (size_t)hh * DH * DH;
                    transpose_item(src, DH, DH, dst, which == 1 ? 0.044194173824159216f : 1.f, scr, rr, lane); continue; } r -= 12 * i_h;
                transpose_item(ka->in[I_WOUT] + (size_t)jl * DI * D, DI, D, WOUT, 1.f, scr, r, lane);
            }
            if (is_m) {
                const float* wg = ka->in[I_WGATE] + (size_t)jl * 3 * DI * 16;
                const int n = lane & 15, eq = lane >> 4;
                for (int k2 = gw; k2 < DI; k2 += NGW) {
                    const int hh = k2 / DH, d = k2 % DH;
                    const float* q = ka->in[I_WQ] + (((size_t)jl * NH + hh) * DH + d) * DH + eq * 128; const float* kx = ka->in[I_WK] + (((size_t)jl * NH + hh) * DH + d) * DH + eq * 128;
                    const float* vx = ka->in[I_WV] + (((size_t)jl * NH + hh) * DH + d) * DH + eq * 128;
                    const float* g0 = wg + ((size_t)0 * DI + hh * DH + eq * 128) * 16 + n; const float* g1 = wg + ((size_t)1 * DI + hh * DH + eq * 128) * 16 + n; const float* g2 = wg + ((size_t)2 * DI + hh * DH + eq * 128) * 16 + n;
                    float s0 = 0.f, s1 = 0.f, s2 = 0.f;
#pragma unroll 8
                    for (int e = 0; e < 128; ++e) { s0 += q[e] * g0[e * 16]; s1 += kx[e] * g1[e * 16]; s2 += vx[e] * g2[e * 16]; }
                    float sa = s0 + 0.044194173824159216f * s1;
                    sa += shx(sa, 16, lane); sa += shx(sa, 32, lane); s2 += shx(s2, 16, lane); s2 += shx(s2, 32, lane);
                    if (lane < 16) { GATET[(size_t)n * 4096 + k2] = (bf16_t)f2bf(sa); GATET[(size_t)n * 4096 + DI + k2] = (bf16_t)f2bf(s2); }
                    else if (lane < 64) { GATET[(size_t)(16 + (lane - 16)) * 4096 + k2] = (bf16_t)0; GATET[(size_t)(16 + (lane - 16)) * 4096 + DI + k2] = (bf16_t)0; }
                }
            }
 }
            SEAM(pb + 0);
        }

        if (EN_MIX && is_m) {
            for (int half = 0; half < 2; ++half) {
                const int hb = pb + 1 + 9 * half;
                if (hi <= hb || lo >= hb + 9) continue;
                if (IN(hb + 0)) { PH_BEGIN();
 for (int rp_ = 0; rp_ < REPN(0); ++rp_) {
                    pg8::Gemm g{HH, WIN, D, D, D, 0, 0, LH / 256, DI / 256, 1};
                    pg8::EpiStore E{S0 + (size_t)LAT0 * DI, 0, DI, 0};
                    pg8::gemm_phase(lds, g, E, G, bx, tid); if (DUP_MIX) pg8::gemm_phase(lds, g, E, G, bx, tid);
                    { SmallGemm sg{HHC, WIN, D, D, D, D, D, 0, 0}; SmallDense sd{S0, 0, DI, LAT0 / 64, DI / 64, 0, 0, 0}; gemm_small_dense(lds, sg, sd, 1, G, bx, tid); if (DUP_CTX) gemm_small_dense(lds, sg, sd, 1, G, bx, tid); }
 }
                    SEAM(hb + 0);
                }
                if (IN(hb + 1)) { PH_BEGIN();
 for (int rp_ = 0; rp_ < REPN(3); ++rp_) {
                    const float* wc = ka->in[I_WCONV] + (size_t)jl * 9 * DI; const float* bc = ka->in[I_BCONV] + (size_t)jl * DI;
                    const int gt = bx * NTHR + tid, NGT = G * NTHR;
                    for (int i = gt; i < 2 * 128 * 2 * (DI / 8); i += NGT) {
                        const int cg = i & 255, rest = i >> 8, hr = rest & 1, r = (rest >> 1) & 127, bl = rest >> 8, c0 = cg * 8, gc0 = 32 * hr;
                        float wv[9][8], bv[8];
#pragma unroll
                        for (int tp = 0; tp < 9; ++tp) { const f32x4 a0 = *(const f32x4*)(wc + (size_t)tp * DI + c0), a1 = *(const f32x4*)(wc + (size_t)tp * DI + c0 + 4);
                            wv[tp][0] = a0[0]; wv[tp][1] = a0[1]; wv[tp][2] = a0[2]; wv[tp][3] = a0[3]; wv[tp][4] = a1[0]; wv[tp][5] = a1[1]; wv[tp][6] = a1[2]; wv[tp][7] = a1[3]; }
                        { const f32x4 a0 = *(const f32x4*)(bc + c0), a1 = *(const f32x4*)(bc + c0 + 4); bv[0] = a0[0]; bv[1] = a0[1]; bv[2] = a0[2]; bv[3] = a0[3]; bv[4] = a1[0]; bv[5] = a1[1]; bv[6] = a1[2]; bv[7] = a1[3]; }
                        const bf16_t* xb = S0 + (size_t)(LAT0 + bl * T + r * 64) * DI + c0;
                        bf16_t* ob = S1 + (size_t)(LAT0 + bl * T + r * 64) * DI + c0;
                        const bool rok[3] = {r > 0, true, r < 127};
                        float win[3][3][8];
#define CV_LOADCOL(slot, col) do { _Pragma("unroll") for (int di = 0; di < 3; ++di) { u32x4 xv = (u32x4){0u, 0u, 0u, 0u}; \
                                if (rok[di] && (col) >= 0 && (col) < 64) xv = *(const u32x4*)(xb + (ptrdiff_t)((di - 1) * 64 + (col)) * DI); \
                                win[slot][di][0] = bflo(xv.x); win[slot][di][1] = bfhi(xv.x); win[slot][di][2] = bflo(xv.y); win[slot][di][3] = bfhi(xv.y); \
                                win[slot][di][4] = bflo(xv.z); win[slot][di][5] = bfhi(xv.z); win[slot][di][6] = bflo(xv.w); win[slot][di][7] = bfhi(xv.w); } } while (0)
#define CV_STEP(sl, sm, sr) do { CV_LOADCOL(sr, gc + 1); \
                                if (gc < gc0 + 32) { float acc[8]; \
                                    _Pragma("unroll") for (int e = 0; e < 8; ++e) { float s = bv[e]; \
                                        _Pragma("unroll") for (int di = 0; di < 3; ++di) s += win[sl][di][e] * wv[di * 3 + 0][e] + win[sm][di][e] * wv[di * 3 + 1][e] + win[sr][di][e] * wv[di * 3 + 2][e]; \
                                        acc[e] = siluf(s); } \
                                    u32x4 o; o.x = pk2(acc[0], acc[1]); o.y = pk2(acc[2], acc[3]); o.z = pk2(acc[4], acc[5]); o.w = pk2(acc[6], acc[7]); \
                                    *(u32x4*)(ob + (size_t)gc * DI) = o; } \
                                ++gc; } while (0)
                        int gc = gc0;
                        CV_LOADCOL(0, gc0 - 1); CV_LOADCOL(1, gc0);
#pragma unroll 1
                        for (int g3 = 0; g3 < 11; ++g3) { CV_STEP(0, 1, 2); CV_STEP(1, 2, 0); CV_STEP(2, 0, 1); }
#undef CV_LOADCOL
#undef CV_STEP
                    }
                    for (int i = gt; i < LAT0 * (DI / 8); i += NGT) {
                        const int q = i / (DI / 8), c0 = (i % (DI / 8)) * 8, t = q % CT;
                        float acc[8];
#pragma unroll
                        for (int e = 0; e < 8; ++e) acc[e] = bc[c0 + e];
#pragma unroll
                        for (int dj = 0; dj < 3; ++dj) { const int tt = t + dj - 1; if (tt < 0 || tt >= CT) continue;
                            const u32x4 xv = *(const u32x4*)(S0 + (size_t)(q + dj - 1) * DI + c0); const float* w = wc + (size_t)(3 + dj) * DI + c0;
                            acc[0] += bflo(xv.x) * w[0]; acc[1] += bfhi(xv.x) * w[1]; acc[2] += bflo(xv.y) * w[2]; acc[3] += bfhi(xv.y) * w[3];
                            acc[4] += bflo(xv.z) * w[4]; acc[5] += bfhi(xv.z) * w[5]; acc[6] += bflo(xv.w) * w[6]; acc[7] += bfhi(xv.w) * w[7]; }
                        u32x4 o; o.x = pk2(siluf(acc[0]), siluf(acc[1])); o.y = pk2(siluf(acc[2]), siluf(acc[3])); o.z = pk2(siluf(acc[4]), siluf(acc[5])); o.w = pk2(siluf(acc[6]), siluf(acc[7]));
                        *(u32x4*)(S1 + (size_t)q * DI + c0) = o;
                    }
 }
                    SEAM(hb + 1);
                }
                if (IN(hb + 2)) { PH_BEGIN();
 for (int rp_ = 0; rp_ < REPN(0); ++rp_) {
                    { pg8::Gemm g{WV, S0 + (size_t)LAT0 * DI, DH, DI, DH, (long)DH * DH, DH, DH / 256, LH / 256, NH};
                      pg8::EpiStore E{S2, 0, 0, 0, 3, LAT0};
                      pg8::gemm_phase(lds, g, E, G, bx, tid); if (DUP_MIX) pg8::gemm_phase(lds, g, E, G, bx, tid); }
                    { SmallGemm sg{WV, S0, DH, DI, DH, DH, DH, 0, 0}; SmallDense sd{S2, 0, 0, DH / 64, LAT0 / 64, 0, (long)DH * DH, DH, 3}; gemm_small_dense(lds, sg, sd, NH, G, bx, tid); if (DUP_CTX) gemm_small_dense(lds, sg, sd, NH, G, bx, tid); }
                    {
                      SmallGemm sg{S1, GATET, DI, 4096, 1024, 1024, 1024, 0, 0};
                      const long xm_off = (long)(S0 - S1);
                      auto dec = [=](int uq, long& ao, long& bo) { const int u = uq >> 2, q = uq & 3; ao = (long)u * 64 * DI + (q & 1) * 1024 + (q >> 1) * xm_off; bo = q * 1024; };
                      auto epi = [=](int uq, int m, int n, const f32x4& v) { const int u = uq >> 2, q = uq & 3; if (n < 16) *(f32x4*)(PREQ + (size_t)q * RH * 16 + ((size_t)u * 64 + m) * 16 + n) = v; };
                      gemm_small(lds, sg, NCH * 4, dec, epi, G, bx, tid); }
 }
                    SEAM(hb + 2);
                }
                if (IN(hb + 3)) { PH_BEGIN();
 for (int rp_ = 0; rp_ < REPN(0); ++rp_) {
                    { pg8::Gemm g{S1 + (size_t)LAT0 * DI, WQ, DI, DH, DH, DH, (long)DH * DH, LH / 256, DH / 256, NH}; pg8::EpiStore E{S3, DH, DI, 0, 1, LAT0}; pg8::gemm_phase(lds, g, E, G, bx, tid); if (DUP_MIX) pg8::gemm_phase(lds, g, E, G, bx, tid); }
                    { SmallGemm sg{S1, WQ, DI, DH, DH, DH, DH, 0, 0}; SmallDense sd{S3, DH, DI, LAT0 / 64, DH / 64, 0, DH, (long)DH * DH, 1}; gemm_small_dense(lds, sg, sd, NH, G, bx, tid); if (DUP_CTX) gemm_small_dense(lds, sg, sd, NH, G, bx, tid); }
                    { pg8::Gemm g{S1 + (size_t)LAT0 * DI, WK, DI, DH, DH, DH, (long)DH * DH, LH / 256, DH / 256, NH}; pg8::EpiStore E{S0 + (size_t)LAT0 * DI, DH, DI, 0}; pg8::gemm_phase(lds, g, E, G, bx, tid); if (DUP_MIX) pg8::gemm_phase(lds, g, E, G, bx, tid); }
                    { SmallGemm sg{S1, WK, DI, DH, DH, DH, DH, 0, 0}; SmallDense sd{S0, DH, DI, LAT0 / 64, DH / 64, 0, DH, (long)DH * DH}; gemm_small_dense(lds, sg, sd, NH, G, bx, tid); if (DUP_CTX) gemm_small_dense(lds, sg, sd, NH, G, bx, tid); }
                    { pg8::Gemm g{WK, S1 + (size_t)LAT0 * DI, DH, DI, DH, (long)DH * DH, DH, DH / 256, LH / 256, NH}; pg8::EpiStore E{S4, (long)DH * RH, RH, 0, 2, LAT0}; pg8::gemm_phase(lds, g, E, G, bx, tid); if (DUP_MIX) pg8::gemm_phase(lds, g, E, G, bx, tid); }
                    { SmallGemm sg{WK, S1, DH, DI, DH, DH, DH, 0, 0}; SmallDense sd{S4, (long)DH * RH, RH, DH / 64, LAT0 / 64, 0, (long)DH * DH, DH, 2}; gemm_small_dense(lds, sg, sd, NH, G, bx, tid); if (DUP_CTX) gemm_small_dense(lds, sg, sd, NH, G, bx, tid); }
                    if (bx < 16) {
                        const int sc = bx, bl = sc >> 3, hh = (sc >> 1) & 3, dir = sc & 1;
                        LAS float* bcs = (LAS float*)lds;
                        LAS float* vss = bcs + 132 * 64;
                        LAS float* bl_ = vss + 132 * 64;
                        LAS float* vm_ = bl_ + 132;
                        LAS float* mi_ = vm_ + 132;
                        const int u = lane, p = dir ? 63 - u : u;
                        const float* bgp = ka->in[I_BGATE] + (size_t)jl * 16 + 8 * dir + hh;
#pragma unroll
                        for (int i = 0; i < 17; ++i) { const int j = wave + 8 * i;
                            if (j < 132) { int row0; if (j < 4) { const int c = dir ? 3 - j : j; row0 = bl * CT + c * 64; } else { const int c = dir ? 127 - (j - 4) : (j - 4); row0 = LAT0 + bl * T + c * 64; }
                                const float* pr = PREQ + (size_t)(row0 + p) * 16 + 8 * dir + hh; const size_t qs = (size_t)RH * 16;
                                bcs[j * 64 + p] = (pr[4] + pr[qs + 4]) + (pr[2 * qs + 4] + pr[3 * qs + 4]) + bgp[4]; vss[j * 64 + p] = (pr[0] + pr[qs]) + (pr[2 * qs] + pr[3 * qs]) + bgp[0]; } }
                        asm volatile("s_waitcnt vmcnt(0) lgkmcnt(0)" ::: "memory");
#pragma unroll 1
                        for (int i = 0; i < 17; ++i) { const int j = wave + 8 * i;
                            if (j < 132) { const float f = bcs[j * 64 + p], lia = vss[j * 64 + p]; float x = fminf(f, 0.f) - log1pf(__expf(-fabsf(f)));
                                x = scan_add64(x);
                                const float v = lia - x; float pm = v;
                                pm = scan_max64(pm);
                                bcs[j * 64 + p] = x; vss[j * 64 + p] = v; if (u == 63) { bl_[j] = x; vm_[j] = pm; } } }
                        __syncthreads();
                        if (wave == 0) {
                            const float ni = -__builtin_inff();
                            float ea[3], eb[3];
#pragma unroll
                            for (int t = 0; t < 3; ++t) { const int j = 3 * lane + t; const bool ok = j < 132; const float blj = bl_[ok ? j : 0], vmj = vm_[ok ? j : 0]; ea[t] = ok ? blj : 0.f; eb[t] = ok ? blj + vmj : ni; }
                            float A = ea[0] + ea[1], B = fmaxf(eb[0] + ea[1], eb[1]); B = fmaxf(B + ea[2], eb[2]); A += ea[2];
#define G12_STEP(CTRL, RM) do { const float pa_ = dppf<CTRL, RM>(0.f, A), pb_ = dppf<CTRL, RM>(ni, B); B = fmaxf(pb_ + A, B); A += pa_; } while (0)
                            G12_STEP(0x111, 0xF); G12_STEP(0x112, 0xF); G12_STEP(0x114, 0xF); G12_STEP(0x118, 0xF); G12_STEP(0x142, 0xA); G12_STEP(0x143, 0xC);
#undef G12_STEP
                            float EA = shup(A, 1, lane), EB = shup(B, 1, lane); if (lane == 0) { EA = 0.f; EB = ni; }
                            float m = fmaxf(EA, EB);
#pragma unroll
                            for (int t = 0; t < 3; ++t) { const int j = 3 * lane + t; if (j < 132) { mi_[j] = m; m = fmaxf(m + ea[t], eb[t]); } }
                        }
                        __syncthreads();
                        float* GPw = (float*)(YH + (size_t)NCH * 4 * 2 * 4096);
#pragma unroll 1
                        for (int i = 0; i < 17; ++i) { const int j = wave + 8 * i;
                            if (j < 132) { int row0; if (j < 4) { const int c = dir ? 3 - j : j; row0 = bl * CT + c * 64; } else { const int c = dir ? 127 - (j - 4) : (j - 4); row0 = LAT0 + bl * T + c * 64; }
                                const float bc = bcs[j * 64 + p], v = vss[j * 64 + p]; float pm = v;
                                pm = scan_max64(pm);
                                const float m_in = mi_[j], btot = bl_[j], m_new = btot + fmaxf(m_in, vm_[j]);
                                const float uu = -fmaxf(m_in, pm);
                                float* gp = GPw + ((size_t)((row0 >> 6) * 4 + hh) * 2 + dir) * 384;
                                gp[p] = uu; gp[64 + p] = v; gp[128 + p] = __expf(m_in + uu); gp[192 + p] = __expf(uu - bc); ((bf16_t*)(gp + 324))[p] = (bf16_t)f2bf(__expf(btot - m_new + v));
                                if (u == 0) gp[320] = __expf(btot + m_in - m_new); } }
                    }
 }
                    SEAM(hb + 3);
                }
                if (IN(hb + 4)) { PH_BEGIN();
 for (int rp_ = 0; rp_ < REPN(4); ++rp_) {
                    SmallGemm sg{S3, S0, DI, DI, DH, DH, DH, 0, 0, 1};
                    bf16_t* SGw = YH; const float* GPr = (const float*)(YH + (size_t)NCH * 4 * 2 * 4096);
                    auto dec = [=](int u, long& ao, long& bo) { const int ch = u >> 2, hh = u & 3; ao = u; bo = (long)ch * 64 * DI + hh * DH; };
                    auto epi = [=](int u, int m, int n, const f32x4& v) {
#pragma unroll
                        for (int dir = 0; dir < 2; ++dir) { const float* gp = GPr + ((size_t)u * 2 + dir) * 384; const float up = gp[m]; const f32x4 vs = *(const f32x4*)(gp + 64 + n); float o[4];
#pragma unroll
                            for (int i = 0; i < 4; ++i) { const int s = n + i; const bool ok = dir ? (s >= m) : (s <= m); const float gte = ok ? __expf(up + vs[i]) : 0.f; o[i] = v[i] * gte; }
                            u32x2 w; w.x = pk2(o[0], o[1]); w.y = pk2(o[2], o[3]);
                            *(u32x2*)(SGw + ((size_t)u * 2 + dir) * 4096 + ((m >> 4) * 2 + (n >> 5)) * 512 + (((n >> 3) & 3) * 16 + (m & 15)) * 8 + (n & 7)) = w; } };
                    gemm_small(lds, sg, NCH * 4, dec, epi, G, bx, tid);
 }
                    SEAM(hb + 4);
                }
                if (EN_SCAN && IN(hb + 5)) { PH_BEGIN();
                    scan_phase(lds, ws, half, bar, tid, lane, wave, bx);
                    SEAM(hb + 5);
                }
                if (IN(hb + 6)) { PH_BEGIN();
 for (int rp_ = 0; rp_ < REPN(0); ++rp_) {
                    pg8::Gemm g{HH, WIN + (size_t)DI * D, D, D, D, 0, 0, LH / 256, DI / 256, 1};
                    pg8::EpiStore E{S3 + (size_t)LAT0 * DI, 0, DI, 0};
                    pg8::gemm_phase(lds, g, E, G, bx, tid); if (DUP_MIX) pg8::gemm_phase(lds, g, E, G, bx, tid);
                    if (layer < 2) { SmallGemm sg{HHC, WIN + (size_t)DI * D, D, D, D, D, D, 0, 0}; SmallDense sd{S3, 0, DI, LAT0 / 64, DI / 64, 0, 0, 0}; gemm_small_dense(lds, sg, sd, 1, G, bx, tid); if (DUP_CTX) gemm_small_dense(lds, sg, sd, 1, G, bx, tid); }
 }
                    SEAM(hb + 6);
                }
                if (IN(hb + 7)) { PH_BEGIN();
 for (int rp_ = 0; rp_ < REPN(3); ++rp_) {
                    const float* gn = ka->in[I_GNW] + (size_t)jl * DI; const float* sk = ka->in[I_SKIP] + (size_t)jl * DI;
#define RO_LOAD(q_, A, B, XC, ZZ) do { const bf16_t* h2_ = ((q_) < LAT0) ? HCB : S2; \
                        _Pragma("unroll") for (int hd = 0; hd < 4; ++hd) { const size_t ho_ = htile_off(q_, hd, 8 * lane); const size_t ro_ = (size_t)(q_) * DI + hd * DH + 8 * lane; \
                            A[hd] = *(const u32x4*)(S0 + ho_); B[hd] = *(const u32x4*)(h2_ + ho_); XC[hd] = *(const u32x4*)(S1 + ro_); ZZ[hd] = *(const u32x4*)(S3 + ro_); } } while (0)
                    u32x4 ra[4], rb[4], rx[4], rz[4], na[4], nb[4], nx[4], nz[4];
#pragma unroll
                    for (int hd = 0; hd < 4; ++hd) { ra[hd] = (u32x4){0u, 0u, 0u, 0u}; rb[hd] = ra[hd]; rx[hd] = ra[hd]; rz[hd] = ra[hd]; na[hd] = ra[hd]; nb[hd] = ra[hd]; nx[hd] = ra[hd]; nz[hd] = ra[hd]; }
                    const int q_first = (layer < 2 ? 0 : LAT0) + gw;
                    if (q_first < RH) RO_LOAD(q_first, ra, rb, rx, rz);
                    for (int q = q_first; q < RH; q += NGW) {
                        if (q + NGW < RH) RO_LOAD(q + NGW, na, nb, nx, nz);
#pragma unroll
                        for (int hd = 0; hd < 4; ++hd) {
                            const int c0 = hd * DH + 8 * lane;
                            const u32x4 a = ra[hd], b = rb[hd];
                            float v[8] = {bflo(a.x) + bflo(b.x), bfhi(a.x) + bfhi(b.x), bflo(a.y) + bflo(b.y), bfhi(a.y) + bfhi(b.y), bflo(a.z) + bflo(b.z), bfhi(a.z) + bfhi(b.z), bflo(a.w) + bflo(b.w), bfhi(a.w) + bfhi(b.w)};
                            float s = 0.f;
#pragma unroll
                            for (int i = 0; i < 8; ++i) s += v[i];
                            const float mean = wave_sum(s, lane) * (1.f / DH); float s2 = 0.f;
#pragma unroll
                            for (int i = 0; i < 8; ++i) { v[i] -= mean; s2 += v[i] * v[i]; }
                            const float rstd = __builtin_amdgcn_rsqf(wave_sum(s2, lane) * (1.f / DH) + LN_EPS);
                            const u32x4 xc = rx[hd], zz = rz[hd];
                            const float xcf[8] = {bflo(xc.x), bfhi(xc.x), bflo(xc.y), bfhi(xc.y), bflo(xc.z), bfhi(xc.z), bflo(xc.w), bfhi(xc.w)};
                            const float zf[8] = {bflo(zz.x), bfhi(zz.x), bflo(zz.y), bfhi(zz.y), bflo(zz.z), bfhi(zz.z), bflo(zz.w), bfhi(zz.w)};
                            float o[8];
#pragma unroll
                            for (int i = 0; i < 8; ++i) o[i] = (v[i] * rstd * gn[c0 + i] + sk[c0 + i] * xcf[i]) * siluf(zf[i]);
                            u32x4 w; w.x = pk2(o[0], o[1]); w.y = pk2(o[2], o[3]); w.z = pk2(o[4], o[5]); w.w = pk2(o[6], o[7]);
                            *(u32x4*)(S4 + (size_t)q * DI + c0) = w;
                        }
#pragma unroll
                        for (int hd = 0; hd < 4; ++hd) { ra[hd] = na[hd]; rb[hd] = nb[hd]; rx[hd] = nx[hd]; rz[hd] = nz[hd]; }
                    }
#undef RO_LOAD
 }
                    SEAM(hb + 7);
                }
                if (IN(hb + 8)) { PH_BEGIN();
 for (int rp_ = 0; rp_ < REPN(0); ++rp_) {
                    pg8::Gemm g{S4 + (size_t)LAT0 * DI, WOUT, DI, DI, DI, 0, 0, LH / 256, D / 256, 1};
                    pg8::EpiStore E{YH, 0, D, 0};
                    pg8::gemm_phase(lds, g, E, G, bx, tid); if (DUP_MIX) pg8::gemm_phase(lds, g, E, G, bx, tid);
                    if (layer < 2) { SmallGemm sg{S4, WOUT, DI, DI, DI, DI, DI, 0, 0}; SmallDense sd{YHC, 0, D, LAT0 / 64, D / 64, 0, 0, 0}; gemm_small_dense(lds, sg, sd, 1, G, bx, tid); if (DUP_CTX) gemm_small_dense(lds, sg, sd, 1, G, bx, tid); }
 }
                    SEAM(hb + 8);
                }
            }
        } else if (EN_FOUR) {
            const bool has_ctx = layer < 3;
            if (IN(pb + 2)) { PH_BEGIN();
 for (int rp_ = 0; rp_ < REPN(2); ++rp_) {
                { pg8::Gemm g{(const bf16_t*)(ws + TAB_A1), HT, 256, 256, 256, 0, (long)D * T, 2, 128, NB};
                  pg8::EpiStore E{PB, (long)512 * 32768, 32768, 0};
                  pg8::gemm_phase(lds, g, E, G, bx, tid); if (DUP_MIX) pg8::gemm_phase(lds, g, E, G, bx, tid); }
                if (has_ctx) {
                    SmallGemm sg{(const bf16_t*)(ws + TAB_ACTX), HTC, 256, 256, 256, 256, 256, 0, 0};
                    auto dec = [=](int u, long& ao, long& bo) { const int b = u / 128, mb = (u / 16) % 8, cht = u % 16; ao = (long)mb * 64 * 256; bo = ((long)b * D + cht * 64) * CT; };
                    auto epi = [=](int u, int m, int n, const f32x4& v) { const int b = u / 128, mb = (u / 16) % 8, cht = u % 16; const int mg = mb * 64 + m, ri = mg >> 8, tp = mg & 255, ch = cht * 64 + n;
                        u32x2 w; w.x = pk2(v[0], v[1]); w.y = pk2(v[2], v[3]); *(u32x2*)(WC + (size_t)ctx_row(b, tp) * DI + (ch >> 8) * 512 + ri * 256 + (ch & 255)) = w; };
                    gemm_small(lds, sg, NB * 8 * 16, dec, epi, G, bx, tid);
                }
 }
                SEAM(pb + 2);
            }
            if (IN(pb + 3)) { PH_BEGIN();
 for (int rp_ = 0; rp_ < REPN(2); ++rp_) {
                {
                    const int wid = tid >> 6, wm = wid >> 1, wn = wid & 1, fr = lane & 15, fq = lane >> 4;
                    const int lrow = tid >> 3, lk = (tid & 7) * 8;
                    const unsigned stoff = (unsigned)(lrow * SG_LD + lk) * 2u;
                    LAS unsigned char* As = lds; LAS unsigned char* Bs0 = lds + SG_TILE; LAS unsigned char* Bs1 = lds + 2 * SG_TILE;
                    const bf16_t* A2 = (const bf16_t*)(ws + TAB_A2);
                    for (int pair = bx; pair < NB * 256; pair += G) {
                        const int b = pair >> 8, t1p = pair & 255;
                        const bf16_t* bp = PB + (size_t)b * 512 * 32768 + (size_t)((lk >> 5) * 256 + t1p) * 32768 + (size_t)lrow * 32 + (lk & 31);
                        u32x4 r0 = *(const u32x4*)(bp), r1 = *(const u32x4*)(bp + 2048), r2 = *(const u32x4*)(bp + 2 * 2048), r3 = *(const u32x4*)(bp + 3 * 2048);
                        *(LAS u32x4*)(As + stoff) = *(const u32x4*)(A2 + (size_t)t1p * 4096 + lrow * 64 + lk);
                        *(LAS u32x4*)(Bs0 + stoff) = r0;
                        LDS_BARRIER();
                        bf16x8 af[2];
#pragma unroll
                        for (int ks = 0; ks < 2; ++ks) af[ks] = *(const LAS bf16x8*)(As + ((wm * 16 + fr) * SG_LD + ks * 32 + fq * 8) * 2);
#define F2_TILE(ct_, BsC, BsN, rcur, rnext) do { \
                            if ((ct_) + 4 < 16) rcur = *(const u32x4*)(bp + ((ct_) + 4) * 2048); \
                            f32x4 acc[2] = {(f32x4){0.f, 0.f, 0.f, 0.f}, (f32x4){0.f, 0.f, 0.f, 0.f}}; \
                            _Pragma("unroll") for (int ks = 0; ks < 2; ++ks) _Pragma("unroll") for (int nt = 0; nt < 2; ++nt) { \
                                const bf16x8 bf = *(const LAS bf16x8*)(BsC + ((wn * 32 + nt * 16 + fr) * SG_LD + ks * 32 + fq * 8) * 2); \
                                acc[nt] = __builtin_amdgcn_mfma_f32_16x16x32_bf16(bf, af[ks], acc[nt], 0, 0, 0); } \
                            if ((ct_) + 1 < 16) *(LAS u32x4*)(BsN + stoff) = rnext; \
                            _Pragma("unroll") for (int nt = 0; nt < 2; ++nt) { const int m = wm * 16 + fr, n = wn * 32 + nt * 16 + fq * 4, rip = m >> 5, t2p = m & 31, ch = (ct_) * 64 + n; \
                                u32x2 w2; w2.x = pk2(acc[nt][0], acc[nt][1]); w2.y = pk2(acc[nt][2], acc[nt][3]); \
                                *(u32x2*)(WC + (size_t)lat_row(b, t1p + 256 * t2p) * DI + (ch >> 8) * 512 + rip * 256 + (ch & 255)) = w2; } \
                            LDS_BARRIER(); } while (0)
#pragma unroll 1
                        for (int ct = 0; ct < 16; ct += 4) { F2_TILE(ct, Bs0, Bs1, r0, r1); F2_TILE(ct + 1, Bs1, Bs0, r1, r2); F2_TILE(ct + 2, Bs0, Bs1, r2, r3); F2_TILE(ct + 3, Bs1, Bs0, r3, r0); }
#undef F2_TILE
                    }
                }
 }
                SEAM(pb + 3);
            }
            if (IN(pb + 4)) { PH_BEGIN();
 for (int rp_ = 0; rp_ < REPN(2); ++rp_) {
                pg8::Gemm g{WC + (size_t)CR * DI, (const bf16_t*)(ws + TAB_BZ), DI, 512, 512, 512, 0, (R - CR) / 256, 1, 4};
                pg8::EpiStore E{ZF + (size_t)CR * D, 256, D, 0};
                pg8::gemm_phase(lds, g, E, G, bx, tid); if (DUP_MIX) pg8::gemm_phase(lds, g, E, G, bx, tid);
                if (has_ctx) { SmallGemm sg{WC, (const bf16_t*)(ws + TAB_BZ), DI, 512, 512, 512, 512, 0, 0}; SmallDense sd{ZF, 256, D, CR / 64, 256 / 64, 0, 512, 0}; gemm_small_dense(lds, sg, sd, 4, G, bx, tid); if (DUP_CTX) gemm_small_dense(lds, sg, sd, 4, G, bx, tid); }
 }
                SEAM(pb + 4);
            }
            if (IN(pb + 5)) { PH_BEGIN();
 for (int rp_ = 0; rp_ < REPN(2); ++rp_) {
                pg8::Gemm g{ZF + (size_t)CR * D, WOUT, D, D, D, 0, 0, (R - CR) / 256, D / 256, 1};
                pg8::EpiStore E{YB + (size_t)CR * D, 0, D, 0};
                pg8::gemm_phase(lds, g, E, G, bx, tid); if (DUP_MIX) pg8::gemm_phase(lds, g, E, G, bx, tid);
                if (has_ctx) { SmallGemm sg{ZF, WOUT, D, D, D, D, D, 0, 0}; SmallDense sd{YB, 0, D, CR / 64, D / 64, 0, 0, 0}; gemm_small_dense(lds, sg, sd, 1, G, bx, tid); if (DUP_CTX) gemm_small_dense(lds, sg, sd, 1, G, bx, tid); }
 }
                SEAM(pb + 5);
            }
        }
#pragma unroll 1
        for (int which = 0; which < 2; ++which) {
            const int pid = pb + (which == 0 ? 19 : 22);
            if (EN_NORM && IN(pid)) { PH_BEGIN();
                const float* pg = ka->in[I_PG] + ((size_t)layer * 2 + which) * D; const float* pbv = ka->in[I_PB] + ((size_t)layer * 2 + which) * D;
                const int mlayer = which == 0 ? layer : layer + 1;
                const int shoff = which == 0 ? 3 * D : 0;
                const int goff = which == 0 ? 2 * D : 5 * D;
                const bool in_f32 = (layer == 0 && which == 0), out_f32 = (layer == 3 && which == 1);
                bf16_t* xbl = (bf16_t*)ka->out; bf16_t* xb3 = S4;
#define NR_LOAD(r_, XW, YW) do { const RowInfo ri_ = row_info(r_); const size_t xi_ = ri_.is_ctx ? ((size_t)ri_.b * CT + ri_.t) * D : ((size_t)ri_.b * T + ri_.t) * D; \
                    const bf16_t* yr_ = YB + (size_t)(r_) * D; \
                    if (in_f32) { const float* xp_ = (ri_.is_ctx ? ka->in[I_CTX] : ka->in[I_X]) + xi_; _Pragma("unroll") for (int j = 0; j < 4; ++j) XW[j] = *(const u32x4*)(xp_ + 256 * j + 4 * lane); } \
                    else { const bf16_t* xp_ = ri_.is_ctx ? (const bf16_t*)CTXX + xi_ : ((layer == 3 && which == 1) ? xb3 + xi_ : xbl + xi_); \
                        _Pragma("unroll") for (int j = 0; j < 4; ++j) { const u32x2 t_ = *(const u32x2*)(xp_ + 256 * j + 4 * lane); XW[j] = (u32x4){t_.x, t_.y, 0u, 0u}; } } \
                    _Pragma("unroll") for (int j = 0; j < 4; ++j) YW[j] = *(const u32x2*)(yr_ + 256 * j + 4 * lane); } while (0)
                if (which == 1 && (layer & 1) == 0) {
                    constexpr int TLD = 1026;
                    LAS bf16_t* TL = (LAS bf16_t*)lds;
                    const float* md2b = MOD + ((size_t)mlayer * 5) * 6 * D + shoff;
#define NT_ROW(r_, i_) do { const RowInfo ri = row_info(r_); const int mi = ri.is_ctx ? 4 : ri.b; \
                        const size_t xi = ri.is_ctx ? ((size_t)ri.b * CT + ri.t) * D : ((size_t)ri.b * T + ri.t) * D; \
                        bf16_t* xout16 = ri.is_ctx ? (bf16_t*)CTXX + xi : xbl + xi; \
                        const float* md = MOD + ((size_t)layer * 5 + mi) * 6 * D; f32x4 v[4]; \
                        _Pragma("unroll") for (int j = 0; j < 4; ++j) { const int c = 256 * j + 4 * lane; const f32x4 x = (f32x4){bflo(xw[j].x), bfhi(xw[j].x), bflo(xw[j].y), bfhi(xw[j].y)}; \
                            const f32x4 gt = *(const f32x4*)(md + goff + c); const f32x4 y = (f32x4){bflo(yw[j].x), bfhi(yw[j].x), bflo(yw[j].y), bfhi(yw[j].y)}; v[j] = x * ALPHA + gt * y; } \
                        ln_norm(v, lane); \
                        _Pragma("unroll") for (int j = 0; j < 4; ++j) { const int c = 256 * j + 4 * lane; v[j] = v[j] * *(const f32x4*)(pg + c) + *(const f32x4*)(pbv + c); \
                            u32x2 xo; xo.x = pk2(v[j][0], v[j][1]); xo.y = pk2(v[j][2], v[j][3]); *(u32x2*)(xout16 + c) = xo; } \
                        ln_norm(v, lane); \
                        const float* md2 = md2b + (size_t)mi * 6 * D; \
                        _Pragma("unroll") for (int j = 0; j < 4; ++j) { const int c = 256 * j + 4 * lane; const f32x4 sh = *(const f32x4*)(md2 + c), sc = *(const f32x4*)(md2 + D + c); \
                            const f32x4 h = v[j] * (1.0f + sc) + sh; LAS unsigned* d_ = (LAS unsigned*)(TL + (i_) * TLD + c); d_[0] = pk2(h[0], h[1]); d_[1] = pk2(h[2], h[3]); } } while (0)
                    u32x4 xw[4], xn[4]; u32x2 yw[4], yn[4];
#pragma unroll
                    for (int j = 0; j < 4; ++j) { xw[j] = (u32x4){0u, 0u, 0u, 0u}; xn[j] = xw[j]; yw[j] = (u32x2){0u, 0u}; yn[j] = yw[j]; }
                    for (int item = bx; item < NB * 32 * 4; item += G) {
                        const int b = item >> 7, t2 = (item >> 2) & 31, tb = item & 3;
                        const int rbase = lat_row(b, 32 * (64 * tb + wave * 8) + t2);
                        NR_LOAD(rbase, xw, yw);
#pragma unroll 1
                        for (int j8 = 0; j8 < 8; ++j8) {
                            if (j8 < 7) NR_LOAD(rbase + 32 * (j8 + 1), xn, yn);
                            NT_ROW(rbase + 32 * j8, wave * 8 + j8);
#pragma unroll
                            for (int j = 0; j < 4; ++j) { xw[j] = xn[j]; yw[j] = yn[j]; }
                        }
                        LDS_BARRIER();
#pragma unroll 4
                        for (int k = 0; k < 16; ++k) { const int idx = k * NTHR + tid, g8 = idx & 7, ch = idx >> 3; const LAS bf16_t* s = TL + (8 * g8) * TLD + ch;
                            u32x4 o; o.x = (unsigned)s[0] | ((unsigned)s[TLD] << 16); o.y = (unsigned)s[2 * TLD] | ((unsigned)s[3 * TLD] << 16); o.z = (unsigned)s[4 * TLD] | ((unsigned)s[5 * TLD] << 16); o.w = (unsigned)s[6 * TLD] | ((unsigned)s[7 * TLD] << 16);
                            *(u32x4*)(HT + (((size_t)b * D + ch) * 32 + t2) * 256 + 64 * tb + 8 * g8) = o; }
                        LDS_BARRIER();
                    }
                    if (layer < 2) {
                        for (int item = bx; item < NB * (CT / 8); item += G) {
                            const int b = item / (CT / 8), t8 = item % (CT / 8);
                            const int r = ctx_row(b, 8 * t8 + wave);
                            NR_LOAD(r, xw, yw);
                            NT_ROW(r, wave);
                            LDS_BARRIER();
#pragma unroll
                            for (int k = 0; k < 2; ++k) { const int ch = k * NTHR + tid; const LAS bf16_t* s = TL + ch;
                                u32x4 o; o.x = (unsigned)s[0] | ((unsigned)s[TLD] << 16); o.y = (unsigned)s[2 * TLD] | ((unsigned)s[3 * TLD] << 16); o.z = (unsigned)s[4 * TLD] | ((unsigned)s[5 * TLD] << 16); o.w = (unsigned)s[6 * TLD] | ((unsigned)s[7 * TLD] << 16);
                                *(u32x4*)(HTC + ((size_t)b * D + ch) * CT + 8 * t8) = o; }
                            LDS_BARRIER();
                        }
                    }
#undef NT_ROW
                } else {
                const int r_first = (layer < 2 ? 0 : CR) + gw;
                u32x4 xw[4], xn[4]; u32x2 yw[4], yn[4];
#pragma unroll
                for (int j = 0; j < 4; ++j) { xw[j] = (u32x4){0u, 0u, 0u, 0u}; xn[j] = xw[j]; yw[j] = (u32x2){0u, 0u}; yn[j] = yw[j]; }
                if (r_first < R) NR_LOAD(r_first, xw, yw);
                for (int r = r_first; r < R; r += NGW) {
                    if (r + NGW < R) NR_LOAD(r + NGW, xn, yn);
                    const RowInfo ri = row_info(r);
                    const int mi = ri.is_ctx ? 4 : ri.b;
                    const size_t xi = ri.is_ctx ? ((size_t)ri.b * CT + ri.t) * D : ((size_t)ri.b * T + ri.t) * D;
                    bf16_t* xout16 = ri.is_ctx ? (bf16_t*)CTXX + xi : ((layer == 3 && which == 0) ? xb3 + xi : xbl + xi);
                    const float* md = MOD + ((size_t)layer * 5 + mi) * 6 * D;
                    f32x4 v[4];
#pragma unroll
                    for (int j = 0; j < 4; ++j) { const int c = 256 * j + 4 * lane; f32x4 x; if (in_f32) x = __builtin_bit_cast(f32x4, xw[j]); else x = (f32x4){bflo(xw[j].x), bfhi(xw[j].x), bflo(xw[j].y), bfhi(xw[j].y)};
                        const f32x4 gt = *(const f32x4*)(md + goff + c);
                        const f32x4 y = (f32x4){bflo(yw[j].x), bfhi(yw[j].x), bflo(yw[j].y), bfhi(yw[j].y)}; v[j] = x * ALPHA + gt * y; }
                    ln_norm(v, lane);
#pragma unroll
                    for (int j = 0; j < 4; ++j) { const int c = 256 * j + 4 * lane; v[j] = v[j] * *(const f32x4*)(pg + c) + *(const f32x4*)(pbv + c);
                        if (out_f32) *(f32x4*)(ka->out + xi + c) = v[j]; else { u32x2 xo; xo.x = pk2(v[j][0], v[j][1]); xo.y = pk2(v[j][2], v[j][3]); *(u32x2*)(xout16 + c) = xo; } }
                    if (mlayer < 4) {
                        const float* md2 = MOD + ((size_t)mlayer * 5 + mi) * 6 * D + shoff;
                        ln_norm(v, lane);
                        bf16_t* o = HIN + (size_t)r * D;
#pragma unroll
                        for (int j = 0; j < 4; ++j) { const int c = 256 * j + 4 * lane; const f32x4 sh = *(const f32x4*)(md2 + c), sc = *(const f32x4*)(md2 + D + c);
                            const f32x4 h = v[j] * (1.0f + sc) + sh; u32x2 w; w.x = pk2(h[0], h[1]); w.y = pk2(h[2], h[3]); *(u32x2*)(o + c) = w; }
                    }
#pragma unroll
                    for (int j = 0; j < 4; ++j) { xw[j] = xn[j]; yw[j] = yn[j]; }
                }
                }
#undef NR_LOAD
                SEAM(pid);
            }
            if (EN_MLP && which == 0) {
                if (IN(pb + 20)) { PH_BEGIN();
 for (int rp_ = 0; rp_ < REPN(1); ++rp_) {
                    pg8::Gemm g{HIN + (size_t)CR * D, W1, D, D, D, 0, 0, (R - CR) / 256, DFF / 256, 1};
                    pg8::EpiStore E{HID + (size_t)CR * DFF, 0, DFF, 1};
                    pg8::gemm_phase(lds, g, E, G, bx, tid);
#if DUP_MLP
                    pg8::gemm_phase(lds, g, E, G, bx, tid);
#endif
                    if (layer < 2) { SmallGemm sg{HIN, W1, D, D, D, D, D, 0, 0}; SmallDense sd{HID, 0, DFF, CR / 64, DFF / 64, 1, 0, 0}; gemm_small_dense(lds, sg, sd, 1, G, bx, tid); }
 }
                    SEAM(pb + 20);
                }
                if (IN(pb + 21)) { PH_BEGIN();
 for (int rp_ = 0; rp_ < REPN(1); ++rp_) {
                    pg8::Gemm g{HID + (size_t)CR * DFF, W2, DFF, DFF, DFF, 0, 0, (R - CR) / 256, D / 256, 1};
                    pg8::EpiStore E{YB + (size_t)CR * D, 0, D, 0};
                    pg8::gemm_phase(lds, g, E, G, bx, tid);
#if DUP_MLP
                    pg8::gemm_phase(lds, g, E, G, bx, tid);
#endif
                    if (layer < 2) { SmallGemm sg{HID, W2, DFF, DFF, DFF, DFF, DFF, 0, 0}; SmallDense sd{YB, 0, D, CR / 64, D / 64, 0, 0, 0}; gemm_small_dense(lds, sg, sd, 1, G, bx, tid); }
 }
                    SEAM(pb + 21);
                }
            }
        }
    }
#undef IN
#undef SEAM
}

extern "C" void kernel_launch(void* const* d_in, const int* in_sizes, int n_in, void* d_out, int out_size, void* d_ws, size_t ws_size, hipStream_t stream) {
    static int grid = 0;
    if (grid == 0) {
        if (n_in != 22 || ws_size < 512 * MiB) { fprintf(stderr, "kernel_launch: unexpected n_in %d / ws_size %zu\n", n_in, ws_size); grid = -1; return; }
        int dev = 0, cus = 0;
        if (hipGetDevice(&dev) != hipSuccess || hipDeviceGetAttribute(&cus, hipDeviceAttributeMultiprocessorCount, dev) != hipSuccess) { grid = -1; return; }
        if (hipFuncSetAttribute((const void*)fwd, hipFuncAttributeMaxDynamicSharedMemorySize, LDS_BYTES) != hipSuccess) { fprintf(stderr, "kernel_launch: hipFuncSetAttribute failed\n"); grid = -1; return; }
        int per_cu = 0;
        if (hipOccupancyMaxActiveBlocksPerMultiprocessor(&per_cu, (const void*)fwd, NTHR, LDS_BYTES) != hipSuccess || per_cu < 1) fprintf(stderr, "kernel_launch: occupancy query says %d\n", per_cu);
        (void)hipGetLastError();
        grid = cus;
        if (grid != 256) fprintf(stderr, "kernel_launch: %d CUs (built for 256)\n", grid);
    }
    if (grid < 0) return;
    (void)hipMemsetAsync((char*)d_ws + WS_CTL, 0, CTL_BYTES, stream);
    Args a{};
    for (int i = 0; i < 22; ++i) a.in[i] = (const float*)d_in[i];
    a.out = (float*)d_out; a.ws = (unsigned char*)d_ws;
#if MK_SINGLE
    { int last = 0; for (int id = 0; id < NPHASE; ++id) if (phase_valid(id)) last = id;
      a.ph_lo = 0; a.ph_hi = NPHASE; a.ph_last = last; a.li = 0;
      hipLaunchKernelGGL(fwd, dim3(grid), dim3(NTHR), LDS_BYTES, stream, a); }
#else
    { int li = 0;
      for (int id = 0; id < NPHASE; ++id) { if (!phase_valid(id)) continue;
          a.ph_lo = id; a.ph_hi = id + 1; a.ph_last = id; a.li = li++;
          hipLaunchKernelGGL(fwd, dim3(grid), dim3(NTHR), LDS_BYTES, stream, a); } }
#endif
}
```

```cpp
#include <hip/hip_runtime.h>
#include <cstdio>
#include <cstdint>

#define LAS __attribute__((address_space(3)))
typedef unsigned short bf16_t;
typedef short bf16x8 __attribute__((ext_vector_type(8)));
typedef float f32x4 __attribute__((ext_vector_type(4)));
typedef unsigned u32x4 __attribute__((ext_vector_type(4)));
typedef unsigned u32x2 __attribute__((ext_vector_type(2)));


#ifndef EN_PRO
#define EN_PRO 1
#endif
#ifndef EN_WC
#define EN_WC 1
#endif
#ifndef EN_MIX
#define EN_MIX 1
#endif
#ifndef EN_SCAN
#define EN_SCAN 1
#endif
#ifndef EN_FOUR
#define EN_FOUR 1
#endif
#ifndef EN_NORM
#define EN_NORM 1
#endif
#ifndef EN_MLP
#define EN_MLP 1
#endif
#ifndef DUP_MIX
#define DUP_MIX 0
#endif
#ifndef DUP_CTX
#define DUP_CTX 0
#endif
#ifndef DUP_BAR
#define DUP_BAR 0
#endif
#ifndef DUP_MLP
#define DUP_MLP 0
#endif
#ifndef REP_MASK
#define REP_MASK 0
#endif
#define REPN(bit) (((REP_MASK) >> (bit)) & 1 ? 2 : 1)
#ifndef SC_QPAD
#define SC_QPAD 64
#endif
#ifndef SC_ABL
#define SC_ABL 0
#endif
#ifndef SCAN_REP
#define SCAN_REP 1
#endif
#ifndef MK_SINGLE
#define MK_SINGLE 1
#endif

constexpr int D = 1024, NB = 4, T = 8192, CT = 256, DI = 2048, NH = 4, DH = 512, DFF = 4096;
constexpr int R = NB * (T + CT);
constexpr int RH = R / 2;
constexpr int LAT0 = 2 * CT;
constexpr int NCH = RH / 64;
constexpr float ALPHA = 1.6817928305074290f;
constexpr float LN_EPS = 1e-5f;
constexpr int NWAVES = 8, NTHR = 512;

constexpr size_t MiB = 1u << 20;
constexpr size_t WS_CTL = 0, CTL_BYTES = 2 * MiB;
constexpr size_t WS_MOD = 2 * MiB;
constexpr size_t WS_CTXX = 3 * MiB;
constexpr size_t WS_PRE = 7 * MiB;
constexpr size_t WS_TAB = 10 * MiB;
constexpr size_t TAB_A1 = WS_TAB;
constexpr size_t TAB_A2 = TAB_A1 + 512 * 256 * 2;
constexpr size_t TAB_BZ = TAB_A2 + 256 * 64 * 64 * 2;
constexpr size_t TAB_ACTX = TAB_BZ + 256 * 512 * 2;
constexpr size_t TAB_GATE = TAB_ACTX + 512 * 256 * 2;
static_assert(TAB_GATE + 64 * 4096 * 2 <= 15 * MiB, "tables");
constexpr size_t WS_W = 15 * MiB;
constexpr size_t W_IN = WS_W;
constexpr size_t W_Q = W_IN + 8 * MiB, W_K = W_Q + 2 * MiB, W_V = W_K + 2 * MiB;
constexpr size_t W_OUT = W_V + 2 * MiB;
constexpr size_t W_1 = W_OUT + 4 * MiB;
constexpr size_t W_2 = W_1 + 8 * MiB;
static_assert(W_2 + 8 * MiB <= 49 * MiB, "weights");
constexpr size_t WS_HIN = 49 * MiB;
constexpr size_t WS_YB = 115 * MiB;
constexpr size_t WS_BIG = 181 * MiB;
constexpr size_t SLOT = 66 * MiB;
static_assert(WS_BIG + 5 * SLOT <= 512 * MiB, "workspace");
static_assert((size_t)RH * DI * 2 == SLOT, "slot");

#define LDS_BARRIER() do { asm volatile("s_waitcnt lgkmcnt(0)" ::: "memory"); __builtin_amdgcn_s_barrier(); asm volatile("" ::: "memory"); } while (0)
__device__ __forceinline__ unsigned f2bf(float f) { unsigned u = __builtin_bit_cast(unsigned, f); return (u + 0x7fffu + ((u >> 16) & 1u)) >> 16; }
typedef __bf16 bf16x2_t __attribute__((ext_vector_type(2)));
typedef float f32x2_t __attribute__((ext_vector_type(2)));
__device__ __forceinline__ unsigned pk2(float lo, float hi) { const f32x2_t v = {lo, hi}; return __builtin_bit_cast(unsigned, __builtin_convertvector(v, bf16x2_t)); }
__device__ __forceinline__ float bf2f(unsigned short b) { return __builtin_bit_cast(float, ((unsigned)b) << 16); }
__device__ __forceinline__ float u2f(unsigned u) { return __builtin_bit_cast(float, u); }
__device__ __forceinline__ float bflo(unsigned w) { return __builtin_bit_cast(float, w << 16); }
__device__ __forceinline__ float bfhi(unsigned w) { return __builtin_bit_cast(float, w & 0xffff0000u); }
__device__ __forceinline__ float shx(float v, int mask, int lane) { return __builtin_bit_cast(float, __builtin_amdgcn_ds_bpermute((lane ^ mask) << 2, __builtin_bit_cast(int, v))); }
template <int CTRL, int RMASK> __device__ __forceinline__ float dppf(float idv, float src) { return __builtin_bit_cast(float, __builtin_amdgcn_update_dpp(__builtin_bit_cast(int, idv), __builtin_bit_cast(int, src), CTRL, RMASK, 0xF, false)); }
__device__ __forceinline__ float scan_add64(float x) {
    x += dppf<0x111, 0xF>(0.f, x); x += dppf<0x112, 0xF>(0.f, x); x += dppf<0x114, 0xF>(0.f, x); x += dppf<0x118, 0xF>(0.f, x);
    x += dppf<0x142, 0xA>(0.f, x); x += dppf<0x143, 0xC>(0.f, x); return x; }
__device__ __forceinline__ float scan_max64(float x) {
    const float ni = -__builtin_inff();
    x = fmaxf(x, dppf<0x111, 0xF>(ni, x)); x = fmaxf(x, dppf<0x112, 0xF>(ni, x)); x = fmaxf(x, dppf<0x114, 0xF>(ni, x)); x = fmaxf(x, dppf<0x118, 0xF>(ni, x));
    x = fmaxf(x, dppf<0x142, 0xA>(ni, x)); x = fmaxf(x, dppf<0x143, 0xC>(ni, x)); return x; }
__device__ __forceinline__ float shup(float v, int d, int lane) { return __builtin_bit_cast(float, __builtin_amdgcn_ds_bpermute((lane - d) << 2, __builtin_bit_cast(int, v))); }
__device__ __forceinline__ float wave_sum(float v, int lane) {
    (void)lane;
    return __builtin_bit_cast(float, __builtin_amdgcn_readlane(__builtin_bit_cast(int, scan_add64(v)), 63));
}
__device__ __forceinline__ float siluf(float x) { return x * __builtin_amdgcn_rcpf(1.0f + __expf(-x)); }

struct RowInfo { int is_ctx, b, t; };
__device__ __forceinline__ RowInfo row_info(int r) {
    RowInfo ri;
    if (r < NB * CT) { ri.is_ctx = 1; ri.b = r / CT; ri.t = r % CT; }
    else { ri.is_ctx = 0; const int u = r - NB * CT; ri.b = u / T; ri.t = u % T; }
    return ri;
}
__device__ __forceinline__ int lat_row(int b, int t) { return NB * CT + b * T + t; }
__device__ __forceinline__ int ctx_row(int b, int t) { return b * CT + t; }
constexpr int CR = NB * CT;
constexpr int LH = RH - LAT0;

#define XB_TMO      128
#define XB_XCNT(j)  (256  + 64 * (j))
#define XB_XSUB(j)  (1280 + 64 * (j))
#define XB_XGEN(j)  (2304 + 64 * (j))
#define XB_TOP      3328
#define XB_TOPGEN   3392
#define XCD_BAR_WORDS 3456
#define XB_SPIN_CAP (1u << 18)

__device__ __forceinline__ unsigned xb_ld(unsigned* p)              { return __hip_atomic_load(p, __ATOMIC_RELAXED, __HIP_MEMORY_SCOPE_AGENT); }
__device__ __forceinline__ unsigned xb_add(unsigned* p, unsigned v) { return __hip_atomic_fetch_add(p, v, __ATOMIC_RELAXED, __HIP_MEMORY_SCOPE_AGENT); }
__device__ __forceinline__ unsigned xb_xcc_id() { return (unsigned)__builtin_amdgcn_s_getreg((3 << 11) | 20) & 0xFu; }
#define XB_SPIN(cond, bar) do { unsigned _sp = 0; while (cond) { __builtin_amdgcn_s_sleep(1); \
    if ((++_sp & 255u) == 0u) { if (xb_ld(&(bar)[XB_TMO])) break; if (_sp > XB_SPIN_CAP) { atomicAdd(&(bar)[XB_TMO], 1u); break; } } } } while (0)

struct XcdBarrier { unsigned* bar; unsigned x; volatile LAS unsigned* st; };

__device__ __forceinline__ XcdBarrier xcd_barrier_post(unsigned* bar, volatile LAS unsigned* st) {
    XcdBarrier b; b.bar = bar; b.x = xb_xcc_id(); b.st = st;
    if (threadIdx.x == 0) (void)xb_add(&bar[XB_XCNT(b.x)], 1u);
    return b;
}
__device__ __forceinline__ void xcd_barrier_complete(unsigned* bar, unsigned x, unsigned& nloc, unsigned& nx) {
    const unsigned G = gridDim.x * gridDim.y * gridDim.z;
    unsigned sum, cnt, mine, sp = 0u;
    for (;;) {
        sum = 0u; cnt = 0u; mine = 0u;
#pragma unroll
        for (unsigned j = 0; j < 16; ++j) { const unsigned c = xb_ld(&bar[XB_XCNT(j)]); sum += c; cnt += (c > 0u) ? 1u : 0u; mine = (j == x) ? c : mine; }
        if (sum == G) break;
        __builtin_amdgcn_s_sleep(1);
        if ((++sp & 255u) == 0u) { if (xb_ld(&bar[XB_TMO])) break; if (sp > XB_SPIN_CAP) { atomicAdd(&bar[XB_TMO], 1u); break; } }
    }
    nloc = mine > 0u ? mine : 1u; nx = cnt > 0u ? cnt : 1u;
}
__device__ __forceinline__ void xcd_barrier(const XcdBarrier& b, bool thread0) {
    asm volatile("s_waitcnt vmcnt(0)" ::: "memory");
    __syncthreads();
    if (thread0) {
        unsigned* bar = b.bar;
        __builtin_amdgcn_s_waitcnt(0);
        unsigned nloc = b.st[0], nx = b.st[1];
        if (nloc == 0u) { xcd_barrier_complete(bar, b.x, nloc, nx); b.st[0] = nloc; b.st[1] = nx; }
        const unsigned old = xb_add(&bar[XB_XSUB(b.x)], 1u);
        const unsigned gen = old / nloc;
        if (old + 1u == (gen + 1u) * nloc) {
            __builtin_amdgcn_fence(__ATOMIC_RELEASE, "agent");
            asm volatile("s_waitcnt vmcnt(0)" ::: "memory");
            const unsigned og = xb_add(&bar[XB_TOP], 1u);
            const unsigned tg = og / nx;
            if (og + 1u == (tg + 1u) * nx) xb_add(&bar[XB_TOPGEN], 1u);
            else XB_SPIN(xb_ld(&bar[XB_TOPGEN]) == tg, bar);
            __builtin_amdgcn_fence(__ATOMIC_ACQUIRE, "agent");
            xb_add(&bar[XB_XGEN(b.x)], 1u);
            asm volatile("s_waitcnt vmcnt(0)" ::: "memory");
        } else {
            XB_SPIN(xb_ld(&bar[XB_XGEN(b.x)]) == gen, bar);
            __builtin_amdgcn_fence(__ATOMIC_ACQUIRE, "agent");
            asm volatile("s_waitcnt vmcnt(0)" ::: "memory");
        }
    }
    __syncthreads();
}

__device__ __forceinline__ size_t qtile_off(int q, int h, int cc) {
    const int chunk = q >> 6, p = q & 63, pt = p >> 4, fr = p & 15, w = cc >> 6, ks = (cc >> 5) & 1, fq = (cc >> 3) & 3;
    const size_t blk = ((((size_t)chunk * 4 + h) * 8 + w) * 4 + pt) * 2 + ks;
    return blk * 512 + (size_t)(fq * 16 + fr) * 8 + (cc & 7);
}
__device__ __forceinline__ size_t ktile_off(int d, int h, int q) {
    const int chunk = q >> 6, s = q & 63, ks = s >> 5, fq = (s >> 3) & 3, w = d >> 6, dd = d & 63, mt = 2 * (dd >> 5) + ((dd >> 2) & 1), frp = 4 * ((dd >> 3) & 3) + (dd & 3);
    const size_t blk = ((((size_t)chunk * 4 + h) * 8 + w) * 4 + mt) * 2 + ks;
    return blk * 512 + (size_t)(fq * 16 + frp) * 8 + (s & 7);
}

__device__ __forceinline__ size_t vtile_off(int e, int h, int q) {
    const int chunk = q >> 6, s = q & 63, slice = e >> 5, e5 = e & 31, nt = e5 >> 4, fr = e5 & 15, ks = s >> 5, fq = (s >> 3) & 3;
    const size_t blk = ((((size_t)chunk * 4 + h) * 16 + slice) * 2 + nt) * 2 + ks;
    return blk * 512 + (size_t)(fq * 16 + fr) * 8 + (s & 7);
}
__device__ __forceinline__ size_t htile_off(int q, int h, int e) {
    return ((((size_t)(q >> 6) * 4 + h) * 16 + (e >> 5)) * 2048) + (size_t)(q & 63) * 32 + (e & 31);
}

namespace pg8 {
constexpr int BM = 256, BK = 64, HALF = 128, HTB = HALF * BK * 2, STAGE_BYTES = 8 * HTB, NXCD = 8, WGM = 8;
__device__ __forceinline__ int lds_byte(int r, int c) { const int st = (r >> 4) * 2 + (c >> 5), rr = r & 15, cc = c & 31, ob = rr * 64 + cc * 2; return st * 1024 + (ob ^ (((ob >> 9) & 1) << 5)); }
__device__ __forceinline__ void stage_rc(int b, int& R_, int& C_) { const int st = b / 1024, sb = b % 1024, swz = sb ^ (((sb >> 9) & 1) << 5); R_ = (st >> 1) * 16 + swz / 64; C_ = (st & 1) * 32 + (swz % 64) / 2; }
__device__ __forceinline__ int perm32(int rho) { const int n = rho >> 4, i = rho & 15; return 8 * (i >> 2) + 4 * n + (i & 3); }

struct Unit { int pm, pn, g; };
struct Gemm {
    const bf16_t* A; const bf16_t* Bt; int lda, ldb, K;
    long a_gs, b_gs;
    int nM, nN, nG;
};
struct Order {
    int nM, nNt, nN, nwg, G, c;
    __device__ void init(const Gemm& g, int G_, int c_) { nM = g.nM; nN = g.nN; nNt = g.nN * g.nG; nwg = nM * nNt; G = G_; c = c_; }
    __device__ bool next(int i, Unit& u) const {
        const long L = (long)i * G + c; if (L >= nwg) return false;
        int wgid = (int)L; { const int q = nwg / NXCD, r = nwg % NXCD, xcd = wgid % NXCD, off = wgid / NXCD; wgid = (xcd < r ? xcd * (q + 1) : r * (q + 1) + (xcd - r) * q) + off; }
        const int nig = WGM * nNt, gid = wgid / nig, fm = gid * WGM, gsz = (nM - fm) < WGM ? (nM - fm) : WGM;
        u.pm = fm + ((wgid % nig) % gsz); const int pnt = (wgid % nig) / gsz; u.g = pnt / nN; u.pn = pnt - u.g * nN; return true;
    }
};
__device__ __forceinline__ unsigned cvt_pk_bf16(float lo, float hi) { return pk2(lo, hi); }

struct EpiStore {
    bf16_t* O; long o_gs; int ldc; int act;
    int mode, off;
    __device__ __forceinline__ void operator()(const f32x4 (&acc)[2][2][4][2], const Unit& u, int wr, int wc, int fr, int fq) const {
        const int row0 = u.pm * BM + wr * 64 + fr; const int col0 = u.pn * BM + wc * 32 + 8 * fq; bf16_t* base = O + (long)u.g * o_gs;
#pragma unroll
        for (int ai = 0; ai < 2; ++ai)
#pragma unroll
            for (int m = 0; m < 4; ++m) { bf16_t* rowp = base + (size_t)(row0 + ai * HALF + m * 16) * ldc + col0;
#pragma unroll
                for (int bj = 0; bj < 2; ++bj) { f32x4 v0 = acc[ai][bj][m][0], v1 = acc[ai][bj][m][1];
                    if (act == 1) {
#pragma unroll
                        for (int j = 0; j < 4; ++j) { const float a = fmaxf(v0[j], 0.f), b = fmaxf(v1[j], 0.f); v0[j] = a * a; v1[j] = b * b; } }
                    u32x4 w; w.x = cvt_pk_bf16(v0[0], v0[1]); w.y = cvt_pk_bf16(v0[2], v0[3]); w.z = cvt_pk_bf16(v1[0], v1[1]); w.w = cvt_pk_bf16(v1[2], v1[3]);
                    if (mode == 0) *(u32x4*)(rowp + bj * HALF) = w;
                    else if (mode == 1) *(u32x4*)(O + qtile_off(off + row0 + ai * HALF + m * 16, u.g, col0 + bj * HALF)) = w;
                    else if (mode == 2) *(u32x4*)(O + ktile_off(row0 + ai * HALF + m * 16, u.g, off + col0 + bj * HALF)) = w;
                    else *(u32x4*)(O + vtile_off(row0 + ai * HALF + m * 16, u.g, off + col0 + bj * HALF)) = w; } }
    }
};

template <class Epi>
__device__ __forceinline__ void gemm_phase(LAS unsigned char* lds, const Gemm g, const Epi& E, int G_, int c_, int tid_in) {
    int tid_ = tid_in; asm volatile("" : "+v"(tid_));
    const int tid = tid_, wid = __builtin_amdgcn_readfirstlane(tid >> 6), lane = tid & 63, wr = wid >> 2, wc = wid & 3, fr = lane & 15, fq = lane >> 4;
    const int K = g.K, nt = K / BK;
    Order S; S.init(g, G_, c_);
    unsigned voffA[2], voffB[2];
#pragma unroll
    for (int i = 0; i < 2; ++i) { int R_, C_; stage_rc(tid * 16 + i * 8192, R_, C_); const int Rb = (R_ & ~31) + perm32(R_ & 31);
        voffA[i] = (unsigned)(R_ * g.lda + C_) * 2u; voffB[i] = (unsigned)(Rb * g.ldb + C_) * 2u; }
    const size_t kstep = (size_t)(BK * 2);
    const size_t hstepA = (size_t)HALF * g.lda * 2, hstepB = (size_t)HALF * g.ldb * 2;
    const unsigned ldsw = (unsigned)wid * 1024u;
    const int aoff = lds_byte(wr * 64 + fr, fq * 8), boff = lds_byte(wc * 32 + fr, fq * 8);
#define PG8_SA(b, h) (((b) * 2 + (h)) * HTB)
#define PG8_SB(b, h) ((4 + (b) * 2 + (h)) * HTB)
#define PG8_STAGE(bufoff, gbase, voff) do { _Pragma("unroll") for (int _i = 0; _i < 2; ++_i) \
        __builtin_amdgcn_global_load_lds((const unsigned*)((const char*)(gbase) + (voff)[_i]), (LAS unsigned*)(lds + (bufoff) + ldsw + _i * 8192), 16, 0, 0); } while (0)
#define PG8_LDA(dst, b, h) do { _Pragma("unroll") for (int m = 0; m < 4; ++m) _Pragma("unroll") for (int k = 0; k < 2; ++k) dst[m][k] = *(const LAS bf16x8*)(lds + PG8_SA(b, h) + aoff + m * 2048 + k * 1024); } while (0)
#define PG8_LDB(dst, b, h) do { _Pragma("unroll") for (int n = 0; n < 2; ++n) _Pragma("unroll") for (int k = 0; k < 2; ++k) dst[n][k] = *(const LAS bf16x8*)(lds + PG8_SB(b, h) + boff + n * 2048 + k * 1024); } while (0)
#define PG8_MMA(ai, bj, At, Bt) do { __builtin_amdgcn_s_setprio(1); _Pragma("unroll") for (int m = 0; m < 4; ++m) _Pragma("unroll") for (int n = 0; n < 2; ++n) _Pragma("unroll") for (int k = 0; k < 2; ++k) \
        acc[ai][bj][m][n] = __builtin_amdgcn_mfma_f32_16x16x32_bf16(Bt[n][k], At[m][k], acc[ai][bj][m][n], 0, 0, 0); __builtin_amdgcn_s_setprio(0); } while (0)
#define PG8_WAIT_V(n) asm volatile("s_waitcnt vmcnt(" #n ")" ::: "memory")
#define PG8_WAIT_L(n) asm volatile("s_waitcnt lgkmcnt(" #n ")" ::: "memory")
#define PG8_BAR __builtin_amdgcn_s_barrier()
#define PG8_SCHED __builtin_amdgcn_sched_barrier(0)
#define PG8_APTR(u) ((const char*)(g.A + (long)(u).g * g.a_gs) + (size_t)(u).pm * 2 * hstepA)
#define PG8_BPTR(u) ((const char*)(g.Bt + (long)(u).g * g.b_gs) + (size_t)(u).pn * 2 * hstepB)
    Unit cur, nxt; int ui = 0;
    if (!S.next(0, cur)) return;
    f32x4 acc[2][2][4][2];
#pragma unroll
    for (int a = 0; a < 2; ++a)
#pragma unroll
        for (int b = 0; b < 2; ++b)
#pragma unroll
            for (int m = 0; m < 4; ++m)
#pragma unroll
                for (int n = 0; n < 2; ++n) acc[a][b][m][n] = (f32x4){0.f, 0.f, 0.f, 0.f};
    bf16x8 At[4][2], B0[2][2], B1[2][2];
    const char* cA = PG8_APTR(cur); const char* cB = PG8_BPTR(cur);
    PG8_STAGE(PG8_SB(0, 0), cB, voffB); PG8_STAGE(PG8_SA(0, 0), cA, voffA); PG8_STAGE(PG8_SB(0, 1), cB + hstepB, voffB); PG8_STAGE(PG8_SA(0, 1), cA + hstepA, voffA);
    if (wr == 1) PG8_BAR;
    PG8_WAIT_V(4); PG8_BAR;
    PG8_STAGE(PG8_SB(1, 0), cB + kstep, voffB); PG8_STAGE(PG8_SA(1, 0), cA + kstep, voffA); PG8_STAGE(PG8_SB(1, 1), cB + hstepB + kstep, voffB);
    PG8_WAIT_V(6); PG8_BAR;
    for (;;) {
        const bool has_next = S.next(ui + 1, nxt);
        const char* nA = has_next ? PG8_APTR(nxt) : cA; const char* nB = has_next ? PG8_BPTR(nxt) : cB;
        for (int t = 0; t < nt; t += 2) {
            const bool last = (t == nt - 2);
            const char* a1 = cA + (size_t)(t + 1) * kstep;
            const char* a2 = last ? nA : cA + (size_t)(t + 2) * kstep; const char* b2 = last ? nB : cB + (size_t)(t + 2) * kstep;
            const char* a3 = a2 + kstep; const char* b3 = b2 + kstep;
            PG8_LDB(B0, 0, 0); PG8_SCHED; PG8_LDA(At, 0, 0); PG8_STAGE(PG8_SA(1, 1), a1 + hstepA, voffA);
            PG8_WAIT_L(8); PG8_BAR; PG8_WAIT_L(0); PG8_MMA(0, 0, At, B0); PG8_BAR; PG8_SCHED;
            PG8_LDB(B1, 0, 1); PG8_STAGE(PG8_SB(0, 0), b2, voffB);
            PG8_BAR; PG8_WAIT_L(0); PG8_MMA(0, 1, At, B1); PG8_BAR;
            PG8_LDA(At, 0, 1); PG8_STAGE(PG8_SA(0, 0), a2, voffA);
            PG8_BAR; PG8_WAIT_L(0); PG8_MMA(1, 0, At, B0); PG8_BAR; PG8_SCHED;
            PG8_STAGE(PG8_SB(0, 1), b2 + hstepB, voffB);
            PG8_WAIT_V(6); PG8_BAR; PG8_MMA(1, 1, At, B1); PG8_BAR;
            PG8_LDB(B0, 1, 0); PG8_SCHED; PG8_LDA(At, 1, 0); PG8_STAGE(PG8_SA(0, 1), a2 + hstepA, voffA);
            PG8_WAIT_L(8); PG8_BAR; PG8_WAIT_L(0); PG8_MMA(0, 0, At, B0); PG8_BAR; PG8_SCHED;
            PG8_LDB(B1, 1, 1); PG8_STAGE(PG8_SB(1, 0), b3, voffB);
            PG8_BAR; PG8_WAIT_L(0); PG8_MMA(0, 1, At, B1); PG8_BAR;
            PG8_LDA(At, 1, 1); PG8_STAGE(PG8_SA(1, 0), a3, voffA);
            PG8_BAR; PG8_WAIT_L(0); PG8_MMA(1, 0, At, B0); PG8_BAR; PG8_SCHED;
            PG8_STAGE(PG8_SB(1, 1), b3 + hstepB, voffB);
            PG8_WAIT_V(6); PG8_BAR; PG8_MMA(1, 1, At, B1); PG8_BAR;
        }
        E(acc, cur, wr, wc, fr, fq);
        if (!has_next) break;
#pragma unroll
        for (int a = 0; a < 2; ++a)
#pragma unroll
            for (int b = 0; b < 2; ++b)
#pragma unroll
                for (int m = 0; m < 4; ++m)
#pragma unroll
                    for (int n = 0; n < 2; ++n) acc[a][b][m][n] = (f32x4){0.f, 0.f, 0.f, 0.f};
        cur = nxt; cA = nA; cB = nB; ++ui;
    }
    PG8_WAIT_V(0);
    if (wr == 0) PG8_BAR;
    PG8_BAR;
#undef PG8_SA
#undef PG8_SB
#undef PG8_STAGE
#undef PG8_LDA
#undef PG8_LDB
#undef PG8_MMA
#undef PG8_WAIT_V
#undef PG8_WAIT_L
#undef PG8_BAR
#undef PG8_SCHED
#undef PG8_APTR
#undef PG8_BPTR
}
}

struct SmallGemm { const bf16_t* A; const bf16_t* B; int lda, ldb, K, akseg, bkseg; long aseg, bseg; int a_tiled; };
constexpr int SG_LD = 72;
constexpr int SG_TILE = 64 * SG_LD * 2;
template <class Dec, class Epi>
__device__ __forceinline__ void gemm_small(LAS unsigned char* lds, const SmallGemm g, int nunits, const Dec& dec, const Epi& epi, int G_, int c_, int tid_in) {
    int tid_ = tid_in; asm volatile("" : "+v"(tid_));
    const int tid = tid_, wid = tid >> 6, lane = tid & 63, wm = wid >> 1, wn = wid & 1, fr = lane & 15, fq = lane >> 4;
    const int lrow = tid >> 3, lk = (tid & 7) * 8;
    const int nk = g.K / 64;
    const unsigned stoff = (unsigned)(lrow * SG_LD + lk) * 2u;
#define SG_LOAD(ra_, rb_, kt_) do { const int k_ = (kt_) * 64 + lk; \
        if (g.a_tiled) ra_ = *(const u32x4*)(g.A + (((((size_t)aoff * 8 + (k_ >> 6)) * 4 + (lrow >> 4)) * 2 + ((k_ >> 5) & 1)) * 512 + (size_t)(((k_ >> 3) & 3) * 16 + (lrow & 15)) * 8)); \
        else ra_ = *(const u32x4*)(ap + (long)(k_ / g.akseg) * g.aseg + (k_ % g.akseg)); \
        rb_ = *(const u32x4*)(bp + (long)(k_ / g.bkseg) * g.bseg + (k_ % g.bkseg)); } while (0)
#define SG_STORE(ra_, rb_, bufi_) do { *(LAS u32x4*)(lds + ((bufi_) * 2 + 0) * SG_TILE + stoff) = ra_; *(LAS u32x4*)(lds + ((bufi_) * 2 + 1) * SG_TILE + stoff) = rb_; } while (0)
#define SG_COMPUTE(bufi_) do { const LAS unsigned char* As = lds + ((bufi_) * 2 + 0) * SG_TILE; const LAS unsigned char* Bs = lds + ((bufi_) * 2 + 1) * SG_TILE; \
        _Pragma("unroll") for (int ks = 0; ks < 2; ++ks) { const bf16x8 af = *(const LAS bf16x8*)(As + ((wm * 16 + fr) * SG_LD + ks * 32 + fq * 8) * 2); \
            _Pragma("unroll") for (int nt = 0; nt < 2; ++nt) { const bf16x8 bf = *(const LAS bf16x8*)(Bs + ((wn * 32 + nt * 16 + fr) * SG_LD + ks * 32 + fq * 8) * 2); \
                acc[nt] = __builtin_amdgcn_mfma_f32_16x16x32_bf16(bf, af, acc[nt], 0, 0, 0); } } } while (0)
    for (int u = c_; u < nunits; u += G_) {
        long aoff, boff; dec(u, aoff, boff);
        const bf16_t* ap = g.A + aoff + (long)lrow * g.lda; const bf16_t* bp = g.B + boff + (long)lrow * g.ldb;
        f32x4 acc[2] = {(f32x4){0.f, 0.f, 0.f, 0.f}, (f32x4){0.f, 0.f, 0.f, 0.f}};
        u32x4 ra0, rb0, ra1, rb1, ra2, rb2, ra3, rb3;
        ra0 = (u32x4){0u, 0u, 0u, 0u}; rb0 = ra0; ra1 = ra0; rb1 = ra0; ra2 = ra0; rb2 = ra0; ra3 = ra0; rb3 = ra0;
        SG_LOAD(ra0, rb0, 0); if (nk > 1) SG_LOAD(ra1, rb1, 1); if (nk > 2) SG_LOAD(ra2, rb2, 2); if (nk > 3) SG_LOAD(ra3, rb3, 3);
        SG_STORE(ra0, rb0, 0);
        LDS_BARRIER();
#define SG_TURN(kt_, bufc, rnextA, rnextB, rfreeA, rfreeB) do { if ((kt_) < nk) { \
            SG_COMPUTE(bufc); \
            if ((kt_) + 1 < nk) SG_STORE(rnextA, rnextB, (bufc) ^ 1); \
            if ((kt_) + 4 < nk) SG_LOAD(rfreeA, rfreeB, (kt_) + 4); \
            LDS_BARRIER(); } } while (0)
        for (int kt = 0; kt < nk; kt += 4) {
            SG_TURN(kt,     0, ra1, rb1, ra0, rb0);
            SG_TURN(kt + 1, 1, ra2, rb2, ra1, rb1);
            SG_TURN(kt + 2, 0, ra3, rb3, ra2, rb2);
            SG_TURN(kt + 3, 1, ra0, rb0, ra3, rb3);
        }
#undef SG_TURN
#pragma unroll
        for (int nt = 0; nt < 2; ++nt) epi(u, wm * 16 + fr, wn * 32 + nt * 16 + fq * 4, acc[nt]);
    }
#undef SG_LOAD
#undef SG_STORE
#undef SG_COMPUTE
}

struct SmallDense { bf16_t* O; long o_gs; int ldc, mt, nt, act; long a_gs, b_gs; int mode; };
__device__ __forceinline__ void gemm_small_dense(LAS unsigned char* lds, const SmallGemm g, const SmallDense d, int ngroups, int G_, int c_, int tid_in) {
    const int per = d.mt * d.nt;
    auto dec = [=](int u, long& ao, long& bo) { const int gi = u / per, r = u % per, mi = r / d.nt, ni = r % d.nt; ao = gi * d.a_gs + (long)mi * 64 * g.lda; bo = gi * d.b_gs + (long)ni * 64 * g.ldb; };
    auto epi = [=](int u, int m, int n, const f32x4& v) { const int gi = u / per, r = u % per, mi = r / d.nt, ni = r % d.nt;
        f32x4 x = v; if (d.act == 1) {
#pragma unroll
            for (int i = 0; i < 4; ++i) { const float a = fmaxf(x[i], 0.f); x[i] = a * a; } }
        u32x2 w; w.x = pk2(x[0], x[1]); w.y = pk2(x[2], x[3]);
        if (d.mode == 0) *(u32x2*)(d.O + gi * d.o_gs + (size_t)(mi * 64 + m) * d.ldc + ni * 64 + n) = w;
        else if (d.mode == 1) *(u32x2*)(d.O + qtile_off(mi * 64 + m, gi, ni * 64 + n)) = w;
        else if (d.mode == 2) *(u32x2*)(d.O + ktile_off(mi * 64 + m, gi, ni * 64 + n)) = w;
        else *(u32x2*)(d.O + vtile_off(mi * 64 + m, gi, ni * 64 + n)) = w; };
    gemm_small(lds, g, ngroups * per, dec, epi, G_, c_, tid_in);
}

struct Args { const float* in[22]; float* out; unsigned char* ws; int ph_lo, ph_hi, ph_last, li; };
enum { I_X = 0, I_C, I_CTX, I_CCTX, I_ADAW, I_ADAB, I_PG, I_PB, I_WIN, I_WCONV, I_BCONV, I_WQ, I_WK, I_WV, I_WGATE, I_BGATE, I_GNW, I_SKIP, I_WOUT, I_FWOUT, I_W1, I_W2 };

constexpr int LDS_BYTES = 147456;
constexpr int LDS_MISC = LDS_BYTES - 256;

__device__ __forceinline__ void transpose_item(const float* W, int K, int N, bf16_t* WT, float scale, LAS float* scr, int item, int lane) {
    const int nblk = N / 32, kb = item / nblk, nb = item % nblk, k0 = 64 * kb, n0 = 32 * nb;
#pragma unroll 8
    for (int i = 0; i < 32; ++i) { const int kk = 2 * i + (lane >> 5); scr[kk * 33 + (lane & 31)] = W[(size_t)(k0 + kk) * N + n0 + (lane & 31)] * scale; }
    asm volatile("s_waitcnt lgkmcnt(0)" ::: "memory");
    const int c = lane & 7;
#pragma unroll
    for (int j = 0; j < 4; ++j) { const int n = (lane >> 3) + 8 * j; const LAS float* s = scr + (8 * c) * 33 + n;
        u32x4 o; o.x = pk2(s[0 * 33], s[1 * 33]); o.y = pk2(s[2 * 33], s[3 * 33]); o.z = pk2(s[4 * 33], s[5 * 33]); o.w = pk2(s[6 * 33], s[7 * 33]);
        *(u32x4*)(WT + (size_t)(n0 + n) * K + k0 + 8 * c) = o; }
    asm volatile("s_waitcnt lgkmcnt(0)" ::: "memory");
}

__device__ __forceinline__ void ln_norm(f32x4 (&v)[4], int lane) {
    float s = 0.f;
#pragma unroll
    for (int j = 0; j < 4; ++j) s += (v[j][0] + v[j][1]) + (v[j][2] + v[j][3]);
    const float mean = wave_sum(s, lane) * (1.f / D); float s2 = 0.f;
#pragma unroll
    for (int j = 0; j < 4; ++j) { v[j] = v[j] - mean; s2 += (v[j][0] * v[j][0] + v[j][1] * v[j][1]) + (v[j][2] * v[j][2] + v[j][3] * v[j][3]); }
    const float rstd = __builtin_amdgcn_rsqf(wave_sum(s2, lane) * (1.f / D) + LN_EPS);
#pragma unroll
    for (int j = 0; j < 4; ++j) v[j] = v[j] * rstd;
}

constexpr int PL = 24;
constexpr int NPHASE = 2 + 4 * PL;
__host__ __device__ inline bool phase_valid(int id) {
    if (id < 2) return true;
    const int layer = (id - 2) / PL, k = (id - 2) % PL;
    if (layer > 3) return false;
    if (k == 0 || (k >= 19 && k <= 22)) return true;
    if (layer & 1) return k >= 2 && k <= 5;
    return k >= 1 && k <= 18;
}


#define MOD ((float*)(ws + WS_MOD))
#define CTXX ((float*)(ws + WS_CTXX))
#define PRE ((float*)(ws + WS_PRE))
#define HIN ((bf16_t*)(ws + WS_HIN))
#define YB ((bf16_t*)(ws + WS_YB))
#define WIN ((bf16_t*)(ws + W_IN))
#define WQ ((bf16_t*)(ws + W_Q))
#define WK ((bf16_t*)(ws + W_K))
#define WV ((bf16_t*)(ws + W_V))
#define WOUT ((bf16_t*)(ws + W_OUT))
#define W1 ((bf16_t*)(ws + W_1))
#define W2 ((bf16_t*)(ws + W_2))
#define GATET ((bf16_t*)(ws + TAB_GATE))
#define S0 ((bf16_t*)(ws + WS_BIG + 0 * SLOT))
#define S1 ((bf16_t*)(ws + WS_BIG + 1 * SLOT))
#define S2 ((bf16_t*)(ws + WS_BIG + 2 * SLOT))
#define S3 ((bf16_t*)(ws + WS_BIG + 3 * SLOT))
#define S4 ((bf16_t*)(ws + WS_BIG + 4 * SLOT))
#define YH (YB + ((size_t)CR + (size_t)half * LH) * D)
#define YHC (YB + (size_t)half * LAT0 * D)
#define HCB (YH + (size_t)NCH * 4 * 2 * 4096 + (size_t)NCH * 4 * 2 * 384 * 2)
#define PREQ ((float*)(HCB + (size_t)LAT0 * DI))
#define HH (HIN + ((size_t)CR + (size_t)half * LH) * D)
#define HHC (HIN + (size_t)half * LAT0 * D)
#define HT ((bf16_t*)(ws + WS_BIG))
#define HTC (HT + (size_t)NB * D * T)
#define PB ((bf16_t*)(ws + WS_BIG + 1 * SLOT))
#define WC ((bf16_t*)(ws + WS_BIG + 3 * SLOT))
#define ZF ((bf16_t*)(ws + WS_BIG))
#define HID ((bf16_t*)(ws + WS_BIG))

constexpr int SC_PLD = 36, SC_VLD = 72;
#define SC_ROW0(j) (((j) < 4) ? (bl * CT + (dir ? 3 - (j) : (j)) * 64) : (LAT0 + bl * T + (dir ? 127 - ((j) - 4) : ((j) - 4)) * 64))
#define SC_LOADQ(dst, r0) do { _Pragma("unroll") for (int pt = 0; pt < 4; ++pt) _Pragma("unroll") for (int ks = 0; ks < 2; ++ks) \
        dst[pt][ks] = __builtin_bit_cast(bf16x8, __builtin_amdgcn_raw_buffer_load_b128(rW, loff, oQ + ((((((r0) >> 6) * 4 + hh) * 8 + w) * 4 + pt) * 2 + ks) * 1024, 0)); } while (0)
#define SC_LOADQ1(dst, r0, pt, ks) dst[pt][ks] = __builtin_bit_cast(bf16x8, __builtin_amdgcn_raw_buffer_load_b128(rW, loff, oQ + ((((((r0) >> 6) * 4 + hh) * 8 + w) * 4 + (pt)) * 2 + (ks)) * 1024, 0))
#define SC_LOADK1(dst, r0, mt, ks) dst[mt][ks] = __builtin_bit_cast(bf16x8, __builtin_amdgcn_raw_buffer_load_b128(rW, loff, oK + ((((((r0) >> 6) * 4 + hh) * 8 + w) * 4 + (mt)) * 2 + (ks)) * 1024, 0))
#define SC_LOADK(dst, r0) do { _Pragma("unroll") for (int mt = 0; mt < 4; ++mt) _Pragma("unroll") for (int ks = 0; ks < 2; ++ks) \
        dst[mt][ks] = __builtin_bit_cast(bf16x8, __builtin_amdgcn_raw_buffer_load_b128(rW, loff, oK + ((((((r0) >> 6) * 4 + hh) * 8 + w) * 4 + mt) * 2 + ks) * 1024, 0)); } while (0)
#define SC_LOADS(P, r0) do { const int ci_ = ((((r0) >> 6) * 4 + hh) * 2 + dir); \
        P##sg0 = __builtin_bit_cast(bf16x8, __builtin_amdgcn_raw_buffer_load_b128(rW, loff, oS + ci_ * 8192 + (w >> 1) * 2048, 0)); P##sg1 = __builtin_bit_cast(bf16x8, __builtin_amdgcn_raw_buffer_load_b128(rW, loff, oS + ci_ * 8192 + (w >> 1) * 2048 + 1024, 0)); \
        P##v = __builtin_bit_cast(u32x4, __builtin_amdgcn_raw_buffer_load_b128(rW, loff, oV + ((((r0) >> 6) * 4 + hh) * 16 + slice) * 4096 + (w & 3) * 1024, 0));     \
        P##wka = __builtin_bit_cast(u32x4, __builtin_amdgcn_raw_buffer_load_b128(rW, wkoff, oG + ci_ * 1536 + 1296, 0));         \
        P##wint = __builtin_bit_cast(float, __builtin_amdgcn_raw_buffer_load_b32(rW, gcp, oG + ci_ * 1536 + 512, 0)); P##em = __builtin_bit_cast(float, __builtin_amdgcn_raw_buffer_load_b32(rW, gcp, oG + ci_ * 1536 + 768, 0)); \
        P##dec = __builtin_bit_cast(float, __builtin_amdgcn_raw_buffer_load_b32(rW, 0, oG + ci_ * 1536 + 1280, 0)); } while (0)
#define SC_VWRITE(bufi, P) do { LAS bf16_t* vt_ = VB + (bufi) * 2 * 3072; LAS bf16_t* vw_ = vt_ + 3072; \
        if (w < 5) { const float wk_[8] = {bflo(P##wka.x), bfhi(P##wka.x), bflo(P##wka.y), bfhi(P##wka.y), bflo(P##wka.z), bfhi(P##wka.z), bflo(P##wka.w), bfhi(P##wka.w)};     \
            if (w < 4) { *(LAS u32x4*)(vt_ + tid * 8) = P##v; \
                u32x4 sv_; sv_.x = pk2(bflo(P##v.x) * wk_[0], bfhi(P##v.x) * wk_[1]); sv_.y = pk2(bflo(P##v.y) * wk_[2], bfhi(P##v.y) * wk_[3]); \
                sv_.z = pk2(bflo(P##v.z) * wk_[4], bfhi(P##v.z) * wk_[5]); sv_.w = pk2(bflo(P##v.w) * wk_[6], bfhi(P##v.w) * wk_[7]); *(LAS u32x4*)(vw_ + tid * 8) = sv_; } \
            else if (lane < 8) { const u32x4 sv_ = P##wka; \
                int ln_ = lane; asm volatile("" : "+v"(ln_));     \
                *(LAS u32x4*)(vw_ + (4 + (ln_ >> 2)) * 512 + (ln_ & 3) * 16 * 8) = sv_; } } } while (0)
#define SC_STEP(J, Qc, Qn, Kc, Kn, C, N) do { \
    const int j_ = (J); const int row0 = SC_ROW0(j_); const int jn_ = j_ < 131 ? j_ + 1 : 131; const int row1 = SC_ROW0(jn_); \
    const int hsel = (j_ < 4) ? (dir ? 2 : 0) : ((j_ < 68) ? 0 : 1); \
    const int buf = j_ & 1; \
    const LAS bf16_t* VT = VB + buf * 2 * 3072; const LAS bf16_t* VW = VT + 3072; \
    LAS bf16_t* Pb_ = Pbh + buf * (8 * 64 * 40); LAS float* Nq_ = NQs + buf * (8 * 64);        \
    SC_LOADS(N, row1); \
      \
    if (!(abl_ & 1)) _Pragma("unroll") for (int nt = 0; nt < 3; ++nt) { \
        f32x4 d1[4]; \
        _Pragma("unroll") for (int pt = 0; pt < 4; ++pt) d1[pt] = (f32x4){0.f, 0.f, 0.f, 0.f}; \
        _Pragma("unroll") for (int ks = 0; ks < 2; ++ks) { \
            u32x4 bw; bw.x = pg8::cvt_pk_bf16(st[2 * ks][nt][0], st[2 * ks][nt][1]); bw.y = pg8::cvt_pk_bf16(st[2 * ks][nt][2], st[2 * ks][nt][3]); \
            bw.z = pg8::cvt_pk_bf16(st[2 * ks + 1][nt][0], st[2 * ks + 1][nt][1]); bw.w = pg8::cvt_pk_bf16(st[2 * ks + 1][nt][2], st[2 * ks + 1][nt][3]); \
            const bf16x8 bs = __builtin_bit_cast(bf16x8, bw); \
            _Pragma("unroll") for (int pt = 0; pt < 4; ++pt) d1[pt] = __builtin_amdgcn_mfma_f32_16x16x32_bf16(bs, Qc[pt][ks], d1[pt], 0, 0, 0); \
            SC_LOADQ1(Qn, row1, (nt * 2 + ks) >> 1, (nt * 2 + ks) & 1);     } \
        _Pragma("unroll") for (int pt = 0; pt < 4; ++pt) { \
            if (nt < 2) { u32x2 pw_; pw_.x = pg8::cvt_pk_bf16(d1[pt][0], d1[pt][1]); pw_.y = pg8::cvt_pk_bf16(d1[pt][2], d1[pt][3]); *(LAS u32x2*)(Pb_ + (w * 64 + 16 * pt + fr) * 40 + 16 * nt + 4 * fq) = pw_; }     \
            else if (fq == 0) Nq_[w * 64 + 16 * pt + fr] = d1[pt][0]; } } \
    SC_LOADQ1(Qn, row1, 3, 0); SC_LOADQ1(Qn, row1, 3, 1); \
    LDS_BARRIER();                                                       \
      \
    f32x4 d2 = (f32x4){0.f, 0.f, 0.f, 0.f}, d3 = (f32x4){0.f, 0.f, 0.f, 0.f}; \
    if (!(abl_ & 2)) {     \
        const int nt2 = w & 1; \
        const bf16x8 vt0 = *(const LAS bf16x8*)(VT + (nt2 * 2 + 0) * 512 + lane * 8), vt1 = *(const LAS bf16x8*)(VT + (nt2 * 2 + 1) * 512 + lane * 8); \
        const bf16x8 vo0 = *(const LAS bf16x8*)(VT + 4 * 512 + lane * 8), vo1 = *(const LAS bf16x8*)(VT + 5 * 512 + lane * 8); \
        d2 = __builtin_amdgcn_mfma_f32_16x16x32_bf16(vt0, C##sg0, d2, 0, 0, 0); d3 = __builtin_amdgcn_mfma_f32_16x16x32_bf16(vo0, C##sg0, d3, 0, 0, 0); \
        d2 = __builtin_amdgcn_mfma_f32_16x16x32_bf16(vt1, C##sg1, d2, 0, 0, 0); d3 = __builtin_amdgcn_mfma_f32_16x16x32_bf16(vo1, C##sg1, d3, 0, 0, 0); } \
      \
    if (!(abl_ & 4)) _Pragma("unroll") for (int nt = 0; nt < 3; ++nt) { \
        const bf16x8 vw0 = *(const LAS bf16x8*)(VW + (nt * 2 + 0) * 512 + lane * 8), vw1 = *(const LAS bf16x8*)(VW + (nt * 2 + 1) * 512 + lane * 8); \
        _Pragma("unroll") for (int mt = 0; mt < 4; ++mt) { f32x4 a = st[mt][nt] * C##dec; \
            a = __builtin_amdgcn_mfma_f32_16x16x32_bf16(Kc[mt][0], vw0, a, 0, 0, 0); \
            a = __builtin_amdgcn_mfma_f32_16x16x32_bf16(Kc[mt][1], vw1, a, 0, 0, 0); st[mt][nt] = a; \
            if (nt < 2) SC_LOADK1(Kn, row1, (nt * 4 + mt) >> 1, (nt * 4 + mt) & 1); } } \
    if (!(abl_ & 8)) {     \
        f32x4 o1 = (f32x4){0.f, 0.f, 0.f, 0.f}; float nq = 0.f; \
        _Pragma("unroll") for (int ww = 0; ww < 8; ++ww) { const u32x2 cpr_ = *(const LAS u32x2*)(Pb_ + (ww * 64 + cp) * 40 + cv); nq += Nq_[ww * 64 + cp]; \
            o1 += (f32x4){bflo(cpr_.x), bfhi(cpr_.x), bflo(cpr_.y), bfhi(cpr_.y)}; } \
        const float den = C##wint * nq + d3[0]; const float scl = __builtin_amdgcn_rcpf(fmaxf(fabsf(den), C##em)); \
        const f32x4 o = (o1 * C##wint + d2) * scl; \
        u32x2 ow; ow.x = pk2(o[0], o[1]); ow.y = pk2(o[2], o[3]); \
        unsigned lo_ = loff; asm volatile("" : "+v"(lo_)); const unsigned hoff_ = ((lo_ >> 4) & 15u) * 64u + (lo_ >> 8) * 8u;     \
        __builtin_amdgcn_raw_buffer_store_b64(ow, rW, hoff_, (rep_ + 1 < SCAN_REP) ? (oC + 512 * DI * 2) : ((hsel == 0 ? oH : (hsel == 1 ? oV : oC)) + (((row0 >> 6) * 4 + hh) * 16 + slice) * 4096 + (w >> 1) * 1024 + (w & 1) * 32), 0); } \
    if (!(abl_ & 16)) SC_VWRITE(buf ^ 1, N);                                     \
} while (0)

__device__ __forceinline__ void scan_phase(LAS unsigned char* lds, unsigned char* ws, int half, const XcdBarrier& bar, int tid, int lane, int wave, int bx) {
    LAS bf16_t* Pbh = (LAS bf16_t*)lds;
    LAS float* NQs = (LAS float*)(lds + 2 * 8 * 64 * 40 * 2);
    LAS bf16_t* VB = (LAS bf16_t*)(NQs + 2 * 8 * 64);
    const int xcd = bx & 7, idx = bx >> 3;
    const int scn = (xcd * 2 + (idx >> 4)) & 15, slice = idx & 15;
    const int bl = scn >> 3, hh = (scn >> 1) & 3, dir = scn & 1, e0 = slice * 32;
    const int fr = lane & 15, fq = lane >> 4, w = wave;
    const int cp = 16 * (w >> 1) + fr, cv = 16 * (w & 1) + 4 * fq;
    const unsigned loff = (unsigned)lane * 16u;
    const unsigned gcp = (unsigned)cp * 4u;
    const unsigned wkoff = (w < 4) ? (unsigned)(32 * ((tid >> 6) & 1) + 8 * ((tid & 63) >> 4)) * 2u : (unsigned)(32 * ((lane >> 2) & 1) + 8 * (lane & 3)) * 2u;
    const __amdgpu_buffer_rsrc_t rW = __builtin_amdgcn_make_buffer_rsrc((void*)ws, 0, (int)(512 * MiB), 0x00020000);
    const int oYH = (int)(WS_YB + ((size_t)CR + (size_t)half * LH) * D * 2);
    const int oQ = (int)(WS_BIG + 3 * SLOT), oK = (int)(WS_BIG + 4 * SLOT), oV = (int)(WS_BIG + 2 * SLOT), oH = (int)(WS_BIG + 0 * SLOT);
    const int oS = oYH, oG = oYH + NCH * 4 * 2 * 8192, oC = oG + NCH * 4 * 2 * 1536;
    for (int i = tid; i < 4 * 1024; i += NTHR) { const int im = i >> 10, r = i & 1023, ln = (r & 511) >> 3; VB[im * 3072 + 2048 + r] = (bf16_t)(((im & 1) == 0 && (ln & 3) == 0) ? 0x3F80u : 0u); }
    __syncthreads();
    for (int rep_ = 0; rep_ < SCAN_REP; ++rep_) {
    const int abl_ = (rep_ + 1 < SCAN_REP) ? SC_ABL : 0;
    f32x4 st[4][3];
#pragma unroll
    for (int a = 0; a < 4; ++a)
#pragma unroll
        for (int b = 0; b < 3; ++b) st[a][b] = (f32x4){0.f, 0.f, 0.f, 0.f};
    bf16x8 Q0[4][2], Q1[4][2], K0[4][2], K1[4][2];
    bf16x8 Asg0, Asg1, Bsg0, Bsg1; u32x4 Av = (u32x4){0u, 0u, 0u, 0u}, Bv = Av, Awka = Av, Bwka = Av; float Awint, Aem, Adec, Bwint, Bem, Bdec;
    { const int r0 = SC_ROW0(0); SC_LOADQ(Q0, r0); SC_LOADK(K0, r0); SC_LOADS(A, r0); SC_VWRITE(0, A); }
#pragma unroll 1
    for (int j = 0; j < 132; j += 2) {
        if (j == 68) xcd_barrier(bar, tid == 0);
        SC_STEP(j, Q0, Q1, K0, K1, A, B);
        SC_STEP(j + 1, Q1, Q0, K1, K0, B, A);
    }
    __syncthreads();
    }
}
#undef SC_ROW0
#undef SC_LOADQ
#undef SC_LOADK
#undef SC_LOADS
#undef SC_VWRITE
#undef SC_STEP

typedef const __attribute__((address_space(4))) Args KA;
__device__ __forceinline__ KA* kargs() { KA* k = (KA*)__builtin_amdgcn_kernarg_segment_ptr(); asm volatile("" : "+s"(k)); return k; }
#define PH_BEGIN() \
    KA* ka = kargs(); unsigned char* ws = ka->ws; (void)ws; \
    int wave = wave0; asm volatile("" : "+s"(wave)); \
    unsigned lz_ = 0u; asm volatile("" : "+v"(lz_)); const int lane = (int)__builtin_amdgcn_mbcnt_hi(~0u, __builtin_amdgcn_mbcnt_lo(~0u, lz_)); \
    const int tid = wave * 64 + lane; (void)tid; \
    const int gw = bx * NWAVES + wave, NGW = G * NWAVES; (void)gw; (void)NGW;

__global__ void __launch_bounds__(NTHR, 2) fwd(Args args) {
    extern __shared__ __attribute__((aligned(16))) unsigned char lds_raw[];
    LAS unsigned char* lds = (LAS unsigned char*)lds_raw;
    const int G = gridDim.x, bx = blockIdx.x;
    const int wave0 = __builtin_amdgcn_readfirstlane(threadIdx.x >> 6);
    volatile LAS unsigned* MISC = (volatile LAS unsigned*)(lds + LDS_MISC);
    if (threadIdx.x < 64) MISC[threadIdx.x] = 0u;
    __syncthreads();
    XcdBarrier bar = xcd_barrier_post((unsigned*)(args.ws + WS_CTL + 65536) + (size_t)args.li * 4096, MISC + 8);
    const int lo = args.ph_lo, hi = args.ph_hi, plast = args.ph_last;
#define IN(k) (lo <= (k) && (k) < hi)
#define SEAM(k) do { if ((k) != plast) { xcd_barrier(bar, tid == 0); if (DUP_BAR) xcd_barrier(bar, tid == 0); } } while (0)

    if (EN_PRO && IN(0)) { PH_BEGIN();
        {
            LAS float* sc = (LAS float*)lds;
            for (int i = tid; i < 5 * D; i += NTHR) { const int r = i / D, k = i % D; const float x = r < 4 ? ka->in[I_C][r * D + k] : ka->in[I_CCTX][k]; sc[i] = siluf(x); }
            __syncthreads();
            LAS float* red = (LAS float*)(lds + 32768);
            const int kp = tid >> 6, cc = tid & 63;
            for (int item = bx; item < 4 * 96; item += G) {
                const int layer = item / 96, n0 = (item % 96) * 64;
                const float* w = ka->in[I_ADAW] + (size_t)layer * D * 6 * D + n0 + cc;
                float a0 = 0.f, a1 = 0.f, a2 = 0.f, a3 = 0.f, a4 = 0.f;
                for (int k = kp * 128; k < kp * 128 + 128; ++k) { const float wv = w[(size_t)k * 6 * D]; a0 += sc[k] * wv; a1 += sc[D + k] * wv; a2 += sc[2 * D + k] * wv; a3 += sc[3 * D + k] * wv; a4 += sc[4 * D + k] * wv; }
                red[(kp * 64 + cc) * 5 + 0] = a0; red[(kp * 64 + cc) * 5 + 1] = a1; red[(kp * 64 + cc) * 5 + 2] = a2; red[(kp * 64 + cc) * 5 + 3] = a3; red[(kp * 64 + cc) * 5 + 4] = a4;
                __syncthreads();
                if (tid < 320) { const int c2 = tid % 64, r = tid / 64; float s = ka->in[I_ADAB][layer * 6 * D + n0 + c2];
                    for (int q = 0; q < 8; ++q) s += red[(q * 64 + c2) * 5 + r];
                    MOD[((size_t)layer * 5 + r) * 6 * D + n0 + c2] = s; }
                __syncthreads();
            }
        }
        {
            bf16_t* A1 = (bf16_t*)(ws + TAB_A1); bf16_t* A2 = (bf16_t*)(ws + TAB_A2); bf16_t* BZ = (bf16_t*)(ws + TAB_BZ); bf16_t* ACTX = (bf16_t*)(ws + TAB_ACTX);
            const int gt = bx * NTHR + tid, NGT = G * NTHR;
            const float s8192 = 0.011048543456039806f;
            for (int i = gt; i < 512 * 256; i += NGT) { const int m = i / 256, t1 = i % 256, ri = m / 256, t1p = m % 256; const int ph = (t1 * t1p) & 255; float sn, cs; sincospif((float)ph * (2.0f / 256.0f), &sn, &cs);
                A1[i] = (bf16_t)f2bf((ri == 0 ? cs : -sn) * s8192);
                ACTX[i] = (bf16_t)f2bf((ri == 0 ? cs : -sn) * 0.0625f); }
            for (int i = gt; i < 256 * 64 * 64; i += NGT) { const int t1p = i / 4096, m = (i / 64) % 64, k = i % 64; const int rip = m / 32, t2p = m % 32, ri = k / 32, t2 = k % 32;
                const int ph = (t2 * t1p + 256 * t2 * t2p) & 8191; float sn, cs; sincospif((float)ph * (2.0f / 8192.0f), &sn, &cs);
                const float v = (rip == ri) ? cs : (rip == 0 ? sn : -sn); A2[i] = (bf16_t)f2bf(v); }
            for (int i = gt; i < 256 * 512; i += NGT) { const int cp = i / 512, k = i % 512, ri = k / 256, c = k % 256; const int ph = (c * cp) & 255; float sn, cs; sincospif((float)ph * (2.0f / 256.0f), &sn, &cs);
                BZ[i] = (bf16_t)f2bf((ri == 0 ? cs : sn) * 0.0625f); }
        }
        SEAM(0);
    }
    if (EN_PRO && IN(1)) { PH_BEGIN();
        for (int r = gw; r < R; r += NGW) {
            const RowInfo ri = row_info(r);
            const float* xr = ri.is_ctx ? ka->in[I_CTX] + ((size_t)ri.b * CT + ri.t) * D : ka->in[I_X] + ((size_t)ri.b * T + ri.t) * D;
            const float* md = MOD + ((size_t)0 * 5 + (ri.is_ctx ? 4 : ri.b)) * 6 * D;
            f32x4 v[4];
#pragma unroll
            for (int j = 0; j < 4; ++j) v[j] = *(const f32x4*)(xr + 256 * j + 4 * lane);
            ln_norm(v, lane);
            bf16_t* o = HIN + (size_t)r * D;
#pragma unroll
            for (int j = 0; j < 4; ++j) { const f32x4 sh = *(const f32x4*)(md + 256 * j + 4 * lane), sc = *(const f32x4*)(md + D + 256 * j + 4 * lane);
                const f32x4 h = v[j] * (1.0f + sc) + sh; u32x2 w; w.x = pk2(h[0], h[1]); w.y = pk2(h[2], h[3]); *(u32x2*)(o + 256 * j + 4 * lane) = w; }
        }
        SEAM(1);
    }

    for (int layer = 0; layer < 4; ++layer) {
        const int pb = 2 + layer * PL;
        if (hi <= pb || lo >= pb + PL) continue;
        const int jl = layer >> 1;
        const bool is_m = (layer & 1) == 0;
        if (EN_WC && IN(pb + 0)) { PH_BEGIN();
 for (int rp_ = 0; rp_ < REPN(5); ++rp_) {
            LAS float* scr = (LAS float*)(lds + wave * 16384);
            const int i_in = (D / 64) * (2 * DI / 32), i_h = (DH / 64) * (DH / 32), i_out = (DI / 64) * (D / 32), i_f = (D / 64) * (D / 32), i_1 = (D / 64) * (DFF / 32), i_2 = (DFF / 64) * (D / 32);
            const int n_mix = is_m ? (i_in + 12 * i_h + i_out) : i_f;
            const int nitems = n_mix + i_1 + i_2;
            for (int it = gw; it < nitems; it += NGW) {
                int r = it;
                if (r >= n_mix) { r -= n_mix;
                    if (r < i_1) transpose_item(ka->in[I_W1] + (size_t)layer * D * DFF, D, DFF, W1, 1.f, scr, r, lane);
                    else transpose_item(ka->in[I_W2] + (size_t)layer * DFF * D, DFF, D, W2, 1.f, scr, r - i_1, lane);
                    continue; }
                if (!is_m) { transpose_item(ka->in[I_FWOUT] + (size_t)jl * D * D, D, D, WOUT, 1.f, scr, r, lane); continue; }
                if (r < i_in) { transpose_item(ka->in[I_WIN] + (size_t)jl * D * 2 * DI, D, 2 * DI, WIN, 1.f, scr, r, lane); continue; } r -= i_in;
                if (r < 12 * i_h) { const int which = r / (4 * i_h), hh = (r / i_h) % 4, rr = r % i_h;
                    const float* src = ka->in[which == 0 ? I_WQ : (which == 1 ? I_WK : I_WV)] + ((size_t)jl * NH + hh) * DH * DH;
                    bf16_t* dst = (which == 0 ? WQ : (which == 1 ? WK : WV)) + (size_t)hh * DH * DH;
                    transpose_item(src, DH, DH, dst, which == 1 ? 0.044194173824159216f : 1.f, scr, rr, lane); continue; } r -= 12 * i_h;
                transpose_item(ka->in[I_WOUT] + (size_t)jl * DI * D, DI, D, WOUT, 1.f, scr, r, lane);
            }
            if (is_m) {
                const float* wg = ka->in[I_WGATE] + (size_t)jl * 3 * DI * 16;
                const int n = lane & 15, eq = lane >> 4;
                for (int k2 = gw; k2 < DI; k2 += NGW) {
                    const int hh = k2 / DH, d = k2 % DH;
                    const float* q = ka->in[I_WQ] + (((size_t)jl * NH + hh) * DH + d) * DH + eq * 128; const float* kx = ka->in[I_WK] + (((size_t)jl * NH + hh) * DH + d) * DH + eq * 128;
                    const float* vx = ka->in[I_WV] + (((size_t)jl * NH + hh) * DH + d) * DH + eq * 128;
                    const float* g0 = wg + ((size_t)0 * DI + hh * DH + eq * 128) * 16 + n; const float* g1 = wg + ((size_t)1 * DI + hh * DH + eq * 128) * 16 + n; const float* g2 = wg + ((size_t)2 * DI + hh * DH + eq * 128) * 16 + n;
                    float s0 = 0.f, s1 = 0.f, s2 = 0.f;
#pragma unroll 8
                    for (int e = 0; e < 128; ++e) { s0 += q[e] * g0[e * 16]; s1 += kx[e] * g1[e * 16]; s2 += vx[e] * g2[e * 16]; }
                    float sa = s0 + 0.044194173824159216f * s1;
                    sa += shx(sa, 16, lane); sa += shx(sa, 32, lane); s2 += shx(s2, 16, lane); s2 += shx(s2, 32, lane);
                    if (lane < 16) { GATET[(size_t)n * 4096 + k2] = (bf16_t)f2bf(sa); GATET[(size_t)n * 4096 + DI + k2] = (bf16_t)f2bf(s2); }
                    else if (lane < 64) { GATET[(size_t)(16 + (lane - 16)) * 4096 + k2] = (bf16_t)0; GATET[(size_t)(16 + (lane - 16)) * 4096 + DI + k2] = (bf16_t)0; }
                }
            }
 }
            SEAM(pb + 0);
        }

        if (EN_MIX && is_m) {
            for (int half = 0; half < 2; ++half) {
                const int hb = pb + 1 + 9 * half;
                if (hi <= hb || lo >= hb + 9) continue;
                if (IN(hb + 0)) { PH_BEGIN();
 for (int rp_ = 0; rp_ < REPN(0); ++rp_) {
                    pg8::Gemm g{HH, WIN, D, D, D, 0, 0, LH / 256, DI / 256, 1};
                    pg8::EpiStore E{S0 + (size_t)LAT0 * DI, 0, DI, 0};
                    pg8::gemm_phase(lds, g, E, G, bx, tid); if (DUP_MIX) pg8::gemm_phase(lds, g, E, G, bx, tid);
                    { SmallGemm sg{HHC, WIN, D, D, D, D, D, 0, 0}; SmallDense sd{S0, 0, DI, LAT0 / 64, DI / 64, 0, 0, 0}; gemm_small_dense(lds, sg, sd, 1, G, bx, tid); if (DUP_CTX) gemm_small_dense(lds, sg, sd, 1, G, bx, tid); }
 }
                    SEAM(hb + 0);
                }
                if (IN(hb + 1)) { PH_BEGIN();
 for (int rp_ = 0; rp_ < REPN(3); ++rp_) {
                    const float* wc = ka->in[I_WCONV] + (size_t)jl * 9 * DI; const float* bc = ka->in[I_BCONV] + (size_t)jl * DI;
                    const int gt = bx * NTHR + tid, NGT = G * NTHR;
                    for (int i = gt; i < 2 * 128 * 2 * (DI / 8); i += NGT) {
                        const int cg = i & 255, rest = i >> 8, hr = rest & 1, r = (rest >> 1) & 127, bl = rest >> 8, c0 = cg * 8, gc0 = 32 * hr;
                        float wv[9][8], bv[8];
#pragma unroll
                        for (int tp = 0; tp < 9; ++tp) { const f32x4 a0 = *(const f32x4*)(wc + (size_t)tp * DI + c0), a1 = *(const f32x4*)(wc + (size_t)tp * DI + c0 + 4);
                            wv[tp][0] = a0[0]; wv[tp][1] = a0[1]; wv[tp][2] = a0[2]; wv[tp][3] = a0[3]; wv[tp][4] = a1[0]; wv[tp][5] = a1[1]; wv[tp][6] = a1[2]; wv[tp][7] = a1[3]; }
                        { const f32x4 a0 = *(const f32x4*)(bc + c0), a1 = *(const f32x4*)(bc + c0 + 4); bv[0] = a0[0]; bv[1] = a0[1]; bv[2] = a0[2]; bv[3] = a0[3]; bv[4] = a1[0]; bv[5] = a1[1]; bv[6] = a1[2]; bv[7] = a1[3]; }
                        const bf16_t* xb = S0 + (size_t)(LAT0 + bl * T + r * 64) * DI + c0;
                        bf16_t* ob = S1 + (size_t)(LAT0 + bl * T + r * 64) * DI + c0;
                        const bool rok[3] = {r > 0, true, r < 127};
                        float win[3][3][8];
#define CV_LOADCOL(slot, col) do { _Pragma("unroll") for (int di = 0; di < 3; ++di) { u32x4 xv = (u32x4){0u, 0u, 0u, 0u}; \
                                if (rok[di] && (col) >= 0 && (col) < 64) xv = *(const u32x4*)(xb + (ptrdiff_t)((di - 1) * 64 + (col)) * DI); \
                                win[slot][di][0] = bflo(xv.x); win[slot][di][1] = bfhi(xv.x); win[slot][di][2] = bflo(xv.y); win[slot][di][3] = bfhi(xv.y); \
                                win[slot][di][4] = bflo(xv.z); win[slot][di][5] = bfhi(xv.z); win[slot][di][6] = bflo(xv.w); win[slot][di][7] = bfhi(xv.w); } } while (0)
#define CV_STEP(sl, sm, sr) do { CV_LOADCOL(sr, gc + 1); \
                                if (gc < gc0 + 32) { float acc[8]; \
                                    _Pragma("unroll") for (int e = 0; e < 8; ++e) { float s = bv[e]; \
                                        _Pragma("unroll") for (int di = 0; di < 3; ++di) s += win[sl][di][e] * wv[di * 3 + 0][e] + win[sm][di][e] * wv[di * 3 + 1][e] + win[sr][di][e] * wv[di * 3 + 2][e]; \
                                        acc[e] = siluf(s); } \
                                    u32x4 o; o.x = pk2(acc[0], acc[1]); o.y = pk2(acc[2], acc[3]); o.z = pk2(acc[4], acc[5]); o.w = pk2(acc[6], acc[7]); \
                                    *(u32x4*)(ob + (size_t)gc * DI) = o; } \
                                ++gc; } while (0)
                        int gc = gc0;
                        CV_LOADCOL(0, gc0 - 1); CV_LOADCOL(1, gc0);
#pragma unroll 1
                        for (int g3 = 0; g3 < 11; ++g3) { CV_STEP(0, 1, 2); CV_STEP(1, 2, 0); CV_STEP(2, 0, 1); }
#undef CV_LOADCOL
#undef CV_STEP
                    }
                    for (int i = gt; i < LAT0 * (DI / 8); i += NGT) {
                        const int q = i / (DI / 8), c0 = (i % (DI / 8)) * 8, t = q % CT;
                        float acc[8];
#pragma unroll
                        for (int e = 0; e < 8; ++e) acc[e] = bc[c0 + e];
#pragma unroll
                        for (int dj = 0; dj < 3; ++dj) { const int tt = t + dj - 1; if (tt < 0 || tt >= CT) continue;
                            const u32x4 xv = *(const u32x4*)(S0 + (size_t)(q + dj - 1) * DI + c0); const float* w = wc + (size_t)(3 + dj) * DI + c0;
                            acc[0] += bflo(xv.x) * w[0]; acc[1] += bfhi(xv.x) * w[1]; acc[2] += bflo(xv.y) * w[2]; acc[3] += bfhi(xv.y) * w[3];
                            acc[4] += bflo(xv.z) * w[4]; acc[5] += bfhi(xv.z) * w[5]; acc[6] += bflo(xv.w) * w[6]; acc[7] += bfhi(xv.w) * w[7]; }
                        u32x4 o; o.x = pk2(siluf(acc[0]), siluf(acc[1])); o.y = pk2(siluf(acc[2]), siluf(acc[3])); o.z = pk2(siluf(acc[4]), siluf(acc[5])); o.w = pk2(siluf(acc[6]), siluf(acc[7]));
                        *(u32x4*)(S1 + (size_t)q * DI + c0) = o;
                    }
 }
                    SEAM(hb + 1);
                }
                if (IN(hb + 2)) { PH_BEGIN();
 for (int rp_ = 0; rp_ < REPN(0); ++rp_) {
                    { pg8::Gemm g{WV, S0 + (size_t)LAT0 * DI, DH, DI, DH, (long)DH * DH, DH, DH / 256, LH / 256, NH};
                      pg8::EpiStore E{S2, 0, 0, 0, 3, LAT0};
                      pg8::gemm_phase(lds, g, E, G, bx, tid); if (DUP_MIX) pg8::gemm_phase(lds, g, E, G, bx, tid); }
                    { SmallGemm sg{WV, S0, DH, DI, DH, DH, DH, 0, 0}; SmallDense sd{S2, 0, 0, DH / 64, LAT0 / 64, 0, (long)DH * DH, DH, 3}; gemm_small_dense(lds, sg, sd, NH, G, bx, tid); if (DUP_CTX) gemm_small_dense(lds, sg, sd, NH, G, bx, tid); }
                    {
                      SmallGemm sg{S1, GATET, DI, 4096, 1024, 1024, 1024, 0, 0};
                      const long xm_off = (long)(S0 - S1);
                      auto dec = [=](int uq, long& ao, long& bo) { const int u = uq >> 2, q = uq & 3; ao = (long)u * 64 * DI + (q & 1) * 1024 + (q >> 1) * xm_off; bo = q * 1024; };
                      auto epi = [=](int uq, int m, int n, const f32x4& v) { const int u = uq >> 2, q = uq & 3; if (n < 16) *(f32x4*)(PREQ + (size_t)q * RH * 16 + ((size_t)u * 64 + m) * 16 + n) = v; };
                      gemm_small(lds, sg, NCH * 4, dec, epi, G, bx, tid); }
 }
                    SEAM(hb + 2);
                }
                if (IN(hb + 3)) { PH_BEGIN();
 for (int rp_ = 0; rp_ < REPN(0); ++rp_) {
                    { pg8::Gemm g{S1 + (size_t)LAT0 * DI, WQ, DI, DH, DH, DH, (long)DH * DH, LH / 256, DH / 256, NH}; pg8::EpiStore E{S3, DH, DI, 0, 1, LAT0}; pg8::gemm_phase(lds, g, E, G, bx, tid); if (DUP_MIX) pg8::gemm_phase(lds, g, E, G, bx, tid); }
                    { SmallGemm sg{S1, WQ, DI, DH, DH, DH, DH, 0, 0}; SmallDense sd{S3, DH, DI, LAT0 / 64, DH / 64, 0, DH, (long)DH * DH, 1}; gemm_small_dense(lds, sg, sd, NH, G, bx, tid); if (DUP_CTX) gemm_small_dense(lds, sg, sd, NH, G, bx, tid); }
                    { pg8::Gemm g{S1 + (size_t)LAT0 * DI, WK, DI, DH, DH, DH, (long)DH * DH, LH / 256, DH / 256, NH}; pg8::EpiStore E{S0 + (size_t)LAT0 * DI, DH, DI, 0}; pg8::gemm_phase(lds, g, E, G, bx, tid); if (DUP_MIX) pg8::gemm_phase(lds, g, E, G, bx, tid); }
                    { SmallGemm sg{S1, WK, DI, DH, DH, DH, DH, 0, 0}; SmallDense sd{S0, DH, DI, LAT0 / 64, DH / 64, 0, DH, (long)DH * DH}; gemm_small_dense(lds, sg, sd, NH, G, bx, tid); if (DUP_CTX) gemm_small_dense(lds, sg, sd, NH, G, bx, tid); }
                    { pg8::Gemm g{WK, S1 + (size_t)LAT0 * DI, DH, DI, DH, (long)DH * DH, DH, DH / 256, LH / 256, NH}; pg8::EpiStore E{S4, (long)DH * RH, RH, 0, 2, LAT0}; pg8::gemm_phase(lds, g, E, G, bx, tid); if (DUP_MIX) pg8::gemm_phase(lds, g, E, G, bx, tid); }
                    { SmallGemm sg{WK, S1, DH, DI, DH, DH, DH, 0, 0}; SmallDense sd{S4, (long)DH * RH, RH, DH / 64, LAT0 / 64, 0, (long)DH * DH, DH, 2}; gemm_small_dense(lds, sg, sd, NH, G, bx, tid); if (DUP_CTX) gemm_small_dense(lds, sg, sd, NH, G, bx, tid); }
                    if (bx < 128) {
                        const int sc = bx >> 3, part = bx & 7, bl = sc >> 3, hh = (sc >> 1) & 3, dir = sc & 1;
                        unsigned* g12cnt = (unsigned*)(ws + WS_CTL + 4096) + ((jl * 2 + half) * 16 + sc) * 16;
                        unsigned* g12tot = (unsigned*)(ws + WS_PRE) + (size_t)((jl * 2 + half) * 16 + sc) * 132 * 2;
                        LAS float* bcs = (LAS float*)lds;
                        LAS float* vss = bcs + 132 * 64;
                        LAS float* bl_ = vss + 132 * 64;
                        LAS float* vm_ = bl_ + 132;
                        LAS float* mi_ = vm_ + 132;
                        const int u = lane, p = dir ? 63 - u : u;
                        const float* bgp = ka->in[I_BGATE] + (size_t)jl * 16 + 8 * dir + hh;
#pragma unroll
                        for (int ii = 0; ii < 3; ++ii) { const int i = part + 8 * ii; const int j = wave + 8 * i;
                            if (i < 17 && j < 132) { int row0; if (j < 4) { const int c = dir ? 3 - j : j; row0 = bl * CT + c * 64; } else { const int c = dir ? 127 - (j - 4) : (j - 4); row0 = LAT0 + bl * T + c * 64; }
                                const float* pr = PREQ + (size_t)(row0 + p) * 16 + 8 * dir + hh; const size_t qs = (size_t)RH * 16;
                                bcs[j * 64 + p] = (pr[4] + pr[qs + 4]) + (pr[2 * qs + 4] + pr[3 * qs + 4]) + bgp[4]; vss[j * 64 + p] = (pr[0] + pr[qs]) + (pr[2 * qs] + pr[3 * qs]) + bgp[0]; } }
                        asm volatile("s_waitcnt vmcnt(0) lgkmcnt(0)" ::: "memory");
#pragma unroll 1
                        for (int ii = 0; ii < 3; ++ii) { const int i = part + 8 * ii; const int j = wave + 8 * i;
                            if (i < 17 && j < 132) { const float f = bcs[j * 64 + p], lia = vss[j * 64 + p]; float x = fminf(f, 0.f) - log1pf(__expf(-fabsf(f)));
                                x = scan_add64(x);
                                const float v = lia - x; float pm = v;
                                pm = scan_max64(pm);
                                bcs[j * 64 + p] = x; vss[j * 64 + p] = v;
                                if (u == 63) { __hip_atomic_store(g12tot + 2 * j, __builtin_bit_cast(unsigned, x), __ATOMIC_RELAXED, __HIP_MEMORY_SCOPE_AGENT); __hip_atomic_store(g12tot + 2 * j + 1, __builtin_bit_cast(unsigned, pm), __ATOMIC_RELAXED, __HIP_MEMORY_SCOPE_AGENT); } } }
                        asm volatile("s_waitcnt vmcnt(0)" ::: "memory");
                        __syncthreads();
                        if (tid == 0) { (void)xb_add(g12cnt, 1u); unsigned sp_ = 0u; while (xb_ld(g12cnt) < 8u && ++sp_ < XB_SPIN_CAP) __builtin_amdgcn_s_sleep(1); }
                        __syncthreads();
                        if (tid < 132) { bl_[tid] = __builtin_bit_cast(float, xb_ld(g12tot + 2 * tid)); vm_[tid] = __builtin_bit_cast(float, xb_ld(g12tot + 2 * tid + 1)); }
                        __syncthreads();
                        if (wave == 0) {
                            const float ni = -__builtin_inff();
                            float ea[3], eb[3];
#pragma unroll
                            for (int t = 0; t < 3; ++t) { const int j = 3 * lane + t; const bool ok = j < 132; const float blj = bl_[ok ? j : 0], vmj = vm_[ok ? j : 0]; ea[t] = ok ? blj : 0.f; eb[t] = ok ? blj + vmj : ni; }
                            float A = ea[0] + ea[1], B = fmaxf(eb[0] + ea[1], eb[1]); B = fmaxf(B + ea[2], eb[2]); A += ea[2];
#define G12_STEP(CTRL, RM) do { const float pa_ = dppf<CTRL, RM>(0.f, A), pb_ = dppf<CTRL, RM>(ni, B); B = fmaxf(pb_ + A, B); A += pa_; } while (0)
                            G12_STEP(0x111, 0xF); G12_STEP(0x112, 0xF); G12_STEP(0x114, 0xF); G12_STEP(0x118, 0xF); G12_STEP(0x142, 0xA); G12_STEP(0x143, 0xC);
#undef G12_STEP
                            float EA = shup(A, 1, lane), EB = shup(B, 1, lane); if (lane == 0) { EA = 0.f; EB = ni; }
                            float m = fmaxf(EA, EB);
#pragma unroll
                            for (int t = 0; t < 3; ++t) { const int j = 3 * lane + t; if (j < 132) { mi_[j] = m; m = fmaxf(m + ea[t], eb[t]); } }
                        }
                        __syncthreads();
                        float* GPw = (float*)(YH + (size_t)NCH * 4 * 2 * 4096);
#pragma unroll 1
                        for (int ii = 0; ii < 3; ++ii) { const int i = part + 8 * ii; const int j = wave + 8 * i;
                            if (i < 17 && j < 132) { int row0; if (j < 4) { const int c = dir ? 3 - j : j; row0 = bl * CT + c * 64; } else { const int c = dir ? 127 - (j - 4) : (j - 4); row0 = LAT0 + bl * T + c * 64; }
                                const float bc = bcs[j * 64 + p], v = vss[j * 64 + p]; float pm = v;
                                pm = scan_max64(pm);
                                const float m_in = mi_[j], btot = bl_[j], m_new = btot + fmaxf(m_in, vm_[j]);
                                const float uu = -fmaxf(m_in, pm);
                                float* gp = GPw + ((size_t)((row0 >> 6) * 4 + hh) * 2 + dir) * 384;
                                gp[p] = uu; gp[64 + p] = v; gp[128 + p] = __expf(m_in + uu); gp[192 + p] = __expf(uu - bc); ((bf16_t*)(gp + 324))[p] = (bf16_t)f2bf(__expf(btot - m_new + v));
                                if (u == 0) gp[320] = __expf(btot + m_in - m_new); } }
                    }
 }
                    SEAM(hb + 3);
                }
                if (IN(hb + 4)) { PH_BEGIN();
 for (int rp_ = 0; rp_ < REPN(4); ++rp_) {
                    SmallGemm sg{S3, S0, DI, DI, DH, DH, DH, 0, 0, 1};
                    bf16_t* SGw = YH; const float* GPr = (const float*)(YH + (size_t)NCH * 4 * 2 * 4096);
                    auto dec = [=](int u, long& ao, long& bo) { const int ch = u >> 2, hh = u & 3; ao = u; bo = (long)ch * 64 * DI + hh * DH; };
                    auto epi = [=](int u, int m, int n, const f32x4& v) {
#pragma unroll
                        for (int dir = 0; dir < 2; ++dir) { const float* gp = GPr + ((size_t)u * 2 + dir) * 384; const float up = gp[m]; const f32x4 vs = *(const f32x4*)(gp + 64 + n); float o[4];
#pragma unroll
                            for (int i = 0; i < 4; ++i) { const int s = n + i; const bool ok = dir ? (s >= m) : (s <= m); const float gte = ok ? __expf(up + vs[i]) : 0.f; o[i] = v[i] * gte; }
                            u32x2 w; w.x = pk2(o[0], o[1]); w.y = pk2(o[2], o[3]);
                            *(u32x2*)(SGw + ((size_t)u * 2 + dir) * 4096 + ((m >> 4) * 2 + (n >> 5)) * 512 + (((n >> 3) & 3) * 16 + (m & 15)) * 8 + (n & 7)) = w; } };
                    gemm_small(lds, sg, NCH * 4, dec, epi, G, bx, tid);
 }
                    SEAM(hb + 4);
                }
                if (EN_SCAN && IN(hb + 5)) { PH_BEGIN();
                    scan_phase(lds, ws, half, bar, tid, lane, wave, bx);
                    SEAM(hb + 5);
                }
                if (IN(hb + 6)) { PH_BEGIN();
 for (int rp_ = 0; rp_ < REPN(0); ++rp_) {
                    pg8::Gemm g{HH, WIN + (size_t)DI * D, D, D, D, 0, 0, LH / 256, DI / 256, 1};
                    pg8::EpiStore E{S3 + (size_t)LAT0 * DI, 0, DI, 0};
                    pg8::gemm_phase(lds, g, E, G, bx, tid); if (DUP_MIX) pg8::gemm_phase(lds, g, E, G, bx, tid);
                    if (layer < 2) { SmallGemm sg{HHC, WIN + (size_t)DI * D, D, D, D, D, D, 0, 0}; SmallDense sd{S3, 0, DI, LAT0 / 64, DI / 64, 0, 0, 0}; gemm_small_dense(lds, sg, sd, 1, G, bx, tid); if (DUP_CTX) gemm_small_dense(lds, sg, sd, 1, G, bx, tid); }
 }
                    SEAM(hb + 6);
                }
                if (IN(hb + 7)) { PH_BEGIN();
 for (int rp_ = 0; rp_ < REPN(3); ++rp_) {
                    const float* gn = ka->in[I_GNW] + (size_t)jl * DI; const float* sk = ka->in[I_SKIP] + (size_t)jl * DI;
#define RO_LOAD(q_, A, B, XC, ZZ) do { const bf16_t* h2_ = ((q_) < LAT0) ? HCB : S2; \
                        _Pragma("unroll") for (int hd = 0; hd < 4; ++hd) { const size_t ho_ = htile_off(q_, hd, 8 * lane); const size_t ro_ = (size_t)(q_) * DI + hd * DH + 8 * lane; \
                            A[hd] = *(const u32x4*)(S0 + ho_); B[hd] = *(const u32x4*)(h2_ + ho_); XC[hd] = *(const u32x4*)(S1 + ro_); ZZ[hd] = *(const u32x4*)(S3 + ro_); } } while (0)
                    u32x4 ra[4], rb[4], rx[4], rz[4], na[4], nb[4], nx[4], nz[4];
#pragma unroll
                    for (int hd = 0; hd < 4; ++hd) { ra[hd] = (u32x4){0u, 0u, 0u, 0u}; rb[hd] = ra[hd]; rx[hd] = ra[hd]; rz[hd] = ra[hd]; na[hd] = ra[hd]; nb[hd] = ra[hd]; nx[hd] = ra[hd]; nz[hd] = ra[hd]; }
                    const int q_first = (layer < 2 ? 0 : LAT0) + gw;
                    if (q_first < RH) RO_LOAD(q_first, ra, rb, rx, rz);
                    for (int q = q_first; q < RH; q += NGW) {
                        if (q + NGW < RH) RO_LOAD(q + NGW, na, nb, nx, nz);
#pragma unroll
                        for (int hd = 0; hd < 4; ++hd) {
                            const int c0 = hd * DH + 8 * lane;
                            const u32x4 a = ra[hd], b = rb[hd];
                            float v[8] = {bflo(a.x) + bflo(b.x), bfhi(a.x) + bfhi(b.x), bflo(a.y) + bflo(b.y), bfhi(a.y) + bfhi(b.y), bflo(a.z) + bflo(b.z), bfhi(a.z) + bfhi(b.z), bflo(a.w) + bflo(b.w), bfhi(a.w) + bfhi(b.w)};
                            float s = 0.f;
#pragma unroll
                            for (int i = 0; i < 8; ++i) s += v[i];
                            const float mean = wave_sum(s, lane) * (1.f / DH); float s2 = 0.f;
#pragma unroll
                            for (int i = 0; i < 8; ++i) { v[i] -= mean; s2 += v[i] * v[i]; }
                            const float rstd = __builtin_amdgcn_rsqf(wave_sum(s2, lane) * (1.f / DH) + LN_EPS);
                            const u32x4 xc = rx[hd], zz = rz[hd];
                            const float xcf[8] = {bflo(xc.x), bfhi(xc.x), bflo(xc.y), bfhi(xc.y), bflo(xc.z), bfhi(xc.z), bflo(xc.w), bfhi(xc.w)};
                            const float zf[8] = {bflo(zz.x), bfhi(zz.x), bflo(zz.y), bfhi(zz.y), bflo(zz.z), bfhi(zz.z), bflo(zz.w), bfhi(zz.w)};
                            float o[8];
#pragma unroll
                            for (int i = 0; i < 8; ++i) o[i] = (v[i] * rstd * gn[c0 + i] + sk[c0 + i] * xcf[i]) * siluf(zf[i]);
                            u32x4 w; w.x = pk2(o[0], o[1]); w.y = pk2(o[2], o[3]); w.z = pk2(o[4], o[5]); w.w = pk2(o[6], o[7]);
                            *(u32x4*)(S4 + (size_t)q * DI + c0) = w;
                        }
#pragma unroll
                        for (int hd = 0; hd < 4; ++hd) { ra[hd] = na[hd]; rb[hd] = nb[hd]; rx[hd] = nx[hd]; rz[hd] = nz[hd]; }
                    }
#undef RO_LOAD
 }
                    SEAM(hb + 7);
                }
                if (IN(hb + 8)) { PH_BEGIN();
 for (int rp_ = 0; rp_ < REPN(0); ++rp_) {
                    pg8::Gemm g{S4 + (size_t)LAT0 * DI, WOUT, DI, DI, DI, 0, 0, LH / 256, D / 256, 1};
                    pg8::EpiStore E{YH, 0, D, 0};
                    pg8::gemm_phase(lds, g, E, G, bx, tid); if (DUP_MIX) pg8::gemm_phase(lds, g, E, G, bx, tid);
                    if (layer < 2) { SmallGemm sg{S4, WOUT, DI, DI, DI, DI, DI, 0, 0}; SmallDense sd{YHC, 0, D, LAT0 / 64, D / 64, 0, 0, 0}; gemm_small_dense(lds, sg, sd, 1, G, bx, tid); if (DUP_CTX) gemm_small_dense(lds, sg, sd, 1, G, bx, tid); }
 }
                    SEAM(hb + 8);
                }
            }
        } else if (EN_FOUR) {
            const bool has_ctx = layer < 3;
            if (IN(pb + 2)) { PH_BEGIN();
 for (int rp_ = 0; rp_ < REPN(2); ++rp_) {
                { pg8::Gemm g{(const bf16_t*)(ws + TAB_A1), HT, 256, 256, 256, 0, (long)D * T, 2, 128, NB};
                  pg8::EpiStore E{PB, (long)512 * 32768, 32768, 0};
                  pg8::gemm_phase(lds, g, E, G, bx, tid); if (DUP_MIX) pg8::gemm_phase(lds, g, E, G, bx, tid); }
                if (has_ctx) {
                    SmallGemm sg{(const bf16_t*)(ws + TAB_ACTX), HTC, 256, 256, 256, 256, 256, 0, 0};
                    auto dec = [=](int u, long& ao, long& bo) { const int b = u / 128, mb = (u / 16) % 8, cht = u % 16; ao = (long)mb * 64 * 256; bo = ((long)b * D + cht * 64) * CT; };
                    auto epi = [=](int u, int m, int n, const f32x4& v) { const int b = u / 128, mb = (u / 16) % 8, cht = u % 16; const int mg = mb * 64 + m, ri = mg >> 8, tp = mg & 255, ch = cht * 64 + n;
                        u32x2 w; w.x = pk2(v[0], v[1]); w.y = pk2(v[2], v[3]); *(u32x2*)(WC + (size_t)ctx_row(b, tp) * DI + (ch >> 8) * 512 + ri * 256 + (ch & 255)) = w; };
                    gemm_small(lds, sg, NB * 8 * 16, dec, epi, G, bx, tid);
                }
 }
                SEAM(pb + 2);
            }
            if (IN(pb + 3)) { PH_BEGIN();
 for (int rp_ = 0; rp_ < REPN(2); ++rp_) {
                {
                    const int wid = tid >> 6, wm = wid >> 1, wn = wid & 1, fr = lane & 15, fq = lane >> 4;
                    const int lrow = tid >> 3, lk = (tid & 7) * 8;
                    const unsigned stoff = (unsigned)(lrow * SG_LD + lk) * 2u;
                    LAS unsigned char* As = lds; LAS unsigned char* Bs0 = lds + SG_TILE; LAS unsigned char* Bs1 = lds + 2 * SG_TILE;
                    const bf16_t* A2 = (const bf16_t*)(ws + TAB_A2);
                    for (int pair = bx; pair < NB * 256; pair += G) {
                        const int b = pair >> 8, t1p = pair & 255;
                        const bf16_t* bp = PB + (size_t)b * 512 * 32768 + (size_t)((lk >> 5) * 256 + t1p) * 32768 + (size_t)lrow * 32 + (lk & 31);
                        u32x4 r0 = *(const u32x4*)(bp), r1 = *(const u32x4*)(bp + 2048), r2 = *(const u32x4*)(bp + 2 * 2048), r3 = *(const u32x4*)(bp + 3 * 2048);
                        *(LAS u32x4*)(As + stoff) = *(const u32x4*)(A2 + (size_t)t1p * 4096 + lrow * 64 + lk);
                        *(LAS u32x4*)(Bs0 + stoff) = r0;
                        LDS_BARRIER();
                        bf16x8 af[2];
#pragma unroll
                        for (int ks = 0; ks < 2; ++ks) af[ks] = *(const LAS bf16x8*)(As + ((wm * 16 + fr) * SG_LD + ks * 32 + fq * 8) * 2);
#define F2_TILE(ct_, BsC, BsN, rcur, rnext) do { \
                            if ((ct_) + 4 < 16) rcur = *(const u32x4*)(bp + ((ct_) + 4) * 2048); \
                            f32x4 acc[2] = {(f32x4){0.f, 0.f, 0.f, 0.f}, (f32x4){0.f, 0.f, 0.f, 0.f}}; \
                            _Pragma("unroll") for (int ks = 0; ks < 2; ++ks) _Pragma("unroll") for (int nt = 0; nt < 2; ++nt) { \
                                const bf16x8 bf = *(const LAS bf16x8*)(BsC + ((wn * 32 + nt * 16 + fr) * SG_LD + ks * 32 + fq * 8) * 2); \
                                acc[nt] = __builtin_amdgcn_mfma_f32_16x16x32_bf16(bf, af[ks], acc[nt], 0, 0, 0); } \
                            if ((ct_) + 1 < 16) *(LAS u32x4*)(BsN + stoff) = rnext; \
                            _Pragma("unroll") for (int nt = 0; nt < 2; ++nt) { const int m = wm * 16 + fr, n = wn * 32 + nt * 16 + fq * 4, rip = m >> 5, t2p = m & 31, ch = (ct_) * 64 + n; \
                                u32x2 w2; w2.x = pk2(acc[nt][0], acc[nt][1]); w2.y = pk2(acc[nt][2], acc[nt][3]); \
                                *(u32x2*)(WC + (size_t)lat_row(b, t1p + 256 * t2p) * DI + (ch >> 8) * 512 + rip * 256 + (ch & 255)) = w2; } \
                            LDS_BARRIER(); } while (0)
#pragma unroll 1
                        for (int ct = 0; ct < 16; ct += 4) { F2_TILE(ct, Bs0, Bs1, r0, r1); F2_TILE(ct + 1, Bs1, Bs0, r1, r2); F2_TILE(ct + 2, Bs0, Bs1, r2, r3); F2_TILE(ct + 3, Bs1, Bs0, r3, r0); }
#undef F2_TILE
                    }
                }
 }
                SEAM(pb + 3);
            }
            if (IN(pb + 4)) { PH_BEGIN();
 for (int rp_ = 0; rp_ < REPN(2); ++rp_) {
                pg8::Gemm g{WC + (size_t)CR * DI, (const bf16_t*)(ws + TAB_BZ), DI, 512, 512, 512, 0, (R - CR) / 256, 1, 4};
                pg8::EpiStore E{ZF + (size_t)CR * D, 256, D, 0};
                pg8::gemm_phase(lds, g, E, G, bx, tid); if (DUP_MIX) pg8::gemm_phase(lds, g, E, G, bx, tid);
                if (has_ctx) { SmallGemm sg{WC, (const bf16_t*)(ws + TAB_BZ), DI, 512, 512, 512, 512, 0, 0}; SmallDense sd{ZF, 256, D, CR / 64, 256 / 64, 0, 512, 0}; gemm_small_dense(lds, sg, sd, 4, G, bx, tid); if (DUP_CTX) gemm_small_dense(lds, sg, sd, 4, G, bx, tid); }
 }
                SEAM(pb + 4);
            }
            if (IN(pb + 5)) { PH_BEGIN();
 for (int rp_ = 0; rp_ < REPN(2); ++rp_) {
                pg8::Gemm g{ZF + (size_t)CR * D, WOUT, D, D, D, 0, 0, (R - CR) / 256, D / 256, 1};
                pg8::EpiStore E{YB + (size_t)CR * D, 0, D, 0};
                pg8::gemm_phase(lds, g, E, G, bx, tid); if (DUP_MIX) pg8::gemm_phase(lds, g, E, G, bx, tid);
                if (has_ctx) { SmallGemm sg{ZF, WOUT, D, D, D, D, D, 0, 0}; SmallDense sd{YB, 0, D, CR / 64, D / 64, 0, 0, 0}; gemm_small_dense(lds, sg, sd, 1, G, bx, tid); if (DUP_CTX) gemm_small_dense(lds, sg, sd, 1, G, bx, tid); }
 }
                SEAM(pb + 5);
            }
        }
#pragma unroll 1
        for (int which = 0; which < 2; ++which) {
            const int pid = pb + (which == 0 ? 19 : 22);
            if (EN_NORM && IN(pid)) { PH_BEGIN();
                const float* pg = ka->in[I_PG] + ((size_t)layer * 2 + which) * D; const float* pbv = ka->in[I_PB] + ((size_t)layer * 2 + which) * D;
                const int mlayer = which == 0 ? layer : layer + 1;
                const int shoff = which == 0 ? 3 * D : 0;
                const int goff = which == 0 ? 2 * D : 5 * D;
                const bool in_f32 = (layer == 0 && which == 0), out_f32 = (layer == 3 && which == 1);
                bf16_t* xbl = (bf16_t*)ka->out; bf16_t* xb3 = S4;
#define NR_LOAD(r_, XW, YW) do { const RowInfo ri_ = row_info(r_); const size_t xi_ = ri_.is_ctx ? ((size_t)ri_.b * CT + ri_.t) * D : ((size_t)ri_.b * T + ri_.t) * D; \
                    const bf16_t* yr_ = YB + (size_t)(r_) * D; \
                    if (in_f32) { const float* xp_ = (ri_.is_ctx ? ka->in[I_CTX] : ka->in[I_X]) + xi_; _Pragma("unroll") for (int j = 0; j < 4; ++j) XW[j] = *(const u32x4*)(xp_ + 256 * j + 4 * lane); } \
                    else { const bf16_t* xp_ = ri_.is_ctx ? (const bf16_t*)CTXX + xi_ : ((layer == 3 && which == 1) ? xb3 + xi_ : xbl + xi_); \
                        _Pragma("unroll") for (int j = 0; j < 4; ++j) { const u32x2 t_ = *(const u32x2*)(xp_ + 256 * j + 4 * lane); XW[j] = (u32x4){t_.x, t_.y, 0u, 0u}; } } \
                    _Pragma("unroll") for (int j = 0; j < 4; ++j) YW[j] = *(const u32x2*)(yr_ + 256 * j + 4 * lane); } while (0)
                if (which == 1 && (layer & 1) == 0) {
                    constexpr int TLD = 1026;
                    LAS bf16_t* TL = (LAS bf16_t*)lds;
                    const float* md2b = MOD + ((size_t)mlayer * 5) * 6 * D + shoff;
#define NT_ROW(r_, i_) do { const RowInfo ri = row_info(r_); const int mi = ri.is_ctx ? 4 : ri.b; \
                        const size_t xi = ri.is_ctx ? ((size_t)ri.b * CT + ri.t) * D : ((size_t)ri.b * T + ri.t) * D; \
                        bf16_t* xout16 = ri.is_ctx ? (bf16_t*)CTXX + xi : xbl + xi; \
                        const float* md = MOD + ((size_t)layer * 5 + mi) * 6 * D; f32x4 v[4]; \
                        _Pragma("unroll") for (int j = 0; j < 4; ++j) { const int c = 256 * j + 4 * lane; const f32x4 x = (f32x4){bflo(xw[j].x), bfhi(xw[j].x), bflo(xw[j].y), bfhi(xw[j].y)}; \
                            const f32x4 gt = *(const f32x4*)(md + goff + c); const f32x4 y = (f32x4){bflo(yw[j].x), bfhi(yw[j].x), bflo(yw[j].y), bfhi(yw[j].y)}; v[j] = x * ALPHA + gt * y; } \
                        ln_norm(v, lane); \
                        _Pragma("unroll") for (int j = 0; j < 4; ++j) { const int c = 256 * j + 4 * lane; v[j] = v[j] * *(const f32x4*)(pg + c) + *(const f32x4*)(pbv + c); \
                            u32x2 xo; xo.x = pk2(v[j][0], v[j][1]); xo.y = pk2(v[j][2], v[j][3]); *(u32x2*)(xout16 + c) = xo; } \
                        ln_norm(v, lane); \
                        const float* md2 = md2b + (size_t)mi * 6 * D; \
                        _Pragma("unroll") for (int j = 0; j < 4; ++j) { const int c = 256 * j + 4 * lane; const f32x4 sh = *(const f32x4*)(md2 + c), sc = *(const f32x4*)(md2 + D + c); \
                            const f32x4 h = v[j] * (1.0f + sc) + sh; LAS unsigned* d_ = (LAS unsigned*)(TL + (i_) * TLD + c); d_[0] = pk2(h[0], h[1]); d_[1] = pk2(h[2], h[3]); } } while (0)
                    u32x4 xw[4], xn[4]; u32x2 yw[4], yn[4];
#pragma unroll
                    for (int j = 0; j < 4; ++j) { xw[j] = (u32x4){0u, 0u, 0u, 0u}; xn[j] = xw[j]; yw[j] = (u32x2){0u, 0u}; yn[j] = yw[j]; }
                    for (int item = bx; item < NB * 32 * 4; item += G) {
                        const int b = item >> 7, t2 = (item >> 2) & 31, tb = item & 3;
                        const int rbase = lat_row(b, 32 * (64 * tb + wave * 8) + t2);
                        NR_LOAD(rbase, xw, yw);
#pragma unroll 1
                        for (int j8 = 0; j8 < 8; ++j8) {
                            if (j8 < 7) NR_LOAD(rbase + 32 * (j8 + 1), xn, yn);
                            NT_ROW(rbase + 32 * j8, wave * 8 + j8);
#pragma unroll
                            for (int j = 0; j < 4; ++j) { xw[j] = xn[j]; yw[j] = yn[j]; }
                        }
                        LDS_BARRIER();
#pragma unroll 4
                        for (int k = 0; k < 16; ++k) { const int idx = k * NTHR + tid, g8 = idx & 7, ch = idx >> 3; const LAS bf16_t* s = TL + (8 * g8) * TLD + ch;
                            u32x4 o; o.x = (unsigned)s[0] | ((unsigned)s[TLD] << 16); o.y = (unsigned)s[2 * TLD] | ((unsigned)s[3 * TLD] << 16); o.z = (unsigned)s[4 * TLD] | ((unsigned)s[5 * TLD] << 16); o.w = (unsigned)s[6 * TLD] | ((unsigned)s[7 * TLD] << 16);
                            *(u32x4*)(HT + (((size_t)b * D + ch) * 32 + t2) * 256 + 64 * tb + 8 * g8) = o; }
                        LDS_BARRIER();
                    }
                    if (layer < 2) {
                        for (int item = bx; item < NB * (CT / 8); item += G) {
                            const int b = item / (CT / 8), t8 = item % (CT / 8);
                            const int r = ctx_row(b, 8 * t8 + wave);
                            NR_LOAD(r, xw, yw);
                            NT_ROW(r, wave);
                            LDS_BARRIER();
#pragma unroll
                            for (int k = 0; k < 2; ++k) { const int ch = k * NTHR + tid; const LAS bf16_t* s = TL + ch;
                                u32x4 o; o.x = (unsigned)s[0] | ((unsigned)s[TLD] << 16); o.y = (unsigned)s[2 * TLD] | ((unsigned)s[3 * TLD] << 16); o.z = (unsigned)s[4 * TLD] | ((unsigned)s[5 * TLD] << 16); o.w = (unsigned)s[6 * TLD] | ((unsigned)s[7 * TLD] << 16);
                                *(u32x4*)(HTC + ((size_t)b * D + ch) * CT + 8 * t8) = o; }
                            LDS_BARRIER();
                        }
                    }
#undef NT_ROW
                } else {
                const int r_first = (layer < 2 ? 0 : CR) + gw;
                u32x4 xw[4], xn[4]; u32x2 yw[4], yn[4];
#pragma unroll
                for (int j = 0; j < 4; ++j) { xw[j] = (u32x4){0u, 0u, 0u, 0u}; xn[j] = xw[j]; yw[j] = (u32x2){0u, 0u}; yn[j] = yw[j]; }
                if (r_first < R) NR_LOAD(r_first, xw, yw);
                for (int r = r_first; r < R; r += NGW) {
                    if (r + NGW < R) NR_LOAD(r + NGW, xn, yn);
                    const RowInfo ri = row_info(r);
                    const int mi = ri.is_ctx ? 4 : ri.b;
                    const size_t xi = ri.is_ctx ? ((size_t)ri.b * CT + ri.t) * D : ((size_t)ri.b * T + ri.t) * D;
                    bf16_t* xout16 = ri.is_ctx ? (bf16_t*)CTXX + xi : ((layer == 3 && which == 0) ? xb3 + xi : xbl + xi);
                    const float* md = MOD + ((size_t)layer * 5 + mi) * 6 * D;
                    f32x4 v[4];
#pragma unroll
                    for (int j = 0; j < 4; ++j) { const int c = 256 * j + 4 * lane; f32x4 x; if (in_f32) x = __builtin_bit_cast(f32x4, xw[j]); else x = (f32x4){bflo(xw[j].x), bfhi(xw[j].x), bflo(xw[j].y), bfhi(xw[j].y)};
                        const f32x4 gt = *(const f32x4*)(md + goff + c);
                        const f32x4 y = (f32x4){bflo(yw[j].x), bfhi(yw[j].x), bflo(yw[j].y), bfhi(yw[j].y)}; v[j] = x * ALPHA + gt * y; }
                    ln_norm(v, lane);
#pragma unroll
                    for (int j = 0; j < 4; ++j) { const int c = 256 * j + 4 * lane; v[j] = v[j] * *(const f32x4*)(pg + c) + *(const f32x4*)(pbv + c);
                        if (out_f32) *(f32x4*)(ka->out + xi + c) = v[j]; else { u32x2 xo; xo.x = pk2(v[j][0], v[j][1]); xo.y = pk2(v[j][2], v[j][3]); *(u32x2*)(xout16 + c) = xo; } }
                    if (mlayer < 4) {
                        const float* md2 = MOD + ((size_t)mlayer * 5 + mi) * 6 * D + shoff;
                        ln_norm(v, lane);
                        bf16_t* o = HIN + (size_t)r * D;
#pragma unroll
                        for (int j = 0; j < 4; ++j) { const int c = 256 * j + 4 * lane; const f32x4 sh = *(const f32x4*)(md2 + c), sc = *(const f32x4*)(md2 + D + c);
                            const f32x4 h = v[j] * (1.0f + sc) + sh; u32x2 w; w.x = pk2(h[0], h[1]); w.y = pk2(h[2], h[3]); *(u32x2*)(o + c) = w; }
                    }
#pragma unroll
                    for (int j = 0; j < 4; ++j) { xw[j] = xn[j]; yw[j] = yn[j]; }
                }
                }
#undef NR_LOAD
                SEAM(pid);
            }
            if (EN_MLP && which == 0) {
                if (IN(pb + 20)) { PH_BEGIN();
 for (int rp_ = 0; rp_ < REPN(1); ++rp_) {
                    pg8::Gemm g{HIN + (size_t)CR * D, W1, D, D, D, 0, 0, (R - CR) / 256, DFF / 256, 1};
                    pg8::EpiStore E{HID + (size_t)CR * DFF, 0, DFF, 1};
                    pg8::gemm_phase(lds, g, E, G, bx, tid);
#if DUP_MLP
                    pg8::gemm_phase(lds, g, E, G, bx, tid);
#endif
                    if (layer < 2) { SmallGemm sg{HIN, W1, D, D, D, D, D, 0, 0}; SmallDense sd{HID, 0, DFF, CR / 64, DFF / 64, 1, 0, 0}; gemm_small_dense(lds, sg, sd, 1, G, bx, tid); }
 }
                    SEAM(pb + 20);
                }
                if (IN(pb + 21)) { PH_BEGIN();
 for (int rp_ = 0; rp_ < REPN(1); ++rp_) {
                    pg8::Gemm g{HID + (size_t)CR * DFF, W2, DFF, DFF, DFF, 0, 0, (R - CR) / 256, D / 256, 1};
                    pg8::EpiStore E{YB + (size_t)CR * D, 0, D, 0};
                    pg8::gemm_phase(lds, g, E, G, bx, tid);
#if DUP_MLP
                    pg8::gemm_phase(lds, g, E, G, bx, tid);
#endif
                    if (layer < 2) { SmallGemm sg{HID, W2, DFF, DFF, DFF, DFF, DFF, 0, 0}; SmallDense sd{YB, 0, D, CR / 64, D / 64, 0, 0, 0}; gemm_small_dense(lds, sg, sd, 1, G, bx, tid); }
 }
                    SEAM(pb + 21);
                }
            }
        }
    }
#undef IN
#undef SEAM
}

extern "C" void kernel_launch(void* const* d_in, const int* in_sizes, int n_in, void* d_out, int out_size, void* d_ws, size_t ws_size, hipStream_t stream) {
    static int grid = 0;
    if (grid == 0) {
        if (n_in != 22 || ws_size < 512 * MiB) { fprintf(stderr, "kernel_launch: unexpected n_in %d / ws_size %zu\n", n_in, ws_size); grid = -1; return; }
        int dev = 0, cus = 0;
        if (hipGetDevice(&dev) != hipSuccess || hipDeviceGetAttribute(&cus, hipDeviceAttributeMultiprocessorCount, dev) != hipSuccess) { grid = -1; return; }
        if (hipFuncSetAttribute((const void*)fwd, hipFuncAttributeMaxDynamicSharedMemorySize, LDS_BYTES) != hipSuccess) { fprintf(stderr, "kernel_launch: hipFuncSetAttribute failed\n"); grid = -1; return; }
        int per_cu = 0;
        if (hipOccupancyMaxActiveBlocksPerMultiprocessor(&per_cu, (const void*)fwd, NTHR, LDS_BYTES) != hipSuccess || per_cu < 1) fprintf(stderr, "kernel_launch: occupancy query says %d\n", per_cu);
        (void)hipGetLastError();
        grid = cus;
        if (grid != 256) fprintf(stderr, "kernel_launch: %d CUs (built for 256)\n", grid);
    }
    if (grid < 0) return;
    (void)hipMemsetAsync((char*)d_ws + WS_CTL, 0, CTL_BYTES, stream);
    Args a{};
    for (int i = 0; i < 22; ++i) a.in[i] = (const float*)d_in[i];
    a.out = (float*)d_out; a.ws = (unsigned char*)d_ws;
#if MK_SINGLE
    { int last = 0; for (int id = 0; id < NPHASE; ++id) if (phase_valid(id)) last = id;
      a.ph_lo = 0; a.ph_hi = NPHASE; a.ph_last = last; a.li = 0;
      hipLaunchKernelGGL(fwd, dim3(grid), dim3(NTHR), LDS_BYTES, stream, a); }
#else
    { int li = 0;
      for (int id = 0; id < NPHASE; ++id) { if (!phase_valid(id)) continue;
          a.ph_lo = id; a.ph_hi = id + 1; a.ph_last = id; a.li = li++;
          hipLaunchKernelGGL(fwd, dim3(grid), dim3(NTHR), LDS_BYTES, stream, a); } }
#endif
}
```

```cpp
#include <hip/hip_runtime.h>
#include <cstdio>
#include <cstdint>

#define LAS __attribute__((address_space(3)))
typedef unsigned short bf16_t;
typedef short bf16x8 __attribute__((ext_vector_type(8)));
typedef float f32x4 __attribute__((ext_vector_type(4)));
typedef unsigned u32x4 __attribute__((ext_vector_type(4)));
typedef unsigned u32x2 __attribute__((ext_vector_type(2)));


#ifndef EN_PRO
#define EN_PRO 1
#endif
#ifndef EN_WC
#define EN_WC 1
#endif
#ifndef EN_MIX
#define EN_MIX 1
#endif
#ifndef EN_SCAN
#define EN_SCAN 1
#endif
#ifndef EN_FOUR
#define EN_FOUR 1
#endif
#ifndef EN_NORM
#define EN_NORM 1
#endif
#ifndef EN_MLP
#define EN_MLP 1
#endif
#ifndef DUP_MIX
#define DUP_MIX 0
#endif
#ifndef DUP_CTX
#define DUP_CTX 0
#endif
#ifndef DUP_BAR
#define DUP_BAR 0
#endif
#ifndef DUP_MLP
#define DUP_MLP 0
#endif
#ifndef REP_MASK
#define REP_MASK 0
#endif
#define REPN(bit) (((REP_MASK) >> (bit)) & 1 ? 2 : 1)
#ifndef SC_QPAD
#define SC_QPAD 64
#endif
#ifndef SC_ABL
#define SC_ABL 0
#endif
#ifndef SCAN_REP
#define SCAN_REP 1
#endif
#ifndef MK_SINGLE
#define MK_SINGLE 1
#endif

constexpr int D = 1024, NB = 4, T = 8192, CT = 256, DI = 2048, NH = 4, DH = 512, DFF = 4096;
constexpr int R = NB * (T + CT);
constexpr int RH = R / 2;
constexpr int LAT0 = 2 * CT;
constexpr int NCH = RH / 64;
constexpr float ALPHA = 1.6817928305074290f;
constexpr float LN_EPS = 1e-5f;
constexpr int NWAVES = 8, NTHR = 512;

constexpr size_t MiB = 1u << 20;
constexpr size_t WS_CTL = 0, CTL_BYTES = 2 * MiB;
constexpr size_t WS_MOD = 2 * MiB;
constexpr size_t WS_CTXX = 3 * MiB;
constexpr size_t WS_PRE = 7 * MiB;
constexpr size_t WS_TAB = 10 * MiB;
constexpr size_t TAB_A1 = WS_TAB;
constexpr size_t TAB_A2 = TAB_A1 + 512 * 256 * 2;
constexpr size_t TAB_BZ = TAB_A2 + 256 * 64 * 64 * 2;
constexpr size_t TAB_ACTX = TAB_BZ + 256 * 512 * 2;
constexpr size_t TAB_GATE = TAB_ACTX + 512 * 256 * 2;
static_assert(TAB_GATE + 64 * 4096 * 2 <= 15 * MiB, "tables");
constexpr size_t WS_W = 15 * MiB;
constexpr size_t W_IN = WS_W;
constexpr size_t W_Q = W_IN + 8 * MiB, W_K = W_Q + 2 * MiB, W_V = W_K + 2 * MiB;
constexpr size_t W_OUT = W_V + 2 * MiB;
constexpr size_t W_1 = W_OUT + 4 * MiB;
constexpr size_t W_2 = W_1 + 8 * MiB;
static_assert(W_2 + 8 * MiB <= 49 * MiB, "weights");
constexpr size_t WS_HIN = 49 * MiB;
constexpr size_t WS_YB = 115 * MiB;
constexpr size_t WS_BIG = 181 * MiB;
constexpr size_t SLOT = 66 * MiB;
static_assert(WS_BIG + 5 * SLOT <= 512 * MiB, "workspace");
static_assert((size_t)RH * DI * 2 == SLOT, "slot");

#define LDS_BARRIER() do { asm volatile("s_waitcnt lgkmcnt(0)" ::: "memory"); __builtin_amdgcn_s_barrier(); asm volatile("" ::: "memory"); } while (0)
__device__ __forceinline__ unsigned f2bf(float f) { unsigned u = __builtin_bit_cast(unsigned, f); return (u + 0x7fffu + ((u >> 16) & 1u)) >> 16; }
typedef __bf16 bf16x2_t __attribute__((ext_vector_type(2)));
typedef float f32x2_t __attribute__((ext_vector_type(2)));
__device__ __forceinline__ unsigned pk2(float lo, float hi) { const f32x2_t v = {lo, hi}; return __builtin_bit_cast(unsigned, __builtin_convertvector(v, bf16x2_t)); }
__device__ __forceinline__ float bf2f(unsigned short b) { return __builtin_bit_cast(float, ((unsigned)b) << 16); }
__device__ __forceinline__ float u2f(unsigned u) { return __builtin_bit_cast(float, u); }
__device__ __forceinline__ float bflo(unsigned w) { return __builtin_bit_cast(float, w << 16); }
__device__ __forceinline__ float bfhi(unsigned w) { return __builtin_bit_cast(float, w & 0xffff0000u); }
__device__ __forceinline__ float shx(float v, int mask, int lane) { return __builtin_bit_cast(float, __builtin_amdgcn_ds_bpermute((lane ^ mask) << 2, __builtin_bit_cast(int, v))); }
template <int CTRL, int RMASK> __device__ __forceinline__ float dppf(float idv, float src) { return __builtin_bit_cast(float, __builtin_amdgcn_update_dpp(__builtin_bit_cast(int, idv), __builtin_bit_cast(int, src), CTRL, RMASK, 0xF, false)); }
__device__ __forceinline__ float scan_add64(float x) {
    x += dppf<0x111, 0xF>(0.f, x); x += dppf<0x112, 0xF>(0.f, x); x += dppf<0x114, 0xF>(0.f, x); x += dppf<0x118, 0xF>(0.f, x);
    x += dppf<0x142, 0xA>(0.f, x); x += dppf<0x143, 0xC>(0.f, x); return x; }
__device__ __forceinline__ float scan_max64(float x) {
    const float ni = -__builtin_inff();
    x = fmaxf(x, dppf<0x111, 0xF>(ni, x)); x = fmaxf(x, dppf<0x112, 0xF>(ni, x)); x = fmaxf(x, dppf<0x114, 0xF>(ni, x)); x = fmaxf(x, dppf<0x118, 0xF>(ni, x));
    x = fmaxf(x, dppf<0x142, 0xA>(ni, x)); x = fmaxf(x, dppf<0x143, 0xC>(ni, x)); return x; }
__device__ __forceinline__ float shup(float v, int d, int lane) { return __builtin_bit_cast(float, __builtin_amdgcn_ds_bpermute((lane - d) << 2, __builtin_bit_cast(int, v))); }
__device__ __forceinline__ float wave_sum(float v, int lane) {
    (void)lane;
    return __builtin_bit_cast(float, __builtin_amdgcn_readlane(__builtin_bit_cast(int, scan_add64(v)), 63));
}
__device__ __forceinline__ float siluf(float x) { return x * __builtin_amdgcn_rcpf(1.0f + __expf(-x)); }

struct RowInfo { int is_ctx, b, t; };
__device__ __forceinline__ RowInfo row_info(int r) {
    RowInfo ri;
    if (r < NB * CT) { ri.is_ctx = 1; ri.b = r / CT; ri.t = r % CT; }
    else { ri.is_ctx = 0; const int u = r - NB * CT; ri.b = u / T; ri.t = u % T; }
    return ri;
}
__device__ __forceinline__ int lat_row(int b, int t) { return NB * CT + b * T + t; }
__device__ __forceinline__ int ctx_row(int b, int t) { return b * CT + t; }
constexpr int CR = NB * CT;
constexpr int LH = RH - LAT0;

#define XB_TMO      128
#define XB_XCNT(j)  (256  + 64 * (j))
#define XB_XSUB(j)  (1280 + 64 * (j))
#define XB_XGEN(j)  (2304 + 64 * (j))
#define XB_TOP      3328
#define XB_TOPGEN   3392
#define XCD_BAR_WORDS 3456
#define XB_SPIN_CAP (1u << 18)

__device__ __forceinline__ unsigned xb_ld(unsigned* p)              { return __hip_atomic_load(p, __ATOMIC_RELAXED, __HIP_MEMORY_SCOPE_AGENT); }
__device__ __forceinline__ unsigned xb_add(unsigned* p, unsigned v) { return __hip_atomic_fetch_add(p, v, __ATOMIC_RELAXED, __HIP_MEMORY_SCOPE_AGENT); }
__device__ __forceinline__ unsigned xb_xcc_id() { return (unsigned)__builtin_amdgcn_s_getreg((3 << 11) | 20) & 0xFu; }
#define XB_SPIN(cond, bar) do { unsigned _sp = 0; while (cond) { __builtin_amdgcn_s_sleep(1); \
    if ((++_sp & 255u) == 0u) { if (xb_ld(&(bar)[XB_TMO])) break; if (_sp > XB_SPIN_CAP) { atomicAdd(&(bar)[XB_TMO], 1u); break; } } } } while (0)

struct XcdBarrier { unsigned* bar; unsigned x; volatile LAS unsigned* st; };

__device__ __forceinline__ XcdBarrier xcd_barrier_post(unsigned* bar, volatile LAS unsigned* st) {
    XcdBarrier b; b.bar = bar; b.x = xb_xcc_id(); b.st = st;
    if (threadIdx.x == 0) (void)xb_add(&bar[XB_XCNT(b.x)], 1u);
    return b;
}
__device__ __forceinline__ void xcd_barrier_complete(unsigned* bar, unsigned x, unsigned& nloc, unsigned& nx) {
    const unsigned G = gridDim.x * gridDim.y * gridDim.z;
    unsigned sum, cnt, mine, sp = 0u;
    for (;;) {
        sum = 0u; cnt = 0u; mine = 0u;
#pragma unroll
        for (unsigned j = 0; j < 16; ++j) { const unsigned c = xb_ld(&bar[XB_XCNT(j)]); sum += c; cnt += (c > 0u) ? 1u : 0u; mine = (j == x) ? c : mine; }
        if (sum == G) break;
        __builtin_amdgcn_s_sleep(1);
        if ((++sp & 255u) == 0u) { if (xb_ld(&bar[XB_TMO])) break; if (sp > XB_SPIN_CAP) { atomicAdd(&bar[XB_TMO], 1u); break; } }
    }
    nloc = mine > 0u ? mine : 1u; nx = cnt > 0u ? cnt : 1u;
}
__device__ __forceinline__ void xcd_barrier(const XcdBarrier& b, bool thread0) {
    asm volatile("s_waitcnt vmcnt(0)" ::: "memory");
    __syncthreads();
    if (thread0) {
        unsigned* bar = b.bar;
        __builtin_amdgcn_s_waitcnt(0);
        unsigned nloc = b.st[0], nx = b.st[1];
        if (nloc == 0u) { xcd_barrier_complete(bar, b.x, nloc, nx); b.st[0] = nloc; b.st[1] = nx; }
        const unsigned old = xb_add(&bar[XB_XSUB(b.x)], 1u);
        const unsigned gen = old / nloc;
        if (old + 1u == (gen + 1u) * nloc) {
            __builtin_amdgcn_fence(__ATOMIC_RELEASE, "agent");
            asm volatile("s_waitcnt vmcnt(0)" ::: "memory");
            const unsigned og = xb_add(&bar[XB_TOP], 1u);
            const unsigned tg = og / nx;
            if (og + 1u == (tg + 1u) * nx) xb_add(&bar[XB_TOPGEN], 1u);
            else XB_SPIN(xb_ld(&bar[XB_TOPGEN]) == tg, bar);
            __builtin_amdgcn_fence(__ATOMIC_ACQUIRE, "agent");
            xb_add(&bar[XB_XGEN(b.x)], 1u);
            asm volatile("s_waitcnt vmcnt(0)" ::: "memory");
        } else {
            XB_SPIN(xb_ld(&bar[XB_XGEN(b.x)]) == gen, bar);
            __builtin_amdgcn_fence(__ATOMIC_ACQUIRE, "agent");
            asm volatile("s_waitcnt vmcnt(0)" ::: "memory");
        }
    }
    __syncthreads();
}

__device__ __forceinline__ size_t qtile_off(int q, int h, int cc) {
    const int chunk = q >> 6, p = q & 63, pt = p >> 4, fr = p & 15, w = cc >> 6, ks = (cc >> 5) & 1, fq = (cc >> 3) & 3;
    const size_t blk = ((((size_t)chunk * 4 + h) * 8 + w) * 4 + pt) * 2 + ks;
    return blk * 512 + (size_t)(fq * 16 + fr) * 8 + (cc & 7);
}
__device__ __forceinline__ size_t ktile_off(int d, int h, int q) {
    const int chunk = q >> 6, s = q & 63, ks = s >> 5, fq = (s >> 3) & 3, w = d >> 6, dd = d & 63, mt = 2 * (dd >> 5) + ((dd >> 2) & 1), frp = 4 * ((dd >> 3) & 3) + (dd & 3);
    const size_t blk = ((((size_t)chunk * 4 + h) * 8 + w) * 4 + mt) * 2 + ks;
    return blk * 512 + (size_t)(fq * 16 + frp) * 8 + (s & 7);
}

__device__ __forceinline__ size_t vtile_off(int e, int h, int q) {
    const int chunk = q >> 6, s = q & 63, slice = e >> 5, e5 = e & 31, nt = e5 >> 4, fr = e5 & 15, ks = s >> 5, fq = (s >> 3) & 3;
    const size_t blk = ((((size_t)chunk * 4 + h) * 16 + slice) * 2 + nt) * 2 + ks;
    return blk * 512 + (size_t)(fq * 16 + fr) * 8 + (s & 7);
}
__device__ __forceinline__ size_t htile_off(int q, int h, int e) {
    return ((((size_t)(q >> 6) * 4 + h) * 16 + (e >> 5)) * 2048) + (size_t)(q & 63) * 32 + (e & 31);
}

namespace pg8 {
constexpr int BM = 256, BK = 64, HALF = 128, HTB = HALF * BK * 2, STAGE_BYTES = 8 * HTB, NXCD = 8, WGM = 8;
__device__ __forceinline__ int lds_byte(int r, int c) { const int st = (r >> 4) * 2 + (c >> 5), rr = r & 15, cc = c & 31, ob = rr * 64 + cc * 2; return st * 1024 + (ob ^ (((ob >> 9) & 1) << 5)); }
__device__ __forceinline__ void stage_rc(int b, int& R_, int& C_) { const int st = b / 1024, sb = b % 1024, swz = sb ^ (((sb >> 9) & 1) << 5); R_ = (st >> 1) * 16 + swz / 64; C_ = (st & 1) * 32 + (swz % 64) / 2; }
__device__ __forceinline__ int perm32(int rho) { const int n = rho >> 4, i = rho & 15; return 8 * (i >> 2) + 4 * n + (i & 3); }

struct Unit { int pm, pn, g; };
struct Gemm {
    const bf16_t* A; const bf16_t* Bt; int lda, ldb, K;
    long a_gs, b_gs;
    int nM, nN, nG;
    int rev;
};
struct Order {
    int nM, nNt, nN, nwg, G, c, rev;
    __device__ void init(const Gemm& g, int G_, int c_) { nM = g.nM; nN = g.nN; nNt = g.nN * g.nG; nwg = nM * nNt; G = G_; c = c_; rev = g.rev; }
    __device__ bool next(int i, Unit& u) const {
        const long L = (long)i * G + c; if (L >= nwg) return false;
        int wgid = (int)L; { const int q = nwg / NXCD, r = nwg % NXCD, xcd = wgid % NXCD, off = wgid / NXCD; wgid = (xcd < r ? xcd * (q + 1) : r * (q + 1) + (xcd - r) * q) + off; }
        const int nig = WGM * nNt, gid = wgid / nig, fm = gid * WGM, gsz = (nM - fm) < WGM ? (nM - fm) : WGM;
        u.pm = fm + ((wgid % nig) % gsz); if (rev) u.pm = nM - 1 - u.pm; const int pnt = (wgid % nig) / gsz; u.g = pnt / nN; u.pn = pnt - u.g * nN; return true;
    }
};
__device__ __forceinline__ unsigned cvt_pk_bf16(float lo, float hi) { return pk2(lo, hi); }

struct EpiStore {
    bf16_t* O; long o_gs; int ldc; int act;
    int mode, off;
    __device__ __forceinline__ void operator()(const f32x4 (&acc)[2][2][4][2], const Unit& u, int wr, int wc, int fr, int fq) const {
        const int row0 = u.pm * BM + wr * 64 + fr; const int col0 = u.pn * BM + wc * 32 + 8 * fq; bf16_t* base = O + (long)u.g * o_gs;
#pragma unroll
        for (int ai = 0; ai < 2; ++ai)
#pragma unroll
            for (int m = 0; m < 4; ++m) { bf16_t* rowp = base + (size_t)(row0 + ai * HALF + m * 16) * ldc + col0;
#pragma unroll
                for (int bj = 0; bj < 2; ++bj) { f32x4 v0 = acc[ai][bj][m][0], v1 = acc[ai][bj][m][1];
                    if (act == 1) {
#pragma unroll
                        for (int j = 0; j < 4; ++j) { const float a = fmaxf(v0[j], 0.f), b = fmaxf(v1[j], 0.f); v0[j] = a * a; v1[j] = b * b; } }
                    u32x4 w; w.x = cvt_pk_bf16(v0[0], v0[1]); w.y = cvt_pk_bf16(v0[2], v0[3]); w.z = cvt_pk_bf16(v1[0], v1[1]); w.w = cvt_pk_bf16(v1[2], v1[3]);
                    if (mode == 0) *(u32x4*)(rowp + bj * HALF) = w;
                    else if (mode == 1) *(u32x4*)(O + qtile_off(off + row0 + ai * HALF + m * 16, u.g, col0 + bj * HALF)) = w;
                    else if (mode == 2) *(u32x4*)(O + ktile_off(row0 + ai * HALF + m * 16, u.g, off + col0 + bj * HALF)) = w;
                    else *(u32x4*)(O + vtile_off(row0 + ai * HALF + m * 16, u.g, off + col0 + bj * HALF)) = w; } }
    }
};

template <class Epi>
__device__ __forceinline__ void gemm_phase(LAS unsigned char* lds, const Gemm g, const Epi& E, int G_, int c_, int tid_in) {
    int tid_ = tid_in; asm volatile("" : "+v"(tid_));
    const int tid = tid_, wid = __builtin_amdgcn_readfirstlane(tid >> 6), lane = tid & 63, wr = wid >> 2, wc = wid & 3, fr = lane & 15, fq = lane >> 4;
    const int K = g.K, nt = K / BK;
    Order S; S.init(g, G_, c_);
    unsigned voffA[2], voffB[2];
#pragma unroll
    for (int i = 0; i < 2; ++i) { int R_, C_; stage_rc(tid * 16 + i * 8192, R_, C_); const int Rb = (R_ & ~31) + perm32(R_ & 31);
        voffA[i] = (unsigned)(R_ * g.lda + C_) * 2u; voffB[i] = (unsigned)(Rb * g.ldb + C_) * 2u; }
    const size_t kstep = (size_t)(BK * 2);
    const size_t hstepA = (size_t)HALF * g.lda * 2, hstepB = (size_t)HALF * g.ldb * 2;
    const unsigned ldsw = (unsigned)wid * 1024u;
    const int aoff = lds_byte(wr * 64 + fr, fq * 8), boff = lds_byte(wc * 32 + fr, fq * 8);
#define PG8_SA(b, h) (((b) * 2 + (h)) * HTB)
#define PG8_SB(b, h) ((4 + (b) * 2 + (h)) * HTB)
#define PG8_STAGE(bufoff, gbase, voff) do { _Pragma("unroll") for (int _i = 0; _i < 2; ++_i) \
        __builtin_amdgcn_global_load_lds((const unsigned*)((const char*)(gbase) + (voff)[_i]), (LAS unsigned*)(lds + (bufoff) + ldsw + _i * 8192), 16, 0, 0); } while (0)
#define PG8_LDA(dst, b, h) do { _Pragma("unroll") for (int m = 0; m < 4; ++m) _Pragma("unroll") for (int k = 0; k < 2; ++k) dst[m][k] = *(const LAS bf16x8*)(lds + PG8_SA(b, h) + aoff + m * 2048 + k * 1024); } while (0)
#define PG8_LDB(dst, b, h) do { _Pragma("unroll") for (int n = 0; n < 2; ++n) _Pragma("unroll") for (int k = 0; k < 2; ++k) dst[n][k] = *(const LAS bf16x8*)(lds + PG8_SB(b, h) + boff + n * 2048 + k * 1024); } while (0)
#define PG8_MMA(ai, bj, At, Bt) do { __builtin_amdgcn_s_setprio(1); _Pragma("unroll") for (int m = 0; m < 4; ++m) _Pragma("unroll") for (int n = 0; n < 2; ++n) _Pragma("unroll") for (int k = 0; k < 2; ++k) \
        acc[ai][bj][m][n] = __builtin_amdgcn_mfma_f32_16x16x32_bf16(Bt[n][k], At[m][k], acc[ai][bj][m][n], 0, 0, 0); __builtin_amdgcn_s_setprio(0); } while (0)
#define PG8_WAIT_V(n) asm volatile("s_waitcnt vmcnt(" #n ")" ::: "memory")
#define PG8_WAIT_L(n) asm volatile("s_waitcnt lgkmcnt(" #n ")" ::: "memory")
#define PG8_BAR __builtin_amdgcn_s_barrier()
#define PG8_SCHED __builtin_amdgcn_sched_barrier(0)
#define PG8_APTR(u) ((const char*)(g.A + (long)(u).g * g.a_gs) + (size_t)(u).pm * 2 * hstepA)
#define PG8_BPTR(u) ((const char*)(g.Bt + (long)(u).g * g.b_gs) + (size_t)(u).pn * 2 * hstepB)
    Unit cur, nxt; int ui = 0;
    if (!S.next(0, cur)) return;
    f32x4 acc[2][2][4][2];
#pragma unroll
    for (int a = 0; a < 2; ++a)
#pragma unroll
        for (int b = 0; b < 2; ++b)
#pragma unroll
            for (int m = 0; m < 4; ++m)
#pragma unroll
                for (int n = 0; n < 2; ++n) acc[a][b][m][n] = (f32x4){0.f, 0.f, 0.f, 0.f};
    bf16x8 At[4][2], B0[2][2], B1[2][2];
    const char* cA = PG8_APTR(cur); const char* cB = PG8_BPTR(cur);
    PG8_STAGE(PG8_SB(0, 0), cB, voffB); PG8_STAGE(PG8_SA(0, 0), cA, voffA); PG8_STAGE(PG8_SB(0, 1), cB + hstepB, voffB); PG8_STAGE(PG8_SA(0, 1), cA + hstepA, voffA);
    if (wr == 1) PG8_BAR;
    PG8_WAIT_V(4); PG8_BAR;
    PG8_STAGE(PG8_SB(1, 0), cB + kstep, voffB); PG8_STAGE(PG8_SA(1, 0), cA + kstep, voffA); PG8_STAGE(PG8_SB(1, 1), cB + hstepB + kstep, voffB);
    PG8_WAIT_V(6); PG8_BAR;
    for (;;) {
        const bool has_next = S.next(ui + 1, nxt);
        const char* nA = has_next ? PG8_APTR(nxt) : cA; const char* nB = has_next ? PG8_BPTR(nxt) : cB;
        for (int t = 0; t < nt; t += 2) {
            const bool last = (t == nt - 2);
            const char* a1 = cA + (size_t)(t + 1) * kstep;
            const char* a2 = last ? nA : cA + (size_t)(t + 2) * kstep; const char* b2 = last ? nB : cB + (size_t)(t + 2) * kstep;
            const char* a3 = a2 + kstep; const char* b3 = b2 + kstep;
            PG8_LDB(B0, 0, 0); PG8_SCHED; PG8_LDA(At, 0, 0); PG8_STAGE(PG8_SA(1, 1), a1 + hstepA, voffA);
            PG8_WAIT_L(8); PG8_BAR; PG8_WAIT_L(0); PG8_MMA(0, 0, At, B0); PG8_BAR; PG8_SCHED;
            PG8_LDB(B1, 0, 1); PG8_STAGE(PG8_SB(0, 0), b2, voffB);
            PG8_BAR; PG8_WAIT_L(0); PG8_MMA(0, 1, At, B1); PG8_BAR;
            PG8_LDA(At, 0, 1); PG8_STAGE(PG8_SA(0, 0), a2, voffA);
            PG8_BAR; PG8_WAIT_L(0); PG8_MMA(1, 0, At, B0); PG8_BAR; PG8_SCHED;
            PG8_STAGE(PG8_SB(0, 1), b2 + hstepB, voffB);
            PG8_WAIT_V(6); PG8_BAR; PG8_MMA(1, 1, At, B1); PG8_BAR;
            PG8_LDB(B0, 1, 0); PG8_SCHED; PG8_LDA(At, 1, 0); PG8_STAGE(PG8_SA(0, 1), a2 + hstepA, voffA);
            PG8_WAIT_L(8); PG8_BAR; PG8_WAIT_L(0); PG8_MMA(0, 0, At, B0); PG8_BAR; PG8_SCHED;
            PG8_LDB(B1, 1, 1); PG8_STAGE(PG8_SB(1, 0), b3, voffB);
            PG8_BAR; PG8_WAIT_L(0); PG8_MMA(0, 1, At, B1); PG8_BAR;
            PG8_LDA(At, 1, 1); PG8_STAGE(PG8_SA(1, 0), a3, voffA);
            PG8_BAR; PG8_WAIT_L(0); PG8_MMA(1, 0, At, B0); PG8_BAR; PG8_SCHED;
            PG8_STAGE(PG8_SB(1, 1), b3 + hstepB, voffB);
            PG8_WAIT_V(6); PG8_BAR; PG8_MMA(1, 1, At, B1); PG8_BAR;
        }
        E(acc, cur, wr, wc, fr, fq);
        if (!has_next) break;
#pragma unroll
        for (int a = 0; a < 2; ++a)
#pragma unroll
            for (int b = 0; b < 2; ++b)
#pragma unroll
                for (int m = 0; m < 4; ++m)
#pragma unroll
                    for (int n = 0; n < 2; ++n) acc[a][b][m][n] = (f32x4){0.f, 0.f, 0.f, 0.f};
        cur = nxt; cA = nA; cB = nB; ++ui;
    }
    PG8_WAIT_V(0);
    if (wr == 0) PG8_BAR;
    PG8_BAR;
#undef PG8_SA
#undef PG8_SB
#undef PG8_STAGE
#undef PG8_LDA
#undef PG8_LDB
#undef PG8_MMA
#undef PG8_WAIT_V
#undef PG8_WAIT_L
#undef PG8_BAR
#undef PG8_SCHED
#undef PG8_APTR
#undef PG8_BPTR
}
}

struct SmallGemm { const bf16_t* A; const bf16_t* B; int lda, ldb, K, akseg, bkseg; long aseg, bseg; int a_tiled; };
constexpr int SG_LD = 72;
constexpr int SG_TILE = 64 * SG_LD * 2;
template <class Dec, class Epi>
__device__ __forceinline__ void gemm_small(LAS unsigned char* lds, const SmallGemm g, int nunits, const Dec& dec, const Epi& epi, int G_, int c_, int tid_in) {
    int tid_ = tid_in; asm volatile("" : "+v"(tid_));
    const int tid = tid_, wid = tid >> 6, lane = tid & 63, wm = wid >> 1, wn = wid & 1, fr = lane & 15, fq = lane >> 4;
    const int lrow = tid >> 3, lk = (tid & 7) * 8;
    const int nk = g.K / 64;
    const unsigned stoff = (unsigned)(lrow * SG_LD + lk) * 2u;
#define SG_LOAD(ra_, rb_, kt_) do { const int k_ = (kt_) * 64 + lk; \
        if (g.a_tiled) ra_ = *(const u32x4*)(g.A + (((((size_t)aoff * 8 + (k_ >> 6)) * 4 + (lrow >> 4)) * 2 + ((k_ >> 5) & 1)) * 512 + (size_t)(((k_ >> 3) & 3) * 16 + (lrow & 15)) * 8)); \
        else ra_ = *(const u32x4*)(ap + (long)(k_ / g.akseg) * g.aseg + (k_ % g.akseg)); \
        rb_ = *(const u32x4*)(bp + (long)(k_ / g.bkseg) * g.bseg + (k_ % g.bkseg)); } while (0)
#define SG_STORE(ra_, rb_, bufi_) do { *(LAS u32x4*)(lds + ((bufi_) * 2 + 0) * SG_TILE + stoff) = ra_; *(LAS u32x4*)(lds + ((bufi_) * 2 + 1) * SG_TILE + stoff) = rb_; } while (0)
#define SG_COMPUTE(bufi_) do { const LAS unsigned char* As = lds + ((bufi_) * 2 + 0) * SG_TILE; const LAS unsigned char* Bs = lds + ((bufi_) * 2 + 1) * SG_TILE; \
        _Pragma("unroll") for (int ks = 0; ks < 2; ++ks) { const bf16x8 af = *(const LAS bf16x8*)(As + ((wm * 16 + fr) * SG_LD + ks * 32 + fq * 8) * 2); \
            _Pragma("unroll") for (int nt = 0; nt < 2; ++nt) { const bf16x8 bf = *(const LAS bf16x8*)(Bs + ((wn * 32 + nt * 16 + fr) * SG_LD + ks * 32 + fq * 8) * 2); \
                acc[nt] = __builtin_amdgcn_mfma_f32_16x16x32_bf16(bf, af, acc[nt], 0, 0, 0); } } } while (0)
    for (int u = c_; u < nunits; u += G_) {
        long aoff, boff; dec(u, aoff, boff);
        const bf16_t* ap = g.A + aoff + (long)lrow * g.lda; const bf16_t* bp = g.B + boff + (long)lrow * g.ldb;
        f32x4 acc[2] = {(f32x4){0.f, 0.f, 0.f, 0.f}, (f32x4){0.f, 0.f, 0.f, 0.f}};
        u32x4 ra0, rb0, ra1, rb1, ra2, rb2, ra3, rb3;
        ra0 = (u32x4){0u, 0u, 0u, 0u}; rb0 = ra0; ra1 = ra0; rb1 = ra0; ra2 = ra0; rb2 = ra0; ra3 = ra0; rb3 = ra0;
        SG_LOAD(ra0, rb0, 0); if (nk > 1) SG_LOAD(ra1, rb1, 1); if (nk > 2) SG_LOAD(ra2, rb2, 2); if (nk > 3) SG_LOAD(ra3, rb3, 3);
        SG_STORE(ra0, rb0, 0);
        LDS_BARRIER();
#define SG_TURN(kt_, bufc, rnextA, rnextB, rfreeA, rfreeB) do { if ((kt_) < nk) { \
            SG_COMPUTE(bufc); \
            if ((kt_) + 1 < nk) SG_STORE(rnextA, rnextB, (bufc) ^ 1); \
            if ((kt_) + 4 < nk) SG_LOAD(rfreeA, rfreeB, (kt_) + 4); \
            LDS_BARRIER(); } } while (0)
        for (int kt = 0; kt < nk; kt += 4) {
            SG_TURN(kt,     0, ra1, rb1, ra0, rb0);
            SG_TURN(kt + 1, 1, ra2, rb2, ra1, rb1);
            SG_TURN(kt + 2, 0, ra3, rb3, ra2, rb2);
            SG_TURN(kt + 3, 1, ra0, rb0, ra3, rb3);
        }
#undef SG_TURN
#pragma unroll
        for (int nt = 0; nt < 2; ++nt) epi(u, wm * 16 + fr, wn * 32 + nt * 16 + fq * 4, acc[nt]);
    }
#undef SG_LOAD
#undef SG_STORE
#undef SG_COMPUTE
}

struct SmallDense { bf16_t* O; long o_gs; int ldc, mt, nt, act; long a_gs, b_gs; int mode; };
__device__ __forceinline__ void gemm_small_dense(LAS unsigned char* lds, const SmallGemm g, const SmallDense d, int ngroups, int G_, int c_, int tid_in) {
    const int per = d.mt * d.nt;
    auto dec = [=](int u, long& ao, long& bo) { const int gi = u / per, r = u % per, mi = r / d.nt, ni = r % d.nt; ao = gi * d.a_gs + (long)mi * 64 * g.lda; bo = gi * d.b_gs + (long)ni * 64 * g.ldb; };
    auto epi = [=](int u, int m, int n, const f32x4& v) { const int gi = u / per, r = u % per, mi = r / d.nt, ni = r % d.nt;
        f32x4 x = v; if (d.act == 1) {
#pragma unroll
            for (int i = 0; i < 4; ++i) { const float a = fmaxf(x[i], 0.f); x[i] = a * a; } }
        u32x2 w; w.x = pk2(x[0], x[1]); w.y = pk2(x[2], x[3]);
        if (d.mode == 0) *(u32x2*)(d.O + gi * d.o_gs + (size_t)(mi * 64 + m) * d.ldc + ni * 64 + n) = w;
        else if (d.mode == 1) *(u32x2*)(d.O + qtile_off(mi * 64 + m, gi, ni * 64 + n)) = w;
        else if (d.mode == 2) *(u32x2*)(d.O + ktile_off(mi * 64 + m, gi, ni * 64 + n)) = w;
        else *(u32x2*)(d.O + vtile_off(mi * 64 + m, gi, ni * 64 + n)) = w; };
    gemm_small(lds, g, ngroups * per, dec, epi, G_, c_, tid_in);
}

struct Args { const float* in[22]; float* out; unsigned char* ws; int ph_lo, ph_hi, ph_last, li; };
enum { I_X = 0, I_C, I_CTX, I_CCTX, I_ADAW, I_ADAB, I_PG, I_PB, I_WIN, I_WCONV, I_BCONV, I_WQ, I_WK, I_WV, I_WGATE, I_BGATE, I_GNW, I_SKIP, I_WOUT, I_FWOUT, I_W1, I_W2 };

constexpr int LDS_BYTES = 147456;
constexpr int LDS_MISC = LDS_BYTES - 256;

__device__ __forceinline__ void transpose_item(const float* W, int K, int N, bf16_t* WT, float scale, LAS float* scr, int item, int lane) {
    const int nblk = N / 32, kb = item / nblk, nb = item % nblk, k0 = 64 * kb, n0 = 32 * nb;
#pragma unroll 8
    for (int i = 0; i < 32; ++i) { const int kk = 2 * i + (lane >> 5); scr[kk * 33 + (lane & 31)] = W[(size_t)(k0 + kk) * N + n0 + (lane & 31)] * scale; }
    asm volatile("s_waitcnt lgkmcnt(0)" ::: "memory");
    const int c = lane & 7;
#pragma unroll
    for (int j = 0; j < 4; ++j) { const int n = (lane >> 3) + 8 * j; const LAS float* s = scr + (8 * c) * 33 + n;
        u32x4 o; o.x = pk2(s[0 * 33], s[1 * 33]); o.y = pk2(s[2 * 33], s[3 * 33]); o.z = pk2(s[4 * 33], s[5 * 33]); o.w = pk2(s[6 * 33], s[7 * 33]);
        *(u32x4*)(WT + (size_t)(n0 + n) * K + k0 + 8 * c) = o; }
    asm volatile("s_waitcnt lgkmcnt(0)" ::: "memory");
}

__device__ __forceinline__ void ln_norm(f32x4 (&v)[4], int lane) {
    float s = 0.f;
#pragma unroll
    for (int j = 0; j < 4; ++j) s += (v[j][0] + v[j][1]) + (v[j][2] + v[j][3]);
    const float mean = wave_sum(s, lane) * (1.f / D); float s2 = 0.f;
#pragma unroll
    for (int j = 0; j < 4; ++j) { v[j] = v[j] - mean; s2 += (v[j][0] * v[j][0] + v[j][1] * v[j][1]) + (v[j][2] * v[j][2] + v[j][3] * v[j][3]); }
    const float rstd = __builtin_amdgcn_rsqf(wave_sum(s2, lane) * (1.f / D) + LN_EPS);
#pragma unroll
    for (int j = 0; j < 4; ++j) v[j] = v[j] * rstd;
}

constexpr int PL = 24;
constexpr int NPHASE = 2 + 4 * PL;
__host__ __device__ inline bool phase_valid(int id) {
    if (id < 2) return true;
    const int layer = (id - 2) / PL, k = (id - 2) % PL;
    if (layer > 3) return false;
    if (k == 0 || (k >= 19 && k <= 22)) return true;
    if (layer & 1) return k >= 2 && k <= 5;
    return k >= 1 && k <= 18;
}


#define MOD ((float*)(ws + WS_MOD))
#define CTXX ((float*)(ws + WS_CTXX))
#define PRE ((float*)(ws + WS_PRE))
#define HIN ((bf16_t*)(ws + WS_HIN))
#define YB ((bf16_t*)(ws + WS_YB))
#define WIN ((bf16_t*)(ws + W_IN))
#define WQ ((bf16_t*)(ws + W_Q))
#define WK ((bf16_t*)(ws + W_K))
#define WV ((bf16_t*)(ws + W_V))
#define WOUT ((bf16_t*)(ws + W_OUT))
#define W1 ((bf16_t*)(ws + W_1))
#define W2 ((bf16_t*)(ws + W_2))
#define GATET ((bf16_t*)(ws + TAB_GATE))
#define S0 ((bf16_t*)(ws + WS_BIG + 0 * SLOT))
#define S1 ((bf16_t*)(ws + WS_BIG + 1 * SLOT))
#define S2 ((bf16_t*)(ws + WS_BIG + 2 * SLOT))
#define S3 ((bf16_t*)(ws + WS_BIG + 3 * SLOT))
#define S4 ((bf16_t*)(ws + WS_BIG + 4 * SLOT))
#define YH (YB + ((size_t)CR + (size_t)half * LH) * D)
#define YHC (YB + (size_t)half * LAT0 * D)
#define HCB (YH + (size_t)NCH * 4 * 2 * 4096 + (size_t)NCH * 4 * 2 * 384 * 2)
#define PREQ ((float*)(HCB + (size_t)LAT0 * DI))
#define HH (HIN + ((size_t)CR + (size_t)half * LH) * D)
#define HHC (HIN + (size_t)half * LAT0 * D)
#define HT ((bf16_t*)(ws + WS_BIG))
#define HTC (HT + (size_t)NB * D * T)
#define PB ((bf16_t*)(ws + WS_BIG + 1 * SLOT))
#define WC ((bf16_t*)(ws + WS_BIG + 3 * SLOT))
#define ZF ((bf16_t*)(ws + WS_BIG))
#define HID ((bf16_t*)(ws + WS_BIG))

constexpr int SC_PLD = 36, SC_VLD = 72;
#define SC_ROW0(j) (((j) < 4) ? (bl * CT + (dir ? 3 - (j) : (j)) * 64) : (LAT0 + bl * T + (dir ? 127 - ((j) - 4) : ((j) - 4)) * 64))
#define SC_LOADQ(dst, r0) do { _Pragma("unroll") for (int pt = 0; pt < 4; ++pt) _Pragma("unroll") for (int ks = 0; ks < 2; ++ks) \
        dst[pt][ks] = __builtin_bit_cast(bf16x8, __builtin_amdgcn_raw_buffer_load_b128(rW, loff, oQ + ((((((r0) >> 6) * 4 + hh) * 8 + w) * 4 + pt) * 2 + ks) * 1024, 0)); } while (0)
#define SC_LOADQ1(dst, r0, pt, ks) dst[pt][ks] = __builtin_bit_cast(bf16x8, __builtin_amdgcn_raw_buffer_load_b128(rW, loff, oQ + ((((((r0) >> 6) * 4 + hh) * 8 + w) * 4 + (pt)) * 2 + (ks)) * 1024, 0))
#define SC_LOADK1(dst, r0, mt, ks) dst[mt][ks] = __builtin_bit_cast(bf16x8, __builtin_amdgcn_raw_buffer_load_b128(rW, loff, oK + ((((((r0) >> 6) * 4 + hh) * 8 + w) * 4 + (mt)) * 2 + (ks)) * 1024, 0))
#define SC_LOADK(dst, r0) do { _Pragma("unroll") for (int mt = 0; mt < 4; ++mt) _Pragma("unroll") for (int ks = 0; ks < 2; ++ks) \
        dst[mt][ks] = __builtin_bit_cast(bf16x8, __builtin_amdgcn_raw_buffer_load_b128(rW, loff, oK + ((((((r0) >> 6) * 4 + hh) * 8 + w) * 4 + mt) * 2 + ks) * 1024, 0)); } while (0)
#define SC_LOADS(P, r0) do { const int ci_ = ((((r0) >> 6) * 4 + hh) * 2 + dir); \
        P##sg0 = __builtin_bit_cast(bf16x8, __builtin_amdgcn_raw_buffer_load_b128(rW, loff, oS + ci_ * 8192 + (w >> 1) * 2048, 0)); P##sg1 = __builtin_bit_cast(bf16x8, __builtin_amdgcn_raw_buffer_load_b128(rW, loff, oS + ci_ * 8192 + (w >> 1) * 2048 + 1024, 0)); \
        P##v = __builtin_bit_cast(u32x4, __builtin_amdgcn_raw_buffer_load_b128(rW, loff, oV + ((((r0) >> 6) * 4 + hh) * 16 + slice) * 4096 + (w & 3) * 1024, 0));     \
        P##wka = __builtin_bit_cast(u32x4, __builtin_amdgcn_raw_buffer_load_b128(rW, wkoff, oG + ci_ * 1536 + 1296, 0));         \
        P##wint = __builtin_bit_cast(float, __builtin_amdgcn_raw_buffer_load_b32(rW, gcp, oG + ci_ * 1536 + 512, 0)); P##em = __builtin_bit_cast(float, __builtin_amdgcn_raw_buffer_load_b32(rW, gcp, oG + ci_ * 1536 + 768, 0)); \
        P##dec = __builtin_bit_cast(float, __builtin_amdgcn_raw_buffer_load_b32(rW, 0, oG + ci_ * 1536 + 1280, 0)); } while (0)
#define SC_VWRITE(bufi, P) do { LAS bf16_t* vt_ = VB + (bufi) * 2 * 3072; LAS bf16_t* vw_ = vt_ + 3072; \
        if (w < 5) { const float wk_[8] = {bflo(P##wka.x), bfhi(P##wka.x), bflo(P##wka.y), bfhi(P##wka.y), bflo(P##wka.z), bfhi(P##wka.z), bflo(P##wka.w), bfhi(P##wka.w)};     \
            if (w < 4) { *(LAS u32x4*)(vt_ + tid * 8) = P##v; \
                u32x4 sv_; sv_.x = pk2(bflo(P##v.x) * wk_[0], bfhi(P##v.x) * wk_[1]); sv_.y = pk2(bflo(P##v.y) * wk_[2], bfhi(P##v.y) * wk_[3]); \
                sv_.z = pk2(bflo(P##v.z) * wk_[4], bfhi(P##v.z) * wk_[5]); sv_.w = pk2(bflo(P##v.w) * wk_[6], bfhi(P##v.w) * wk_[7]); *(LAS u32x4*)(vw_ + tid * 8) = sv_; } \
            else if (lane < 8) { const u32x4 sv_ = P##wka; \
                int ln_ = lane; asm volatile("" : "+v"(ln_));     \
                *(LAS u32x4*)(vw_ + (4 + (ln_ >> 2)) * 512 + (ln_ & 3) * 16 * 8) = sv_; } } } while (0)
#define SC_STEP(J, Qc, Qn, Kc, Kn, C, N) do { \
    const int j_ = (J); const int row0 = SC_ROW0(j_); const int jn_ = j_ < 131 ? j_ + 1 : 131; const int row1 = SC_ROW0(jn_); \
    const int hsel = (j_ < 4) ? (dir ? 2 : 0) : ((j_ < 68) ? 0 : 1); \
    const int buf = j_ & 1; \
    const LAS bf16_t* VT = VB + buf * 2 * 3072; const LAS bf16_t* VW = VT + 3072; \
    LAS bf16_t* Pb_ = Pbh + buf * (8 * 64 * 40); LAS float* Nq_ = NQs + buf * (8 * 64);        \
    SC_LOADS(N, row1); \
      \
    if (!(abl_ & 1)) _Pragma("unroll") for (int nt = 0; nt < 3; ++nt) { \
        f32x4 d1[4]; \
        _Pragma("unroll") for (int pt = 0; pt < 4; ++pt) d1[pt] = (f32x4){0.f, 0.f, 0.f, 0.f}; \
        _Pragma("unroll") for (int ks = 0; ks < 2; ++ks) { \
            u32x4 bw; bw.x = pg8::cvt_pk_bf16(st[2 * ks][nt][0], st[2 * ks][nt][1]); bw.y = pg8::cvt_pk_bf16(st[2 * ks][nt][2], st[2 * ks][nt][3]); \
            bw.z = pg8::cvt_pk_bf16(st[2 * ks + 1][nt][0], st[2 * ks + 1][nt][1]); bw.w = pg8::cvt_pk_bf16(st[2 * ks + 1][nt][2], st[2 * ks + 1][nt][3]); \
            const bf16x8 bs = __builtin_bit_cast(bf16x8, bw); \
            _Pragma("unroll") for (int pt = 0; pt < 4; ++pt) d1[pt] = __builtin_amdgcn_mfma_f32_16x16x32_bf16(bs, Qc[pt][ks], d1[pt], 0, 0, 0); \
            SC_LOADQ1(Qn, row1, (nt * 2 + ks) >> 1, (nt * 2 + ks) & 1);     } \
        _Pragma("unroll") for (int pt = 0; pt < 4; ++pt) { \
            if (nt < 2) { u32x2 pw_; pw_.x = pg8::cvt_pk_bf16(d1[pt][0], d1[pt][1]); pw_.y = pg8::cvt_pk_bf16(d1[pt][2], d1[pt][3]); *(LAS u32x2*)(Pb_ + (w * 64 + 16 * pt + fr) * 40 + 16 * nt + 4 * fq) = pw_; }     \
            else if (fq == 0) Nq_[w * 64 + 16 * pt + fr] = d1[pt][0]; } } \
    SC_LOADQ1(Qn, row1, 3, 0); SC_LOADQ1(Qn, row1, 3, 1); \
    LDS_BARRIER();                                                       \
      \
    f32x4 d2 = (f32x4){0.f, 0.f, 0.f, 0.f}, d3 = (f32x4){0.f, 0.f, 0.f, 0.f}; \
    if (!(abl_ & 2)) {     \
        const int nt2 = w & 1; \
        const bf16x8 vt0 = *(const LAS bf16x8*)(VT + (nt2 * 2 + 0) * 512 + lane * 8), vt1 = *(const LAS bf16x8*)(VT + (nt2 * 2 + 1) * 512 + lane * 8); \
        const bf16x8 vo0 = *(const LAS bf16x8*)(VT + 4 * 512 + lane * 8), vo1 = *(const LAS bf16x8*)(VT + 5 * 512 + lane * 8); \
        d2 = __builtin_amdgcn_mfma_f32_16x16x32_bf16(vt0, C##sg0, d2, 0, 0, 0); d3 = __builtin_amdgcn_mfma_f32_16x16x32_bf16(vo0, C##sg0, d3, 0, 0, 0); \
        d2 = __builtin_amdgcn_mfma_f32_16x16x32_bf16(vt1, C##sg1, d2, 0, 0, 0); d3 = __builtin_amdgcn_mfma_f32_16x16x32_bf16(vo1, C##sg1, d3, 0, 0, 0); } \
      \
    if (!(abl_ & 4)) _Pragma("unroll") for (int nt = 0; nt < 3; ++nt) { \
        const bf16x8 vw0 = *(const LAS bf16x8*)(VW + (nt * 2 + 0) * 512 + lane * 8), vw1 = *(const LAS bf16x8*)(VW + (nt * 2 + 1) * 512 + lane * 8); \
        _Pragma("unroll") for (int mt = 0; mt < 4; ++mt) { f32x4 a = st[mt][nt] * C##dec; \
            a = __builtin_amdgcn_mfma_f32_16x16x32_bf16(Kc[mt][0], vw0, a, 0, 0, 0); \
            a = __builtin_amdgcn_mfma_f32_16x16x32_bf16(Kc[mt][1], vw1, a, 0, 0, 0); st[mt][nt] = a; \
            if (nt < 2) SC_LOADK1(Kn, row1, (nt * 4 + mt) >> 1, (nt * 4 + mt) & 1); } } \
    if (!(abl_ & 8)) {     \
        f32x4 o1 = (f32x4){0.f, 0.f, 0.f, 0.f}; float nq = 0.f; \
        _Pragma("unroll") for (int ww = 0; ww < 8; ++ww) { const u32x2 cpr_ = *(const LAS u32x2*)(Pb_ + (ww * 64 + cp) * 40 + cv); nq += Nq_[ww * 64 + cp]; \
            o1 += (f32x4){bflo(cpr_.x), bfhi(cpr_.x), bflo(cpr_.y), bfhi(cpr_.y)}; } \
        const float den = C##wint * nq + d3[0]; const float scl = __builtin_amdgcn_rcpf(fmaxf(fabsf(den), C##em)); \
        const f32x4 o = (o1 * C##wint + d2) * scl; \
        u32x2 ow; ow.x = pk2(o[0], o[1]); ow.y = pk2(o[2], o[3]); \
        unsigned lo_ = loff; asm volatile("" : "+v"(lo_)); const unsigned hoff_ = ((lo_ >> 4) & 15u) * 64u + (lo_ >> 8) * 8u;     \
        __builtin_amdgcn_raw_buffer_store_b64(ow, rW, hoff_, (rep_ + 1 < SCAN_REP) ? (oC + 512 * DI * 2) : ((hsel == 0 ? oH : (hsel == 1 ? oV : oC)) + (((row0 >> 6) * 4 + hh) * 16 + slice) * 4096 + (w >> 1) * 1024 + (w & 1) * 32), 0); } \
    if (!(abl_ & 16)) SC_VWRITE(buf ^ 1, N);                                     \
} while (0)

__device__ __forceinline__ void scan_phase(LAS unsigned char* lds, unsigned char* ws, int half, const XcdBarrier& bar, int tid, int lane, int wave, int bx) {
    LAS bf16_t* Pbh = (LAS bf16_t*)lds;
    LAS float* NQs = (LAS float*)(lds + 2 * 8 * 64 * 40 * 2);
    LAS bf16_t* VB = (LAS bf16_t*)(NQs + 2 * 8 * 64);
    const int xcd = bx & 7, idx = bx >> 3;
    const int scn = (xcd * 2 + (idx >> 4)) & 15, slice = idx & 15;
    const int bl = scn >> 3, hh = (scn >> 1) & 3, dir = scn & 1, e0 = slice * 32;
    const int fr = lane & 15, fq = lane >> 4, w = wave;
    const int cp = 16 * (w >> 1) + fr, cv = 16 * (w & 1) + 4 * fq;
    const unsigned loff = (unsigned)lane * 16u;
    const unsigned gcp = (unsigned)cp * 4u;
    const unsigned wkoff = (w < 4) ? (unsigned)(32 * ((tid >> 6) & 1) + 8 * ((tid & 63) >> 4)) * 2u : (unsigned)(32 * ((lane >> 2) & 1) + 8 * (lane & 3)) * 2u;
    const __amdgpu_buffer_rsrc_t rW = __builtin_amdgcn_make_buffer_rsrc((void*)ws, 0, (int)(512 * MiB), 0x00020000);
    const int oYH = (int)(WS_YB + ((size_t)CR + (size_t)half * LH) * D * 2);
    const int oQ = (int)(WS_BIG + 3 * SLOT), oK = (int)(WS_BIG + 4 * SLOT), oV = (int)(WS_BIG + 2 * SLOT), oH = (int)(WS_BIG + 0 * SLOT);
    const int oS = oYH, oG = oYH + NCH * 4 * 2 * 8192, oC = oG + NCH * 4 * 2 * 1536;
    for (int i = tid; i < 4 * 1024; i += NTHR) { const int im = i >> 10, r = i & 1023, ln = (r & 511) >> 3; VB[im * 3072 + 2048 + r] = (bf16_t)(((im & 1) == 0 && (ln & 3) == 0) ? 0x3F80u : 0u); }
    __syncthreads();
    for (int rep_ = 0; rep_ < SCAN_REP; ++rep_) {
    const int abl_ = (rep_ + 1 < SCAN_REP) ? SC_ABL : 0;
    f32x4 st[4][3];
#pragma unroll
    for (int a = 0; a < 4; ++a)
#pragma unroll
        for (int b = 0; b < 3; ++b) st[a][b] = (f32x4){0.f, 0.f, 0.f, 0.f};
    bf16x8 Q0[4][2], Q1[4][2], K0[4][2], K1[4][2];
    bf16x8 Asg0, Asg1, Bsg0, Bsg1; u32x4 Av = (u32x4){0u, 0u, 0u, 0u}, Bv = Av, Awka = Av, Bwka = Av; float Awint, Aem, Adec, Bwint, Bem, Bdec;
    { const int r0 = SC_ROW0(0); SC_LOADQ(Q0, r0); SC_LOADK(K0, r0); SC_LOADS(A, r0); SC_VWRITE(0, A); }
#pragma unroll 1
    for (int j = 0; j < 132; j += 2) {
        if (j == 68) xcd_barrier(bar, tid == 0);
        SC_STEP(j, Q0, Q1, K0, K1, A, B);
        SC_STEP(j + 1, Q1, Q0, K1, K0, B, A);
    }
    __syncthreads();
    }
}
#undef SC_ROW0
#undef SC_LOADQ
#undef SC_LOADK
#undef SC_LOADS
#undef SC_VWRITE
#undef SC_STEP

typedef const __attribute__((address_space(4))) Args KA;
__device__ __forceinline__ KA* kargs() { KA* k = (KA*)__builtin_amdgcn_kernarg_segment_ptr(); asm volatile("" : "+s"(k)); return k; }
#define PH_BEGIN() \
    KA* ka = kargs(); unsigned char* ws = ka->ws; (void)ws; \
    int wave = wave0; asm volatile("" : "+s"(wave)); \
    unsigned lz_ = 0u; asm volatile("" : "+v"(lz_)); const int lane = (int)__builtin_amdgcn_mbcnt_hi(~0u, __builtin_amdgcn_mbcnt_lo(~0u, lz_)); \
    const int tid = wave * 64 + lane; (void)tid; \
    const int gw = bx * NWAVES + wave, NGW = G * NWAVES; (void)gw; (void)NGW;

__global__ void __launch_bounds__(NTHR, 2) fwd(Args args) {
    extern __shared__ __attribute__((aligned(16))) unsigned char lds_raw[];
    LAS unsigned char* lds = (LAS unsigned char*)lds_raw;
    const int G = gridDim.x, bx = blockIdx.x;
    const int wave0 = __builtin_amdgcn_readfirstlane(threadIdx.x >> 6);
    volatile LAS unsigned* MISC = (volatile LAS unsigned*)(lds + LDS_MISC);
    if (threadIdx.x < 64) MISC[threadIdx.x] = 0u;
    __syncthreads();
    XcdBarrier bar = xcd_barrier_post((unsigned*)(args.ws + WS_CTL + 65536) + (size_t)args.li * 4096, MISC + 8);
    const int lo = args.ph_lo, hi = args.ph_hi, plast = args.ph_last;
#define IN(k) (lo <= (k) && (k) < hi)
#define SEAM(k) do { if ((k) != plast) { xcd_barrier(bar, tid == 0); if (DUP_BAR) xcd_barrier(bar, tid == 0); } } while (0)

    if (EN_PRO && IN(0)) { PH_BEGIN();
        {
            LAS float* sc = (LAS float*)lds;
            for (int i = tid; i < 5 * D; i += NTHR) { const int r = i / D, k = i % D; const float x = r < 4 ? ka->in[I_C][r * D + k] : ka->in[I_CCTX][k]; sc[i] = siluf(x); }
            __syncthreads();
            LAS float* red = (LAS float*)(lds + 32768);
            const int kp = tid >> 6, cc = tid & 63;
            for (int item = bx; item < 4 * 96; item += G) {
                const int layer = item / 96, n0 = (item % 96) * 64;
                const float* w = ka->in[I_ADAW] + (size_t)layer * D * 6 * D + n0 + cc;
                float a0 = 0.f, a1 = 0.f, a2 = 0.f, a3 = 0.f, a4 = 0.f;
                for (int k = kp * 128; k < kp * 128 + 128; ++k) { const float wv = w[(size_t)k * 6 * D]; a0 += sc[k] * wv; a1 += sc[D + k] * wv; a2 += sc[2 * D + k] * wv; a3 += sc[3 * D + k] * wv; a4 += sc[4 * D + k] * wv; }
                red[(kp * 64 + cc) * 5 + 0] = a0; red[(kp * 64 + cc) * 5 + 1] = a1; red[(kp * 64 + cc) * 5 + 2] = a2; red[(kp * 64 + cc) * 5 + 3] = a3; red[(kp * 64 + cc) * 5 + 4] = a4;
                __syncthreads();
                if (tid < 320) { const int c2 = tid % 64, r = tid / 64; float s = ka->in[I_ADAB][layer * 6 * D + n0 + c2];
                    for (int q = 0; q < 8; ++q) s += red[(q * 64 + c2) * 5 + r];
                    MOD[((size_t)layer * 5 + r) * 6 * D + n0 + c2] = s; }
                __syncthreads();
            }
        }
        {
            bf16_t* A1 = (bf16_t*)(ws + TAB_A1); bf16_t* A2 = (bf16_t*)(ws + TAB_A2); bf16_t* BZ = (bf16_t*)(ws + TAB_BZ); bf16_t* ACTX = (bf16_t*)(ws + TAB_ACTX);
            const int gt = bx * NTHR + tid, NGT = G * NTHR;
            const float s8192 = 0.011048543456039806f;
            for (int i = gt; i < 512 * 256; i += NGT) { const int m = i / 256, t1 = i % 256, ri = m / 256, t1p = m % 256; const int ph = (t1 * t1p) & 255; float sn, cs; sincospif((float)ph * (2.0f / 256.0f), &sn, &cs);
                A1[i] = (bf16_t)f2bf((ri == 0 ? cs : -sn) * s8192);
                ACTX[i] = (bf16_t)f2bf((ri == 0 ? cs : -sn) * 0.0625f); }
            for (int i = gt; i < 256 * 64 * 64; i += NGT) { const int t1p = i / 4096, m = (i / 64) % 64, k = i % 64; const int rip = m / 32, t2p = m % 32, ri = k / 32, t2 = k % 32;
                const int ph = (t2 * t1p + 256 * t2 * t2p) & 8191; float sn, cs; sincospif((float)ph * (2.0f / 8192.0f), &sn, &cs);
                const float v = (rip == ri) ? cs : (rip == 0 ? sn : -sn); A2[i] = (bf16_t)f2bf(v); }
            for (int i = gt; i < 256 * 512; i += NGT) { const int cp = i / 512, k = i % 512, ri = k / 256, c = k % 256; const int ph = (c * cp) & 255; float sn, cs; sincospif((float)ph * (2.0f / 256.0f), &sn, &cs);
                BZ[i] = (bf16_t)f2bf((ri == 0 ? cs : sn) * 0.0625f); }
        }
        SEAM(0);
    }
    if (EN_PRO && IN(1)) { PH_BEGIN();
        for (int r = gw; r < R; r += NGW) {
            const RowInfo ri = row_info(r);
            const float* xr = ri.is_ctx ? ka->in[I_CTX] + ((size_t)ri.b * CT + ri.t) * D : ka->in[I_X] + ((size_t)ri.b * T + ri.t) * D;
            const float* md = MOD + ((size_t)0 * 5 + (ri.is_ctx ? 4 : ri.b)) * 6 * D;
            f32x4 v[4];
#pragma unroll
            for (int j = 0; j < 4; ++j) v[j] = *(const f32x4*)(xr + 256 * j + 4 * lane);
            ln_norm(v, lane);
            bf16_t* o = HIN + (size_t)r * D;
#pragma unroll
            for (int j = 0; j < 4; ++j) { const f32x4 sh = *(const f32x4*)(md + 256 * j + 4 * lane), sc = *(const f32x4*)(md + D + 256 * j + 4 * lane);
                const f32x4 h = v[j] * (1.0f + sc) + sh; u32x2 w; w.x = pk2(h[0], h[1]); w.y = pk2(h[2], h[3]); *(u32x2*)(o + 256 * j + 4 * lane) = w; }
        }
        SEAM(1);
    }

    for (int layer = 0; layer < 4; ++layer) {
        const int pb = 2 + layer * PL;
        if (hi <= pb || lo >= pb + PL) continue;
        const int jl = layer >> 1;
        const bool is_m = (layer & 1) == 0;
        if (EN_WC && IN(pb + 0)) { PH_BEGIN();
 for (int rp_ = 0; rp_ < REPN(5); ++rp_) {
            LAS float* scr = (LAS float*)(lds + wave * 16384);
            const int i_in = (D / 64) * (2 * DI / 32), i_h = (DH / 64) * (DH / 32), i_out = (DI / 64) * (D / 32), i_f = (D / 64) * (D / 32), i_1 = (D / 64) * (DFF / 32), i_2 = (DFF / 64) * (D / 32);
            const int n_mix = is_m ? (i_in + 12 * i_h + i_out) : i_f;
            const int nitems = n_mix + i_1 + i_2;
            for (int it = gw; it < nitems; it += NGW) {
                int r = it;
                if (r >= n_mix) { r -= n_mix;
                    if (r < i_1) transpose_item(ka->in[I_W1] + (size_t)layer * D * DFF, D, DFF, W1, 1.f, scr, r, lane);
                    else transpose_item(ka->in[I_W2] + (size_t)layer * DFF * D, DFF, D, W2, 1.f, scr, r - i_1, lane);
                    continue; }
                if (!is_m) { transpose_item(ka->in[I_FWOUT] + (size_t)jl * D * D, D, D, WOUT, 1.f, scr, r, lane); continue; }
                if (r < i_in) { transpose_item(ka->in[I_WIN] + (size_t)jl * D * 2 * DI, D, 2 * DI, WIN, 1.f, scr, r, lane); continue; } r -= i_in;
                if (r < 12 * i_h) { const int which = r / (4 * i_h), hh = (r / i_h) % 4, rr = r % i_h;
                    const float* src = ka->in[which == 0 ? I_WQ : (which == 1 ? I_WK : I_WV)] + ((size_t)jl * NH + hh) * DH * DH;
                    bf16_t* dst = (which == 0 ? WQ : (which == 1 ? WK : WV)) + (size_t)hh * DH * DH;
                    transpose_item(src, DH, DH, dst, which == 1 ? 0.044194173824159216f : 1.f, scr, rr, lane); continue; } r -= 12 * i_h;
                transpose_item(ka->in[I_WOUT] + (size_t)jl * DI * D, DI, D, WOUT, 1.f, scr, r, lane);
            }
            if (is_m) {
                const float* wg = ka->in[I_WGATE] + (size_t)jl * 3 * DI * 16;
                const int n = lane & 15, eq = lane >> 4;
                for (int k2 = gw; k2 < DI; k2 += NGW) {
                    const int hh = k2 / DH, d = k2 % DH;
                    const float* q = ka->in[I_WQ] + (((size_t)jl * NH + hh) * DH + d) * DH + eq * 128; const float* kx = ka->in[I_WK] + (((size_t)jl * NH + hh) * DH + d) * DH + eq * 128;
                    const float* vx = ka->in[I_WV] + (((size_t)jl * NH + hh) * DH + d) * DH + eq * 128;
                    const float* g0 = wg + ((size_t)0 * DI + hh * DH + eq * 128) * 16 + n; const float* g1 = wg + ((size_t)1 * DI + hh * DH + eq * 128) * 16 + n; const float* g2 = wg + ((size_t)2 * DI + hh * DH + eq * 128) * 16 + n;
                    float s0 = 0.f, s1 = 0.f, s2 = 0.f;
#pragma unroll 8
                    for (int e = 0; e < 128; ++e) { s0 += q[e] * g0[e * 16]; s1 += kx[e] * g1[e * 16]; s2 += vx[e] * g2[e * 16]; }
                    float sa = s0 + 0.044194173824159216f * s1;
                    sa += shx(sa, 16, lane); sa += shx(sa, 32, lane); s2 += shx(s2, 16, lane); s2 += shx(s2, 32, lane);
                    if (lane < 16) { GATET[(size_t)n * 4096 + k2] = (bf16_t)f2bf(sa); GATET[(size_t)n * 4096 + DI + k2] = (bf16_t)f2bf(s2); }
                    else if (lane < 64) { GATET[(size_t)(16 + (lane - 16)) * 4096 + k2] = (bf16_t)0; GATET[(size_t)(16 + (lane - 16)) * 4096 + DI + k2] = (bf16_t)0; }
                }
            }
 }
            SEAM(pb + 0);
        }

        if (EN_MIX && is_m) {
            for (int half = 0; half < 2; ++half) {
                const int hb = pb + 1 + 9 * half;
                if (hi <= hb || lo >= hb + 9) continue;
                if (IN(hb + 0)) { PH_BEGIN();
 for (int rp_ = 0; rp_ < REPN(0); ++rp_) {
                    pg8::Gemm g{HH, WIN, D, D, D, 0, 0, LH / 256, DI / 256, 1};
                    pg8::EpiStore E{S0 + (size_t)LAT0 * DI, 0, DI, 0};
                    pg8::gemm_phase(lds, g, E, G, bx, tid); if (DUP_MIX) pg8::gemm_phase(lds, g, E, G, bx, tid);
                    { SmallGemm sg{HHC, WIN, D, D, D, D, D, 0, 0}; SmallDense sd{S0, 0, DI, LAT0 / 64, DI / 64, 0, 0, 0}; gemm_small_dense(lds, sg, sd, 1, G, bx, tid); if (DUP_CTX) gemm_small_dense(lds, sg, sd, 1, G, bx, tid); }
 }
                    SEAM(hb + 0);
                }
                if (IN(hb + 1)) { PH_BEGIN();
 for (int rp_ = 0; rp_ < REPN(3); ++rp_) {
                    const float* wc = ka->in[I_WCONV] + (size_t)jl * 9 * DI; const float* bc = ka->in[I_BCONV] + (size_t)jl * DI;
                    const int gt = bx * NTHR + tid, NGT = G * NTHR;
                    for (int i = gt; i < 2 * 128 * 2 * (DI / 8); i += NGT) {
                        const int cg = i & 255, rest = i >> 8, hr = rest & 1, r = (rest >> 1) & 127, bl = rest >> 8, c0 = cg * 8, gc0 = 32 * hr;
                        float wv[9][8], bv[8];
#pragma unroll
                        for (int tp = 0; tp < 9; ++tp) { const f32x4 a0 = *(const f32x4*)(wc + (size_t)tp * DI + c0), a1 = *(const f32x4*)(wc + (size_t)tp * DI + c0 + 4);
                            wv[tp][0] = a0[0]; wv[tp][1] = a0[1]; wv[tp][2] = a0[2]; wv[tp][3] = a0[3]; wv[tp][4] = a1[0]; wv[tp][5] = a1[1]; wv[tp][6] = a1[2]; wv[tp][7] = a1[3]; }
                        { const f32x4 a0 = *(const f32x4*)(bc + c0), a1 = *(const f32x4*)(bc + c0 + 4); bv[0] = a0[0]; bv[1] = a0[1]; bv[2] = a0[2]; bv[3] = a0[3]; bv[4] = a1[0]; bv[5] = a1[1]; bv[6] = a1[2]; bv[7] = a1[3]; }
                        const bf16_t* xb = S0 + (size_t)(LAT0 + bl * T + r * 64) * DI + c0;
                        bf16_t* ob = S1 + (size_t)(LAT0 + bl * T + r * 64) * DI + c0;
                        const bool rok[3] = {r > 0, true, r < 127};
                        float win[3][3][8];
#define CV_LOADCOL(slot, col) do { _Pragma("unroll") for (int di = 0; di < 3; ++di) { u32x4 xv = (u32x4){0u, 0u, 0u, 0u}; \
                                if (rok[di] && (col) >= 0 && (col) < 64) xv = *(const u32x4*)(xb + (ptrdiff_t)((di - 1) * 64 + (col)) * DI); \
                                win[slot][di][0] = bflo(xv.x); win[slot][di][1] = bfhi(xv.x); win[slot][di][2] = bflo(xv.y); win[slot][di][3] = bfhi(xv.y); \
                                win[slot][di][4] = bflo(xv.z); win[slot][di][5] = bfhi(xv.z); win[slot][di][6] = bflo(xv.w); win[slot][di][7] = bfhi(xv.w); } } while (0)
#define CV_STEP(sl, sm, sr) do { CV_LOADCOL(sr, gc + 1); \
                                if (gc < gc0 + 32) { float acc[8]; \
                                    _Pragma("unroll") for (int e = 0; e < 8; ++e) { float s = bv[e]; \
                                        _Pragma("unroll") for (int di = 0; di < 3; ++di) s += win[sl][di][e] * wv[di * 3 + 0][e] + win[sm][di][e] * wv[di * 3 + 1][e] + win[sr][di][e] * wv[di * 3 + 2][e]; \
                                        acc[e] = siluf(s); } \
                                    u32x4 o; o.x = pk2(acc[0], acc[1]); o.y = pk2(acc[2], acc[3]); o.z = pk2(acc[4], acc[5]); o.w = pk2(acc[6], acc[7]); \
                                    *(u32x4*)(ob + (size_t)gc * DI) = o; } \
                                ++gc; } while (0)
                        int gc = gc0;
                        CV_LOADCOL(0, gc0 - 1); CV_LOADCOL(1, gc0);
#pragma unroll 1
                        for (int g3 = 0; g3 < 11; ++g3) { CV_STEP(0, 1, 2); CV_STEP(1, 2, 0); CV_STEP(2, 0, 1); }
#undef CV_LOADCOL
#undef CV_STEP
                    }
                    for (int i = gt; i < LAT0 * (DI / 8); i += NGT) {
                        const int q = i / (DI / 8), c0 = (i % (DI / 8)) * 8, t = q % CT;
                        float acc[8];
#pragma unroll
                        for (int e = 0; e < 8; ++e) acc[e] = bc[c0 + e];
#pragma unroll
                        for (int dj = 0; dj < 3; ++dj) { const int tt = t + dj - 1; if (tt < 0 || tt >= CT) continue;
                            const u32x4 xv = *(const u32x4*)(S0 + (size_t)(q + dj - 1) * DI + c0); const float* w = wc + (size_t)(3 + dj) * DI + c0;
                            acc[0] += bflo(xv.x) * w[0]; acc[1] += bfhi(xv.x) * w[1]; acc[2] += bflo(xv.y) * w[2]; acc[3] += bfhi(xv.y) * w[3];
                            acc[4] += bflo(xv.z) * w[4]; acc[5] += bfhi(xv.z) * w[5]; acc[6] += bflo(xv.w) * w[6]; acc[7] += bfhi(xv.w) * w[7]; }
                        u32x4 o; o.x = pk2(siluf(acc[0]), siluf(acc[1])); o.y = pk2(siluf(acc[2]), siluf(acc[3])); o.z = pk2(siluf(acc[4]), siluf(acc[5])); o.w = pk2(siluf(acc[6]), siluf(acc[7]));
                        *(u32x4*)(S1 + (size_t)q * DI + c0) = o;
                    }
 }
                    SEAM(hb + 1);
                }
                if (IN(hb + 2)) { PH_BEGIN();
 for (int rp_ = 0; rp_ < REPN(0); ++rp_) {
                    { pg8::Gemm g{WV, S0 + (size_t)LAT0 * DI, DH, DI, DH, (long)DH * DH, DH, DH / 256, LH / 256, NH};
                      pg8::EpiStore E{S2, 0, 0, 0, 3, LAT0};
                      pg8::gemm_phase(lds, g, E, G, bx, tid); if (DUP_MIX) pg8::gemm_phase(lds, g, E, G, bx, tid); }
                    { SmallGemm sg{WV, S0, DH, DI, DH, DH, DH, 0, 0}; SmallDense sd{S2, 0, 0, DH / 64, LAT0 / 64, 0, (long)DH * DH, DH, 3}; gemm_small_dense(lds, sg, sd, NH, G, bx, tid); if (DUP_CTX) gemm_small_dense(lds, sg, sd, NH, G, bx, tid); }
                    {
                      SmallGemm sg{S1, GATET, DI, 4096, 1024, 1024, 1024, 0, 0};
                      const long xm_off = (long)(S0 - S1);
                      auto dec = [=](int uq, long& ao, long& bo) { const int u = uq >> 2, q = uq & 3; ao = (long)u * 64 * DI + (q & 1) * 1024 + (q >> 1) * xm_off; bo = q * 1024; };
                      auto epi = [=](int uq, int m, int n, const f32x4& v) { const int u = uq >> 2, q = uq & 3; if (n < 16) *(f32x4*)(PREQ + (size_t)q * RH * 16 + ((size_t)u * 64 + m) * 16 + n) = v; };
                      gemm_small(lds, sg, NCH * 4, dec, epi, G, bx, tid); }
 }
                    SEAM(hb + 2);
                }
                if (IN(hb + 3)) { PH_BEGIN();
 for (int rp_ = 0; rp_ < REPN(0); ++rp_) {
                    { pg8::Gemm g{S1 + (size_t)LAT0 * DI, WQ, DI, DH, DH, DH, (long)DH * DH, LH / 256, DH / 256, NH}; pg8::EpiStore E{S3, DH, DI, 0, 1, LAT0}; pg8::gemm_phase(lds, g, E, G, bx, tid); if (DUP_MIX) pg8::gemm_phase(lds, g, E, G, bx, tid); }
                    { SmallGemm sg{S1, WQ, DI, DH, DH, DH, DH, 0, 0}; SmallDense sd{S3, DH, DI, LAT0 / 64, DH / 64, 0, DH, (long)DH * DH, 1}; gemm_small_dense(lds, sg, sd, NH, G, bx, tid); if (DUP_CTX) gemm_small_dense(lds, sg, sd, NH, G, bx, tid); }
                    { pg8::Gemm g{S1 + (size_t)LAT0 * DI, WK, DI, DH, DH, DH, (long)DH * DH, LH / 256, DH / 256, NH}; pg8::EpiStore E{S0 + (size_t)LAT0 * DI, DH, DI, 0}; pg8::gemm_phase(lds, g, E, G, bx, tid); if (DUP_MIX) pg8::gemm_phase(lds, g, E, G, bx, tid); }
                    { SmallGemm sg{S1, WK, DI, DH, DH, DH, DH, 0, 0}; SmallDense sd{S0, DH, DI, LAT0 / 64, DH / 64, 0, DH, (long)DH * DH}; gemm_small_dense(lds, sg, sd, NH, G, bx, tid); if (DUP_CTX) gemm_small_dense(lds, sg, sd, NH, G, bx, tid); }
                    { pg8::Gemm g{WK, S1 + (size_t)LAT0 * DI, DH, DI, DH, (long)DH * DH, DH, DH / 256, LH / 256, NH}; pg8::EpiStore E{S4, (long)DH * RH, RH, 0, 2, LAT0}; pg8::gemm_phase(lds, g, E, G, bx, tid); if (DUP_MIX) pg8::gemm_phase(lds, g, E, G, bx, tid); }
                    { SmallGemm sg{WK, S1, DH, DI, DH, DH, DH, 0, 0}; SmallDense sd{S4, (long)DH * RH, RH, DH / 64, LAT0 / 64, 0, (long)DH * DH, DH, 2}; gemm_small_dense(lds, sg, sd, NH, G, bx, tid); if (DUP_CTX) gemm_small_dense(lds, sg, sd, NH, G, bx, tid); }
                    if (bx < 128) {
                        const int sc = bx >> 3, part = bx & 7, bl = sc >> 3, hh = (sc >> 1) & 3, dir = sc & 1;
                        unsigned* g12cnt = (unsigned*)(ws + WS_CTL + 4096) + ((jl * 2 + half) * 16 + sc) * 16;
                        unsigned* g12tot = (unsigned*)(ws + WS_PRE) + (size_t)((jl * 2 + half) * 16 + sc) * 132 * 2;
                        LAS float* bcs = (LAS float*)lds;
                        LAS float* vss = bcs + 132 * 64;
                        LAS float* bl_ = vss + 132 * 64;
                        LAS float* vm_ = bl_ + 132;
                        LAS float* mi_ = vm_ + 132;
                        const int u = lane, p = dir ? 63 - u : u;
                        const float* bgp = ka->in[I_BGATE] + (size_t)jl * 16 + 8 * dir + hh;
#pragma unroll
                        for (int ii = 0; ii < 3; ++ii) { const int i = part + 8 * ii; const int j = wave + 8 * i;
                            if (i < 17 && j < 132) { int row0; if (j < 4) { const int c = dir ? 3 - j : j; row0 = bl * CT + c * 64; } else { const int c = dir ? 127 - (j - 4) : (j - 4); row0 = LAT0 + bl * T + c * 64; }
                                const float* pr = PREQ + (size_t)(row0 + p) * 16 + 8 * dir + hh; const size_t qs = (size_t)RH * 16;
                                bcs[j * 64 + p] = (pr[4] + pr[qs + 4]) + (pr[2 * qs + 4] + pr[3 * qs + 4]) + bgp[4]; vss[j * 64 + p] = (pr[0] + pr[qs]) + (pr[2 * qs] + pr[3 * qs]) + bgp[0]; } }
                        asm volatile("s_waitcnt vmcnt(0) lgkmcnt(0)" ::: "memory");
#pragma unroll 1
                        for (int ii = 0; ii < 3; ++ii) { const int i = part + 8 * ii; const int j = wave + 8 * i;
                            if (i < 17 && j < 132) { const float f = bcs[j * 64 + p], lia = vss[j * 64 + p]; float x = fminf(f, 0.f) - log1pf(__expf(-fabsf(f)));
                                x = scan_add64(x);
                                const float v = lia - x; float pm = v;
                                pm = scan_max64(pm);
                                bcs[j * 64 + p] = x; vss[j * 64 + p] = v;
                                if (u == 63) { __hip_atomic_store(g12tot + 2 * j, __builtin_bit_cast(unsigned, x), __ATOMIC_RELAXED, __HIP_MEMORY_SCOPE_AGENT); __hip_atomic_store(g12tot + 2 * j + 1, __builtin_bit_cast(unsigned, pm), __ATOMIC_RELAXED, __HIP_MEMORY_SCOPE_AGENT); } } }
                        asm volatile("s_waitcnt vmcnt(0)" ::: "memory");
                        __syncthreads();
                        if (tid == 0) { (void)xb_add(g12cnt, 1u); unsigned sp_ = 0u; while (xb_ld(g12cnt) < 8u && ++sp_ < XB_SPIN_CAP) __builtin_amdgcn_s_sleep(1); }
                        __syncthreads();
                        if (tid < 132) { bl_[tid] = __builtin_bit_cast(float, xb_ld(g12tot + 2 * tid)); vm_[tid] = __builtin_bit_cast(float, xb_ld(g12tot + 2 * tid + 1)); }
                        __syncthreads();
                        if (wave == 0) {
                            const float ni = -__builtin_inff();
                            float ea[3], eb[3];
#pragma unroll
                            for (int t = 0; t < 3; ++t) { const int j = 3 * lane + t; const bool ok = j < 132; const float blj = bl_[ok ? j : 0], vmj = vm_[ok ? j : 0]; ea[t] = ok ? blj : 0.f; eb[t] = ok ? blj + vmj : ni; }
                            float A = ea[0] + ea[1], B = fmaxf(eb[0] + ea[1], eb[1]); B = fmaxf(B + ea[2], eb[2]); A += ea[2];
#define G12_STEP(CTRL, RM) do { const float pa_ = dppf<CTRL, RM>(0.f, A), pb_ = dppf<CTRL, RM>(ni, B); B = fmaxf(pb_ + A, B); A += pa_; } while (0)
                            G12_STEP(0x111, 0xF); G12_STEP(0x112, 0xF); G12_STEP(0x114, 0xF); G12_STEP(0x118, 0xF); G12_STEP(0x142, 0xA); G12_STEP(0x143, 0xC);
#undef G12_STEP
                            float EA = shup(A, 1, lane), EB = shup(B, 1, lane); if (lane == 0) { EA = 0.f; EB = ni; }
                            float m = fmaxf(EA, EB);
#pragma unroll
                            for (int t = 0; t < 3; ++t) { const int j = 3 * lane + t; if (j < 132) { mi_[j] = m; m = fmaxf(m + ea[t], eb[t]); } }
                        }
                        __syncthreads();
                        float* GPw = (float*)(YH + (size_t)NCH * 4 * 2 * 4096);
#pragma unroll 1
                        for (int ii = 0; ii < 3; ++ii) { const int i = part + 8 * ii; const int j = wave + 8 * i;
                            if (i < 17 && j < 132) { int row0; if (j < 4) { const int c = dir ? 3 - j : j; row0 = bl * CT + c * 64; } else { const int c = dir ? 127 - (j - 4) : (j - 4); row0 = LAT0 + bl * T + c * 64; }
                                const float bc = bcs[j * 64 + p], v = vss[j * 64 + p]; float pm = v;
                                pm = scan_max64(pm);
                                const float m_in = mi_[j], btot = bl_[j], m_new = btot + fmaxf(m_in, vm_[j]);
                                const float uu = -fmaxf(m_in, pm);
                                float* gp = GPw + ((size_t)((row0 >> 6) * 4 + hh) * 2 + dir) * 384;
                                gp[p] = uu; gp[64 + p] = v; gp[128 + p] = __expf(m_in + uu); gp[192 + p] = __expf(uu - bc); ((bf16_t*)(gp + 324))[p] = (bf16_t)f2bf(__expf(btot - m_new + v));
                                if (u == 0) gp[320] = __expf(btot + m_in - m_new); } }
                    }
 }
                    SEAM(hb + 3);
                }
                if (IN(hb + 4)) { PH_BEGIN();
 for (int rp_ = 0; rp_ < REPN(4); ++rp_) {
                    SmallGemm sg{S3, S0, DI, DI, DH, DH, DH, 0, 0, 1};
                    bf16_t* SGw = YH; const float* GPr = (const float*)(YH + (size_t)NCH * 4 * 2 * 4096);
                    auto dec = [=](int u, long& ao, long& bo) { const int ch = u >> 2, hh = u & 3; ao = u; bo = (long)ch * 64 * DI + hh * DH; };
                    auto epi = [=](int u, int m, int n, const f32x4& v) {
#pragma unroll
                        for (int dir = 0; dir < 2; ++dir) { const float* gp = GPr + ((size_t)u * 2 + dir) * 384; const float up = gp[m]; const f32x4 vs = *(const f32x4*)(gp + 64 + n); float o[4];
#pragma unroll
                            for (int i = 0; i < 4; ++i) { const int s = n + i; const bool ok = dir ? (s >= m) : (s <= m); const float gte = ok ? __expf(up + vs[i]) : 0.f; o[i] = v[i] * gte; }
                            u32x2 w; w.x = pk2(o[0], o[1]); w.y = pk2(o[2], o[3]);
                            *(u32x2*)(SGw + ((size_t)u * 2 + dir) * 4096 + ((m >> 4) * 2 + (n >> 5)) * 512 + (((n >> 3) & 3) * 16 + (m & 15)) * 8 + (n & 7)) = w; } };
                    gemm_small(lds, sg, NCH * 4, dec, epi, G, bx, tid);
 }
                    SEAM(hb + 4);
                }
                if (EN_SCAN && IN(hb + 5)) { PH_BEGIN();
                    scan_phase(lds, ws, half, bar, tid, lane, wave, bx);
                    SEAM(hb + 5);
                }
                if (IN(hb + 6)) { PH_BEGIN();
 for (int rp_ = 0; rp_ < REPN(0); ++rp_) {
                    pg8::Gemm g{HH, WIN + (size_t)DI * D, D, D, D, 0, 0, LH / 256, DI / 256, 1};
                    pg8::EpiStore E{S3 + (size_t)LAT0 * DI, 0, DI, 0};
                    pg8::gemm_phase(lds, g, E, G, bx, tid); if (DUP_MIX) pg8::gemm_phase(lds, g, E, G, bx, tid);
                    if (layer < 2) { SmallGemm sg{HHC, WIN + (size_t)DI * D, D, D, D, D, D, 0, 0}; SmallDense sd{S3, 0, DI, LAT0 / 64, DI / 64, 0, 0, 0}; gemm_small_dense(lds, sg, sd, 1, G, bx, tid); if (DUP_CTX) gemm_small_dense(lds, sg, sd, 1, G, bx, tid); }
 }
                    SEAM(hb + 6);
                }
                if (IN(hb + 7)) { PH_BEGIN();
 for (int rp_ = 0; rp_ < REPN(3); ++rp_) {
                    const float* gn = ka->in[I_GNW] + (size_t)jl * DI; const float* sk = ka->in[I_SKIP] + (size_t)jl * DI;
#define RO_LOAD(q_, A, B, XC, ZZ) do { const bf16_t* h2_ = ((q_) < LAT0) ? HCB : S2; \
                        _Pragma("unroll") for (int hd = 0; hd < 4; ++hd) { const size_t ho_ = htile_off(q_, hd, 8 * lane); const size_t ro_ = (size_t)(q_) * DI + hd * DH + 8 * lane; \
                            A[hd] = *(const u32x4*)(S0 + ho_); B[hd] = *(const u32x4*)(h2_ + ho_); XC[hd] = *(const u32x4*)(S1 + ro_); ZZ[hd] = *(const u32x4*)(S3 + ro_); } } while (0)
                    u32x4 ra[4], rb[4], rx[4], rz[4], na[4], nb[4], nx[4], nz[4];
#pragma unroll
                    for (int hd = 0; hd < 4; ++hd) { ra[hd] = (u32x4){0u, 0u, 0u, 0u}; rb[hd] = ra[hd]; rx[hd] = ra[hd]; rz[hd] = ra[hd]; na[hd] = ra[hd]; nb[hd] = ra[hd]; nx[hd] = ra[hd]; nz[hd] = ra[hd]; }
                    const int q_first = (layer < 2 ? 0 : LAT0) + gw;
                    if (q_first < RH) RO_LOAD(q_first, ra, rb, rx, rz);
                    for (int q = q_first; q < RH; q += NGW) {
                        if (q + NGW < RH) RO_LOAD(q + NGW, na, nb, nx, nz);
#pragma unroll
                        for (int hd = 0; hd < 4; ++hd) {
                            const int c0 = hd * DH + 8 * lane;
                            const u32x4 a = ra[hd], b = rb[hd];
                            float v[8] = {bflo(a.x) + bflo(b.x), bfhi(a.x) + bfhi(b.x), bflo(a.y) + bflo(b.y), bfhi(a.y) + bfhi(b.y), bflo(a.z) + bflo(b.z), bfhi(a.z) + bfhi(b.z), bflo(a.w) + bflo(b.w), bfhi(a.w) + bfhi(b.w)};
                            float s = 0.f;
#pragma unroll
                            for (int i = 0; i < 8; ++i) s += v[i];
                            const float mean = wave_sum(s, lane) * (1.f / DH); float s2 = 0.f;
#pragma unroll
                            for (int i = 0; i < 8; ++i) { v[i] -= mean; s2 += v[i] * v[i]; }
                            const float rstd = __builtin_amdgcn_rsqf(wave_sum(s2, lane) * (1.f / DH) + LN_EPS);
                            const u32x4 xc = rx[hd], zz = rz[hd];
                            const float xcf[8] = {bflo(xc.x), bfhi(xc.x), bflo(xc.y), bfhi(xc.y), bflo(xc.z), bfhi(xc.z), bflo(xc.w), bfhi(xc.w)};
                            const float zf[8] = {bflo(zz.x), bfhi(zz.x), bflo(zz.y), bfhi(zz.y), bflo(zz.z), bfhi(zz.z), bflo(zz.w), bfhi(zz.w)};
                            float o[8];
#pragma unroll
                            for (int i = 0; i < 8; ++i) o[i] = (v[i] * rstd * gn[c0 + i] + sk[c0 + i] * xcf[i]) * siluf(zf[i]);
                            u32x4 w; w.x = pk2(o[0], o[1]); w.y = pk2(o[2], o[3]); w.z = pk2(o[4], o[5]); w.w = pk2(o[6], o[7]);
                            *(u32x4*)(S4 + (size_t)q * DI + c0) = w;
                        }
#pragma unroll
                        for (int hd = 0; hd < 4; ++hd) { ra[hd] = na[hd]; rb[hd] = nb[hd]; rx[hd] = nx[hd]; rz[hd] = nz[hd]; }
                    }
#undef RO_LOAD
 }
                    SEAM(hb + 7);
                }
                if (IN(hb + 8)) { PH_BEGIN();
 for (int rp_ = 0; rp_ < REPN(0); ++rp_) {
                    pg8::Gemm g{S4 + (size_t)LAT0 * DI, WOUT, DI, DI, DI, 0, 0, LH / 256, D / 256, 1};
                    pg8::EpiStore E{YH, 0, D, 0};
                    pg8::gemm_phase(lds, g, E, G, bx, tid); if (DUP_MIX) pg8::gemm_phase(lds, g, E, G, bx, tid);
                    if (layer < 2) { SmallGemm sg{S4, WOUT, DI, DI, DI, DI, DI, 0, 0}; SmallDense sd{YHC, 0, D, LAT0 / 64, D / 64, 0, 0, 0}; gemm_small_dense(lds, sg, sd, 1, G, bx, tid); if (DUP_CTX) gemm_small_dense(lds, sg, sd, 1, G, bx, tid); }
 }
                    SEAM(hb + 8);
                }
            }
        } else if (EN_FOUR) {
            const bool has_ctx = layer < 3;
            if (IN(pb + 2)) { PH_BEGIN();
 for (int rp_ = 0; rp_ < REPN(2); ++rp_) {
                { pg8::Gemm g{(const bf16_t*)(ws + TAB_A1), HT, 256, 256, 256, 0, (long)D * T, 2, 128, NB};
                  pg8::EpiStore E{PB, (long)512 * 32768, 32768, 0};
                  pg8::gemm_phase(lds, g, E, G, bx, tid); if (DUP_MIX) pg8::gemm_phase(lds, g, E, G, bx, tid); }
                if (has_ctx) {
                    SmallGemm sg{(const bf16_t*)(ws + TAB_ACTX), HTC, 256, 256, 256, 256, 256, 0, 0};
                    auto dec = [=](int u, long& ao, long& bo) { const int b = u / 128, mb = (u / 16) % 8, cht = u % 16; ao = (long)mb * 64 * 256; bo = ((long)b * D + cht * 64) * CT; };
                    auto epi = [=](int u, int m, int n, const f32x4& v) { const int b = u / 128, mb = (u / 16) % 8, cht = u % 16; const int mg = mb * 64 + m, ri = mg >> 8, tp = mg & 255, ch = cht * 64 + n;
                        u32x2 w; w.x = pk2(v[0], v[1]); w.y = pk2(v[2], v[3]); *(u32x2*)(WC + (size_t)ctx_row(b, tp) * DI + (ch >> 8) * 512 + ri * 256 + (ch & 255)) = w; };
                    gemm_small(lds, sg, NB * 8 * 16, dec, epi, G, bx, tid);
                }
 }
                SEAM(pb + 2);
            }
            if (IN(pb + 3)) { PH_BEGIN();
 for (int rp_ = 0; rp_ < REPN(2); ++rp_) {
                {
                    const int wid = tid >> 6, wm = wid >> 1, wn = wid & 1, fr = lane & 15, fq = lane >> 4;
                    const int lrow = tid >> 3, lk = (tid & 7) * 8;
                    const unsigned stoff = (unsigned)(lrow * SG_LD + lk) * 2u;
                    LAS unsigned char* As = lds; LAS unsigned char* Bs0 = lds + SG_TILE; LAS unsigned char* Bs1 = lds + 2 * SG_TILE;
                    const bf16_t* A2 = (const bf16_t*)(ws + TAB_A2);
                    for (int pair = bx; pair < NB * 256; pair += G) {
                        const int b = pair >> 8, t1p = pair & 255;
                        const bf16_t* bp = PB + (size_t)b * 512 * 32768 + (size_t)((lk >> 5) * 256 + t1p) * 32768 + (size_t)lrow * 32 + (lk & 31);
                        u32x4 r0 = *(const u32x4*)(bp), r1 = *(const u32x4*)(bp + 2048), r2 = *(const u32x4*)(bp + 2 * 2048), r3 = *(const u32x4*)(bp + 3 * 2048);
                        *(LAS u32x4*)(As + stoff) = *(const u32x4*)(A2 + (size_t)t1p * 4096 + lrow * 64 + lk);
                        *(LAS u32x4*)(Bs0 + stoff) = r0;
                        LDS_BARRIER();
                        bf16x8 af[2];
#pragma unroll
                        for (int ks = 0; ks < 2; ++ks) af[ks] = *(const LAS bf16x8*)(As + ((wm * 16 + fr) * SG_LD + ks * 32 + fq * 8) * 2);
#define F2_TILE(ct_, BsC, BsN, rcur, rnext) do { \
                            if ((ct_) + 4 < 16) rcur = *(const u32x4*)(bp + ((ct_) + 4) * 2048); \
                            f32x4 acc[2] = {(f32x4){0.f, 0.f, 0.f, 0.f}, (f32x4){0.f, 0.f, 0.f, 0.f}}; \
                            _Pragma("unroll") for (int ks = 0; ks < 2; ++ks) _Pragma("unroll") for (int nt = 0; nt < 2; ++nt) { \
                                const bf16x8 bf = *(const LAS bf16x8*)(BsC + ((wn * 32 + nt * 16 + fr) * SG_LD + ks * 32 + fq * 8) * 2); \
                                acc[nt] = __builtin_amdgcn_mfma_f32_16x16x32_bf16(bf, af[ks], acc[nt], 0, 0, 0); } \
                            if ((ct_) + 1 < 16) *(LAS u32x4*)(BsN + stoff) = rnext; \
                            _Pragma("unroll") for (int nt = 0; nt < 2; ++nt) { const int m = wm * 16 + fr, n = wn * 32 + nt * 16 + fq * 4, rip = m >> 5, t2p = m & 31, ch = (ct_) * 64 + n; \
                                u32x2 w2; w2.x = pk2(acc[nt][0], acc[nt][1]); w2.y = pk2(acc[nt][2], acc[nt][3]); \
                                *(u32x2*)(WC + (size_t)lat_row(b, t1p + 256 * t2p) * DI + (ch >> 8) * 512 + rip * 256 + (ch & 255)) = w2; } \
                            LDS_BARRIER(); } while (0)
#pragma unroll 1
                        for (int ct = 0; ct < 16; ct += 4) { F2_TILE(ct, Bs0, Bs1, r0, r1); F2_TILE(ct + 1, Bs1, Bs0, r1, r2); F2_TILE(ct + 2, Bs0, Bs1, r2, r3); F2_TILE(ct + 3, Bs1, Bs0, r3, r0); }
#undef F2_TILE
                    }
                }
 }
                SEAM(pb + 3);
            }
            if (IN(pb + 4)) { PH_BEGIN();
 for (int rp_ = 0; rp_ < REPN(2); ++rp_) {
                pg8::Gemm g{WC + (size_t)CR * DI, (const bf16_t*)(ws + TAB_BZ), DI, 512, 512, 512, 0, (R - CR) / 256, 1, 4};
                pg8::EpiStore E{ZF + (size_t)CR * D, 256, D, 0};
                pg8::gemm_phase(lds, g, E, G, bx, tid); if (DUP_MIX) pg8::gemm_phase(lds, g, E, G, bx, tid);
                if (has_ctx) { SmallGemm sg{WC, (const bf16_t*)(ws + TAB_BZ), DI, 512, 512, 512, 512, 0, 0}; SmallDense sd{ZF, 256, D, CR / 64, 256 / 64, 0, 512, 0}; gemm_small_dense(lds, sg, sd, 4, G, bx, tid); if (DUP_CTX) gemm_small_dense(lds, sg, sd, 4, G, bx, tid); }
 }
                SEAM(pb + 4);
            }
            if (IN(pb + 5)) { PH_BEGIN();
 for (int rp_ = 0; rp_ < REPN(2); ++rp_) {
                pg8::Gemm g{ZF + (size_t)CR * D, WOUT, D, D, D, 0, 0, (R - CR) / 256, D / 256, 1};
                pg8::EpiStore E{YB + (size_t)CR * D, 0, D, 0};
                pg8::gemm_phase(lds, g, E, G, bx, tid); if (DUP_MIX) pg8::gemm_phase(lds, g, E, G, bx, tid);
                if (has_ctx) { SmallGemm sg{ZF, WOUT, D, D, D, D, D, 0, 0}; SmallDense sd{YB, 0, D, CR / 64, D / 64, 0, 0, 0}; gemm_small_dense(lds, sg, sd, 1, G, bx, tid); if (DUP_CTX) gemm_small_dense(lds, sg, sd, 1, G, bx, tid); }
 }
                SEAM(pb + 5);
            }
        }
#pragma unroll 1
        for (int which = 0; which < 2; ++which) {
            const int pid = pb + (which == 0 ? 19 : 22);
            if (EN_NORM && IN(pid)) { PH_BEGIN();
                const float* pg = ka->in[I_PG] + ((size_t)layer * 2 + which) * D; const float* pbv = ka->in[I_PB] + ((size_t)layer * 2 + which) * D;
                const int mlayer = which == 0 ? layer : layer + 1;
                const int shoff = which == 0 ? 3 * D : 0;
                const int goff = which == 0 ? 2 * D : 5 * D;
                const bool in_f32 = (layer == 0 && which == 0), out_f32 = (layer == 3 && which == 1);
                bf16_t* xbl = (bf16_t*)ka->out; bf16_t* xb3 = S4;
#define NR_LOAD(r_, XW, YW) do { const RowInfo ri_ = row_info(r_); const size_t xi_ = ri_.is_ctx ? ((size_t)ri_.b * CT + ri_.t) * D : ((size_t)ri_.b * T + ri_.t) * D; \
                    const bf16_t* yr_ = YB + (size_t)(r_) * D; \
                    if (in_f32) { const float* xp_ = (ri_.is_ctx ? ka->in[I_CTX] : ka->in[I_X]) + xi_; _Pragma("unroll") for (int j = 0; j < 4; ++j) XW[j] = *(const u32x4*)(xp_ + 256 * j + 4 * lane); } \
                    else { const bf16_t* xp_ = ri_.is_ctx ? (const bf16_t*)CTXX + xi_ : ((layer == 3 && which == 1) ? xb3 + xi_ : xbl + xi_); \
                        _Pragma("unroll") for (int j = 0; j < 4; ++j) { const u32x2 t_ = *(const u32x2*)(xp_ + 256 * j + 4 * lane); XW[j] = (u32x4){t_.x, t_.y, 0u, 0u}; } } \
                    _Pragma("unroll") for (int j = 0; j < 4; ++j) YW[j] = *(const u32x2*)(yr_ + 256 * j + 4 * lane); } while (0)
                if (which == 1 && (layer & 1) == 0) {
                    constexpr int TLD = 1026;
                    LAS bf16_t* TL = (LAS bf16_t*)lds;
                    const float* md2b = MOD + ((size_t)mlayer * 5) * 6 * D + shoff;
#define NT_ROW(r_, i_) do { const RowInfo ri = row_info(r_); const int mi = ri.is_ctx ? 4 : ri.b; \
                        const size_t xi = ri.is_ctx ? ((size_t)ri.b * CT + ri.t) * D : ((size_t)ri.b * T + ri.t) * D; \
                        bf16_t* xout16 = ri.is_ctx ? (bf16_t*)CTXX + xi : xbl + xi; \
                        const float* md = MOD + ((size_t)layer * 5 + mi) * 6 * D; f32x4 v[4]; \
                        _Pragma("unroll") for (int j = 0; j < 4; ++j) { const int c = 256 * j + 4 * lane; const f32x4 x = (f32x4){bflo(xw[j].x), bfhi(xw[j].x), bflo(xw[j].y), bfhi(xw[j].y)}; \
                            const f32x4 gt = *(const f32x4*)(md + goff + c); const f32x4 y = (f32x4){bflo(yw[j].x), bfhi(yw[j].x), bflo(yw[j].y), bfhi(yw[j].y)}; v[j] = x * ALPHA + gt * y; } \
                        ln_norm(v, lane); \
                        _Pragma("unroll") for (int j = 0; j < 4; ++j) { const int c = 256 * j + 4 * lane; v[j] = v[j] * *(const f32x4*)(pg + c) + *(const f32x4*)(pbv + c); \
                            u32x2 xo; xo.x = pk2(v[j][0], v[j][1]); xo.y = pk2(v[j][2], v[j][3]); *(u32x2*)(xout16 + c) = xo; } \
                        ln_norm(v, lane); \
                        const float* md2 = md2b + (size_t)mi * 6 * D; \
                        _Pragma("unroll") for (int j = 0; j < 4; ++j) { const int c = 256 * j + 4 * lane; const f32x4 sh = *(const f32x4*)(md2 + c), sc = *(const f32x4*)(md2 + D + c); \
                            const f32x4 h = v[j] * (1.0f + sc) + sh; LAS unsigned* d_ = (LAS unsigned*)(TL + (i_) * TLD + c); d_[0] = pk2(h[0], h[1]); d_[1] = pk2(h[2], h[3]); } } while (0)
                    u32x4 xw[4], xn[4]; u32x2 yw[4], yn[4];
#pragma unroll
                    for (int j = 0; j < 4; ++j) { xw[j] = (u32x4){0u, 0u, 0u, 0u}; xn[j] = xw[j]; yw[j] = (u32x2){0u, 0u}; yn[j] = yw[j]; }
                    for (int item = bx; item < NB * 32 * 4; item += G) {
                        const int b = item >> 7, t2 = (item >> 2) & 31, tb = item & 3;
                        const int rbase = lat_row(b, 32 * (64 * tb + wave * 8) + t2);
                        NR_LOAD(rbase, xw, yw);
#pragma unroll 1
                        for (int j8 = 0; j8 < 8; ++j8) {
                            if (j8 < 7) NR_LOAD(rbase + 32 * (j8 + 1), xn, yn);
                            NT_ROW(rbase + 32 * j8, wave * 8 + j8);
#pragma unroll
                            for (int j = 0; j < 4; ++j) { xw[j] = xn[j]; yw[j] = yn[j]; }
                        }
                        LDS_BARRIER();
#pragma unroll 4
                        for (int k = 0; k < 16; ++k) { const int idx = k * NTHR + tid, g8 = idx & 7, ch = idx >> 3; const LAS bf16_t* s = TL + (8 * g8) * TLD + ch;
                            u32x4 o; o.x = (unsigned)s[0] | ((unsigned)s[TLD] << 16); o.y = (unsigned)s[2 * TLD] | ((unsigned)s[3 * TLD] << 16); o.z = (unsigned)s[4 * TLD] | ((unsigned)s[5 * TLD] << 16); o.w = (unsigned)s[6 * TLD] | ((unsigned)s[7 * TLD] << 16);
                            *(u32x4*)(HT + (((size_t)b * D + ch) * 32 + t2) * 256 + 64 * tb + 8 * g8) = o; }
                        LDS_BARRIER();
                    }
                    if (layer < 2) {
                        for (int item = bx; item < NB * (CT / 8); item += G) {
                            const int b = item / (CT / 8), t8 = item % (CT / 8);
                            const int r = ctx_row(b, 8 * t8 + wave);
                            NR_LOAD(r, xw, yw);
                            NT_ROW(r, wave);
                            LDS_BARRIER();
#pragma unroll
                            for (int k = 0; k < 2; ++k) { const int ch = k * NTHR + tid; const LAS bf16_t* s = TL + ch;
                                u32x4 o; o.x = (unsigned)s[0] | ((unsigned)s[TLD] << 16); o.y = (unsigned)s[2 * TLD] | ((unsigned)s[3 * TLD] << 16); o.z = (unsigned)s[4 * TLD] | ((unsigned)s[5 * TLD] << 16); o.w = (unsigned)s[6 * TLD] | ((unsigned)s[7 * TLD] << 16);
                                *(u32x4*)(HTC + ((size_t)b * D + ch) * CT + 8 * t8) = o; }
                            LDS_BARRIER();
                        }
                    }
#undef NT_ROW
                } else {
                const int r_first = (layer < 2 ? 0 : CR) + gw;
                u32x4 xw[4], xn[4]; u32x2 yw[4], yn[4];
#pragma unroll
                for (int j = 0; j < 4; ++j) { xw[j] = (u32x4){0u, 0u, 0u, 0u}; xn[j] = xw[j]; yw[j] = (u32x2){0u, 0u}; yn[j] = yw[j]; }
                if (r_first < R) NR_LOAD(r_first, xw, yw);
                for (int r = r_first; r < R; r += NGW) {
                    if (r + NGW < R) NR_LOAD(r + NGW, xn, yn);
                    const RowInfo ri = row_info(r);
                    const int mi = ri.is_ctx ? 4 : ri.b;
                    const size_t xi = ri.is_ctx ? ((size_t)ri.b * CT + ri.t) * D : ((size_t)ri.b * T + ri.t) * D;
                    bf16_t* xout16 = ri.is_ctx ? (bf16_t*)CTXX + xi : ((layer == 3 && which == 0) ? xb3 + xi : xbl + xi);
                    const float* md = MOD + ((size_t)layer * 5 + mi) * 6 * D;
                    f32x4 v[4];
#pragma unroll
                    for (int j = 0; j < 4; ++j) { const int c = 256 * j + 4 * lane; f32x4 x; if (in_f32) x = __builtin_bit_cast(f32x4, xw[j]); else x = (f32x4){bflo(xw[j].x), bfhi(xw[j].x), bflo(xw[j].y), bfhi(xw[j].y)};
                        const f32x4 gt = *(const f32x4*)(md + goff + c);
                        const f32x4 y = (f32x4){bflo(yw[j].x), bfhi(yw[j].x), bflo(yw[j].y), bfhi(yw[j].y)}; v[j] = x * ALPHA + gt * y; }
                    ln_norm(v, lane);
#pragma unroll
                    for (int j = 0; j < 4; ++j) { const int c = 256 * j + 4 * lane; v[j] = v[j] * *(const f32x4*)(pg + c) + *(const f32x4*)(pbv + c);
                        if (out_f32) *(f32x4*)(ka->out + xi + c) = v[j]; else { u32x2 xo; xo.x = pk2(v[j][0], v[j][1]); xo.y = pk2(v[j][2], v[j][3]); *(u32x2*)(xout16 + c) = xo; } }
                    if (mlayer < 4) {
                        const float* md2 = MOD + ((size_t)mlayer * 5 + mi) * 6 * D + shoff;
                        ln_norm(v, lane);
                        bf16_t* o = HIN + (size_t)r * D;
#pragma unroll
                        for (int j = 0; j < 4; ++j) { const int c = 256 * j + 4 * lane; const f32x4 sh = *(const f32x4*)(md2 + c), sc = *(const f32x4*)(md2 + D + c);
                            const f32x4 h = v[j] * (1.0f + sc) + sh; u32x2 w; w.x = pk2(h[0], h[1]); w.y = pk2(h[2], h[3]); *(u32x2*)(o + c) = w; }
                    }
#pragma unroll
                    for (int j = 0; j < 4; ++j) { xw[j] = xn[j]; yw[j] = yn[j]; }
                }
                }
#undef NR_LOAD
                SEAM(pid);
            }
            if (EN_MLP && which == 0) {
                if (IN(pb + 20)) { PH_BEGIN();
 for (int rp_ = 0; rp_ < REPN(1); ++rp_) {
                    pg8::Gemm g{HIN + (size_t)CR * D, W1, D, D, D, 0, 0, (R - CR) / 256, DFF / 256, 1};
                    pg8::EpiStore E{HID + (size_t)CR * DFF, 0, DFF, 1};
                    pg8::gemm_phase(lds, g, E, G, bx, tid);
#if DUP_MLP
                    pg8::gemm_phase(lds, g, E, G, bx, tid);
#endif
                    if (layer < 2) { SmallGemm sg{HIN, W1, D, D, D, D, D, 0, 0}; SmallDense sd{HID, 0, DFF, CR / 64, DFF / 64, 1, 0, 0}; gemm_small_dense(lds, sg, sd, 1, G, bx, tid); }
 }
                    SEAM(pb + 20);
                }
                if (IN(pb + 21)) { PH_BEGIN();
 for (int rp_ = 0; rp_ < REPN(1); ++rp_) {
                    pg8::Gemm g{HID + (size_t)CR * DFF, W2, DFF, DFF, DFF, 0, 0, (R - CR) / 256, D / 256, 1, 1};
                    pg8::EpiStore E{YB + (size_t)CR * D, 0, D, 0};
                    pg8::gemm_phase(lds, g, E, G, bx, tid);
#if DUP_MLP
                    pg8::gemm_phase(lds, g, E, G, bx, tid);
#endif
                    if (layer < 2) { SmallGemm sg{HID, W2, DFF, DFF, DFF, DFF, DFF, 0, 0}; SmallDense sd{YB, 0, D, CR / 64, D / 64, 0, 0, 0}; gemm_small_dense(lds, sg, sd, 1, G, bx, tid); }
 }
                    SEAM(pb + 21);
                }
            }
        }
    }
#undef IN
#undef SEAM
}

extern "C" void kernel_launch(void* const* d_in, const int* in_sizes, int n_in, void* d_out, int out_size, void* d_ws, size_t ws_size, hipStream_t stream) {
    static int grid = 0;
    if (grid == 0) {
        if (n_in != 22 || ws_size < 512 * MiB) { fprintf(stderr, "kernel_launch: unexpected n_in %d / ws_size %zu\n", n_in, ws_size); grid = -1; return; }
        int dev = 0, cus = 0;
        if (hipGetDevice(&dev) != hipSuccess || hipDeviceGetAttribute(&cus, hipDeviceAttributeMultiprocessorCount, dev) != hipSuccess) { grid = -1; return; }
        if (hipFuncSetAttribute((const void*)fwd, hipFuncAttributeMaxDynamicSharedMemorySize, LDS_BYTES) != hipSuccess) { fprintf(stderr, "kernel_launch: hipFuncSetAttribute failed\n"); grid = -1; return; }
        int per_cu = 0;
        if (hipOccupancyMaxActiveBlocksPerMultiprocessor(&per_cu, (const void*)fwd, NTHR, LDS_BYTES) != hipSuccess || per_cu < 1) fprintf(stderr, "kernel_launch: occupancy query says %d\n", per_cu);
        (void)hipGetLastError();
        grid = cus;
        if (grid != 256) fprintf(stderr, "kernel_launch: %d CUs (built for 256)\n", grid);
    }
    if (grid < 0) return;
    (void)hipMemsetAsync((char*)d_ws + WS_CTL, 0, CTL_BYTES, stream);
    Args a{};
    for (int i = 0; i < 22; ++i) a.in[i] = (const float*)d_in[i];
    a.out = (float*)d_out; a.ws = (unsigned char*)d_ws;
#if MK_SINGLE
    { int last = 0; for (int id = 0; id < NPHASE; ++id) if (phase_valid(id)) last = id;
      a.ph_lo = 0; a.ph_hi = NPHASE; a.ph_last = last; a.li = 0;
      hipLaunchKernelGGL(fwd, dim3(grid), dim3(NTHR), LDS_BYTES, stream, a); }
#else
    { int li = 0;
      for (int id = 0; id < NPHASE; ++id) { if (!phase_valid(id)) continue;
          a.ph_lo = id; a.ph_hi = id + 1; a.ph_last = id; a.li = li++;
          hipLaunchKernelGGL(fwd, dim3(grid), dim3(NTHR), LDS_BYTES, stream, a); } }
#endif
}
```

```cpp
#include <hip/hip_runtime.h>
#include <cstdio>
#include <cstdint>

#define LAS __attribute__((address_space(3)))
typedef unsigned short bf16_t;
typedef short bf16x8 __attribute__((ext_vector_type(8)));
typedef float f32x4 __attribute__((ext_vector_type(4)));
typedef unsigned u32x4 __attribute__((ext_vector_type(4)));
typedef unsigned u32x2 __attribute__((ext_vector_type(2)));


#ifndef EN_PRO
#define EN_PRO 1
#endif
#ifndef EN_WC
#define EN_WC 1
#endif
#ifndef EN_MIX
#define EN_MIX 1
#endif
#ifndef EN_SCAN
#define EN_SCAN 1
#endif
#ifndef EN_FOUR
#define EN_FOUR 1
#endif
#ifndef EN_NORM
#define EN_NORM 1
#endif
#ifndef EN_MLP
#define EN_MLP 1
#endif
#ifndef DUP_MIX
#define DUP_MIX 0
#endif
#ifndef DUP_CTX
#define DUP_CTX 0
#endif
#ifndef DUP_BAR
#define DUP_BAR 0
#endif
#ifndef DUP_MLP
#define DUP_MLP 0
#endif
#ifndef REP_MASK
#define REP_MASK 0
#endif
#define REPN(bit) (((REP_MASK) >> (bit)) & 1 ? 2 : 1)
#ifndef SC_QPAD
#define SC_QPAD 64
#endif
#ifndef SC_ABL
#define SC_ABL 0
#endif
#ifndef SCAN_REP
#define SCAN_REP 1
#endif
#ifndef MK_SINGLE
#define MK_SINGLE 1
#endif

constexpr int D = 1024, NB = 4, T = 8192, CT = 256, DI = 2048, NH = 4, DH = 512, DFF = 4096;
constexpr int R = NB * (T + CT);
constexpr int RH = R / 2;
constexpr int LAT0 = 2 * CT;
constexpr int NCH = RH / 64;
constexpr float ALPHA = 1.6817928305074290f;
constexpr float LN_EPS = 1e-5f;
constexpr int NWAVES = 8, NTHR = 512;

constexpr size_t MiB = 1u << 20;
constexpr size_t WS_CTL = 0, CTL_BYTES = 2 * MiB;
constexpr size_t WS_MOD = 2 * MiB;
constexpr size_t WS_CTXX = 3 * MiB;
constexpr size_t WS_PRE = 7 * MiB;
constexpr size_t WS_TAB = 10 * MiB;
constexpr size_t TAB_A1 = WS_TAB;
constexpr size_t TAB_A2 = TAB_A1 + 512 * 256 * 2;
constexpr size_t TAB_BZ = TAB_A2 + 256 * 64 * 64 * 2;
constexpr size_t TAB_ACTX = TAB_BZ + 256 * 512 * 2;
constexpr size_t TAB_GATE = TAB_ACTX + 512 * 256 * 2;
static_assert(TAB_GATE + 64 * 4096 * 2 <= 15 * MiB, "tables");
constexpr size_t WS_W = 15 * MiB;
constexpr size_t W_IN = WS_W;
constexpr size_t W_Q = W_IN + 8 * MiB, W_K = W_Q + 2 * MiB, W_V = W_K + 2 * MiB;
constexpr size_t W_OUT = W_V + 2 * MiB;
constexpr size_t W_1 = W_OUT + 4 * MiB;
constexpr size_t W_2 = W_1 + 8 * MiB;
static_assert(W_2 + 8 * MiB <= 49 * MiB, "weights");
constexpr size_t WS_HIN = 49 * MiB;
constexpr size_t WS_YB = 115 * MiB;
constexpr size_t WS_BIG = 181 * MiB;
constexpr size_t SLOT = 66 * MiB;
static_assert(WS_BIG + 5 * SLOT <= 512 * MiB, "workspace");
static_assert((size_t)RH * DI * 2 == SLOT, "slot");

#define LDS_BARRIER() do { asm volatile("s_waitcnt lgkmcnt(0)" ::: "memory"); __builtin_amdgcn_s_barrier(); asm volatile("" ::: "memory"); } while (0)
__device__ __forceinline__ unsigned f2bf(float f) { unsigned u = __builtin_bit_cast(unsigned, f); return (u + 0x7fffu + ((u >> 16) & 1u)) >> 16; }
typedef __bf16 bf16x2_t __attribute__((ext_vector_type(2)));
typedef float f32x2_t __attribute__((ext_vector_type(2)));
__device__ __forceinline__ unsigned pk2(float lo, float hi) { const f32x2_t v = {lo, hi}; return __builtin_bit_cast(unsigned, __builtin_convertvector(v, bf16x2_t)); }
__device__ __forceinline__ float bf2f(unsigned short b) { return __builtin_bit_cast(float, ((unsigned)b) << 16); }
__device__ __forceinline__ float u2f(unsigned u) { return __builtin_bit_cast(float, u); }
__device__ __forceinline__ float bflo(unsigned w) { return __builtin_bit_cast(float, w << 16); }
__device__ __forceinline__ float bfhi(unsigned w) { return __builtin_bit_cast(float, w & 0xffff0000u); }
__device__ __forceinline__ float shx(float v, int mask, int lane) { return __builtin_bit_cast(float, __builtin_amdgcn_ds_bpermute((lane ^ mask) << 2, __builtin_bit_cast(int, v))); }
template <int CTRL, int RMASK> __device__ __forceinline__ float dppf(float idv, float src) { return __builtin_bit_cast(float, __builtin_amdgcn_update_dpp(__builtin_bit_cast(int, idv), __builtin_bit_cast(int, src), CTRL, RMASK, 0xF, false)); }
__device__ __forceinline__ float scan_add64(float x) {
    x += dppf<0x111, 0xF>(0.f, x); x += dppf<0x112, 0xF>(0.f, x); x += dppf<0x114, 0xF>(0.f, x); x += dppf<0x118, 0xF>(0.f, x);
    x += dppf<0x142, 0xA>(0.f, x); x += dppf<0x143, 0xC>(0.f, x); return x; }
__device__ __forceinline__ float scan_max64(float x) {
    const float ni = -__builtin_inff();
    x = fmaxf(x, dppf<0x111, 0xF>(ni, x)); x = fmaxf(x, dppf<0x112, 0xF>(ni, x)); x = fmaxf(x, dppf<0x114, 0xF>(ni, x)); x = fmaxf(x, dppf<0x118, 0xF>(ni, x));
    x = fmaxf(x, dppf<0x142, 0xA>(ni, x)); x = fmaxf(x, dppf<0x143, 0xC>(ni, x)); return x; }
__device__ __forceinline__ float shup(float v, int d, int lane) { return __builtin_bit_cast(float, __builtin_amdgcn_ds_bpermute((lane - d) << 2, __builtin_bit_cast(int, v))); }
__device__ __forceinline__ float wave_sum(float v, int lane) {
    (void)lane;
    return __builtin_bit_cast(float, __builtin_amdgcn_readlane(__builtin_bit_cast(int, scan_add64(v)), 63));
}
__device__ __forceinline__ float siluf(float x) { return x * __builtin_amdgcn_rcpf(1.0f + __expf(-x)); }

struct RowInfo { int is_ctx, b, t; };
__device__ __forceinline__ RowInfo row_info(int r) {
    RowInfo ri;
    if (r < NB * CT) { ri.is_ctx = 1; ri.b = r / CT; ri.t = r % CT; }
    else { ri.is_ctx = 0; const int u = r - NB * CT; ri.b = u / T; ri.t = u % T; }
    return ri;
}
__device__ __forceinline__ int lat_row(int b, int t) { return NB * CT + b * T + t; }
__device__ __forceinline__ int ctx_row(int b, int t) { return b * CT + t; }
constexpr int CR = NB * CT;
constexpr int LH = RH - LAT0;

#define XB_TMO      128
#define XB_XCNT(j)  (256  + 64 * (j))
#define XB_XSUB(j)  (1280 + 64 * (j))
#define XB_XGEN(j)  (2304 + 64 * (j))
#define XB_TOP      3328
#define XB_TOPGEN   3392
#define XCD_BAR_WORDS 3456
#define XB_SPIN_CAP (1u << 18)

__device__ __forceinline__ unsigned xb_ld(unsigned* p)              { return __hip_atomic_load(p, __ATOMIC_RELAXED, __HIP_MEMORY_SCOPE_AGENT); }
__device__ __forceinline__ unsigned xb_add(unsigned* p, unsigned v) { return __hip_atomic_fetch_add(p, v, __ATOMIC_RELAXED, __HIP_MEMORY_SCOPE_AGENT); }
__device__ __forceinline__ unsigned xb_xcc_id() { return (unsigned)__builtin_amdgcn_s_getreg((3 << 11) | 20) & 0xFu; }
#define XB_SPIN(cond, bar) do { unsigned _sp = 0; while (cond) { __builtin_amdgcn_s_sleep(1); \
    if ((++_sp & 255u) == 0u) { if (xb_ld(&(bar)[XB_TMO])) break; if (_sp > XB_SPIN_CAP) { atomicAdd(&(bar)[XB_TMO], 1u); break; } } } } while (0)

struct XcdBarrier { unsigned* bar; unsigned x; volatile LAS unsigned* st; };

__device__ __forceinline__ XcdBarrier xcd_barrier_post(unsigned* bar, volatile LAS unsigned* st) {
    XcdBarrier b; b.bar = bar; b.x = xb_xcc_id(); b.st = st;
    if (threadIdx.x == 0) (void)xb_add(&bar[XB_XCNT(b.x)], 1u);
    return b;
}
__device__ __forceinline__ void xcd_barrier_complete(unsigned* bar, unsigned x, unsigned& nloc, unsigned& nx) {
    const unsigned G = gridDim.x * gridDim.y * gridDim.z;
    unsigned sum, cnt, mine, sp = 0u;
    for (;;) {
        sum = 0u; cnt = 0u; mine = 0u;
#pragma unroll
        for (unsigned j = 0; j < 16; ++j) { const unsigned c = xb_ld(&bar[XB_XCNT(j)]); sum += c; cnt += (c > 0u) ? 1u : 0u; mine = (j == x) ? c : mine; }
        if (sum == G) break;
        __builtin_amdgcn_s_sleep(1);
        if ((++sp & 255u) == 0u) { if (xb_ld(&bar[XB_TMO])) break; if (sp > XB_SPIN_CAP) { atomicAdd(&bar[XB_TMO], 1u); break; } }
    }
    nloc = mine > 0u ? mine : 1u; nx = cnt > 0u ? cnt : 1u;
}
__device__ __forceinline__ void xcd_barrier(const XcdBarrier& b, bool thread0) {
    asm volatile("s_waitcnt vmcnt(0)" ::: "memory");
    __syncthreads();
    if (thread0) {
        unsigned* bar = b.bar;
        __builtin_amdgcn_s_waitcnt(0);
        unsigned nloc = b.st[0], nx = b.st[1];
        if (nloc == 0u) { xcd_barrier_complete(bar, b.x, nloc, nx); b.st[0] = nloc; b.st[1] = nx; }
        const unsigned old = xb_add(&bar[XB_XSUB(b.x)], 1u);
        const unsigned gen = old / nloc;
        if (old + 1u == (gen + 1u) * nloc) {
            __builtin_amdgcn_fence(__ATOMIC_RELEASE, "agent");
            asm volatile("s_waitcnt vmcnt(0)" ::: "memory");
            const unsigned og = xb_add(&bar[XB_TOP], 1u);
            const unsigned tg = og / nx;
            if (og + 1u == (tg + 1u) * nx) xb_add(&bar[XB_TOPGEN], 1u);
            else XB_SPIN(xb_ld(&bar[XB_TOPGEN]) == tg, bar);
            __builtin_amdgcn_fence(__ATOMIC_ACQUIRE, "agent");
            xb_add(&bar[XB_XGEN(b.x)], 1u);
            asm volatile("s_waitcnt vmcnt(0)" ::: "memory");
        } else {
            XB_SPIN(xb_ld(&bar[XB_XGEN(b.x)]) == gen, bar);
            __builtin_amdgcn_fence(__ATOMIC_ACQUIRE, "agent");
            asm volatile("s_waitcnt vmcnt(0)" ::: "memory");
        }
    }
    __syncthreads();
}

__device__ __forceinline__ size_t qtile_off(int q, int h, int cc) {
    const int chunk = q >> 6, p = q & 63, pt = p >> 4, fr = p & 15, w = cc >> 6, ks = (cc >> 5) & 1, fq = (cc >> 3) & 3;
    const size_t blk = ((((size_t)chunk * 4 + h) * 8 + w) * 4 + pt) * 2 + ks;
    return blk * 512 + (size_t)(fq * 16 + fr) * 8 + (cc & 7);
}
__device__ __forceinline__ size_t ktile_off(int d, int h, int q) {
    const int chunk = q >> 6, s = q & 63, ks = s >> 5, fq = (s >> 3) & 3, w = d >> 6, dd = d & 63, mt = 2 * (dd >> 5) + ((dd >> 2) & 1), frp = 4 * ((dd >> 3) & 3) + (dd & 3);
    const size_t blk = ((((size_t)chunk * 4 + h) * 8 + w) * 4 + mt) * 2 + ks;
    return blk * 512 + (size_t)(fq * 16 + frp) * 8 + (s & 7);
}

__device__ __forceinline__ size_t vtile_off(int e, int h, int q) {
    const int chunk = q >> 6, s = q & 63, slice = e >> 5, e5 = e & 31, nt = e5 >> 4, fr = e5 & 15, ks = s >> 5, fq = (s >> 3) & 3;
    const size_t blk = ((((size_t)chunk * 4 + h) * 16 + slice) * 2 + nt) * 2 + ks;
    return blk * 512 + (size_t)(fq * 16 + fr) * 8 + (s & 7);
}
__device__ __forceinline__ size_t htile_off(int q, int h, int e) {
    return ((((size_t)(q >> 6) * 4 + h) * 16 + (e >> 5)) * 2048) + (size_t)(q & 63) * 32 + (e & 31);
}

namespace pg8 {
constexpr int BM = 256, BK = 64, HALF = 128, HTB = HALF * BK * 2, STAGE_BYTES = 8 * HTB, NXCD = 8, WGM = 8;
__device__ __forceinline__ int lds_byte(int r, int c) { const int st = (r >> 4) * 2 + (c >> 5), rr = r & 15, cc = c & 31, ob = rr * 64 + cc * 2; return st * 1024 + (ob ^ (((ob >> 9) & 1) << 5)); }
__device__ __forceinline__ void stage_rc(int b, int& R_, int& C_) { const int st = b / 1024, sb = b % 1024, swz = sb ^ (((sb >> 9) & 1) << 5); R_ = (st >> 1) * 16 + swz / 64; C_ = (st & 1) * 32 + (swz % 64) / 2; }
__device__ __forceinline__ int perm32(int rho) { const int n = rho >> 4, i = rho & 15; return 8 * (i >> 2) + 4 * n + (i & 3); }

struct Unit { int pm, pn, g; };
struct Gemm {
    const bf16_t* A; const bf16_t* Bt; int lda, ldb, K;
    long a_gs, b_gs;
    int nM, nN, nG;
    int rev;
};
struct Order {
    int nM, nNt, nN, nwg, G, c, rev;
    __device__ void init(const Gemm& g, int G_, int c_) { nM = g.nM; nN = g.nN; nNt = g.nN * g.nG; nwg = nM * nNt; G = G_; c = c_; rev = g.rev; }
    __device__ bool next(int i, Unit& u) const {
        const long L = (long)i * G + c; if (L >= nwg) return false;
        int wgid = (int)L; { const int q = nwg / NXCD, r = nwg % NXCD, xcd = wgid % NXCD, off = wgid / NXCD; wgid = (xcd < r ? xcd * (q + 1) : r * (q + 1) + (xcd - r) * q) + off; }
        const int nig = WGM * nNt, gid = wgid / nig, fm = gid * WGM, gsz = (nM - fm) < WGM ? (nM - fm) : WGM;
        u.pm = fm + ((wgid % nig) % gsz); if (rev) u.pm = nM - 1 - u.pm; const int pnt = (wgid % nig) / gsz; u.g = pnt / nN; u.pn = pnt - u.g * nN; return true;
    }
};
__device__ __forceinline__ unsigned cvt_pk_bf16(float lo, float hi) { return pk2(lo, hi); }

struct EpiStore {
    bf16_t* O; long o_gs; int ldc; int act;
    int mode, off;
    __device__ __forceinline__ void operator()(const f32x4 (&acc)[2][2][4][2], const Unit& u, int wr, int wc, int fr, int fq) const {
        const int row0 = u.pm * BM + wr * 64 + fr; const int col0 = u.pn * BM + wc * 32 + 8 * fq; bf16_t* base = O + (long)u.g * o_gs;
#pragma unroll
        for (int ai = 0; ai < 2; ++ai)
#pragma unroll
            for (int m = 0; m < 4; ++m) { bf16_t* rowp = base + (size_t)(row0 + ai * HALF + m * 16) * ldc + col0;
#pragma unroll
                for (int bj = 0; bj < 2; ++bj) { f32x4 v0 = acc[ai][bj][m][0], v1 = acc[ai][bj][m][1];
                    if (act == 1) {
#pragma unroll
                        for (int j = 0; j < 4; ++j) { const float a = fmaxf(v0[j], 0.f), b = fmaxf(v1[j], 0.f); v0[j] = a * a; v1[j] = b * b; } }
                    u32x4 w; w.x = cvt_pk_bf16(v0[0], v0[1]); w.y = cvt_pk_bf16(v0[2], v0[3]); w.z = cvt_pk_bf16(v1[0], v1[1]); w.w = cvt_pk_bf16(v1[2], v1[3]);
                    if (mode == 0) *(u32x4*)(rowp + bj * HALF) = w;
                    else if (mode == 1) *(u32x4*)(O + qtile_off(off + row0 + ai * HALF + m * 16, u.g, col0 + bj * HALF)) = w;
                    else if (mode == 2) *(u32x4*)(O + ktile_off(row0 + ai * HALF + m * 16, u.g, off + col0 + bj * HALF)) = w;
                    else *(u32x4*)(O + vtile_off(row0 + ai * HALF + m * 16, u.g, off + col0 + bj * HALF)) = w; } }
    }
};

template <class Epi>
__device__ __forceinline__ void gemm_phase(LAS unsigned char* lds, const Gemm g, const Epi& E, int G_, int c_, int tid_in) {
    int tid_ = tid_in; asm volatile("" : "+v"(tid_));
    const int tid = tid_, wid = __builtin_amdgcn_readfirstlane(tid >> 6), lane = tid & 63, wr = wid >> 2, wc = wid & 3, fr = lane & 15, fq = lane >> 4;
    const int K = g.K, nt = K / BK;
    Order S; S.init(g, G_, c_);
    unsigned voffA[2], voffB[2];
#pragma unroll
    for (int i = 0; i < 2; ++i) { int R_, C_; stage_rc(tid * 16 + i * 8192, R_, C_); const int Rb = (R_ & ~31) + perm32(R_ & 31);
        voffA[i] = (unsigned)(R_ * g.lda + C_) * 2u; voffB[i] = (unsigned)(Rb * g.ldb + C_) * 2u; }
    const size_t kstep = (size_t)(BK * 2);
    const size_t hstepA = (size_t)HALF * g.lda * 2, hstepB = (size_t)HALF * g.ldb * 2;
    const unsigned ldsw = (unsigned)wid * 1024u;
    const int aoff = lds_byte(wr * 64 + fr, fq * 8), boff = lds_byte(wc * 32 + fr, fq * 8);
#define PG8_SA(b, h) (((b) * 2 + (h)) * HTB)
#define PG8_SB(b, h) ((4 + (b) * 2 + (h)) * HTB)
#define PG8_STAGE(bufoff, gbase, voff) do { _Pragma("unroll") for (int _i = 0; _i < 2; ++_i) \
        __builtin_amdgcn_global_load_lds((const unsigned*)((const char*)(gbase) + (voff)[_i]), (LAS unsigned*)(lds + (bufoff) + ldsw + _i * 8192), 16, 0, 0); } while (0)
#define PG8_LDA(dst, b, h) do { _Pragma("unroll") for (int m = 0; m < 4; ++m) _Pragma("unroll") for (int k = 0; k < 2; ++k) dst[m][k] = *(const LAS bf16x8*)(lds + PG8_SA(b, h) + aoff + m * 2048 + k * 1024); } while (0)
#define PG8_LDB(dst, b, h) do { _Pragma("unroll") for (int n = 0; n < 2; ++n) _Pragma("unroll") for (int k = 0; k < 2; ++k) dst[n][k] = *(const LAS bf16x8*)(lds + PG8_SB(b, h) + boff + n * 2048 + k * 1024); } while (0)
#define PG8_MMA(ai, bj, At, Bt) do { __builtin_amdgcn_s_setprio(1); _Pragma("unroll") for (int m = 0; m < 4; ++m) _Pragma("unroll") for (int n = 0; n < 2; ++n) _Pragma("unroll") for (int k = 0; k < 2; ++k) \
        acc[ai][bj][m][n] = __builtin_amdgcn_mfma_f32_16x16x32_bf16(Bt[n][k], At[m][k], acc[ai][bj][m][n], 0, 0, 0); __builtin_amdgcn_s_setprio(0); } while (0)
#define PG8_WAIT_V(n) asm volatile("s_waitcnt vmcnt(" #n ")" ::: "memory")
#define PG8_WAIT_L(n) asm volatile("s_waitcnt lgkmcnt(" #n ")" ::: "memory")
#define PG8_BAR __builtin_amdgcn_s_barrier()
#define PG8_SCHED __builtin_amdgcn_sched_barrier(0)
#define PG8_APTR(u) ((const char*)(g.A + (long)(u).g * g.a_gs) + (size_t)(u).pm * 2 * hstepA)
#define PG8_BPTR(u) ((const char*)(g.Bt + (long)(u).g * g.b_gs) + (size_t)(u).pn * 2 * hstepB)
    Unit cur, nxt; int ui = 0;
    if (!S.next(0, cur)) return;
    f32x4 acc[2][2][4][2];
#pragma unroll
    for (int a = 0; a < 2; ++a)
#pragma unroll
        for (int b = 0; b < 2; ++b)
#pragma unroll
            for (int m = 0; m < 4; ++m)
#pragma unroll
                for (int n = 0; n < 2; ++n) acc[a][b][m][n] = (f32x4){0.f, 0.f, 0.f, 0.f};
    bf16x8 At[4][2], B0[2][2], B1[2][2];
    const char* cA = PG8_APTR(cur); const char* cB = PG8_BPTR(cur);
    PG8_STAGE(PG8_SB(0, 0), cB, voffB); PG8_STAGE(PG8_SA(0, 0), cA, voffA); PG8_STAGE(PG8_SB(0, 1), cB + hstepB, voffB); PG8_STAGE(PG8_SA(0, 1), cA + hstepA, voffA);
    if (wr == 1) PG8_BAR;
    PG8_WAIT_V(4); PG8_BAR;
    PG8_STAGE(PG8_SB(1, 0), cB + kstep, voffB); PG8_STAGE(PG8_SA(1, 0), cA + kstep, voffA); PG8_STAGE(PG8_SB(1, 1), cB + hstepB + kstep, voffB);
    PG8_WAIT_V(6); PG8_BAR;
    for (;;) {
        const bool has_next = S.next(ui + 1, nxt);
        const char* nA = has_next ? PG8_APTR(nxt) : cA; const char* nB = has_next ? PG8_BPTR(nxt) : cB;
        for (int t = 0; t < nt; t += 2) {
            const bool last = (t == nt - 2);
            const char* a1 = cA + (size_t)(t + 1) * kstep;
            const char* a2 = last ? nA : cA + (size_t)(t + 2) * kstep; const char* b2 = last ? nB : cB + (size_t)(t + 2) * kstep;
            const char* a3 = a2 + kstep; const char* b3 = b2 + kstep;
            PG8_LDB(B0, 0, 0); PG8_SCHED; PG8_LDA(At, 0, 0); PG8_STAGE(PG8_SA(1, 1), a1 + hstepA, voffA);
            PG8_WAIT_L(8); PG8_BAR; PG8_WAIT_L(0); PG8_MMA(0, 0, At, B0); PG8_BAR; PG8_SCHED;
            PG8_LDB(B1, 0, 1); PG8_STAGE(PG8_SB(0, 0), b2, voffB);
            PG8_BAR; PG8_WAIT_L(0); PG8_MMA(0, 1, At, B1); PG8_BAR;
            PG8_LDA(At, 0, 1); PG8_STAGE(PG8_SA(0, 0), a2, voffA);
            PG8_BAR; PG8_WAIT_L(0); PG8_MMA(1, 0, At, B0); PG8_BAR; PG8_SCHED;
            PG8_STAGE(PG8_SB(0, 1), b2 + hstepB, voffB);
            PG8_WAIT_V(6); PG8_BAR; PG8_MMA(1, 1, At, B1); PG8_BAR;
            PG8_LDB(B0, 1, 0); PG8_SCHED; PG8_LDA(At, 1, 0); PG8_STAGE(PG8_SA(0, 1), a2 + hstepA, voffA);
            PG8_WAIT_L(8); PG8_BAR; PG8_WAIT_L(0); PG8_MMA(0, 0, At, B0); PG8_BAR; PG8_SCHED;
            PG8_LDB(B1, 1, 1); PG8_STAGE(PG8_SB(1, 0), b3, voffB);
            PG8_BAR; PG8_WAIT_L(0); PG8_MMA(0, 1, At, B1); PG8_BAR;
            PG8_LDA(At, 1, 1); PG8_STAGE(PG8_SA(1, 0), a3, voffA);
            PG8_BAR; PG8_WAIT_L(0); PG8_MMA(1, 0, At, B0); PG8_BAR; PG8_SCHED;
            PG8_STAGE(PG8_SB(1, 1), b3 + hstepB, voffB);
            PG8_WAIT_V(6); PG8_BAR; PG8_MMA(1, 1, At, B1); PG8_BAR;
        }
        E(acc, cur, wr, wc, fr, fq);
        if (!has_next) break;
#pragma unroll
        for (int a = 0; a < 2; ++a)
#pragma unroll
            for (int b = 0; b < 2; ++b)
#pragma unroll
                for (int m = 0; m < 4; ++m)
#pragma unroll
                    for (int n = 0; n < 2; ++n) acc[a][b][m][n] = (f32x4){0.f, 0.f, 0.f, 0.f};
        cur = nxt; cA = nA; cB = nB; ++ui;
    }
    PG8_WAIT_V(0);
    if (wr == 0) PG8_BAR;
    PG8_BAR;
#undef PG8_SA
#undef PG8_SB
#undef PG8_STAGE
#undef PG8_LDA
#undef PG8_LDB
#undef PG8_MMA
#undef PG8_WAIT_V
#undef PG8_WAIT_L
#undef PG8_BAR
#undef PG8_SCHED
#undef PG8_APTR
#undef PG8_BPTR
}
}

struct SmallGemm { const bf16_t* A; const bf16_t* B; int lda, ldb, K, akseg, bkseg; long aseg, bseg; int a_tiled; };
constexpr int SG_LD = 72;
constexpr int SG_TILE = 64 * SG_LD * 2;
template <class Dec, class Epi>
__device__ __forceinline__ void gemm_small(LAS unsigned char* lds, const SmallGemm g, int nunits, const Dec& dec, const Epi& epi, int G_, int c_, int tid_in) {
    int tid_ = tid_in; asm volatile("" : "+v"(tid_));
    const int tid = tid_, wid = tid >> 6, lane = tid & 63, wm = wid >> 1, wn = wid & 1, fr = lane & 15, fq = lane >> 4;
    const int lrow = tid >> 3, lk = (tid & 7) * 8;
    const int nk = g.K / 64;
    const unsigned stoff = (unsigned)(lrow * SG_LD + lk) * 2u;
#define SG_LOAD(ra_, rb_, kt_) do { const int k_ = (kt_) * 64 + lk; \
        if (g.a_tiled) ra_ = *(const u32x4*)(g.A + (((((size_t)aoff * 8 + (k_ >> 6)) * 4 + (lrow >> 4)) * 2 + ((k_ >> 5) & 1)) * 512 + (size_t)(((k_ >> 3) & 3) * 16 + (lrow & 15)) * 8)); \
        else ra_ = *(const u32x4*)(ap + (long)(k_ / g.akseg) * g.aseg + (k_ % g.akseg)); \
        rb_ = *(const u32x4*)(bp + (long)(k_ / g.bkseg) * g.bseg + (k_ % g.bkseg)); } while (0)
#define SG_STORE(ra_, rb_, bufi_) do { *(LAS u32x4*)(lds + ((bufi_) * 2 + 0) * SG_TILE + stoff) = ra_; *(LAS u32x4*)(lds + ((bufi_) * 2 + 1) * SG_TILE + stoff) = rb_; } while (0)
#define SG_COMPUTE(bufi_) do { const LAS unsigned char* As = lds + ((bufi_) * 2 + 0) * SG_TILE; const LAS unsigned char* Bs = lds + ((bufi_) * 2 + 1) * SG_TILE; \
        _Pragma("unroll") for (int ks = 0; ks < 2; ++ks) { const bf16x8 af = *(const LAS bf16x8*)(As + ((wm * 16 + fr) * SG_LD + ks * 32 + fq * 8) * 2); \
            _Pragma("unroll") for (int nt = 0; nt < 2; ++nt) { const bf16x8 bf = *(const LAS bf16x8*)(Bs + ((wn * 32 + nt * 16 + fr) * SG_LD + ks * 32 + fq * 8) * 2); \
                acc[nt] = __builtin_amdgcn_mfma_f32_16x16x32_bf16(bf, af, acc[nt], 0, 0, 0); } } } while (0)
    for (int u = c_; u < nunits; u += G_) {
        long aoff, boff; dec(u, aoff, boff);
        const bf16_t* ap = g.A + aoff + (long)lrow * g.lda; const bf16_t* bp = g.B + boff + (long)lrow * g.ldb;
        f32x4 acc[2] = {(f32x4){0.f, 0.f, 0.f, 0.f}, (f32x4){0.f, 0.f, 0.f, 0.f}};
        u32x4 ra0, rb0, ra1, rb1, ra2, rb2, ra3, rb3;
        ra0 = (u32x4){0u, 0u, 0u, 0u}; rb0 = ra0; ra1 = ra0; rb1 = ra0; ra2 = ra0; rb2 = ra0; ra3 = ra0; rb3 = ra0;
        SG_LOAD(ra0, rb0, 0); if (nk > 1) SG_LOAD(ra1, rb1, 1); if (nk > 2) SG_LOAD(ra2, rb2, 2); if (nk > 3) SG_LOAD(ra3, rb3, 3);
        SG_STORE(ra0, rb0, 0);
        LDS_BARRIER();
#define SG_TURN(kt_, bufc, rnextA, rnextB, rfreeA, rfreeB) do { if ((kt_) < nk) { \
            SG_COMPUTE(bufc); \
            if ((kt_) + 1 < nk) SG_STORE(rnextA, rnextB, (bufc) ^ 1); \
            if ((kt_) + 4 < nk) SG_LOAD(rfreeA, rfreeB, (kt_) + 4); \
            LDS_BARRIER(); } } while (0)
        for (int kt = 0; kt < nk; kt += 4) {
            SG_TURN(kt,     0, ra1, rb1, ra0, rb0);
            SG_TURN(kt + 1, 1, ra2, rb2, ra1, rb1);
            SG_TURN(kt + 2, 0, ra3, rb3, ra2, rb2);
            SG_TURN(kt + 3, 1, ra0, rb0, ra3, rb3);
        }
#undef SG_TURN
#pragma unroll
        for (int nt = 0; nt < 2; ++nt) epi(u, wm * 16 + fr, wn * 32 + nt * 16 + fq * 4, acc[nt]);
    }
#undef SG_LOAD
#undef SG_STORE
#undef SG_COMPUTE
}

struct SmallDense { bf16_t* O; long o_gs; int ldc, mt, nt, act; long a_gs, b_gs; int mode; };
__device__ __forceinline__ void gemm_small_dense(LAS unsigned char* lds, const SmallGemm g, const SmallDense d, int ngroups, int G_, int c_, int tid_in) {
    const int per = d.mt * d.nt;
    auto dec = [=](int u, long& ao, long& bo) { const int gi = u / per, r = u % per, mi = r / d.nt, ni = r % d.nt; ao = gi * d.a_gs + (long)mi * 64 * g.lda; bo = gi * d.b_gs + (long)ni * 64 * g.ldb; };
    auto epi = [=](int u, int m, int n, const f32x4& v) { const int gi = u / per, r = u % per, mi = r / d.nt, ni = r % d.nt;
        f32x4 x = v; if (d.act == 1) {
#pragma unroll
            for (int i = 0; i < 4; ++i) { const float a = fmaxf(x[i], 0.f); x[i] = a * a; } }
        u32x2 w; w.x = pk2(x[0], x[1]); w.y = pk2(x[2], x[3]);
        if (d.mode == 0) *(u32x2*)(d.O + gi * d.o_gs + (size_t)(mi * 64 + m) * d.ldc + ni * 64 + n) = w;
        else if (d.mode == 1) *(u32x2*)(d.O + qtile_off(mi * 64 + m, gi, ni * 64 + n)) = w;
        else if (d.mode == 2) *(u32x2*)(d.O + ktile_off(mi * 64 + m, gi, ni * 64 + n)) = w;
        else *(u32x2*)(d.O + vtile_off(mi * 64 + m, gi, ni * 64 + n)) = w; };
    gemm_small(lds, g, ngroups * per, dec, epi, G_, c_, tid_in);
}

struct Args { const float* in[22]; float* out; unsigned char* ws; int ph_lo, ph_hi, ph_last, li; };
enum { I_X = 0, I_C, I_CTX, I_CCTX, I_ADAW, I_ADAB, I_PG, I_PB, I_WIN, I_WCONV, I_BCONV, I_WQ, I_WK, I_WV, I_WGATE, I_BGATE, I_GNW, I_SKIP, I_WOUT, I_FWOUT, I_W1, I_W2 };

constexpr int LDS_BYTES = 147456;
constexpr int LDS_MISC = LDS_BYTES - 256;

__device__ __forceinline__ void transpose_item(const float* W, int K, int N, bf16_t* WT, float scale, LAS float* scr, int item, int lane) {
    const int nblk = N / 32, kb = item / nblk, nb = item % nblk, k0 = 64 * kb, n0 = 32 * nb;
#pragma unroll 8
    for (int i = 0; i < 32; ++i) { const int kk = 2 * i + (lane >> 5); scr[kk * 33 + (lane & 31)] = W[(size_t)(k0 + kk) * N + n0 + (lane & 31)] * scale; }
    asm volatile("s_waitcnt lgkmcnt(0)" ::: "memory");
    const int c = lane & 7;
#pragma unroll
    for (int j = 0; j < 4; ++j) { const int n = (lane >> 3) + 8 * j; const LAS float* s = scr + (8 * c) * 33 + n;
        u32x4 o; o.x = pk2(s[0 * 33], s[1 * 33]); o.y = pk2(s[2 * 33], s[3 * 33]); o.z = pk2(s[4 * 33], s[5 * 33]); o.w = pk2(s[6 * 33], s[7 * 33]);
        *(u32x4*)(WT + (size_t)(n0 + n) * K + k0 + 8 * c) = o; }
    asm volatile("s_waitcnt lgkmcnt(0)" ::: "memory");
}

__device__ __forceinline__ void ln_norm(f32x4 (&v)[4], int lane) {
    float s = 0.f;
#pragma unroll
    for (int j = 0; j < 4; ++j) s += (v[j][0] + v[j][1]) + (v[j][2] + v[j][3]);
    const float mean = wave_sum(s, lane) * (1.f / D); float s2 = 0.f;
#pragma unroll
    for (int j = 0; j < 4; ++j) { v[j] = v[j] - mean; s2 += (v[j][0] * v[j][0] + v[j][1] * v[j][1]) + (v[j][2] * v[j][2] + v[j][3] * v[j][3]); }
    const float rstd = __builtin_amdgcn_rsqf(wave_sum(s2, lane) * (1.f / D) + LN_EPS);
#pragma unroll
    for (int j = 0; j < 4; ++j) v[j] = v[j] * rstd;
}

constexpr int PL = 24;
constexpr int NPHASE = 2 + 4 * PL;
__host__ __device__ inline bool phase_valid(int id) {
    if (id < 2) return true;
    const int layer = (id - 2) / PL, k = (id - 2) % PL;
    if (layer > 3) return false;
    if (k == 0 || (k >= 19 && k <= 22)) return true;
    if (layer & 1) return k >= 2 && k <= 5;
    return k >= 1 && k <= 18;
}


#define MOD ((float*)(ws + WS_MOD))
#define CTXX ((float*)(ws + WS_CTXX))
#define PRE ((float*)(ws + WS_PRE))
#define HIN ((bf16_t*)(ws + WS_HIN))
#define YB ((bf16_t*)(ws + WS_YB))
#define WIN ((bf16_t*)(ws + W_IN))
#define WQ ((bf16_t*)(ws + W_Q))
#define WK ((bf16_t*)(ws + W_K))
#define WV ((bf16_t*)(ws + W_V))
#define WOUT ((bf16_t*)(ws + W_OUT))
#define W1 ((bf16_t*)(ws + W_1))
#define W2 ((bf16_t*)(ws + W_2))
#define GATET ((bf16_t*)(ws + TAB_GATE))
#define S0 ((bf16_t*)(ws + WS_BIG + 0 * SLOT))
#define S1 ((bf16_t*)(ws + WS_BIG + 1 * SLOT))
#define S2 ((bf16_t*)(ws + WS_BIG + 2 * SLOT))
#define S3 ((bf16_t*)(ws + WS_BIG + 3 * SLOT))
#define S4 ((bf16_t*)(ws + WS_BIG + 4 * SLOT))
#define YH (YB + ((size_t)CR + (size_t)half * LH) * D)
#define YHC (YB + (size_t)half * LAT0 * D)
#define HCB (YH + (size_t)NCH * 4 * 2 * 4096 + (size_t)NCH * 4 * 2 * 384 * 2)
#define PREQ ((float*)(HCB + (size_t)LAT0 * DI))
#define HH (HIN + ((size_t)CR + (size_t)half * LH) * D)
#define HHC (HIN + (size_t)half * LAT0 * D)
#define HT ((bf16_t*)(ws + WS_BIG))
#define HTC (HT + (size_t)NB * D * T)
#define PB ((bf16_t*)(ws + WS_BIG + 1 * SLOT))
#define WC ((bf16_t*)(ws + WS_BIG + 3 * SLOT))
#define ZF ((bf16_t*)(ws + WS_BIG))
#define HID ((bf16_t*)(ws + WS_BIG))

constexpr int SC_PLD = 36, SC_VLD = 72;
#define SC_ROW0(j) (((j) < 4) ? (bl * CT + (dir ? 3 - (j) : (j)) * 64) : (LAT0 + bl * T + (dir ? 127 - ((j) - 4) : ((j) - 4)) * 64))
#define SC_LOADQ(dst, r0) do { _Pragma("unroll") for (int pt = 0; pt < 4; ++pt) _Pragma("unroll") for (int ks = 0; ks < 2; ++ks) \
        dst[pt][ks] = __builtin_bit_cast(bf16x8, __builtin_amdgcn_raw_buffer_load_b128(rW, loff, oQ + ((((((r0) >> 6) * 4 + hh) * 8 + w) * 4 + pt) * 2 + ks) * 1024, 0)); } while (0)
#define SC_LOADQ1(dst, r0, pt, ks) dst[pt][ks] = __builtin_bit_cast(bf16x8, __builtin_amdgcn_raw_buffer_load_b128(rW, loff, oQ + ((((((r0) >> 6) * 4 + hh) * 8 + w) * 4 + (pt)) * 2 + (ks)) * 1024, 0))
#define SC_LOADK1(dst, r0, mt, ks) dst[mt][ks] = __builtin_bit_cast(bf16x8, __builtin_amdgcn_raw_buffer_load_b128(rW, loff, oK + ((((((r0) >> 6) * 4 + hh) * 8 + w) * 4 + (mt)) * 2 + (ks)) * 1024, 0))
#define SC_LOADK(dst, r0) do { _Pragma("unroll") for (int mt = 0; mt < 4; ++mt) _Pragma("unroll") for (int ks = 0; ks < 2; ++ks) \
        dst[mt][ks] = __builtin_bit_cast(bf16x8, __builtin_amdgcn_raw_buffer_load_b128(rW, loff, oK + ((((((r0) >> 6) * 4 + hh) * 8 + w) * 4 + mt) * 2 + ks) * 1024, 0)); } while (0)
#define SC_LOADS(P, r0) do { const int ci_ = ((((r0) >> 6) * 4 + hh) * 2 + dir); \
        P##sg0 = __builtin_bit_cast(bf16x8, __builtin_amdgcn_raw_buffer_load_b128(rW, loff, oS + ci_ * 8192 + (w >> 1) * 2048, 0)); P##sg1 = __builtin_bit_cast(bf16x8, __builtin_amdgcn_raw_buffer_load_b128(rW, loff, oS + ci_ * 8192 + (w >> 1) * 2048 + 1024, 0)); \
        P##v = __builtin_bit_cast(u32x4, __builtin_amdgcn_raw_buffer_load_b128(rW, loff, oV + ((((r0) >> 6) * 4 + hh) * 16 + slice) * 4096 + (w & 3) * 1024, 0));     \
        P##wka = __builtin_bit_cast(u32x4, __builtin_amdgcn_raw_buffer_load_b128(rW, wkoff, oG + ci_ * 1536 + 1296, 0));         \
        P##wint = __builtin_bit_cast(float, __builtin_amdgcn_raw_buffer_load_b32(rW, gcp, oG + ci_ * 1536 + 512, 0)); P##em = __builtin_bit_cast(float, __builtin_amdgcn_raw_buffer_load_b32(rW, gcp, oG + ci_ * 1536 + 768, 0)); \
        P##dec = __builtin_bit_cast(float, __builtin_amdgcn_raw_buffer_load_b32(rW, 0, oG + ci_ * 1536 + 1280, 0)); } while (0)
#define SC_VWRITE(bufi, P) do { LAS bf16_t* vt_ = VB + (bufi) * 2 * 3072; LAS bf16_t* vw_ = vt_ + 3072; \
        if (w < 5) { const float wk_[8] = {bflo(P##wka.x), bfhi(P##wka.x), bflo(P##wka.y), bfhi(P##wka.y), bflo(P##wka.z), bfhi(P##wka.z), bflo(P##wka.w), bfhi(P##wka.w)};     \
            if (w < 4) { *(LAS u32x4*)(vt_ + tid * 8) = P##v; \
                u32x4 sv_; sv_.x = pk2(bflo(P##v.x) * wk_[0], bfhi(P##v.x) * wk_[1]); sv_.y = pk2(bflo(P##v.y) * wk_[2], bfhi(P##v.y) * wk_[3]); \
                sv_.z = pk2(bflo(P##v.z) * wk_[4], bfhi(P##v.z) * wk_[5]); sv_.w = pk2(bflo(P##v.w) * wk_[6], bfhi(P##v.w) * wk_[7]); *(LAS u32x4*)(vw_ + tid * 8) = sv_; } \
            else if (lane < 8) { const u32x4 sv_ = P##wka; \
                int ln_ = lane; asm volatile("" : "+v"(ln_));     \
                *(LAS u32x4*)(vw_ + (4 + (ln_ >> 2)) * 512 + (ln_ & 3) * 16 * 8) = sv_; } } } while (0)
#define SC_STEP(J, Qc, Qn, Kc, Kn, C, N) do { \
    const int j_ = (J); const int row0 = SC_ROW0(j_); const int jn_ = j_ < 131 ? j_ + 1 : 131; const int row1 = SC_ROW0(jn_); \
    const int hsel = (j_ < 4) ? (dir ? 2 : 0) : ((j_ < 68) ? 0 : 1); \
    const int buf = j_ & 1; \
    const LAS bf16_t* VT = VB + buf * 2 * 3072; const LAS bf16_t* VW = VT + 3072; \
    LAS bf16_t* Pb_ = Pbh + buf * (8 * 64 * 40); LAS float* Nq_ = NQs + buf * (8 * 64);        \
    SC_LOADS(N, row1); \
      \
    if (!(abl_ & 1)) _Pragma("unroll") for (int nt = 0; nt < 3; ++nt) { \
        f32x4 d1[4]; \
        _Pragma("unroll") for (int pt = 0; pt < 4; ++pt) d1[pt] = (f32x4){0.f, 0.f, 0.f, 0.f}; \
        _Pragma("unroll") for (int ks = 0; ks < 2; ++ks) { \
            u32x4 bw; bw.x = pg8::cvt_pk_bf16(st[2 * ks][nt][0], st[2 * ks][nt][1]); bw.y = pg8::cvt_pk_bf16(st[2 * ks][nt][2], st[2 * ks][nt][3]); \
            bw.z = pg8::cvt_pk_bf16(st[2 * ks + 1][nt][0], st[2 * ks + 1][nt][1]); bw.w = pg8::cvt_pk_bf16(st[2 * ks + 1][nt][2], st[2 * ks + 1][nt][3]); \
            const bf16x8 bs = __builtin_bit_cast(bf16x8, bw); \
            _Pragma("unroll") for (int pt = 0; pt < 4; ++pt) d1[pt] = __builtin_amdgcn_mfma_f32_16x16x32_bf16(bs, Qc[pt][ks], d1[pt], 0, 0, 0); \
            SC_LOADQ1(Qn, row1, (nt * 2 + ks) >> 1, (nt * 2 + ks) & 1);     } \
        _Pragma("unroll") for (int pt = 0; pt < 4; ++pt) { \
            if (nt < 2) { u32x2 pw_; pw_.x = pg8::cvt_pk_bf16(d1[pt][0], d1[pt][1]); pw_.y = pg8::cvt_pk_bf16(d1[pt][2], d1[pt][3]); *(LAS u32x2*)(Pb_ + (w * 64 + 16 * pt + fr) * 40 + 16 * nt + 4 * fq) = pw_; }     \
            else if (fq == 0) Nq_[w * 64 + 16 * pt + fr] = d1[pt][0]; } } \
    SC_LOADQ1(Qn, row1, 3, 0); SC_LOADQ1(Qn, row1, 3, 1); \
    LDS_BARRIER();                                                       \
      \
    f32x4 d2 = (f32x4){0.f, 0.f, 0.f, 0.f}, d3 = (f32x4){0.f, 0.f, 0.f, 0.f}; \
    if (!(abl_ & 2)) {     \
        const int nt2 = w & 1; \
        const bf16x8 vt0 = *(const LAS bf16x8*)(VT + (nt2 * 2 + 0) * 512 + lane * 8), vt1 = *(const LAS bf16x8*)(VT + (nt2 * 2 + 1) * 512 + lane * 8); \
        const bf16x8 vo0 = *(const LAS bf16x8*)(VT + 4 * 512 + lane * 8), vo1 = *(const LAS bf16x8*)(VT + 5 * 512 + lane * 8); \
        d2 = __builtin_amdgcn_mfma_f32_16x16x32_bf16(vt0, C##sg0, d2, 0, 0, 0); d3 = __builtin_amdgcn_mfma_f32_16x16x32_bf16(vo0, C##sg0, d3, 0, 0, 0); \
        d2 = __builtin_amdgcn_mfma_f32_16x16x32_bf16(vt1, C##sg1, d2, 0, 0, 0); d3 = __builtin_amdgcn_mfma_f32_16x16x32_bf16(vo1, C##sg1, d3, 0, 0, 0); } \
      \
    if (!(abl_ & 4)) _Pragma("unroll") for (int nt = 0; nt < 3; ++nt) { \
        const bf16x8 vw0 = *(const LAS bf16x8*)(VW + (nt * 2 + 0) * 512 + lane * 8), vw1 = *(const LAS bf16x8*)(VW + (nt * 2 + 1) * 512 + lane * 8); \
        _Pragma("unroll") for (int mt = 0; mt < 4; ++mt) { f32x4 a = st[mt][nt] * C##dec; \
            a = __builtin_amdgcn_mfma_f32_16x16x32_bf16(Kc[mt][0], vw0, a, 0, 0, 0); \
            a = __builtin_amdgcn_mfma_f32_16x16x32_bf16(Kc[mt][1], vw1, a, 0, 0, 0); st[mt][nt] = a; \
            if (nt < 2) SC_LOADK1(Kn, row1, (nt * 4 + mt) >> 1, (nt * 4 + mt) & 1); } } \
    if (!(abl_ & 8)) {     \
        f32x4 o1 = (f32x4){0.f, 0.f, 0.f, 0.f}; float nq = 0.f; \
        _Pragma("unroll") for (int ww = 0; ww < 8; ++ww) { const u32x2 cpr_ = *(const LAS u32x2*)(Pb_ + (ww * 64 + cp) * 40 + cv); nq += Nq_[ww * 64 + cp]; \
            o1 += (f32x4){bflo(cpr_.x), bfhi(cpr_.x), bflo(cpr_.y), bfhi(cpr_.y)}; } \
        const float den = C##wint * nq + d3[0]; const float scl = __builtin_amdgcn_rcpf(fmaxf(fabsf(den), C##em)); \
        const f32x4 o = (o1 * C##wint + d2) * scl; \
        u32x2 ow; ow.x = pk2(o[0], o[1]); ow.y = pk2(o[2], o[3]); \
        unsigned lo_ = loff; asm volatile("" : "+v"(lo_)); const unsigned hoff_ = ((lo_ >> 4) & 15u) * 64u + (lo_ >> 8) * 8u;     \
        __builtin_amdgcn_raw_buffer_store_b64(ow, rW, hoff_, (rep_ + 1 < SCAN_REP) ? (oC + 512 * DI * 2) : ((hsel == 0 ? oH : (hsel == 1 ? oV : oC)) + (((row0 >> 6) * 4 + hh) * 16 + slice) * 4096 + (w >> 1) * 1024 + (w & 1) * 32), 0); } \
    if (!(abl_ & 16)) SC_VWRITE(buf ^ 1, N);                                     \
} while (0)

__device__ __forceinline__ void scan_phase(LAS unsigned char* lds, unsigned char* ws, int half, const XcdBarrier& bar, int tid, int lane, int wave, int bx) {
    LAS bf16_t* Pbh = (LAS bf16_t*)lds;
    LAS float* NQs = (LAS float*)(lds + 2 * 8 * 64 * 40 * 2);
    LAS bf16_t* VB = (LAS bf16_t*)(NQs + 2 * 8 * 64);
    const int xcd = bx & 7, idx = bx >> 3;
    const int scn = (xcd * 2 + (idx >> 4)) & 15, slice = idx & 15;
    const int bl = scn >> 3, hh = (scn >> 1) & 3, dir = scn & 1, e0 = slice * 32;
    const int fr = lane & 15, fq = lane >> 4, w = wave;
    const int cp = 16 * (w >> 1) + fr, cv = 16 * (w & 1) + 4 * fq;
    const unsigned loff = (unsigned)lane * 16u;
    const unsigned gcp = (unsigned)cp * 4u;
    const unsigned wkoff = (w < 4) ? (unsigned)(32 * ((tid >> 6) & 1) + 8 * ((tid & 63) >> 4)) * 2u : (unsigned)(32 * ((lane >> 2) & 1) + 8 * (lane & 3)) * 2u;
    const __amdgpu_buffer_rsrc_t rW = __builtin_amdgcn_make_buffer_rsrc((void*)ws, 0, (int)(512 * MiB), 0x00020000);
    const int oYH = (int)(WS_YB + ((size_t)CR + (size_t)half * LH) * D * 2);
    const int oQ = (int)(WS_BIG + 3 * SLOT), oK = (int)(WS_BIG + 4 * SLOT), oV = (int)(WS_BIG + 2 * SLOT), oH = (int)(WS_BIG + 0 * SLOT);
    const int oS = oYH, oG = oYH + NCH * 4 * 2 * 8192, oC = oG + NCH * 4 * 2 * 1536;
    for (int i = tid; i < 4 * 1024; i += NTHR) { const int im = i >> 10, r = i & 1023, ln = (r & 511) >> 3; VB[im * 3072 + 2048 + r] = (bf16_t)(((im & 1) == 0 && (ln & 3) == 0) ? 0x3F80u : 0u); }
    __syncthreads();
    for (int rep_ = 0; rep_ < SCAN_REP; ++rep_) {
    const int abl_ = (rep_ + 1 < SCAN_REP) ? SC_ABL : 0;
    f32x4 st[4][3];
#pragma unroll
    for (int a = 0; a < 4; ++a)
#pragma unroll
        for (int b = 0; b < 3; ++b) st[a][b] = (f32x4){0.f, 0.f, 0.f, 0.f};
    bf16x8 Q0[4][2], Q1[4][2], K0[4][2], K1[4][2];
    bf16x8 Asg0, Asg1, Bsg0, Bsg1; u32x4 Av = (u32x4){0u, 0u, 0u, 0u}, Bv = Av, Awka = Av, Bwka = Av; float Awint, Aem, Adec, Bwint, Bem, Bdec;
    { const int r0 = SC_ROW0(0); SC_LOADQ(Q0, r0); SC_LOADK(K0, r0); SC_LOADS(A, r0); SC_VWRITE(0, A); }
#pragma unroll 1
    for (int j = 0; j < 132; j += 2) {
        if (j == 68) xcd_barrier(bar, tid == 0);
        SC_STEP(j, Q0, Q1, K0, K1, A, B);
        SC_STEP(j + 1, Q1, Q0, K1, K0, B, A);
    }
    __syncthreads();
    }
}
#undef SC_ROW0
#undef SC_LOADQ
#undef SC_LOADK
#undef SC_LOADS
#undef SC_VWRITE
#undef SC_STEP

typedef const __attribute__((address_space(4))) Args KA;
__device__ __forceinline__ KA* kargs() { KA* k = (KA*)__builtin_amdgcn_kernarg_segment_ptr(); asm volatile("" : "+s"(k)); return k; }
#define PH_BEGIN() \
    KA* ka = kargs(); unsigned char* ws = ka->ws; (void)ws; \
    int wave = wave0; asm volatile("" : "+s"(wave)); \
    unsigned lz_ = 0u; asm volatile("" : "+v"(lz_)); const int lane = (int)__builtin_amdgcn_mbcnt_hi(~0u, __builtin_amdgcn_mbcnt_lo(~0u, lz_)); \
    const int tid = wave * 64 + lane; (void)tid; \
    const int gw = bx * NWAVES + wave, NGW = G * NWAVES; (void)gw; (void)NGW;

__global__ void __launch_bounds__(NTHR, 2) fwd(Args args) {
    extern __shared__ __attribute__((aligned(16))) unsigned char lds_raw[];
    LAS unsigned char* lds = (LAS unsigned char*)lds_raw;
    const int G = gridDim.x, bx = blockIdx.x;
    const int wave0 = __builtin_amdgcn_readfirstlane(threadIdx.x >> 6);
    volatile LAS unsigned* MISC = (volatile LAS unsigned*)(lds + LDS_MISC);
    if (threadIdx.x < 64) MISC[threadIdx.x] = 0u;
    __syncthreads();
    XcdBarrier bar = xcd_barrier_post((unsigned*)(args.ws + WS_CTL + 65536) + (size_t)args.li * 4096, MISC + 8);
    const int lo = args.ph_lo, hi = args.ph_hi, plast = args.ph_last;
#define IN(k) (lo <= (k) && (k) < hi)
#define SEAM(k) do { if ((k) != plast) { xcd_barrier(bar, tid == 0); if (DUP_BAR) xcd_barrier(bar, tid == 0); } } while (0)

    if (EN_PRO && IN(0)) { PH_BEGIN();
        {
            LAS float* sc = (LAS float*)lds;
            for (int i = tid; i < 5 * D; i += NTHR) { const int r = i / D, k = i % D; const float x = r < 4 ? ka->in[I_C][r * D + k] : ka->in[I_CCTX][k]; sc[i] = siluf(x); }
            __syncthreads();
            LAS float* red = (LAS float*)(lds + 32768);
            const int kp = tid >> 6, cc = tid & 63;
            for (int item = bx; item < 4 * 96; item += G) {
                const int layer = item / 96, n0 = (item % 96) * 64;
                const float* w = ka->in[I_ADAW] + (size_t)layer * D * 6 * D + n0 + cc;
                float a0 = 0.f, a1 = 0.f, a2 = 0.f, a3 = 0.f, a4 = 0.f;
                for (int k = kp * 128; k < kp * 128 + 128; ++k) { const float wv = w[(size_t)k * 6 * D]; a0 += sc[k] * wv; a1 += sc[D + k] * wv; a2 += sc[2 * D + k] * wv; a3 += sc[3 * D + k] * wv; a4 += sc[4 * D + k] * wv; }
                red[(kp * 64 + cc) * 5 + 0] = a0; red[(kp * 64 + cc) * 5 + 1] = a1; red[(kp * 64 + cc) * 5 + 2] = a2; red[(kp * 64 + cc) * 5 + 3] = a3; red[(kp * 64 + cc) * 5 + 4] = a4;
                __syncthreads();
                if (tid < 320) { const int c2 = tid % 64, r = tid / 64; float s = ka->in[I_ADAB][layer * 6 * D + n0 + c2];
                    for (int q = 0; q < 8; ++q) s += red[(q * 64 + c2) * 5 + r];
                    MOD[((size_t)layer * 5 + r) * 6 * D + n0 + c2] = s; }
                __syncthreads();
            }
        }
        {
            bf16_t* A1 = (bf16_t*)(ws + TAB_A1); bf16_t* A2 = (bf16_t*)(ws + TAB_A2); bf16_t* BZ = (bf16_t*)(ws + TAB_BZ); bf16_t* ACTX = (bf16_t*)(ws + TAB_ACTX);
            const int gt = bx * NTHR + tid, NGT = G * NTHR;
            const float s8192 = 0.011048543456039806f;
            for (int i = gt; i < 512 * 256; i += NGT) { const int m = i / 256, t1 = i % 256, ri = m / 256, t1p = m % 256; const int ph = (t1 * t1p) & 255; float sn, cs; sincospif((float)ph * (2.0f / 256.0f), &sn, &cs);
                A1[i] = (bf16_t)f2bf((ri == 0 ? cs : -sn) * s8192);
                ACTX[i] = (bf16_t)f2bf((ri == 0 ? cs : -sn) * 0.0625f); }
            for (int i = gt; i < 256 * 64 * 64; i += NGT) { const int t1p = i / 4096, m = (i / 64) % 64, k = i % 64; const int rip = m / 32, t2p = m % 32, ri = k / 32, t2 = k % 32;
                const int ph = (t2 * t1p + 256 * t2 * t2p) & 8191; float sn, cs; sincospif((float)ph * (2.0f / 8192.0f), &sn, &cs);
                const float v = (rip == ri) ? cs : (rip == 0 ? sn : -sn); A2[i] = (bf16_t)f2bf(v); }
            for (int i = gt; i < 256 * 512; i += NGT) { const int cp = i / 512, k = i % 512, ri = k / 256, c = k % 256; const int ph = (c * cp) & 255; float sn, cs; sincospif((float)ph * (2.0f / 256.0f), &sn, &cs);
                BZ[i] = (bf16_t)f2bf((ri == 0 ? cs : sn) * 0.0625f); }
        }
        SEAM(0);
    }
    if (EN_PRO && IN(1)) { PH_BEGIN();
        const int nseg = gw < CR ? 2 : 1;
#pragma unroll 1
        for (int seg = 0; seg < nseg; ++seg) {
            const int mi = seg == 0 ? (gw >> 9) : 4, rbeg = seg == 0 ? lat_row(gw >> 9, gw & 511) : gw, nr = seg == 0 ? T / 512 : 1;
            const float* md = MOD + ((size_t)0 * 5 + mi) * 6 * D;
            f32x4 shv[4], scv[4];
#pragma unroll
            for (int j = 0; j < 4; ++j) { shv[j] = *(const f32x4*)(md + 256 * j + 4 * lane); scv[j] = *(const f32x4*)(md + D + 256 * j + 4 * lane) + 1.0f; }
#pragma unroll 2
            for (int k = 0; k < nr; ++k) {
                const int r = rbeg + 512 * k;
                const RowInfo ri = row_info(r);
                const float* xr = ri.is_ctx ? ka->in[I_CTX] + ((size_t)ri.b * CT + ri.t) * D : ka->in[I_X] + ((size_t)ri.b * T + ri.t) * D;
                f32x4 v[4];
#pragma unroll
                for (int j = 0; j < 4; ++j) v[j] = *(const f32x4*)(xr + 256 * j + 4 * lane);
                ln_norm(v, lane);
                bf16_t* o = HIN + (size_t)r * D;
#pragma unroll
                for (int j = 0; j < 4; ++j) { const f32x4 h = v[j] * scv[j] + shv[j]; u32x2 w; w.x = pk2(h[0], h[1]); w.y = pk2(h[2], h[3]); *(u32x2*)(o + 256 * j + 4 * lane) = w; }
            }
        }
        SEAM(1);
    }

    for (int layer = 0; layer < 4; ++layer) {
        const int pb = 2 + layer * PL;
        if (hi <= pb || lo >= pb + PL) continue;
        const int jl = layer >> 1;
        const bool is_m = (layer & 1) == 0;
        if (EN_WC && IN(pb + 0)) { PH_BEGIN();
 for (int rp_ = 0; rp_ < REPN(5); ++rp_) {
            LAS float* scr = (LAS float*)(lds + wave * 16384);
            const int i_in = (D / 64) * (2 * DI / 32), i_h = (DH / 64) * (DH / 32), i_out = (DI / 64) * (D / 32), i_f = (D / 64) * (D / 32), i_1 = (D / 64) * (DFF / 32), i_2 = (DFF / 64) * (D / 32);
            const int n_mix = is_m ? (i_in + 12 * i_h + i_out) : i_f;
            const int nitems = n_mix + i_1 + i_2;
            for (int it = gw; it < nitems; it += NGW) {
                int r = it;
                if (r >= n_mix) { r -= n_mix;
                    if (r < i_1) transpose_item(ka->in[I_W1] + (size_t)layer * D * DFF, D, DFF, W1, 1.f, scr, r, lane);
                    else transpose_item(ka->in[I_W2] + (size_t)layer * DFF * D, DFF, D, W2, 1.f, scr, r - i_1, lane);
                    continue; }
                if (!is_m) { transpose_item(ka->in[I_FWOUT] + (size_t)jl * D * D, D, D, WOUT, 1.f, scr, r, lane); continue; }
                if (r < i_in) { transpose_item(ka->in[I_WIN] + (size_t)jl * D * 2 * DI, D, 2 * DI, WIN, 1.f, scr, r, lane); continue; } r -= i_in;
                if (r < 12 * i_h) { const int which = r / (4 * i_h), hh = (r / i_h) % 4, rr = r % i_h;
                    const float* src = ka->in[which == 0 ? I_WQ : (which == 1 ? I_WK : I_WV)] + ((size_t)jl * NH + hh) * DH * DH;
                    bf16_t* dst = (which == 0 ? WQ : (which == 1 ? WK : WV)) + (size_t)hh * DH * DH;
                    transpose_item(src, DH, DH, dst, which == 1 ? 0.044194173824159216f : 1.f, scr, rr, lane); continue; } r -= 12 * i_h;
                transpose_item(ka->in[I_WOUT] + (size_t)jl * DI * D, DI, D, WOUT, 1.f, scr, r, lane);
            }
            if (is_m) {
                const float* wg = ka->in[I_WGATE] + (size_t)jl * 3 * DI * 16;
                const int n = lane & 15, eq = lane >> 4;
                for (int k2 = gw; k2 < DI; k2 += NGW) {
                    const int hh = k2 / DH, d = k2 % DH;
                    const float* q = ka->in[I_WQ] + (((size_t)jl * NH + hh) * DH + d) * DH + eq * 128; const float* kx = ka->in[I_WK] + (((size_t)jl * NH + hh) * DH + d) * DH + eq * 128;
                    const float* vx = ka->in[I_WV] + (((size_t)jl * NH + hh) * DH + d) * DH + eq * 128;
                    const float* g0 = wg + ((size_t)0 * DI + hh * DH + eq * 128) * 16 + n; const float* g1 = wg + ((size_t)1 * DI + hh * DH + eq * 128) * 16 + n; const float* g2 = wg + ((size_t)2 * DI + hh * DH + eq * 128) * 16 + n;
                    float s0 = 0.f, s1 = 0.f, s2 = 0.f;
#pragma unroll 8
                    for (int e = 0; e < 128; ++e) { s0 += q[e] * g0[e * 16]; s1 += kx[e] * g1[e * 16]; s2 += vx[e] * g2[e * 16]; }
                    float sa = s0 + 0.044194173824159216f * s1;
                    sa += shx(sa, 16, lane); sa += shx(sa, 32, lane); s2 += shx(s2, 16, lane); s2 += shx(s2, 32, lane);
                    if (lane < 16) { GATET[(size_t)n * 4096 + k2] = (bf16_t)f2bf(sa); GATET[(size_t)n * 4096 + DI + k2] = (bf16_t)f2bf(s2); }
                    else if (lane < 64) { GATET[(size_t)(16 + (lane - 16)) * 4096 + k2] = (bf16_t)0; GATET[(size_t)(16 + (lane - 16)) * 4096 + DI + k2] = (bf16_t)0; }
                }
            }
 }
            SEAM(pb + 0);
        }

        if (EN_MIX && is_m) {
            for (int half = 0; half < 2; ++half) {
                const int hb = pb + 1 + 9 * half;
                if (hi <= hb || lo >= hb + 9) continue;
                if (IN(hb + 0)) { PH_BEGIN();
 for (int rp_ = 0; rp_ < REPN(0); ++rp_) {
                    pg8::Gemm g{HH, WIN, D, D, D, 0, 0, LH / 256, DI / 256, 1};
                    pg8::EpiStore E{S0 + (size_t)LAT0 * DI, 0, DI, 0};
                    pg8::gemm_phase(lds, g, E, G, bx, tid); if (DUP_MIX) pg8::gemm_phase(lds, g, E, G, bx, tid);
                    { SmallGemm sg{HHC, WIN, D, D, D, D, D, 0, 0}; SmallDense sd{S0, 0, DI, LAT0 / 64, DI / 64, 0, 0, 0}; gemm_small_dense(lds, sg, sd, 1, G, bx, tid); if (DUP_CTX) gemm_small_dense(lds, sg, sd, 1, G, bx, tid); }
 }
                    SEAM(hb + 0);
                }
                if (IN(hb + 1)) { PH_BEGIN();
 for (int rp_ = 0; rp_ < REPN(3); ++rp_) {
                    const float* wc = ka->in[I_WCONV] + (size_t)jl * 9 * DI; const float* bc = ka->in[I_BCONV] + (size_t)jl * DI;
                    const int gt = bx * NTHR + tid, NGT = G * NTHR;
                    for (int i = gt; i < 2 * 128 * 2 * (DI / 8); i += NGT) {
                        const int cg = i & 255, rest = i >> 8, hr = rest & 1, r = (rest >> 1) & 127, bl = rest >> 8, c0 = cg * 8, gc0 = 32 * hr;
                        float wv[9][8], bv[8];
#pragma unroll
                        for (int tp = 0; tp < 9; ++tp) { const f32x4 a0 = *(const f32x4*)(wc + (size_t)tp * DI + c0), a1 = *(const f32x4*)(wc + (size_t)tp * DI + c0 + 4);
                            wv[tp][0] = a0[0]; wv[tp][1] = a0[1]; wv[tp][2] = a0[2]; wv[tp][3] = a0[3]; wv[tp][4] = a1[0]; wv[tp][5] = a1[1]; wv[tp][6] = a1[2]; wv[tp][7] = a1[3]; }
                        { const f32x4 a0 = *(const f32x4*)(bc + c0), a1 = *(const f32x4*)(bc + c0 + 4); bv[0] = a0[0]; bv[1] = a0[1]; bv[2] = a0[2]; bv[3] = a0[3]; bv[4] = a1[0]; bv[5] = a1[1]; bv[6] = a1[2]; bv[7] = a1[3]; }
                        const bf16_t* xb = S0 + (size_t)(LAT0 + bl * T + r * 64) * DI + c0;
                        bf16_t* ob = S1 + (size_t)(LAT0 + bl * T + r * 64) * DI + c0;
                        const bool rok[3] = {r > 0, true, r < 127};
                        float win[3][3][8];
#define CV_LOADCOL(slot, col) do { _Pragma("unroll") for (int di = 0; di < 3; ++di) { u32x4 xv = (u32x4){0u, 0u, 0u, 0u}; \
                                if (rok[di] && (col) >= 0 && (col) < 64) xv = *(const u32x4*)(xb + (ptrdiff_t)((di - 1) * 64 + (col)) * DI); \
                                win[slot][di][0] = bflo(xv.x); win[slot][di][1] = bfhi(xv.x); win[slot][di][2] = bflo(xv.y); win[slot][di][3] = bfhi(xv.y); \
                                win[slot][di][4] = bflo(xv.z); win[slot][di][5] = bfhi(xv.z); win[slot][di][6] = bflo(xv.w); win[slot][di][7] = bfhi(xv.w); } } while (0)
#define CV_STEP(sl, sm, sr) do { CV_LOADCOL(sr, gc + 1); \
                                if (gc < gc0 + 32) { float acc[8]; \
                                    _Pragma("unroll") for (int e = 0; e < 8; ++e) { float s = bv[e]; \
                                        _Pragma("unroll") for (int di = 0; di < 3; ++di) s += win[sl][di][e] * wv[di * 3 + 0][e] + win[sm][di][e] * wv[di * 3 + 1][e] + win[sr][di][e] * wv[di * 3 + 2][e]; \
                                        acc[e] = siluf(s); } \
                                    u32x4 o; o.x = pk2(acc[0], acc[1]); o.y = pk2(acc[2], acc[3]); o.z = pk2(acc[4], acc[5]); o.w = pk2(acc[6], acc[7]); \
                                    *(u32x4*)(ob + (size_t)gc * DI) = o; } \
                                ++gc; } while (0)
                        int gc = gc0;
                        CV_LOADCOL(0, gc0 - 1); CV_LOADCOL(1, gc0);
#pragma unroll 1
                        for (int g3 = 0; g3 < 11; ++g3) { CV_STEP(0, 1, 2); CV_STEP(1, 2, 0); CV_STEP(2, 0, 1); }
#undef CV_LOADCOL
#undef CV_STEP
                    }
                    for (int i = gt; i < LAT0 * (DI / 8); i += NGT) {
                        const int q = i / (DI / 8), c0 = (i % (DI / 8)) * 8, t = q % CT;
                        float acc[8];
#pragma unroll
                        for (int e = 0; e < 8; ++e) acc[e] = bc[c0 + e];
#pragma unroll
                        for (int dj = 0; dj < 3; ++dj) { const int tt = t + dj - 1; if (tt < 0 || tt >= CT) continue;
                            const u32x4 xv = *(const u32x4*)(S0 + (size_t)(q + dj - 1) * DI + c0); const float* w = wc + (size_t)(3 + dj) * DI + c0;
                            acc[0] += bflo(xv.x) * w[0]; acc[1] += bfhi(xv.x) * w[1]; acc[2] += bflo(xv.y) * w[2]; acc[3] += bfhi(xv.y) * w[3];
                            acc[4] += bflo(xv.z) * w[4]; acc[5] += bfhi(xv.z) * w[5]; acc[6] += bflo(xv.w) * w[6]; acc[7] += bfhi(xv.w) * w[7]; }
                        u32x4 o; o.x = pk2(siluf(acc[0]), siluf(acc[1])); o.y = pk2(siluf(acc[2]), siluf(acc[3])); o.z = pk2(siluf(acc[4]), siluf(acc[5])); o.w = pk2(siluf(acc[6]), siluf(acc[7]));
                        *(u32x4*)(S1 + (size_t)q * DI + c0) = o;
                    }
 }
                    SEAM(hb + 1);
                }
                if (IN(hb + 2)) { PH_BEGIN();
 for (int rp_ = 0; rp_ < REPN(0); ++rp_) {
                    { pg8::Gemm g{WV, S0 + (size_t)LAT0 * DI, DH, DI, DH, (long)DH * DH, DH, DH / 256, LH / 256, NH};
                      pg8::EpiStore E{S2, 0, 0, 0, 3, LAT0};
                      pg8::gemm_phase(lds, g, E, G, bx, tid); if (DUP_MIX) pg8::gemm_phase(lds, g, E, G, bx, tid); }
                    { SmallGemm sg{WV, S0, DH, DI, DH, DH, DH, 0, 0}; SmallDense sd{S2, 0, 0, DH / 64, LAT0 / 64, 0, (long)DH * DH, DH, 3}; gemm_small_dense(lds, sg, sd, NH, G, bx, tid); if (DUP_CTX) gemm_small_dense(lds, sg, sd, NH, G, bx, tid); }
                    {
                      SmallGemm sg{S1, GATET, DI, 4096, 1024, 1024, 1024, 0, 0};
                      const long xm_off = (long)(S0 - S1);
                      auto dec = [=](int uq, long& ao, long& bo) { const int u = uq >> 2, q = uq & 3; ao = (long)u * 64 * DI + (q & 1) * 1024 + (q >> 1) * xm_off; bo = q * 1024; };
                      auto epi = [=](int uq, int m, int n, const f32x4& v) { const int u = uq >> 2, q = uq & 3; if (n < 16) *(f32x4*)(PREQ + (size_t)q * RH * 16 + ((size_t)u * 64 + m) * 16 + n) = v; };
                      gemm_small(lds, sg, NCH * 4, dec, epi, G, bx, tid); }
 }
                    SEAM(hb + 2);
                }
                if (IN(hb + 3)) { PH_BEGIN();
 for (int rp_ = 0; rp_ < REPN(0); ++rp_) {
                    { pg8::Gemm g{S1 + (size_t)LAT0 * DI, WQ, DI, DH, DH, DH, (long)DH * DH, LH / 256, DH / 256, NH}; pg8::EpiStore E{S3, DH, DI, 0, 1, LAT0}; pg8::gemm_phase(lds, g, E, G, bx, tid); if (DUP_MIX) pg8::gemm_phase(lds, g, E, G, bx, tid); }
                    { SmallGemm sg{S1, WQ, DI, DH, DH, DH, DH, 0, 0}; SmallDense sd{S3, DH, DI, LAT0 / 64, DH / 64, 0, DH, (long)DH * DH, 1}; gemm_small_dense(lds, sg, sd, NH, G, bx, tid); if (DUP_CTX) gemm_small_dense(lds, sg, sd, NH, G, bx, tid); }
                    { pg8::Gemm g{S1 + (size_t)LAT0 * DI, WK, DI, DH, DH, DH, (long)DH * DH, LH / 256, DH / 256, NH}; pg8::EpiStore E{S0 + (size_t)LAT0 * DI, DH, DI, 0}; pg8::gemm_phase(lds, g, E, G, bx, tid); if (DUP_MIX) pg8::gemm_phase(lds, g, E, G, bx, tid); }
                    { SmallGemm sg{S1, WK, DI, DH, DH, DH, DH, 0, 0}; SmallDense sd{S0, DH, DI, LAT0 / 64, DH / 64, 0, DH, (long)DH * DH}; gemm_small_dense(lds, sg, sd, NH, G, bx, tid); if (DUP_CTX) gemm_small_dense(lds, sg, sd, NH, G, bx, tid); }
                    { pg8::Gemm g{WK, S1 + (size_t)LAT0 * DI, DH, DI, DH, (long)DH * DH, DH, DH / 256, LH / 256, NH}; pg8::EpiStore E{S4, (long)DH * RH, RH, 0, 2, LAT0}; pg8::gemm_phase(lds, g, E, G, bx, tid); if (DUP_MIX) pg8::gemm_phase(lds, g, E, G, bx, tid); }
                    { SmallGemm sg{WK, S1, DH, DI, DH, DH, DH, 0, 0}; SmallDense sd{S4, (long)DH * RH, RH, DH / 64, LAT0 / 64, 0, (long)DH * DH, DH, 2}; gemm_small_dense(lds, sg, sd, NH, G, bx, tid); if (DUP_CTX) gemm_small_dense(lds, sg, sd, NH, G, bx, tid); }
                    if (bx < 128) {
                        const int sc = bx >> 3, part = bx & 7, bl = sc >> 3, hh = (sc >> 1) & 3, dir = sc & 1;
                        unsigned* g12cnt = (unsigned*)(ws + WS_CTL + 4096) + ((jl * 2 + half) * 16 + sc) * 16;
                        unsigned* g12tot = (unsigned*)(ws + WS_PRE) + (size_t)((jl * 2 + half) * 16 + sc) * 132 * 2;
                        LAS float* bcs = (LAS float*)lds;
                        LAS float* vss = bcs + 132 * 64;
                        LAS float* bl_ = vss + 132 * 64;
                        LAS float* vm_ = bl_ + 132;
                        LAS float* mi_ = vm_ + 132;
                        const int u = lane, p = dir ? 63 - u : u;
                        const float* bgp = ka->in[I_BGATE] + (size_t)jl * 16 + 8 * dir + hh;
#pragma unroll
                        for (int ii = 0; ii < 3; ++ii) { const int i = part + 8 * ii; const int j = wave + 8 * i;
                            if (i < 17 && j < 132) { int row0; if (j < 4) { const int c = dir ? 3 - j : j; row0 = bl * CT + c * 64; } else { const int c = dir ? 127 - (j - 4) : (j - 4); row0 = LAT0 + bl * T + c * 64; }
                                const float* pr = PREQ + (size_t)(row0 + p) * 16 + 8 * dir + hh; const size_t qs = (size_t)RH * 16;
                                bcs[j * 64 + p] = (pr[4] + pr[qs + 4]) + (pr[2 * qs + 4] + pr[3 * qs + 4]) + bgp[4]; vss[j * 64 + p] = (pr[0] + pr[qs]) + (pr[2 * qs] + pr[3 * qs]) + bgp[0]; } }
                        asm volatile("s_waitcnt vmcnt(0) lgkmcnt(0)" ::: "memory");
#pragma unroll 1
                        for (int ii = 0; ii < 3; ++ii) { const int i = part + 8 * ii; const int j = wave + 8 * i;
                            if (i < 17 && j < 132) { const float f = bcs[j * 64 + p], lia = vss[j * 64 + p]; float x = fminf(f, 0.f) - log1pf(__expf(-fabsf(f)));
                                x = scan_add64(x);
                                const float v = lia - x; float pm = v;
                                pm = scan_max64(pm);
                                bcs[j * 64 + p] = x; vss[j * 64 + p] = v;
                                if (u == 63) { __hip_atomic_store(g12tot + 2 * j, __builtin_bit_cast(unsigned, x), __ATOMIC_RELAXED, __HIP_MEMORY_SCOPE_AGENT); __hip_atomic_store(g12tot + 2 * j + 1, __builtin_bit_cast(unsigned, pm), __ATOMIC_RELAXED, __HIP_MEMORY_SCOPE_AGENT); } } }
                        asm volatile("s_waitcnt vmcnt(0)" ::: "memory");
                        __syncthreads();
                        if (tid == 0) { (void)xb_add(g12cnt, 1u); unsigned sp_ = 0u; while (xb_ld(g12cnt) < 8u && ++sp_ < XB_SPIN_CAP) __builtin_amdgcn_s_sleep(1); }
                        __syncthreads();
                        if (tid < 132) { bl_[tid] = __builtin_bit_cast(float, xb_ld(g12tot + 2 * tid)); vm_[tid] = __builtin_bit_cast(float, xb_ld(g12tot + 2 * tid + 1)); }
                        __syncthreads();
                        if (wave == 0) {
                            const float ni = -__builtin_inff();
                            float ea[3], eb[3];
#pragma unroll
                            for (int t = 0; t < 3; ++t) { const int j = 3 * lane + t; const bool ok = j < 132; const float blj = bl_[ok ? j : 0], vmj = vm_[ok ? j : 0]; ea[t] = ok ? blj : 0.f; eb[t] = ok ? blj + vmj : ni; }
                            float A = ea[0] + ea[1], B = fmaxf(eb[0] + ea[1], eb[1]); B = fmaxf(B + ea[2], eb[2]); A += ea[2];
#define G12_STEP(CTRL, RM) do { const float pa_ = dppf<CTRL, RM>(0.f, A), pb_ = dppf<CTRL, RM>(ni, B); B = fmaxf(pb_ + A, B); A += pa_; } while (0)
                            G12_STEP(0x111, 0xF); G12_STEP(0x112, 0xF); G12_STEP(0x114, 0xF); G12_STEP(0x118, 0xF); G12_STEP(0x142, 0xA); G12_STEP(0x143, 0xC);
#undef G12_STEP
                            float EA = shup(A, 1, lane), EB = shup(B, 1, lane); if (lane == 0) { EA = 0.f; EB = ni; }
                            float m = fmaxf(EA, EB);
#pragma unroll
                            for (int t = 0; t < 3; ++t) { const int j = 3 * lane + t; if (j < 132) { mi_[j] = m; m = fmaxf(m + ea[t], eb[t]); } }
                        }
                        __syncthreads();
                        float* GPw = (float*)(YH + (size_t)NCH * 4 * 2 * 4096);
#pragma unroll 1
                        for (int ii = 0; ii < 3; ++ii) { const int i = part + 8 * ii; const int j = wave + 8 * i;
                            if (i < 17 && j < 132) { int row0; if (j < 4) { const int c = dir ? 3 - j : j; row0 = bl * CT + c * 64; } else { const int c = dir ? 127 - (j - 4) : (j - 4); row0 = LAT0 + bl * T + c * 64; }
                                const float bc = bcs[j * 64 + p], v = vss[j * 64 + p]; float pm = v;
                                pm = scan_max64(pm);
                                const float m_in = mi_[j], btot = bl_[j], m_new = btot + fmaxf(m_in, vm_[j]);
                                const float uu = -fmaxf(m_in, pm);
                                float* gp = GPw + ((size_t)((row0 >> 6) * 4 + hh) * 2 + dir) * 384;
                                gp[p] = uu; gp[64 + p] = v; gp[128 + p] = __expf(m_in + uu); gp[192 + p] = __expf(uu - bc); ((bf16_t*)(gp + 324))[p] = (bf16_t)f2bf(__expf(btot - m_new + v));
                                if (u == 0) gp[320] = __expf(btot + m_in - m_new); } }
                    }
 }
                    SEAM(hb + 3);
                }
                if (IN(hb + 4)) { PH_BEGIN();
 for (int rp_ = 0; rp_ < REPN(4); ++rp_) {
                    SmallGemm sg{S3, S0, DI, DI, DH, DH, DH, 0, 0, 1};
                    bf16_t* SGw = YH; const float* GPr = (const float*)(YH + (size_t)NCH * 4 * 2 * 4096);
                    auto dec = [=](int u, long& ao, long& bo) { const int ch = u >> 2, hh = u & 3; ao = u; bo = (long)ch * 64 * DI + hh * DH; };
                    auto epi = [=](int u, int m, int n, const f32x4& v) {
#pragma unroll
                        for (int dir = 0; dir < 2; ++dir) { const float* gp = GPr + ((size_t)u * 2 + dir) * 384; const float up = gp[m]; const f32x4 vs = *(const f32x4*)(gp + 64 + n); float o[4];
#pragma unroll
                            for (int i = 0; i < 4; ++i) { const int s = n + i; const bool ok = dir ? (s >= m) : (s <= m); const float gte = ok ? __expf(up + vs[i]) : 0.f; o[i] = v[i] * gte; }
                            u32x2 w; w.x = pk2(o[0], o[1]); w.y = pk2(o[2], o[3]);
                            *(u32x2*)(SGw + ((size_t)u * 2 + dir) * 4096 + ((m >> 4) * 2 + (n >> 5)) * 512 + (((n >> 3) & 3) * 16 + (m & 15)) * 8 + (n & 7)) = w; } };
                    gemm_small(lds, sg, NCH * 4, dec, epi, G, bx, tid);
 }
                    SEAM(hb + 4);
                }
                if (EN_SCAN && IN(hb + 5)) { PH_BEGIN();
                    scan_phase(lds, ws, half, bar, tid, lane, wave, bx);
                    SEAM(hb + 5);
                }
                if (IN(hb + 6)) { PH_BEGIN();
 for (int rp_ = 0; rp_ < REPN(0); ++rp_) {
                    pg8::Gemm g{HH, WIN + (size_t)DI * D, D, D, D, 0, 0, LH / 256, DI / 256, 1};
                    pg8::EpiStore E{S3 + (size_t)LAT0 * DI, 0, DI, 0};
                    pg8::gemm_phase(lds, g, E, G, bx, tid); if (DUP_MIX) pg8::gemm_phase(lds, g, E, G, bx, tid);
                    if (layer < 2) { SmallGemm sg{HHC, WIN + (size_t)DI * D, D, D, D, D, D, 0, 0}; SmallDense sd{S3, 0, DI, LAT0 / 64, DI / 64, 0, 0, 0}; gemm_small_dense(lds, sg, sd, 1, G, bx, tid); if (DUP_CTX) gemm_small_dense(lds, sg, sd, 1, G, bx, tid); }
 }
                    SEAM(hb + 6);
                }
                if (IN(hb + 7)) { PH_BEGIN();
 for (int rp_ = 0; rp_ < REPN(3); ++rp_) {
                    const float* gn = ka->in[I_GNW] + (size_t)jl * DI; const float* sk = ka->in[I_SKIP] + (size_t)jl * DI;
#define RO_LOAD(q_, A, B, XC, ZZ) do { const bf16_t* h2_ = ((q_) < LAT0) ? HCB : S2; \
                        _Pragma("unroll") for (int hd = 0; hd < 4; ++hd) { const size_t ho_ = htile_off(q_, hd, 8 * lane); const size_t ro_ = (size_t)(q_) * DI + hd * DH + 8 * lane; \
                            A[hd] = *(const u32x4*)(S0 + ho_); B[hd] = *(const u32x4*)(h2_ + ho_); XC[hd] = *(const u32x4*)(S1 + ro_); ZZ[hd] = *(const u32x4*)(S3 + ro_); } } while (0)
                    u32x4 ra[4], rb[4], rx[4], rz[4], na[4], nb[4], nx[4], nz[4];
                    f32x4 gnv[4][2], skv[4][2];
#pragma unroll
                    for (int hd = 0; hd < 4; ++hd) { gnv[hd][0] = *(const f32x4*)(gn + hd * DH + 8 * lane); gnv[hd][1] = *(const f32x4*)(gn + hd * DH + 8 * lane + 4); skv[hd][0] = *(const f32x4*)(sk + hd * DH + 8 * lane); skv[hd][1] = *(const f32x4*)(sk + hd * DH + 8 * lane + 4); }
#pragma unroll
                    for (int hd = 0; hd < 4; ++hd) { ra[hd] = (u32x4){0u, 0u, 0u, 0u}; rb[hd] = ra[hd]; rx[hd] = ra[hd]; rz[hd] = ra[hd]; na[hd] = ra[hd]; nb[hd] = ra[hd]; nx[hd] = ra[hd]; nz[hd] = ra[hd]; }
                    const int q_first = (layer < 2 ? 0 : LAT0) + gw;
                    if (q_first < RH) RO_LOAD(q_first, ra, rb, rx, rz);
                    for (int q = q_first; q < RH; q += NGW) {
                        if (q + NGW < RH) RO_LOAD(q + NGW, na, nb, nx, nz);
#pragma unroll
                        for (int hd = 0; hd < 4; ++hd) {
                            const int c0 = hd * DH + 8 * lane;
                            const u32x4 a = ra[hd], b = rb[hd];
                            float v[8] = {bflo(a.x) + bflo(b.x), bfhi(a.x) + bfhi(b.x), bflo(a.y) + bflo(b.y), bfhi(a.y) + bfhi(b.y), bflo(a.z) + bflo(b.z), bfhi(a.z) + bfhi(b.z), bflo(a.w) + bflo(b.w), bfhi(a.w) + bfhi(b.w)};
                            float s = 0.f;
#pragma unroll
                            for (int i = 0; i < 8; ++i) s += v[i];
                            const float mean = wave_sum(s, lane) * (1.f / DH); float s2 = 0.f;
#pragma unroll
                            for (int i = 0; i < 8; ++i) { v[i] -= mean; s2 += v[i] * v[i]; }
                            const float rstd = __builtin_amdgcn_rsqf(wave_sum(s2, lane) * (1.f / DH) + LN_EPS);
                            const u32x4 xc = rx[hd], zz = rz[hd];
                            const float xcf[8] = {bflo(xc.x), bfhi(xc.x), bflo(xc.y), bfhi(xc.y), bflo(xc.z), bfhi(xc.z), bflo(xc.w), bfhi(xc.w)};
                            const float zf[8] = {bflo(zz.x), bfhi(zz.x), bflo(zz.y), bfhi(zz.y), bflo(zz.z), bfhi(zz.z), bflo(zz.w), bfhi(zz.w)};
                            float o[8];
#pragma unroll
                            for (int i = 0; i < 8; ++i) o[i] = (v[i] * rstd * gnv[hd][i >> 2][i & 3] + skv[hd][i >> 2][i & 3] * xcf[i]) * siluf(zf[i]);
                            u32x4 w; w.x = pk2(o[0], o[1]); w.y = pk2(o[2], o[3]); w.z = pk2(o[4], o[5]); w.w = pk2(o[6], o[7]);
                            *(u32x4*)(S4 + (size_t)q * DI + c0) = w;
                        }
#pragma unroll
                        for (int hd = 0; hd < 4; ++hd) { ra[hd] = na[hd]; rb[hd] = nb[hd]; rx[hd] = nx[hd]; rz[hd] = nz[hd]; }
                    }
#undef RO_LOAD
 }
                    SEAM(hb + 7);
                }
                if (IN(hb + 8)) { PH_BEGIN();
 for (int rp_ = 0; rp_ < REPN(0); ++rp_) {
                    pg8::Gemm g{S4 + (size_t)LAT0 * DI, WOUT, DI, DI, DI, 0, 0, LH / 256, D / 256, 1};
                    pg8::EpiStore E{YH, 0, D, 0};
                    pg8::gemm_phase(lds, g, E, G, bx, tid); if (DUP_MIX) pg8::gemm_phase(lds, g, E, G, bx, tid);
                    if (layer < 2) { SmallGemm sg{S4, WOUT, DI, DI, DI, DI, DI, 0, 0}; SmallDense sd{YHC, 0, D, LAT0 / 64, D / 64, 0, 0, 0}; gemm_small_dense(lds, sg, sd, 1, G, bx, tid); if (DUP_CTX) gemm_small_dense(lds, sg, sd, 1, G, bx, tid); }
 }
                    SEAM(hb + 8);
                }
            }
        } else if (EN_FOUR) {
            const bool has_ctx = layer < 3;
            if (IN(pb + 2)) { PH_BEGIN();
 for (int rp_ = 0; rp_ < REPN(2); ++rp_) {
                { pg8::Gemm g{(const bf16_t*)(ws + TAB_A1), HT, 256, 256, 256, 0, (long)D * T, 2, 128, NB};
                  pg8::EpiStore E{PB, (long)512 * 32768, 32768, 0};
                  pg8::gemm_phase(lds, g, E, G, bx, tid); if (DUP_MIX) pg8::gemm_phase(lds, g, E, G, bx, tid); }
                if (has_ctx) {
                    SmallGemm sg{(const bf16_t*)(ws + TAB_ACTX), HTC, 256, 256, 256, 256, 256, 0, 0};
                    auto dec = [=](int u, long& ao, long& bo) { const int b = u / 128, mb = (u / 16) % 8, cht = u % 16; ao = (long)mb * 64 * 256; bo = ((long)b * D + cht * 64) * CT; };
                    auto epi = [=](int u, int m, int n, const f32x4& v) { const int b = u / 128, mb = (u / 16) % 8, cht = u % 16; const int mg = mb * 64 + m, ri = mg >> 8, tp = mg & 255, ch = cht * 64 + n;
                        u32x2 w; w.x = pk2(v[0], v[1]); w.y = pk2(v[2], v[3]); *(u32x2*)(WC + (size_t)ctx_row(b, tp) * DI + (ch >> 8) * 512 + ri * 256 + (ch & 255)) = w; };
                    gemm_small(lds, sg, NB * 8 * 16, dec, epi, G, bx, tid);
                }
 }
                SEAM(pb + 2);
            }
            if (IN(pb + 3)) { PH_BEGIN();
 for (int rp_ = 0; rp_ < REPN(2); ++rp_) {
                {
                    const int wid = tid >> 6, wm = wid >> 1, wn = wid & 1, fr = lane & 15, fq = lane >> 4;
                    const int lrow = tid >> 3, lk = (tid & 7) * 8;
                    const unsigned stoff = (unsigned)(lrow * SG_LD + lk) * 2u;
                    LAS unsigned char* As = lds; LAS unsigned char* Bs0 = lds + SG_TILE; LAS unsigned char* Bs1 = lds + 2 * SG_TILE;
                    const bf16_t* A2 = (const bf16_t*)(ws + TAB_A2);
                    for (int pair = bx; pair < NB * 256; pair += G) {
                        const int b = pair >> 8, t1p = pair & 255;
                        const bf16_t* bp = PB + (size_t)b * 512 * 32768 + (size_t)((lk >> 5) * 256 + t1p) * 32768 + (size_t)lrow * 32 + (lk & 31);
                        u32x4 r0 = *(const u32x4*)(bp), r1 = *(const u32x4*)(bp + 2048), r2 = *(const u32x4*)(bp + 2 * 2048), r3 = *(const u32x4*)(bp + 3 * 2048);
                        *(LAS u32x4*)(As + stoff) = *(const u32x4*)(A2 + (size_t)t1p * 4096 + lrow * 64 + lk);
                        *(LAS u32x4*)(Bs0 + stoff) = r0;
                        LDS_BARRIER();
                        bf16x8 af[2];
#pragma unroll
                        for (int ks = 0; ks < 2; ++ks) af[ks] = *(const LAS bf16x8*)(As + ((wm * 16 + fr) * SG_LD + ks * 32 + fq * 8) * 2);
#define F2_TILE(ct_, BsC, BsN, rcur, rnext) do { \
                            if ((ct_) + 4 < 16) rcur = *(const u32x4*)(bp + ((ct_) + 4) * 2048); \
                            f32x4 acc[2] = {(f32x4){0.f, 0.f, 0.f, 0.f}, (f32x4){0.f, 0.f, 0.f, 0.f}}; \
                            _Pragma("unroll") for (int ks = 0; ks < 2; ++ks) _Pragma("unroll") for (int nt = 0; nt < 2; ++nt) { \
                                const bf16x8 bf = *(const LAS bf16x8*)(BsC + ((wn * 32 + nt * 16 + fr) * SG_LD + ks * 32 + fq * 8) * 2); \
                                acc[nt] = __builtin_amdgcn_mfma_f32_16x16x32_bf16(bf, af[ks], acc[nt], 0, 0, 0); } \
                            if ((ct_) + 1 < 16) *(LAS u32x4*)(BsN + stoff) = rnext; \
                            _Pragma("unroll") for (int nt = 0; nt < 2; ++nt) { const int m = wm * 16 + fr, n = wn * 32 + nt * 16 + fq * 4, rip = m >> 5, t2p = m & 31, ch = (ct_) * 64 + n; \
                                u32x2 w2; w2.x = pk2(acc[nt][0], acc[nt][1]); w2.y = pk2(acc[nt][2], acc[nt][3]); \
                                *(u32x2*)(WC + (size_t)lat_row(b, t1p + 256 * t2p) * DI + (ch >> 8) * 512 + rip * 256 + (ch & 255)) = w2; } \
                            LDS_BARRIER(); } while (0)
#pragma unroll 1
                        for (int ct = 0; ct < 16; ct += 4) { F2_TILE(ct, Bs0, Bs1, r0, r1); F2_TILE(ct + 1, Bs1, Bs0, r1, r2); F2_TILE(ct + 2, Bs0, Bs1, r2, r3); F2_TILE(ct + 3, Bs1, Bs0, r3, r0); }
#undef F2_TILE
                    }
                }
 }
                SEAM(pb + 3);
            }
            if (IN(pb + 4)) { PH_BEGIN();
 for (int rp_ = 0; rp_ < REPN(2); ++rp_) {
                pg8::Gemm g{WC + (size_t)CR * DI, (const bf16_t*)(ws + TAB_BZ), DI, 512, 512, 512, 0, (R - CR) / 256, 1, 4};
                pg8::EpiStore E{ZF + (size_t)CR * D, 256, D, 0};
                pg8::gemm_phase(lds, g, E, G, bx, tid); if (DUP_MIX) pg8::gemm_phase(lds, g, E, G, bx, tid);
                if (has_ctx) { SmallGemm sg{WC, (const bf16_t*)(ws + TAB_BZ), DI, 512, 512, 512, 512, 0, 0}; SmallDense sd{ZF, 256, D, CR / 64, 256 / 64, 0, 512, 0}; gemm_small_dense(lds, sg, sd, 4, G, bx, tid); if (DUP_CTX) gemm_small_dense(lds, sg, sd, 4, G, bx, tid); }
 }
                SEAM(pb + 4);
            }
            if (IN(pb + 5)) { PH_BEGIN();
 for (int rp_ = 0; rp_ < REPN(2); ++rp_) {
                pg8::Gemm g{ZF + (size_t)CR * D, WOUT, D, D, D, 0, 0, (R - CR) / 256, D / 256, 1};
                pg8::EpiStore E{YB + (size_t)CR * D, 0, D, 0};
                pg8::gemm_phase(lds, g, E, G, bx, tid); if (DUP_MIX) pg8::gemm_phase(lds, g, E, G, bx, tid);
                if (has_ctx) { SmallGemm sg{ZF, WOUT, D, D, D, D, D, 0, 0}; SmallDense sd{YB, 0, D, CR / 64, D / 64, 0, 0, 0}; gemm_small_dense(lds, sg, sd, 1, G, bx, tid); if (DUP_CTX) gemm_small_dense(lds, sg, sd, 1, G, bx, tid); }
 }
                SEAM(pb + 5);
            }
        }
#pragma unroll 1
        for (int which = 0; which < 2; ++which) {
            const int pid = pb + (which == 0 ? 19 : 22);
            if (EN_NORM && IN(pid)) { PH_BEGIN();
                const float* pg = ka->in[I_PG] + ((size_t)layer * 2 + which) * D; const float* pbv = ka->in[I_PB] + ((size_t)layer * 2 + which) * D;
                const int mlayer = which == 0 ? layer : layer + 1;
                const int shoff = which == 0 ? 3 * D : 0;
                const int goff = which == 0 ? 2 * D : 5 * D;
                const bool in_f32 = (layer == 0 && which == 0), out_f32 = (layer == 3 && which == 1);
                bf16_t* xbl = (bf16_t*)ka->out; bf16_t* xb3 = S4;
#define NR_LOAD(r_, XW, YW) do { const RowInfo ri_ = row_info(r_); const size_t xi_ = ri_.is_ctx ? ((size_t)ri_.b * CT + ri_.t) * D : ((size_t)ri_.b * T + ri_.t) * D; \
                    const bf16_t* yr_ = YB + (size_t)(r_) * D; \
                    if (in_f32) { const float* xp_ = (ri_.is_ctx ? ka->in[I_CTX] : ka->in[I_X]) + xi_; _Pragma("unroll") for (int j = 0; j < 4; ++j) XW[j] = *(const u32x4*)(xp_ + 256 * j + 4 * lane); } \
                    else { const bf16_t* xp_ = ri_.is_ctx ? (const bf16_t*)CTXX + xi_ : ((layer == 3 && which == 1) ? xb3 + xi_ : xbl + xi_); \
                        _Pragma("unroll") for (int j = 0; j < 4; ++j) { const u32x2 t_ = *(const u32x2*)(xp_ + 256 * j + 4 * lane); XW[j] = (u32x4){t_.x, t_.y, 0u, 0u}; } } \
                    _Pragma("unroll") for (int j = 0; j < 4; ++j) YW[j] = *(const u32x2*)(yr_ + 256 * j + 4 * lane); } while (0)
                if (which == 1 && (layer & 1) == 0) {
                    constexpr int TLD = 1026;
                    LAS bf16_t* TL = (LAS bf16_t*)lds;
                    const float* md2b = MOD + ((size_t)mlayer * 5) * 6 * D + shoff;
#define NT_ROW(r_, i_) do { const RowInfo ri = row_info(r_); const int mi = ri.is_ctx ? 4 : ri.b; \
                        const size_t xi = ri.is_ctx ? ((size_t)ri.b * CT + ri.t) * D : ((size_t)ri.b * T + ri.t) * D; \
                        bf16_t* xout16 = ri.is_ctx ? (bf16_t*)CTXX + xi : xbl + xi; \
                        (void)mi; f32x4 v[4]; \
                        _Pragma("unroll") for (int j = 0; j < 4; ++j) { const f32x4 x = (f32x4){bflo(xw[j].x), bfhi(xw[j].x), bflo(xw[j].y), bfhi(xw[j].y)}; \
                            const f32x4 y = (f32x4){bflo(yw[j].x), bfhi(yw[j].x), bflo(yw[j].y), bfhi(yw[j].y)}; v[j] = x * ALPHA + gtv[j] * y; } \
                        ln_norm(v, lane); \
                        _Pragma("unroll") for (int j = 0; j < 4; ++j) { const int c = 256 * j + 4 * lane; v[j] = v[j] * pgv[j] + pbw[j]; \
                            u32x2 xo; xo.x = pk2(v[j][0], v[j][1]); xo.y = pk2(v[j][2], v[j][3]); *(u32x2*)(xout16 + c) = xo; } \
                        ln_norm(v, lane); \
                        _Pragma("unroll") for (int j = 0; j < 4; ++j) { const int c = 256 * j + 4 * lane; \
                            const f32x4 h = v[j] * scv[j] + shv[j]; LAS unsigned* d_ = (LAS unsigned*)(TL + (i_) * TLD + c); d_[0] = pk2(h[0], h[1]); d_[1] = pk2(h[2], h[3]); } } while (0)
#define NT_PARAMS(mi_) do { const float* md_ = MOD + ((size_t)layer * 5 + (mi_)) * 6 * D; const float* md2_ = md2b + (size_t)(mi_) * 6 * D; \
                        _Pragma("unroll") for (int j = 0; j < 4; ++j) { const int c = 256 * j + 4 * lane; gtv[j] = *(const f32x4*)(md_ + goff + c); shv[j] = *(const f32x4*)(md2_ + c); scv[j] = *(const f32x4*)(md2_ + D + c) + 1.0f; } } while (0)
                    u32x4 xw[4], xn[4]; u32x2 yw[4], yn[4];
#pragma unroll
                    for (int j = 0; j < 4; ++j) { xw[j] = (u32x4){0u, 0u, 0u, 0u}; xn[j] = xw[j]; yw[j] = (u32x2){0u, 0u}; yn[j] = yw[j]; }
                    f32x4 pgv[4], pbw[4], gtv[4], shv[4], scv[4];
#pragma unroll
                    for (int j = 0; j < 4; ++j) { pgv[j] = *(const f32x4*)(pg + 256 * j + 4 * lane); pbw[j] = *(const f32x4*)(pbv + 256 * j + 4 * lane); }
                    for (int item = bx; item < NB * 32 * 4; item += G) {
                        const int b = item >> 7, t2 = (item >> 2) & 31, tb = item & 3;
                        NT_PARAMS(b);
                        const int rbase = lat_row(b, 32 * (64 * tb + wave * 8) + t2);
                        NR_LOAD(rbase, xw, yw);
#pragma unroll 1
                        for (int j8 = 0; j8 < 8; ++j8) {
                            if (j8 < 7) NR_LOAD(rbase + 32 * (j8 + 1), xn, yn);
                            NT_ROW(rbase + 32 * j8, wave * 8 + j8);
#pragma unroll
                            for (int j = 0; j < 4; ++j) { xw[j] = xn[j]; yw[j] = yn[j]; }
                        }
                        LDS_BARRIER();
#pragma unroll 4
                        for (int k = 0; k < 16; ++k) { const int idx = k * NTHR + tid, g8 = idx & 7, ch = idx >> 3; const LAS bf16_t* s = TL + (8 * g8) * TLD + ch;
                            u32x4 o; o.x = (unsigned)s[0] | ((unsigned)s[TLD] << 16); o.y = (unsigned)s[2 * TLD] | ((unsigned)s[3 * TLD] << 16); o.z = (unsigned)s[4 * TLD] | ((unsigned)s[5 * TLD] << 16); o.w = (unsigned)s[6 * TLD] | ((unsigned)s[7 * TLD] << 16);
                            *(u32x4*)(HT + (((size_t)b * D + ch) * 32 + t2) * 256 + 64 * tb + 8 * g8) = o; }
                        LDS_BARRIER();
                    }
                    if (layer < 2) {
                        NT_PARAMS(4);
                        for (int item = bx; item < NB * (CT / 8); item += G) {
                            const int b = item / (CT / 8), t8 = item % (CT / 8);
                            const int r = ctx_row(b, 8 * t8 + wave);
                            NR_LOAD(r, xw, yw);
                            NT_ROW(r, wave);
                            LDS_BARRIER();
#pragma unroll
                            for (int k = 0; k < 2; ++k) { const int ch = k * NTHR + tid; const LAS bf16_t* s = TL + ch;
                                u32x4 o; o.x = (unsigned)s[0] | ((unsigned)s[TLD] << 16); o.y = (unsigned)s[2 * TLD] | ((unsigned)s[3 * TLD] << 16); o.z = (unsigned)s[4 * TLD] | ((unsigned)s[5 * TLD] << 16); o.w = (unsigned)s[6 * TLD] | ((unsigned)s[7 * TLD] << 16);
                                *(u32x4*)(HTC + ((size_t)b * D + ch) * CT + 8 * t8) = o; }
                            LDS_BARRIER();
                        }
                    }
#undef NT_ROW
#undef NT_PARAMS
                } else {
                u32x4 xw[4], xn[4]; u32x2 yw[4], yn[4];
#pragma unroll
                for (int j = 0; j < 4; ++j) { xw[j] = (u32x4){0u, 0u, 0u, 0u}; xn[j] = xw[j]; yw[j] = (u32x2){0u, 0u}; yn[j] = yw[j]; }
                f32x4 pgv[4], pbw[4];
#pragma unroll
                for (int j = 0; j < 4; ++j) { pgv[j] = *(const f32x4*)(pg + 256 * j + 4 * lane); pbw[j] = *(const f32x4*)(pbv + 256 * j + 4 * lane); }
                const int nseg = (layer < 2 && gw < CR) ? 2 : 1;
#pragma unroll 1
                for (int seg = 0; seg < nseg; ++seg) {
                    const int mi = seg == 0 ? (gw >> 9) : 4;
                    const int rbeg = seg == 0 ? lat_row(gw >> 9, gw & 511) : gw, nr = seg == 0 ? T / 512 : 1;
                    const float* md = MOD + ((size_t)layer * 5 + mi) * 6 * D;
                    const float* md2 = MOD + ((size_t)(mlayer < 4 ? mlayer : 3) * 5 + mi) * 6 * D + shoff;
                    f32x4 gtv[4], shv[4], scv[4];
#pragma unroll
                    for (int j = 0; j < 4; ++j) { const int c = 256 * j + 4 * lane; gtv[j] = *(const f32x4*)(md + goff + c); shv[j] = *(const f32x4*)(md2 + c); scv[j] = *(const f32x4*)(md2 + D + c) + 1.0f; }
                    NR_LOAD(rbeg, xw, yw);
#pragma unroll 1
                    for (int k = 0; k < nr; ++k) {
                        const int r = rbeg + 512 * k;
                        if (k + 1 < nr) NR_LOAD(r + 512, xn, yn);
                        const RowInfo ri = row_info(r);
                        const size_t xi = ri.is_ctx ? ((size_t)ri.b * CT + ri.t) * D : ((size_t)ri.b * T + ri.t) * D;
                        bf16_t* xout16 = ri.is_ctx ? (bf16_t*)CTXX + xi : ((layer == 3 && which == 0) ? xb3 + xi : xbl + xi);
                        f32x4 v[4];
#pragma unroll
                        for (int j = 0; j < 4; ++j) { f32x4 x; if (in_f32) x = __builtin_bit_cast(f32x4, xw[j]); else x = (f32x4){bflo(xw[j].x), bfhi(xw[j].x), bflo(xw[j].y), bfhi(xw[j].y)};
                            const f32x4 y = (f32x4){bflo(yw[j].x), bfhi(yw[j].x), bflo(yw[j].y), bfhi(yw[j].y)}; v[j] = x * ALPHA + gtv[j] * y; }
                        ln_norm(v, lane);
#pragma unroll
                        for (int j = 0; j < 4; ++j) { const int c = 256 * j + 4 * lane; v[j] = v[j] * pgv[j] + pbw[j];
                            if (out_f32) *(f32x4*)(ka->out + xi + c) = v[j]; else { u32x2 xo; xo.x = pk2(v[j][0], v[j][1]); xo.y = pk2(v[j][2], v[j][3]); *(u32x2*)(xout16 + c) = xo; } }
                        if (mlayer < 4) {
                            ln_norm(v, lane);
                            bf16_t* o = HIN + (size_t)r * D;
#pragma unroll
                            for (int j = 0; j < 4; ++j) { const int c = 256 * j + 4 * lane; const f32x4 h = v[j] * scv[j] + shv[j]; u32x2 w; w.x = pk2(h[0], h[1]); w.y = pk2(h[2], h[3]); *(u32x2*)(o + c) = w; }
                        }
#pragma unroll
                        for (int j = 0; j < 4; ++j) { xw[j] = xn[j]; yw[j] = yn[j]; }
                    }
                }
                }
#undef NR_LOAD
                SEAM(pid);
            }
            if (EN_MLP && which == 0) {
                if (IN(pb + 20)) { PH_BEGIN();
 for (int rp_ = 0; rp_ < REPN(1); ++rp_) {
                    pg8::Gemm g{HIN + (size_t)CR * D, W1, D, D, D, 0, 0, (R - CR) / 256, DFF / 256, 1};
                    pg8::EpiStore E{HID + (size_t)CR * DFF, 0, DFF, 1};
                    pg8::gemm_phase(lds, g, E, G, bx, tid);
#if DUP_MLP
                    pg8::gemm_phase(lds, g, E, G, bx, tid);
#endif
                    if (layer < 2) { SmallGemm sg{HIN, W1, D, D, D, D, D, 0, 0}; SmallDense sd{HID, 0, DFF, CR / 64, DFF / 64, 1, 0, 0}; gemm_small_dense(lds, sg, sd, 1, G, bx, tid); }
 }
                    SEAM(pb + 20);
                }
                if (IN(pb + 21)) { PH_BEGIN();
 for (int rp_ = 0; rp_ < REPN(1); ++rp_) {
                    pg8::Gemm g{HID + (size_t)CR * DFF, W2, DFF, DFF, DFF, 0, 0, (R - CR) / 256, D / 256, 1, 1};
                    pg8::EpiStore E{YB + (size_t)CR * D, 0, D, 0};
                    pg8::gemm_phase(lds, g, E, G, bx, tid);
#if DUP_MLP
                    pg8::gemm_phase(lds, g, E, G, bx, tid);
#endif
                    if (layer < 2) { SmallGemm sg{HID, W2, DFF, DFF, DFF, DFF, DFF, 0, 0}; SmallDense sd{YB, 0, D, CR / 64, D / 64, 0, 0, 0}; gemm_small_dense(lds, sg, sd, 1, G, bx, tid); }
 }
                    SEAM(pb + 21);
                }
            }
        }
    }
#undef IN
#undef SEAM
}

extern "C" void kernel_launch(void* const* d_in, const int* in_sizes, int n_in, void* d_out, int out_size, void* d_ws, size_t ws_size, hipStream_t stream) {
    static int grid = 0;
    if (grid == 0) {
        if (n_in != 22 || ws_size < 512 * MiB) { fprintf(stderr, "kernel_launch: unexpected n_in %d / ws_size %zu\n", n_in, ws_size); grid = -1; return; }
        int dev = 0, cus = 0;
        if (hipGetDevice(&dev) != hipSuccess || hipDeviceGetAttribute(&cus, hipDeviceAttributeMultiprocessorCount, dev) != hipSuccess) { grid = -1; return; }
        if (hipFuncSetAttribute((const void*)fwd, hipFuncAttributeMaxDynamicSharedMemorySize, LDS_BYTES) != hipSuccess) { fprintf(stderr, "kernel_launch: hipFuncSetAttribute failed\n"); grid = -1; return; }
        int per_cu = 0;
        if (hipOccupancyMaxActiveBlocksPerMultiprocessor(&per_cu, (const void*)fwd, NTHR, LDS_BYTES) != hipSuccess || per_cu < 1) fprintf(stderr, "kernel_launch: occupancy query says %d\n", per_cu);
        (void)hipGetLastError();
        grid = cus;
        if (grid != 256) fprintf(stderr, "kernel_launch: %d CUs (built for 256)\n", grid);
    }
    if (grid < 0) return;
    (void)hipMemsetAsync((char*)d_ws + WS_CTL, 0, CTL_BYTES, stream);
    Args a{};
    for (int i = 0; i < 22; ++i) a.in[i] = (const float*)d_in[i];
    a.out = (float*)d_out; a.ws = (unsigned char*)d_ws;
#if MK_SINGLE
    { int last = 0; for (int id = 0; id < NPHASE; ++id) if (phase_valid(id)) last = id;
      a.ph_lo = 0; a.ph_hi = NPHASE; a.ph_last = last; a.li = 0;
      hipLaunchKernelGGL(fwd, dim3(grid), dim3(NTHR), LDS_BYTES, stream, a); }
#else
    { int li = 0;
      for (int id = 0; id < NPHASE; ++id) { if (!phase_valid(id)) continue;
          a.ph_lo = id; a.ph_hi = id + 1; a.ph_last = id; a.li = li++;
          hipLaunchKernelGGL(fwd, dim3(grid), dim3(NTHR), LDS_BYTES, stream, a); } }
#endif
}
```

```cpp
#include <hip/hip_runtime.h>
#include <cstdio>
#include <cstdint>

#define LAS __attribute__((address_space(3)))
typedef unsigned short bf16_t;
typedef short bf16x8 __attribute__((ext_vector_type(8)));
typedef float f32x4 __attribute__((ext_vector_type(4)));
typedef unsigned u32x4 __attribute__((ext_vector_type(4)));
typedef unsigned u32x2 __attribute__((ext_vector_type(2)));
typedef short s16x4 __attribute__((ext_vector_type(4)));


#ifndef EN_PRO
#define EN_PRO 1
#endif
#ifndef EN_WC
#define EN_WC 1
#endif
#ifndef EN_MIX
#define EN_MIX 1
#endif
#ifndef EN_SCAN
#define EN_SCAN 1
#endif
#ifndef EN_FOUR
#define EN_FOUR 1
#endif
#ifndef EN_NORM
#define EN_NORM 1
#endif
#ifndef EN_MLP
#define EN_MLP 1
#endif
#ifndef DUP_MIX
#define DUP_MIX 0
#endif
#ifndef DUP_CTX
#define DUP_CTX 0
#endif
#ifndef DUP_BAR
#define DUP_BAR 0
#endif
#ifndef DUP_MLP
#define DUP_MLP 0
#endif
#ifndef REP_MASK
#define REP_MASK 0
#endif
#define REPN(bit) (((REP_MASK) >> (bit)) & 1 ? 2 : 1)
#ifndef SC_QPAD
#define SC_QPAD 64
#endif
#ifndef SC_ABL
#define SC_ABL 0
#endif
#ifndef SCAN_REP
#define SCAN_REP 1
#endif
#ifndef MK_SINGLE
#define MK_SINGLE 1
#endif

constexpr int D = 1024, NB = 4, T = 8192, CT = 256, DI = 2048, NH = 4, DH = 512, DFF = 4096;
constexpr int R = NB * (T + CT);
constexpr int RH = R / 2;
constexpr int LAT0 = 2 * CT;
constexpr int NCH = RH / 64;
constexpr float ALPHA = 1.6817928305074290f;
constexpr float LN_EPS = 1e-5f;
constexpr int NWAVES = 8, NTHR = 512;

constexpr size_t MiB = 1u << 20;
constexpr size_t WS_CTL = 0, CTL_BYTES = 2 * MiB;
constexpr size_t WS_MOD = 2 * MiB;
constexpr size_t WS_CTXX = 3 * MiB;
constexpr size_t WS_PRE = 7 * MiB;
constexpr size_t WS_TAB = 10 * MiB;
constexpr size_t TAB_A1 = WS_TAB;
constexpr size_t TAB_A2 = TAB_A1 + 512 * 256 * 2;
constexpr size_t TAB_BZ = TAB_A2 + 256 * 64 * 64 * 2;
constexpr size_t TAB_ACTX = TAB_BZ + 256 * 512 * 2;
constexpr size_t TAB_GATE = TAB_ACTX + 512 * 256 * 2;
static_assert(TAB_GATE + 64 * 4096 * 2 <= 15 * MiB, "tables");
constexpr size_t WS_W = 15 * MiB;
constexpr size_t W_IN = WS_W;
constexpr size_t W_Q = W_IN + 8 * MiB, W_K = W_Q + 2 * MiB, W_V = W_K + 2 * MiB;
constexpr size_t W_OUT = W_V + 2 * MiB;
constexpr size_t W_1 = W_OUT + 4 * MiB;
constexpr size_t W_2 = W_1 + 8 * MiB;
static_assert(W_2 + 8 * MiB <= 49 * MiB, "weights");
constexpr size_t WS_HIN = 49 * MiB;
constexpr size_t WS_YB = 115 * MiB;
constexpr size_t WS_BIG = 181 * MiB;
constexpr size_t SLOT = 66 * MiB;
static_assert(WS_BIG + 5 * SLOT <= 512 * MiB, "workspace");
static_assert((size_t)RH * DI * 2 == SLOT, "slot");

#define LDS_BARRIER() do { asm volatile("s_waitcnt lgkmcnt(0)" ::: "memory"); __builtin_amdgcn_s_barrier(); asm volatile("" ::: "memory"); } while (0)
__device__ __forceinline__ unsigned f2bf(float f) { unsigned u = __builtin_bit_cast(unsigned, f); return (u + 0x7fffu + ((u >> 16) & 1u)) >> 16; }
typedef __bf16 bf16x2_t __attribute__((ext_vector_type(2)));
typedef float f32x2_t __attribute__((ext_vector_type(2)));
__device__ __forceinline__ unsigned pk2(float lo, float hi) { const f32x2_t v = {lo, hi}; return __builtin_bit_cast(unsigned, __builtin_convertvector(v, bf16x2_t)); }
__device__ __forceinline__ float bf2f(unsigned short b) { return __builtin_bit_cast(float, ((unsigned)b) << 16); }
__device__ __forceinline__ float u2f(unsigned u) { return __builtin_bit_cast(float, u); }
__device__ __forceinline__ float bflo(unsigned w) { return __builtin_bit_cast(float, w << 16); }
__device__ __forceinline__ float bfhi(unsigned w) { return __builtin_bit_cast(float, w & 0xffff0000u); }
__device__ __forceinline__ float shx(float v, int mask, int lane) { return __builtin_bit_cast(float, __builtin_amdgcn_ds_bpermute((lane ^ mask) << 2, __builtin_bit_cast(int, v))); }
template <int CTRL, int RMASK> __device__ __forceinline__ float dppf(float idv, float src) { return __builtin_bit_cast(float, __builtin_amdgcn_update_dpp(__builtin_bit_cast(int, idv), __builtin_bit_cast(int, src), CTRL, RMASK, 0xF, false)); }
__device__ __forceinline__ float scan_add64(float x) {
    x += dppf<0x111, 0xF>(0.f, x); x += dppf<0x112, 0xF>(0.f, x); x += dppf<0x114, 0xF>(0.f, x); x += dppf<0x118, 0xF>(0.f, x);
    x += dppf<0x142, 0xA>(0.f, x); x += dppf<0x143, 0xC>(0.f, x); return x; }
__device__ __forceinline__ float scan_max64(float x) {
    const float ni = -__builtin_inff();
    x = fmaxf(x, dppf<0x111, 0xF>(ni, x)); x = fmaxf(x, dppf<0x112, 0xF>(ni, x)); x = fmaxf(x, dppf<0x114, 0xF>(ni, x)); x = fmaxf(x, dppf<0x118, 0xF>(ni, x));
    x = fmaxf(x, dppf<0x142, 0xA>(ni, x)); x = fmaxf(x, dppf<0x143, 0xC>(ni, x)); return x; }
__device__ __forceinline__ float shup(float v, int d, int lane) { return __builtin_bit_cast(float, __builtin_amdgcn_ds_bpermute((lane - d) << 2, __builtin_bit_cast(int, v))); }
__device__ __forceinline__ float wave_sum(float v, int lane) {
    (void)lane;
    return __builtin_bit_cast(float, __builtin_amdgcn_readlane(__builtin_bit_cast(int, scan_add64(v)), 63));
}
__device__ __forceinline__ float siluf(float x) { return x * __builtin_amdgcn_rcpf(1.0f + __expf(-x)); }

struct RowInfo { int is_ctx, b, t; };
__device__ __forceinline__ RowInfo row_info(int r) {
    RowInfo ri;
    if (r < NB * CT) { ri.is_ctx = 1; ri.b = r / CT; ri.t = r % CT; }
    else { ri.is_ctx = 0; const int u = r - NB * CT; ri.b = u / T; ri.t = u % T; }
    return ri;
}
__device__ __forceinline__ int lat_row(int b, int t) { return NB * CT + b * T + t; }
__device__ __forceinline__ int ctx_row(int b, int t) { return b * CT + t; }
constexpr int CR = NB * CT;
constexpr int LH = RH - LAT0;

#define XB_TMO      128
#define XB_XCNT(j)  (256  + 64 * (j))
#define XB_XSUB(j)  (1280 + 64 * (j))
#define XB_XGEN(j)  (2304 + 64 * (j))
#define XB_TOP      3328
#define XB_TOPGEN   3392
#define XCD_BAR_WORDS 3456
#define XB_SPIN_CAP (1u << 18)

__device__ __forceinline__ unsigned xb_ld(unsigned* p)              { return __hip_atomic_load(p, __ATOMIC_RELAXED, __HIP_MEMORY_SCOPE_AGENT); }
__device__ __forceinline__ unsigned xb_add(unsigned* p, unsigned v) { return __hip_atomic_fetch_add(p, v, __ATOMIC_RELAXED, __HIP_MEMORY_SCOPE_AGENT); }
__device__ __forceinline__ unsigned xb_xcc_id() { return (unsigned)__builtin_amdgcn_s_getreg((3 << 11) | 20) & 0xFu; }
#define XB_SPIN(cond, bar) do { unsigned _sp = 0; while (cond) { __builtin_amdgcn_s_sleep(1); \
    if ((++_sp & 255u) == 0u) { if (xb_ld(&(bar)[XB_TMO])) break; if (_sp > XB_SPIN_CAP) { atomicAdd(&(bar)[XB_TMO], 1u); break; } } } } while (0)

struct XcdBarrier { unsigned* bar; unsigned x; volatile LAS unsigned* st; };

__device__ __forceinline__ XcdBarrier xcd_barrier_post(unsigned* bar, volatile LAS unsigned* st) {
    XcdBarrier b; b.bar = bar; b.x = xb_xcc_id(); b.st = st;
    if (threadIdx.x == 0) (void)xb_add(&bar[XB_XCNT(b.x)], 1u);
    return b;
}
__device__ __forceinline__ void xcd_barrier_complete(unsigned* bar, unsigned x, unsigned& nloc, unsigned& nx) {
    const unsigned G = gridDim.x * gridDim.y * gridDim.z;
    unsigned sum, cnt, mine, sp = 0u;
    for (;;) {
        sum = 0u; cnt = 0u; mine = 0u;
#pragma unroll
        for (unsigned j = 0; j < 16; ++j) { const unsigned c = xb_ld(&bar[XB_XCNT(j)]); sum += c; cnt += (c > 0u) ? 1u : 0u; mine = (j == x) ? c : mine; }
        if (sum == G) break;
        __builtin_amdgcn_s_sleep(1);
        if ((++sp & 255u) == 0u) { if (xb_ld(&bar[XB_TMO])) break; if (sp > XB_SPIN_CAP) { atomicAdd(&bar[XB_TMO], 1u); break; } }
    }
    nloc = mine > 0u ? mine : 1u; nx = cnt > 0u ? cnt : 1u;
}
__device__ __forceinline__ void xcd_barrier(const XcdBarrier& b, bool thread0) {
    asm volatile("s_waitcnt vmcnt(0)" ::: "memory");
    __syncthreads();
    if (thread0) {
        unsigned* bar = b.bar;
        __builtin_amdgcn_s_waitcnt(0);
        unsigned nloc = b.st[0], nx = b.st[1];
        if (nloc == 0u) { xcd_barrier_complete(bar, b.x, nloc, nx); b.st[0] = nloc; b.st[1] = nx; }
        const unsigned old = xb_add(&bar[XB_XSUB(b.x)], 1u);
        const unsigned gen = old / nloc;
        if (old + 1u == (gen + 1u) * nloc) {
            __builtin_amdgcn_fence(__ATOMIC_RELEASE, "agent");
            asm volatile("s_waitcnt vmcnt(0)" ::: "memory");
            const unsigned og = xb_add(&bar[XB_TOP], 1u);
            const unsigned tg = og / nx;
            if (og + 1u == (tg + 1u) * nx) xb_add(&bar[XB_TOPGEN], 1u);
            else XB_SPIN(xb_ld(&bar[XB_TOPGEN]) == tg, bar);
            __builtin_amdgcn_fence(__ATOMIC_ACQUIRE, "agent");
            xb_add(&bar[XB_XGEN(b.x)], 1u);
            asm volatile("s_waitcnt vmcnt(0)" ::: "memory");
        } else {
            XB_SPIN(xb_ld(&bar[XB_XGEN(b.x)]) == gen, bar);
            __builtin_amdgcn_fence(__ATOMIC_ACQUIRE, "agent");
            asm volatile("s_waitcnt vmcnt(0)" ::: "memory");
        }
    }
    __syncthreads();
}

__device__ __forceinline__ size_t qtile_off(int q, int h, int cc) {
    const int chunk = q >> 6, p = q & 63, pt = p >> 4, fr = p & 15, w = cc >> 6, ks = (cc >> 5) & 1, fq = (cc >> 3) & 3;
    const size_t blk = ((((size_t)chunk * 4 + h) * 8 + w) * 4 + pt) * 2 + ks;
    return blk * 512 + (size_t)(fq * 16 + fr) * 8 + (cc & 7);
}
__device__ __forceinline__ size_t ktile_off(int d, int h, int q) {
    const int chunk = q >> 6, s = q & 63, ks = s >> 5, fq = (s >> 3) & 3, w = d >> 6, dd = d & 63, mt = 2 * (dd >> 5) + ((dd >> 2) & 1), frp = 4 * ((dd >> 3) & 3) + (dd & 3);
    const size_t blk = ((((size_t)chunk * 4 + h) * 8 + w) * 4 + mt) * 2 + ks;
    return blk * 512 + (size_t)(fq * 16 + frp) * 8 + (s & 7);
}

__device__ __forceinline__ size_t vtile_off(int e, int h, int q) {
    const int chunk = q >> 6, s = q & 63, slice = e >> 5, e5 = e & 31, nt = e5 >> 4, fr = e5 & 15, ks = s >> 5, fq = (s >> 3) & 3;
    const size_t blk = ((((size_t)chunk * 4 + h) * 16 + slice) * 2 + nt) * 2 + ks;
    return blk * 512 + (size_t)(fq * 16 + fr) * 8 + (s & 7);
}
__device__ __forceinline__ size_t htile_off(int q, int h, int e) {
    return ((((size_t)(q >> 6) * 4 + h) * 16 + (e >> 5)) * 2048) + (size_t)(q & 63) * 32 + (e & 31);
}

namespace pg8 {
constexpr int BM = 256, BK = 64, HALF = 128, HTB = HALF * BK * 2, STAGE_BYTES = 8 * HTB, NXCD = 8, WGM = 8;
__device__ __forceinline__ int lds_byte(int r, int c) { const int st = (r >> 4) * 2 + (c >> 5), rr = r & 15, cc = c & 31, ob = rr * 64 + cc * 2; return st * 1024 + (ob ^ (((ob >> 9) & 1) << 5)); }
__device__ __forceinline__ void stage_rc(int b, int& R_, int& C_) { const int st = b / 1024, sb = b % 1024, swz = sb ^ (((sb >> 9) & 1) << 5); R_ = (st >> 1) * 16 + swz / 64; C_ = (st & 1) * 32 + (swz % 64) / 2; }
__device__ __forceinline__ int perm32(int rho) { const int n = rho >> 4, i = rho & 15; return 8 * (i >> 2) + 4 * n + (i & 3); }

struct Unit { int pm, pn, g; };
struct Gemm {
    const bf16_t* A; const bf16_t* Bt; int lda, ldb, K;
    long a_gs, b_gs;
    int nM, nN, nG;
    int rev;
};
struct Order {
    int nM, nNt, nN, nwg, G, c, rev;
    __device__ void init(const Gemm& g, int G_, int c_) { nM = g.nM; nN = g.nN; nNt = g.nN * g.nG; nwg = nM * nNt; G = G_; c = c_; rev = g.rev; }
    __device__ bool next(int i, Unit& u) const {
        const long L = (long)i * G + c; if (L >= nwg) return false;
        int wgid = (int)L; { const int q = nwg / NXCD, r = nwg % NXCD, xcd = wgid % NXCD, off = wgid / NXCD; wgid = (xcd < r ? xcd * (q + 1) : r * (q + 1) + (xcd - r) * q) + off; }
        const int nig = WGM * nNt, gid = wgid / nig, fm = gid * WGM, gsz = (nM - fm) < WGM ? (nM - fm) : WGM;
        u.pm = fm + ((wgid % nig) % gsz); if (rev) u.pm = nM - 1 - u.pm; const int pnt = (wgid % nig) / gsz; u.g = pnt / nN; u.pn = pnt - u.g * nN; return true;
    }
};
__device__ __forceinline__ unsigned cvt_pk_bf16(float lo, float hi) { return pk2(lo, hi); }

struct EpiStore {
    bf16_t* O; long o_gs; int ldc; int act;
    int mode, off;
    __device__ __forceinline__ void operator()(const f32x4 (&acc)[2][2][4][2], const Unit& u, int wr, int wc, int fr, int fq) const {
        const int row0 = u.pm * BM + wr * 64 + fr; const int col0 = u.pn * BM + wc * 32 + 8 * fq; bf16_t* base = O + (long)u.g * o_gs;
#pragma unroll
        for (int ai = 0; ai < 2; ++ai)
#pragma unroll
            for (int m = 0; m < 4; ++m) { bf16_t* rowp = base + (size_t)(row0 + ai * HALF + m * 16) * ldc + col0;
#pragma unroll
                for (int bj = 0; bj < 2; ++bj) { f32x4 v0 = acc[ai][bj][m][0], v1 = acc[ai][bj][m][1];
                    if (act == 1) {
#pragma unroll
                        for (int j = 0; j < 4; ++j) { const float a = fmaxf(v0[j], 0.f), b = fmaxf(v1[j], 0.f); v0[j] = a * a; v1[j] = b * b; } }
                    u32x4 w; w.x = cvt_pk_bf16(v0[0], v0[1]); w.y = cvt_pk_bf16(v0[2], v0[3]); w.z = cvt_pk_bf16(v1[0], v1[1]); w.w = cvt_pk_bf16(v1[2], v1[3]);
                    if (mode == 0) *(u32x4*)(rowp + bj * HALF) = w;
                    else if (mode == 1) *(u32x4*)(O + qtile_off(off + row0 + ai * HALF + m * 16, u.g, col0 + bj * HALF)) = w;
                    else if (mode == 2) *(u32x4*)(O + ktile_off(row0 + ai * HALF + m * 16, u.g, off + col0 + bj * HALF)) = w;
                    else *(u32x4*)(O + vtile_off(row0 + ai * HALF + m * 16, u.g, off + col0 + bj * HALF)) = w; } }
    }
};

template <class Epi>
__device__ __forceinline__ void gemm_phase(LAS unsigned char* lds, const Gemm g, const Epi& E, int G_, int c_, int tid_in) {
    int tid_ = tid_in; asm volatile("" : "+v"(tid_));
    const int tid = tid_, wid = __builtin_amdgcn_readfirstlane(tid >> 6), lane = tid & 63, wr = wid >> 2, wc = wid & 3, fr = lane & 15, fq = lane >> 4;
    const int K = g.K, nt = K / BK;
    Order S; S.init(g, G_, c_);
    unsigned voffA[2], voffB[2];
#pragma unroll
    for (int i = 0; i < 2; ++i) { int R_, C_; stage_rc(tid * 16 + i * 8192, R_, C_); const int Rb = (R_ & ~31) + perm32(R_ & 31);
        voffA[i] = (unsigned)(R_ * g.lda + C_) * 2u; voffB[i] = (unsigned)(Rb * g.ldb + C_) * 2u; }
    const size_t kstep = (size_t)(BK * 2);
    const size_t hstepA = (size_t)HALF * g.lda * 2, hstepB = (size_t)HALF * g.ldb * 2;
    const unsigned ldsw = (unsigned)wid * 1024u;
    const int aoff = lds_byte(wr * 64 + fr, fq * 8), boff = lds_byte(wc * 32 + fr, fq * 8);
#define PG8_SA(b, h) (((b) * 2 + (h)) * HTB)
#define PG8_SB(b, h) ((4 + (b) * 2 + (h)) * HTB)
#define PG8_STAGE(bufoff, gbase, voff) do { _Pragma("unroll") for (int _i = 0; _i < 2; ++_i) \
        __builtin_amdgcn_global_load_lds((const unsigned*)((const char*)(gbase) + (voff)[_i]), (LAS unsigned*)(lds + (bufoff) + ldsw + _i * 8192), 16, 0, 0); } while (0)
#define PG8_LDA(dst, b, h) do { _Pragma("unroll") for (int m = 0; m < 4; ++m) _Pragma("unroll") for (int k = 0; k < 2; ++k) dst[m][k] = *(const LAS bf16x8*)(lds + PG8_SA(b, h) + aoff + m * 2048 + k * 1024); } while (0)
#define PG8_LDB(dst, b, h) do { _Pragma("unroll") for (int n = 0; n < 2; ++n) _Pragma("unroll") for (int k = 0; k < 2; ++k) dst[n][k] = *(const LAS bf16x8*)(lds + PG8_SB(b, h) + boff + n * 2048 + k * 1024); } while (0)
#define PG8_MMA(ai, bj, At, Bt) do { __builtin_amdgcn_s_setprio(1); _Pragma("unroll") for (int m = 0; m < 4; ++m) _Pragma("unroll") for (int n = 0; n < 2; ++n) _Pragma("unroll") for (int k = 0; k < 2; ++k) \
        acc[ai][bj][m][n] = __builtin_amdgcn_mfma_f32_16x16x32_bf16(Bt[n][k], At[m][k], acc[ai][bj][m][n], 0, 0, 0); __builtin_amdgcn_s_setprio(0); } while (0)
#define PG8_WAIT_V(n) asm volatile("s_waitcnt vmcnt(" #n ")" ::: "memory")
#define PG8_WAIT_L(n) asm volatile("s_waitcnt lgkmcnt(" #n ")" ::: "memory")
#define PG8_BAR __builtin_amdgcn_s_barrier()
#define PG8_SCHED __builtin_amdgcn_sched_barrier(0)
#define PG8_APTR(u) ((const char*)(g.A + (long)(u).g * g.a_gs) + (size_t)(u).pm * 2 * hstepA)
#define PG8_BPTR(u) ((const char*)(g.Bt + (long)(u).g * g.b_gs) + (size_t)(u).pn * 2 * hstepB)
    Unit cur, nxt; int ui = 0;
    if (!S.next(0, cur)) return;
    f32x4 acc[2][2][4][2];
#pragma unroll
    for (int a = 0; a < 2; ++a)
#pragma unroll
        for (int b = 0; b < 2; ++b)
#pragma unroll
            for (int m = 0; m < 4; ++m)
#pragma unroll
                for (int n = 0; n < 2; ++n) acc[a][b][m][n] = (f32x4){0.f, 0.f, 0.f, 0.f};
    bf16x8 At[4][2], B0[2][2], B1[2][2];
    const char* cA = PG8_APTR(cur); const char* cB = PG8_BPTR(cur);
    PG8_STAGE(PG8_SB(0, 0), cB, voffB); PG8_STAGE(PG8_SA(0, 0), cA, voffA); PG8_STAGE(PG8_SB(0, 1), cB + hstepB, voffB); PG8_STAGE(PG8_SA(0, 1), cA + hstepA, voffA);
    if (wr == 1) PG8_BAR;
    PG8_WAIT_V(4); PG8_BAR;
    PG8_STAGE(PG8_SB(1, 0), cB + kstep, voffB); PG8_STAGE(PG8_SA(1, 0), cA + kstep, voffA); PG8_STAGE(PG8_SB(1, 1), cB + hstepB + kstep, voffB);
    PG8_WAIT_V(6); PG8_BAR;
    for (;;) {
        const bool has_next = S.next(ui + 1, nxt);
        const char* nA = has_next ? PG8_APTR(nxt) : cA; const char* nB = has_next ? PG8_BPTR(nxt) : cB;
        for (int t = 0; t < nt; t += 2) {
            const bool last = (t == nt - 2);
            const char* a1 = cA + (size_t)(t + 1) * kstep;
            const char* a2 = last ? nA : cA + (size_t)(t + 2) * kstep; const char* b2 = last ? nB : cB + (size_t)(t + 2) * kstep;
            const char* a3 = a2 + kstep; const char* b3 = b2 + kstep;
            PG8_LDB(B0, 0, 0); PG8_SCHED; PG8_LDA(At, 0, 0); PG8_STAGE(PG8_SA(1, 1), a1 + hstepA, voffA);
            PG8_WAIT_L(8); PG8_BAR; PG8_WAIT_L(0); PG8_MMA(0, 0, At, B0); PG8_BAR; PG8_SCHED;
            PG8_LDB(B1, 0, 1); PG8_STAGE(PG8_SB(0, 0), b2, voffB);
            PG8_BAR; PG8_WAIT_L(0); PG8_MMA(0, 1, At, B1); PG8_BAR;
            PG8_LDA(At, 0, 1); PG8_STAGE(PG8_SA(0, 0), a2, voffA);
            PG8_BAR; PG8_WAIT_L(0); PG8_MMA(1, 0, At, B0); PG8_BAR; PG8_SCHED;
            PG8_STAGE(PG8_SB(0, 1), b2 + hstepB, voffB);
            PG8_WAIT_V(6); PG8_BAR; PG8_MMA(1, 1, At, B1); PG8_BAR;
            PG8_LDB(B0, 1, 0); PG8_SCHED; PG8_LDA(At, 1, 0); PG8_STAGE(PG8_SA(0, 1), a2 + hstepA, voffA);
            PG8_WAIT_L(8); PG8_BAR; PG8_WAIT_L(0); PG8_MMA(0, 0, At, B0); PG8_BAR; PG8_SCHED;
            PG8_LDB(B1, 1, 1); PG8_STAGE(PG8_SB(1, 0), b3, voffB);
            PG8_BAR; PG8_WAIT_L(0); PG8_MMA(0, 1, At, B1); PG8_BAR;
            PG8_LDA(At, 1, 1); PG8_STAGE(PG8_SA(1, 0), a3, voffA);
            PG8_BAR; PG8_WAIT_L(0); PG8_MMA(1, 0, At, B0); PG8_BAR; PG8_SCHED;
            PG8_STAGE(PG8_SB(1, 1), b3 + hstepB, voffB);
            PG8_WAIT_V(6); PG8_BAR; PG8_MMA(1, 1, At, B1); PG8_BAR;
        }
        E(acc, cur, wr, wc, fr, fq);
        if (!has_next) break;
#pragma unroll
        for (int a = 0; a < 2; ++a)
#pragma unroll
            for (int b = 0; b < 2; ++b)
#pragma unroll
                for (int m = 0; m < 4; ++m)
#pragma unroll
                    for (int n = 0; n < 2; ++n) acc[a][b][m][n] = (f32x4){0.f, 0.f, 0.f, 0.f};
        cur = nxt; cA = nA; cB = nB; ++ui;
    }
    PG8_WAIT_V(0);
    if (wr == 0) PG8_BAR;
    PG8_BAR;
#undef PG8_SA
#undef PG8_SB
#undef PG8_STAGE
#undef PG8_LDA
#undef PG8_LDB
#undef PG8_MMA
#undef PG8_WAIT_V
#undef PG8_WAIT_L
#undef PG8_BAR
#undef PG8_SCHED
#undef PG8_APTR
#undef PG8_BPTR
}
}

struct SmallGemm { const bf16_t* A; const bf16_t* B; int lda, ldb, K, akseg, bkseg; long aseg, bseg; int a_tiled; int b_kt; };
constexpr int SG_LD = 72;
constexpr int SG_TILE = 64 * SG_LD * 2;
template <class Dec, class Epi>
__device__ __forceinline__ void gemm_small(LAS unsigned char* lds, const SmallGemm g, int nunits, const Dec& dec, const Epi& epi, int G_, int c_, int tid_in) {
    int tid_ = tid_in; asm volatile("" : "+v"(tid_));
    const int tid = tid_, wid = tid >> 6, lane = tid & 63, wm = wid >> 1, wn = wid & 1, fr = lane & 15, fq = lane >> 4;
    const int lrow = tid >> 3, lk = (tid & 7) * 8;
    const int nk = g.K / 64;
    const unsigned stoff = (unsigned)(lrow * SG_LD + lk) * 2u;
#define SG_LOAD(ra_, rb_, kt_) do { const int k_ = (kt_) * 64 + lk; \
        if (g.a_tiled) ra_ = *(const u32x4*)(g.A + (((((size_t)aoff * 8 + (k_ >> 6)) * 4 + (lrow >> 4)) * 2 + ((k_ >> 5) & 1)) * 512 + (size_t)(((k_ >> 3) & 3) * 16 + (lrow & 15)) * 8)); \
        else ra_ = *(const u32x4*)(ap + (long)(k_ / g.akseg) * g.aseg + (k_ % g.akseg)); \
        if (g.b_kt) rb_ = *(const u32x4*)(g.B + ktile_off((kt_) * 64 + lrow, (int)(boff & 3), (int)(boff >> 2) * 64 + lk));     \
        else rb_ = *(const u32x4*)(bp + (long)(k_ / g.bkseg) * g.bseg + (k_ % g.bkseg)); } while (0)
#define SG_STORE(ra_, rb_, bufi_) do { *(LAS u32x4*)(lds + ((bufi_) * 2 + 0) * SG_TILE + stoff) = ra_; *(LAS u32x4*)(lds + ((bufi_) * 2 + 1) * SG_TILE + stoff) = rb_; } while (0)
#define SG_COMPUTE(bufi_) do { const LAS unsigned char* As = lds + ((bufi_) * 2 + 0) * SG_TILE; const LAS unsigned char* Bs = lds + ((bufi_) * 2 + 1) * SG_TILE; \
        _Pragma("unroll") for (int ks = 0; ks < 2; ++ks) { const bf16x8 af = *(const LAS bf16x8*)(As + ((wm * 16 + fr) * SG_LD + ks * 32 + fq * 8) * 2); \
            _Pragma("unroll") for (int nt = 0; nt < 2; ++nt) { bf16x8 bf; \
                if (g.b_kt) {     \
                    const s16x4 t0_ = __builtin_amdgcn_ds_read_tr16_b64_v4i16((LAS s16x4*)(Bs + ((ks * 32 + 8 * fq + (fr >> 2)) * SG_LD + wn * 32 + nt * 16 + 4 * (fr & 3)) * 2)); \
                    const s16x4 t1_ = __builtin_amdgcn_ds_read_tr16_b64_v4i16((LAS s16x4*)(Bs + ((ks * 32 + 8 * fq + 4 + (fr >> 2)) * SG_LD + wn * 32 + nt * 16 + 4 * (fr & 3)) * 2)); \
                    bf = (bf16x8){t0_[0], t0_[1], t0_[2], t0_[3], t1_[0], t1_[1], t1_[2], t1_[3]}; } \
                else bf = *(const LAS bf16x8*)(Bs + ((wn * 32 + nt * 16 + fr) * SG_LD + ks * 32 + fq * 8) * 2); \
                acc[nt] = __builtin_amdgcn_mfma_f32_16x16x32_bf16(bf, af, acc[nt], 0, 0, 0); } } } while (0)
    for (int u = c_; u < nunits; u += G_) {
        long aoff, boff; dec(u, aoff, boff);
        const bf16_t* ap = g.A + aoff + (long)lrow * g.lda; const bf16_t* bp = g.B + boff + (long)lrow * g.ldb;
        f32x4 acc[2] = {(f32x4){0.f, 0.f, 0.f, 0.f}, (f32x4){0.f, 0.f, 0.f, 0.f}};
        u32x4 ra0, rb0, ra1, rb1, ra2, rb2, ra3, rb3;
        ra0 = (u32x4){0u, 0u, 0u, 0u}; rb0 = ra0; ra1 = ra0; rb1 = ra0; ra2 = ra0; rb2 = ra0; ra3 = ra0; rb3 = ra0;
        SG_LOAD(ra0, rb0, 0); if (nk > 1) SG_LOAD(ra1, rb1, 1); if (nk > 2) SG_LOAD(ra2, rb2, 2); if (nk > 3) SG_LOAD(ra3, rb3, 3);
        SG_STORE(ra0, rb0, 0);
        LDS_BARRIER();
#define SG_TURN(kt_, bufc, rnextA, rnextB, rfreeA, rfreeB) do { if ((kt_) < nk) { \
            SG_COMPUTE(bufc); \
            if ((kt_) + 1 < nk) SG_STORE(rnextA, rnextB, (bufc) ^ 1); \
            if ((kt_) + 4 < nk) SG_LOAD(rfreeA, rfreeB, (kt_) + 4); \
            LDS_BARRIER(); } } while (0)
        for (int kt = 0; kt < nk; kt += 4) {
            SG_TURN(kt,     0, ra1, rb1, ra0, rb0);
            SG_TURN(kt + 1, 1, ra2, rb2, ra1, rb1);
            SG_TURN(kt + 2, 0, ra3, rb3, ra2, rb2);
            SG_TURN(kt + 3, 1, ra0, rb0, ra3, rb3);
        }
#undef SG_TURN
#pragma unroll
        for (int nt = 0; nt < 2; ++nt) epi(u, wm * 16 + fr, wn * 32 + nt * 16 + fq * 4, acc[nt]);
    }
#undef SG_LOAD
#undef SG_STORE
#undef SG_COMPUTE
}

struct SmallDense { bf16_t* O; long o_gs; int ldc, mt, nt, act; long a_gs, b_gs; int mode; };
__device__ __forceinline__ void gemm_small_dense(LAS unsigned char* lds, const SmallGemm g, const SmallDense d, int ngroups, int G_, int c_, int tid_in) {
    const int per = d.mt * d.nt;
    auto dec = [=](int u, long& ao, long& bo) { const int gi = u / per, r = u % per, mi = r / d.nt, ni = r % d.nt; ao = gi * d.a_gs + (long)mi * 64 * g.lda; bo = gi * d.b_gs + (long)ni * 64 * g.ldb; };
    auto epi = [=](int u, int m, int n, const f32x4& v) { const int gi = u / per, r = u % per, mi = r / d.nt, ni = r % d.nt;
        f32x4 x = v; if (d.act == 1) {
#pragma unroll
            for (int i = 0; i < 4; ++i) { const float a = fmaxf(x[i], 0.f); x[i] = a * a; } }
        u32x2 w; w.x = pk2(x[0], x[1]); w.y = pk2(x[2], x[3]);
        if (d.mode == 0) *(u32x2*)(d.O + gi * d.o_gs + (size_t)(mi * 64 + m) * d.ldc + ni * 64 + n) = w;
        else if (d.mode == 1) *(u32x2*)(d.O + qtile_off(mi * 64 + m, gi, ni * 64 + n)) = w;
        else if (d.mode == 2) *(u32x2*)(d.O + ktile_off(mi * 64 + m, gi, ni * 64 + n)) = w;
        else *(u32x2*)(d.O + vtile_off(mi * 64 + m, gi, ni * 64 + n)) = w; };
    gemm_small(lds, g, ngroups * per, dec, epi, G_, c_, tid_in);
}

struct Args { const float* in[22]; float* out; unsigned char* ws; int ph_lo, ph_hi, ph_last, li; };
enum { I_X = 0, I_C, I_CTX, I_CCTX, I_ADAW, I_ADAB, I_PG, I_PB, I_WIN, I_WCONV, I_BCONV, I_WQ, I_WK, I_WV, I_WGATE, I_BGATE, I_GNW, I_SKIP, I_WOUT, I_FWOUT, I_W1, I_W2 };

constexpr int LDS_BYTES = 147456;
constexpr int LDS_MISC = LDS_BYTES - 256;

__device__ __forceinline__ void transpose_item(const float* W, int K, int N, bf16_t* WT, float scale, LAS float* scr, int item, int lane) {
    const int nblk = N / 32, kb = item / nblk, nb = item % nblk, k0 = 64 * kb, n0 = 32 * nb;
#pragma unroll 8
    for (int i = 0; i < 32; ++i) { const int kk = 2 * i + (lane >> 5); scr[kk * 33 + (lane & 31)] = W[(size_t)(k0 + kk) * N + n0 + (lane & 31)] * scale; }
    asm volatile("s_waitcnt lgkmcnt(0)" ::: "memory");
    const int c = lane & 7;
#pragma unroll
    for (int j = 0; j < 4; ++j) { const int n = (lane >> 3) + 8 * j; const LAS float* s = scr + (8 * c) * 33 + n;
        u32x4 o; o.x = pk2(s[0 * 33], s[1 * 33]); o.y = pk2(s[2 * 33], s[3 * 33]); o.z = pk2(s[4 * 33], s[5 * 33]); o.w = pk2(s[6 * 33], s[7 * 33]);
        *(u32x4*)(WT + (size_t)(n0 + n) * K + k0 + 8 * c) = o; }
    asm volatile("s_waitcnt lgkmcnt(0)" ::: "memory");
}

__device__ __forceinline__ void ln_norm(f32x4 (&v)[4], int lane) {
    float s = 0.f;
#pragma unroll
    for (int j = 0; j < 4; ++j) s += (v[j][0] + v[j][1]) + (v[j][2] + v[j][3]);
    const float mean = wave_sum(s, lane) * (1.f / D); float s2 = 0.f;
#pragma unroll
    for (int j = 0; j < 4; ++j) { v[j] = v[j] - mean; s2 += (v[j][0] * v[j][0] + v[j][1] * v[j][1]) + (v[j][2] * v[j][2] + v[j][3] * v[j][3]); }
    const float rstd = __builtin_amdgcn_rsqf(wave_sum(s2, lane) * (1.f / D) + LN_EPS);
#pragma unroll
    for (int j = 0; j < 4; ++j) v[j] = v[j] * rstd;
}

constexpr int PL = 24;
constexpr int NPHASE = 2 + 4 * PL;
__host__ __device__ inline bool phase_valid(int id) {
    if (id < 2) return true;
    const int layer = (id - 2) / PL, k = (id - 2) % PL;
    if (layer > 3) return false;
    if (k == 0 || (k >= 19 && k <= 22)) return true;
    if (layer & 1) return k >= 2 && k <= 5;
    return k >= 1 && k <= 18;
}


#define MOD ((float*)(ws + WS_MOD))
#define CTXX ((float*)(ws + WS_CTXX))
#define PRE ((float*)(ws + WS_PRE))
#define HIN ((bf16_t*)(ws + WS_HIN))
#define YB ((bf16_t*)(ws + WS_YB))
#define WIN ((bf16_t*)(ws + W_IN))
#define WQ ((bf16_t*)(ws + W_Q))
#define WK ((bf16_t*)(ws + W_K))
#define WV ((bf16_t*)(ws + W_V))
#define WOUT ((bf16_t*)(ws + W_OUT))
#define W1 ((bf16_t*)(ws + W_1))
#define W2 ((bf16_t*)(ws + W_2))
#define GATET ((bf16_t*)(ws + TAB_GATE))
#define S0 ((bf16_t*)(ws + WS_BIG + 0 * SLOT))
#define S1 ((bf16_t*)(ws + WS_BIG + 1 * SLOT))
#define S2 ((bf16_t*)(ws + WS_BIG + 2 * SLOT))
#define S3 ((bf16_t*)(ws + WS_BIG + 3 * SLOT))
#define S4 ((bf16_t*)(ws + WS_BIG + 4 * SLOT))
#define YH (YB + ((size_t)CR + (size_t)half * LH) * D)
#define YHC (YB + (size_t)half * LAT0 * D)
#define HCB (YH + (size_t)NCH * 4 * 2 * 4096 + (size_t)NCH * 4 * 2 * 384 * 2)
#define PREQ ((float*)(HCB + (size_t)LAT0 * DI))
#define HH (HIN + ((size_t)CR + (size_t)half * LH) * D)
#define HHC (HIN + (size_t)half * LAT0 * D)
#define HT ((bf16_t*)(ws + WS_BIG))
#define HTC (HT + (size_t)NB * D * T)
#define PB ((bf16_t*)(ws + WS_BIG + 1 * SLOT))
#define WC ((bf16_t*)(ws + WS_BIG + 3 * SLOT))
#define ZF ((bf16_t*)(ws + WS_BIG))
#define HID ((bf16_t*)(ws + WS_BIG))

constexpr int SC_PLD = 36, SC_VLD = 72;
#define SC_ROW0(j) (((j) < 4) ? (bl * CT + (dir ? 3 - (j) : (j)) * 64) : (LAT0 + bl * T + (dir ? 127 - ((j) - 4) : ((j) - 4)) * 64))
#define SC_LOADQ(dst, r0) do { _Pragma("unroll") for (int pt = 0; pt < 4; ++pt) _Pragma("unroll") for (int ks = 0; ks < 2; ++ks) \
        dst[pt][ks] = __builtin_bit_cast(bf16x8, __builtin_amdgcn_raw_buffer_load_b128(rW, loff, oQ + ((((((r0) >> 6) * 4 + hh) * 8 + w) * 4 + pt) * 2 + ks) * 1024, 0)); } while (0)
#define SC_LOADQ1(dst, r0, pt, ks) dst[pt][ks] = __builtin_bit_cast(bf16x8, __builtin_amdgcn_raw_buffer_load_b128(rW, loff, oQ + ((((((r0) >> 6) * 4 + hh) * 8 + w) * 4 + (pt)) * 2 + (ks)) * 1024, 0))
#define SC_LOADK1(dst, r0, mt, ks) dst[mt][ks] = __builtin_bit_cast(bf16x8, __builtin_amdgcn_raw_buffer_load_b128(rW, loff, oK + ((((((r0) >> 6) * 4 + hh) * 8 + w) * 4 + (mt)) * 2 + (ks)) * 1024, 0))
#define SC_LOADK(dst, r0) do { _Pragma("unroll") for (int mt = 0; mt < 4; ++mt) _Pragma("unroll") for (int ks = 0; ks < 2; ++ks) \
        dst[mt][ks] = __builtin_bit_cast(bf16x8, __builtin_amdgcn_raw_buffer_load_b128(rW, loff, oK + ((((((r0) >> 6) * 4 + hh) * 8 + w) * 4 + mt) * 2 + ks) * 1024, 0)); } while (0)
#define SC_LOADS(P, r0) do { const int ci_ = ((((r0) >> 6) * 4 + hh) * 2 + dir); \
        P##sg0 = __builtin_bit_cast(bf16x8, __builtin_amdgcn_raw_buffer_load_b128(rW, loff, oS + ci_ * 8192 + (w >> 1) * 2048, 0)); P##sg1 = __builtin_bit_cast(bf16x8, __builtin_amdgcn_raw_buffer_load_b128(rW, loff, oS + ci_ * 8192 + (w >> 1) * 2048 + 1024, 0)); \
        P##v = __builtin_bit_cast(u32x4, __builtin_amdgcn_raw_buffer_load_b128(rW, loff, oV + ((((r0) >> 6) * 4 + hh) * 16 + slice) * 4096 + (w & 3) * 1024, 0));     \
        P##wka = __builtin_bit_cast(u32x4, __builtin_amdgcn_raw_buffer_load_b128(rW, wkoff, oG + ci_ * 1536 + 1296, 0));         \
        P##wint = __builtin_bit_cast(float, __builtin_amdgcn_raw_buffer_load_b32(rW, gcp, oG + ci_ * 1536 + 512, 0)); P##em = __builtin_bit_cast(float, __builtin_amdgcn_raw_buffer_load_b32(rW, gcp, oG + ci_ * 1536 + 768, 0)); \
        P##dec = __builtin_bit_cast(float, __builtin_amdgcn_raw_buffer_load_b32(rW, 0, oG + ci_ * 1536 + 1280, 0)); } while (0)
#define SC_VWRITE(bufi, P) do { LAS bf16_t* vt_ = VB + (bufi) * 2 * 3072; LAS bf16_t* vw_ = vt_ + 3072; \
        if (w < 5) { const float wk_[8] = {bflo(P##wka.x), bfhi(P##wka.x), bflo(P##wka.y), bfhi(P##wka.y), bflo(P##wka.z), bfhi(P##wka.z), bflo(P##wka.w), bfhi(P##wka.w)};     \
            if (w < 4) { *(LAS u32x4*)(vt_ + tid * 8) = P##v; \
                u32x4 sv_; sv_.x = pk2(bflo(P##v.x) * wk_[0], bfhi(P##v.x) * wk_[1]); sv_.y = pk2(bflo(P##v.y) * wk_[2], bfhi(P##v.y) * wk_[3]); \
                sv_.z = pk2(bflo(P##v.z) * wk_[4], bfhi(P##v.z) * wk_[5]); sv_.w = pk2(bflo(P##v.w) * wk_[6], bfhi(P##v.w) * wk_[7]); *(LAS u32x4*)(vw_ + tid * 8) = sv_; } \
            else if (lane < 8) { const u32x4 sv_ = P##wka; \
                int ln_ = lane; asm volatile("" : "+v"(ln_));     \
                *(LAS u32x4*)(vw_ + (4 + (ln_ >> 2)) * 512 + (ln_ & 3) * 16 * 8) = sv_; } } } while (0)
#define SC_STEP(J, Qc, Qn, Kc, Kn, C, N) do { \
    const int j_ = (J); const int row0 = SC_ROW0(j_); const int jn_ = j_ < 131 ? j_ + 1 : 131; const int row1 = SC_ROW0(jn_); \
    const int hsel = (j_ < 4) ? (dir ? 2 : 0) : ((j_ < 68) ? 0 : 1); \
    const int buf = j_ & 1; \
    const LAS bf16_t* VT = VB + buf * 2 * 3072; const LAS bf16_t* VW = VT + 3072; \
    LAS bf16_t* Pb_ = Pbh + buf * (8 * 64 * 40); LAS float* Nq_ = NQs + buf * (8 * 64);        \
    SC_LOADS(N, row1); \
      \
    if (!(abl_ & 1)) _Pragma("unroll") for (int nt = 0; nt < 3; ++nt) { \
        f32x4 d1[4]; \
        _Pragma("unroll") for (int pt = 0; pt < 4; ++pt) d1[pt] = (f32x4){0.f, 0.f, 0.f, 0.f}; \
        _Pragma("unroll") for (int ks = 0; ks < 2; ++ks) { \
            u32x4 bw; bw.x = pg8::cvt_pk_bf16(st[2 * ks][nt][0], st[2 * ks][nt][1]); bw.y = pg8::cvt_pk_bf16(st[2 * ks][nt][2], st[2 * ks][nt][3]); \
            bw.z = pg8::cvt_pk_bf16(st[2 * ks + 1][nt][0], st[2 * ks + 1][nt][1]); bw.w = pg8::cvt_pk_bf16(st[2 * ks + 1][nt][2], st[2 * ks + 1][nt][3]); \
            const bf16x8 bs = __builtin_bit_cast(bf16x8, bw); \
            _Pragma("unroll") for (int pt = 0; pt < 4; ++pt) d1[pt] = __builtin_amdgcn_mfma_f32_16x16x32_bf16(bs, Qc[pt][ks], d1[pt], 0, 0, 0); \
            SC_LOADQ1(Qn, row1, (nt * 2 + ks) >> 1, (nt * 2 + ks) & 1);     } \
        _Pragma("unroll") for (int pt = 0; pt < 4; ++pt) { \
            if (nt < 2) { u32x2 pw_; pw_.x = pg8::cvt_pk_bf16(d1[pt][0], d1[pt][1]); pw_.y = pg8::cvt_pk_bf16(d1[pt][2], d1[pt][3]); *(LAS u32x2*)(Pb_ + (w * 64 + 16 * pt + fr) * 40 + 16 * nt + 4 * fq) = pw_; }     \
            else if (fq == 0) Nq_[w * 64 + 16 * pt + fr] = d1[pt][0]; } } \
    SC_LOADQ1(Qn, row1, 3, 0); SC_LOADQ1(Qn, row1, 3, 1); \
    LDS_BARRIER();                                                       \
      \
    f32x4 d2 = (f32x4){0.f, 0.f, 0.f, 0.f}, d3 = (f32x4){0.f, 0.f, 0.f, 0.f}; \
    if (!(abl_ & 2)) {     \
        const int nt2 = w & 1; \
        const bf16x8 vt0 = *(const LAS bf16x8*)(VT + (nt2 * 2 + 0) * 512 + lane * 8), vt1 = *(const LAS bf16x8*)(VT + (nt2 * 2 + 1) * 512 + lane * 8); \
        const bf16x8 vo0 = *(const LAS bf16x8*)(VT + 4 * 512 + lane * 8), vo1 = *(const LAS bf16x8*)(VT + 5 * 512 + lane * 8); \
        d2 = __builtin_amdgcn_mfma_f32_16x16x32_bf16(vt0, C##sg0, d2, 0, 0, 0); d3 = __builtin_amdgcn_mfma_f32_16x16x32_bf16(vo0, C##sg0, d3, 0, 0, 0); \
        d2 = __builtin_amdgcn_mfma_f32_16x16x32_bf16(vt1, C##sg1, d2, 0, 0, 0); d3 = __builtin_amdgcn_mfma_f32_16x16x32_bf16(vo1, C##sg1, d3, 0, 0, 0); } \
      \
    if (!(abl_ & 4)) _Pragma("unroll") for (int nt = 0; nt < 3; ++nt) { \
        const bf16x8 vw0 = *(const LAS bf16x8*)(VW + (nt * 2 + 0) * 512 + lane * 8), vw1 = *(const LAS bf16x8*)(VW + (nt * 2 + 1) * 512 + lane * 8); \
        _Pragma("unroll") for (int mt = 0; mt < 4; ++mt) { f32x4 a = st[mt][nt] * C##dec; \
            a = __builtin_amdgcn_mfma_f32_16x16x32_bf16(Kc[mt][0], vw0, a, 0, 0, 0); \
            a = __builtin_amdgcn_mfma_f32_16x16x32_bf16(Kc[mt][1], vw1, a, 0, 0, 0); st[mt][nt] = a; \
            if (nt < 2) SC_LOADK1(Kn, row1, (nt * 4 + mt) >> 1, (nt * 4 + mt) & 1); } } \
    if (!(abl_ & 8)) {     \
        f32x4 o1 = (f32x4){0.f, 0.f, 0.f, 0.f}; float nq = 0.f; \
        _Pragma("unroll") for (int ww = 0; ww < 8; ++ww) { const u32x2 cpr_ = *(const LAS u32x2*)(Pb_ + (ww * 64 + cp) * 40 + cv); nq += Nq_[ww * 64 + cp]; \
            o1 += (f32x4){bflo(cpr_.x), bfhi(cpr_.x), bflo(cpr_.y), bfhi(cpr_.y)}; } \
        const float den = C##wint * nq + d3[0]; const float scl = __builtin_amdgcn_rcpf(fmaxf(fabsf(den), C##em)); \
        const f32x4 o = (o1 * C##wint + d2) * scl; \
        u32x2 ow; ow.x = pk2(o[0], o[1]); ow.y = pk2(o[2], o[3]); \
        unsigned lo_ = loff; asm volatile("" : "+v"(lo_)); const unsigned hoff_ = ((lo_ >> 4) & 15u) * 64u + (lo_ >> 8) * 8u;     \
        __builtin_amdgcn_raw_buffer_store_b64(ow, rW, hoff_, (rep_ + 1 < SCAN_REP) ? (oC + 512 * DI * 2) : ((hsel == 0 ? oH : (hsel == 1 ? oV : oC)) + (((row0 >> 6) * 4 + hh) * 16 + slice) * 4096 + (w >> 1) * 1024 + (w & 1) * 32), 0); } \
    if (!(abl_ & 16)) SC_VWRITE(buf ^ 1, N);                                     \
} while (0)

__device__ __forceinline__ void scan_phase(LAS unsigned char* lds, unsigned char* ws, int half, const XcdBarrier& bar, int tid, int lane, int wave, int bx) {
    LAS bf16_t* Pbh = (LAS bf16_t*)lds;
    LAS float* NQs = (LAS float*)(lds + 2 * 8 * 64 * 40 * 2);
    LAS bf16_t* VB = (LAS bf16_t*)(NQs + 2 * 8 * 64);
    const int xcd = bx & 7, idx = bx >> 3;
    const int scn = (xcd * 2 + (idx >> 4)) & 15, slice = idx & 15;
    const int bl = scn >> 3, hh = (scn >> 1) & 3, dir = scn & 1, e0 = slice * 32;
    const int fr = lane & 15, fq = lane >> 4, w = wave;
    const int cp = 16 * (w >> 1) + fr, cv = 16 * (w & 1) + 4 * fq;
    const unsigned loff = (unsigned)lane * 16u;
    const unsigned gcp = (unsigned)cp * 4u;
    const unsigned wkoff = (w < 4) ? (unsigned)(32 * ((tid >> 6) & 1) + 8 * ((tid & 63) >> 4)) * 2u : (unsigned)(32 * ((lane >> 2) & 1) + 8 * (lane & 3)) * 2u;
    const __amdgpu_buffer_rsrc_t rW = __builtin_amdgcn_make_buffer_rsrc((void*)ws, 0, (int)(512 * MiB), 0x00020000);
    const int oYH = (int)(WS_YB + ((size_t)CR + (size_t)half * LH) * D * 2);
    const int oQ = (int)(WS_BIG + 3 * SLOT), oK = (int)(WS_BIG + 4 * SLOT), oV = (int)(WS_BIG + 2 * SLOT), oH = (int)(WS_BIG + 0 * SLOT);
    const int oS = oYH, oG = oYH + NCH * 4 * 2 * 8192, oC = oG + NCH * 4 * 2 * 1536;
    for (int i = tid; i < 4 * 1024; i += NTHR) { const int im = i >> 10, r = i & 1023, ln = (r & 511) >> 3; VB[im * 3072 + 2048 + r] = (bf16_t)(((im & 1) == 0 && (ln & 3) == 0) ? 0x3F80u : 0u); }
    __syncthreads();
    for (int rep_ = 0; rep_ < SCAN_REP; ++rep_) {
    const int abl_ = (rep_ + 1 < SCAN_REP) ? SC_ABL : 0;
    f32x4 st[4][3];
#pragma unroll
    for (int a = 0; a < 4; ++a)
#pragma unroll
        for (int b = 0; b < 3; ++b) st[a][b] = (f32x4){0.f, 0.f, 0.f, 0.f};
    bf16x8 Q0[4][2], Q1[4][2], K0[4][2], K1[4][2];
    bf16x8 Asg0, Asg1, Bsg0, Bsg1; u32x4 Av = (u32x4){0u, 0u, 0u, 0u}, Bv = Av, Awka = Av, Bwka = Av; float Awint, Aem, Adec, Bwint, Bem, Bdec;
    { const int r0 = SC_ROW0(0); SC_LOADQ(Q0, r0); SC_LOADK(K0, r0); SC_LOADS(A, r0); SC_VWRITE(0, A); }
#pragma unroll 1
    for (int j = 0; j < 132; j += 2) {
        if (j == 68) xcd_barrier(bar, tid == 0);
        SC_STEP(j, Q0, Q1, K0, K1, A, B);
        SC_STEP(j + 1, Q1, Q0, K1, K0, B, A);
    }
    __syncthreads();
    }
}
#undef SC_ROW0
#undef SC_LOADQ
#undef SC_LOADK
#undef SC_LOADS
#undef SC_VWRITE
#undef SC_STEP

typedef const __attribute__((address_space(4))) Args KA;
__device__ __forceinline__ KA* kargs() { KA* k = (KA*)__builtin_amdgcn_kernarg_segment_ptr(); asm volatile("" : "+s"(k)); return k; }
#define PH_BEGIN() \
    KA* ka = kargs(); unsigned char* ws = ka->ws; (void)ws; \
    int wave = wave0; asm volatile("" : "+s"(wave)); \
    unsigned lz_ = 0u; asm volatile("" : "+v"(lz_)); const int lane = (int)__builtin_amdgcn_mbcnt_hi(~0u, __builtin_amdgcn_mbcnt_lo(~0u, lz_)); \
    const int tid = wave * 64 + lane; (void)tid; \
    const int gw = bx * NWAVES + wave, NGW = G * NWAVES; (void)gw; (void)NGW;

__global__ void __launch_bounds__(NTHR, 2) fwd(Args args) {
    extern __shared__ __attribute__((aligned(16))) unsigned char lds_raw[];
    LAS unsigned char* lds = (LAS unsigned char*)lds_raw;
    const int G = gridDim.x, bx = blockIdx.x;
    const int wave0 = __builtin_amdgcn_readfirstlane(threadIdx.x >> 6);
    volatile LAS unsigned* MISC = (volatile LAS unsigned*)(lds + LDS_MISC);
    if (threadIdx.x < 64) MISC[threadIdx.x] = 0u;
    __syncthreads();
    XcdBarrier bar = xcd_barrier_post((unsigned*)(args.ws + WS_CTL + 65536) + (size_t)args.li * 4096, MISC + 8);
    const int lo = args.ph_lo, hi = args.ph_hi, plast = args.ph_last;
#define IN(k) (lo <= (k) && (k) < hi)
#define SEAM(k) do { if ((k) != plast) { xcd_barrier(bar, tid == 0); if (DUP_BAR) xcd_barrier(bar, tid == 0); } } while (0)

    if (EN_PRO && IN(0)) { PH_BEGIN();
        {
            LAS float* sc = (LAS float*)lds;
            for (int i = tid; i < 5 * D; i += NTHR) { const int r = i / D, k = i % D; const float x = r < 4 ? ka->in[I_C][r * D + k] : ka->in[I_CCTX][k]; sc[i] = siluf(x); }
            __syncthreads();
            LAS float* red = (LAS float*)(lds + 32768);
            const int kp = tid >> 6, cc = tid & 63;
            for (int item = bx; item < 4 * 96; item += G) {
                const int layer = item / 96, n0 = (item % 96) * 64;
                const float* w = ka->in[I_ADAW] + (size_t)layer * D * 6 * D + n0 + cc;
                float a0 = 0.f, a1 = 0.f, a2 = 0.f, a3 = 0.f, a4 = 0.f;
                for (int k = kp * 128; k < kp * 128 + 128; ++k) { const float wv = w[(size_t)k * 6 * D]; a0 += sc[k] * wv; a1 += sc[D + k] * wv; a2 += sc[2 * D + k] * wv; a3 += sc[3 * D + k] * wv; a4 += sc[4 * D + k] * wv; }
                red[(kp * 64 + cc) * 5 + 0] = a0; red[(kp * 64 + cc) * 5 + 1] = a1; red[(kp * 64 + cc) * 5 + 2] = a2; red[(kp * 64 + cc) * 5 + 3] = a3; red[(kp * 64 + cc) * 5 + 4] = a4;
                __syncthreads();
                if (tid < 320) { const int c2 = tid % 64, r = tid / 64; float s = ka->in[I_ADAB][layer * 6 * D + n0 + c2];
                    for (int q = 0; q < 8; ++q) s += red[(q * 64 + c2) * 5 + r];
                    MOD[((size_t)layer * 5 + r) * 6 * D + n0 + c2] = s; }
                __syncthreads();
            }
        }
        {
            bf16_t* A1 = (bf16_t*)(ws + TAB_A1); bf16_t* A2 = (bf16_t*)(ws + TAB_A2); bf16_t* BZ = (bf16_t*)(ws + TAB_BZ); bf16_t* ACTX = (bf16_t*)(ws + TAB_ACTX);
            const int gt = bx * NTHR + tid, NGT = G * NTHR;
            const float s8192 = 0.011048543456039806f;
            for (int i = gt; i < 512 * 256; i += NGT) { const int m = i / 256, t1 = i % 256, ri = m / 256, t1p = m % 256; const int ph = (t1 * t1p) & 255; float sn, cs; sincospif((float)ph * (2.0f / 256.0f), &sn, &cs);
                A1[i] = (bf16_t)f2bf((ri == 0 ? cs : -sn) * s8192);
                ACTX[i] = (bf16_t)f2bf((ri == 0 ? cs : -sn) * 0.0625f); }
            for (int i = gt; i < 256 * 64 * 64; i += NGT) { const int t1p = i / 4096, m = (i / 64) % 64, k = i % 64; const int rip = m / 32, t2p = m % 32, ri = k / 32, t2 = k % 32;
                const int ph = (t2 * t1p + 256 * t2 * t2p) & 8191; float sn, cs; sincospif((float)ph * (2.0f / 8192.0f), &sn, &cs);
                const float v = (rip == ri) ? cs : (rip == 0 ? sn : -sn); A2[i] = (bf16_t)f2bf(v); }
            for (int i = gt; i < 256 * 512; i += NGT) { const int cp = i / 512, k = i % 512, ri = k / 256, c = k % 256; const int ph = (c * cp) & 255; float sn, cs; sincospif((float)ph * (2.0f / 256.0f), &sn, &cs);
                BZ[i] = (bf16_t)f2bf((ri == 0 ? cs : sn) * 0.0625f); }
        }
        SEAM(0);
    }
    if (EN_PRO && IN(1)) { PH_BEGIN();
        const int nseg = gw < CR ? 2 : 1;
#pragma unroll 1
        for (int seg = 0; seg < nseg; ++seg) {
            const int mi = seg == 0 ? (gw >> 9) : 4, rbeg = seg == 0 ? lat_row(gw >> 9, gw & 511) : gw, nr = seg == 0 ? T / 512 : 1;
            const float* md = MOD + ((size_t)0 * 5 + mi) * 6 * D;
            f32x4 shv[4], scv[4];
#pragma unroll
            for (int j = 0; j < 4; ++j) { shv[j] = *(const f32x4*)(md + 256 * j + 4 * lane); scv[j] = *(const f32x4*)(md + D + 256 * j + 4 * lane) + 1.0f; }
#pragma unroll 2
            for (int k = 0; k < nr; ++k) {
                const int r = rbeg + 512 * k;
                const RowInfo ri = row_info(r);
                const float* xr = ri.is_ctx ? ka->in[I_CTX] + ((size_t)ri.b * CT + ri.t) * D : ka->in[I_X] + ((size_t)ri.b * T + ri.t) * D;
                f32x4 v[4];
#pragma unroll
                for (int j = 0; j < 4; ++j) v[j] = *(const f32x4*)(xr + 256 * j + 4 * lane);
                ln_norm(v, lane);
                bf16_t* o = HIN + (size_t)r * D;
#pragma unroll
                for (int j = 0; j < 4; ++j) { const f32x4 h = v[j] * scv[j] + shv[j]; u32x2 w; w.x = pk2(h[0], h[1]); w.y = pk2(h[2], h[3]); *(u32x2*)(o + 256 * j + 4 * lane) = w; }
            }
        }
        SEAM(1);
    }

    for (int layer = 0; layer < 4; ++layer) {
        const int pb = 2 + layer * PL;
        if (hi <= pb || lo >= pb + PL) continue;
        const int jl = layer >> 1;
        const bool is_m = (layer & 1) == 0;
        if (EN_WC && IN(pb + 0)) { PH_BEGIN();
 for (int rp_ = 0; rp_ < REPN(5); ++rp_) {
            LAS float* scr = (LAS float*)(lds + wave * 16384);
            const int i_in = (D / 64) * (2 * DI / 32), i_h = (DH / 64) * (DH / 32), i_out = (DI / 64) * (D / 32), i_f = (D / 64) * (D / 32), i_1 = (D / 64) * (DFF / 32), i_2 = (DFF / 64) * (D / 32);
            const int n_mix = is_m ? (i_in + 12 * i_h + i_out) : i_f;
            const int nitems = n_mix + i_1 + i_2;
            for (int it = gw; it < nitems; it += NGW) {
                int r = it;
                if (r >= n_mix) { r -= n_mix;
                    if (r < i_1) transpose_item(ka->in[I_W1] + (size_t)layer * D * DFF, D, DFF, W1, 1.f, scr, r, lane);
                    else transpose_item(ka->in[I_W2] + (size_t)layer * DFF * D, DFF, D, W2, 1.f, scr, r - i_1, lane);
                    continue; }
                if (!is_m) { transpose_item(ka->in[I_FWOUT] + (size_t)jl * D * D, D, D, WOUT, 1.f, scr, r, lane); continue; }
                if (r < i_in) { transpose_item(ka->in[I_WIN] + (size_t)jl * D * 2 * DI, D, 2 * DI, WIN, 1.f, scr, r, lane); continue; } r -= i_in;
                if (r < 12 * i_h) { const int which = r / (4 * i_h), hh = (r / i_h) % 4, rr = r % i_h;
                    const float* src = ka->in[which == 0 ? I_WQ : (which == 1 ? I_WK : I_WV)] + ((size_t)jl * NH + hh) * DH * DH;
                    bf16_t* dst = (which == 0 ? WQ : (which == 1 ? WK : WV)) + (size_t)hh * DH * DH;
                    transpose_item(src, DH, DH, dst, which == 1 ? 0.044194173824159216f : 1.f, scr, rr, lane); continue; } r -= 12 * i_h;
                transpose_item(ka->in[I_WOUT] + (size_t)jl * DI * D, DI, D, WOUT, 1.f, scr, r, lane);
            }
            if (is_m) {
                const float* wg = ka->in[I_WGATE] + (size_t)jl * 3 * DI * 16;
                const int n = lane & 15, eq = lane >> 4;
                for (int k2 = gw; k2 < DI; k2 += NGW) {
                    const int hh = k2 / DH, d = k2 % DH;
                    const float* q = ka->in[I_WQ] + (((size_t)jl * NH + hh) * DH + d) * DH + eq * 128; const float* kx = ka->in[I_WK] + (((size_t)jl * NH + hh) * DH + d) * DH + eq * 128;
                    const float* vx = ka->in[I_WV] + (((size_t)jl * NH + hh) * DH + d) * DH + eq * 128;
                    const float* g0 = wg + ((size_t)0 * DI + hh * DH + eq * 128) * 16 + n; const float* g1 = wg + ((size_t)1 * DI + hh * DH + eq * 128) * 16 + n; const float* g2 = wg + ((size_t)2 * DI + hh * DH + eq * 128) * 16 + n;
                    float s0 = 0.f, s1 = 0.f, s2 = 0.f;
#pragma unroll 8
                    for (int e = 0; e < 128; ++e) { s0 += q[e] * g0[e * 16]; s1 += kx[e] * g1[e * 16]; s2 += vx[e] * g2[e * 16]; }
                    float sa = s0 + 0.044194173824159216f * s1;
                    sa += shx(sa, 16, lane); sa += shx(sa, 32, lane); s2 += shx(s2, 16, lane); s2 += shx(s2, 32, lane);
                    if (lane < 16) { GATET[(size_t)n * 4096 + k2] = (bf16_t)f2bf(sa); GATET[(size_t)n * 4096 + DI + k2] = (bf16_t)f2bf(s2); }
                    else if (lane < 64) { GATET[(size_t)(16 + (lane - 16)) * 4096 + k2] = (bf16_t)0; GATET[(size_t)(16 + (lane - 16)) * 4096 + DI + k2] = (bf16_t)0; }
                }
            }
 }
            SEAM(pb + 0);
        }

        if (EN_MIX && is_m) {
            for (int half = 0; half < 2; ++half) {
                const int hb = pb + 1 + 9 * half;
                if (hi <= hb || lo >= hb + 9) continue;
                if (IN(hb + 0)) { PH_BEGIN();
 for (int rp_ = 0; rp_ < REPN(0); ++rp_) {
                    pg8::Gemm g{HH, WIN, D, D, D, 0, 0, LH / 256, DI / 256, 1};
                    pg8::EpiStore E{S0 + (size_t)LAT0 * DI, 0, DI, 0};
                    pg8::gemm_phase(lds, g, E, G, bx, tid); if (DUP_MIX) pg8::gemm_phase(lds, g, E, G, bx, tid);
                    { SmallGemm sg{HHC, WIN, D, D, D, D, D, 0, 0}; SmallDense sd{S0, 0, DI, LAT0 / 64, DI / 64, 0, 0, 0}; gemm_small_dense(lds, sg, sd, 1, G, bx, tid); if (DUP_CTX) gemm_small_dense(lds, sg, sd, 1, G, bx, tid); }
 }
                    SEAM(hb + 0);
                }
                if (IN(hb + 1)) { PH_BEGIN();
 for (int rp_ = 0; rp_ < REPN(3); ++rp_) {
                    const float* wc = ka->in[I_WCONV] + (size_t)jl * 9 * DI; const float* bc = ka->in[I_BCONV] + (size_t)jl * DI;
                    const int gt = bx * NTHR + tid, NGT = G * NTHR;
                    for (int i = gt; i < 2 * 128 * 2 * (DI / 8); i += NGT) {
                        const int cg = i & 255, rest = i >> 8, hr = rest & 1, r = (rest >> 1) & 127, bl = rest >> 8, c0 = cg * 8, gc0 = 32 * hr;
                        float wv[9][8], bv[8];
#pragma unroll
                        for (int tp = 0; tp < 9; ++tp) { const f32x4 a0 = *(const f32x4*)(wc + (size_t)tp * DI + c0), a1 = *(const f32x4*)(wc + (size_t)tp * DI + c0 + 4);
                            wv[tp][0] = a0[0]; wv[tp][1] = a0[1]; wv[tp][2] = a0[2]; wv[tp][3] = a0[3]; wv[tp][4] = a1[0]; wv[tp][5] = a1[1]; wv[tp][6] = a1[2]; wv[tp][7] = a1[3]; }
                        { const f32x4 a0 = *(const f32x4*)(bc + c0), a1 = *(const f32x4*)(bc + c0 + 4); bv[0] = a0[0]; bv[1] = a0[1]; bv[2] = a0[2]; bv[3] = a0[3]; bv[4] = a1[0]; bv[5] = a1[1]; bv[6] = a1[2]; bv[7] = a1[3]; }
                        const bf16_t* xb = S0 + (size_t)(LAT0 + bl * T + r * 64) * DI + c0;
                        bf16_t* ob = S1 + (size_t)(LAT0 + bl * T + r * 64) * DI + c0;
                        const bool rok[3] = {r > 0, true, r < 127};
                        float win[3][3][8];
#define CV_LOADCOL(slot, col) do { _Pragma("unroll") for (int di = 0; di < 3; ++di) { u32x4 xv = (u32x4){0u, 0u, 0u, 0u}; \
                                if (rok[di] && (col) >= 0 && (col) < 64) xv = *(const u32x4*)(xb + (ptrdiff_t)((di - 1) * 64 + (col)) * DI); \
                                win[slot][di][0] = bflo(xv.x); win[slot][di][1] = bfhi(xv.x); win[slot][di][2] = bflo(xv.y); win[slot][di][3] = bfhi(xv.y); \
                                win[slot][di][4] = bflo(xv.z); win[slot][di][5] = bfhi(xv.z); win[slot][di][6] = bflo(xv.w); win[slot][di][7] = bfhi(xv.w); } } while (0)
#define CV_STEP(sl, sm, sr) do { CV_LOADCOL(sr, gc + 1); \
                                if (gc < gc0 + 32) { float acc[8]; \
                                    _Pragma("unroll") for (int e = 0; e < 8; ++e) { float s = bv[e]; \
                                        _Pragma("unroll") for (int di = 0; di < 3; ++di) s += win[sl][di][e] * wv[di * 3 + 0][e] + win[sm][di][e] * wv[di * 3 + 1][e] + win[sr][di][e] * wv[di * 3 + 2][e]; \
                                        acc[e] = siluf(s); } \
                                    u32x4 o; o.x = pk2(acc[0], acc[1]); o.y = pk2(acc[2], acc[3]); o.z = pk2(acc[4], acc[5]); o.w = pk2(acc[6], acc[7]); \
                                    *(u32x4*)(ob + (size_t)gc * DI) = o; } \
                                ++gc; } while (0)
                        int gc = gc0;
                        CV_LOADCOL(0, gc0 - 1); CV_LOADCOL(1, gc0);
#pragma unroll 1
                        for (int g3 = 0; g3 < 11; ++g3) { CV_STEP(0, 1, 2); CV_STEP(1, 2, 0); CV_STEP(2, 0, 1); }
#undef CV_LOADCOL
#undef CV_STEP
                    }
                    for (int i = gt; i < LAT0 * (DI / 8); i += NGT) {
                        const int q = i / (DI / 8), c0 = (i % (DI / 8)) * 8, t = q % CT;
                        float acc[8];
#pragma unroll
                        for (int e = 0; e < 8; ++e) acc[e] = bc[c0 + e];
#pragma unroll
                        for (int dj = 0; dj < 3; ++dj) { const int tt = t + dj - 1; if (tt < 0 || tt >= CT) continue;
                            const u32x4 xv = *(const u32x4*)(S0 + (size_t)(q + dj - 1) * DI + c0); const float* w = wc + (size_t)(3 + dj) * DI + c0;
                            acc[0] += bflo(xv.x) * w[0]; acc[1] += bfhi(xv.x) * w[1]; acc[2] += bflo(xv.y) * w[2]; acc[3] += bfhi(xv.y) * w[3];
                            acc[4] += bflo(xv.z) * w[4]; acc[5] += bfhi(xv.z) * w[5]; acc[6] += bflo(xv.w) * w[6]; acc[7] += bfhi(xv.w) * w[7]; }
                        u32x4 o; o.x = pk2(siluf(acc[0]), siluf(acc[1])); o.y = pk2(siluf(acc[2]), siluf(acc[3])); o.z = pk2(siluf(acc[4]), siluf(acc[5])); o.w = pk2(siluf(acc[6]), siluf(acc[7]));
                        *(u32x4*)(S1 + (size_t)q * DI + c0) = o;
                    }
 }
                    SEAM(hb + 1);
                }
                if (IN(hb + 2)) { PH_BEGIN();
 for (int rp_ = 0; rp_ < REPN(0); ++rp_) {
                    { pg8::Gemm g{WV, S0 + (size_t)LAT0 * DI, DH, DI, DH, (long)DH * DH, DH, DH / 256, LH / 256, NH};
                      pg8::EpiStore E{S2, 0, 0, 0, 3, LAT0};
                      pg8::gemm_phase(lds, g, E, G, bx, tid); if (DUP_MIX) pg8::gemm_phase(lds, g, E, G, bx, tid); }
                    { SmallGemm sg{WV, S0, DH, DI, DH, DH, DH, 0, 0}; SmallDense sd{S2, 0, 0, DH / 64, LAT0 / 64, 0, (long)DH * DH, DH, 3}; gemm_small_dense(lds, sg, sd, NH, G, bx, tid); if (DUP_CTX) gemm_small_dense(lds, sg, sd, NH, G, bx, tid); }
                    {
                      SmallGemm sg{S1, GATET, DI, 4096, 1024, 1024, 1024, 0, 0};
                      const long xm_off = (long)(S0 - S1);
                      auto dec = [=](int uq, long& ao, long& bo) { const int u = uq >> 2, q = uq & 3; ao = (long)u * 64 * DI + (q & 1) * 1024 + (q >> 1) * xm_off; bo = q * 1024; };
                      auto epi = [=](int uq, int m, int n, const f32x4& v) { const int u = uq >> 2, q = uq & 3; if (n < 16) *(f32x4*)(PREQ + (size_t)q * RH * 16 + ((size_t)u * 64 + m) * 16 + n) = v; };
                      gemm_small(lds, sg, NCH * 4, dec, epi, G, bx, tid); }
 }
                    SEAM(hb + 2);
                }
                if (IN(hb + 3)) { PH_BEGIN();
 for (int rp_ = 0; rp_ < REPN(0); ++rp_) {
                    { pg8::Gemm g{S1 + (size_t)LAT0 * DI, WQ, DI, DH, DH, DH, (long)DH * DH, LH / 256, DH / 256, NH}; pg8::EpiStore E{S3, DH, DI, 0, 1, LAT0}; pg8::gemm_phase(lds, g, E, G, bx, tid); if (DUP_MIX) pg8::gemm_phase(lds, g, E, G, bx, tid); }
                    { SmallGemm sg{S1, WQ, DI, DH, DH, DH, DH, 0, 0}; SmallDense sd{S3, DH, DI, LAT0 / 64, DH / 64, 0, DH, (long)DH * DH, 1}; gemm_small_dense(lds, sg, sd, NH, G, bx, tid); if (DUP_CTX) gemm_small_dense(lds, sg, sd, NH, G, bx, tid); }
                    { pg8::Gemm g{WK, S1 + (size_t)LAT0 * DI, DH, DI, DH, (long)DH * DH, DH, DH / 256, LH / 256, NH}; pg8::EpiStore E{S4, (long)DH * RH, RH, 0, 2, LAT0}; pg8::gemm_phase(lds, g, E, G, bx, tid); if (DUP_MIX) pg8::gemm_phase(lds, g, E, G, bx, tid); }
                    { SmallGemm sg{WK, S1, DH, DI, DH, DH, DH, 0, 0}; SmallDense sd{S4, (long)DH * RH, RH, DH / 64, LAT0 / 64, 0, (long)DH * DH, DH, 2}; gemm_small_dense(lds, sg, sd, NH, G, bx, tid); if (DUP_CTX) gemm_small_dense(lds, sg, sd, NH, G, bx, tid); }
                    if (bx < 128) {
                        const int sc = bx >> 3, part = bx & 7, bl = sc >> 3, hh = (sc >> 1) & 3, dir = sc & 1;
                        unsigned* g12cnt = (unsigned*)(ws + WS_CTL + 4096) + ((jl * 2 + half) * 16 + sc) * 16;
                        unsigned* g12tot = (unsigned*)(ws + WS_PRE) + (size_t)((jl * 2 + half) * 16 + sc) * 132 * 2;
                        LAS float* bcs = (LAS float*)lds;
                        LAS float* vss = bcs + 132 * 64;
                        LAS float* bl_ = vss + 132 * 64;
                        LAS float* vm_ = bl_ + 132;
                        LAS float* mi_ = vm_ + 132;
                        const int u = lane, p = dir ? 63 - u : u;
                        const float* bgp = ka->in[I_BGATE] + (size_t)jl * 16 + 8 * dir + hh;
#pragma unroll
                        for (int ii = 0; ii < 3; ++ii) { const int i = part + 8 * ii; const int j = wave + 8 * i;
                            if (i < 17 && j < 132) { int row0; if (j < 4) { const int c = dir ? 3 - j : j; row0 = bl * CT + c * 64; } else { const int c = dir ? 127 - (j - 4) : (j - 4); row0 = LAT0 + bl * T + c * 64; }
                                const float* pr = PREQ + (size_t)(row0 + p) * 16 + 8 * dir + hh; const size_t qs = (size_t)RH * 16;
                                bcs[j * 64 + p] = (pr[4] + pr[qs + 4]) + (pr[2 * qs + 4] + pr[3 * qs + 4]) + bgp[4]; vss[j * 64 + p] = (pr[0] + pr[qs]) + (pr[2 * qs] + pr[3 * qs]) + bgp[0]; } }
                        asm volatile("s_waitcnt vmcnt(0) lgkmcnt(0)" ::: "memory");
#pragma unroll 1
                        for (int ii = 0; ii < 3; ++ii) { const int i = part + 8 * ii; const int j = wave + 8 * i;
                            if (i < 17 && j < 132) { const float f = bcs[j * 64 + p], lia = vss[j * 64 + p]; float x = fminf(f, 0.f) - log1pf(__expf(-fabsf(f)));
                                x = scan_add64(x);
                                const float v = lia - x; float pm = v;
                                pm = scan_max64(pm);
                                bcs[j * 64 + p] = x; vss[j * 64 + p] = v;
                                if (u == 63) { __hip_atomic_store(g12tot + 2 * j, __builtin_bit_cast(unsigned, x), __ATOMIC_RELAXED, __HIP_MEMORY_SCOPE_AGENT); __hip_atomic_store(g12tot + 2 * j + 1, __builtin_bit_cast(unsigned, pm), __ATOMIC_RELAXED, __HIP_MEMORY_SCOPE_AGENT); } } }
                        asm volatile("s_waitcnt vmcnt(0)" ::: "memory");
                        __syncthreads();
                        if (tid == 0) { (void)xb_add(g12cnt, 1u); unsigned sp_ = 0u; while (xb_ld(g12cnt) < 8u && ++sp_ < XB_SPIN_CAP) __builtin_amdgcn_s_sleep(1); }
                        __syncthreads();
                        if (tid < 132) { bl_[tid] = __builtin_bit_cast(float, xb_ld(g12tot + 2 * tid)); vm_[tid] = __builtin_bit_cast(float, xb_ld(g12tot + 2 * tid + 1)); }
                        __syncthreads();
                        if (wave == 0) {
                            const float ni = -__builtin_inff();
                            float ea[3], eb[3];
#pragma unroll
                            for (int t = 0; t < 3; ++t) { const int j = 3 * lane + t; const bool ok = j < 132; const float blj = bl_[ok ? j : 0], vmj = vm_[ok ? j : 0]; ea[t] = ok ? blj : 0.f; eb[t] = ok ? blj + vmj : ni; }
                            float A = ea[0] + ea[1], B = fmaxf(eb[0] + ea[1], eb[1]); B = fmaxf(B + ea[2], eb[2]); A += ea[2];
#define G12_STEP(CTRL, RM) do { const float pa_ = dppf<CTRL, RM>(0.f, A), pb_ = dppf<CTRL, RM>(ni, B); B = fmaxf(pb_ + A, B); A += pa_; } while (0)
                            G12_STEP(0x111, 0xF); G12_STEP(0x112, 0xF); G12_STEP(0x114, 0xF); G12_STEP(0x118, 0xF); G12_STEP(0x142, 0xA); G12_STEP(0x143, 0xC);
#undef G12_STEP
                            float EA = shup(A, 1, lane), EB = shup(B, 1, lane); if (lane == 0) { EA = 0.f; EB = ni; }
                            float m = fmaxf(EA, EB);
#pragma unroll
                            for (int t = 0; t < 3; ++t) { const int j = 3 * lane + t; if (j < 132) { mi_[j] = m; m = fmaxf(m + ea[t], eb[t]); } }
                        }
                        __syncthreads();
                        float* GPw = (float*)(YH + (size_t)NCH * 4 * 2 * 4096);
#pragma unroll 1
                        for (int ii = 0; ii < 3; ++ii) { const int i = part + 8 * ii; const int j = wave + 8 * i;
                            if (i < 17 && j < 132) { int row0; if (j < 4) { const int c = dir ? 3 - j : j; row0 = bl * CT + c * 64; } else { const int c = dir ? 127 - (j - 4) : (j - 4); row0 = LAT0 + bl * T + c * 64; }
                                const float bc = bcs[j * 64 + p], v = vss[j * 64 + p]; float pm = v;
                                pm = scan_max64(pm);
                                const float m_in = mi_[j], btot = bl_[j], m_new = btot + fmaxf(m_in, vm_[j]);
                                const float uu = -fmaxf(m_in, pm);
                                float* gp = GPw + ((size_t)((row0 >> 6) * 4 + hh) * 2 + dir) * 384;
                                gp[p] = uu; gp[64 + p] = v; gp[128 + p] = __expf(m_in + uu); gp[192 + p] = __expf(uu - bc); ((bf16_t*)(gp + 324))[p] = (bf16_t)f2bf(__expf(btot - m_new + v));
                                if (u == 0) gp[320] = __expf(btot + m_in - m_new); } }
                    }
 }
                    SEAM(hb + 3);
                }
                if (IN(hb + 4)) { PH_BEGIN();
 for (int rp_ = 0; rp_ < REPN(4); ++rp_) {
                    SmallGemm sg{S3, S4, DI, DI, DH, DH, DH, 0, 0, 1, 1};
                    bf16_t* SGw = YH; const float* GPr = (const float*)(YH + (size_t)NCH * 4 * 2 * 4096);
                    auto dec = [=](int u, long& ao, long& bo) { ao = u; bo = u; };
                    auto epi = [=](int u, int m, int n, const f32x4& v) {
#pragma unroll
                        for (int dir = 0; dir < 2; ++dir) { const float* gp = GPr + ((size_t)u * 2 + dir) * 384; const float up = gp[m]; const f32x4 vs = *(const f32x4*)(gp + 64 + n); float o[4];
#pragma unroll
                            for (int i = 0; i < 4; ++i) { const int s = n + i; const bool ok = dir ? (s >= m) : (s <= m); const float gte = ok ? __expf(up + vs[i]) : 0.f; o[i] = v[i] * gte; }
                            u32x2 w; w.x = pk2(o[0], o[1]); w.y = pk2(o[2], o[3]);
                            *(u32x2*)(SGw + ((size_t)u * 2 + dir) * 4096 + ((m >> 4) * 2 + (n >> 5)) * 512 + (((n >> 3) & 3) * 16 + (m & 15)) * 8 + (n & 7)) = w; } };
                    gemm_small(lds, sg, NCH * 4, dec, epi, G, bx, tid);
 }
                    SEAM(hb + 4);
                }
                if (EN_SCAN && IN(hb + 5)) { PH_BEGIN();
                    scan_phase(lds, ws, half, bar, tid, lane, wave, bx);
                    SEAM(hb + 5);
                }
                if (IN(hb + 6)) { PH_BEGIN();
 for (int rp_ = 0; rp_ < REPN(0); ++rp_) {
                    pg8::Gemm g{HH, WIN + (size_t)DI * D, D, D, D, 0, 0, LH / 256, DI / 256, 1};
                    pg8::EpiStore E{S3 + (size_t)LAT0 * DI, 0, DI, 0};
                    pg8::gemm_phase(lds, g, E, G, bx, tid); if (DUP_MIX) pg8::gemm_phase(lds, g, E, G, bx, tid);
                    if (layer < 2) { SmallGemm sg{HHC, WIN + (size_t)DI * D, D, D, D, D, D, 0, 0}; SmallDense sd{S3, 0, DI, LAT0 / 64, DI / 64, 0, 0, 0}; gemm_small_dense(lds, sg, sd, 1, G, bx, tid); if (DUP_CTX) gemm_small_dense(lds, sg, sd, 1, G, bx, tid); }
 }
                    SEAM(hb + 6);
                }
                if (IN(hb + 7)) { PH_BEGIN();
 for (int rp_ = 0; rp_ < REPN(3); ++rp_) {
                    const float* gn = ka->in[I_GNW] + (size_t)jl * DI; const float* sk = ka->in[I_SKIP] + (size_t)jl * DI;
#define RO_LOAD(q_, A, B, XC, ZZ) do { const bf16_t* h2_ = ((q_) < LAT0) ? HCB : S2; \
                        _Pragma("unroll") for (int hd = 0; hd < 4; ++hd) { const size_t ho_ = htile_off(q_, hd, 8 * lane); const size_t ro_ = (size_t)(q_) * DI + hd * DH + 8 * lane; \
                            A[hd] = *(const u32x4*)(S0 + ho_); B[hd] = *(const u32x4*)(h2_ + ho_); XC[hd] = *(const u32x4*)(S1 + ro_); ZZ[hd] = *(const u32x4*)(S3 + ro_); } } while (0)
                    u32x4 ra[4], rb[4], rx[4], rz[4], na[4], nb[4], nx[4], nz[4];
                    f32x4 gnv[4][2], skv[4][2];
#pragma unroll
                    for (int hd = 0; hd < 4; ++hd) { gnv[hd][0] = *(const f32x4*)(gn + hd * DH + 8 * lane); gnv[hd][1] = *(const f32x4*)(gn + hd * DH + 8 * lane + 4); skv[hd][0] = *(const f32x4*)(sk + hd * DH + 8 * lane); skv[hd][1] = *(const f32x4*)(sk + hd * DH + 8 * lane + 4); }
#pragma unroll
                    for (int hd = 0; hd < 4; ++hd) { ra[hd] = (u32x4){0u, 0u, 0u, 0u}; rb[hd] = ra[hd]; rx[hd] = ra[hd]; rz[hd] = ra[hd]; na[hd] = ra[hd]; nb[hd] = ra[hd]; nx[hd] = ra[hd]; nz[hd] = ra[hd]; }
                    const int q_first = (layer < 2 ? 0 : LAT0) + gw;
                    if (q_first < RH) RO_LOAD(q_first, ra, rb, rx, rz);
                    for (int q = q_first; q < RH; q += NGW) {
                        if (q + NGW < RH) RO_LOAD(q + NGW, na, nb, nx, nz);
#pragma unroll
                        for (int hd = 0; hd < 4; ++hd) {
                            const int c0 = hd * DH + 8 * lane;
                            const u32x4 a = ra[hd], b = rb[hd];
                            float v[8] = {bflo(a.x) + bflo(b.x), bfhi(a.x) + bfhi(b.x), bflo(a.y) + bflo(b.y), bfhi(a.y) + bfhi(b.y), bflo(a.z) + bflo(b.z), bfhi(a.z) + bfhi(b.z), bflo(a.w) + bflo(b.w), bfhi(a.w) + bfhi(b.w)};
                            float s = 0.f;
#pragma unroll
                            for (int i = 0; i < 8; ++i) s += v[i];
                            const float mean = wave_sum(s, lane) * (1.f / DH); float s2 = 0.f;
#pragma unroll
                            for (int i = 0; i < 8; ++i) { v[i] -= mean; s2 += v[i] * v[i]; }
                            const float rstd = __builtin_amdgcn_rsqf(wave_sum(s2, lane) * (1.f / DH) + LN_EPS);
                            const u32x4 xc = rx[hd], zz = rz[hd];
                            const float xcf[8] = {bflo(xc.x), bfhi(xc.x), bflo(xc.y), bfhi(xc.y), bflo(xc.z), bfhi(xc.z), bflo(xc.w), bfhi(xc.w)};
                            const float zf[8] = {bflo(zz.x), bfhi(zz.x), bflo(zz.y), bfhi(zz.y), bflo(zz.z), bfhi(zz.z), bflo(zz.w), bfhi(zz.w)};
                            float o[8];
#pragma unroll
                            for (int i = 0; i < 8; ++i) o[i] = (v[i] * rstd * gnv[hd][i >> 2][i & 3] + skv[hd][i >> 2][i & 3] * xcf[i]) * siluf(zf[i]);
                            u32x4 w; w.x = pk2(o[0], o[1]); w.y = pk2(o[2], o[3]); w.z = pk2(o[4], o[5]); w.w = pk2(o[6], o[7]);
                            *(u32x4*)(S4 + (size_t)q * DI + c0) = w;
                        }
#pragma unroll
                        for (int hd = 0; hd < 4; ++hd) { ra[hd] = na[hd]; rb[hd] = nb[hd]; rx[hd] = nx[hd]; rz[hd] = nz[hd]; }
                    }
#undef RO_LOAD
 }
                    SEAM(hb + 7);
                }
                if (IN(hb + 8)) { PH_BEGIN();
 for (int rp_ = 0; rp_ < REPN(0); ++rp_) {
                    pg8::Gemm g{S4 + (size_t)LAT0 * DI, WOUT, DI, DI, DI, 0, 0, LH / 256, D / 256, 1};
                    pg8::EpiStore E{YH, 0, D, 0};
                    pg8::gemm_phase(lds, g, E, G, bx, tid); if (DUP_MIX) pg8::gemm_phase(lds, g, E, G, bx, tid);
                    if (layer < 2) { SmallGemm sg{S4, WOUT, DI, DI, DI, DI, DI, 0, 0}; SmallDense sd{YHC, 0, D, LAT0 / 64, D / 64, 0, 0, 0}; gemm_small_dense(lds, sg, sd, 1, G, bx, tid); if (DUP_CTX) gemm_small_dense(lds, sg, sd, 1, G, bx, tid); }
 }
                    SEAM(hb + 8);
                }
            }
        } else if (EN_FOUR) {
            const bool has_ctx = layer < 3;
            if (IN(pb + 2)) { PH_BEGIN();
 for (int rp_ = 0; rp_ < REPN(2); ++rp_) {
                { pg8::Gemm g{(const bf16_t*)(ws + TAB_A1), HT, 256, 256, 256, 0, (long)D * T, 2, 128, NB};
                  pg8::EpiStore E{PB, (long)512 * 32768, 32768, 0};
                  pg8::gemm_phase(lds, g, E, G, bx, tid); if (DUP_MIX) pg8::gemm_phase(lds, g, E, G, bx, tid); }
                if (has_ctx) {
                    SmallGemm sg{(const bf16_t*)(ws + TAB_ACTX), HTC, 256, 256, 256, 256, 256, 0, 0};
                    auto dec = [=](int u, long& ao, long& bo) { const int b = u / 128, mb = (u / 16) % 8, cht = u % 16; ao = (long)mb * 64 * 256; bo = ((long)b * D + cht * 64) * CT; };
                    auto epi = [=](int u, int m, int n, const f32x4& v) { const int b = u / 128, mb = (u / 16) % 8, cht = u % 16; const int mg = mb * 64 + m, ri = mg >> 8, tp = mg & 255, ch = cht * 64 + n;
                        u32x2 w; w.x = pk2(v[0], v[1]); w.y = pk2(v[2], v[3]); *(u32x2*)(WC + (size_t)ctx_row(b, tp) * DI + (ch >> 8) * 512 + ri * 256 + (ch & 255)) = w; };
                    gemm_small(lds, sg, NB * 8 * 16, dec, epi, G, bx, tid);
                }
 }
                SEAM(pb + 2);
            }
            if (IN(pb + 3)) { PH_BEGIN();
 for (int rp_ = 0; rp_ < REPN(2); ++rp_) {
                {
                    const int wid = tid >> 6, wm = wid >> 1, wn = wid & 1, fr = lane & 15, fq = lane >> 4;
                    const int lrow = tid >> 3, lk = (tid & 7) * 8;
                    const unsigned stoff = (unsigned)(lrow * SG_LD + lk) * 2u;
                    LAS unsigned char* As = lds; LAS unsigned char* Bs0 = lds + SG_TILE; LAS unsigned char* Bs1 = lds + 2 * SG_TILE;
                    const bf16_t* A2 = (const bf16_t*)(ws + TAB_A2);
                    for (int pair = bx; pair < NB * 256; pair += G) {
                        const int b = pair >> 8, t1p = pair & 255;
                        const bf16_t* bp = PB + (size_t)b * 512 * 32768 + (size_t)((lk >> 5) * 256 + t1p) * 32768 + (size_t)lrow * 32 + (lk & 31);
                        u32x4 r0 = *(const u32x4*)(bp), r1 = *(const u32x4*)(bp + 2048), r2 = *(const u32x4*)(bp + 2 * 2048), r3 = *(const u32x4*)(bp + 3 * 2048);
                        *(LAS u32x4*)(As + stoff) = *(const u32x4*)(A2 + (size_t)t1p * 4096 + lrow * 64 + lk);
                        *(LAS u32x4*)(Bs0 + stoff) = r0;
                        LDS_BARRIER();
                        bf16x8 af[2];
#pragma unroll
                        for (int ks = 0; ks < 2; ++ks) af[ks] = *(const LAS bf16x8*)(As + ((wm * 16 + fr) * SG_LD + ks * 32 + fq * 8) * 2);
#define F2_TILE(ct_, BsC, BsN, rcur, rnext) do { \
                            if ((ct_) + 4 < 16) rcur = *(const u32x4*)(bp + ((ct_) + 4) * 2048); \
                            f32x4 acc[2] = {(f32x4){0.f, 0.f, 0.f, 0.f}, (f32x4){0.f, 0.f, 0.f, 0.f}}; \
                            _Pragma("unroll") for (int ks = 0; ks < 2; ++ks) _Pragma("unroll") for (int nt = 0; nt < 2; ++nt) { \
                                const bf16x8 bf = *(const LAS bf16x8*)(BsC + ((wn * 32 + nt * 16 + fr) * SG_LD + ks * 32 + fq * 8) * 2); \
                                acc[nt] = __builtin_amdgcn_mfma_f32_16x16x32_bf16(bf, af[ks], acc[nt], 0, 0, 0); } \
                            if ((ct_) + 1 < 16) *(LAS u32x4*)(BsN + stoff) = rnext; \
                            _Pragma("unroll") for (int nt = 0; nt < 2; ++nt) { const int m = wm * 16 + fr, n = wn * 32 + nt * 16 + fq * 4, rip = m >> 5, t2p = m & 31, ch = (ct_) * 64 + n; \
                                u32x2 w2; w2.x = pk2(acc[nt][0], acc[nt][1]); w2.y = pk2(acc[nt][2], acc[nt][3]); \
                                *(u32x2*)(WC + (size_t)lat_row(b, t1p + 256 * t2p) * DI + (ch >> 8) * 512 + rip * 256 + (ch & 255)) = w2; } \
                            LDS_BARRIER(); } while (0)
#pragma unroll 1
                        for (int ct = 0; ct < 16; ct += 4) { F2_TILE(ct, Bs0, Bs1, r0, r1); F2_TILE(ct + 1, Bs1, Bs0, r1, r2); F2_TILE(ct + 2, Bs0, Bs1, r2, r3); F2_TILE(ct + 3, Bs1, Bs0, r3, r0); }
#undef F2_TILE
                    }
                }
 }
                SEAM(pb + 3);
            }
            if (IN(pb + 4)) { PH_BEGIN();
 for (int rp_ = 0; rp_ < REPN(2); ++rp_) {
                pg8::Gemm g{WC + (size_t)CR * DI, (const bf16_t*)(ws + TAB_BZ), DI, 512, 512, 512, 0, (R - CR) / 256, 1, 4};
                pg8::EpiStore E{ZF + (size_t)CR * D, 256, D, 0};
                pg8::gemm_phase(lds, g, E, G, bx, tid); if (DUP_MIX) pg8::gemm_phase(lds, g, E, G, bx, tid);
                if (has_ctx) { SmallGemm sg{WC, (const bf16_t*)(ws + TAB_BZ), DI, 512, 512, 512, 512, 0, 0}; SmallDense sd{ZF, 256, D, CR / 64, 256 / 64, 0, 512, 0}; gemm_small_dense(lds, sg, sd, 4, G, bx, tid); if (DUP_CTX) gemm_small_dense(lds, sg, sd, 4, G, bx, tid); }
 }
                SEAM(pb + 4);
            }
            if (IN(pb + 5)) { PH_BEGIN();
 for (int rp_ = 0; rp_ < REPN(2); ++rp_) {
                pg8::Gemm g{ZF + (size_t)CR * D, WOUT, D, D, D, 0, 0, (R - CR) / 256, D / 256, 1};
                pg8::EpiStore E{YB + (size_t)CR * D, 0, D, 0};
                pg8::gemm_phase(lds, g, E, G, bx, tid); if (DUP_MIX) pg8::gemm_phase(lds, g, E, G, bx, tid);
                if (has_ctx) { SmallGemm sg{ZF, WOUT, D, D, D, D, D, 0, 0}; SmallDense sd{YB, 0, D, CR / 64, D / 64, 0, 0, 0}; gemm_small_dense(lds, sg, sd, 1, G, bx, tid); if (DUP_CTX) gemm_small_dense(lds, sg, sd, 1, G, bx, tid); }
 }
                SEAM(pb + 5);
            }
        }
#pragma unroll 1
        for (int which = 0; which < 2; ++which) {
            const int pid = pb + (which == 0 ? 19 : 22);
            if (EN_NORM && IN(pid)) { PH_BEGIN();
                const float* pg = ka->in[I_PG] + ((size_t)layer * 2 + which) * D; const float* pbv = ka->in[I_PB] + ((size_t)layer * 2 + which) * D;
                const int mlayer = which == 0 ? layer : layer + 1;
                const int shoff = which == 0 ? 3 * D : 0;
                const int goff = which == 0 ? 2 * D : 5 * D;
                const bool in_f32 = (layer == 0 && which == 0), out_f32 = (layer == 3 && which == 1);
                bf16_t* xbl = (bf16_t*)ka->out; bf16_t* xb3 = S4;
#define NR_LOAD(r_, XW, YW) do { const RowInfo ri_ = row_info(r_); const size_t xi_ = ri_.is_ctx ? ((size_t)ri_.b * CT + ri_.t) * D : ((size_t)ri_.b * T + ri_.t) * D; \
                    const bf16_t* yr_ = YB + (size_t)(r_) * D; \
                    if (in_f32) { const float* xp_ = (ri_.is_ctx ? ka->in[I_CTX] : ka->in[I_X]) + xi_; _Pragma("unroll") for (int j = 0; j < 4; ++j) XW[j] = *(const u32x4*)(xp_ + 256 * j + 4 * lane); } \
                    else { const bf16_t* xp_ = ri_.is_ctx ? (const bf16_t*)CTXX + xi_ : ((layer == 3 && which == 1) ? xb3 + xi_ : xbl + xi_); \
                        _Pragma("unroll") for (int j = 0; j < 4; ++j) { const u32x2 t_ = *(const u32x2*)(xp_ + 256 * j + 4 * lane); XW[j] = (u32x4){t_.x, t_.y, 0u, 0u}; } } \
                    _Pragma("unroll") for (int j = 0; j < 4; ++j) YW[j] = *(const u32x2*)(yr_ + 256 * j + 4 * lane); } while (0)
                if (which == 1 && (layer & 1) == 0) {
                    constexpr int TLD = 1026;
                    LAS bf16_t* TL = (LAS bf16_t*)lds;
                    const float* md2b = MOD + ((size_t)mlayer * 5) * 6 * D + shoff;
#define NT_ROW(r_, i_) do { const RowInfo ri = row_info(r_); const int mi = ri.is_ctx ? 4 : ri.b; \
                        const size_t xi = ri.is_ctx ? ((size_t)ri.b * CT + ri.t) * D : ((size_t)ri.b * T + ri.t) * D; \
                        bf16_t* xout16 = ri.is_ctx ? (bf16_t*)CTXX + xi : xbl + xi; \
                        (void)mi; f32x4 v[4]; \
                        _Pragma("unroll") for (int j = 0; j < 4; ++j) { const f32x4 x = (f32x4){bflo(xw[j].x), bfhi(xw[j].x), bflo(xw[j].y), bfhi(xw[j].y)}; \
                            const f32x4 y = (f32x4){bflo(yw[j].x), bfhi(yw[j].x), bflo(yw[j].y), bfhi(yw[j].y)}; v[j] = x * ALPHA + gtv[j] * y; } \
                        ln_norm(v, lane); \
                        _Pragma("unroll") for (int j = 0; j < 4; ++j) { const int c = 256 * j + 4 * lane; v[j] = v[j] * pgv[j] + pbw[j]; \
                            u32x2 xo; xo.x = pk2(v[j][0], v[j][1]); xo.y = pk2(v[j][2], v[j][3]); *(u32x2*)(xout16 + c) = xo; } \
                        ln_norm(v, lane); \
                        _Pragma("unroll") for (int j = 0; j < 4; ++j) { const int c = 256 * j + 4 * lane; \
                            const f32x4 h = v[j] * scv[j] + shv[j]; LAS unsigned* d_ = (LAS unsigned*)(TL + (i_) * TLD + c); d_[0] = pk2(h[0], h[1]); d_[1] = pk2(h[2], h[3]); } } while (0)
#define NT_PARAMS(mi_) do { const float* md_ = MOD + ((size_t)layer * 5 + (mi_)) * 6 * D; const float* md2_ = md2b + (size_t)(mi_) * 6 * D; \
                        _Pragma("unroll") for (int j = 0; j < 4; ++j) { const int c = 256 * j + 4 * lane; gtv[j] = *(const f32x4*)(md_ + goff + c); shv[j] = *(const f32x4*)(md2_ + c); scv[j] = *(const f32x4*)(md2_ + D + c) + 1.0f; } } while (0)
                    u32x4 xw[4], xn[4]; u32x2 yw[4], yn[4];
#pragma unroll
                    for (int j = 0; j < 4; ++j) { xw[j] = (u32x4){0u, 0u, 0u, 0u}; xn[j] = xw[j]; yw[j] = (u32x2){0u, 0u}; yn[j] = yw[j]; }
                    f32x4 pgv[4], pbw[4], gtv[4], shv[4], scv[4];
#pragma unroll
                    for (int j = 0; j < 4; ++j) { pgv[j] = *(const f32x4*)(pg + 256 * j + 4 * lane); pbw[j] = *(const f32x4*)(pbv + 256 * j + 4 * lane); }
                    for (int item = bx; item < NB * 32 * 4; item += G) {
                        const int b = item >> 7, t2 = (item >> 2) & 31, tb = item & 3;
                        NT_PARAMS(b);
                        const int rbase = lat_row(b, 32 * (64 * tb + wave * 8) + t2);
                        NR_LOAD(rbase, xw, yw);
#pragma unroll 1
                        for (int j8 = 0; j8 < 8; ++j8) {
                            if (j8 < 7) NR_LOAD(rbase + 32 * (j8 + 1), xn, yn);
                            NT_ROW(rbase + 32 * j8, wave * 8 + j8);
#pragma unroll
                            for (int j = 0; j < 4; ++j) { xw[j] = xn[j]; yw[j] = yn[j]; }
                        }
                        LDS_BARRIER();
#pragma unroll 4
                        for (int k = 0; k < 16; ++k) { const int idx = k * NTHR + tid, g8 = idx & 7, ch = idx >> 3; const LAS bf16_t* s = TL + (8 * g8) * TLD + ch;
                            u32x4 o; o.x = (unsigned)s[0] | ((unsigned)s[TLD] << 16); o.y = (unsigned)s[2 * TLD] | ((unsigned)s[3 * TLD] << 16); o.z = (unsigned)s[4 * TLD] | ((unsigned)s[5 * TLD] << 16); o.w = (unsigned)s[6 * TLD] | ((unsigned)s[7 * TLD] << 16);
                            *(u32x4*)(HT + (((size_t)b * D + ch) * 32 + t2) * 256 + 64 * tb + 8 * g8) = o; }
                        LDS_BARRIER();
                    }
                    if (layer < 2) {
                        NT_PARAMS(4);
                        for (int item = bx; item < NB * (CT / 8); item += G) {
                            const int b = item / (CT / 8), t8 = item % (CT / 8);
                            const int r = ctx_row(b, 8 * t8 + wave);
                            NR_LOAD(r, xw, yw);
                            NT_ROW(r, wave);
                            LDS_BARRIER();
#pragma unroll
                            for (int k = 0; k < 2; ++k) { const int ch = k * NTHR + tid; const LAS bf16_t* s = TL + ch;
                                u32x4 o; o.x = (unsigned)s[0] | ((unsigned)s[TLD] << 16); o.y = (unsigned)s[2 * TLD] | ((unsigned)s[3 * TLD] << 16); o.z = (unsigned)s[4 * TLD] | ((unsigned)s[5 * TLD] << 16); o.w = (unsigned)s[6 * TLD] | ((unsigned)s[7 * TLD] << 16);
                                *(u32x4*)(HTC + ((size_t)b * D + ch) * CT + 8 * t8) = o; }
                            LDS_BARRIER();
                        }
                    }
#undef NT_ROW
#undef NT_PARAMS
                } else {
                u32x4 xw[4], xn[4]; u32x2 yw[4], yn[4];
#pragma unroll
                for (int j = 0; j < 4; ++j) { xw[j] = (u32x4){0u, 0u, 0u, 0u}; xn[j] = xw[j]; yw[j] = (u32x2){0u, 0u}; yn[j] = yw[j]; }
                f32x4 pgv[4], pbw[4];
#pragma unroll
                for (int j = 0; j < 4; ++j) { pgv[j] = *(const f32x4*)(pg + 256 * j + 4 * lane); pbw[j] = *(const f32x4*)(pbv + 256 * j + 4 * lane); }
                const int nseg = (layer < 2 && gw < CR) ? 2 : 1;
#pragma unroll 1
                for (int seg = 0; seg < nseg; ++seg) {
                    const int mi = seg == 0 ? (gw >> 9) : 4;
                    const int rbeg = seg == 0 ? lat_row(gw >> 9, gw & 511) : gw, nr = seg == 0 ? T / 512 : 1;
                    const float* md = MOD + ((size_t)layer * 5 + mi) * 6 * D;
                    const float* md2 = MOD + ((size_t)(mlayer < 4 ? mlayer : 3) * 5 + mi) * 6 * D + shoff;
                    f32x4 gtv[4], shv[4], scv[4];
#pragma unroll
                    for (int j = 0; j < 4; ++j) { const int c = 256 * j + 4 * lane; gtv[j] = *(const f32x4*)(md + goff + c); shv[j] = *(const f32x4*)(md2 + c); scv[j] = *(const f32x4*)(md2 + D + c) + 1.0f; }
                    NR_LOAD(rbeg, xw, yw);
#pragma unroll 1
                    for (int k = 0; k < nr; ++k) {
                        const int r = rbeg + 512 * k;
                        if (k + 1 < nr) NR_LOAD(r + 512, xn, yn);
                        const RowInfo ri = row_info(r);
                        const size_t xi = ri.is_ctx ? ((size_t)ri.b * CT + ri.t) * D : ((size_t)ri.b * T + ri.t) * D;
                        bf16_t* xout16 = ri.is_ctx ? (bf16_t*)CTXX + xi : ((layer == 3 && which == 0) ? xb3 + xi : xbl + xi);
                        f32x4 v[4];
#pragma unroll
                        for (int j = 0; j < 4; ++j) { f32x4 x; if (in_f32) x = __builtin_bit_cast(f32x4, xw[j]); else x = (f32x4){bflo(xw[j].x), bfhi(xw[j].x), bflo(xw[j].y), bfhi(xw[j].y)};
                            const f32x4 y = (f32x4){bflo(yw[j].x), bfhi(yw[j].x), bflo(yw[j].y), bfhi(yw[j].y)}; v[j] = x * ALPHA + gtv[j] * y; }
                        ln_norm(v, lane);
#pragma unroll
                        for (int j = 0; j < 4; ++j) { const int c = 256 * j + 4 * lane; v[j] = v[j] * pgv[j] + pbw[j];
                            if (out_f32) *(f32x4*)(ka->out + xi + c) = v[j]; else { u32x2 xo; xo.x = pk2(v[j][0], v[j][1]); xo.y = pk2(v[j][2], v[j][3]); *(u32x2*)(xout16 + c) = xo; } }
                        if (mlayer < 4) {
                            ln_norm(v, lane);
                            bf16_t* o = HIN + (size_t)r * D;
#pragma unroll
                            for (int j = 0; j < 4; ++j) { const int c = 256 * j + 4 * lane; const f32x4 h = v[j] * scv[j] + shv[j]; u32x2 w; w.x = pk2(h[0], h[1]); w.y = pk2(h[2], h[3]); *(u32x2*)(o + c) = w; }
                        }
#pragma unroll
                        for (int j = 0; j < 4; ++j) { xw[j] = xn[j]; yw[j] = yn[j]; }
                    }
                }
                }
#undef NR_LOAD
                SEAM(pid);
            }
            if (EN_MLP && which == 0) {
                if (IN(pb + 20)) { PH_BEGIN();
 for (int rp_ = 0; rp_ < REPN(1); ++rp_) {
                    pg8::Gemm g{HIN + (size_t)CR * D, W1, D, D, D, 0, 0, (R - CR) / 256, DFF / 256, 1};
                    pg8::EpiStore E{HID + (size_t)CR * DFF, 0, DFF, 1};
                    pg8::gemm_phase(lds, g, E, G, bx, tid);
#if DUP_MLP
                    pg8::gemm_phase(lds, g, E, G, bx, tid);
#endif
                    if (layer < 2) { SmallGemm sg{HIN, W1, D, D, D, D, D, 0, 0}; SmallDense sd{HID, 0, DFF, CR / 64, DFF / 64, 1, 0, 0}; gemm_small_dense(lds, sg, sd, 1, G, bx, tid); }
 }
                    SEAM(pb + 20);
                }
                if (IN(pb + 21)) { PH_BEGIN();
 for (int rp_ = 0; rp_ < REPN(1); ++rp_) {
                    pg8::Gemm g{HID + (size_t)CR * DFF, W2, DFF, DFF, DFF, 0, 0, (R - CR) / 256, D / 256, 1, 1};
                    pg8::EpiStore E{YB + (size_t)CR * D, 0, D, 0};
                    pg8::gemm_phase(lds, g, E, G, bx, tid);
#if DUP_MLP
                    pg8::gemm_phase(lds, g, E, G, bx, tid);
#endif
                    if (layer < 2) { SmallGemm sg{HID, W2, DFF, DFF, DFF, DFF, DFF, 0, 0}; SmallDense sd{YB, 0, D, CR / 64, D / 64, 0, 0, 0}; gemm_small_dense(lds, sg, sd, 1, G, bx, tid); }
 }
                    SEAM(pb + 21);
                }
            }
        }
    }
#undef IN
#undef SEAM
}

extern "C" void kernel_launch(void* const* d_in, const int* in_sizes, int n_in, void* d_out, int out_size, void* d_ws, size_t ws_size, hipStream_t stream) {
    static int grid = 0;
    if (grid == 0) {
        if (n_in != 22 || ws_size < 512 * MiB) { fprintf(stderr, "kernel_launch: unexpected n_in %d / ws_size %zu\n", n_in, ws_size); grid = -1; return; }
        int dev = 0, cus = 0;
        if (hipGetDevice(&dev) != hipSuccess || hipDeviceGetAttribute(&cus, hipDeviceAttributeMultiprocessorCount, dev) != hipSuccess) { grid = -1; return; }
        if (hipFuncSetAttribute((const void*)fwd, hipFuncAttributeMaxDynamicSharedMemorySize, LDS_BYTES) != hipSuccess) { fprintf(stderr, "kernel_launch: hipFuncSetAttribute failed\n"); grid = -1; return; }
        int per_cu = 0;
        if (hipOccupancyMaxActiveBlocksPerMultiprocessor(&per_cu, (const void*)fwd, NTHR, LDS_BYTES) != hipSuccess || per_cu < 1) fprintf(stderr, "kernel_launch: occupancy query says %d\n", per_cu);
        (void)hipGetLastError();
        grid = cus;
        if (grid != 256) fprintf(stderr, "kernel_launch: %d CUs (built for 256)\n", grid);
    }
    if (grid < 0) return;
    (void)hipMemsetAsync((char*)d_ws + WS_CTL, 0, CTL_BYTES, stream);
    Args a{};
    for (int i = 0; i < 22; ++i) a.in[i] = (const float*)d_in[i];
    a.out = (float*)d_out; a.ws = (unsigned char*)d_ws;
#if MK_SINGLE
    { int last = 0; for (int id = 0; id < NPHASE; ++id) if (phase_valid(id)) last = id;
      a.ph_lo = 0; a.ph_hi = NPHASE; a.ph_last = last; a.li = 0;
      hipLaunchKernelGGL(fwd, dim3(grid), dim3(NTHR), LDS_BYTES, stream, a); }
#else
    { int li = 0;
      for (int id = 0; id < NPHASE; ++id) { if (!phase_valid(id)) continue;
          a.ph_lo = id; a.ph_hi = id + 1; a.ph_last = id; a.li = li++;
          hipLaunchKernelGGL(fwd, dim3(grid), dim3(NTHR), LDS_BYTES, stream, a); } }
#endif
}
```

```cpp
#include <hip/hip_runtime.h>
#include <cstdio>
#include <cstdint>

#define LAS __attribute__((address_space(3)))
typedef unsigned short bf16_t;
typedef short bf16x8 __attribute__((ext_vector_type(8)));
typedef float f32x4 __attribute__((ext_vector_type(4)));
typedef unsigned u32x4 __attribute__((ext_vector_type(4)));
typedef unsigned u32x2 __attribute__((ext_vector_type(2)));
typedef short s16x4 __attribute__((ext_vector_type(4)));


#ifndef EN_PRO
#define EN_PRO 1
#endif
#ifndef EN_WC
#define EN_WC 1
#endif
#ifndef EN_MIX
#define EN_MIX 1
#endif
#ifndef EN_SCAN
#define EN_SCAN 1
#endif
#ifndef EN_FOUR
#define EN_FOUR 1
#endif
#ifndef EN_NORM
#define EN_NORM 1
#endif
#ifndef EN_MLP
#define EN_MLP 1
#endif
#ifndef DUP_MIX
#define DUP_MIX 0
#endif
#ifndef DUP_CTX
#define DUP_CTX 0
#endif
#ifndef DUP_BAR
#define DUP_BAR 0
#endif
#ifndef DUP_MLP
#define DUP_MLP 0
#endif
#ifndef REP_MASK
#define REP_MASK 0
#endif
#define REPN(bit) (((REP_MASK) >> (bit)) & 1 ? 2 : 1)
#ifndef SC_QPAD
#define SC_QPAD 64
#endif
#ifndef SC_ABL
#define SC_ABL 0
#endif
#ifndef SCAN_REP
#define SCAN_REP 1
#endif
#ifndef MK_SINGLE
#define MK_SINGLE 1
#endif

constexpr int D = 1024, NB = 4, T = 8192, CT = 256, DI = 2048, NH = 4, DH = 512, DFF = 4096;
constexpr int R = NB * (T + CT);
constexpr int RH = R / 2;
constexpr int LAT0 = 2 * CT;
constexpr int NCH = RH / 64;
constexpr float ALPHA = 1.6817928305074290f;
constexpr float LN_EPS = 1e-5f;
constexpr int NWAVES = 8, NTHR = 512;

constexpr size_t MiB = 1u << 20;
constexpr size_t WS_CTL = 0, CTL_BYTES = 2 * MiB;
constexpr size_t WS_MOD = 2 * MiB;
constexpr size_t WS_CTXX = 3 * MiB;
constexpr size_t WS_PRE = 7 * MiB;
constexpr size_t WS_TAB = 10 * MiB;
constexpr size_t TAB_A1 = WS_TAB;
constexpr size_t TAB_A2 = TAB_A1 + 512 * 256 * 2;
constexpr size_t TAB_BZ = TAB_A2 + 256 * 64 * 64 * 2;
constexpr size_t TAB_ACTX = TAB_BZ + 256 * 512 * 2;
constexpr size_t TAB_GATE = TAB_ACTX + 512 * 256 * 2;
static_assert(TAB_GATE + 64 * 4096 * 2 <= 15 * MiB, "tables");
constexpr size_t WS_W = 15 * MiB;
constexpr size_t W_IN = WS_W;
constexpr size_t W_Q = W_IN + 8 * MiB, W_K = W_Q + 2 * MiB, W_V = W_K + 2 * MiB;
constexpr size_t W_OUT = W_V + 2 * MiB;
constexpr size_t W_1 = W_OUT + 4 * MiB;
constexpr size_t W_2 = W_1 + 8 * MiB;
static_assert(W_2 + 8 * MiB <= 49 * MiB, "weights");
constexpr size_t WS_HIN = 49 * MiB;
constexpr size_t WS_YB = 115 * MiB;
constexpr size_t WS_BIG = 181 * MiB;
constexpr size_t SLOT = 66 * MiB;
static_assert(WS_BIG + 5 * SLOT <= 512 * MiB, "workspace");
static_assert((size_t)RH * DI * 2 == SLOT, "slot");

#define LDS_BARRIER() do { asm volatile("s_waitcnt lgkmcnt(0)" ::: "memory"); __builtin_amdgcn_s_barrier(); asm volatile("" ::: "memory"); } while (0)
__device__ __forceinline__ unsigned f2bf(float f) { unsigned u = __builtin_bit_cast(unsigned, f); return (u + 0x7fffu + ((u >> 16) & 1u)) >> 16; }
typedef __bf16 bf16x2_t __attribute__((ext_vector_type(2)));
typedef float f32x2_t __attribute__((ext_vector_type(2)));
__device__ __forceinline__ unsigned pk2(float lo, float hi) { const f32x2_t v = {lo, hi}; return __builtin_bit_cast(unsigned, __builtin_convertvector(v, bf16x2_t)); }
__device__ __forceinline__ float bf2f(unsigned short b) { return __builtin_bit_cast(float, ((unsigned)b) << 16); }
__device__ __forceinline__ float u2f(unsigned u) { return __builtin_bit_cast(float, u); }
__device__ __forceinline__ float bflo(unsigned w) { return __builtin_bit_cast(float, w << 16); }
__device__ __forceinline__ float bfhi(unsigned w) { return __builtin_bit_cast(float, w & 0xffff0000u); }
__device__ __forceinline__ float shx(float v, int mask, int lane) { return __builtin_bit_cast(float, __builtin_amdgcn_ds_bpermute((lane ^ mask) << 2, __builtin_bit_cast(int, v))); }
template <int CTRL, int RMASK> __device__ __forceinline__ float dppf(float idv, float src) { return __builtin_bit_cast(float, __builtin_amdgcn_update_dpp(__builtin_bit_cast(int, idv), __builtin_bit_cast(int, src), CTRL, RMASK, 0xF, false)); }
__device__ __forceinline__ float scan_add64(float x) {
    x += dppf<0x111, 0xF>(0.f, x); x += dppf<0x112, 0xF>(0.f, x); x += dppf<0x114, 0xF>(0.f, x); x += dppf<0x118, 0xF>(0.f, x);
    x += dppf<0x142, 0xA>(0.f, x); x += dppf<0x143, 0xC>(0.f, x); return x; }
__device__ __forceinline__ float scan_max64(float x) {
    const float ni = -__builtin_inff();
    x = fmaxf(x, dppf<0x111, 0xF>(ni, x)); x = fmaxf(x, dppf<0x112, 0xF>(ni, x)); x = fmaxf(x, dppf<0x114, 0xF>(ni, x)); x = fmaxf(x, dppf<0x118, 0xF>(ni, x));
    x = fmaxf(x, dppf<0x142, 0xA>(ni, x)); x = fmaxf(x, dppf<0x143, 0xC>(ni, x)); return x; }
__device__ __forceinline__ float shup(float v, int d, int lane) { return __builtin_bit_cast(float, __builtin_amdgcn_ds_bpermute((lane - d) << 2, __builtin_bit_cast(int, v))); }
__device__ __forceinline__ float wave_sum(float v, int lane) {
    (void)lane;
    return __builtin_bit_cast(float, __builtin_amdgcn_readlane(__builtin_bit_cast(int, scan_add64(v)), 63));
}
__device__ __forceinline__ float siluf(float x) { return x * __builtin_amdgcn_rcpf(1.0f + __expf(-x)); }

struct RowInfo { int is_ctx, b, t; };
__device__ __forceinline__ RowInfo row_info(int r) {
    RowInfo ri;
    if (r < NB * CT) { ri.is_ctx = 1; ri.b = r / CT; ri.t = r % CT; }
    else { ri.is_ctx = 0; const int u = r - NB * CT; ri.b = u / T; ri.t = u % T; }
    return ri;
}
__device__ __forceinline__ int lat_row(int b, int t) { return NB * CT + b * T + t; }
__device__ __forceinline__ int ctx_row(int b, int t) { return b * CT + t; }
constexpr int CR = NB * CT;
constexpr int LH = RH - LAT0;

#define XB_TMO      128
#define XB_XCNT(j)  (256  + 64 * (j))
#define XB_XSUB(j)  (1280 + 64 * (j))
#define XB_XGEN(j)  (2304 + 64 * (j))
#define XB_TOP      3328
#define XB_TOPGEN   3392
#define XCD_BAR_WORDS 3456
#define XB_SPIN_CAP (1u << 18)

__device__ __forceinline__ unsigned xb_ld(unsigned* p)              { return __hip_atomic_load(p, __ATOMIC_RELAXED, __HIP_MEMORY_SCOPE_AGENT); }
__device__ __forceinline__ unsigned xb_add(unsigned* p, unsigned v) { return __hip_atomic_fetch_add(p, v, __ATOMIC_RELAXED, __HIP_MEMORY_SCOPE_AGENT); }
__device__ __forceinline__ unsigned xb_xcc_id() { return (unsigned)__builtin_amdgcn_s_getreg((3 << 11) | 20) & 0xFu; }
#define XB_SPIN(cond, bar) do { unsigned _sp = 0; while (cond) { __builtin_amdgcn_s_sleep(1); \
    if ((++_sp & 255u) == 0u) { if (xb_ld(&(bar)[XB_TMO])) break; if (_sp > XB_SPIN_CAP) { atomicAdd(&(bar)[XB_TMO], 1u); break; } } } } while (0)

struct XcdBarrier { unsigned* bar; unsigned x; volatile LAS unsigned* st; };

__device__ __forceinline__ XcdBarrier xcd_barrier_post(unsigned* bar, volatile LAS unsigned* st) {
    XcdBarrier b; b.bar = bar; b.x = xb_xcc_id(); b.st = st;
    if (threadIdx.x == 0) (void)xb_add(&bar[XB_XCNT(b.x)], 1u);
    return b;
}
__device__ __forceinline__ void xcd_barrier_complete(unsigned* bar, unsigned x, unsigned& nloc, unsigned& nx) {
    const unsigned G = gridDim.x * gridDim.y * gridDim.z;
    unsigned sum, cnt, mine, sp = 0u;
    for (;;) {
        sum = 0u; cnt = 0u; mine = 0u;
#pragma unroll
        for (unsigned j = 0; j < 16; ++j) { const unsigned c = xb_ld(&bar[XB_XCNT(j)]); sum += c; cnt += (c > 0u) ? 1u : 0u; mine = (j == x) ? c : mine; }
        if (sum == G) break;
        __builtin_amdgcn_s_sleep(1);
        if ((++sp & 255u) == 0u) { if (xb_ld(&bar[XB_TMO])) break; if (sp > XB_SPIN_CAP) { atomicAdd(&bar[XB_TMO], 1u); break; } }
    }
    nloc = mine > 0u ? mine : 1u; nx = cnt > 0u ? cnt : 1u;
}
__device__ __forceinline__ void xcd_barrier(const XcdBarrier& b, bool thread0) {
    asm volatile("s_waitcnt vmcnt(0)" ::: "memory");
    __syncthreads();
    if (thread0) {
        unsigned* bar = b.bar;
        __builtin_amdgcn_s_waitcnt(0);
        unsigned nloc = b.st[0], nx = b.st[1];
        if (nloc == 0u) { xcd_barrier_complete(bar, b.x, nloc, nx); b.st[0] = nloc; b.st[1] = nx; }
        const unsigned old = xb_add(&bar[XB_XSUB(b.x)], 1u);
        const unsigned gen = old / nloc;
        if (old + 1u == (gen + 1u) * nloc) {
            __builtin_amdgcn_fence(__ATOMIC_RELEASE, "agent");
            asm volatile("s_waitcnt vmcnt(0)" ::: "memory");
            const unsigned og = xb_add(&bar[XB_TOP], 1u);
            const unsigned tg = og / nx;
            if (og + 1u == (tg + 1u) * nx) xb_add(&bar[XB_TOPGEN], 1u);
            else XB_SPIN(xb_ld(&bar[XB_TOPGEN]) == tg, bar);
            __builtin_amdgcn_fence(__ATOMIC_ACQUIRE, "agent");
            xb_add(&bar[XB_XGEN(b.x)], 1u);
            asm volatile("s_waitcnt vmcnt(0)" ::: "memory");
        } else {
            XB_SPIN(xb_ld(&bar[XB_XGEN(b.x)]) == gen, bar);
            __builtin_amdgcn_fence(__ATOMIC_ACQUIRE, "agent");
            asm volatile("s_waitcnt vmcnt(0)" ::: "memory");
        }
    }
    __syncthreads();
}

__device__ __forceinline__ size_t qtile_off(int q, int h, int cc) {
    const int chunk = q >> 6, p = q & 63, pt = p >> 4, fr = p & 15, w = cc >> 6, ks = (cc >> 5) & 1, fq = (cc >> 3) & 3;
    const size_t blk = ((((size_t)chunk * 4 + h) * 8 + w) * 4 + pt) * 2 + ks;
    return blk * 512 + (size_t)(fq * 16 + fr) * 8 + (cc & 7);
}
__device__ __forceinline__ size_t ktile_off(int d, int h, int q) {
    const int chunk = q >> 6, s = q & 63, ks = s >> 5, fq = (s >> 3) & 3, w = d >> 6, dd = d & 63, mt = 2 * (dd >> 5) + ((dd >> 2) & 1), frp = 4 * ((dd >> 3) & 3) + (dd & 3);
    const size_t blk = ((((size_t)chunk * 4 + h) * 8 + w) * 4 + mt) * 2 + ks;
    return blk * 512 + (size_t)(fq * 16 + frp) * 8 + (s & 7);
}

__device__ __forceinline__ size_t vtile_off(int e, int h, int q) {
    const int chunk = q >> 6, s = q & 63, slice = e >> 5, e5 = e & 31, nt = e5 >> 4, fr = e5 & 15, ks = s >> 5, fq = (s >> 3) & 3;
    const size_t blk = ((((size_t)chunk * 4 + h) * 16 + slice) * 2 + nt) * 2 + ks;
    return blk * 512 + (size_t)(fq * 16 + fr) * 8 + (s & 7);
}
__device__ __forceinline__ size_t htile_off(int q, int h, int e) {
    return ((((size_t)(q >> 6) * 4 + h) * 16 + (e >> 5)) * 2048) + (size_t)(q & 63) * 32 + (e & 31);
}

namespace pg8 {
constexpr int BM = 256, BK = 64, HALF = 128, HTB = HALF * BK * 2, STAGE_BYTES = 8 * HTB, NXCD = 8, WGM = 8;
__device__ __forceinline__ int lds_byte(int r, int c) { const int st = (r >> 4) * 2 + (c >> 5), rr = r & 15, cc = c & 31, ob = rr * 64 + cc * 2; return st * 1024 + (ob ^ (((ob >> 9) & 1) << 5)); }
__device__ __forceinline__ void stage_rc(int b, int& R_, int& C_) { const int st = b / 1024, sb = b % 1024, swz = sb ^ (((sb >> 9) & 1) << 5); R_ = (st >> 1) * 16 + swz / 64; C_ = (st & 1) * 32 + (swz % 64) / 2; }
__device__ __forceinline__ int perm32(int rho) { const int n = rho >> 4, i = rho & 15; return 8 * (i >> 2) + 4 * n + (i & 3); }

struct Unit { int pm, pn, g; };
struct Gemm {
    const bf16_t* A; const bf16_t* Bt; int lda, ldb, K;
    long a_gs, b_gs;
    int nM, nN, nG;
    int rev;
};
struct Order {
    int nM, nNt, nN, nwg, G, c, rev;
    __device__ void init(const Gemm& g, int G_, int c_) { nM = g.nM; nN = g.nN; nNt = g.nN * g.nG; nwg = nM * nNt; G = G_; c = c_; rev = g.rev; }
    __device__ bool next(int i, Unit& u) const {
        const long L = (long)i * G + c; if (L >= nwg) return false;
        int wgid = (int)L; { const int q = nwg / NXCD, r = nwg % NXCD, xcd = wgid % NXCD, off = wgid / NXCD; wgid = (xcd < r ? xcd * (q + 1) : r * (q + 1) + (xcd - r) * q) + off; }
        const int nig = WGM * nNt, gid = wgid / nig, fm = gid * WGM, gsz = (nM - fm) < WGM ? (nM - fm) : WGM;
        u.pm = fm + ((wgid % nig) % gsz); if (rev) u.pm = nM - 1 - u.pm; const int pnt = (wgid % nig) / gsz; u.g = pnt / nN; u.pn = pnt - u.g * nN; return true;
    }
};
__device__ __forceinline__ unsigned cvt_pk_bf16(float lo, float hi) { return pk2(lo, hi); }

struct EpiStore {
    bf16_t* O; long o_gs; int ldc; int act;
    int mode, off;
    __device__ __forceinline__ void operator()(const f32x4 (&acc)[2][2][4][2], const Unit& u, int wr, int wc, int fr, int fq) const {
        const int row0 = u.pm * BM + wr * 64 + fr; const int col0 = u.pn * BM + wc * 32 + 8 * fq; bf16_t* base = O + (long)u.g * o_gs;
#pragma unroll
        for (int ai = 0; ai < 2; ++ai)
#pragma unroll
            for (int m = 0; m < 4; ++m) { bf16_t* rowp = base + (size_t)(row0 + ai * HALF + m * 16) * ldc + col0;
#pragma unroll
                for (int bj = 0; bj < 2; ++bj) { f32x4 v0 = acc[ai][bj][m][0], v1 = acc[ai][bj][m][1];
                    if (act == 1) {
#pragma unroll
                        for (int j = 0; j < 4; ++j) { const float a = fmaxf(v0[j], 0.f), b = fmaxf(v1[j], 0.f); v0[j] = a * a; v1[j] = b * b; } }
                    u32x4 w; w.x = cvt_pk_bf16(v0[0], v0[1]); w.y = cvt_pk_bf16(v0[2], v0[3]); w.z = cvt_pk_bf16(v1[0], v1[1]); w.w = cvt_pk_bf16(v1[2], v1[3]);
                    if (mode == 0) *(u32x4*)(rowp + bj * HALF) = w;
                    else if (mode == 1) *(u32x4*)(O + qtile_off(off + row0 + ai * HALF + m * 16, u.g, col0 + bj * HALF)) = w;
                    else if (mode == 2) *(u32x4*)(O + ktile_off(row0 + ai * HALF + m * 16, u.g, off + col0 + bj * HALF)) = w;
                    else *(u32x4*)(O + vtile_off(row0 + ai * HALF + m * 16, u.g, off + col0 + bj * HALF)) = w; } }
    }
};

template <class Epi>
__device__ __forceinline__ void gemm_phase(LAS unsigned char* lds, const Gemm g, const Epi& E, int G_, int c_, int tid_in) {
    int tid_ = tid_in; asm volatile("" : "+v"(tid_));
    const int tid = tid_, wid = __builtin_amdgcn_readfirstlane(tid >> 6), lane = tid & 63, wr = wid >> 2, wc = wid & 3, fr = lane & 15, fq = lane >> 4;
    const int K = g.K, nt = K / BK;
    Order S; S.init(g, G_, c_);
    unsigned voffA[2], voffB[2];
#pragma unroll
    for (int i = 0; i < 2; ++i) { int R_, C_; stage_rc(tid * 16 + i * 8192, R_, C_); const int Rb = (R_ & ~31) + perm32(R_ & 31);
        voffA[i] = (unsigned)(R_ * g.lda + C_) * 2u; voffB[i] = (unsigned)(Rb * g.ldb + C_) * 2u; }
    const size_t kstep = (size_t)(BK * 2);
    const size_t hstepA = (size_t)HALF * g.lda * 2, hstepB = (size_t)HALF * g.ldb * 2;
    const unsigned ldsw = (unsigned)wid * 1024u;
    const int aoff = lds_byte(wr * 64 + fr, fq * 8), boff = lds_byte(wc * 32 + fr, fq * 8);
#define PG8_SA(b, h) (((b) * 2 + (h)) * HTB)
#define PG8_SB(b, h) ((4 + (b) * 2 + (h)) * HTB)
#define PG8_STAGE(bufoff, gbase, voff) do { _Pragma("unroll") for (int _i = 0; _i < 2; ++_i) \
        __builtin_amdgcn_global_load_lds((const unsigned*)((const char*)(gbase) + (voff)[_i]), (LAS unsigned*)(lds + (bufoff) + ldsw + _i * 8192), 16, 0, 0); } while (0)
#define PG8_LDA(dst, b, h) do { _Pragma("unroll") for (int m = 0; m < 4; ++m) _Pragma("unroll") for (int k = 0; k < 2; ++k) dst[m][k] = *(const LAS bf16x8*)(lds + PG8_SA(b, h) + aoff + m * 2048 + k * 1024); } while (0)
#define PG8_LDB(dst, b, h) do { _Pragma("unroll") for (int n = 0; n < 2; ++n) _Pragma("unroll") for (int k = 0; k < 2; ++k) dst[n][k] = *(const LAS bf16x8*)(lds + PG8_SB(b, h) + boff + n * 2048 + k * 1024); } while (0)
#define PG8_MMA(ai, bj, At, Bt) do { __builtin_amdgcn_s_setprio(1); _Pragma("unroll") for (int m = 0; m < 4; ++m) _Pragma("unroll") for (int n = 0; n < 2; ++n) _Pragma("unroll") for (int k = 0; k < 2; ++k) \
        acc[ai][bj][m][n] = __builtin_amdgcn_mfma_f32_16x16x32_bf16(Bt[n][k], At[m][k], acc[ai][bj][m][n], 0, 0, 0); __builtin_amdgcn_s_setprio(0); } while (0)
#define PG8_WAIT_V(n) asm volatile("s_waitcnt vmcnt(" #n ")" ::: "memory")
#define PG8_WAIT_L(n) asm volatile("s_waitcnt lgkmcnt(" #n ")" ::: "memory")
#define PG8_BAR __builtin_amdgcn_s_barrier()
#define PG8_SCHED __builtin_amdgcn_sched_barrier(0)
#define PG8_APTR(u) ((const char*)(g.A + (long)(u).g * g.a_gs) + (size_t)(u).pm * 2 * hstepA)
#define PG8_BPTR(u) ((const char*)(g.Bt + (long)(u).g * g.b_gs) + (size_t)(u).pn * 2 * hstepB)
    Unit cur, nxt; int ui = 0;
    if (!S.next(0, cur)) return;
    f32x4 acc[2][2][4][2];
#pragma unroll
    for (int a = 0; a < 2; ++a)
#pragma unroll
        for (int b = 0; b < 2; ++b)
#pragma unroll
            for (int m = 0; m < 4; ++m)
#pragma unroll
                for (int n = 0; n < 2; ++n) acc[a][b][m][n] = (f32x4){0.f, 0.f, 0.f, 0.f};
    bf16x8 At[4][2], B0[2][2], B1[2][2];
    const char* cA = PG8_APTR(cur); const char* cB = PG8_BPTR(cur);
    PG8_STAGE(PG8_SB(0, 0), cB, voffB); PG8_STAGE(PG8_SA(0, 0), cA, voffA); PG8_STAGE(PG8_SB(0, 1), cB + hstepB, voffB); PG8_STAGE(PG8_SA(0, 1), cA + hstepA, voffA);
    if (wr == 1) PG8_BAR;
    PG8_WAIT_V(4); PG8_BAR;
    PG8_STAGE(PG8_SB(1, 0), cB + kstep, voffB); PG8_STAGE(PG8_SA(1, 0), cA + kstep, voffA); PG8_STAGE(PG8_SB(1, 1), cB + hstepB + kstep, voffB);
    PG8_WAIT_V(6); PG8_BAR;
    for (;;) {
        const bool has_next = S.next(ui + 1, nxt);
        const char* nA = has_next ? PG8_APTR(nxt) : cA; const char* nB = has_next ? PG8_BPTR(nxt) : cB;
        for (int t = 0; t < nt; t += 2) {
            const bool last = (t == nt - 2);
            const char* a1 = cA + (size_t)(t + 1) * kstep;
            const char* a2 = last ? nA : cA + (size_t)(t + 2) * kstep; const char* b2 = last ? nB : cB + (size_t)(t + 2) * kstep;
            const char* a3 = a2 + kstep; const char* b3 = b2 + kstep;
            PG8_LDB(B0, 0, 0); PG8_SCHED; PG8_LDA(At, 0, 0); PG8_STAGE(PG8_SA(1, 1), a1 + hstepA, voffA);
            PG8_WAIT_L(8); PG8_BAR; PG8_WAIT_L(0); PG8_MMA(0, 0, At, B0); PG8_BAR; PG8_SCHED;
            PG8_LDB(B1, 0, 1); PG8_STAGE(PG8_SB(0, 0), b2, voffB);
            PG8_BAR; PG8_WAIT_L(0); PG8_MMA(0, 1, At, B1); PG8_BAR;
            PG8_LDA(At, 0, 1); PG8_STAGE(PG8_SA(0, 0), a2, voffA);
            PG8_BAR; PG8_WAIT_L(0); PG8_MMA(1, 0, At, B0); PG8_BAR; PG8_SCHED;
            PG8_STAGE(PG8_SB(0, 1), b2 + hstepB, voffB);
            PG8_WAIT_V(6); PG8_BAR; PG8_MMA(1, 1, At, B1); PG8_BAR;
            PG8_LDB(B0, 1, 0); PG8_SCHED; PG8_LDA(At, 1, 0); PG8_STAGE(PG8_SA(0, 1), a2 + hstepA, voffA);
            PG8_WAIT_L(8); PG8_BAR; PG8_WAIT_L(0); PG8_MMA(0, 0, At, B0); PG8_BAR; PG8_SCHED;
            PG8_LDB(B1, 1, 1); PG8_STAGE(PG8_SB(1, 0), b3, voffB);
            PG8_BAR; PG8_WAIT_L(0); PG8_MMA(0, 1, At, B1); PG8_BAR;
            PG8_LDA(At, 1, 1); PG8_STAGE(PG8_SA(1, 0), a3, voffA);
            PG8_BAR; PG8_WAIT_L(0); PG8_MMA(1, 0, At, B0); PG8_BAR; PG8_SCHED;
            PG8_STAGE(PG8_SB(1, 1), b3 + hstepB, voffB);
            PG8_WAIT_V(6); PG8_BAR; PG8_MMA(1, 1, At, B1); PG8_BAR;
        }
        E(acc, cur, wr, wc, fr, fq);
        if (!has_next) break;
#pragma unroll
        for (int a = 0; a < 2; ++a)
#pragma unroll
            for (int b = 0; b < 2; ++b)
#pragma unroll
                for (int m = 0; m < 4; ++m)
#pragma unroll
                    for (int n = 0; n < 2; ++n) acc[a][b][m][n] = (f32x4){0.f, 0.f, 0.f, 0.f};
        cur = nxt; cA = nA; cB = nB; ++ui;
    }
    PG8_WAIT_V(0);
    if (wr == 0) PG8_BAR;
    PG8_BAR;
#undef PG8_SA
#undef PG8_SB
#undef PG8_STAGE
#undef PG8_LDA
#undef PG8_LDB
#undef PG8_MMA
#undef PG8_WAIT_V
#undef PG8_WAIT_L
#undef PG8_BAR
#undef PG8_SCHED
#undef PG8_APTR
#undef PG8_BPTR
}
}

struct SmallGemm { const bf16_t* A; const bf16_t* B; int lda, ldb, K, akseg, bkseg; long aseg, bseg; int a_tiled; int b_kt; };
constexpr int SG_LD = 72;
constexpr int SG_TILE = 64 * SG_LD * 2;
template <class Dec, class Epi>
__device__ __forceinline__ void gemm_small(LAS unsigned char* lds, const SmallGemm g, int nunits, const Dec& dec, const Epi& epi, int G_, int c_, int tid_in) {
    int tid_ = tid_in; asm volatile("" : "+v"(tid_));
    const int tid = tid_, wid = tid >> 6, lane = tid & 63, wm = wid >> 1, wn = wid & 1, fr = lane & 15, fq = lane >> 4;
    const int lrow = tid >> 3, lk = (tid & 7) * 8;
    const int nk = g.K / 64;
    const unsigned stoff = (unsigned)(lrow * SG_LD + lk) * 2u;
#define SG_LOAD(ra_, rb_, kt_) do { const int k_ = (kt_) * 64 + lk; \
        if (g.a_tiled) ra_ = *(const u32x4*)(g.A + (((((size_t)aoff * 8 + (k_ >> 6)) * 4 + (lrow >> 4)) * 2 + ((k_ >> 5) & 1)) * 512 + (size_t)(((k_ >> 3) & 3) * 16 + (lrow & 15)) * 8)); \
        else ra_ = *(const u32x4*)(ap + (long)(k_ / g.akseg) * g.aseg + (k_ % g.akseg)); \
        if (g.b_kt) rb_ = *(const u32x4*)(g.B + ktile_off((kt_) * 64 + lrow, (int)(boff & 3), (int)(boff >> 2) * 64 + lk));     \
        else rb_ = *(const u32x4*)(bp + (long)(k_ / g.bkseg) * g.bseg + (k_ % g.bkseg)); } while (0)
#define SG_STORE(ra_, rb_, bufi_) do { *(LAS u32x4*)(lds + ((bufi_) * 2 + 0) * SG_TILE + stoff) = ra_; *(LAS u32x4*)(lds + ((bufi_) * 2 + 1) * SG_TILE + stoff) = rb_; } while (0)
#define SG_COMPUTE(bufi_) do { const LAS unsigned char* As = lds + ((bufi_) * 2 + 0) * SG_TILE; const LAS unsigned char* Bs = lds + ((bufi_) * 2 + 1) * SG_TILE; \
        _Pragma("unroll") for (int ks = 0; ks < 2; ++ks) { const bf16x8 af = *(const LAS bf16x8*)(As + ((wm * 16 + fr) * SG_LD + ks * 32 + fq * 8) * 2); \
            _Pragma("unroll") for (int nt = 0; nt < 2; ++nt) { bf16x8 bf; \
                if (g.b_kt) {     \
                    const s16x4 t0_ = __builtin_amdgcn_ds_read_tr16_b64_v4i16((LAS s16x4*)(Bs + ((ks * 32 + 8 * fq + (fr >> 2)) * SG_LD + wn * 32 + nt * 16 + 4 * (fr & 3)) * 2)); \
                    const s16x4 t1_ = __builtin_amdgcn_ds_read_tr16_b64_v4i16((LAS s16x4*)(Bs + ((ks * 32 + 8 * fq + 4 + (fr >> 2)) * SG_LD + wn * 32 + nt * 16 + 4 * (fr & 3)) * 2)); \
                    bf = (bf16x8){t0_[0], t0_[1], t0_[2], t0_[3], t1_[0], t1_[1], t1_[2], t1_[3]}; } \
                else bf = *(const LAS bf16x8*)(Bs + ((wn * 32 + nt * 16 + fr) * SG_LD + ks * 32 + fq * 8) * 2); \
                acc[nt] = __builtin_amdgcn_mfma_f32_16x16x32_bf16(bf, af, acc[nt], 0, 0, 0); } } } while (0)
    for (int u = c_; u < nunits; u += G_) {
        long aoff, boff; dec(u, aoff, boff);
        const bf16_t* ap = g.A + aoff + (long)lrow * g.lda; const bf16_t* bp = g.B + boff + (long)lrow * g.ldb;
        f32x4 acc[2] = {(f32x4){0.f, 0.f, 0.f, 0.f}, (f32x4){0.f, 0.f, 0.f, 0.f}};
        u32x4 ra0, rb0, ra1, rb1, ra2, rb2, ra3, rb3;
        ra0 = (u32x4){0u, 0u, 0u, 0u}; rb0 = ra0; ra1 = ra0; rb1 = ra0; ra2 = ra0; rb2 = ra0; ra3 = ra0; rb3 = ra0;
        SG_LOAD(ra0, rb0, 0); if (nk > 1) SG_LOAD(ra1, rb1, 1); if (nk > 2) SG_LOAD(ra2, rb2, 2); if (nk > 3) SG_LOAD(ra3, rb3, 3);
        SG_STORE(ra0, rb0, 0);
        LDS_BARRIER();
#define SG_TURN(kt_, bufc, rnextA, rnextB, rfreeA, rfreeB) do { if ((kt_) < nk) { \
            SG_COMPUTE(bufc); \
            if ((kt_) + 1 < nk) SG_STORE(rnextA, rnextB, (bufc) ^ 1); \
            if ((kt_) + 4 < nk) SG_LOAD(rfreeA, rfreeB, (kt_) + 4); \
            LDS_BARRIER(); } } while (0)
        for (int kt = 0; kt < nk; kt += 4) {
            SG_TURN(kt,     0, ra1, rb1, ra0, rb0);
            SG_TURN(kt + 1, 1, ra2, rb2, ra1, rb1);
            SG_TURN(kt + 2, 0, ra3, rb3, ra2, rb2);
            SG_TURN(kt + 3, 1, ra0, rb0, ra3, rb3);
        }
#undef SG_TURN
#pragma unroll
        for (int nt = 0; nt < 2; ++nt) epi(u, wm * 16 + fr, wn * 32 + nt * 16 + fq * 4, acc[nt]);
    }
#undef SG_LOAD
#undef SG_STORE
#undef SG_COMPUTE
}

struct SmallDense { bf16_t* O; long o_gs; int ldc, mt, nt, act; long a_gs, b_gs; int mode; };
__device__ __forceinline__ void gemm_small_dense(LAS unsigned char* lds, const SmallGemm g, const SmallDense d, int ngroups, int G_, int c_, int tid_in) {
    const int per = d.mt * d.nt;
    auto dec = [=](int u, long& ao, long& bo) { const int gi = u / per, r = u % per, mi = r / d.nt, ni = r % d.nt; ao = gi * d.a_gs + (long)mi * 64 * g.lda; bo = gi * d.b_gs + (long)ni * 64 * g.ldb; };
    auto epi = [=](int u, int m, int n, const f32x4& v) { const int gi = u / per, r = u % per, mi = r / d.nt, ni = r % d.nt;
        f32x4 x = v; if (d.act == 1) {
#pragma unroll
            for (int i = 0; i < 4; ++i) { const float a = fmaxf(x[i], 0.f); x[i] = a * a; } }
        u32x2 w; w.x = pk2(x[0], x[1]); w.y = pk2(x[2], x[3]);
        if (d.mode == 0) *(u32x2*)(d.O + gi * d.o_gs + (size_t)(mi * 64 + m) * d.ldc + ni * 64 + n) = w;
        else if (d.mode == 1) *(u32x2*)(d.O + qtile_off(mi * 64 + m, gi, ni * 64 + n)) = w;
        else if (d.mode == 2) *(u32x2*)(d.O + ktile_off(mi * 64 + m, gi, ni * 64 + n)) = w;
        else *(u32x2*)(d.O + vtile_off(mi * 64 + m, gi, ni * 64 + n)) = w; };
    gemm_small(lds, g, ngroups * per, dec, epi, G_, c_, tid_in);
}

struct Args { const float* in[22]; float* out; unsigned char* ws; int ph_lo, ph_hi, ph_last, li; };
enum { I_X = 0, I_C, I_CTX, I_CCTX, I_ADAW, I_ADAB, I_PG, I_PB, I_WIN, I_WCONV, I_BCONV, I_WQ, I_WK, I_WV, I_WGATE, I_BGATE, I_GNW, I_SKIP, I_WOUT, I_FWOUT, I_W1, I_W2 };

constexpr int LDS_BYTES = 147456;
constexpr int LDS_MISC = LDS_BYTES - 256;

__device__ __forceinline__ void transpose_item(const float* W, int K, int N, bf16_t* WT, float scale, LAS float* scr, int item, int lane) {
    constexpr int TS = 36;
    LAS bf16_t* t = (LAS bf16_t*)scr;
    const int nblk = N / 32, kb = item / nblk, nb = item % nblk, k0 = 64 * kb, n0 = 32 * nb;
    const int n4 = (lane & 7) * 4;
#pragma unroll
    for (int i = 0; i < 8; ++i) { const int kk = 8 * i + (lane >> 3); const f32x4 w = *(const f32x4*)(W + (size_t)(k0 + kk) * N + n0 + n4) * scale;
        u32x2 p; p.x = pk2(w[0], w[1]); p.y = pk2(w[2], w[3]); *(LAS u32x2*)(t + kk * TS + n4) = p; }
    asm volatile("s_waitcnt lgkmcnt(0)" ::: "memory");
    const int g = lane >> 4, l = lane & 15;
#pragma unroll
    for (int j = 0; j < 4; ++j) { const int nh = j & 1, kg = 4 * (j >> 1) + g;
        const LAS bf16_t* bp = t + (8 * kg + (l >> 2)) * TS + 16 * nh + 4 * (l & 3);
        const s16x4 a0 = __builtin_amdgcn_ds_read_tr16_b64_v4i16((LAS s16x4*)bp), a1 = __builtin_amdgcn_ds_read_tr16_b64_v4i16((LAS s16x4*)(bp + 4 * TS));
        u32x4 o; o.x = (unsigned)(unsigned short)a0[0] | ((unsigned)(unsigned short)a0[1] << 16); o.y = (unsigned)(unsigned short)a0[2] | ((unsigned)(unsigned short)a0[3] << 16);
        o.z = (unsigned)(unsigned short)a1[0] | ((unsigned)(unsigned short)a1[1] << 16); o.w = (unsigned)(unsigned short)a1[2] | ((unsigned)(unsigned short)a1[3] << 16);
        *(u32x4*)(WT + (size_t)(n0 + 16 * nh + l) * K + k0 + 8 * kg) = o; }
    asm volatile("s_waitcnt lgkmcnt(0)" ::: "memory");
}

__device__ __forceinline__ void ln_norm(f32x4 (&v)[4], int lane) {
    float s = 0.f;
#pragma unroll
    for (int j = 0; j < 4; ++j) s += (v[j][0] + v[j][1]) + (v[j][2] + v[j][3]);
    const float mean = wave_sum(s, lane) * (1.f / D); float s2 = 0.f;
#pragma unroll
    for (int j = 0; j < 4; ++j) { v[j] = v[j] - mean; s2 += (v[j][0] * v[j][0] + v[j][1] * v[j][1]) + (v[j][2] * v[j][2] + v[j][3] * v[j][3]); }
    const float rstd = __builtin_amdgcn_rsqf(wave_sum(s2, lane) * (1.f / D) + LN_EPS);
#pragma unroll
    for (int j = 0; j < 4; ++j) v[j] = v[j] * rstd;
}

constexpr int PL = 24;
constexpr int NPHASE = 2 + 4 * PL;
__host__ __device__ inline bool phase_valid(int id) {
    if (id < 2) return true;
    const int layer = (id - 2) / PL, k = (id - 2) % PL;
    if (layer > 3) return false;
    if (k == 0 || (k >= 19 && k <= 22)) return true;
    if (layer & 1) return k >= 2 && k <= 5;
    return k >= 1 && k <= 18;
}


#define MOD ((float*)(ws + WS_MOD))
#define CTXX ((float*)(ws + WS_CTXX))
#define PRE ((float*)(ws + WS_PRE))
#define HIN ((bf16_t*)(ws + WS_HIN))
#define YB ((bf16_t*)(ws + WS_YB))
#define WIN ((bf16_t*)(ws + W_IN))
#define WQ ((bf16_t*)(ws + W_Q))
#define WK ((bf16_t*)(ws + W_K))
#define WV ((bf16_t*)(ws + W_V))
#define WOUT ((bf16_t*)(ws + W_OUT))
#define W1 ((bf16_t*)(ws + W_1))
#define W2 ((bf16_t*)(ws + W_2))
#define GATET ((bf16_t*)(ws + TAB_GATE))
#define S0 ((bf16_t*)(ws + WS_BIG + 0 * SLOT))
#define S1 ((bf16_t*)(ws + WS_BIG + 1 * SLOT))
#define S2 ((bf16_t*)(ws + WS_BIG + 2 * SLOT))
#define S3 ((bf16_t*)(ws + WS_BIG + 3 * SLOT))
#define S4 ((bf16_t*)(ws + WS_BIG + 4 * SLOT))
#define YH (YB + ((size_t)CR + (size_t)half * LH) * D)
#define YHC (YB + (size_t)half * LAT0 * D)
#define HCB (YH + (size_t)NCH * 4 * 2 * 4096 + (size_t)NCH * 4 * 2 * 384 * 2)
#define PREQ ((float*)(HCB + (size_t)LAT0 * DI))
#define HH (HIN + ((size_t)CR + (size_t)half * LH) * D)
#define HHC (HIN + (size_t)half * LAT0 * D)
#define HT ((bf16_t*)(ws + WS_BIG))
#define HTC (HT + (size_t)NB * D * T)
#define PB ((bf16_t*)(ws + WS_BIG + 1 * SLOT))
#define WC ((bf16_t*)(ws + WS_BIG + 3 * SLOT))
#define ZF ((bf16_t*)(ws + WS_BIG))
#define HID ((bf16_t*)(ws + WS_BIG))

constexpr int SC_PLD = 36, SC_VLD = 72;
#define SC_ROW0(j) (((j) < 4) ? (bl * CT + (dir ? 3 - (j) : (j)) * 64) : (LAT0 + bl * T + (dir ? 127 - ((j) - 4) : ((j) - 4)) * 64))
#define SC_LOADQ(dst, r0) do { _Pragma("unroll") for (int pt = 0; pt < 4; ++pt) _Pragma("unroll") for (int ks = 0; ks < 2; ++ks) \
        dst[pt][ks] = __builtin_bit_cast(bf16x8, __builtin_amdgcn_raw_buffer_load_b128(rW, loff, oQ + ((((((r0) >> 6) * 4 + hh) * 8 + w) * 4 + pt) * 2 + ks) * 1024, 0)); } while (0)
#define SC_LOADQ1(dst, r0, pt, ks) dst[pt][ks] = __builtin_bit_cast(bf16x8, __builtin_amdgcn_raw_buffer_load_b128(rW, loff, oQ + ((((((r0) >> 6) * 4 + hh) * 8 + w) * 4 + (pt)) * 2 + (ks)) * 1024, 0))
#define SC_LOADK1(dst, r0, mt, ks) dst[mt][ks] = __builtin_bit_cast(bf16x8, __builtin_amdgcn_raw_buffer_load_b128(rW, loff, oK + ((((((r0) >> 6) * 4 + hh) * 8 + w) * 4 + (mt)) * 2 + (ks)) * 1024, 0))
#define SC_LOADK(dst, r0) do { _Pragma("unroll") for (int mt = 0; mt < 4; ++mt) _Pragma("unroll") for (int ks = 0; ks < 2; ++ks) \
        dst[mt][ks] = __builtin_bit_cast(bf16x8, __builtin_amdgcn_raw_buffer_load_b128(rW, loff, oK + ((((((r0) >> 6) * 4 + hh) * 8 + w) * 4 + mt) * 2 + ks) * 1024, 0)); } while (0)
#define SC_LOADS(P, r0) do { const int ci_ = ((((r0) >> 6) * 4 + hh) * 2 + dir); \
        P##sg0 = __builtin_bit_cast(bf16x8, __builtin_amdgcn_raw_buffer_load_b128(rW, loff, oS + ci_ * 8192 + (w >> 1) * 2048, 0)); P##sg1 = __builtin_bit_cast(bf16x8, __builtin_amdgcn_raw_buffer_load_b128(rW, loff, oS + ci_ * 8192 + (w >> 1) * 2048 + 1024, 0)); \
        P##v = __builtin_bit_cast(u32x4, __builtin_amdgcn_raw_buffer_load_b128(rW, loff, oV + ((((r0) >> 6) * 4 + hh) * 16 + slice) * 4096 + (w & 3) * 1024, 0));     \
        P##wka = __builtin_bit_cast(u32x4, __builtin_amdgcn_raw_buffer_load_b128(rW, wkoff, oG + ci_ * 1536 + 1296, 0));         \
        P##wint = __builtin_bit_cast(float, __builtin_amdgcn_raw_buffer_load_b32(rW, gcp, oG + ci_ * 1536 + 512, 0)); P##em = __builtin_bit_cast(float, __builtin_amdgcn_raw_buffer_load_b32(rW, gcp, oG + ci_ * 1536 + 768, 0)); \
        P##dec = __builtin_bit_cast(float, __builtin_amdgcn_raw_buffer_load_b32(rW, 0, oG + ci_ * 1536 + 1280, 0)); } while (0)
#define SC_VWRITE(bufi, P) do { LAS bf16_t* vt_ = VB + (bufi) * 2 * 3072; LAS bf16_t* vw_ = vt_ + 3072; \
        if (w < 5) { const float wk_[8] = {bflo(P##wka.x), bfhi(P##wka.x), bflo(P##wka.y), bfhi(P##wka.y), bflo(P##wka.z), bfhi(P##wka.z), bflo(P##wka.w), bfhi(P##wka.w)};     \
            if (w < 4) { *(LAS u32x4*)(vt_ + tid * 8) = P##v; \
                u32x4 sv_; sv_.x = pk2(bflo(P##v.x) * wk_[0], bfhi(P##v.x) * wk_[1]); sv_.y = pk2(bflo(P##v.y) * wk_[2], bfhi(P##v.y) * wk_[3]); \
                sv_.z = pk2(bflo(P##v.z) * wk_[4], bfhi(P##v.z) * wk_[5]); sv_.w = pk2(bflo(P##v.w) * wk_[6], bfhi(P##v.w) * wk_[7]); *(LAS u32x4*)(vw_ + tid * 8) = sv_; } \
            else if (lane < 8) { const u32x4 sv_ = P##wka; \
                int ln_ = lane; asm volatile("" : "+v"(ln_));     \
                *(LAS u32x4*)(vw_ + (4 + (ln_ >> 2)) * 512 + (ln_ & 3) * 16 * 8) = sv_; } } } while (0)
#define SC_STEP(J, Qc, Qn, Kc, Kn, C, N) do { \
    const int j_ = (J); const int row0 = SC_ROW0(j_); const int jn_ = j_ < 131 ? j_ + 1 : 131; const int row1 = SC_ROW0(jn_); \
    const int hsel = (j_ < 4) ? (dir ? 2 : 0) : ((j_ < 68) ? 0 : 1); \
    const int buf = j_ & 1; \
    const LAS bf16_t* VT = VB + buf * 2 * 3072; const LAS bf16_t* VW = VT + 3072; \
    LAS bf16_t* Pb_ = Pbh + buf * (8 * 64 * 40); LAS float* Nq_ = NQs + buf * (8 * 64);        \
    SC_LOADS(N, row1); \
      \
    if (!(abl_ & 1)) _Pragma("unroll") for (int nt = 0; nt < 3; ++nt) { \
        f32x4 d1[4]; \
        _Pragma("unroll") for (int pt = 0; pt < 4; ++pt) d1[pt] = (f32x4){0.f, 0.f, 0.f, 0.f}; \
        _Pragma("unroll") for (int ks = 0; ks < 2; ++ks) { \
            u32x4 bw; bw.x = pg8::cvt_pk_bf16(st[2 * ks][nt][0], st[2 * ks][nt][1]); bw.y = pg8::cvt_pk_bf16(st[2 * ks][nt][2], st[2 * ks][nt][3]); \
            bw.z = pg8::cvt_pk_bf16(st[2 * ks + 1][nt][0], st[2 * ks + 1][nt][1]); bw.w = pg8::cvt_pk_bf16(st[2 * ks + 1][nt][2], st[2 * ks + 1][nt][3]); \
            const bf16x8 bs = __builtin_bit_cast(bf16x8, bw); \
            _Pragma("unroll") for (int pt = 0; pt < 4; ++pt) d1[pt] = __builtin_amdgcn_mfma_f32_16x16x32_bf16(bs, Qc[pt][ks], d1[pt], 0, 0, 0); \
            SC_LOADQ1(Qn, row1, (nt * 2 + ks) >> 1, (nt * 2 + ks) & 1);     } \
        _Pragma("unroll") for (int pt = 0; pt < 4; ++pt) { \
            if (nt < 2) { u32x2 pw_; pw_.x = pg8::cvt_pk_bf16(d1[pt][0], d1[pt][1]); pw_.y = pg8::cvt_pk_bf16(d1[pt][2], d1[pt][3]); *(LAS u32x2*)(Pb_ + (w * 64 + 16 * pt + fr) * 40 + 16 * nt + 4 * fq) = pw_; }     \
            else if (fq == 0) Nq_[w * 64 + 16 * pt + fr] = d1[pt][0]; } } \
    SC_LOADQ1(Qn, row1, 3, 0); SC_LOADQ1(Qn, row1, 3, 1); \
    LDS_BARRIER();                                                       \
      \
    f32x4 d2 = (f32x4){0.f, 0.f, 0.f, 0.f}, d3 = (f32x4){0.f, 0.f, 0.f, 0.f}; \
    if (!(abl_ & 2)) {     \
        const int nt2 = w & 1; \
        const bf16x8 vt0 = *(const LAS bf16x8*)(VT + (nt2 * 2 + 0) * 512 + lane * 8), vt1 = *(const LAS bf16x8*)(VT + (nt2 * 2 + 1) * 512 + lane * 8); \
        const bf16x8 vo0 = *(const LAS bf16x8*)(VT + 4 * 512 + lane * 8), vo1 = *(const LAS bf16x8*)(VT + 5 * 512 + lane * 8); \
        d2 = __builtin_amdgcn_mfma_f32_16x16x32_bf16(vt0, C##sg0, d2, 0, 0, 0); d3 = __builtin_amdgcn_mfma_f32_16x16x32_bf16(vo0, C##sg0, d3, 0, 0, 0); \
        d2 = __builtin_amdgcn_mfma_f32_16x16x32_bf16(vt1, C##sg1, d2, 0, 0, 0); d3 = __builtin_amdgcn_mfma_f32_16x16x32_bf16(vo1, C##sg1, d3, 0, 0, 0); } \
      \
    if (!(abl_ & 4)) _Pragma("unroll") for (int nt = 0; nt < 3; ++nt) { \
        const bf16x8 vw0 = *(const LAS bf16x8*)(VW + (nt * 2 + 0) * 512 + lane * 8), vw1 = *(const LAS bf16x8*)(VW + (nt * 2 + 1) * 512 + lane * 8); \
        _Pragma("unroll") for (int mt = 0; mt < 4; ++mt) { f32x4 a = st[mt][nt] * C##dec; \
            a = __builtin_amdgcn_mfma_f32_16x16x32_bf16(Kc[mt][0], vw0, a, 0, 0, 0); \
            a = __builtin_amdgcn_mfma_f32_16x16x32_bf16(Kc[mt][1], vw1, a, 0, 0, 0); st[mt][nt] = a; \
            if (nt < 2) SC_LOADK1(Kn, row1, (nt * 4 + mt) >> 1, (nt * 4 + mt) & 1); } } \
    if (!(abl_ & 8)) {     \
        f32x4 o1 = (f32x4){0.f, 0.f, 0.f, 0.f}; float nq = 0.f; \
        _Pragma("unroll") for (int ww = 0; ww < 8; ++ww) { const u32x2 cpr_ = *(const LAS u32x2*)(Pb_ + (ww * 64 + cp) * 40 + cv); nq += Nq_[ww * 64 + cp]; \
            o1 += (f32x4){bflo(cpr_.x), bfhi(cpr_.x), bflo(cpr_.y), bfhi(cpr_.y)}; } \
        const float den = C##wint * nq + d3[0]; const float scl = __builtin_amdgcn_rcpf(fmaxf(fabsf(den), C##em)); \
        const f32x4 o = (o1 * C##wint + d2) * scl; \
        u32x2 ow; ow.x = pk2(o[0], o[1]); ow.y = pk2(o[2], o[3]); \
        unsigned lo_ = loff; asm volatile("" : "+v"(lo_)); const unsigned hoff_ = ((lo_ >> 4) & 15u) * 64u + (lo_ >> 8) * 8u;     \
        __builtin_amdgcn_raw_buffer_store_b64(ow, rW, hoff_, (rep_ + 1 < SCAN_REP) ? (oC + 512 * DI * 2) : ((hsel == 0 ? oH : (hsel == 1 ? oV : oC)) + (((row0 >> 6) * 4 + hh) * 16 + slice) * 4096 + (w >> 1) * 1024 + (w & 1) * 32), 0); } \
    if (!(abl_ & 16)) SC_VWRITE(buf ^ 1, N);                                     \
} while (0)

__device__ __forceinline__ void scan_phase(LAS unsigned char* lds, unsigned char* ws, int half, const XcdBarrier& bar, int tid, int lane, int wave, int bx) {
    LAS bf16_t* Pbh = (LAS bf16_t*)lds;
    LAS float* NQs = (LAS float*)(lds + 2 * 8 * 64 * 40 * 2);
    LAS bf16_t* VB = (LAS bf16_t*)(NQs + 2 * 8 * 64);
    const int xcd = bx & 7, idx = bx >> 3;
    const int scn = (xcd * 2 + (idx >> 4)) & 15, slice = idx & 15;
    const int bl = scn >> 3, hh = (scn >> 1) & 3, dir = scn & 1, e0 = slice * 32;
    const int fr = lane & 15, fq = lane >> 4, w = wave;
    const int cp = 16 * (w >> 1) + fr, cv = 16 * (w & 1) + 4 * fq;
    const unsigned loff = (unsigned)lane * 16u;
    const unsigned gcp = (unsigned)cp * 4u;
    const unsigned wkoff = (w < 4) ? (unsigned)(32 * ((tid >> 6) & 1) + 8 * ((tid & 63) >> 4)) * 2u : (unsigned)(32 * ((lane >> 2) & 1) + 8 * (lane & 3)) * 2u;
    const __amdgpu_buffer_rsrc_t rW = __builtin_amdgcn_make_buffer_rsrc((void*)ws, 0, (int)(512 * MiB), 0x00020000);
    const int oYH = (int)(WS_YB + ((size_t)CR + (size_t)half * LH) * D * 2);
    const int oQ = (int)(WS_BIG + 3 * SLOT), oK = (int)(WS_BIG + 4 * SLOT), oV = (int)(WS_BIG + 2 * SLOT), oH = (int)(WS_BIG + 0 * SLOT);
    const int oS = oYH, oG = oYH + NCH * 4 * 2 * 8192, oC = oG + NCH * 4 * 2 * 1536;
    for (int i = tid; i < 4 * 1024; i += NTHR) { const int im = i >> 10, r = i & 1023, ln = (r & 511) >> 3; VB[im * 3072 + 2048 + r] = (bf16_t)(((im & 1) == 0 && (ln & 3) == 0) ? 0x3F80u : 0u); }
    __syncthreads();
    for (int rep_ = 0; rep_ < SCAN_REP; ++rep_) {
    const int abl_ = (rep_ + 1 < SCAN_REP) ? SC_ABL : 0;
    f32x4 st[4][3];
#pragma unroll
    for (int a = 0; a < 4; ++a)
#pragma unroll
        for (int b = 0; b < 3; ++b) st[a][b] = (f32x4){0.f, 0.f, 0.f, 0.f};
    bf16x8 Q0[4][2], Q1[4][2], K0[4][2], K1[4][2];
    bf16x8 Asg0, Asg1, Bsg0, Bsg1; u32x4 Av = (u32x4){0u, 0u, 0u, 0u}, Bv = Av, Awka = Av, Bwka = Av; float Awint, Aem, Adec, Bwint, Bem, Bdec;
    { const int r0 = SC_ROW0(0); SC_LOADQ(Q0, r0); SC_LOADK(K0, r0); SC_LOADS(A, r0); SC_VWRITE(0, A); }
#pragma unroll 1
    for (int j = 0; j < 132; j += 2) {
        if (j == 68) xcd_barrier(bar, tid == 0);
        SC_STEP(j, Q0, Q1, K0, K1, A, B);
        SC_STEP(j + 1, Q1, Q0, K1, K0, B, A);
    }
    __syncthreads();
    }
}
#undef SC_ROW0
#undef SC_LOADQ
#undef SC_LOADK
#undef SC_LOADS
#undef SC_VWRITE
#undef SC_STEP

typedef const __attribute__((address_space(4))) Args KA;
__device__ __forceinline__ KA* kargs() { KA* k = (KA*)__builtin_amdgcn_kernarg_segment_ptr(); asm volatile("" : "+s"(k)); return k; }
#define PH_BEGIN() \
    KA* ka = kargs(); unsigned char* ws = ka->ws; (void)ws; \
    int wave = wave0; asm volatile("" : "+s"(wave)); \
    unsigned lz_ = 0u; asm volatile("" : "+v"(lz_)); const int lane = (int)__builtin_amdgcn_mbcnt_hi(~0u, __builtin_amdgcn_mbcnt_lo(~0u, lz_)); \
    const int tid = wave * 64 + lane; (void)tid; \
    const int gw = bx * NWAVES + wave, NGW = G * NWAVES; (void)gw; (void)NGW;

__global__ void __launch_bounds__(NTHR, 2) fwd(Args args) {
    extern __shared__ __attribute__((aligned(16))) unsigned char lds_raw[];
    LAS unsigned char* lds = (LAS unsigned char*)lds_raw;
    const int G = gridDim.x, bx = blockIdx.x;
    const int wave0 = __builtin_amdgcn_readfirstlane(threadIdx.x >> 6);
    volatile LAS unsigned* MISC = (volatile LAS unsigned*)(lds + LDS_MISC);
    if (threadIdx.x < 64) MISC[threadIdx.x] = 0u;
    __syncthreads();
    XcdBarrier bar = xcd_barrier_post((unsigned*)(args.ws + WS_CTL + 65536) + (size_t)args.li * 4096, MISC + 8);
    const int lo = args.ph_lo, hi = args.ph_hi, plast = args.ph_last;
#define IN(k) (lo <= (k) && (k) < hi)
#define SEAM(k) do { if ((k) != plast) { xcd_barrier(bar, tid == 0); if (DUP_BAR) xcd_barrier(bar, tid == 0); } } while (0)

    if (EN_PRO && IN(0)) { PH_BEGIN();
        {
            LAS float* sc = (LAS float*)lds;
            for (int i = tid; i < 5 * D; i += NTHR) { const int r = i / D, k = i % D; const float x = r < 4 ? ka->in[I_C][r * D + k] : ka->in[I_CCTX][k]; sc[i] = siluf(x); }
            __syncthreads();
            LAS float* red = (LAS float*)(lds + 32768);
            const int kp = tid >> 6, cc = tid & 63;
            for (int item = bx; item < 4 * 96; item += G) {
                const int layer = item / 96, n0 = (item % 96) * 64;
                const float* w = ka->in[I_ADAW] + (size_t)layer * D * 6 * D + n0 + cc;
                float a0 = 0.f, a1 = 0.f, a2 = 0.f, a3 = 0.f, a4 = 0.f;
                for (int k = kp * 128; k < kp * 128 + 128; ++k) { const float wv = w[(size_t)k * 6 * D]; a0 += sc[k] * wv; a1 += sc[D + k] * wv; a2 += sc[2 * D + k] * wv; a3 += sc[3 * D + k] * wv; a4 += sc[4 * D + k] * wv; }
                red[(kp * 64 + cc) * 5 + 0] = a0; red[(kp * 64 + cc) * 5 + 1] = a1; red[(kp * 64 + cc) * 5 + 2] = a2; red[(kp * 64 + cc) * 5 + 3] = a3; red[(kp * 64 + cc) * 5 + 4] = a4;
                __syncthreads();
                if (tid < 320) { const int c2 = tid % 64, r = tid / 64; float s = ka->in[I_ADAB][layer * 6 * D + n0 + c2];
                    for (int q = 0; q < 8; ++q) s += red[(q * 64 + c2) * 5 + r];
                    MOD[((size_t)layer * 5 + r) * 6 * D + n0 + c2] = s; }
                __syncthreads();
            }
        }
        {
            bf16_t* A1 = (bf16_t*)(ws + TAB_A1); bf16_t* A2 = (bf16_t*)(ws + TAB_A2); bf16_t* BZ = (bf16_t*)(ws + TAB_BZ); bf16_t* ACTX = (bf16_t*)(ws + TAB_ACTX);
            const int gt = bx * NTHR + tid, NGT = G * NTHR;
            const float s8192 = 0.011048543456039806f;
            for (int i = gt; i < 512 * 256; i += NGT) { const int m = i / 256, t1 = i % 256, ri = m / 256, t1p = m % 256; const int ph = (t1 * t1p) & 255; float sn, cs; sincospif((float)ph * (2.0f / 256.0f), &sn, &cs);
                A1[i] = (bf16_t)f2bf((ri == 0 ? cs : -sn) * s8192);
                ACTX[i] = (bf16_t)f2bf((ri == 0 ? cs : -sn) * 0.0625f); }
            for (int i = gt; i < 256 * 64 * 64; i += NGT) { const int t1p = i / 4096, m = (i / 64) % 64, k = i % 64; const int rip = m / 32, t2p = m % 32, ri = k / 32, t2 = k % 32;
                const int ph = (t2 * t1p + 256 * t2 * t2p) & 8191; float sn, cs; sincospif((float)ph * (2.0f / 8192.0f), &sn, &cs);
                const float v = (rip == ri) ? cs : (rip == 0 ? sn : -sn); A2[i] = (bf16_t)f2bf(v); }
            for (int i = gt; i < 256 * 512; i += NGT) { const int cp = i / 512, k = i % 512, ri = k / 256, c = k % 256; const int ph = (c * cp) & 255; float sn, cs; sincospif((float)ph * (2.0f / 256.0f), &sn, &cs);
                BZ[i] = (bf16_t)f2bf((ri == 0 ? cs : sn) * 0.0625f); }
        }
        SEAM(0);
    }
    if (EN_PRO && IN(1)) { PH_BEGIN();
        const int nseg = gw < CR ? 2 : 1;
#pragma unroll 1
        for (int seg = 0; seg < nseg; ++seg) {
            const int mi = seg == 0 ? (gw >> 9) : 4, rbeg = seg == 0 ? lat_row(gw >> 9, gw & 511) : gw, nr = seg == 0 ? T / 512 : 1;
            const float* md = MOD + ((size_t)0 * 5 + mi) * 6 * D;
            f32x4 shv[4], scv[4];
#pragma unroll
            for (int j = 0; j < 4; ++j) { shv[j] = *(const f32x4*)(md + 256 * j + 4 * lane); scv[j] = *(const f32x4*)(md + D + 256 * j + 4 * lane) + 1.0f; }
#pragma unroll 2
            for (int k = 0; k < nr; ++k) {
                const int r = rbeg + 512 * k;
                const RowInfo ri = row_info(r);
                const float* xr = ri.is_ctx ? ka->in[I_CTX] + ((size_t)ri.b * CT + ri.t) * D : ka->in[I_X] + ((size_t)ri.b * T + ri.t) * D;
                f32x4 v[4];
#pragma unroll
                for (int j = 0; j < 4; ++j) v[j] = *(const f32x4*)(xr + 256 * j + 4 * lane);
                ln_norm(v, lane);
                bf16_t* o = HIN + (size_t)r * D;
#pragma unroll
                for (int j = 0; j < 4; ++j) { const f32x4 h = v[j] * scv[j] + shv[j]; u32x2 w; w.x = pk2(h[0], h[1]); w.y = pk2(h[2], h[3]); *(u32x2*)(o + 256 * j + 4 * lane) = w; }
            }
        }
        SEAM(1);
    }

    for (int layer = 0; layer < 4; ++layer) {
        const int pb = 2 + layer * PL;
        if (hi <= pb || lo >= pb + PL) continue;
        const int jl = layer >> 1;
        const bool is_m = (layer & 1) == 0;
        if (EN_WC && IN(pb + 0)) { PH_BEGIN();
 for (int rp_ = 0; rp_ < REPN(5); ++rp_) {
            LAS float* scr = (LAS float*)(lds + wave * 16384);
            const int i_in = (D / 64) * (2 * DI / 32), i_h = (DH / 64) * (DH / 32), i_out = (DI / 64) * (D / 32), i_f = (D / 64) * (D / 32), i_1 = (D / 64) * (DFF / 32), i_2 = (DFF / 64) * (D / 32);
            const int n_mix = is_m ? (i_in + 12 * i_h + i_out) : i_f;
            const int nitems = n_mix + i_1 + i_2;
            for (int it = gw; it < nitems; it += NGW) {
                int r = it;
                if (r >= n_mix) { r -= n_mix;
                    if (r < i_1) transpose_item(ka->in[I_W1] + (size_t)layer * D * DFF, D, DFF, W1, 1.f, scr, r, lane);
                    else transpose_item(ka->in[I_W2] + (size_t)layer * DFF * D, DFF, D, W2, 1.f, scr, r - i_1, lane);
                    continue; }
                if (!is_m) { transpose_item(ka->in[I_FWOUT] + (size_t)jl * D * D, D, D, WOUT, 1.f, scr, r, lane); continue; }
                if (r < i_in) { transpose_item(ka->in[I_WIN] + (size_t)jl * D * 2 * DI, D, 2 * DI, WIN, 1.f, scr, r, lane); continue; } r -= i_in;
                if (r < 12 * i_h) { const int which = r / (4 * i_h), hh = (r / i_h) % 4, rr = r % i_h;
                    const float* src = ka->in[which == 0 ? I_WQ : (which == 1 ? I_WK : I_WV)] + ((size_t)jl * NH + hh) * DH * DH;
                    bf16_t* dst = (which == 0 ? WQ : (which == 1 ? WK : WV)) + (size_t)hh * DH * DH;
                    transpose_item(src, DH, DH, dst, which == 1 ? 0.044194173824159216f : 1.f, scr, rr, lane); continue; } r -= 12 * i_h;
                transpose_item(ka->in[I_WOUT] + (size_t)jl * DI * D, DI, D, WOUT, 1.f, scr, r, lane);
            }
            if (is_m) {
                const float* wg = ka->in[I_WGATE] + (size_t)jl * 3 * DI * 16;
                const int n = lane & 15, eq = lane >> 4;
                for (int k2 = gw; k2 < DI; k2 += NGW) {
                    const int hh = k2 / DH, d = k2 % DH;
                    const float* q = ka->in[I_WQ] + (((size_t)jl * NH + hh) * DH + d) * DH + eq * 128; const float* kx = ka->in[I_WK] + (((size_t)jl * NH + hh) * DH + d) * DH + eq * 128;
                    const float* vx = ka->in[I_WV] + (((size_t)jl * NH + hh) * DH + d) * DH + eq * 128;
                    const float* g0 = wg + ((size_t)0 * DI + hh * DH + eq * 128) * 16 + n; const float* g1 = wg + ((size_t)1 * DI + hh * DH + eq * 128) * 16 + n; const float* g2 = wg + ((size_t)2 * DI + hh * DH + eq * 128) * 16 + n;
                    float s0 = 0.f, s1 = 0.f, s2 = 0.f;
#pragma unroll 8
                    for (int e = 0; e < 128; ++e) { s0 += q[e] * g0[e * 16]; s1 += kx[e] * g1[e * 16]; s2 += vx[e] * g2[e * 16]; }
                    float sa = s0 + 0.044194173824159216f * s1;
                    sa += shx(sa, 16, lane); sa += shx(sa, 32, lane); s2 += shx(s2, 16, lane); s2 += shx(s2, 32, lane);
                    if (lane < 16) { GATET[(size_t)n * 4096 + k2] = (bf16_t)f2bf(sa); GATET[(size_t)n * 4096 + DI + k2] = (bf16_t)f2bf(s2); }
                    else if (lane < 64) { GATET[(size_t)(16 + (lane - 16)) * 4096 + k2] = (bf16_t)0; GATET[(size_t)(16 + (lane - 16)) * 4096 + DI + k2] = (bf16_t)0; }
                }
            }
 }
            SEAM(pb + 0);
        }

        if (EN_MIX && is_m) {
            for (int half = 0; half < 2; ++half) {
                const int hb = pb + 1 + 9 * half;
                if (hi <= hb || lo >= hb + 9) continue;
                if (IN(hb + 0)) { PH_BEGIN();
 for (int rp_ = 0; rp_ < REPN(0); ++rp_) {
                    pg8::Gemm g{HH, WIN, D, D, D, 0, 0, LH / 256, DI / 256, 1};
                    pg8::EpiStore E{S0 + (size_t)LAT0 * DI, 0, DI, 0};
                    pg8::gemm_phase(lds, g, E, G, bx, tid); if (DUP_MIX) pg8::gemm_phase(lds, g, E, G, bx, tid);
                    { SmallGemm sg{HHC, WIN, D, D, D, D, D, 0, 0}; SmallDense sd{S0, 0, DI, LAT0 / 64, DI / 64, 0, 0, 0}; gemm_small_dense(lds, sg, sd, 1, G, bx, tid); if (DUP_CTX) gemm_small_dense(lds, sg, sd, 1, G, bx, tid); }
 }
                    SEAM(hb + 0);
                }
                if (IN(hb + 1)) { PH_BEGIN();
 for (int rp_ = 0; rp_ < REPN(3); ++rp_) {
                    const float* wc = ka->in[I_WCONV] + (size_t)jl * 9 * DI; const float* bc = ka->in[I_BCONV] + (size_t)jl * DI;
                    const int gt = bx * NTHR + tid, NGT = G * NTHR;
                    for (int i = gt; i < 2 * 128 * 2 * (DI / 8); i += NGT) {
                        const int cg = i & 255, rest = i >> 8, hr = rest & 1, r = (rest >> 1) & 127, bl = rest >> 8, c0 = cg * 8, gc0 = 32 * hr;
                        float wv[9][8], bv[8];
#pragma unroll
                        for (int tp = 0; tp < 9; ++tp) { const f32x4 a0 = *(const f32x4*)(wc + (size_t)tp * DI + c0), a1 = *(const f32x4*)(wc + (size_t)tp * DI + c0 + 4);
                            wv[tp][0] = a0[0]; wv[tp][1] = a0[1]; wv[tp][2] = a0[2]; wv[tp][3] = a0[3]; wv[tp][4] = a1[0]; wv[tp][5] = a1[1]; wv[tp][6] = a1[2]; wv[tp][7] = a1[3]; }
                        { const f32x4 a0 = *(const f32x4*)(bc + c0), a1 = *(const f32x4*)(bc + c0 + 4); bv[0] = a0[0]; bv[1] = a0[1]; bv[2] = a0[2]; bv[3] = a0[3]; bv[4] = a1[0]; bv[5] = a1[1]; bv[6] = a1[2]; bv[7] = a1[3]; }
                        const bf16_t* xb = S0 + (size_t)(LAT0 + bl * T + r * 64) * DI + c0;
                        bf16_t* ob = S1 + (size_t)(LAT0 + bl * T + r * 64) * DI + c0;
                        const bool rok[3] = {r > 0, true, r < 127};
                        float win[3][3][8];
#define CV_LOADCOL(slot, col) do { _Pragma("unroll") for (int di = 0; di < 3; ++di) { u32x4 xv = (u32x4){0u, 0u, 0u, 0u}; \
                                if (rok[di] && (col) >= 0 && (col) < 64) xv = *(const u32x4*)(xb + (ptrdiff_t)((di - 1) * 64 + (col)) * DI); \
                                win[slot][di][0] = bflo(xv.x); win[slot][di][1] = bfhi(xv.x); win[slot][di][2] = bflo(xv.y); win[slot][di][3] = bfhi(xv.y); \
                                win[slot][di][4] = bflo(xv.z); win[slot][di][5] = bfhi(xv.z); win[slot][di][6] = bflo(xv.w); win[slot][di][7] = bfhi(xv.w); } } while (0)
#define CV_STEP(sl, sm, sr) do { CV_LOADCOL(sr, gc + 1); \
                                if (gc < gc0 + 32) { float acc[8]; \
                                    _Pragma("unroll") for (int e = 0; e < 8; ++e) { float s = bv[e]; \
                                        _Pragma("unroll") for (int di = 0; di < 3; ++di) s += win[sl][di][e] * wv[di * 3 + 0][e] + win[sm][di][e] * wv[di * 3 + 1][e] + win[sr][di][e] * wv[di * 3 + 2][e]; \
                                        acc[e] = siluf(s); } \
                                    u32x4 o; o.x = pk2(acc[0], acc[1]); o.y = pk2(acc[2], acc[3]); o.z = pk2(acc[4], acc[5]); o.w = pk2(acc[6], acc[7]); \
                                    *(u32x4*)(ob + (size_t)gc * DI) = o; } \
                                ++gc; } while (0)
                        int gc = gc0;
                        CV_LOADCOL(0, gc0 - 1); CV_LOADCOL(1, gc0);
#pragma unroll 1
                        for (int g3 = 0; g3 < 11; ++g3) { CV_STEP(0, 1, 2); CV_STEP(1, 2, 0); CV_STEP(2, 0, 1); }
#undef CV_LOADCOL
#undef CV_STEP
                    }
                    for (int i = gt; i < LAT0 * (DI / 8); i += NGT) {
                        const int q = i / (DI / 8), c0 = (i % (DI / 8)) * 8, t = q % CT;
                        float acc[8];
#pragma unroll
                        for (int e = 0; e < 8; ++e) acc[e] = bc[c0 + e];
#pragma unroll
                        for (int dj = 0; dj < 3; ++dj) { const int tt = t + dj - 1; if (tt < 0 || tt >= CT) continue;
                            const u32x4 xv = *(const u32x4*)(S0 + (size_t)(q + dj - 1) * DI + c0); const float* w = wc + (size_t)(3 + dj) * DI + c0;
                            acc[0] += bflo(xv.x) * w[0]; acc[1] += bfhi(xv.x) * w[1]; acc[2] += bflo(xv.y) * w[2]; acc[3] += bfhi(xv.y) * w[3];
                            acc[4] += bflo(xv.z) * w[4]; acc[5] += bfhi(xv.z) * w[5]; acc[6] += bflo(xv.w) * w[6]; acc[7] += bfhi(xv.w) * w[7]; }
                        u32x4 o; o.x = pk2(siluf(acc[0]), siluf(acc[1])); o.y = pk2(siluf(acc[2]), siluf(acc[3])); o.z = pk2(siluf(acc[4]), siluf(acc[5])); o.w = pk2(siluf(acc[6]), siluf(acc[7]));
                        *(u32x4*)(S1 + (size_t)q * DI + c0) = o;
                    }
 }
                    SEAM(hb + 1);
                }
                if (IN(hb + 2)) { PH_BEGIN();
 for (int rp_ = 0; rp_ < REPN(0); ++rp_) {
                    { pg8::Gemm g{WV, S0 + (size_t)LAT0 * DI, DH, DI, DH, (long)DH * DH, DH, DH / 256, LH / 256, NH};
                      pg8::EpiStore E{S2, 0, 0, 0, 3, LAT0};
                      pg8::gemm_phase(lds, g, E, G, bx, tid); if (DUP_MIX) pg8::gemm_phase(lds, g, E, G, bx, tid); }
                    { SmallGemm sg{WV, S0, DH, DI, DH, DH, DH, 0, 0}; SmallDense sd{S2, 0, 0, DH / 64, LAT0 / 64, 0, (long)DH * DH, DH, 3}; gemm_small_dense(lds, sg, sd, NH, G, bx, tid); if (DUP_CTX) gemm_small_dense(lds, sg, sd, NH, G, bx, tid); }
                    {
                      SmallGemm sg{S1, GATET, DI, 4096, 1024, 1024, 1024, 0, 0};
                      const long xm_off = (long)(S0 - S1);
                      auto dec = [=](int uq, long& ao, long& bo) { const int u = uq >> 2, q = uq & 3; ao = (long)u * 64 * DI + (q & 1) * 1024 + (q >> 1) * xm_off; bo = q * 1024; };
                      auto epi = [=](int uq, int m, int n, const f32x4& v) { const int u = uq >> 2, q = uq & 3; if (n < 16) *(f32x4*)(PREQ + (size_t)q * RH * 16 + ((size_t)u * 64 + m) * 16 + n) = v; };
                      gemm_small(lds, sg, NCH * 4, dec, epi, G, bx, tid); }
 }
                    SEAM(hb + 2);
                }
                if (IN(hb + 3)) { PH_BEGIN();
 for (int rp_ = 0; rp_ < REPN(0); ++rp_) {
                    { pg8::Gemm g{S1 + (size_t)LAT0 * DI, WQ, DI, DH, DH, DH, (long)DH * DH, LH / 256, DH / 256, NH}; pg8::EpiStore E{S3, DH, DI, 0, 1, LAT0}; pg8::gemm_phase(lds, g, E, G, bx, tid); if (DUP_MIX) pg8::gemm_phase(lds, g, E, G, bx, tid); }
                    { SmallGemm sg{S1, WQ, DI, DH, DH, DH, DH, 0, 0}; SmallDense sd{S3, DH, DI, LAT0 / 64, DH / 64, 0, DH, (long)DH * DH, 1}; gemm_small_dense(lds, sg, sd, NH, G, bx, tid); if (DUP_CTX) gemm_small_dense(lds, sg, sd, NH, G, bx, tid); }
                    { pg8::Gemm g{WK, S1 + (size_t)LAT0 * DI, DH, DI, DH, (long)DH * DH, DH, DH / 256, LH / 256, NH}; pg8::EpiStore E{S4, (long)DH * RH, RH, 0, 2, LAT0}; pg8::gemm_phase(lds, g, E, G, bx, tid); if (DUP_MIX) pg8::gemm_phase(lds, g, E, G, bx, tid); }
                    { SmallGemm sg{WK, S1, DH, DI, DH, DH, DH, 0, 0}; SmallDense sd{S4, (long)DH * RH, RH, DH / 64, LAT0 / 64, 0, (long)DH * DH, DH, 2}; gemm_small_dense(lds, sg, sd, NH, G, bx, tid); if (DUP_CTX) gemm_small_dense(lds, sg, sd, NH, G, bx, tid); }
                    if (bx < 128) {
                        const int sc = bx >> 3, part = bx & 7, bl = sc >> 3, hh = (sc >> 1) & 3, dir = sc & 1;
                        unsigned* g12cnt = (unsigned*)(ws + WS_CTL + 4096) + ((jl * 2 + half) * 16 + sc) * 16;
                        unsigned* g12tot = (unsigned*)(ws + WS_PRE) + (size_t)((jl * 2 + half) * 16 + sc) * 132 * 2;
                        LAS float* bcs = (LAS float*)lds;
                        LAS float* vss = bcs + 132 * 64;
                        LAS float* bl_ = vss + 132 * 64;
                        LAS float* vm_ = bl_ + 132;
                        LAS float* mi_ = vm_ + 132;
                        const int u = lane, p = dir ? 63 - u : u;
                        const float* bgp = ka->in[I_BGATE] + (size_t)jl * 16 + 8 * dir + hh;
#pragma unroll
                        for (int ii = 0; ii < 3; ++ii) { const int i = part + 8 * ii; const int j = wave + 8 * i;
                            if (i < 17 && j < 132) { int row0; if (j < 4) { const int c = dir ? 3 - j : j; row0 = bl * CT + c * 64; } else { const int c = dir ? 127 - (j - 4) : (j - 4); row0 = LAT0 + bl * T + c * 64; }
                                const float* pr = PREQ + (size_t)(row0 + p) * 16 + 8 * dir + hh; const size_t qs = (size_t)RH * 16;
                                bcs[j * 64 + p] = (pr[4] + pr[qs + 4]) + (pr[2 * qs + 4] + pr[3 * qs + 4]) + bgp[4]; vss[j * 64 + p] = (pr[0] + pr[qs]) + (pr[2 * qs] + pr[3 * qs]) + bgp[0]; } }
                        asm volatile("s_waitcnt vmcnt(0) lgkmcnt(0)" ::: "memory");
#pragma unroll 1
                        for (int ii = 0; ii < 3; ++ii) { const int i = part + 8 * ii; const int j = wave + 8 * i;
                            if (i < 17 && j < 132) { const float f = bcs[j * 64 + p], lia = vss[j * 64 + p]; float x = fminf(f, 0.f) - log1pf(__expf(-fabsf(f)));
                                x = scan_add64(x);
                                const float v = lia - x; float pm = v;
                                pm = scan_max64(pm);
                                bcs[j * 64 + p] = x; vss[j * 64 + p] = v;
                                if (u == 63) { __hip_atomic_store(g12tot + 2 * j, __builtin_bit_cast(unsigned, x), __ATOMIC_RELAXED, __HIP_MEMORY_SCOPE_AGENT); __hip_atomic_store(g12tot + 2 * j + 1, __builtin_bit_cast(unsigned, pm), __ATOMIC_RELAXED, __HIP_MEMORY_SCOPE_AGENT); } } }
                        asm volatile("s_waitcnt vmcnt(0)" ::: "memory");
                        __syncthreads();
                        if (tid == 0) { (void)xb_add(g12cnt, 1u); unsigned sp_ = 0u; while (xb_ld(g12cnt) < 8u && ++sp_ < XB_SPIN_CAP) __builtin_amdgcn_s_sleep(1); }
                        __syncthreads();
                        if (tid < 132) { bl_[tid] = __builtin_bit_cast(float, xb_ld(g12tot + 2 * tid)); vm_[tid] = __builtin_bit_cast(float, xb_ld(g12tot + 2 * tid + 1)); }
                        __syncthreads();
                        if (wave == 0) {
                            const float ni = -__builtin_inff();
                            float ea[3], eb[3];
#pragma unroll
                            for (int t = 0; t < 3; ++t) { const int j = 3 * lane + t; const bool ok = j < 132; const float blj = bl_[ok ? j : 0], vmj = vm_[ok ? j : 0]; ea[t] = ok ? blj : 0.f; eb[t] = ok ? blj + vmj : ni; }
                            float A = ea[0] + ea[1], B = fmaxf(eb[0] + ea[1], eb[1]); B = fmaxf(B + ea[2], eb[2]); A += ea[2];
#define G12_STEP(CTRL, RM) do { const float pa_ = dppf<CTRL, RM>(0.f, A), pb_ = dppf<CTRL, RM>(ni, B); B = fmaxf(pb_ + A, B); A += pa_; } while (0)
                            G12_STEP(0x111, 0xF); G12_STEP(0x112, 0xF); G12_STEP(0x114, 0xF); G12_STEP(0x118, 0xF); G12_STEP(0x142, 0xA); G12_STEP(0x143, 0xC);
#undef G12_STEP
                            float EA = shup(A, 1, lane), EB = shup(B, 1, lane); if (lane == 0) { EA = 0.f; EB = ni; }
                            float m = fmaxf(EA, EB);
#pragma unroll
                            for (int t = 0; t < 3; ++t) { const int j = 3 * lane + t; if (j < 132) { mi_[j] = m; m = fmaxf(m + ea[t], eb[t]); } }
                        }
                        __syncthreads();
                        float* GPw = (float*)(YH + (size_t)NCH * 4 * 2 * 4096);
#pragma unroll 1
                        for (int ii = 0; ii < 3; ++ii) { const int i = part + 8 * ii; const int j = wave + 8 * i;
                            if (i < 17 && j < 132) { int row0; if (j < 4) { const int c = dir ? 3 - j : j; row0 = bl * CT + c * 64; } else { const int c = dir ? 127 - (j - 4) : (j - 4); row0 = LAT0 + bl * T + c * 64; }
                                const float bc = bcs[j * 64 + p], v = vss[j * 64 + p]; float pm = v;
                                pm = scan_max64(pm);
                                const float m_in = mi_[j], btot = bl_[j], m_new = btot + fmaxf(m_in, vm_[j]);
                                const float uu = -fmaxf(m_in, pm);
                                float* gp = GPw + ((size_t)((row0 >> 6) * 4 + hh) * 2 + dir) * 384;
                                gp[p] = uu; gp[64 + p] = v; gp[128 + p] = __expf(m_in + uu); gp[192 + p] = __expf(uu - bc); ((bf16_t*)(gp + 324))[p] = (bf16_t)f2bf(__expf(btot - m_new + v));
                                if (u == 0) gp[320] = __expf(btot + m_in - m_new); } }
                    }
 }
                    SEAM(hb + 3);
                }
                if (IN(hb + 4)) { PH_BEGIN();
 for (int rp_ = 0; rp_ < REPN(4); ++rp_) {
                    SmallGemm sg{S3, S4, DI, DI, DH, DH, DH, 0, 0, 1, 1};
                    bf16_t* SGw = YH; const float* GPr = (const float*)(YH + (size_t)NCH * 4 * 2 * 4096);
                    auto dec = [=](int u, long& ao, long& bo) { ao = u; bo = u; };
                    auto epi = [=](int u, int m, int n, const f32x4& v) {
#pragma unroll
                        for (int dir = 0; dir < 2; ++dir) { const float* gp = GPr + ((size_t)u * 2 + dir) * 384; const float up = gp[m]; const f32x4 vs = *(const f32x4*)(gp + 64 + n); float o[4];
#pragma unroll
                            for (int i = 0; i < 4; ++i) { const int s = n + i; const bool ok = dir ? (s >= m) : (s <= m); const float gte = ok ? __expf(up + vs[i]) : 0.f; o[i] = v[i] * gte; }
                            u32x2 w; w.x = pk2(o[0], o[1]); w.y = pk2(o[2], o[3]);
                            *(u32x2*)(SGw + ((size_t)u * 2 + dir) * 4096 + ((m >> 4) * 2 + (n >> 5)) * 512 + (((n >> 3) & 3) * 16 + (m & 15)) * 8 + (n & 7)) = w; } };
                    gemm_small(lds, sg, NCH * 4, dec, epi, G, bx, tid);
 }
                    SEAM(hb + 4);
                }
                if (EN_SCAN && IN(hb + 5)) { PH_BEGIN();
                    scan_phase(lds, ws, half, bar, tid, lane, wave, bx);
                    SEAM(hb + 5);
                }
                if (IN(hb + 6)) { PH_BEGIN();
 for (int rp_ = 0; rp_ < REPN(0); ++rp_) {
                    pg8::Gemm g{HH, WIN + (size_t)DI * D, D, D, D, 0, 0, LH / 256, DI / 256, 1};
                    pg8::EpiStore E{S3 + (size_t)LAT0 * DI, 0, DI, 0};
                    pg8::gemm_phase(lds, g, E, G, bx, tid); if (DUP_MIX) pg8::gemm_phase(lds, g, E, G, bx, tid);
                    if (layer < 2) { SmallGemm sg{HHC, WIN + (size_t)DI * D, D, D, D, D, D, 0, 0}; SmallDense sd{S3, 0, DI, LAT0 / 64, DI / 64, 0, 0, 0}; gemm_small_dense(lds, sg, sd, 1, G, bx, tid); if (DUP_CTX) gemm_small_dense(lds, sg, sd, 1, G, bx, tid); }
 }
                    SEAM(hb + 6);
                }
                if (IN(hb + 7)) { PH_BEGIN();
 for (int rp_ = 0; rp_ < REPN(3); ++rp_) {
                    const float* gn = ka->in[I_GNW] + (size_t)jl * DI; const float* sk = ka->in[I_SKIP] + (size_t)jl * DI;
#define RO_LOAD(q_, A, B, XC, ZZ) do { const bf16_t* h2_ = ((q_) < LAT0) ? HCB : S2; \
                        _Pragma("unroll") for (int hd = 0; hd < 4; ++hd) { const size_t ho_ = htile_off(q_, hd, 8 * lane); const size_t ro_ = (size_t)(q_) * DI + hd * DH + 8 * lane; \
                            A[hd] = *(const u32x4*)(S0 + ho_); B[hd] = *(const u32x4*)(h2_ + ho_); XC[hd] = *(const u32x4*)(S1 + ro_); ZZ[hd] = *(const u32x4*)(S3 + ro_); } } while (0)
                    u32x4 ra[4], rb[4], rx[4], rz[4], na[4], nb[4], nx[4], nz[4];
                    f32x4 gnv[4][2], skv[4][2];
#pragma unroll
                    for (int hd = 0; hd < 4; ++hd) { gnv[hd][0] = *(const f32x4*)(gn + hd * DH + 8 * lane); gnv[hd][1] = *(const f32x4*)(gn + hd * DH + 8 * lane + 4); skv[hd][0] = *(const f32x4*)(sk + hd * DH + 8 * lane); skv[hd][1] = *(const f32x4*)(sk + hd * DH + 8 * lane + 4); }
#pragma unroll
                    for (int hd = 0; hd < 4; ++hd) { ra[hd] = (u32x4){0u, 0u, 0u, 0u}; rb[hd] = ra[hd]; rx[hd] = ra[hd]; rz[hd] = ra[hd]; na[hd] = ra[hd]; nb[hd] = ra[hd]; nx[hd] = ra[hd]; nz[hd] = ra[hd]; }
                    const int q_first = (layer < 2 ? 0 : LAT0) + gw;
                    if (q_first < RH) RO_LOAD(q_first, ra, rb, rx, rz);
                    for (int q = q_first; q < RH; q += NGW) {
                        if (q + NGW < RH) RO_LOAD(q + NGW, na, nb, nx, nz);
#pragma unroll
                        for (int hd = 0; hd < 4; ++hd) {
                            const int c0 = hd * DH + 8 * lane;
                            const u32x4 a = ra[hd], b = rb[hd];
                            float v[8] = {bflo(a.x) + bflo(b.x), bfhi(a.x) + bfhi(b.x), bflo(a.y) + bflo(b.y), bfhi(a.y) + bfhi(b.y), bflo(a.z) + bflo(b.z), bfhi(a.z) + bfhi(b.z), bflo(a.w) + bflo(b.w), bfhi(a.w) + bfhi(b.w)};
                            float s = 0.f;
#pragma unroll
                            for (int i = 0; i < 8; ++i) s += v[i];
                            const float mean = wave_sum(s, lane) * (1.f / DH); float s2 = 0.f;
#pragma unroll
                            for (int i = 0; i < 8; ++i) { v[i] -= mean; s2 += v[i] * v[i]; }
                            const float rstd = __builtin_amdgcn_rsqf(wave_sum(s2, lane) * (1.f / DH) + LN_EPS);
                            const u32x4 xc = rx[hd], zz = rz[hd];
                            const float xcf[8] = {bflo(xc.x), bfhi(xc.x), bflo(xc.y), bfhi(xc.y), bflo(xc.z), bfhi(xc.z), bflo(xc.w), bfhi(xc.w)};
                            const float zf[8] = {bflo(zz.x), bfhi(zz.x), bflo(zz.y), bfhi(zz.y), bflo(zz.z), bfhi(zz.z), bflo(zz.w), bfhi(zz.w)};
                            float o[8];
#pragma unroll
                            for (int i = 0; i < 8; ++i) o[i] = (v[i] * rstd * gnv[hd][i >> 2][i & 3] + skv[hd][i >> 2][i & 3] * xcf[i]) * siluf(zf[i]);
                            u32x4 w; w.x = pk2(o[0], o[1]); w.y = pk2(o[2], o[3]); w.z = pk2(o[4], o[5]); w.w = pk2(o[6], o[7]);
                            *(u32x4*)(S4 + (size_t)q * DI + c0) = w;
                        }
#pragma unroll
                        for (int hd = 0; hd < 4; ++hd) { ra[hd] = na[hd]; rb[hd] = nb[hd]; rx[hd] = nx[hd]; rz[hd] = nz[hd]; }
                    }
#undef RO_LOAD
 }
                    SEAM(hb + 7);
                }
                if (IN(hb + 8)) { PH_BEGIN();
 for (int rp_ = 0; rp_ < REPN(0); ++rp_) {
                    pg8::Gemm g{S4 + (size_t)LAT0 * DI, WOUT, DI, DI, DI, 0, 0, LH / 256, D / 256, 1};
                    pg8::EpiStore E{YH, 0, D, 0};
                    pg8::gemm_phase(lds, g, E, G, bx, tid); if (DUP_MIX) pg8::gemm_phase(lds, g, E, G, bx, tid);
                    if (layer < 2) { SmallGemm sg{S4, WOUT, DI, DI, DI, DI, DI, 0, 0}; SmallDense sd{YHC, 0, D, LAT0 / 64, D / 64, 0, 0, 0}; gemm_small_dense(lds, sg, sd, 1, G, bx, tid); if (DUP_CTX) gemm_small_dense(lds, sg, sd, 1, G, bx, tid); }
 }
                    SEAM(hb + 8);
                }
            }
        } else if (EN_FOUR) {
            const bool has_ctx = layer < 3;
            if (IN(pb + 2)) { PH_BEGIN();
 for (int rp_ = 0; rp_ < REPN(2); ++rp_) {
                { pg8::Gemm g{(const bf16_t*)(ws + TAB_A1), HT, 256, 256, 256, 0, (long)D * T, 2, 128, NB};
                  pg8::EpiStore E{PB, (long)512 * 32768, 32768, 0};
                  pg8::gemm_phase(lds, g, E, G, bx, tid); if (DUP_MIX) pg8::gemm_phase(lds, g, E, G, bx, tid); }
                if (has_ctx) {
                    SmallGemm sg{(const bf16_t*)(ws + TAB_ACTX), HTC, 256, 256, 256, 256, 256, 0, 0};
                    auto dec = [=](int u, long& ao, long& bo) { const int b = u / 128, mb = (u / 16) % 8, cht = u % 16; ao = (long)mb * 64 * 256; bo = ((long)b * D + cht * 64) * CT; };
                    auto epi = [=](int u, int m, int n, const f32x4& v) { const int b = u / 128, mb = (u / 16) % 8, cht = u % 16; const int mg = mb * 64 + m, ri = mg >> 8, tp = mg & 255, ch = cht * 64 + n;
                        u32x2 w; w.x = pk2(v[0], v[1]); w.y = pk2(v[2], v[3]); *(u32x2*)(WC + (size_t)ctx_row(b, tp) * DI + (ch >> 8) * 512 + ri * 256 + (ch & 255)) = w; };
                    gemm_small(lds, sg, NB * 8 * 16, dec, epi, G, bx, tid);
                }
 }
                SEAM(pb + 2);
            }
            if (IN(pb + 3)) { PH_BEGIN();
 for (int rp_ = 0; rp_ < REPN(2); ++rp_) {
                {
                    const int wid = tid >> 6, wm = wid >> 1, wn = wid & 1, fr = lane & 15, fq = lane >> 4;
                    const int lrow = tid >> 3, lk = (tid & 7) * 8;
                    const unsigned stoff = (unsigned)(lrow * SG_LD + lk) * 2u;
                    LAS unsigned char* As = lds; LAS unsigned char* Bs0 = lds + SG_TILE; LAS unsigned char* Bs1 = lds + 2 * SG_TILE;
                    const bf16_t* A2 = (const bf16_t*)(ws + TAB_A2);
                    for (int pair = bx; pair < NB * 256; pair += G) {
                        const int b = pair >> 8, t1p = pair & 255;
                        const bf16_t* bp = PB + (size_t)b * 512 * 32768 + (size_t)((lk >> 5) * 256 + t1p) * 32768 + (size_t)lrow * 32 + (lk & 31);
                        u32x4 r0 = *(const u32x4*)(bp), r1 = *(const u32x4*)(bp + 2048), r2 = *(const u32x4*)(bp + 2 * 2048), r3 = *(const u32x4*)(bp + 3 * 2048);
                        *(LAS u32x4*)(As + stoff) = *(const u32x4*)(A2 + (size_t)t1p * 4096 + lrow * 64 + lk);
                        *(LAS u32x4*)(Bs0 + stoff) = r0;
                        LDS_BARRIER();
                        bf16x8 af[2];
#pragma unroll
                        for (int ks = 0; ks < 2; ++ks) af[ks] = *(const LAS bf16x8*)(As + ((wm * 16 + fr) * SG_LD + ks * 32 + fq * 8) * 2);
#define F2_TILE(ct_, BsC, BsN, rcur, rnext) do { \
                            if ((ct_) + 4 < 16) rcur = *(const u32x4*)(bp + ((ct_) + 4) * 2048); \
                            f32x4 acc[2] = {(f32x4){0.f, 0.f, 0.f, 0.f}, (f32x4){0.f, 0.f, 0.f, 0.f}}; \
                            _Pragma("unroll") for (int ks = 0; ks < 2; ++ks) _Pragma("unroll") for (int nt = 0; nt < 2; ++nt) { \
                                const bf16x8 bf = *(const LAS bf16x8*)(BsC + ((wn * 32 + nt * 16 + fr) * SG_LD + ks * 32 + fq * 8) * 2); \
                                acc[nt] = __builtin_amdgcn_mfma_f32_16x16x32_bf16(bf, af[ks], acc[nt], 0, 0, 0); } \
                            if ((ct_) + 1 < 16) *(LAS u32x4*)(BsN + stoff) = rnext; \
                            _Pragma("unroll") for (int nt = 0; nt < 2; ++nt) { const int m = wm * 16 + fr, n = wn * 32 + nt * 16 + fq * 4, rip = m >> 5, t2p = m & 31, ch = (ct_) * 64 + n; \
                                u32x2 w2; w2.x = pk2(acc[nt][0], acc[nt][1]); w2.y = pk2(acc[nt][2], acc[nt][3]); \
                                *(u32x2*)(WC + (size_t)lat_row(b, t1p + 256 * t2p) * DI + (ch >> 8) * 512 + rip * 256 + (ch & 255)) = w2; } \
                            LDS_BARRIER(); } while (0)
#pragma unroll 1
                        for (int ct = 0; ct < 16; ct += 4) { F2_TILE(ct, Bs0, Bs1, r0, r1); F2_TILE(ct + 1, Bs1, Bs0, r1, r2); F2_TILE(ct + 2, Bs0, Bs1, r2, r3); F2_TILE(ct + 3, Bs1, Bs0, r3, r0); }
#undef F2_TILE
                    }
                }
 }
                SEAM(pb + 3);
            }
            if (IN(pb + 4)) { PH_BEGIN();
 for (int rp_ = 0; rp_ < REPN(2); ++rp_) {
                pg8::Gemm g{WC + (size_t)CR * DI, (const bf16_t*)(ws + TAB_BZ), DI, 512, 512, 512, 0, (R - CR) / 256, 1, 4};
                pg8::EpiStore E{ZF + (size_t)CR * D, 256, D, 0};
                pg8::gemm_phase(lds, g, E, G, bx, tid); if (DUP_MIX) pg8::gemm_phase(lds, g, E, G, bx, tid);
                if (has_ctx) { SmallGemm sg{WC, (const bf16_t*)(ws + TAB_BZ), DI, 512, 512, 512, 512, 0, 0}; SmallDense sd{ZF, 256, D, CR / 64, 256 / 64, 0, 512, 0}; gemm_small_dense(lds, sg, sd, 4, G, bx, tid); if (DUP_CTX) gemm_small_dense(lds, sg, sd, 4, G, bx, tid); }
 }
                SEAM(pb + 4);
            }
            if (IN(pb + 5)) { PH_BEGIN();
 for (int rp_ = 0; rp_ < REPN(2); ++rp_) {
                pg8::Gemm g{ZF + (size_t)CR * D, WOUT, D, D, D, 0, 0, (R - CR) / 256, D / 256, 1};
                pg8::EpiStore E{YB + (size_t)CR * D, 0, D, 0};
                pg8::gemm_phase(lds, g, E, G, bx, tid); if (DUP_MIX) pg8::gemm_phase(lds, g, E, G, bx, tid);
                if (has_ctx) { SmallGemm sg{ZF, WOUT, D, D, D, D, D, 0, 0}; SmallDense sd{YB, 0, D, CR / 64, D / 64, 0, 0, 0}; gemm_small_dense(lds, sg, sd, 1, G, bx, tid); if (DUP_CTX) gemm_small_dense(lds, sg, sd, 1, G, bx, tid); }
 }
                SEAM(pb + 5);
            }
        }
#pragma unroll 1
        for (int which = 0; which < 2; ++which) {
            const int pid = pb + (which == 0 ? 19 : 22);
            if (EN_NORM && IN(pid)) { PH_BEGIN();
                const float* pg = ka->in[I_PG] + ((size_t)layer * 2 + which) * D; const float* pbv = ka->in[I_PB] + ((size_t)layer * 2 + which) * D;
                const int mlayer = which == 0 ? layer : layer + 1;
                const int shoff = which == 0 ? 3 * D : 0;
                const int goff = which == 0 ? 2 * D : 5 * D;
                const bool in_f32 = (layer == 0 && which == 0), out_f32 = (layer == 3 && which == 1);
                bf16_t* xbl = (bf16_t*)ka->out; bf16_t* xb3 = S4;
#define NR_LOAD(r_, XW, YW) do { const RowInfo ri_ = row_info(r_); const size_t xi_ = ri_.is_ctx ? ((size_t)ri_.b * CT + ri_.t) * D : ((size_t)ri_.b * T + ri_.t) * D; \
                    const bf16_t* yr_ = YB + (size_t)(r_) * D; \
                    if (in_f32) { const float* xp_ = (ri_.is_ctx ? ka->in[I_CTX] : ka->in[I_X]) + xi_; _Pragma("unroll") for (int j = 0; j < 4; ++j) XW[j] = *(const u32x4*)(xp_ + 256 * j + 4 * lane); } \
                    else { const bf16_t* xp_ = ri_.is_ctx ? (const bf16_t*)CTXX + xi_ : ((layer == 3 && which == 1) ? xb3 + xi_ : xbl + xi_); \
                        _Pragma("unroll") for (int j = 0; j < 4; ++j) { const u32x2 t_ = *(const u32x2*)(xp_ + 256 * j + 4 * lane); XW[j] = (u32x4){t_.x, t_.y, 0u, 0u}; } } \
                    _Pragma("unroll") for (int j = 0; j < 4; ++j) YW[j] = *(const u32x2*)(yr_ + 256 * j + 4 * lane); } while (0)
                if (which == 1 && (layer & 1) == 0) {
                    constexpr int TLD = 1026;
                    LAS bf16_t* TL = (LAS bf16_t*)lds;
                    const float* md2b = MOD + ((size_t)mlayer * 5) * 6 * D + shoff;
#define NT_ROW(r_, i_) do { const RowInfo ri = row_info(r_); const int mi = ri.is_ctx ? 4 : ri.b; \
                        const size_t xi = ri.is_ctx ? ((size_t)ri.b * CT + ri.t) * D : ((size_t)ri.b * T + ri.t) * D; \
                        bf16_t* xout16 = ri.is_ctx ? (bf16_t*)CTXX + xi : xbl + xi; \
                        (void)mi; f32x4 v[4]; \
                        _Pragma("unroll") for (int j = 0; j < 4; ++j) { const f32x4 x = (f32x4){bflo(xw[j].x), bfhi(xw[j].x), bflo(xw[j].y), bfhi(xw[j].y)}; \
                            const f32x4 y = (f32x4){bflo(yw[j].x), bfhi(yw[j].x), bflo(yw[j].y), bfhi(yw[j].y)}; v[j] = x * ALPHA + gtv[j] * y; } \
                        ln_norm(v, lane); \
                        _Pragma("unroll") for (int j = 0; j < 4; ++j) { const int c = 256 * j + 4 * lane; v[j] = v[j] * pgv[j] + pbw[j]; \
                            u32x2 xo; xo.x = pk2(v[j][0], v[j][1]); xo.y = pk2(v[j][2], v[j][3]); *(u32x2*)(xout16 + c) = xo; } \
                        ln_norm(v, lane); \
                        _Pragma("unroll") for (int j = 0; j < 4; ++j) { const int c = 256 * j + 4 * lane; \
                            const f32x4 h = v[j] * scv[j] + shv[j]; LAS unsigned* d_ = (LAS unsigned*)(TL + (i_) * TLD + c); d_[0] = pk2(h[0], h[1]); d_[1] = pk2(h[2], h[3]); } } while (0)
#define NT_PARAMS(mi_) do { const float* md_ = MOD + ((size_t)layer * 5 + (mi_)) * 6 * D; const float* md2_ = md2b + (size_t)(mi_) * 6 * D; \
                        _Pragma("unroll") for (int j = 0; j < 4; ++j) { const int c = 256 * j + 4 * lane; gtv[j] = *(const f32x4*)(md_ + goff + c); shv[j] = *(const f32x4*)(md2_ + c); scv[j] = *(const f32x4*)(md2_ + D + c) + 1.0f; } } while (0)
                    u32x4 xw[4], xn[4]; u32x2 yw[4], yn[4];
#pragma unroll
                    for (int j = 0; j < 4; ++j) { xw[j] = (u32x4){0u, 0u, 0u, 0u}; xn[j] = xw[j]; yw[j] = (u32x2){0u, 0u}; yn[j] = yw[j]; }
                    f32x4 pgv[4], pbw[4], gtv[4], shv[4], scv[4];
#pragma unroll
                    for (int j = 0; j < 4; ++j) { pgv[j] = *(const f32x4*)(pg + 256 * j + 4 * lane); pbw[j] = *(const f32x4*)(pbv + 256 * j + 4 * lane); }
                    for (int item = bx; item < NB * 32 * 4; item += G) {
                        const int b = item >> 7, t2 = (item >> 2) & 31, tb = item & 3;
                        NT_PARAMS(b);
                        const int rbase = lat_row(b, 32 * (64 * tb + wave * 8) + t2);
                        NR_LOAD(rbase, xw, yw);
#pragma unroll 1
                        for (int j8 = 0; j8 < 8; ++j8) {
                            if (j8 < 7) NR_LOAD(rbase + 32 * (j8 + 1), xn, yn);
                            NT_ROW(rbase + 32 * j8, wave * 8 + j8);
#pragma unroll
                            for (int j = 0; j < 4; ++j) { xw[j] = xn[j]; yw[j] = yn[j]; }
                        }
                        LDS_BARRIER();
#pragma unroll 4
                        for (int k = 0; k < 16; ++k) { const int idx = k * NTHR + tid, g8 = idx & 7, ch = idx >> 3; const LAS bf16_t* s = TL + (8 * g8) * TLD + ch;
                            u32x4 o; o.x = (unsigned)s[0] | ((unsigned)s[TLD] << 16); o.y = (unsigned)s[2 * TLD] | ((unsigned)s[3 * TLD] << 16); o.z = (unsigned)s[4 * TLD] | ((unsigned)s[5 * TLD] << 16); o.w = (unsigned)s[6 * TLD] | ((unsigned)s[7 * TLD] << 16);
                            *(u32x4*)(HT + (((size_t)b * D + ch) * 32 + t2) * 256 + 64 * tb + 8 * g8) = o; }
                        LDS_BARRIER();
                    }
                    if (layer < 2) {
                        NT_PARAMS(4);
                        for (int item = bx; item < NB * (CT / 8); item += G) {
                            const int b = item / (CT / 8), t8 = item % (CT / 8);
                            const int r = ctx_row(b, 8 * t8 + wave);
                            NR_LOAD(r, xw, yw);
                            NT_ROW(r, wave);
                            LDS_BARRIER();
#pragma unroll
                            for (int k = 0; k < 2; ++k) { const int ch = k * NTHR + tid; const LAS bf16_t* s = TL + ch;
                                u32x4 o; o.x = (unsigned)s[0] | ((unsigned)s[TLD] << 16); o.y = (unsigned)s[2 * TLD] | ((unsigned)s[3 * TLD] << 16); o.z = (unsigned)s[4 * TLD] | ((unsigned)s[5 * TLD] << 16); o.w = (unsigned)s[6 * TLD] | ((unsigned)s[7 * TLD] << 16);
                                *(u32x4*)(HTC + ((size_t)b * D + ch) * CT + 8 * t8) = o; }
                            LDS_BARRIER();
                        }
                    }
#undef NT_ROW
#undef NT_PARAMS
                } else {
                u32x4 xw[4], xn[4]; u32x2 yw[4], yn[4];
#pragma unroll
                for (int j = 0; j < 4; ++j) { xw[j] = (u32x4){0u, 0u, 0u, 0u}; xn[j] = xw[j]; yw[j] = (u32x2){0u, 0u}; yn[j] = yw[j]; }
                f32x4 pgv[4], pbw[4];
#pragma unroll
                for (int j = 0; j < 4; ++j) { pgv[j] = *(const f32x4*)(pg + 256 * j + 4 * lane); pbw[j] = *(const f32x4*)(pbv + 256 * j + 4 * lane); }
                const int nseg = (layer < 2 && gw < CR) ? 2 : 1;
#pragma unroll 1
                for (int seg = 0; seg < nseg; ++seg) {
                    const int mi = seg == 0 ? (gw >> 9) : 4;
                    const int rbeg = seg == 0 ? lat_row(gw >> 9, gw & 511) : gw, nr = seg == 0 ? T / 512 : 1;
                    const float* md = MOD + ((size_t)layer * 5 + mi) * 6 * D;
                    const float* md2 = MOD + ((size_t)(mlayer < 4 ? mlayer : 3) * 5 + mi) * 6 * D + shoff;
                    f32x4 gtv[4], shv[4], scv[4];
#pragma unroll
                    for (int j = 0; j < 4; ++j) { const int c = 256 * j + 4 * lane; gtv[j] = *(const f32x4*)(md + goff + c); shv[j] = *(const f32x4*)(md2 + c); scv[j] = *(const f32x4*)(md2 + D + c) + 1.0f; }
                    NR_LOAD(rbeg, xw, yw);
#pragma unroll 1
                    for (int k = 0; k < nr; ++k) {
                        const int r = rbeg + 512 * k;
                        if (k + 1 < nr) NR_LOAD(r + 512, xn, yn);
                        const RowInfo ri = row_info(r);
                        const size_t xi = ri.is_ctx ? ((size_t)ri.b * CT + ri.t) * D : ((size_t)ri.b * T + ri.t) * D;
                        bf16_t* xout16 = ri.is_ctx ? (bf16_t*)CTXX + xi : ((layer == 3 && which == 0) ? xb3 + xi : xbl + xi);
                        f32x4 v[4];
#pragma unroll
                        for (int j = 0; j < 4; ++j) { f32x4 x; if (in_f32) x = __builtin_bit_cast(f32x4, xw[j]); else x = (f32x4){bflo(xw[j].x), bfhi(xw[j].x), bflo(xw[j].y), bfhi(xw[j].y)};
                            const f32x4 y = (f32x4){bflo(yw[j].x), bfhi(yw[j].x), bflo(yw[j].y), bfhi(yw[j].y)}; v[j] = x * ALPHA + gtv[j] * y; }
                        ln_norm(v, lane);
#pragma unroll
                        for (int j = 0; j < 4; ++j) { const int c = 256 * j + 4 * lane; v[j] = v[j] * pgv[j] + pbw[j];
                            if (out_f32) *(f32x4*)(ka->out + xi + c) = v[j]; else { u32x2 xo; xo.x = pk2(v[j][0], v[j][1]); xo.y = pk2(v[j][2], v[j][3]); *(u32x2*)(xout16 + c) = xo; } }
                        if (mlayer < 4) {
                            ln_norm(v, lane);
                            bf16_t* o = HIN + (size_t)r * D;
#pragma unroll
                            for (int j = 0; j < 4; ++j) { const int c = 256 * j + 4 * lane; const f32x4 h = v[j] * scv[j] + shv[j]; u32x2 w; w.x = pk2(h[0], h[1]); w.y = pk2(h[2], h[3]); *(u32x2*)(o + c) = w; }
                        }
#pragma unroll
                        for (int j = 0; j < 4; ++j) { xw[j] = xn[j]; yw[j] = yn[j]; }
                    }
                }
                }
#undef NR_LOAD
                SEAM(pid);
            }
            if (EN_MLP && which == 0) {
                if (IN(pb + 20)) { PH_BEGIN();
 for (int rp_ = 0; rp_ < REPN(1); ++rp_) {
                    pg8::Gemm g{HIN + (size_t)CR * D, W1, D, D, D, 0, 0, (R - CR) / 256, DFF / 256, 1};
                    pg8::EpiStore E{HID + (size_t)CR * DFF, 0, DFF, 1};
                    pg8::gemm_phase(lds, g, E, G, bx, tid);
#if DUP_MLP
                    pg8::gemm_phase(lds, g, E, G, bx, tid);
#endif
                    if (layer < 2) { SmallGemm sg{HIN, W1, D, D, D, D, D, 0, 0}; SmallDense sd{HID, 0, DFF, CR / 64, DFF / 64, 1, 0, 0}; gemm_small_dense(lds, sg, sd, 1, G, bx, tid); }
 }
                    SEAM(pb + 20);
                }
                if (IN(pb + 21)) { PH_BEGIN();
 for (int rp_ = 0; rp_ < REPN(1); ++rp_) {
                    pg8::Gemm g{HID + (size_t)CR * DFF, W2, DFF, DFF, DFF, 0, 0, (R - CR) / 256, D / 256, 1, 1};
                    pg8::EpiStore E{YB + (size_t)CR * D, 0, D, 0};
                    pg8::gemm_phase(lds, g, E, G, bx, tid);
#if DUP_MLP
                    pg8::gemm_phase(lds, g, E, G, bx, tid);
#endif
                    if (layer < 2) { SmallGemm sg{HID, W2, DFF, DFF, DFF, DFF, DFF, 0, 0}; SmallDense sd{YB, 0, D, CR / 64, D / 64, 0, 0, 0}; gemm_small_dense(lds, sg, sd, 1, G, bx, tid); }
 }
                    SEAM(pb + 21);
                }
            }
        }
    }
#undef IN
#undef SEAM
}

extern "C" void kernel_launch(void* const* d_in, const int* in_sizes, int n_in, void* d_out, int out_size, void* d_ws, size_t ws_size, hipStream_t stream) {
    static int grid = 0;
    if (grid == 0) {
        if (n_in != 22 || ws_size < 512 * MiB) { fprintf(stderr, "kernel_launch: unexpected n_in %d / ws_size %zu\n", n_in, ws_size); grid = -1; return; }
        int dev = 0, cus = 0;
        if (hipGetDevice(&dev) != hipSuccess || hipDeviceGetAttribute(&cus, hipDeviceAttributeMultiprocessorCount, dev) != hipSuccess) { grid = -1; return; }
        if (hipFuncSetAttribute((const void*)fwd, hipFuncAttributeMaxDynamicSharedMemorySize, LDS_BYTES) != hipSuccess) { fprintf(stderr, "kernel_launch: hipFuncSetAttribute failed\n"); grid = -1; return; }
        int per_cu = 0;
        if (hipOccupancyMaxActiveBlocksPerMultiprocessor(&per_cu, (const void*)fwd, NTHR, LDS_BYTES) != hipSuccess || per_cu < 1) fprintf(stderr, "kernel_launch: occupancy query says %d\n", per_cu);
        (void)hipGetLastError();
        grid = cus;
        if (grid != 256) fprintf(stderr, "kernel_launch: %d CUs (built for 256)\n", grid);
    }
    if (grid < 0) return;
    (void)hipMemsetAsync((char*)d_ws + WS_CTL, 0, CTL_BYTES, stream);
    Args a{};
    for (int i = 0; i < 22; ++i) a.in[i] = (const float*)d_in[i];
    a.out = (float*)d_out; a.ws = (unsigned char*)d_ws;
#if MK_SINGLE
    { int last = 0; for (int id = 0; id < NPHASE; ++id) if (phase_valid(id)) last = id;
      a.ph_lo = 0; a.ph_hi = NPHASE; a.ph_last = last; a.li = 0;
      hipLaunchKernelGGL(fwd, dim3(grid), dim3(NTHR), LDS_BYTES, stream, a); }
#else
    { int li = 0;
      for (int id = 0; id < NPHASE; ++id) { if (!phase_valid(id)) continue;
          a.ph_lo = id; a.ph_hi = id + 1; a.ph_last = id; a.li = li++;
          hipLaunchKernelGGL(fwd, dim3(grid), dim3(NTHR), LDS_BYTES, stream, a); } }
#endif
}
```

```cpp
#include <hip/hip_runtime.h>
#include <cstdio>
#include <cstdint>

#define LAS __attribute__((address_space(3)))
typedef unsigned short bf16_t;
typedef short bf16x8 __attribute__((ext_vector_type(8)));
typedef float f32x4 __attribute__((ext_vector_type(4)));
typedef unsigned u32x4 __attribute__((ext_vector_type(4)));
typedef unsigned u32x2 __attribute__((ext_vector_type(2)));
typedef short s16x4 __attribute__((ext_vector_type(4)));


#ifndef EN_PRO
#define EN_PRO 1
#endif
#ifndef EN_WC
#define EN_WC 1
#endif
#ifndef EN_MIX
#define EN_MIX 1
#endif
#ifndef EN_SCAN
#define EN_SCAN 1
#endif
#ifndef EN_FOUR
#define EN_FOUR 1
#endif
#ifndef EN_NORM
#define EN_NORM 1
#endif
#ifndef EN_MLP
#define EN_MLP 1
#endif
#ifndef DUP_MIX
#define DUP_MIX 0
#endif
#ifndef DUP_CTX
#define DUP_CTX 0
#endif
#ifndef DUP_BAR
#define DUP_BAR 0
#endif
#ifndef DUP_MLP
#define DUP_MLP 0
#endif
#ifndef REP_MASK
#define REP_MASK 0
#endif
#define REPN(bit) (((REP_MASK) >> (bit)) & 1 ? 2 : 1)
#ifndef SC_QPAD
#define SC_QPAD 64
#endif
#ifndef SC_ABL
#define SC_ABL 0
#endif
#ifndef SCAN_REP
#define SCAN_REP 1
#endif
#ifndef MK_SINGLE
#define MK_SINGLE 1
#endif

constexpr int D = 1024, NB = 4, T = 8192, CT = 256, DI = 2048, NH = 4, DH = 512, DFF = 4096;
constexpr int R = NB * (T + CT);
constexpr int RH = R / 2;
constexpr int LAT0 = 2 * CT;
constexpr int NCH = RH / 64;
constexpr float ALPHA = 1.6817928305074290f;
constexpr float LN_EPS = 1e-5f;
constexpr int NWAVES = 8, NTHR = 512;

constexpr size_t MiB = 1u << 20;
constexpr size_t WS_CTL = 0, CTL_BYTES = 2 * MiB;
constexpr size_t WS_MOD = 2 * MiB;
constexpr size_t WS_CTXX = 3 * MiB;
constexpr size_t WS_PRE = 7 * MiB;
constexpr size_t WS_TAB = 10 * MiB;
constexpr size_t TAB_A1 = WS_TAB;
constexpr size_t TAB_A2 = TAB_A1 + 512 * 256 * 2;
constexpr size_t TAB_BZ = TAB_A2 + 256 * 64 * 64 * 2;
constexpr size_t TAB_ACTX = TAB_BZ + 256 * 512 * 2;
constexpr size_t TAB_GATE = TAB_ACTX + 512 * 256 * 2;
static_assert(TAB_GATE + 64 * 4096 * 2 <= 15 * MiB, "tables");
constexpr size_t WS_W = 15 * MiB;
constexpr size_t W_IN = WS_W;
constexpr size_t W_Q = W_IN + 8 * MiB, W_K = W_Q + 2 * MiB, W_V = W_K + 2 * MiB;
constexpr size_t W_OUT = W_V + 2 * MiB;
constexpr size_t W_1 = W_OUT + 4 * MiB;
constexpr size_t W_2 = W_1 + 8 * MiB;
static_assert(W_2 + 8 * MiB <= 49 * MiB, "weights");
constexpr size_t WS_HIN = 49 * MiB;
constexpr size_t WS_YB = 115 * MiB;
constexpr size_t WS_BIG = 181 * MiB;
constexpr size_t SLOT = 66 * MiB;
static_assert(WS_BIG + 5 * SLOT <= 512 * MiB, "workspace");
static_assert((size_t)RH * DI * 2 == SLOT, "slot");

#define LDS_BARRIER() do { asm volatile("s_waitcnt lgkmcnt(0)" ::: "memory"); __builtin_amdgcn_s_barrier(); asm volatile("" ::: "memory"); } while (0)
__device__ __forceinline__ unsigned f2bf(float f) { unsigned u = __builtin_bit_cast(unsigned, f); return (u + 0x7fffu + ((u >> 16) & 1u)) >> 16; }
typedef __bf16 bf16x2_t __attribute__((ext_vector_type(2)));
typedef float f32x2_t __attribute__((ext_vector_type(2)));
__device__ __forceinline__ unsigned pk2(float lo, float hi) { const f32x2_t v = {lo, hi}; return __builtin_bit_cast(unsigned, __builtin_convertvector(v, bf16x2_t)); }
__device__ __forceinline__ float bf2f(unsigned short b) { return __builtin_bit_cast(float, ((unsigned)b) << 16); }
__device__ __forceinline__ float u2f(unsigned u) { return __builtin_bit_cast(float, u); }
__device__ __forceinline__ float bflo(unsigned w) { return __builtin_bit_cast(float, w << 16); }
__device__ __forceinline__ float bfhi(unsigned w) { return __builtin_bit_cast(float, w & 0xffff0000u); }
__device__ __forceinline__ float shx(float v, int mask, int lane) { return __builtin_bit_cast(float, __builtin_amdgcn_ds_bpermute((lane ^ mask) << 2, __builtin_bit_cast(int, v))); }
template <int CTRL, int RMASK> __device__ __forceinline__ float dppf(float idv, float src) { return __builtin_bit_cast(float, __builtin_amdgcn_update_dpp(__builtin_bit_cast(int, idv), __builtin_bit_cast(int, src), CTRL, RMASK, 0xF, false)); }
__device__ __forceinline__ float scan_add64(float x) {
    x += dppf<0x111, 0xF>(0.f, x); x += dppf<0x112, 0xF>(0.f, x); x += dppf<0x114, 0xF>(0.f, x); x += dppf<0x118, 0xF>(0.f, x);
    x += dppf<0x142, 0xA>(0.f, x); x += dppf<0x143, 0xC>(0.f, x); return x; }
__device__ __forceinline__ float scan_max64(float x) {
    const float ni = -__builtin_inff();
    x = fmaxf(x, dppf<0x111, 0xF>(ni, x)); x = fmaxf(x, dppf<0x112, 0xF>(ni, x)); x = fmaxf(x, dppf<0x114, 0xF>(ni, x)); x = fmaxf(x, dppf<0x118, 0xF>(ni, x));
    x = fmaxf(x, dppf<0x142, 0xA>(ni, x)); x = fmaxf(x, dppf<0x143, 0xC>(ni, x)); return x; }
__device__ __forceinline__ float shup(float v, int d, int lane) { return __builtin_bit_cast(float, __builtin_amdgcn_ds_bpermute((lane - d) << 2, __builtin_bit_cast(int, v))); }
__device__ __forceinline__ float wave_sum(float v, int lane) {
    (void)lane;
    return __builtin_bit_cast(float, __builtin_amdgcn_readlane(__builtin_bit_cast(int, scan_add64(v)), 63));
}
__device__ __forceinline__ float siluf(float x) { return x * __builtin_amdgcn_rcpf(1.0f + __expf(-x)); }

struct RowInfo { int is_ctx, b, t; };
__device__ __forceinline__ RowInfo row_info(int r) {
    RowInfo ri;
    if (r < NB * CT) { ri.is_ctx = 1; ri.b = r / CT; ri.t = r % CT; }
    else { ri.is_ctx = 0; const int u = r - NB * CT; ri.b = u / T; ri.t = u % T; }
    return ri;
}
__device__ __forceinline__ int lat_row(int b, int t) { return NB * CT + b * T + t; }
__device__ __forceinline__ int ctx_row(int b, int t) { return b * CT + t; }
constexpr int CR = NB * CT;
constexpr int LH = RH - LAT0;

#define XB_TMO      128
#define XB_XCNT(j)  (256  + 64 * (j))
#define XB_XSUB(j)  (1280 + 64 * (j))
#define XB_XGEN(j)  (2304 + 64 * (j))
#define XB_TOP      3328
#define XB_TOPGEN   3392
#define XCD_BAR_WORDS 3456
#define XB_SPIN_CAP (1u << 18)

__device__ __forceinline__ unsigned xb_ld(unsigned* p)              { return __hip_atomic_load(p, __ATOMIC_RELAXED, __HIP_MEMORY_SCOPE_AGENT); }
__device__ __forceinline__ unsigned xb_add(unsigned* p, unsigned v) { return __hip_atomic_fetch_add(p, v, __ATOMIC_RELAXED, __HIP_MEMORY_SCOPE_AGENT); }
__device__ __forceinline__ unsigned xb_xcc_id() { return (unsigned)__builtin_amdgcn_s_getreg((3 << 11) | 20) & 0xFu; }
#define XB_SPIN(cond, bar) do { unsigned _sp = 0; while (cond) { __builtin_amdgcn_s_sleep(1); \
    if ((++_sp & 255u) == 0u) { if (xb_ld(&(bar)[XB_TMO])) break; if (_sp > XB_SPIN_CAP) { atomicAdd(&(bar)[XB_TMO], 1u); break; } } } } while (0)

struct XcdBarrier { unsigned* bar; unsigned x; volatile LAS unsigned* st; };

__device__ __forceinline__ XcdBarrier xcd_barrier_post(unsigned* bar, volatile LAS unsigned* st) {
    XcdBarrier b; b.bar = bar; b.x = xb_xcc_id(); b.st = st;
    if (threadIdx.x == 0) (void)xb_add(&bar[XB_XCNT(b.x)], 1u);
    return b;
}
__device__ __forceinline__ void xcd_barrier_complete(unsigned* bar, unsigned x, unsigned& nloc, unsigned& nx) {
    const unsigned G = gridDim.x * gridDim.y * gridDim.z;
    unsigned sum, cnt, mine, sp = 0u;
    for (;;) {
        sum = 0u; cnt = 0u; mine = 0u;
#pragma unroll
        for (unsigned j = 0; j < 16; ++j) { const unsigned c = xb_ld(&bar[XB_XCNT(j)]); sum += c; cnt += (c > 0u) ? 1u : 0u; mine = (j == x) ? c : mine; }
        if (sum == G) break;
        __builtin_amdgcn_s_sleep(1);
        if ((++sp & 255u) == 0u) { if (xb_ld(&bar[XB_TMO])) break; if (sp > XB_SPIN_CAP) { atomicAdd(&bar[XB_TMO], 1u); break; } }
    }
    nloc = mine > 0u ? mine : 1u; nx = cnt > 0u ? cnt : 1u;
}
__device__ __forceinline__ void xcd_barrier(const XcdBarrier& b, bool thread0) {
    asm volatile("s_waitcnt vmcnt(0)" ::: "memory");
    __syncthreads();
    if (thread0) {
        unsigned* bar = b.bar;
        __builtin_amdgcn_s_waitcnt(0);
        unsigned nloc = b.st[0], nx = b.st[1];
        if (nloc == 0u) { xcd_barrier_complete(bar, b.x, nloc, nx); b.st[0] = nloc; b.st[1] = nx; }
        const unsigned old = xb_add(&bar[XB_XSUB(b.x)], 1u);
        const unsigned gen = old / nloc;
        if (old + 1u == (gen + 1u) * nloc) {
            __builtin_amdgcn_fence(__ATOMIC_RELEASE, "agent");
            asm volatile("s_waitcnt vmcnt(0)" ::: "memory");
            (void)xb_add(&bar[XB_TOP], 1u);
        }
        XB_SPIN(xb_ld(&bar[XB_TOP]) < (gen + 1u) * nx, bar);
        __builtin_amdgcn_fence(__ATOMIC_ACQUIRE, "agent");
        asm volatile("s_waitcnt vmcnt(0)" ::: "memory");
    }
    __syncthreads();
}

__device__ __forceinline__ size_t qtile_off(int q, int h, int cc) {
    const int chunk = q >> 6, p = q & 63, pt = p >> 4, fr = p & 15, w = cc >> 6, ks = (cc >> 5) & 1, fq = (cc >> 3) & 3;
    const size_t blk = ((((size_t)chunk * 4 + h) * 8 + w) * 4 + pt) * 2 + ks;
    return blk * 512 + (size_t)(fq * 16 + fr) * 8 + (cc & 7);
}
__device__ __forceinline__ size_t ktile_off(int d, int h, int q) {
    const int chunk = q >> 6, s = q & 63, ks = s >> 5, fq = (s >> 3) & 3, w = d >> 6, dd = d & 63, mt = 2 * (dd >> 5) + ((dd >> 2) & 1), frp = 4 * ((dd >> 3) & 3) + (dd & 3);
    const size_t blk = ((((size_t)chunk * 4 + h) * 8 + w) * 4 + mt) * 2 + ks;
    return blk * 512 + (size_t)(fq * 16 + frp) * 8 + (s & 7);
}

__device__ __forceinline__ size_t vtile_off(int e, int h, int q) {
    const int chunk = q >> 6, s = q & 63, slice = e >> 5, e5 = e & 31, nt = e5 >> 4, fr = e5 & 15, ks = s >> 5, fq = (s >> 3) & 3;
    const size_t blk = ((((size_t)chunk * 4 + h) * 16 + slice) * 2 + nt) * 2 + ks;
    return blk * 512 + (size_t)(fq * 16 + fr) * 8 + (s & 7);
}
__device__ __forceinline__ size_t htile_off(int q, int h, int e) {
    return ((((size_t)(q >> 6) * 4 + h) * 16 + (e >> 5)) * 2048) + (size_t)(q & 63) * 32 + (e & 31);
}

namespace pg8 {
constexpr int BM = 256, BK = 64, HALF = 128, HTB = HALF * BK * 2, STAGE_BYTES = 8 * HTB, NXCD = 8, WGM = 8;
__device__ __forceinline__ int lds_byte(int r, int c) { const int st = (r >> 4) * 2 + (c >> 5), rr = r & 15, cc = c & 31, ob = rr * 64 + cc * 2; return st * 1024 + (ob ^ (((ob >> 9) & 1) << 5)); }
__device__ __forceinline__ void stage_rc(int b, int& R_, int& C_) { const int st = b / 1024, sb = b % 1024, swz = sb ^ (((sb >> 9) & 1) << 5); R_ = (st >> 1) * 16 + swz / 64; C_ = (st & 1) * 32 + (swz % 64) / 2; }
__device__ __forceinline__ int perm32(int rho) { const int n = rho >> 4, i = rho & 15; return 8 * (i >> 2) + 4 * n + (i & 3); }

struct Unit { int pm, pn, g; };
struct Gemm {
    const bf16_t* A; const bf16_t* Bt; int lda, ldb, K;
    long a_gs, b_gs;
    int nM, nN, nG;
    int rev;
};
struct Order {
    int nM, nNt, nN, nwg, G, c, rev;
    __device__ void init(const Gemm& g, int G_, int c_) { nM = g.nM; nN = g.nN; nNt = g.nN * g.nG; nwg = nM * nNt; G = G_; c = c_; rev = g.rev; }
    __device__ bool next(int i, Unit& u) const {
        const long L = (long)i * G + c; if (L >= nwg) return false;
        int wgid = (int)L; { const int q = nwg / NXCD, r = nwg % NXCD, xcd = wgid % NXCD, off = wgid / NXCD; wgid = (xcd < r ? xcd * (q + 1) : r * (q + 1) + (xcd - r) * q) + off; }
        const int nig = WGM * nNt, gid = wgid / nig, fm = gid * WGM, gsz = (nM - fm) < WGM ? (nM - fm) : WGM;
        u.pm = fm + ((wgid % nig) % gsz); if (rev) u.pm = nM - 1 - u.pm; const int pnt = (wgid % nig) / gsz; u.g = pnt / nN; u.pn = pnt - u.g * nN; return true;
    }
};
__device__ __forceinline__ unsigned cvt_pk_bf16(float lo, float hi) { return pk2(lo, hi); }

struct EpiStore {
    bf16_t* O; long o_gs; int ldc; int act;
    int mode, off;
    __device__ __forceinline__ void operator()(const f32x4 (&acc)[2][2][4][2], const Unit& u, int wr, int wc, int fr, int fq) const {
        const int row0 = u.pm * BM + wr * 64 + fr; const int col0 = u.pn * BM + wc * 32 + 8 * fq; bf16_t* base = O + (long)u.g * o_gs;
#pragma unroll
        for (int ai = 0; ai < 2; ++ai)
#pragma unroll
            for (int m = 0; m < 4; ++m) { bf16_t* rowp = base + (size_t)(row0 + ai * HALF + m * 16) * ldc + col0;
#pragma unroll
                for (int bj = 0; bj < 2; ++bj) { f32x4 v0 = acc[ai][bj][m][0], v1 = acc[ai][bj][m][1];
                    if (act == 1) {
#pragma unroll
                        for (int j = 0; j < 4; ++j) { const float a = fmaxf(v0[j], 0.f), b = fmaxf(v1[j], 0.f); v0[j] = a * a; v1[j] = b * b; } }
                    u32x4 w; w.x = cvt_pk_bf16(v0[0], v0[1]); w.y = cvt_pk_bf16(v0[2], v0[3]); w.z = cvt_pk_bf16(v1[0], v1[1]); w.w = cvt_pk_bf16(v1[2], v1[3]);
                    if (mode == 0) *(u32x4*)(rowp + bj * HALF) = w;
                    else if (mode == 1) *(u32x4*)(O + qtile_off(off + row0 + ai * HALF + m * 16, u.g, col0 + bj * HALF)) = w;
                    else if (mode == 2) *(u32x4*)(O + ktile_off(row0 + ai * HALF + m * 16, u.g, off + col0 + bj * HALF)) = w;
                    else *(u32x4*)(O + vtile_off(row0 + ai * HALF + m * 16, u.g, off + col0 + bj * HALF)) = w; } }
    }
};

template <class Epi>
__device__ __forceinline__ void gemm_phase(LAS unsigned char* lds, const Gemm g, const Epi& E, int G_, int c_, int tid_in) {
    int tid_ = tid_in; asm volatile("" : "+v"(tid_));
    const int tid = tid_, wid = __builtin_amdgcn_readfirstlane(tid >> 6), lane = tid & 63, wr = wid >> 2, wc = wid & 3, fr = lane & 15, fq = lane >> 4;
    const int K = g.K, nt = K / BK;
    Order S; S.init(g, G_, c_);
    unsigned voffA[2], voffB[2];
#pragma unroll
    for (int i = 0; i < 2; ++i) { int R_, C_; stage_rc(tid * 16 + i * 8192, R_, C_); const int Rb = (R_ & ~31) + perm32(R_ & 31);
        voffA[i] = (unsigned)(R_ * g.lda + C_) * 2u; voffB[i] = (unsigned)(Rb * g.ldb + C_) * 2u; }
    const size_t kstep = (size_t)(BK * 2);
    const size_t hstepA = (size_t)HALF * g.lda * 2, hstepB = (size_t)HALF * g.ldb * 2;
    const unsigned ldsw = (unsigned)wid * 1024u;
    const int aoff = lds_byte(wr * 64 + fr, fq * 8), boff = lds_byte(wc * 32 + fr, fq * 8);
#define PG8_SA(b, h) (((b) * 2 + (h)) * HTB)
#define PG8_SB(b, h) ((4 + (b) * 2 + (h)) * HTB)
#define PG8_STAGE(bufoff, gbase, voff) do { _Pragma("unroll") for (int _i = 0; _i < 2; ++_i) \
        __builtin_amdgcn_global_load_lds((const unsigned*)((const char*)(gbase) + (voff)[_i]), (LAS unsigned*)(lds + (bufoff) + ldsw + _i * 8192), 16, 0, 0); } while (0)
#define PG8_LDA(dst, b, h) do { _Pragma("unroll") for (int m = 0; m < 4; ++m) _Pragma("unroll") for (int k = 0; k < 2; ++k) dst[m][k] = *(const LAS bf16x8*)(lds + PG8_SA(b, h) + aoff + m * 2048 + k * 1024); } while (0)
#define PG8_LDB(dst, b, h) do { _Pragma("unroll") for (int n = 0; n < 2; ++n) _Pragma("unroll") for (int k = 0; k < 2; ++k) dst[n][k] = *(const LAS bf16x8*)(lds + PG8_SB(b, h) + boff + n * 2048 + k * 1024); } while (0)
#define PG8_MMA(ai, bj, At, Bt) do { __builtin_amdgcn_s_setprio(1); _Pragma("unroll") for (int m = 0; m < 4; ++m) _Pragma("unroll") for (int n = 0; n < 2; ++n) _Pragma("unroll") for (int k = 0; k < 2; ++k) \
        acc[ai][bj][m][n] = __builtin_amdgcn_mfma_f32_16x16x32_bf16(Bt[n][k], At[m][k], acc[ai][bj][m][n], 0, 0, 0); __builtin_amdgcn_s_setprio(0); } while (0)
#define PG8_WAIT_V(n) asm volatile("s_waitcnt vmcnt(" #n ")" ::: "memory")
#define PG8_WAIT_L(n) asm volatile("s_waitcnt lgkmcnt(" #n ")" ::: "memory")
#define PG8_BAR __builtin_amdgcn_s_barrier()
#define PG8_SCHED __builtin_amdgcn_sched_barrier(0)
#define PG8_APTR(u) ((const char*)(g.A + (long)(u).g * g.a_gs) + (size_t)(u).pm * 2 * hstepA)
#define PG8_BPTR(u) ((const char*)(g.Bt + (long)(u).g * g.b_gs) + (size_t)(u).pn * 2 * hstepB)
    Unit cur, nxt; int ui = 0;
    if (!S.next(0, cur)) return;
    f32x4 acc[2][2][4][2];
#pragma unroll
    for (int a = 0; a < 2; ++a)
#pragma unroll
        for (int b = 0; b < 2; ++b)
#pragma unroll
            for (int m = 0; m < 4; ++m)
#pragma unroll
                for (int n = 0; n < 2; ++n) acc[a][b][m][n] = (f32x4){0.f, 0.f, 0.f, 0.f};
    bf16x8 At[4][2], B0[2][2], B1[2][2];
    const char* cA = PG8_APTR(cur); const char* cB = PG8_BPTR(cur);
    PG8_STAGE(PG8_SB(0, 0), cB, voffB); PG8_STAGE(PG8_SA(0, 0), cA, voffA); PG8_STAGE(PG8_SB(0, 1), cB + hstepB, voffB); PG8_STAGE(PG8_SA(0, 1), cA + hstepA, voffA);
    if (wr == 1) PG8_BAR;
    PG8_WAIT_V(4); PG8_BAR;
    PG8_STAGE(PG8_SB(1, 0), cB + kstep, voffB); PG8_STAGE(PG8_SA(1, 0), cA + kstep, voffA); PG8_STAGE(PG8_SB(1, 1), cB + hstepB + kstep, voffB);
    PG8_WAIT_V(6); PG8_BAR;
    for (;;) {
        const bool has_next = S.next(ui + 1, nxt);
        const char* nA = has_next ? PG8_APTR(nxt) : cA; const char* nB = has_next ? PG8_BPTR(nxt) : cB;
        for (int t = 0; t < nt; t += 2) {
            const bool last = (t == nt - 2);
            const char* a1 = cA + (size_t)(t + 1) * kstep;
            const char* a2 = last ? nA : cA + (size_t)(t + 2) * kstep; const char* b2 = last ? nB : cB + (size_t)(t + 2) * kstep;
            const char* a3 = a2 + kstep; const char* b3 = b2 + kstep;
            PG8_LDB(B0, 0, 0); PG8_SCHED; PG8_LDA(At, 0, 0); PG8_STAGE(PG8_SA(1, 1), a1 + hstepA, voffA);
            PG8_WAIT_L(8); PG8_BAR; PG8_WAIT_L(0); PG8_MMA(0, 0, At, B0); PG8_BAR; PG8_SCHED;
            PG8_LDB(B1, 0, 1); PG8_STAGE(PG8_SB(0, 0), b2, voffB);
            PG8_BAR; PG8_WAIT_L(0); PG8_MMA(0, 1, At, B1); PG8_BAR;
            PG8_LDA(At, 0, 1); PG8_STAGE(PG8_SA(0, 0), a2, voffA);
            PG8_BAR; PG8_WAIT_L(0); PG8_MMA(1, 0, At, B0); PG8_BAR; PG8_SCHED;
            PG8_STAGE(PG8_SB(0, 1), b2 + hstepB, voffB);
            PG8_WAIT_V(6); PG8_BAR; PG8_MMA(1, 1, At, B1); PG8_BAR;
            PG8_LDB(B0, 1, 0); PG8_SCHED; PG8_LDA(At, 1, 0); PG8_STAGE(PG8_SA(0, 1), a2 + hstepA, voffA);
            PG8_WAIT_L(8); PG8_BAR; PG8_WAIT_L(0); PG8_MMA(0, 0, At, B0); PG8_BAR; PG8_SCHED;
            PG8_LDB(B1, 1, 1); PG8_STAGE(PG8_SB(1, 0), b3, voffB);
            PG8_BAR; PG8_WAIT_L(0); PG8_MMA(0, 1, At, B1); PG8_BAR;
            PG8_LDA(At, 1, 1); PG8_STAGE(PG8_SA(1, 0), a3, voffA);
            PG8_BAR; PG8_WAIT_L(0); PG8_MMA(1, 0, At, B0); PG8_BAR; PG8_SCHED;
            PG8_STAGE(PG8_SB(1, 1), b3 + hstepB, voffB);
            PG8_WAIT_V(6); PG8_BAR; PG8_MMA(1, 1, At, B1); PG8_BAR;
        }
        E(acc, cur, wr, wc, fr, fq);
        if (!has_next) break;
#pragma unroll
        for (int a = 0; a < 2; ++a)
#pragma unroll
            for (int b = 0; b < 2; ++b)
#pragma unroll
                for (int m = 0; m < 4; ++m)
#pragma unroll
                    for (int n = 0; n < 2; ++n) acc[a][b][m][n] = (f32x4){0.f, 0.f, 0.f, 0.f};
        cur = nxt; cA = nA; cB = nB; ++ui;
    }
    PG8_WAIT_V(0);
    if (wr == 0) PG8_BAR;
    PG8_BAR;
#undef PG8_SA
#undef PG8_SB
#undef PG8_STAGE
#undef PG8_LDA
#undef PG8_LDB
#undef PG8_MMA
#undef PG8_WAIT_V
#undef PG8_WAIT_L
#undef PG8_BAR
#undef PG8_SCHED
#undef PG8_APTR
#undef PG8_BPTR
}
}

struct SmallGemm { const bf16_t* A; const bf16_t* B; int lda, ldb, K, akseg, bkseg; long aseg, bseg; int a_tiled; int b_kt; };
constexpr int SG_LD = 72;
constexpr int SG_TILE = 64 * SG_LD * 2;
template <class Dec, class Epi>
__device__ __forceinline__ void gemm_small(LAS unsigned char* lds, const SmallGemm g, int nunits, const Dec& dec, const Epi& epi, int G_, int c_, int tid_in) {
    int tid_ = tid_in; asm volatile("" : "+v"(tid_));
    const int tid = tid_, wid = tid >> 6, lane = tid & 63, wm = wid >> 1, wn = wid & 1, fr = lane & 15, fq = lane >> 4;
    const int lrow = tid >> 3, lk = (tid & 7) * 8;
    const int nk = g.K / 64;
    const unsigned stoff = (unsigned)(lrow * SG_LD + lk) * 2u;
#define SG_LOAD(ra_, rb_, kt_) do { const int k_ = (kt_) * 64 + lk; \
        if (g.a_tiled) ra_ = *(const u32x4*)(g.A + (((((size_t)aoff * 8 + (k_ >> 6)) * 4 + (lrow >> 4)) * 2 + ((k_ >> 5) & 1)) * 512 + (size_t)(((k_ >> 3) & 3) * 16 + (lrow & 15)) * 8)); \
        else ra_ = *(const u32x4*)(ap + (long)(k_ / g.akseg) * g.aseg + (k_ % g.akseg)); \
        if (g.b_kt) rb_ = *(const u32x4*)(g.B + ktile_off((kt_) * 64 + lrow, (int)(boff & 3), (int)(boff >> 2) * 64 + lk));     \
        else rb_ = *(const u32x4*)(bp + (long)(k_ / g.bkseg) * g.bseg + (k_ % g.bkseg)); } while (0)
#define SG_STORE(ra_, rb_, bufi_) do { *(LAS u32x4*)(lds + ((bufi_) * 2 + 0) * SG_TILE + stoff) = ra_; *(LAS u32x4*)(lds + ((bufi_) * 2 + 1) * SG_TILE + stoff) = rb_; } while (0)
#define SG_COMPUTE(bufi_) do { const LAS unsigned char* As = lds + ((bufi_) * 2 + 0) * SG_TILE; const LAS unsigned char* Bs = lds + ((bufi_) * 2 + 1) * SG_TILE; \
        _Pragma("unroll") for (int ks = 0; ks < 2; ++ks) { const bf16x8 af = *(const LAS bf16x8*)(As + ((wm * 16 + fr) * SG_LD + ks * 32 + fq * 8) * 2); \
            _Pragma("unroll") for (int nt = 0; nt < 2; ++nt) { bf16x8 bf; \
                if (g.b_kt) {     \
                    const s16x4 t0_ = __builtin_amdgcn_ds_read_tr16_b64_v4i16((LAS s16x4*)(Bs + ((ks * 32 + 8 * fq + (fr >> 2)) * SG_LD + wn * 32 + nt * 16 + 4 * (fr & 3)) * 2)); \
                    const s16x4 t1_ = __builtin_amdgcn_ds_read_tr16_b64_v4i16((LAS s16x4*)(Bs + ((ks * 32 + 8 * fq + 4 + (fr >> 2)) * SG_LD + wn * 32 + nt * 16 + 4 * (fr & 3)) * 2)); \
                    bf = (bf16x8){t0_[0], t0_[1], t0_[2], t0_[3], t1_[0], t1_[1], t1_[2], t1_[3]}; } \
                else bf = *(const LAS bf16x8*)(Bs + ((wn * 32 + nt * 16 + fr) * SG_LD + ks * 32 + fq * 8) * 2); \
                acc[nt] = __builtin_amdgcn_mfma_f32_16x16x32_bf16(bf, af, acc[nt], 0, 0, 0); } } } while (0)
    for (int u = c_; u < nunits; u += G_) {
        long aoff, boff; dec(u, aoff, boff);
        const bf16_t* ap = g.A + aoff + (long)lrow * g.lda; const bf16_t* bp = g.B + boff + (long)lrow * g.ldb;
        f32x4 acc[2] = {(f32x4){0.f, 0.f, 0.f, 0.f}, (f32x4){0.f, 0.f, 0.f, 0.f}};
        u32x4 ra0, rb0, ra1, rb1, ra2, rb2, ra3, rb3;
        ra0 = (u32x4){0u, 0u, 0u, 0u}; rb0 = ra0; ra1 = ra0; rb1 = ra0; ra2 = ra0; rb2 = ra0; ra3 = ra0; rb3 = ra0;
        SG_LOAD(ra0, rb0, 0); if (nk > 1) SG_LOAD(ra1, rb1, 1); if (nk > 2) SG_LOAD(ra2, rb2, 2); if (nk > 3) SG_LOAD(ra3, rb3, 3);
        SG_STORE(ra0, rb0, 0);
        LDS_BARRIER();
#define SG_TURN(kt_, bufc, rnextA, rnextB, rfreeA, rfreeB) do { if ((kt_) < nk) { \
            SG_COMPUTE(bufc); \
            if ((kt_) + 1 < nk) SG_STORE(rnextA, rnextB, (bufc) ^ 1); \
            if ((kt_) + 4 < nk) SG_LOAD(rfreeA, rfreeB, (kt_) + 4); \
            LDS_BARRIER(); } } while (0)
        for (int kt = 0; kt < nk; kt += 4) {
            SG_TURN(kt,     0, ra1, rb1, ra0, rb0);
            SG_TURN(kt + 1, 1, ra2, rb2, ra1, rb1);
            SG_TURN(kt + 2, 0, ra3, rb3, ra2, rb2);
            SG_TURN(kt + 3, 1, ra0, rb0, ra3, rb3);
        }
#undef SG_TURN
#pragma unroll
        for (int nt = 0; nt < 2; ++nt) epi(u, wm * 16 + fr, wn * 32 + nt * 16 + fq * 4, acc[nt]);
    }
#undef SG_LOAD
#undef SG_STORE
#undef SG_COMPUTE
}

struct SmallDense { bf16_t* O; long o_gs; int ldc, mt, nt, act; long a_gs, b_gs; int mode; };
__device__ __forceinline__ void gemm_small_dense(LAS unsigned char* lds, const SmallGemm g, const SmallDense d, int ngroups, int G_, int c_, int tid_in) {
    const int per = d.mt * d.nt;
    auto dec = [=](int u, long& ao, long& bo) { const int gi = u / per, r = u % per, mi = r / d.nt, ni = r % d.nt; ao = gi * d.a_gs + (long)mi * 64 * g.lda; bo = gi * d.b_gs + (long)ni * 64 * g.ldb; };
    auto epi = [=](int u, int m, int n, const f32x4& v) { const int gi = u / per, r = u % per, mi = r / d.nt, ni = r % d.nt;
        f32x4 x = v; if (d.act == 1) {
#pragma unroll
            for (int i = 0; i < 4; ++i) { const float a = fmaxf(x[i], 0.f); x[i] = a * a; } }
        u32x2 w; w.x = pk2(x[0], x[1]); w.y = pk2(x[2], x[3]);
        if (d.mode == 0) *(u32x2*)(d.O + gi * d.o_gs + (size_t)(mi * 64 + m) * d.ldc + ni * 64 + n) = w;
        else if (d.mode == 1) *(u32x2*)(d.O + qtile_off(mi * 64 + m, gi, ni * 64 + n)) = w;
        else if (d.mode == 2) *(u32x2*)(d.O + ktile_off(mi * 64 + m, gi, ni * 64 + n)) = w;
        else *(u32x2*)(d.O + vtile_off(mi * 64 + m, gi, ni * 64 + n)) = w; };
    gemm_small(lds, g, ngroups * per, dec, epi, G_, c_, tid_in);
}

struct Args { const float* in[22]; float* out; unsigned char* ws; int ph_lo, ph_hi, ph_last, li; };
enum { I_X = 0, I_C, I_CTX, I_CCTX, I_ADAW, I_ADAB, I_PG, I_PB, I_WIN, I_WCONV, I_BCONV, I_WQ, I_WK, I_WV, I_WGATE, I_BGATE, I_GNW, I_SKIP, I_WOUT, I_FWOUT, I_W1, I_W2 };

constexpr int LDS_BYTES = 147456;
constexpr int LDS_MISC = LDS_BYTES - 256;

__device__ __forceinline__ void transpose_item(const float* W, int K, int N, bf16_t* WT, float scale, LAS float* scr, int item, int lane) {
    constexpr int TS = 36;
    LAS bf16_t* t = (LAS bf16_t*)scr;
    const int nblk = N / 32, kb = item / nblk, nb = item % nblk, k0 = 64 * kb, n0 = 32 * nb;
    const int n4 = (lane & 7) * 4;
#pragma unroll
    for (int i = 0; i < 8; ++i) { const int kk = 8 * i + (lane >> 3); const f32x4 w = *(const f32x4*)(W + (size_t)(k0 + kk) * N + n0 + n4) * scale;
        u32x2 p; p.x = pk2(w[0], w[1]); p.y = pk2(w[2], w[3]); *(LAS u32x2*)(t + kk * TS + n4) = p; }
    asm volatile("s_waitcnt lgkmcnt(0)" ::: "memory");
    const int g = lane >> 4, l = lane & 15;
#pragma unroll
    for (int j = 0; j < 4; ++j) { const int nh = j & 1, kg = 4 * (j >> 1) + g;
        const LAS bf16_t* bp = t + (8 * kg + (l >> 2)) * TS + 16 * nh + 4 * (l & 3);
        const s16x4 a0 = __builtin_amdgcn_ds_read_tr16_b64_v4i16((LAS s16x4*)bp), a1 = __builtin_amdgcn_ds_read_tr16_b64_v4i16((LAS s16x4*)(bp + 4 * TS));
        u32x4 o; o.x = (unsigned)(unsigned short)a0[0] | ((unsigned)(unsigned short)a0[1] << 16); o.y = (unsigned)(unsigned short)a0[2] | ((unsigned)(unsigned short)a0[3] << 16);
        o.z = (unsigned)(unsigned short)a1[0] | ((unsigned)(unsigned short)a1[1] << 16); o.w = (unsigned)(unsigned short)a1[2] | ((unsigned)(unsigned short)a1[3] << 16);
        *(u32x4*)(WT + (size_t)(n0 + 16 * nh + l) * K + k0 + 8 * kg) = o; }
    asm volatile("s_waitcnt lgkmcnt(0)" ::: "memory");
}

__device__ __forceinline__ void ln_norm(f32x4 (&v)[4], int lane) {
    float s = 0.f;
#pragma unroll
    for (int j = 0; j < 4; ++j) s += (v[j][0] + v[j][1]) + (v[j][2] + v[j][3]);
    const float mean = wave_sum(s, lane) * (1.f / D); float s2 = 0.f;
#pragma unroll
    for (int j = 0; j < 4; ++j) { v[j] = v[j] - mean; s2 += (v[j][0] * v[j][0] + v[j][1] * v[j][1]) + (v[j][2] * v[j][2] + v[j][3] * v[j][3]); }
    const float rstd = __builtin_amdgcn_rsqf(wave_sum(s2, lane) * (1.f / D) + LN_EPS);
#pragma unroll
    for (int j = 0; j < 4; ++j) v[j] = v[j] * rstd;
}

constexpr int PL = 24;
constexpr int NPHASE = 2 + 4 * PL;
__host__ __device__ inline bool phase_valid(int id) {
    if (id < 2) return true;
    const int layer = (id - 2) / PL, k = (id - 2) % PL;
    if (layer > 3) return false;
    if (k == 0 || (k >= 19 && k <= 22)) return true;
    if (layer & 1) return k >= 2 && k <= 5;
    return k >= 1 && k <= 18;
}


#define MOD ((float*)(ws + WS_MOD))
#define CTXX ((float*)(ws + WS_CTXX))
#define PRE ((float*)(ws + WS_PRE))
#define HIN ((bf16_t*)(ws + WS_HIN))
#define YB ((bf16_t*)(ws + WS_YB))
#define WIN ((bf16_t*)(ws + W_IN))
#define WQ ((bf16_t*)(ws + W_Q))
#define WK ((bf16_t*)(ws + W_K))
#define WV ((bf16_t*)(ws + W_V))
#define WOUT ((bf16_t*)(ws + W_OUT))
#define W1 ((bf16_t*)(ws + W_1))
#define W2 ((bf16_t*)(ws + W_2))
#define GATET ((bf16_t*)(ws + TAB_GATE))
#define S0 ((bf16_t*)(ws + WS_BIG + 0 * SLOT))
#define S1 ((bf16_t*)(ws + WS_BIG + 1 * SLOT))
#define S2 ((bf16_t*)(ws + WS_BIG + 2 * SLOT))
#define S3 ((bf16_t*)(ws + WS_BIG + 3 * SLOT))
#define S4 ((bf16_t*)(ws + WS_BIG + 4 * SLOT))
#define YH (YB + ((size_t)CR + (size_t)half * LH) * D)
#define YHC (YB + (size_t)half * LAT0 * D)
#define HCB (YH + (size_t)NCH * 4 * 2 * 4096 + (size_t)NCH * 4 * 2 * 384 * 2)
#define PREQ ((float*)(HCB + (size_t)LAT0 * DI))
#define HH (HIN + ((size_t)CR + (size_t)half * LH) * D)
#define HHC (HIN + (size_t)half * LAT0 * D)
#define ZL ((bf16_t*)((char*)ka->out + (size_t)64 * MiB))
#define ZC ((bf16_t*)(ws + WS_PRE + 1 * MiB))
#define HT ((bf16_t*)(ws + WS_BIG))
#define HTC (HT + (size_t)NB * D * T)
#define PB ((bf16_t*)(ws + WS_BIG + 1 * SLOT))
#define WC ((bf16_t*)(ws + WS_BIG + 3 * SLOT))
#define ZF ((bf16_t*)(ws + WS_BIG))
#define HID ((bf16_t*)(ws + WS_BIG))

constexpr int SC_PLD = 36, SC_VLD = 72;
#define SC_ROW0(j) (((j) < 4) ? (bl * CT + (dir ? 3 - (j) : (j)) * 64) : (LAT0 + bl * T + (dir ? 127 - ((j) - 4) : ((j) - 4)) * 64))
#define SC_LOADQ(dst, r0) do { _Pragma("unroll") for (int pt = 0; pt < 4; ++pt) _Pragma("unroll") for (int ks = 0; ks < 2; ++ks) \
        dst[pt][ks] = __builtin_bit_cast(bf16x8, __builtin_amdgcn_raw_buffer_load_b128(rW, loff, oQ + ((((((r0) >> 6) * 4 + hh) * 8 + w) * 4 + pt) * 2 + ks) * 1024, 0)); } while (0)
#define SC_LOADQ1(dst, r0, pt, ks) dst[pt][ks] = __builtin_bit_cast(bf16x8, __builtin_amdgcn_raw_buffer_load_b128(rW, loff, oQ + ((((((r0) >> 6) * 4 + hh) * 8 + w) * 4 + (pt)) * 2 + (ks)) * 1024, 0))
#define SC_LOADK1(dst, r0, mt, ks) dst[mt][ks] = __builtin_bit_cast(bf16x8, __builtin_amdgcn_raw_buffer_load_b128(rW, loff, oK + ((((((r0) >> 6) * 4 + hh) * 8 + w) * 4 + (mt)) * 2 + (ks)) * 1024, 0))
#define SC_LOADK(dst, r0) do { _Pragma("unroll") for (int mt = 0; mt < 4; ++mt) _Pragma("unroll") for (int ks = 0; ks < 2; ++ks) \
        dst[mt][ks] = __builtin_bit_cast(bf16x8, __builtin_amdgcn_raw_buffer_load_b128(rW, loff, oK + ((((((r0) >> 6) * 4 + hh) * 8 + w) * 4 + mt) * 2 + ks) * 1024, 0)); } while (0)
#define SC_LOADS(P, r0) do { const int ci_ = ((((r0) >> 6) * 4 + hh) * 2 + dir); \
        P##sg0 = __builtin_bit_cast(bf16x8, __builtin_amdgcn_raw_buffer_load_b128(rW, loff, oS + ci_ * 8192 + (w >> 1) * 2048, 0)); P##sg1 = __builtin_bit_cast(bf16x8, __builtin_amdgcn_raw_buffer_load_b128(rW, loff, oS + ci_ * 8192 + (w >> 1) * 2048 + 1024, 0)); \
        P##v = __builtin_bit_cast(u32x4, __builtin_amdgcn_raw_buffer_load_b128(rW, loff, oV + ((((r0) >> 6) * 4 + hh) * 16 + slice) * 4096 + (w & 3) * 1024, 0));     \
        P##wka = __builtin_bit_cast(u32x4, __builtin_amdgcn_raw_buffer_load_b128(rW, wkoff, oG + ci_ * 1536 + 1296, 0));         \
        P##wint = __builtin_bit_cast(float, __builtin_amdgcn_raw_buffer_load_b32(rW, gcp, oG + ci_ * 1536 + 512, 0)); P##em = __builtin_bit_cast(float, __builtin_amdgcn_raw_buffer_load_b32(rW, gcp, oG + ci_ * 1536 + 768, 0)); \
        P##dec = __builtin_bit_cast(float, __builtin_amdgcn_raw_buffer_load_b32(rW, 0, oG + ci_ * 1536 + 1280, 0)); } while (0)
#define SC_VWRITE(bufi, P) do { LAS bf16_t* vt_ = VB + (bufi) * 2 * 3072; LAS bf16_t* vw_ = vt_ + 3072; \
        if (w < 5) { const float wk_[8] = {bflo(P##wka.x), bfhi(P##wka.x), bflo(P##wka.y), bfhi(P##wka.y), bflo(P##wka.z), bfhi(P##wka.z), bflo(P##wka.w), bfhi(P##wka.w)};     \
            if (w < 4) { *(LAS u32x4*)(vt_ + tid * 8) = P##v; \
                u32x4 sv_; sv_.x = pk2(bflo(P##v.x) * wk_[0], bfhi(P##v.x) * wk_[1]); sv_.y = pk2(bflo(P##v.y) * wk_[2], bfhi(P##v.y) * wk_[3]); \
                sv_.z = pk2(bflo(P##v.z) * wk_[4], bfhi(P##v.z) * wk_[5]); sv_.w = pk2(bflo(P##v.w) * wk_[6], bfhi(P##v.w) * wk_[7]); *(LAS u32x4*)(vw_ + tid * 8) = sv_; } \
            else if (lane < 8) { const u32x4 sv_ = P##wka; \
                int ln_ = lane; asm volatile("" : "+v"(ln_));     \
                *(LAS u32x4*)(vw_ + (4 + (ln_ >> 2)) * 512 + (ln_ & 3) * 16 * 8) = sv_; } } } while (0)
#define SC_STEP(J, Qc, Qn, Kc, Kn, C, N) do { \
    const int j_ = (J); const int row0 = SC_ROW0(j_); const int jn_ = j_ < 131 ? j_ + 1 : 131; const int row1 = SC_ROW0(jn_); \
    const int hsel = (j_ < 4) ? (dir ? 2 : 0) : ((j_ < 68) ? 0 : 1); \
    const int buf = j_ & 1; \
    const LAS bf16_t* VT = VB + buf * 2 * 3072; const LAS bf16_t* VW = VT + 3072; \
    LAS bf16_t* Pb_ = Pbh + buf * (8 * 64 * 40); LAS float* Nq_ = NQs + buf * (8 * 64);        \
    SC_LOADS(N, row1); \
      \
    if (!(abl_ & 1)) _Pragma("unroll") for (int nt = 0; nt < 3; ++nt) { \
        f32x4 d1[4]; \
        _Pragma("unroll") for (int pt = 0; pt < 4; ++pt) d1[pt] = (f32x4){0.f, 0.f, 0.f, 0.f}; \
        _Pragma("unroll") for (int ks = 0; ks < 2; ++ks) { \
            u32x4 bw; bw.x = pg8::cvt_pk_bf16(st[2 * ks][nt][0], st[2 * ks][nt][1]); bw.y = pg8::cvt_pk_bf16(st[2 * ks][nt][2], st[2 * ks][nt][3]); \
            bw.z = pg8::cvt_pk_bf16(st[2 * ks + 1][nt][0], st[2 * ks + 1][nt][1]); bw.w = pg8::cvt_pk_bf16(st[2 * ks + 1][nt][2], st[2 * ks + 1][nt][3]); \
            const bf16x8 bs = __builtin_bit_cast(bf16x8, bw); \
            _Pragma("unroll") for (int pt = 0; pt < 4; ++pt) d1[pt] = __builtin_amdgcn_mfma_f32_16x16x32_bf16(bs, Qc[pt][ks], d1[pt], 0, 0, 0); \
            SC_LOADQ1(Qn, row1, (nt * 2 + ks) >> 1, (nt * 2 + ks) & 1);     } \
        _Pragma("unroll") for (int pt = 0; pt < 4; ++pt) { \
            if (nt < 2) { u32x2 pw_; pw_.x = pg8::cvt_pk_bf16(d1[pt][0], d1[pt][1]); pw_.y = pg8::cvt_pk_bf16(d1[pt][2], d1[pt][3]); *(LAS u32x2*)(Pb_ + (w * 64 + 16 * pt + fr) * 40 + 16 * nt + 4 * fq) = pw_; }     \
            else if (fq == 0) Nq_[w * 64 + 16 * pt + fr] = d1[pt][0]; } } \
    SC_LOADQ1(Qn, row1, 3, 0); SC_LOADQ1(Qn, row1, 3, 1); \
    LDS_BARRIER();                                                       \
      \
    f32x4 d2 = (f32x4){0.f, 0.f, 0.f, 0.f}, d3 = (f32x4){0.f, 0.f, 0.f, 0.f}; \
    if (!(abl_ & 2)) {     \
        const int nt2 = w & 1; \
        const bf16x8 vt0 = *(const LAS bf16x8*)(VT + (nt2 * 2 + 0) * 512 + lane * 8), vt1 = *(const LAS bf16x8*)(VT + (nt2 * 2 + 1) * 512 + lane * 8); \
        const bf16x8 vo0 = *(const LAS bf16x8*)(VT + 4 * 512 + lane * 8), vo1 = *(const LAS bf16x8*)(VT + 5 * 512 + lane * 8); \
        d2 = __builtin_amdgcn_mfma_f32_16x16x32_bf16(vt0, C##sg0, d2, 0, 0, 0); d3 = __builtin_amdgcn_mfma_f32_16x16x32_bf16(vo0, C##sg0, d3, 0, 0, 0); \
        d2 = __builtin_amdgcn_mfma_f32_16x16x32_bf16(vt1, C##sg1, d2, 0, 0, 0); d3 = __builtin_amdgcn_mfma_f32_16x16x32_bf16(vo1, C##sg1, d3, 0, 0, 0); } \
      \
    if (!(abl_ & 4)) _Pragma("unroll") for (int nt = 0; nt < 3; ++nt) { \
        const bf16x8 vw0 = *(const LAS bf16x8*)(VW + (nt * 2 + 0) * 512 + lane * 8), vw1 = *(const LAS bf16x8*)(VW + (nt * 2 + 1) * 512 + lane * 8); \
        _Pragma("unroll") for (int mt = 0; mt < 4; ++mt) { f32x4 a = st[mt][nt] * C##dec; \
            a = __builtin_amdgcn_mfma_f32_16x16x32_bf16(Kc[mt][0], vw0, a, 0, 0, 0); \
            a = __builtin_amdgcn_mfma_f32_16x16x32_bf16(Kc[mt][1], vw1, a, 0, 0, 0); st[mt][nt] = a; \
            if (nt < 2) SC_LOADK1(Kn, row1, (nt * 4 + mt) >> 1, (nt * 4 + mt) & 1); } } \
    if (!(abl_ & 8)) {     \
        f32x4 o1 = (f32x4){0.f, 0.f, 0.f, 0.f}; float nq = 0.f; \
        _Pragma("unroll") for (int ww = 0; ww < 8; ++ww) { const u32x2 cpr_ = *(const LAS u32x2*)(Pb_ + (ww * 64 + cp) * 40 + cv); nq += Nq_[ww * 64 + cp]; \
            o1 += (f32x4){bflo(cpr_.x), bfhi(cpr_.x), bflo(cpr_.y), bfhi(cpr_.y)}; } \
        const float den = C##wint * nq + d3[0]; const float scl = __builtin_amdgcn_rcpf(fmaxf(fabsf(den), C##em)); \
        const f32x4 o = (o1 * C##wint + d2) * scl; \
        u32x2 ow; ow.x = pk2(o[0], o[1]); ow.y = pk2(o[2], o[3]); \
        unsigned lo_ = loff; asm volatile("" : "+v"(lo_)); const unsigned hoff_ = ((lo_ >> 4) & 15u) * 64u + (lo_ >> 8) * 8u;     \
        __builtin_amdgcn_raw_buffer_store_b64(ow, rW, hoff_, (rep_ + 1 < SCAN_REP) ? (oC + 512 * DI * 2) : ((hsel == 0 ? oH : (hsel == 1 ? oV : oC)) + (((row0 >> 6) * 4 + hh) * 16 + slice) * 4096 + (w >> 1) * 1024 + (w & 1) * 32), 0); } \
    if (!(abl_ & 16)) SC_VWRITE(buf ^ 1, N);                                     \
} while (0)

__device__ __forceinline__ void scan_phase(LAS unsigned char* lds, unsigned char* ws, int half, const XcdBarrier& bar, int tid, int lane, int wave, int bx) {
    LAS bf16_t* Pbh = (LAS bf16_t*)lds;
    LAS float* NQs = (LAS float*)(lds + 2 * 8 * 64 * 40 * 2);
    LAS bf16_t* VB = (LAS bf16_t*)(NQs + 2 * 8 * 64);
    const int xcd = bx & 7, idx = bx >> 3;
    const int scn = (xcd * 2 + (idx >> 4)) & 15, slice = idx & 15;
    const int bl = scn >> 3, hh = (scn >> 1) & 3, dir = scn & 1, e0 = slice * 32;
    const int fr = lane & 15, fq = lane >> 4, w = wave;
    const int cp = 16 * (w >> 1) + fr, cv = 16 * (w & 1) + 4 * fq;
    const unsigned loff = (unsigned)lane * 16u;
    const unsigned gcp = (unsigned)cp * 4u;
    const unsigned wkoff = (w < 4) ? (unsigned)(32 * ((tid >> 6) & 1) + 8 * ((tid & 63) >> 4)) * 2u : (unsigned)(32 * ((lane >> 2) & 1) + 8 * (lane & 3)) * 2u;
    const __amdgpu_buffer_rsrc_t rW = __builtin_amdgcn_make_buffer_rsrc((void*)ws, 0, (int)(512 * MiB), 0x00020000);
    const int oYH = (int)(WS_YB + ((size_t)CR + (size_t)half * LH) * D * 2);
    const int oQ = (int)(WS_BIG + 3 * SLOT), oK = (int)(WS_BIG + 4 * SLOT), oV = (int)(WS_BIG + 2 * SLOT), oH = (int)(WS_BIG + 0 * SLOT);
    const int oS = oYH, oG = oYH + NCH * 4 * 2 * 8192, oC = oG + NCH * 4 * 2 * 1536;
    for (int i = tid; i < 4 * 1024; i += NTHR) { const int im = i >> 10, r = i & 1023, ln = (r & 511) >> 3; VB[im * 3072 + 2048 + r] = (bf16_t)(((im & 1) == 0 && (ln & 3) == 0) ? 0x3F80u : 0u); }
    __syncthreads();
    for (int rep_ = 0; rep_ < SCAN_REP; ++rep_) {
    const int abl_ = (rep_ + 1 < SCAN_REP) ? SC_ABL : 0;
    f32x4 st[4][3];
#pragma unroll
    for (int a = 0; a < 4; ++a)
#pragma unroll
        for (int b = 0; b < 3; ++b) st[a][b] = (f32x4){0.f, 0.f, 0.f, 0.f};
    bf16x8 Q0[4][2], Q1[4][2], K0[4][2], K1[4][2];
    bf16x8 Asg0, Asg1, Bsg0, Bsg1; u32x4 Av = (u32x4){0u, 0u, 0u, 0u}, Bv = Av, Awka = Av, Bwka = Av; float Awint, Aem, Adec, Bwint, Bem, Bdec;
    { const int r0 = SC_ROW0(0); SC_LOADQ(Q0, r0); SC_LOADK(K0, r0); SC_LOADS(A, r0); SC_VWRITE(0, A); }
#pragma unroll 1
    for (int j = 0; j < 132; j += 2) {
        if (j == 68) xcd_barrier(bar, tid == 0);
        SC_STEP(j, Q0, Q1, K0, K1, A, B);
        SC_STEP(j + 1, Q1, Q0, K1, K0, B, A);
    }
    __syncthreads();
    }
}
#undef SC_ROW0
#undef SC_LOADQ
#undef SC_LOADK
#undef SC_LOADS
#undef SC_VWRITE
#undef SC_STEP

typedef const __attribute__((address_space(4))) Args KA;
__device__ __forceinline__ KA* kargs() { KA* k = (KA*)__builtin_amdgcn_kernarg_segment_ptr(); asm volatile("" : "+s"(k)); return k; }
#define PH_BEGIN() \
    KA* ka = kargs(); unsigned char* ws = ka->ws; (void)ws; \
    int wave = wave0; asm volatile("" : "+s"(wave)); \
    unsigned lz_ = 0u; asm volatile("" : "+v"(lz_)); const int lane = (int)__builtin_amdgcn_mbcnt_hi(~0u, __builtin_amdgcn_mbcnt_lo(~0u, lz_)); \
    const int tid = wave * 64 + lane; (void)tid; \
    const int gw = bx * NWAVES + wave, NGW = G * NWAVES; (void)gw; (void)NGW;

__global__ void __launch_bounds__(NTHR, 2) fwd(Args args) {
    extern __shared__ __attribute__((aligned(16))) unsigned char lds_raw[];
    LAS unsigned char* lds = (LAS unsigned char*)lds_raw;
    const int G = gridDim.x, bx = blockIdx.x;
    const int wave0 = __builtin_amdgcn_readfirstlane(threadIdx.x >> 6);
    volatile LAS unsigned* MISC = (volatile LAS unsigned*)(lds + LDS_MISC);
    if (threadIdx.x < 64) MISC[threadIdx.x] = 0u;
    __syncthreads();
    XcdBarrier bar = xcd_barrier_post((unsigned*)(args.ws + WS_CTL + 65536) + (size_t)args.li * 4096, MISC + 8);
    const int lo = args.ph_lo, hi = args.ph_hi, plast = args.ph_last;
#define IN(k) (lo <= (k) && (k) < hi)
#define SEAM(k) do { if ((k) != plast) { xcd_barrier(bar, tid == 0); if (DUP_BAR) xcd_barrier(bar, tid == 0); } } while (0)

    if (EN_PRO && IN(0)) { PH_BEGIN();
        {
            LAS float* sc = (LAS float*)lds;
            { float xs[10];
#pragma unroll
              for (int q = 0; q < 10; ++q) { const int i = tid + q * NTHR; const int r = i / D, k = i % D; xs[q] = r < 4 ? ka->in[I_C][r * D + k] : ka->in[I_CCTX][k]; }
#pragma unroll
              for (int q = 0; q < 10; ++q) sc[tid + q * NTHR] = siluf(xs[q]); }
            __syncthreads();
            LAS float* red = (LAS float*)(lds + 32768);
            const int kp = tid >> 5, cc = tid & 31;
            for (int item = bx; item < 4 * 192; item += G) {
                const int layer = item / 192, n0 = (item % 192) * 32;
                const float* w = ka->in[I_ADAW] + (size_t)layer * D * 6 * D + (size_t)(kp * 64) * 6 * D + n0 + cc;
                LAS const float* s = sc + kp * 64;
                float a0 = 0.f, a1 = 0.f, a2 = 0.f, a3 = 0.f, a4 = 0.f;
#pragma unroll
                for (int k0 = 0; k0 < 64; k0 += 32) {
                    float wv[32];
#pragma unroll
                    for (int u = 0; u < 32; ++u) wv[u] = w[(size_t)(k0 + u) * 6 * D];
#pragma unroll
                    for (int u = 0; u < 32; ++u) { const int k = k0 + u; a0 += s[k] * wv[u]; a1 += s[D + k] * wv[u]; a2 += s[2 * D + k] * wv[u]; a3 += s[3 * D + k] * wv[u]; a4 += s[4 * D + k] * wv[u]; }
                }
                red[(kp * 32 + cc) * 5 + 0] = a0; red[(kp * 32 + cc) * 5 + 1] = a1; red[(kp * 32 + cc) * 5 + 2] = a2; red[(kp * 32 + cc) * 5 + 3] = a3; red[(kp * 32 + cc) * 5 + 4] = a4;
                __syncthreads();
                if (tid < 160) { const int c2 = tid & 31, r = tid >> 5; float sm = ka->in[I_ADAB][layer * 6 * D + n0 + c2];
#pragma unroll
                    for (int q = 0; q < 16; ++q) sm += red[(q * 32 + c2) * 5 + r];
                    MOD[((size_t)layer * 5 + r) * 6 * D + n0 + c2] = sm; }
                __syncthreads();
            }
        }
        {
            bf16_t* A1 = (bf16_t*)(ws + TAB_A1); bf16_t* A2 = (bf16_t*)(ws + TAB_A2); bf16_t* BZ = (bf16_t*)(ws + TAB_BZ); bf16_t* ACTX = (bf16_t*)(ws + TAB_ACTX);
            const int gt = bx * NTHR + tid, NGT = G * NTHR;
            const float s8192 = 0.011048543456039806f;
            for (int i = gt; i < 512 * 256; i += NGT) { const int m = i / 256, t1 = i % 256, ri = m / 256, t1p = m % 256; const int ph = (t1 * t1p) & 255; float sn, cs; sincospif((float)ph * (2.0f / 256.0f), &sn, &cs);
                A1[i] = (bf16_t)f2bf((ri == 0 ? cs : -sn) * s8192);
                ACTX[i] = (bf16_t)f2bf((ri == 0 ? cs : -sn) * 0.0625f); }
            for (int i = gt; i < 256 * 64 * 64; i += NGT) { const int t1p = i / 4096, m = (i / 64) % 64, k = i % 64; const int rip = m / 32, t2p = m % 32, ri = k / 32, t2 = k % 32;
                const int ph = (t2 * t1p + 256 * t2 * t2p) & 8191; float sn, cs; sincospif((float)ph * (2.0f / 8192.0f), &sn, &cs);
                const float v = (rip == ri) ? cs : (rip == 0 ? sn : -sn); A2[i] = (bf16_t)f2bf(v); }
            for (int i = gt; i < 256 * 512; i += NGT) { const int cp = i / 512, k = i % 512, ri = k / 256, c = k % 256; const int ph = (c * cp) & 255; float sn, cs; sincospif((float)ph * (2.0f / 256.0f), &sn, &cs);
                BZ[i] = (bf16_t)f2bf((ri == 0 ? cs : sn) * 0.0625f); }
        }
        SEAM(0);
    }
    if (EN_PRO && IN(1)) { PH_BEGIN();
        const int nseg = gw < CR ? 2 : 1;
#pragma unroll 1
        for (int seg = 0; seg < nseg; ++seg) {
            const int mi = seg == 0 ? (gw >> 9) : 4, rbeg = seg == 0 ? lat_row(gw >> 9, gw & 511) : gw, nr = seg == 0 ? T / 512 : 1;
            const float* md = MOD + ((size_t)0 * 5 + mi) * 6 * D;
            f32x4 shv[4], scv[4];
#pragma unroll
            for (int j = 0; j < 4; ++j) { shv[j] = *(const f32x4*)(md + 256 * j + 4 * lane); scv[j] = *(const f32x4*)(md + D + 256 * j + 4 * lane) + 1.0f; }
#pragma unroll 2
            for (int k = 0; k < nr; ++k) {
                const int r = rbeg + 512 * k;
                const RowInfo ri = row_info(r);
                const float* xr = ri.is_ctx ? ka->in[I_CTX] + ((size_t)ri.b * CT + ri.t) * D : ka->in[I_X] + ((size_t)ri.b * T + ri.t) * D;
                f32x4 v[4];
#pragma unroll
                for (int j = 0; j < 4; ++j) v[j] = *(const f32x4*)(xr + 256 * j + 4 * lane);
                ln_norm(v, lane);
                bf16_t* o = HIN + (size_t)r * D;
#pragma unroll
                for (int j = 0; j < 4; ++j) { const f32x4 h = v[j] * scv[j] + shv[j]; u32x2 w; w.x = pk2(h[0], h[1]); w.y = pk2(h[2], h[3]); *(u32x2*)(o + 256 * j + 4 * lane) = w; }
            }
        }
    }

    for (int layer = 0; layer < 4; ++layer) {
        const int pb = 2 + layer * PL;
        if (hi <= pb || lo >= pb + PL) continue;
        const int jl = layer >> 1;
        const bool is_m = (layer & 1) == 0;
        if (EN_WC && IN(pb + 0)) { PH_BEGIN();
 for (int rp_ = 0; rp_ < REPN(5); ++rp_) {
            LAS float* scr = (LAS float*)(lds + wave * 16384);
            const int i_in = (D / 64) * (2 * DI / 32), i_h = (DH / 64) * (DH / 32), i_out = (DI / 64) * (D / 32), i_f = (D / 64) * (D / 32), i_1 = (D / 64) * (DFF / 32), i_2 = (DFF / 64) * (D / 32);
            const int n_mix = is_m ? (i_in + 12 * i_h + i_out) : i_f;
            const int nitems = n_mix + i_1 + i_2;
            for (int it = gw; it < nitems; it += NGW) {
                int r = it;
                if (r >= n_mix) { r -= n_mix;
                    if (r < i_1) transpose_item(ka->in[I_W1] + (size_t)layer * D * DFF, D, DFF, W1, 1.f, scr, r, lane);
                    else transpose_item(ka->in[I_W2] + (size_t)layer * DFF * D, DFF, D, W2, 1.f, scr, r - i_1, lane);
                    continue; }
                if (!is_m) { transpose_item(ka->in[I_FWOUT] + (size_t)jl * D * D, D, D, WOUT, 1.f, scr, r, lane); continue; }
                if (r < i_in) { transpose_item(ka->in[I_WIN] + (size_t)jl * D * 2 * DI, D, 2 * DI, WIN, 1.f, scr, r, lane); continue; } r -= i_in;
                if (r < 12 * i_h) { const int which = r / (4 * i_h), hh = (r / i_h) % 4, rr = r % i_h;
                    const float* src = ka->in[which == 0 ? I_WQ : (which == 1 ? I_WK : I_WV)] + ((size_t)jl * NH + hh) * DH * DH;
                    bf16_t* dst = (which == 0 ? WQ : (which == 1 ? WK : WV)) + (size_t)hh * DH * DH;
                    transpose_item(src, DH, DH, dst, which == 1 ? 0.044194173824159216f : 1.f, scr, rr, lane); continue; } r -= 12 * i_h;
                transpose_item(ka->in[I_WOUT] + (size_t)jl * DI * D, DI, D, WOUT, 1.f, scr, r, lane);
            }
            if (is_m) {
                const float* wg = ka->in[I_WGATE] + (size_t)jl * 3 * DI * 16;
                const int n = lane & 15, eq = lane >> 4;
                for (int k2 = gw; k2 < DI; k2 += NGW) {
                    const int hh = k2 / DH, d = k2 % DH;
                    const float* q = ka->in[I_WQ] + (((size_t)jl * NH + hh) * DH + d) * DH + eq * 128; const float* kx = ka->in[I_WK] + (((size_t)jl * NH + hh) * DH + d) * DH + eq * 128;
                    const float* vx = ka->in[I_WV] + (((size_t)jl * NH + hh) * DH + d) * DH + eq * 128;
                    const float* g0 = wg + ((size_t)0 * DI + hh * DH + eq * 128) * 16 + n; const float* g1 = wg + ((size_t)1 * DI + hh * DH + eq * 128) * 16 + n; const float* g2 = wg + ((size_t)2 * DI + hh * DH + eq * 128) * 16 + n;
                    float s0 = 0.f, s1 = 0.f, s2 = 0.f;
#pragma unroll 8
                    for (int e = 0; e < 128; ++e) { s0 += q[e] * g0[e * 16]; s1 += kx[e] * g1[e * 16]; s2 += vx[e] * g2[e * 16]; }
                    float sa = s0 + 0.044194173824159216f * s1;
                    sa += shx(sa, 16, lane); sa += shx(sa, 32, lane); s2 += shx(s2, 16, lane); s2 += shx(s2, 32, lane);
                    if (lane < 16) { GATET[(size_t)n * 4096 + k2] = (bf16_t)f2bf(sa); GATET[(size_t)n * 4096 + DI + k2] = (bf16_t)f2bf(s2); }
                    else if (lane < 64) { GATET[(size_t)(16 + (lane - 16)) * 4096 + k2] = (bf16_t)0; GATET[(size_t)(16 + (lane - 16)) * 4096 + DI + k2] = (bf16_t)0; }
                }
            }
 }
            SEAM(pb + 0);
        }

        if (EN_MIX && is_m) {
            for (int half = 0; half < 2; ++half) {
                const int hb = pb + 1 + 9 * half;
                if (hi <= hb || lo >= hb + 9) continue;
                if (IN(hb + 0)) { PH_BEGIN();
 for (int rp_ = 0; rp_ < REPN(0); ++rp_) {
                    pg8::Gemm g{HH, WIN, D, D, D, 0, 0, LH / 256, DI / 256, 1};
                    pg8::EpiStore E{S0 + (size_t)LAT0 * DI, 0, DI, 0};
                    pg8::gemm_phase(lds, g, E, G, bx, tid); if (DUP_MIX) pg8::gemm_phase(lds, g, E, G, bx, tid);
                    { SmallGemm sg{HHC, WIN, D, D, D, D, D, 0, 0}; SmallDense sd{S0, 0, DI, LAT0 / 64, DI / 64, 0, 0, 0}; gemm_small_dense(lds, sg, sd, 1, G, bx, tid); if (DUP_CTX) gemm_small_dense(lds, sg, sd, 1, G, bx, tid); }
 }
                    SEAM(hb + 0);
                }
                if (IN(hb + 1)) { PH_BEGIN();
                    const bool v_first = (bx & 1) != 0;
                    if (v_first) {
                    { pg8::Gemm g{WV, S0 + (size_t)LAT0 * DI, DH, DI, DH, (long)DH * DH, DH, DH / 256, LH / 256, NH};
                      pg8::EpiStore E{S2, 0, 0, 0, 3, LAT0};
                      pg8::gemm_phase(lds, g, E, G, bx, tid); if (DUP_MIX) pg8::gemm_phase(lds, g, E, G, bx, tid); }
                    { SmallGemm sg{WV, S0, DH, DI, DH, DH, DH, 0, 0}; SmallDense sd{S2, 0, 0, DH / 64, LAT0 / 64, 0, (long)DH * DH, DH, 3}; gemm_small_dense(lds, sg, sd, NH, G, bx, tid); if (DUP_CTX) gemm_small_dense(lds, sg, sd, NH, G, bx, tid); }
                    }
 for (int rp_ = 0; rp_ < REPN(3); ++rp_) {
                    const float* wc = ka->in[I_WCONV] + (size_t)jl * 9 * DI; const float* bc = ka->in[I_BCONV] + (size_t)jl * DI;
                    const int gt = bx * NTHR + tid, NGT = G * NTHR;
                    for (int i = gt; i < 2 * 128 * 2 * (DI / 8); i += NGT) {
                        const int cg = i & 255, rest = i >> 8, hr = rest & 1, r = (rest >> 1) & 127, bl = rest >> 8, c0 = cg * 8, gc0 = 32 * hr;
                        float wv[9][8], bv[8];
#pragma unroll
                        for (int tp = 0; tp < 9; ++tp) { const f32x4 a0 = *(const f32x4*)(wc + (size_t)tp * DI + c0), a1 = *(const f32x4*)(wc + (size_t)tp * DI + c0 + 4);
                            wv[tp][0] = a0[0]; wv[tp][1] = a0[1]; wv[tp][2] = a0[2]; wv[tp][3] = a0[3]; wv[tp][4] = a1[0]; wv[tp][5] = a1[1]; wv[tp][6] = a1[2]; wv[tp][7] = a1[3]; }
                        { const f32x4 a0 = *(const f32x4*)(bc + c0), a1 = *(const f32x4*)(bc + c0 + 4); bv[0] = a0[0]; bv[1] = a0[1]; bv[2] = a0[2]; bv[3] = a0[3]; bv[4] = a1[0]; bv[5] = a1[1]; bv[6] = a1[2]; bv[7] = a1[3]; }
                        const bf16_t* xb = S0 + (size_t)(LAT0 + bl * T + r * 64) * DI + c0;
                        bf16_t* ob = S1 + (size_t)(LAT0 + bl * T + r * 64) * DI + c0;
                        const bool rok[3] = {r > 0, true, r < 127};
                        float win[3][3][8];
                        u32x4 raw[3][3];
#define CV_RAWLOAD(slot, col) do { _Pragma("unroll") for (int di = 0; di < 3; ++di) { u32x4 xv = (u32x4){0u, 0u, 0u, 0u}; \
                                if (rok[di] && (col) >= 0 && (col) < 64 && (col) <= gc0 + 32) xv = *(const u32x4*)(xb + (ptrdiff_t)((di - 1) * 64 + (col)) * DI); raw[slot][di] = xv; } } while (0)
#define CV_CONVERT(slot) do { _Pragma("unroll") for (int di = 0; di < 3; ++di) { const u32x4 xv = raw[slot][di]; \
                                win[slot][di][0] = bflo(xv.x); win[slot][di][1] = bfhi(xv.x); win[slot][di][2] = bflo(xv.y); win[slot][di][3] = bfhi(xv.y); \
                                win[slot][di][4] = bflo(xv.z); win[slot][di][5] = bfhi(xv.z); win[slot][di][6] = bflo(xv.w); win[slot][di][7] = bfhi(xv.w); } } while (0)
#define CV_STEP(sl, sm, sr) do { CV_CONVERT(sr); CV_RAWLOAD(sr, gc + 4); \
                                if (gc < gc0 + 32) { float acc[8]; \
                                    _Pragma("unroll") for (int e = 0; e < 8; ++e) { float s = bv[e]; \
                                        _Pragma("unroll") for (int di = 0; di < 3; ++di) s += win[sl][di][e] * wv[di * 3 + 0][e] + win[sm][di][e] * wv[di * 3 + 1][e] + win[sr][di][e] * wv[di * 3 + 2][e]; \
                                        acc[e] = siluf(s); } \
                                    u32x4 o; o.x = pk2(acc[0], acc[1]); o.y = pk2(acc[2], acc[3]); o.z = pk2(acc[4], acc[5]); o.w = pk2(acc[6], acc[7]); \
                                    *(u32x4*)(ob + (size_t)gc * DI) = o; } \
                                ++gc; } while (0)
                        int gc = gc0;
                        CV_RAWLOAD(0, gc0 - 1); CV_RAWLOAD(1, gc0); CV_RAWLOAD(2, gc0 + 1);
                        CV_CONVERT(0); CV_RAWLOAD(0, gc0 + 2); CV_CONVERT(1); CV_RAWLOAD(1, gc0 + 3);
#pragma unroll 1
                        for (int g3 = 0; g3 < 11; ++g3) { CV_STEP(0, 1, 2); CV_STEP(1, 2, 0); CV_STEP(2, 0, 1); }
#undef CV_RAWLOAD
#undef CV_CONVERT
#undef CV_STEP
                    }
                    for (int i = gt; i < LAT0 * (DI / 8); i += NGT) {
                        const int q = i / (DI / 8), c0 = (i % (DI / 8)) * 8, t = q % CT;
                        float acc[8];
#pragma unroll
                        for (int e = 0; e < 8; ++e) acc[e] = bc[c0 + e];
#pragma unroll
                        for (int dj = 0; dj < 3; ++dj) { const int tt = t + dj - 1; if (tt < 0 || tt >= CT) continue;
                            const u32x4 xv = *(const u32x4*)(S0 + (size_t)(q + dj - 1) * DI + c0); const float* w = wc + (size_t)(3 + dj) * DI + c0;
                            acc[0] += bflo(xv.x) * w[0]; acc[1] += bfhi(xv.x) * w[1]; acc[2] += bflo(xv.y) * w[2]; acc[3] += bfhi(xv.y) * w[3];
                            acc[4] += bflo(xv.z) * w[4]; acc[5] += bfhi(xv.z) * w[5]; acc[6] += bflo(xv.w) * w[6]; acc[7] += bfhi(xv.w) * w[7]; }
                        u32x4 o; o.x = pk2(siluf(acc[0]), siluf(acc[1])); o.y = pk2(siluf(acc[2]), siluf(acc[3])); o.z = pk2(siluf(acc[4]), siluf(acc[5])); o.w = pk2(siluf(acc[6]), siluf(acc[7]));
                        *(u32x4*)(S1 + (size_t)q * DI + c0) = o;
                    }
 }
                    if (!v_first) {
                    { pg8::Gemm g{WV, S0 + (size_t)LAT0 * DI, DH, DI, DH, (long)DH * DH, DH, DH / 256, LH / 256, NH};
                      pg8::EpiStore E{S2, 0, 0, 0, 3, LAT0};
                      pg8::gemm_phase(lds, g, E, G, bx, tid); if (DUP_MIX) pg8::gemm_phase(lds, g, E, G, bx, tid); }
                    { SmallGemm sg{WV, S0, DH, DI, DH, DH, DH, 0, 0}; SmallDense sd{S2, 0, 0, DH / 64, LAT0 / 64, 0, (long)DH * DH, DH, 3}; gemm_small_dense(lds, sg, sd, NH, G, bx, tid); if (DUP_CTX) gemm_small_dense(lds, sg, sd, NH, G, bx, tid); }
                    }
                    SEAM(hb + 1);
                }
                if (IN(hb + 2)) { PH_BEGIN();
 for (int rp_ = 0; rp_ < REPN(0); ++rp_) {
                    {
                      SmallGemm sg{S1, GATET, DI, 4096, 1024, 1024, 1024, 0, 0};
                      const long xm_off = (long)(S0 - S1);
                      auto dec = [=](int uq, long& ao, long& bo) { const int u = uq >> 2, q = uq & 3; ao = (long)u * 64 * DI + (q & 1) * 1024 + (q >> 1) * xm_off; bo = q * 1024; };
                      auto epi = [=](int uq, int m, int n, const f32x4& v) { const int u = uq >> 2, q = uq & 3; if (n < 16) *(f32x4*)(PREQ + (size_t)q * RH * 16 + ((size_t)u * 64 + m) * 16 + n) = v; };
                      gemm_small(lds, sg, NCH * 4, dec, epi, G, bx, tid); }
 }
                    SEAM(hb + 2);
                }
                if (IN(hb + 3)) { PH_BEGIN();
 for (int rp_ = 0; rp_ < REPN(0); ++rp_) {
                    { pg8::Gemm g{S1 + (size_t)LAT0 * DI, WQ, DI, DH, DH, DH, (long)DH * DH, LH / 256, DH / 256, NH}; pg8::EpiStore E{S3, DH, DI, 0, 1, LAT0}; pg8::gemm_phase(lds, g, E, G, bx, tid); if (DUP_MIX) pg8::gemm_phase(lds, g, E, G, bx, tid); }
                    if (bx >= 128) { SmallGemm sg{S1, WQ, DI, DH, DH, DH, DH, 0, 0}; SmallDense sd{S3, DH, DI, LAT0 / 64, DH / 64, 0, DH, (long)DH * DH, 1}; gemm_small_dense(lds, sg, sd, NH, G - 128, bx - 128, tid); }
                    { pg8::Gemm g{WK, S1 + (size_t)LAT0 * DI, DH, DI, DH, (long)DH * DH, DH, DH / 256, LH / 256, NH}; pg8::EpiStore E{S4, (long)DH * RH, RH, 0, 2, LAT0}; pg8::gemm_phase(lds, g, E, G, bx, tid); if (DUP_MIX) pg8::gemm_phase(lds, g, E, G, bx, tid); }
                    if (bx >= 128) { SmallGemm sg{WK, S1, DH, DI, DH, DH, DH, 0, 0}; SmallDense sd{S4, (long)DH * RH, RH, DH / 64, LAT0 / 64, 0, (long)DH * DH, DH, 2}; gemm_small_dense(lds, sg, sd, NH, G - 128, bx - 128, tid); }
                    if (bx < 128) {
                        const int sc = bx >> 3, part = bx & 7, bl = sc >> 3, hh = (sc >> 1) & 3, dir = sc & 1;
                        unsigned* g12cnt = (unsigned*)(ws + WS_CTL + 4096) + ((jl * 2 + half) * 16 + sc) * 16;
                        unsigned* g12tot = (unsigned*)(ws + WS_PRE) + (size_t)((jl * 2 + half) * 16 + sc) * 132 * 2;
                        LAS float* bcs = (LAS float*)lds;
                        LAS float* vss = bcs + 132 * 64;
                        LAS float* bl_ = vss + 132 * 64;
                        LAS float* vm_ = bl_ + 132;
                        LAS float* mi_ = vm_ + 132;
                        const int u = lane, p = dir ? 63 - u : u;
                        const float* bgp = ka->in[I_BGATE] + (size_t)jl * 16 + 8 * dir + hh;
#pragma unroll
                        for (int ii = 0; ii < 3; ++ii) { const int i = part + 8 * ii; const int j = wave + 8 * i;
                            if (i < 17 && j < 132) { int row0; if (j < 4) { const int c = dir ? 3 - j : j; row0 = bl * CT + c * 64; } else { const int c = dir ? 127 - (j - 4) : (j - 4); row0 = LAT0 + bl * T + c * 64; }
                                const float* pr = PREQ + (size_t)(row0 + p) * 16 + 8 * dir + hh; const size_t qs = (size_t)RH * 16;
                                bcs[j * 64 + p] = (pr[4] + pr[qs + 4]) + (pr[2 * qs + 4] + pr[3 * qs + 4]) + bgp[4]; vss[j * 64 + p] = (pr[0] + pr[qs]) + (pr[2 * qs] + pr[3 * qs]) + bgp[0]; } }
                        asm volatile("s_waitcnt vmcnt(0) lgkmcnt(0)" ::: "memory");
#pragma unroll 1
                        for (int ii = 0; ii < 3; ++ii) { const int i = part + 8 * ii; const int j = wave + 8 * i;
                            if (i < 17 && j < 132) { const float f = bcs[j * 64 + p], lia = vss[j * 64 + p]; float x = fminf(f, 0.f) - log1pf(__expf(-fabsf(f)));
                                x = scan_add64(x);
                                const float v = lia - x; float pm = v;
                                pm = scan_max64(pm);
                                bcs[j * 64 + p] = x; vss[j * 64 + p] = v;
                                if (u == 63) { __hip_atomic_store(g12tot + 2 * j, __builtin_bit_cast(unsigned, x), __ATOMIC_RELAXED, __HIP_MEMORY_SCOPE_AGENT); __hip_atomic_store(g12tot + 2 * j + 1, __builtin_bit_cast(unsigned, pm), __ATOMIC_RELAXED, __HIP_MEMORY_SCOPE_AGENT); } } }
                        asm volatile("s_waitcnt vmcnt(0)" ::: "memory");
                        __syncthreads();
                        if (tid == 0) { (void)xb_add(g12cnt, 1u); unsigned sp_ = 0u; while (xb_ld(g12cnt) < 8u && ++sp_ < XB_SPIN_CAP) __builtin_amdgcn_s_sleep(1); }
                        __syncthreads();
                        if (tid < 132) { bl_[tid] = __builtin_bit_cast(float, xb_ld(g12tot + 2 * tid)); vm_[tid] = __builtin_bit_cast(float, xb_ld(g12tot + 2 * tid + 1)); }
                        __syncthreads();
                        if (wave == 0) {
                            const float ni = -__builtin_inff();
                            float ea[3], eb[3];
#pragma unroll
                            for (int t = 0; t < 3; ++t) { const int j = 3 * lane + t; const bool ok = j < 132; const float blj = bl_[ok ? j : 0], vmj = vm_[ok ? j : 0]; ea[t] = ok ? blj : 0.f; eb[t] = ok ? blj + vmj : ni; }
                            float A = ea[0] + ea[1], B = fmaxf(eb[0] + ea[1], eb[1]); B = fmaxf(B + ea[2], eb[2]); A += ea[2];
#define G12_STEP(CTRL, RM) do { const float pa_ = dppf<CTRL, RM>(0.f, A), pb_ = dppf<CTRL, RM>(ni, B); B = fmaxf(pb_ + A, B); A += pa_; } while (0)
                            G12_STEP(0x111, 0xF); G12_STEP(0x112, 0xF); G12_STEP(0x114, 0xF); G12_STEP(0x118, 0xF); G12_STEP(0x142, 0xA); G12_STEP(0x143, 0xC);
#undef G12_STEP
                            float EA = shup(A, 1, lane), EB = shup(B, 1, lane); if (lane == 0) { EA = 0.f; EB = ni; }
                            float m = fmaxf(EA, EB);
#pragma unroll
                            for (int t = 0; t < 3; ++t) { const int j = 3 * lane + t; if (j < 132) { mi_[j] = m; m = fmaxf(m + ea[t], eb[t]); } }
                        }
                        __syncthreads();
                        float* GPw = (float*)(YH + (size_t)NCH * 4 * 2 * 4096);
#pragma unroll 1
                        for (int ii = 0; ii < 3; ++ii) { const int i = part + 8 * ii; const int j = wave + 8 * i;
                            if (i < 17 && j < 132) { int row0; if (j < 4) { const int c = dir ? 3 - j : j; row0 = bl * CT + c * 64; } else { const int c = dir ? 127 - (j - 4) : (j - 4); row0 = LAT0 + bl * T + c * 64; }
                                const float bc = bcs[j * 64 + p], v = vss[j * 64 + p]; float pm = v;
                                pm = scan_max64(pm);
                                const float m_in = mi_[j], btot = bl_[j], m_new = btot + fmaxf(m_in, vm_[j]);
                                const float uu = -fmaxf(m_in, pm);
                                float* gp = GPw + ((size_t)((row0 >> 6) * 4 + hh) * 2 + dir) * 384;
                                gp[p] = uu; gp[64 + p] = v; gp[128 + p] = __expf(m_in + uu); gp[192 + p] = __expf(uu - bc); ((bf16_t*)(gp + 324))[p] = (bf16_t)f2bf(__expf(btot - m_new + v));
                                if (u == 0) gp[320] = __expf(btot + m_in - m_new); } }
                    }
 }
                    SEAM(hb + 3);
                }
                if (IN(hb + 4)) { PH_BEGIN();
 for (int rp_ = 0; rp_ < REPN(4); ++rp_) {
                    SmallGemm sg{S3, S4, DI, DI, DH, DH, DH, 0, 0, 1, 1};
                    bf16_t* SGw = YH; const float* GPr = (const float*)(YH + (size_t)NCH * 4 * 2 * 4096);
                    auto dec = [=](int u, long& ao, long& bo) { ao = u; bo = u; };
                    auto epi = [=](int u, int m, int n, const f32x4& v) {
#pragma unroll
                        for (int dir = 0; dir < 2; ++dir) { const float* gp = GPr + ((size_t)u * 2 + dir) * 384; const float up = gp[m]; const f32x4 vs = *(const f32x4*)(gp + 64 + n); float o[4];
#pragma unroll
                            for (int i = 0; i < 4; ++i) { const int s = n + i; const bool ok = dir ? (s >= m) : (s <= m); const float gte = ok ? __expf(up + vs[i]) : 0.f; o[i] = v[i] * gte; }
                            u32x2 w; w.x = pk2(o[0], o[1]); w.y = pk2(o[2], o[3]);
                            *(u32x2*)(SGw + ((size_t)u * 2 + dir) * 4096 + ((m >> 4) * 2 + (n >> 5)) * 512 + (((n >> 3) & 3) * 16 + (m & 15)) * 8 + (n & 7)) = w; } };
                    gemm_small(lds, sg, NCH * 4, dec, epi, G, bx, tid);
 }
                    SEAM(hb + 4);
                }
                if (EN_SCAN && IN(hb + 5)) { PH_BEGIN();
                    scan_phase(lds, ws, half, bar, tid, lane, wave, bx);
                }
                if (IN(hb + 6)) { PH_BEGIN();
 for (int rp_ = 0; rp_ < REPN(0); ++rp_) {
                    pg8::Gemm g{HH, WIN + (size_t)DI * D, D, D, D, 0, 0, LH / 256, DI / 256, 1};
                    pg8::EpiStore E{ZL, 0, DI, 0};
                    pg8::gemm_phase(lds, g, E, G, bx, tid); if (DUP_MIX) pg8::gemm_phase(lds, g, E, G, bx, tid);
                    if (layer < 2) { SmallGemm sg{HHC, WIN + (size_t)DI * D, D, D, D, D, D, 0, 0}; SmallDense sd{ZC, 0, DI, LAT0 / 64, DI / 64, 0, 0, 0}; gemm_small_dense(lds, sg, sd, 1, G, bx, tid); if (DUP_CTX) gemm_small_dense(lds, sg, sd, 1, G, bx, tid); }
 }
                    SEAM(hb + 6);
                }
                if (IN(hb + 7)) { PH_BEGIN();
 for (int rp_ = 0; rp_ < REPN(3); ++rp_) {
                    const float* gn = ka->in[I_GNW] + (size_t)jl * DI; const float* sk = ka->in[I_SKIP] + (size_t)jl * DI;
#define RO_LOAD(q_, A, B, XC, ZZ) do { const bf16_t* h2_ = ((q_) < LAT0) ? HCB : S2; \
                        _Pragma("unroll") for (int hd = 0; hd < 4; ++hd) { const size_t ho_ = htile_off(q_, hd, 8 * lane); const size_t ro_ = (size_t)(q_) * DI + hd * DH + 8 * lane; \
                            A[hd] = *(const u32x4*)(S0 + ho_); B[hd] = *(const u32x4*)(h2_ + ho_); XC[hd] = *(const u32x4*)(S1 + ro_); ZZ[hd] = *(const u32x4*)(((q_) < LAT0 ? ZC : ZL - (size_t)LAT0 * DI) + ro_); } } while (0)
                    u32x4 ra[4], rb[4], rx[4], rz[4], na[4], nb[4], nx[4], nz[4];
                    f32x4 gnv[4][2], skv[4][2];
#pragma unroll
                    for (int hd = 0; hd < 4; ++hd) { gnv[hd][0] = *(const f32x4*)(gn + hd * DH + 8 * lane); gnv[hd][1] = *(const f32x4*)(gn + hd * DH + 8 * lane + 4); skv[hd][0] = *(const f32x4*)(sk + hd * DH + 8 * lane); skv[hd][1] = *(const f32x4*)(sk + hd * DH + 8 * lane + 4); }
#pragma unroll
                    for (int hd = 0; hd < 4; ++hd) { ra[hd] = (u32x4){0u, 0u, 0u, 0u}; rb[hd] = ra[hd]; rx[hd] = ra[hd]; rz[hd] = ra[hd]; na[hd] = ra[hd]; nb[hd] = ra[hd]; nx[hd] = ra[hd]; nz[hd] = ra[hd]; }
                    const int q_first = (layer < 2 ? 0 : LAT0) + gw;
                    if (q_first < RH) RO_LOAD(q_first, ra, rb, rx, rz);
                    for (int q = q_first; q < RH; q += NGW) {
                        if (q + NGW < RH) RO_LOAD(q + NGW, na, nb, nx, nz);
#pragma unroll
                        for (int hd = 0; hd < 4; ++hd) {
                            const int c0 = hd * DH + 8 * lane;
                            const u32x4 a = ra[hd], b = rb[hd];
                            float v[8] = {bflo(a.x) + bflo(b.x), bfhi(a.x) + bfhi(b.x), bflo(a.y) + bflo(b.y), bfhi(a.y) + bfhi(b.y), bflo(a.z) + bflo(b.z), bfhi(a.z) + bfhi(b.z), bflo(a.w) + bflo(b.w), bfhi(a.w) + bfhi(b.w)};
                            float s = 0.f;
#pragma unroll
                            for (int i = 0; i < 8; ++i) s += v[i];
                            const float mean = wave_sum(s, lane) * (1.f / DH); float s2 = 0.f;
#pragma unroll
                            for (int i = 0; i < 8; ++i) { v[i] -= mean; s2 += v[i] * v[i]; }
                            const float rstd = __builtin_amdgcn_rsqf(wave_sum(s2, lane) * (1.f / DH) + LN_EPS);
                            const u32x4 xc = rx[hd], zz = rz[hd];
                            const float xcf[8] = {bflo(xc.x), bfhi(xc.x), bflo(xc.y), bfhi(xc.y), bflo(xc.z), bfhi(xc.z), bflo(xc.w), bfhi(xc.w)};
                            const float zf[8] = {bflo(zz.x), bfhi(zz.x), bflo(zz.y), bfhi(zz.y), bflo(zz.z), bfhi(zz.z), bflo(zz.w), bfhi(zz.w)};
                            float o[8];
#pragma unroll
                            for (int i = 0; i < 8; ++i) o[i] = (v[i] * rstd * gnv[hd][i >> 2][i & 3] + skv[hd][i >> 2][i & 3] * xcf[i]) * siluf(zf[i]);
                            u32x4 w; w.x = pk2(o[0], o[1]); w.y = pk2(o[2], o[3]); w.z = pk2(o[4], o[5]); w.w = pk2(o[6], o[7]);
                            *(u32x4*)(S4 + (size_t)q * DI + c0) = w;
                        }
#pragma unroll
                        for (int hd = 0; hd < 4; ++hd) { ra[hd] = na[hd]; rb[hd] = nb[hd]; rx[hd] = nx[hd]; rz[hd] = nz[hd]; }
                    }
#undef RO_LOAD
 }
                    SEAM(hb + 7);
                }
                if (IN(hb + 8)) { PH_BEGIN();
 for (int rp_ = 0; rp_ < REPN(0); ++rp_) {
                    pg8::Gemm g{S4 + (size_t)LAT0 * DI, WOUT, DI, DI, DI, 0, 0, LH / 256, D / 256, 1};
                    pg8::EpiStore E{YH, 0, D, 0};
                    pg8::gemm_phase(lds, g, E, G, bx, tid); if (DUP_MIX) pg8::gemm_phase(lds, g, E, G, bx, tid);
                    if (layer < 2) { SmallGemm sg{S4, WOUT, DI, DI, DI, DI, DI, 0, 0}; SmallDense sd{YHC, 0, D, LAT0 / 64, D / 64, 0, 0, 0}; gemm_small_dense(lds, sg, sd, 1, G, bx, tid); if (DUP_CTX) gemm_small_dense(lds, sg, sd, 1, G, bx, tid); }
 }
                    if (half == 1) SEAM(hb + 8);
                }
            }
        } else if (EN_FOUR) {
            const bool has_ctx = layer < 3;
            if (IN(pb + 2)) { PH_BEGIN();
 for (int rp_ = 0; rp_ < REPN(2); ++rp_) {
                { pg8::Gemm g{(const bf16_t*)(ws + TAB_A1), HT, 256, 256, 256, 0, (long)D * T, 2, 128, NB};
                  pg8::EpiStore E{PB, (long)512 * 32768, 32768, 0};
                  pg8::gemm_phase(lds, g, E, G, bx, tid); if (DUP_MIX) pg8::gemm_phase(lds, g, E, G, bx, tid); }
                if (has_ctx) {
                    SmallGemm sg{(const bf16_t*)(ws + TAB_ACTX), HTC, 256, 256, 256, 256, 256, 0, 0};
                    auto dec = [=](int u, long& ao, long& bo) { const int b = u / 128, mb = (u / 16) % 8, cht = u % 16; ao = (long)mb * 64 * 256; bo = ((long)b * D + cht * 64) * CT; };
                    auto epi = [=](int u, int m, int n, const f32x4& v) { const int b = u / 128, mb = (u / 16) % 8, cht = u % 16; const int mg = mb * 64 + m, ri = mg >> 8, tp = mg & 255, ch = cht * 64 + n;
                        u32x2 w; w.x = pk2(v[0], v[1]); w.y = pk2(v[2], v[3]); *(u32x2*)(WC + (size_t)ctx_row(b, tp) * DI + (ch >> 8) * 512 + ri * 256 + (ch & 255)) = w; };
                    gemm_small(lds, sg, NB * 8 * 16, dec, epi, G, bx, tid);
                }
 }
                SEAM(pb + 2);
            }
            if (IN(pb + 3)) { PH_BEGIN();
 for (int rp_ = 0; rp_ < REPN(2); ++rp_) {
                {
                    const int wid = tid >> 6, wm = wid >> 1, wn = wid & 1, fr = lane & 15, fq = lane >> 4;
                    const int lrow = tid >> 3, lk = (tid & 7) * 8;
                    const unsigned stoff = (unsigned)(lrow * SG_LD + lk) * 2u;
                    const unsigned stoffB = (unsigned)(((lrow & 32) + 16 * ((lrow >> 2) & 1) + 4 * ((lrow & 31) >> 3) + (lrow & 3)) * SG_LD + lk) * 2u;
                    LAS unsigned char* As = lds; LAS unsigned char* Bs0 = lds + SG_TILE; LAS unsigned char* Bs1 = lds + 2 * SG_TILE;
                    const bf16_t* A2 = (const bf16_t*)(ws + TAB_A2);
                    for (int pair = bx; pair < NB * 256; pair += G) {
                        const int b = pair >> 8, t1p = pair & 255;
                        const bf16_t* bp = PB + (size_t)b * 512 * 32768 + (size_t)((lk >> 5) * 256 + t1p) * 32768 + (size_t)lrow * 32 + (lk & 31);
                        u32x4 r0 = *(const u32x4*)(bp), r1 = *(const u32x4*)(bp + 2048), r2 = *(const u32x4*)(bp + 2 * 2048), r3 = *(const u32x4*)(bp + 3 * 2048);
                        *(LAS u32x4*)(As + stoff) = *(const u32x4*)(A2 + (size_t)t1p * 4096 + lrow * 64 + lk);
                        *(LAS u32x4*)(Bs0 + stoffB) = r0;
                        LDS_BARRIER();
                        bf16x8 af[2];
#pragma unroll
                        for (int ks = 0; ks < 2; ++ks) af[ks] = *(const LAS bf16x8*)(As + ((wm * 16 + fr) * SG_LD + ks * 32 + fq * 8) * 2);
#define F2_TILE(ct_, BsC, BsN, rcur, rnext) do { \
                            if ((ct_) + 4 < 16) rcur = *(const u32x4*)(bp + ((ct_) + 4) * 2048); \
                            f32x4 acc[2] = {(f32x4){0.f, 0.f, 0.f, 0.f}, (f32x4){0.f, 0.f, 0.f, 0.f}}; \
                            _Pragma("unroll") for (int ks = 0; ks < 2; ++ks) _Pragma("unroll") for (int nt = 0; nt < 2; ++nt) { \
                                const bf16x8 bf = *(const LAS bf16x8*)(BsC + ((wn * 32 + nt * 16 + fr) * SG_LD + ks * 32 + fq * 8) * 2); \
                                acc[nt] = __builtin_amdgcn_mfma_f32_16x16x32_bf16(bf, af[ks], acc[nt], 0, 0, 0); } \
                            if ((ct_) + 1 < 16) *(LAS u32x4*)(BsN + stoffB) = rnext; \
                            { const int m = wm * 16 + fr, rip = m >> 5, t2p = m & 31, ch = (ct_) * 64 + wn * 32 + 8 * fq; \
                                u32x4 w4; w4.x = pk2(acc[0][0], acc[0][1]); w4.y = pk2(acc[0][2], acc[0][3]); w4.z = pk2(acc[1][0], acc[1][1]); w4.w = pk2(acc[1][2], acc[1][3]); \
                                *(u32x4*)(WC + (size_t)lat_row(b, t1p + 256 * t2p) * DI + (ch >> 8) * 512 + rip * 256 + (ch & 255)) = w4; } \
                            LDS_BARRIER(); } while (0)
#pragma unroll 1
                        for (int ct = 0; ct < 16; ct += 4) { F2_TILE(ct, Bs0, Bs1, r0, r1); F2_TILE(ct + 1, Bs1, Bs0, r1, r2); F2_TILE(ct + 2, Bs0, Bs1, r2, r3); F2_TILE(ct + 3, Bs1, Bs0, r3, r0); }
#undef F2_TILE
                    }
                }
 }
                SEAM(pb + 3);
            }
            if (IN(pb + 4)) { PH_BEGIN();
 for (int rp_ = 0; rp_ < REPN(2); ++rp_) {
                pg8::Gemm g{WC + (size_t)CR * DI, (const bf16_t*)(ws + TAB_BZ), DI, 512, 512, 512, 0, (R - CR) / 256, 1, 4};
                pg8::EpiStore E{ZF + (size_t)CR * D, 256, D, 0};
                pg8::gemm_phase(lds, g, E, G, bx, tid); if (DUP_MIX) pg8::gemm_phase(lds, g, E, G, bx, tid);
                if (has_ctx) { SmallGemm sg{WC, (const bf16_t*)(ws + TAB_BZ), DI, 512, 512, 512, 512, 0, 0}; SmallDense sd{ZF, 256, D, CR / 64, 256 / 64, 0, 512, 0}; gemm_small_dense(lds, sg, sd, 4, G, bx, tid); if (DUP_CTX) gemm_small_dense(lds, sg, sd, 4, G, bx, tid); }
 }
                SEAM(pb + 4);
            }
            if (IN(pb + 5)) { PH_BEGIN();
 for (int rp_ = 0; rp_ < REPN(2); ++rp_) {
                pg8::Gemm g{ZF + (size_t)CR * D, WOUT, D, D, D, 0, 0, (R - CR) / 256, D / 256, 1};
                pg8::EpiStore E{YB + (size_t)CR * D, 0, D, 0};
                pg8::gemm_phase(lds, g, E, G, bx, tid); if (DUP_MIX) pg8::gemm_phase(lds, g, E, G, bx, tid);
                if (has_ctx) { SmallGemm sg{ZF, WOUT, D, D, D, D, D, 0, 0}; SmallDense sd{YB, 0, D, CR / 64, D / 64, 0, 0, 0}; gemm_small_dense(lds, sg, sd, 1, G, bx, tid); if (DUP_CTX) gemm_small_dense(lds, sg, sd, 1, G, bx, tid); }
 }
                SEAM(pb + 5);
            }
        }
#pragma unroll 1
        for (int which = 0; which < 2; ++which) {
            const int pid = pb + (which == 0 ? 19 : 22);
            if (EN_NORM && IN(pid)) { PH_BEGIN();
                const float* pg = ka->in[I_PG] + ((size_t)layer * 2 + which) * D; const float* pbv = ka->in[I_PB] + ((size_t)layer * 2 + which) * D;
                const int mlayer = which == 0 ? layer : layer + 1;
                const int shoff = which == 0 ? 3 * D : 0;
                const int goff = which == 0 ? 2 * D : 5 * D;
                const bool in_f32 = (layer == 0 && which == 0), out_f32 = (layer == 3 && which == 1);
                bf16_t* xbl = (bf16_t*)ka->out; bf16_t* xb3 = S4;
#define NR_LOAD(r_, XW, YW) do { const RowInfo ri_ = row_info(r_); const size_t xi_ = ri_.is_ctx ? ((size_t)ri_.b * CT + ri_.t) * D : ((size_t)ri_.b * T + ri_.t) * D; \
                    const bf16_t* yr_ = YB + (size_t)(r_) * D; \
                    if (in_f32) { const float* xp_ = (ri_.is_ctx ? ka->in[I_CTX] : ka->in[I_X]) + xi_; _Pragma("unroll") for (int j = 0; j < 4; ++j) XW[j] = *(const u32x4*)(xp_ + 256 * j + 4 * lane); } \
                    else { const bf16_t* xp_ = ri_.is_ctx ? (const bf16_t*)CTXX + xi_ : ((layer == 3 && which == 1) ? xb3 + xi_ : xbl + xi_); \
                        _Pragma("unroll") for (int j = 0; j < 4; ++j) { const u32x2 t_ = *(const u32x2*)(xp_ + 256 * j + 4 * lane); XW[j] = (u32x4){t_.x, t_.y, 0u, 0u}; } } \
                    _Pragma("unroll") for (int j = 0; j < 4; ++j) YW[j] = *(const u32x2*)(yr_ + 256 * j + 4 * lane); } while (0)
                if (which == 1 && (layer & 1) == 0) {
                    constexpr int TLD = 1026;
                    LAS bf16_t* TL = (LAS bf16_t*)lds;
                    const float* md2b = MOD + ((size_t)mlayer * 5) * 6 * D + shoff;
#define NT_ROW(r_, i_) do { const RowInfo ri = row_info(r_); const int mi = ri.is_ctx ? 4 : ri.b; \
                        const size_t xi = ri.is_ctx ? ((size_t)ri.b * CT + ri.t) * D : ((size_t)ri.b * T + ri.t) * D; \
                        bf16_t* xout16 = ri.is_ctx ? (bf16_t*)CTXX + xi : xbl + xi; \
                        (void)mi; f32x4 v[4]; \
                        _Pragma("unroll") for (int j = 0; j < 4; ++j) { const f32x4 x = (f32x4){bflo(xw[j].x), bfhi(xw[j].x), bflo(xw[j].y), bfhi(xw[j].y)}; \
                            const f32x4 y = (f32x4){bflo(yw[j].x), bfhi(yw[j].x), bflo(yw[j].y), bfhi(yw[j].y)}; v[j] = x * ALPHA + gtv[j] * y; } \
                        ln_norm(v, lane); \
                        _Pragma("unroll") for (int j = 0; j < 4; ++j) { const int c = 256 * j + 4 * lane; v[j] = v[j] * pgv[j] + pbw[j]; \
                            u32x2 xo; xo.x = pk2(v[j][0], v[j][1]); xo.y = pk2(v[j][2], v[j][3]); *(u32x2*)(xout16 + c) = xo; } \
                        ln_norm(v, lane); \
                        _Pragma("unroll") for (int j = 0; j < 4; ++j) { const int c = 256 * j + 4 * lane; \
                            const f32x4 h = v[j] * scv[j] + shv[j]; LAS unsigned* d_ = (LAS unsigned*)(TL + (i_) * TLD + c); d_[0] = pk2(h[0], h[1]); d_[1] = pk2(h[2], h[3]); } } while (0)
#define NT_PARAMS(mi_) do { const float* md_ = MOD + ((size_t)layer * 5 + (mi_)) * 6 * D; const float* md2_ = md2b + (size_t)(mi_) * 6 * D; \
                        _Pragma("unroll") for (int j = 0; j < 4; ++j) { const int c = 256 * j + 4 * lane; gtv[j] = *(const f32x4*)(md_ + goff + c); shv[j] = *(const f32x4*)(md2_ + c); scv[j] = *(const f32x4*)(md2_ + D + c) + 1.0f; } } while (0)
                    u32x4 xw[4], xn[4]; u32x2 yw[4], yn[4];
#pragma unroll
                    for (int j = 0; j < 4; ++j) { xw[j] = (u32x4){0u, 0u, 0u, 0u}; xn[j] = xw[j]; yw[j] = (u32x2){0u, 0u}; yn[j] = yw[j]; }
                    f32x4 pgv[4], pbw[4], gtv[4], shv[4], scv[4];
#pragma unroll
                    for (int j = 0; j < 4; ++j) { pgv[j] = *(const f32x4*)(pg + 256 * j + 4 * lane); pbw[j] = *(const f32x4*)(pbv + 256 * j + 4 * lane); }
                    for (int item = bx; item < NB * 32 * 4; item += G) {
                        const int b = item >> 7, t2 = (item >> 2) & 31, tb = item & 3;
                        NT_PARAMS(b);
                        const int rbase = lat_row(b, 32 * (64 * tb + wave * 8) + t2);
                        NR_LOAD(rbase, xw, yw);
#pragma unroll 1
                        for (int j8 = 0; j8 < 8; ++j8) {
                            if (j8 < 7) NR_LOAD(rbase + 32 * (j8 + 1), xn, yn);
                            NT_ROW(rbase + 32 * j8, wave * 8 + j8);
#pragma unroll
                            for (int j = 0; j < 4; ++j) { xw[j] = xn[j]; yw[j] = yn[j]; }
                        }
                        LDS_BARRIER();
#pragma unroll 4
                        for (int k = 0; k < 16; ++k) { const int idx = k * NTHR + tid, g8 = idx & 7, ch = idx >> 3; const LAS bf16_t* s = TL + (8 * g8) * TLD + ch;
                            u32x4 o; o.x = (unsigned)s[0] | ((unsigned)s[TLD] << 16); o.y = (unsigned)s[2 * TLD] | ((unsigned)s[3 * TLD] << 16); o.z = (unsigned)s[4 * TLD] | ((unsigned)s[5 * TLD] << 16); o.w = (unsigned)s[6 * TLD] | ((unsigned)s[7 * TLD] << 16);
                            *(u32x4*)(HT + (((size_t)b * D + ch) * 32 + t2) * 256 + 64 * tb + 8 * g8) = o; }
                        LDS_BARRIER();
                    }
                    if (layer < 2) {
                        NT_PARAMS(4);
                        for (int item = bx; item < NB * (CT / 8); item += G) {
                            const int b = item / (CT / 8), t8 = item % (CT / 8);
                            const int r = ctx_row(b, 8 * t8 + wave);
                            NR_LOAD(r, xw, yw);
                            NT_ROW(r, wave);
                            LDS_BARRIER();
#pragma unroll
                            for (int k = 0; k < 2; ++k) { const int ch = k * NTHR + tid; const LAS bf16_t* s = TL + ch;
                                u32x4 o; o.x = (unsigned)s[0] | ((unsigned)s[TLD] << 16); o.y = (unsigned)s[2 * TLD] | ((unsigned)s[3 * TLD] << 16); o.z = (unsigned)s[4 * TLD] | ((unsigned)s[5 * TLD] << 16); o.w = (unsigned)s[6 * TLD] | ((unsigned)s[7 * TLD] << 16);
                                *(u32x4*)(HTC + ((size_t)b * D + ch) * CT + 8 * t8) = o; }
                            LDS_BARRIER();
                        }
                    }
#undef NT_ROW
#undef NT_PARAMS
                } else {
                u32x4 xw[4], xn[4]; u32x2 yw[4], yn[4];
#pragma unroll
                for (int j = 0; j < 4; ++j) { xw[j] = (u32x4){0u, 0u, 0u, 0u}; xn[j] = xw[j]; yw[j] = (u32x2){0u, 0u}; yn[j] = yw[j]; }
                f32x4 pgv[4], pbw[4];
#pragma unroll
                for (int j = 0; j < 4; ++j) { pgv[j] = *(const f32x4*)(pg + 256 * j + 4 * lane); pbw[j] = *(const f32x4*)(pbv + 256 * j + 4 * lane); }
                const int nseg = (layer < 2 && gw < CR) ? 2 : 1;
#pragma unroll 1
                for (int seg = 0; seg < nseg; ++seg) {
                    const int mi = seg == 0 ? (gw >> 9) : 4;
                    const int rbeg = seg == 0 ? lat_row(gw >> 9, gw & 511) : gw, nr = seg == 0 ? T / 512 : 1;
                    const float* md = MOD + ((size_t)layer * 5 + mi) * 6 * D;
                    const float* md2 = MOD + ((size_t)(mlayer < 4 ? mlayer : 3) * 5 + mi) * 6 * D + shoff;
                    f32x4 gtv[4], shv[4], scv[4];
#pragma unroll
                    for (int j = 0; j < 4; ++j) { const int c = 256 * j + 4 * lane; gtv[j] = *(const f32x4*)(md + goff + c); shv[j] = *(const f32x4*)(md2 + c); scv[j] = *(const f32x4*)(md2 + D + c) + 1.0f; }
                    NR_LOAD(rbeg, xw, yw);
#pragma unroll 1
                    for (int k = 0; k < nr; ++k) {
                        const int r = rbeg + 512 * k;
                        if (k + 1 < nr) NR_LOAD(r + 512, xn, yn);
                        const RowInfo ri = row_info(r);
                        const size_t xi = ri.is_ctx ? ((size_t)ri.b * CT + ri.t) * D : ((size_t)ri.b * T + ri.t) * D;
                        bf16_t* xout16 = ri.is_ctx ? (bf16_t*)CTXX + xi : ((layer == 3 && which == 0) ? xb3 + xi : xbl + xi);
                        f32x4 v[4];
#pragma unroll
                        for (int j = 0; j < 4; ++j) { f32x4 x; if (in_f32) x = __builtin_bit_cast(f32x4, xw[j]); else x = (f32x4){bflo(xw[j].x), bfhi(xw[j].x), bflo(xw[j].y), bfhi(xw[j].y)};
                            const f32x4 y = (f32x4){bflo(yw[j].x), bfhi(yw[j].x), bflo(yw[j].y), bfhi(yw[j].y)}; v[j] = x * ALPHA + gtv[j] * y; }
                        ln_norm(v, lane);
#pragma unroll
                        for (int j = 0; j < 4; ++j) { const int c = 256 * j + 4 * lane; v[j] = v[j] * pgv[j] + pbw[j];
                            if (out_f32) *(f32x4*)(ka->out + xi + c) = v[j]; else { u32x2 xo; xo.x = pk2(v[j][0], v[j][1]); xo.y = pk2(v[j][2], v[j][3]); *(u32x2*)(xout16 + c) = xo; } }
                        if (mlayer < 4) {
                            ln_norm(v, lane);
                            bf16_t* o = HIN + (size_t)r * D;
#pragma unroll
                            for (int j = 0; j < 4; ++j) { const int c = 256 * j + 4 * lane; const f32x4 h = v[j] * scv[j] + shv[j]; u32x2 w; w.x = pk2(h[0], h[1]); w.y = pk2(h[2], h[3]); *(u32x2*)(o + c) = w; }
                        }
#pragma unroll
                        for (int j = 0; j < 4; ++j) { xw[j] = xn[j]; yw[j] = yn[j]; }
                    }
                }
                }
#undef NR_LOAD
                if (!(which == 1 && layer < 3)) SEAM(pid);
            }
            if (EN_MLP && which == 0) {
                if (IN(pb + 20)) { PH_BEGIN();
 for (int rp_ = 0; rp_ < REPN(1); ++rp_) {
                    pg8::Gemm g{HIN + (size_t)CR * D, W1, D, D, D, 0, 0, (R - CR) / 256, DFF / 256, 1};
                    pg8::EpiStore E{HID + (size_t)CR * DFF, 0, DFF, 1};
                    pg8::gemm_phase(lds, g, E, G, bx, tid);
#if DUP_MLP
                    pg8::gemm_phase(lds, g, E, G, bx, tid);
#endif
                    if (layer < 2) { SmallGemm sg{HIN, W1, D, D, D, D, D, 0, 0}; SmallDense sd{HID, 0, DFF, CR / 64, DFF / 64, 1, 0, 0}; gemm_small_dense(lds, sg, sd, 1, G, bx, tid); }
 }
                    SEAM(pb + 20);
                }
                if (IN(pb + 21)) { PH_BEGIN();
 for (int rp_ = 0; rp_ < REPN(1); ++rp_) {
                    pg8::Gemm g{HID + (size_t)CR * DFF, W2, DFF, DFF, DFF, 0, 0, (R - CR) / 256, D / 256, 1, 1};
                    pg8::EpiStore E{YB + (size_t)CR * D, 0, D, 0};
                    pg8::gemm_phase(lds, g, E, G, bx, tid);
#if DUP_MLP
                    pg8::gemm_phase(lds, g, E, G, bx, tid);
#endif
                    if (layer < 2) { SmallGemm sg{HID, W2, DFF, DFF, DFF, DFF, DFF, 0, 0}; SmallDense sd{YB, 0, D, CR / 64, D / 64, 0, 0, 0}; gemm_small_dense(lds, sg, sd, 1, G, bx, tid); }
 }
                    SEAM(pb + 21);
                }
            }
        }
    }
#undef IN
#undef SEAM
}

extern "C" void kernel_launch(void* const* d_in, const int* in_sizes, int n_in, void* d_out, int out_size, void* d_ws, size_t ws_size, hipStream_t stream) {
    static int grid = 0;
    if (grid == 0) {
        if (n_in != 22 || ws_size < 512 * MiB) { fprintf(stderr, "kernel_launch: unexpected n_in %d / ws_size %zu\n", n_in, ws_size); grid = -1; return; }
        int dev = 0, cus = 0;
        if (hipGetDevice(&dev) != hipSuccess || hipDeviceGetAttribute(&cus, hipDeviceAttributeMultiprocessorCount, dev) != hipSuccess) { grid = -1; return; }
        if (hipFuncSetAttribute((const void*)fwd, hipFuncAttributeMaxDynamicSharedMemorySize, LDS_BYTES) != hipSuccess) { fprintf(stderr, "kernel_launch: hipFuncSetAttribute failed\n"); grid = -1; return; }
        int per_cu = 0;
        if (hipOccupancyMaxActiveBlocksPerMultiprocessor(&per_cu, (const void*)fwd, NTHR, LDS_BYTES) != hipSuccess || per_cu < 1) fprintf(stderr, "kernel_launch: occupancy query says %d\n", per_cu);
        (void)hipGetLastError();
        grid = cus;
        if (grid != 256) fprintf(stderr, "kernel_launch: %d CUs (built for 256)\n", grid);
    }
    if (grid < 0) return;
    (void)hipMemsetAsync((char*)d_ws + WS_CTL, 0, CTL_BYTES, stream);
    Args a{};
    for (int i = 0; i < 22; ++i) a.in[i] = (const float*)d_in[i];
    a.out = (float*)d_out; a.ws = (unsigned char*)d_ws;
#if MK_SINGLE
    { int last = 0; for (int id = 0; id < NPHASE; ++id) if (phase_valid(id)) last = id;
      a.ph_lo = 0; a.ph_hi = NPHASE; a.ph_last = last; a.li = 0;
      hipLaunchKernelGGL(fwd, dim3(grid), dim3(NTHR), LDS_BYTES, stream, a); }
#else
    { int li = 0;
      for (int id = 0; id < NPHASE; ++id) { if (!phase_valid(id)) continue;
          a.ph_lo = id; a.ph_hi = id + 1; a.ph_last = id; a.li = li++;
          hipLaunchKernelGGL(fwd, dim3(grid), dim3(NTHR), LDS_BYTES, stream, a); } }
#endif
}
```
